# Optimizing an MI355X kernel written in HIP

```python
import math
import jax, jax.numpy as jnp
from jax import lax
import numpy as np

D_MODEL = 1024
BATCH = 8
SEQ = 4096
DEPTH = 1

CHUNK = 64
EPS = 1e-6

SSD_WIDTH = D_MODEL // 2
SSD_HEAD_DIM = 64
SSD_HEADS = SSD_WIDTH // SSD_HEAD_DIM
SSD_GROUPS = 2
SSD_HEADS_PER_GROUP = SSD_HEADS // SSD_GROUPS
SSD_STATE = 128
CONV_WIDTH = 4
SSD_CONV_CH = SSD_WIDTH + 2 * SSD_GROUPS * SSD_STATE

DIFF_WIDTH = D_MODEL - SSD_WIDTH
DIFF_HEADS = 4
DIFF_VDIM = DIFF_WIDTH // DIFF_HEADS
DIFF_QKDIM = DIFF_VDIM // 2
ROPE_DIM = DIFF_QKDIM // 4
ROPE_THETA = 500000.0
Q_BLOCK = 128

QK_COLS = DIFF_HEADS * 2 * DIFF_QKDIM
SPLITS = (SSD_WIDTH,
          SSD_WIDTH + SSD_CONV_CH,
          SSD_WIDTH + SSD_CONV_CH + SSD_HEADS,
          SSD_WIDTH + SSD_CONV_CH + SSD_HEADS + QK_COLS,
          SSD_WIDTH + SSD_CONV_CH + SSD_HEADS + 2 * QK_COLS)
IN_COLS = SPLITS[-1] + DIFF_WIDTH
MIX_WIDTH = SSD_WIDTH + DIFF_WIDTH

PEER_HEADS = 8
N_KEYS = 128
N_EXPERTS = N_KEYS * N_KEYS
PEER_KEY_DIM = 256
PEER_HALF = PEER_KEY_DIM // 2
PEER_TOPK = 16
PEER_TOKEN_BLOCK = 128

kernel_name = "hybrid_ssd_diffattn_peer_block"


def rmsnorm(x, w):
    xf = x.astype(jnp.float32)
    y = xf * lax.rsqrt(jnp.mean(xf * xf, axis=-1, keepdims=True) + EPS)
    return (y * w.astype(jnp.float32)).astype(x.dtype)


def rotary_tables(seq):
    inv = jnp.power(ROPE_THETA, -jnp.arange(0, ROPE_DIM, 2, dtype=jnp.float32) / ROPE_DIM)
    ang = jnp.arange(seq, dtype=jnp.float32)[:, None] * inv[None, :]
    return jnp.cos(ang), jnp.sin(ang)


def partial_rotary(x, cos, sin):
    half = ROPE_DIM // 2
    c = cos[:, None, None, :]
    s = sin[:, None, None, :]
    xf = x.astype(jnp.float32)
    x1, x2, xp = xf[..., :half], xf[..., half:ROPE_DIM], xf[..., ROPE_DIM:]
    out = jnp.concatenate([x1 * c - x2 * s, x1 * s + x2 * c, xp], axis=-1)
    return out.astype(x.dtype)


def causal_depthwise_conv(u, w, b):
    out = lax.conv_general_dilated(
        u, w[:, None, :].astype(u.dtype), window_strides=(1,),
        padding=[(CONV_WIDTH - 1, 0)],
        dimension_numbers=('NWC', 'WIO', 'NWC'),
        feature_group_count=u.shape[-1])
    return out + b.astype(u.dtype)


def ssd_branch(z, xbc, dt_raw, conv_w, conv_b, dt_bias, a_log, d_skip, norm_w):
    f32 = jnp.float32
    b, s, _ = z.shape
    nc = s // CHUNK
    G, HG = SSD_GROUPS, SSD_HEADS_PER_GROUP
    xbc = jax.nn.silu(causal_depthwise_conv(xbc, conv_w, conv_b))
    xs, bm, cm = jnp.split(xbc, [SSD_WIDTH, SSD_WIDTH + G * SSD_STATE], axis=-1)
    xs = xs.reshape(b, nc, CHUNK, G, HG, SSD_HEAD_DIM).astype(f32)
    bm = bm.reshape(b, nc, CHUNK, G, SSD_STATE).astype(f32)
    cm = cm.reshape(b, nc, CHUNK, G, SSD_STATE).astype(f32)
    dt = jax.nn.softplus(dt_raw.astype(f32) + dt_bias.astype(f32)).reshape(b, nc, CHUNK, G, HG)
    a = -jnp.exp(a_log.astype(f32)).reshape(G, HG)
    a_cs = jnp.cumsum(dt * a, axis=2)
    xdt = xs * dt[..., None]
    seg = a_cs[:, :, :, None] - a_cs[:, :, None, :]
    causal = jnp.tril(jnp.ones((CHUNK, CHUNK), dtype=bool))[:, :, None, None]
    decay = jnp.exp(jnp.where(causal, seg, -jnp.inf))
    cb = jnp.einsum('bclgn,bcsgn->bclsg', cm, bm)
    y_diag = jnp.einsum('bclsg,bclsgh,bcsghp->bclghp', cb, decay, xdt)
    decay_to_end = jnp.exp(a_cs[:, :, -1:] - a_cs)
    states = jnp.einsum('bclgn,bclgh,bclghp->bcghpn', bm, decay_to_end, xdt)
    chunk_decay = jnp.exp(a_cs[:, :, -1])

    def step(carry, inp):
        st, dc = inp
        return carry * dc[..., None, None] + st, carry

    init = jnp.zeros_like(states[:, 0])
    _, prev = lax.scan(step, init, (jnp.moveaxis(states, 1, 0), jnp.moveaxis(chunk_decay, 1, 0)))
    prev = jnp.moveaxis(prev, 0, 1)
    y_off = jnp.einsum('bclgn,bcghpn,bclgh->bclghp', cm, prev, jnp.exp(a_cs))
    y = y_diag + y_off + xs * d_skip.astype(f32).reshape(G, HG)[:, :, None]
    y = y.reshape(b, s, SSD_WIDTH)
    y = (y * jax.nn.silu(z.astype(f32))).reshape(b, s, G, SSD_WIDTH // G)
    y = y * lax.rsqrt(jnp.mean(y * y, axis=-1, keepdims=True) + EPS)
    y = y.reshape(b, s, SSD_WIDTH) * norm_w.astype(f32)
    return y.astype(z.dtype)


def diff_attention(q, k, v, qn_w, kn_w, lq1, lk1, lq2, lk2, subln_w, lambda_init, cos, sin):
    f32 = jnp.float32
    b, s, _ = q.shape
    nb = s // Q_BLOCK
    q = q.reshape(b, s, DIFF_HEADS, 2, DIFF_QKDIM)
    k = k.reshape(b, s, DIFF_HEADS, 2, DIFF_QKDIM)
    vf = v.reshape(b, s, DIFF_HEADS, DIFF_VDIM).astype(f32)
    q = partial_rotary(rmsnorm(q, qn_w), cos, sin).astype(f32)
    kf = partial_rotary(rmsnorm(k, kn_w), cos, sin).astype(f32)
    lam = (jnp.exp(jnp.sum(lq1.astype(f32) * lk1.astype(f32)))
           - jnp.exp(jnp.sum(lq2.astype(f32) * lk2.astype(f32))) + lambda_init)
    qb = jnp.moveaxis(q.reshape(b, nb, Q_BLOCK, DIFF_HEADS, 2, DIFF_QKDIM), 1, 0)
    k_chunk = jnp.arange(s) // CHUNK
    scale = DIFF_QKDIM ** -0.5

    def block(args):
        qi, i = args
        q_chunk = (i * Q_BLOCK + jnp.arange(Q_BLOCK)) // CHUNK
        mask = k_chunk[None, :] <= q_chunk[:, None]
        sc = jnp.einsum('bqhjd,bkhjd->bhjqk', qi, kf) * scale
        p = jax.nn.softmax(jnp.where(mask, sc, -jnp.inf), axis=-1)
        attn = p[:, :, 0] - lam * p[:, :, 1]
        return jnp.einsum('bhqk,bkhd->bqhd', attn, vf)

    o = lax.map(block, (qb, jnp.arange(nb)))
    o = jnp.moveaxis(o, 0, 1).reshape(b, s, DIFF_HEADS, DIFF_VDIM)
    o = rmsnorm(o, subln_w) * (1.0 - lambda_init)
    return o.reshape(b, s, DIFF_WIDTH).astype(v.dtype)


def peer_ffn(x, w_q, sub_keys, u, v):
    f32 = jnp.float32
    b, s, d = x.shape
    tb = PEER_TOKEN_BLOCK
    xt = x.reshape((b * s) // tb, tb, d)
    K = PEER_TOPK

    def block(xb):
        q = (xb @ w_q).reshape(tb, PEER_HEADS, 2, PEER_HALF).astype(f32)
        sc = jnp.einsum('thjd,hjnd->thjn', q, sub_keys.astype(f32))
        s_half, i_half = lax.top_k(sc, K)
        cand = (s_half[:, :, 0, :, None] + s_half[:, :, 1, None, :]).reshape(tb, PEER_HEADS, K * K)
        cand_idx = (i_half[:, :, 0, :, None] * N_KEYS + i_half[:, :, 1, None, :]).reshape(tb, PEER_HEADS, K * K)
        top_s, top_pos = lax.top_k(cand, K)
        idx = jnp.take_along_axis(cand_idx, top_pos, axis=-1)
        g = jax.nn.softmax(top_s, axis=-1)
        u_sel = u[idx]
        v_sel = v[idx]
        h = jax.nn.gelu(jnp.einsum('td,thkd->thk', xb, u_sel).astype(f32), approximate=False)
        return jnp.einsum('thk,thkd->td', (g * h).astype(xb.dtype), v_sel)

    out = lax.map(block, xt)
    return out.reshape(b, s, d).astype(x.dtype)


def setup_inputs(seed: int = 0) -> dict:
    key = jax.random.key(seed)
    ks = jax.random.split(key, 24)
    f32 = jnp.float32
    nrm = lambda k, shape, sc: jax.random.normal(k, shape, f32) * sc
    L = DEPTH
    dt0 = jnp.exp(jax.random.uniform(ks[5], (L, SSD_HEADS), f32) * (math.log(0.1) - math.log(0.001)) + math.log(0.001))
    return {
        'x': nrm(ks[0], (BATCH, SEQ, D_MODEL), 1.0),
        'mix_norm_w': 1.0 + nrm(ks[1], (L, D_MODEL), 0.05),
        'w_in': nrm(ks[2], (L, D_MODEL, IN_COLS), D_MODEL ** -0.5),
        'conv_w': nrm(ks[3], (L, CONV_WIDTH, SSD_CONV_CH), CONV_WIDTH ** -0.5),
        'conv_b': nrm(ks[4], (L, SSD_CONV_CH), 0.02),
        'dt_bias': dt0 + jnp.log(-jnp.expm1(-dt0)),
        'a_log': jnp.log(jax.random.uniform(ks[6], (L, SSD_HEADS), f32, 1.0, 16.0)),
        'd_skip': 1.0 + nrm(ks[7], (L, SSD_HEADS), 0.1),
        'ssd_norm_w': 1.0 + nrm(ks[8], (L, SSD_WIDTH), 0.05),
        'q_norm_w': 1.0 + nrm(ks[9], (L, DIFF_QKDIM), 0.05),
        'k_norm_w': 1.0 + nrm(ks[10], (L, DIFF_QKDIM), 0.05),
        'lambda_q1': nrm(ks[11], (L, DIFF_QKDIM), 0.1),
        'lambda_k1': nrm(ks[12], (L, DIFF_QKDIM), 0.1),
        'lambda_q2': nrm(ks[13], (L, DIFF_QKDIM), 0.1),
        'lambda_k2': nrm(ks[14], (L, DIFF_QKDIM), 0.1),
        'subln_w': 1.0 + nrm(ks[15], (L, DIFF_VDIM), 0.05),
        'w_out': nrm(ks[16], (L, MIX_WIDTH, D_MODEL), MIX_WIDTH ** -0.5),
        'ffn_norm_w': 1.0 + nrm(ks[17], (L, D_MODEL), 0.05),
        'peer_w_q': nrm(ks[18], (L, D_MODEL, PEER_HEADS * PEER_KEY_DIM), D_MODEL ** -0.5),
        'peer_sub_keys': nrm(ks[19], (L, PEER_HEADS, 2, N_KEYS, PEER_HALF), PEER_HALF ** -0.5),
        'peer_u': nrm(ks[20], (L, N_EXPERTS, D_MODEL), D_MODEL ** -0.5),
        'peer_v': nrm(ks[21], (L, N_EXPERTS, D_MODEL), 0.5),
    }


def reference(x, mix_norm_w, w_in, conv_w, conv_b, dt_bias, a_log, d_skip, ssd_norm_w,
              q_norm_w, k_norm_w, lambda_q1, lambda_k1, lambda_q2, lambda_k2, subln_w,
              w_out, ffn_norm_w, peer_w_q, peer_sub_keys, peer_u, peer_v):
    cos, sin = rotary_tables(x.shape[1])
    for layer in range(DEPTH):
        lambda_init = 0.8 - 0.6 * math.exp(-0.3 * layer)
        hn = rmsnorm(x, mix_norm_w[layer])
        proj = hn @ w_in[layer]
        z, xbc, dt_raw, q, k, v = jnp.split(proj, SPLITS, axis=-1)
        y_ssd = ssd_branch(z, xbc, dt_raw, conv_w[layer], conv_b[layer], dt_bias[layer],
                           a_log[layer], d_skip[layer], ssd_norm_w[layer])
        y_diff = diff_attention(q, k, v, q_norm_w[layer], k_norm_w[layer], lambda_q1[layer],
                                lambda_k1[layer], lambda_q2[layer], lambda_k2[layer],
                                subln_w[layer], lambda_init, cos, sin)
        x = x + jnp.concatenate([y_ssd, y_diff], axis=-1) @ w_out[layer]
        x = x + peer_ffn(rmsnorm(x, ffn_norm_w[layer]), peer_w_q[layer], peer_sub_keys[layer],
                         peer_u[layer], peer_v[layer])
    return x
```

```cpp
#include <hip/hip_runtime.h>
#include <cstdio>
#include <cstdint>

#define LAS __attribute__((address_space(3)))
#define GAS __attribute__((address_space(1)))
typedef unsigned short bf16_t;
typedef short bf16x8 __attribute__((ext_vector_type(8)));
typedef short s16x4 __attribute__((ext_vector_type(4)));
typedef float f32x4 __attribute__((ext_vector_type(4)));
typedef float f32x8 __attribute__((ext_vector_type(8)));
typedef float f32x16 __attribute__((ext_vector_type(16)));
typedef unsigned u32x4 __attribute__((ext_vector_type(4)));
typedef unsigned u32x2 __attribute__((ext_vector_type(2)));

constexpr int NB = 8, SEQ = 4096, TOK = NB * SEQ, DM = 1024;
constexpr int NIN = 3072;
constexpr int PZ = 0, PXS = 512, PBM = 1024, PCM = 1280, PQ = 1536, PK = 2048, PV = 2560;
constexpr int CHUNK = 64, NCH = SEQ / CHUNK;
constexpr int NHS = 8;
constexpr float EPSN = 1e-6f;
constexpr int PEER_H = 8, NKEYS = 128, TOPK = 16;
constexpr float LAMBDA_INIT = 0.2f;

constexpr size_t MiB = 1u << 20;
constexpr size_t WS_CTL = 0, CTL_BYTES = 1 * MiB;
constexpr size_t WS_WINT = 1 * MiB;
constexpr size_t WS_WOUTT = 7 * MiB;
constexpr size_t WS_WQT = 9 * MiB;
constexpr size_t WS_KEYS = 13 * MiB;
constexpr size_t WS_ROPE = 13 * MiB + 512 * 1024;
constexpr size_t WS_MISC = 13 * MiB + 768 * 1024;
constexpr size_t WS_DTRAW = 14 * MiB;
constexpr size_t WS_ACS = 15 * MiB;
constexpr size_t WS_CDEC = 16 * MiB;
constexpr size_t WS_UB = 20 * MiB;
constexpr size_t WS_VB = 52 * MiB;
constexpr size_t WS_XB = 84 * MiB;
constexpr size_t WS_YCAT = WS_XB;
constexpr size_t WS_PROJ = 148 * MiB;
constexpr size_t WS_QP = WS_PROJ;
constexpr size_t WS_IDX = 276 * MiB;
constexpr size_t WS_GW = 292 * MiB;
constexpr size_t WS_CMC = 340 * MiB;
constexpr size_t WS_STATES = 356 * MiB;
constexpr size_t WS_X1B = WS_STATES;
constexpr size_t WS_END = 484 * MiB;
constexpr int CW_BAR = 4096;
constexpr int CW_ROWSQ = 131072;
static_assert((CW_ROWSQ + TOK) * 4 <= (int)CTL_BYTES, "ctl");

constexpr int LDS_BYTES = 163840;

__device__ __forceinline__ float bf2f(unsigned h) { return __uint_as_float(h << 16); }
__device__ __forceinline__ unsigned f2bf(float f) { unsigned u = __float_as_uint(f); return (u + 0x7fffu + ((u >> 16) & 1u)) >> 16; }
__device__ __forceinline__ unsigned pk2(float lo, float hi) { return f2bf(lo) | (f2bf(hi) << 16); }
__device__ __forceinline__ float wave_sum(float v) {
#pragma unroll
    for (int o = 1; o < 64; o <<= 1) v += __shfl_xor(v, o);
    return v;
}
__device__ __forceinline__ float silu_f(float x) { return x / (1.f + __expf(-x)); }
__device__ __forceinline__ f32x4 mfma16(bf16x8 a, bf16x8 b, f32x4 c) { return __builtin_amdgcn_mfma_f32_16x16x32_bf16(a, b, c, 0, 0, 0); }
__device__ __forceinline__ f32x16 mfma32(bf16x8 a, bf16x8 b, f32x16 c) { return __builtin_amdgcn_mfma_f32_32x32x16_bf16(a, b, c, 0, 0, 0); }
#define LDS_WAIT() asm volatile("s_waitcnt lgkmcnt(0)" ::: "memory")
#define VM_WAIT() asm volatile("s_waitcnt vmcnt(0)" ::: "memory")

namespace pg8 {
#define PG8_LAS __attribute__((address_space(3)))
typedef unsigned short bf16_t;
typedef short bf16x8 __attribute__((ext_vector_type(8)));
typedef float f32x4 __attribute__((ext_vector_type(4)));
typedef unsigned u32x4 __attribute__((ext_vector_type(4)));
constexpr int BM = 256, BK = 64, HALF = 128, HTB = HALF * BK * 2  , STAGE_BYTES = 8 * HTB, NXCD = 8, WGM = 8;

__host__ __device__ __forceinline__ int lds_byte(int r, int c) { const int st = (r >> 4) * 2 + (c >> 5), rr = r & 15, cc = c & 31, ob = rr * 64 + cc * 2; return st * 1024 + (ob ^ (((ob >> 9) & 1) << 5)); }
__host__ __device__ __forceinline__ void stage_rc(int b, int& R, int& C) { const int st = b / 1024, sb = b % 1024, swz = sb ^ (((sb >> 9) & 1) << 5); R = (st >> 1) * 16 + swz / 64; C = (st & 1) * 32 + (swz % 64) / 2; }
__host__ __device__ __forceinline__ int perm32(int rho) { const int n = rho >> 4, i = rho & 15; return 8 * (i >> 2) + 4 * n + (i & 3); }

struct Unit { int pm, pn; };
struct Gemm { const bf16_t* A; const bf16_t* Bt; int M, N, K; };

struct StaticOrder {
    int nM, nN, nwg, G, c;
    __host__ __device__ void init(int M, int N, int G_, int c_) { nM = M / BM; nN = N / BM; nwg = nM * nN; G = G_; c = c_; }
    __host__ __device__ bool next(int i, Unit& u) const {
        const long L = (long)i * G + c; if (L >= nwg) return false;
        int wgid = (int)L; { const int q = nwg / NXCD, r = nwg % NXCD, xcd = wgid % NXCD, off = wgid / NXCD; wgid = (xcd < r ? xcd * (q + 1) : r * (q + 1) + (xcd - r) * q) + off; }
        const int nig = WGM * nN, gid = wgid / nig, fm = gid * WGM, gsz = (nM - fm) < WGM ? (nM - fm) : WGM;
        u.pm = fm + ((wgid % nig) % gsz); u.pn = (wgid % nig) / gsz; return true;
    }
    __device__ __forceinline__ void a_ready(const Unit&) const {}
    __device__ __forceinline__ void done(const Unit&) const {}
};

__device__ __forceinline__ unsigned cvt_pk_bf16(float lo, float hi) { unsigned r; asm volatile("v_cvt_pk_bf16_f32 %0, %1, %2" : "=v"(r) : "v"(lo), "v"(hi)); return r; }
typedef float f32x2 __attribute__((ext_vector_type(2)));
__device__ __forceinline__ f32x2 gelu_pk(f32x2 v) {
    const f32x2 av = __builtin_elementwise_abs(v), d = av * 0.2316418882f + 1.0f;
    f32x2 t; t.x = __builtin_amdgcn_rcpf(d.x); t.y = __builtin_amdgcn_rcpf(d.y);
    f32x2 q = t * 0.5307027145f + (-0.7265760135f); q = q * t + 0.7107068705f; q = q * t + (-0.142248368f); q = q * t + 0.127414796f; q = q * t;
    const f32x2 s = (v * v) * (-0.72134752044f);
    f32x2 e; e.x = __builtin_amdgcn_exp2f(s.x); e.y = __builtin_amdgcn_exp2f(s.y);
    const f32x2 m = v * (q * e), r = v - m;
    f32x2 o; o.x = v.x < 0.f ? m.x : r.x; o.y = v.y < 0.f ? m.y : r.y; return o;
}

template <int ACT  > struct EpiBf16 {
    static constexpr bool PERM = true, AFTER_DRAIN = false; static_assert(ACT == 0 || ACT == 1, "EpiBf16: ACT is 0 (none) or 1 (gelu_pk)");
    bf16_t* O; int ldc; const float* bias; int split_cols; size_t split_stride; float scale0;
    __device__ __forceinline__ void operator()(const f32x4 (&acc)[2][2][4][2], const Unit& u, int wr, int wc, int fr, int fq) const {
        const int row0 = u.pm * BM + wr * 64 + fr; int colt = u.pn * BM; bf16_t* base = O;
        float sc = 1.f; if (split_cols) { const int t = colt / split_cols; base += (size_t)t * split_stride; colt -= t * split_cols; if (t == 0) sc = scale0; }
        const int col0 = colt + wc * 32 + 8 * fq, bcol0 = u.pn * BM + wc * 32 + 8 * fq;
        f32x4 bv[2][2];
#pragma unroll
        for (int bj = 0; bj < 2; ++bj)
#pragma unroll
            for (int n = 0; n < 2; ++n) bv[bj][n] = bias ? *(const f32x4*)(bias + bcol0 + bj * HALF + 4 * n) : (f32x4){0.f, 0.f, 0.f, 0.f};
#pragma unroll
        for (int ai = 0; ai < 2; ++ai)
#pragma unroll
            for (int m = 0; m < 4; ++m) { bf16_t* rowp = base + (size_t)(row0 + ai * HALF + m * 16) * ldc + col0;
#pragma unroll
                for (int bj = 0; bj < 2; ++bj) { f32x4 v0 = acc[ai][bj][m][0] + bv[bj][0], v1 = acc[ai][bj][m][1] + bv[bj][1];
                    if (ACT == 1) { f32x2 a = gelu_pk((f32x2){v0[0], v0[1]}), b = gelu_pk((f32x2){v0[2], v0[3]}), c = gelu_pk((f32x2){v1[0], v1[1]}), d = gelu_pk((f32x2){v1[2], v1[3]});
                        v0 = (f32x4){a.x, a.y, b.x, b.y}; v1 = (f32x4){c.x, c.y, d.x, d.y}; }
                    v0 = v0 * sc; v1 = v1 * sc; u32x4 w; w.x = cvt_pk_bf16(v0[0], v0[1]); w.y = cvt_pk_bf16(v0[2], v0[3]); w.z = cvt_pk_bf16(v1[0], v1[1]); w.w = cvt_pk_bf16(v1[2], v1[3]);
                    *(u32x4*)(rowp + bj * HALF) = w; } }
    }
};

struct EpiResid {
    static constexpr bool PERM = false, AFTER_DRAIN = false;
    const float* x; float* out; bf16_t* xb; float* rowsq; int ldc;
    __device__ __forceinline__ void operator()(const f32x4 (&acc)[2][2][4][2], const Unit& u, int wr, int wc, int fr, int fq) const {
        const int col0 = u.pn * BM + wc * 32 + 4 * fq;
#pragma unroll
        for (int ai = 0; ai < 2; ++ai)
#pragma unroll
            for (int m = 0; m < 4; ++m) {
                const int row = u.pm * BM + ai * HALF + wr * 64 + m * 16 + fr;
                const size_t off = (size_t)row * ldc + col0;
                float ss = 0.f;
#pragma unroll
                for (int bj = 0; bj < 2; ++bj)
#pragma unroll
                    for (int n = 0; n < 2; ++n) {
                        const size_t c = off + bj * HALF + n * 16;
                        const f32x4 xv = *(const f32x4*)(x + c);
                        const f32x4 o = xv + acc[ai][bj][m][n];
                        *(f32x4*)(out + c) = o;
                        ss += (o[0] * o[0] + o[1] * o[1]) + (o[2] * o[2] + o[3] * o[3]);
                        typedef unsigned u32x2v __attribute__((ext_vector_type(2)));
                        u32x2v w; w.x = cvt_pk_bf16(o[0], o[1]); w.y = cvt_pk_bf16(o[2], o[3]);
                        *(u32x2v*)(xb + c) = w;
                    }
                ss += __shfl_xor(ss, 16); ss += __shfl_xor(ss, 32);
                if (fq == 0) atomicAdd(rowsq + row, ss);
            }
    }
};

template <class Epi, class Sched, bool ALIGN_EPI = false, bool SP2 = false>
__device__ __forceinline__ void gemm_phase(PG8_LAS unsigned char* lds, const Gemm g, const Sched& S, const Epi& E) {
    const int tid = threadIdx.x, wid = __builtin_amdgcn_readfirstlane(tid >> 6), lane = tid & 63, wr = wid >> 2, wc = wid & 3, fr = lane & 15, fq = lane >> 4;
    const int K = g.K, nt = K / BK;
    unsigned voffA[2], voffB[2];
#pragma unroll
    for (int i = 0; i < 2; ++i) { int R, C; stage_rc(tid * 16 + i * 8192, R, C); const int Rb = Epi::PERM ? ((R & ~31) + perm32(R & 31)) : R;
        voffA[i] = (unsigned)(R * K + C) * 2u; voffB[i] = (unsigned)(Rb * K + C) * 2u; }
    const size_t kstep = (size_t)(BK * 2);
    const size_t hstep = (size_t)HALF * K * 2;
    const size_t tstep = 2 * hstep;
    const unsigned ldsw = (unsigned)wid * 1024u;
    const int aoff = lds_byte(wr * 64 + fr, fq * 8), boff = lds_byte(wc * 32 + fr, fq * 8);
#define PG8_SA(b, h) (((b) * 2 + (h)) * HTB)
#define PG8_SB(b, h) ((4 + (b) * 2 + (h)) * HTB)
#define PG8_STAGE(bufoff, gbase, voff) do { _Pragma("unroll") for (int _i = 0; _i < 2; ++_i) \
        __builtin_amdgcn_global_load_lds((const unsigned*)((const char*)(gbase) + (voff)[_i]), (PG8_LAS unsigned*)(lds + (bufoff) + ldsw + _i * 8192), 16, 0, 0); } while (0)
#define PG8_LDA(dst, b, h) do { _Pragma("unroll") for (int m = 0; m < 4; ++m) _Pragma("unroll") for (int k = 0; k < 2; ++k) dst[m][k] = *(const PG8_LAS bf16x8*)(lds + PG8_SA(b, h) + aoff + m * 2048 + k * 1024); } while (0)
#define PG8_LDB(dst, b, h) do { _Pragma("unroll") for (int n = 0; n < 2; ++n) _Pragma("unroll") for (int k = 0; k < 2; ++k) dst[n][k] = *(const PG8_LAS bf16x8*)(lds + PG8_SB(b, h) + boff + n * 2048 + k * 1024); } while (0)
#define PG8_MMA(ai, bj, At, Bt) do { __builtin_amdgcn_s_setprio(1); _Pragma("unroll") for (int m = 0; m < 4; ++m) _Pragma("unroll") for (int n = 0; n < 2; ++n) _Pragma("unroll") for (int k = 0; k < 2; ++k) \
        acc[ai][bj][m][n] = __builtin_amdgcn_mfma_f32_16x16x32_bf16(Bt[n][k], At[m][k], acc[ai][bj][m][n], 0, 0, 0); __builtin_amdgcn_s_setprio(0); } while (0)
#define PG8_WAIT_V(n) asm volatile("s_waitcnt vmcnt(" #n ")" ::: "memory")
#define PG8_WAIT_L(n) asm volatile("s_waitcnt lgkmcnt(" #n ")" ::: "memory")
#define PG8_BAR __builtin_amdgcn_s_barrier()
#define PG8_SCHED __builtin_amdgcn_sched_barrier(0)
    Unit cur, nxt; int ui = 0;
    if (!S.next(0, cur)) return;
    f32x4 acc[2][2][4][2];
#pragma unroll
    for (int a = 0; a < 2; ++a)
#pragma unroll
        for (int b = 0; b < 2; ++b)
#pragma unroll
            for (int m = 0; m < 4; ++m)
#pragma unroll
                for (int n = 0; n < 2; ++n) acc[a][b][m][n] = (f32x4){0.f, 0.f, 0.f, 0.f};
    bf16x8 At[4][2], B0[2][2], B1[2][2];
    const char* cA = (const char*)g.A + (size_t)cur.pm * tstep; const char* cB = (const char*)g.Bt + (size_t)cur.pn * tstep;
    S.a_ready(cur);
    if constexpr (SP2) {
        PG8_STAGE(PG8_SB(0, 0), cB, voffB); PG8_STAGE(PG8_SB(0, 1), cB + hstep, voffB); PG8_STAGE(PG8_SA(0, 0), cA, voffA); PG8_STAGE(PG8_SA(0, 1), cA + hstep, voffA);
        if (wr == 1) PG8_BAR;
        PG8_WAIT_V(2); PG8_BAR;
        PG8_STAGE(PG8_SB(1, 0), cB + kstep, voffB); PG8_STAGE(PG8_SA(1, 0), cA + kstep, voffA); PG8_STAGE(PG8_SB(1, 1), cB + hstep + kstep, voffB);
        PG8_WAIT_V(6); PG8_BAR;
    } else {
        PG8_STAGE(PG8_SB(0, 0), cB, voffB); PG8_STAGE(PG8_SA(0, 0), cA, voffA); PG8_STAGE(PG8_SB(0, 1), cB + hstep, voffB); PG8_STAGE(PG8_SA(0, 1), cA + hstep, voffA);
        if (wr == 1) PG8_BAR;
        PG8_WAIT_V(4); PG8_BAR;
        PG8_STAGE(PG8_SB(1, 0), cB + kstep, voffB); PG8_STAGE(PG8_SA(1, 0), cA + kstep, voffA); PG8_STAGE(PG8_SB(1, 1), cB + hstep + kstep, voffB);
        PG8_WAIT_V(6); PG8_BAR;
    }
    for (;;) {
        const bool has_next = S.next(ui + 1, nxt);
        const char* nA = has_next ? (const char*)g.A + (size_t)nxt.pm * tstep : cA; const char* nB = has_next ? (const char*)g.Bt + (size_t)nxt.pn * tstep : cB;
        for (int t = 0; t < nt; t += 2) {
            const bool last = (t == nt - 2);
            const char* a1 = cA + (size_t)(t + 1) * kstep;
            const char* a2 = last ? nA : cA + (size_t)(t + 2) * kstep; const char* b2 = last ? nB : cB + (size_t)(t + 2) * kstep;
            const char* a3 = a2 + kstep; const char* b3 = b2 + kstep;
            if (last && has_next) S.a_ready(nxt);
            if constexpr (SP2) {
            PG8_LDB(B0, 0, 0); PG8_LDB(B1, 0, 1); PG8_SCHED; PG8_LDA(At, 0, 0); PG8_STAGE(PG8_SA(1, 1), a1 + hstep, voffA);
            PG8_WAIT_V(8); PG8_WAIT_L(0); PG8_BAR; PG8_MMA(0, 0, At, B0); PG8_MMA(0, 1, At, B1); PG8_BAR; PG8_SCHED;
            PG8_LDA(At, 0, 1); PG8_STAGE(PG8_SB(0, 0), b2, voffB); PG8_STAGE(PG8_SB(0, 1), b2 + hstep, voffB); PG8_STAGE(PG8_SA(0, 0), a2, voffA);
            PG8_WAIT_V(8); PG8_WAIT_L(0); PG8_BAR; PG8_MMA(1, 0, At, B0); PG8_MMA(1, 1, At, B1); PG8_BAR; PG8_SCHED;
            PG8_LDB(B0, 1, 0); PG8_LDB(B1, 1, 1); PG8_SCHED; PG8_LDA(At, 1, 0); PG8_STAGE(PG8_SA(0, 1), a2 + hstep, voffA);
            PG8_WAIT_V(8); PG8_WAIT_L(0); PG8_BAR; PG8_MMA(0, 0, At, B0); PG8_MMA(0, 1, At, B1); PG8_BAR; PG8_SCHED;
            PG8_LDA(At, 1, 1); PG8_STAGE(PG8_SB(1, 0), b3, voffB); PG8_STAGE(PG8_SB(1, 1), b3 + hstep, voffB); PG8_STAGE(PG8_SA(1, 0), a3, voffA);
            PG8_WAIT_V(8); PG8_WAIT_L(0); PG8_BAR; PG8_MMA(1, 0, At, B0); PG8_MMA(1, 1, At, B1); PG8_BAR; PG8_SCHED;
            } else {
            PG8_LDB(B0, 0, 0); PG8_SCHED; PG8_LDA(At, 0, 0); PG8_STAGE(PG8_SA(1, 1), a1 + hstep, voffA);
            PG8_WAIT_L(8); PG8_BAR; PG8_WAIT_L(0); PG8_MMA(0, 0, At, B0); PG8_BAR; PG8_SCHED;
            PG8_LDB(B1, 0, 1); PG8_STAGE(PG8_SB(0, 0), b2, voffB);
            PG8_BAR; PG8_WAIT_L(0); PG8_MMA(0, 1, At, B1); PG8_BAR;
            PG8_LDA(At, 0, 1); PG8_STAGE(PG8_SA(0, 0), a2, voffA);
            PG8_BAR; PG8_WAIT_L(0); PG8_MMA(1, 0, At, B0); PG8_BAR; PG8_SCHED;
            PG8_STAGE(PG8_SB(0, 1), b2 + hstep, voffB);
            PG8_WAIT_V(6); PG8_BAR; PG8_MMA(1, 1, At, B1); PG8_BAR;
            PG8_LDB(B0, 1, 0); PG8_SCHED; PG8_LDA(At, 1, 0); PG8_STAGE(PG8_SA(0, 1), a2 + hstep, voffA);
            PG8_WAIT_L(8); PG8_BAR; PG8_WAIT_L(0); PG8_MMA(0, 0, At, B0); PG8_BAR; PG8_SCHED;
            PG8_LDB(B1, 1, 1); PG8_STAGE(PG8_SB(1, 0), b3, voffB);
            PG8_BAR; PG8_WAIT_L(0); PG8_MMA(0, 1, At, B1); PG8_BAR;
            PG8_LDA(At, 1, 1); PG8_STAGE(PG8_SA(1, 0), a3, voffA);
            PG8_BAR; PG8_WAIT_L(0); PG8_MMA(1, 0, At, B0); PG8_BAR; PG8_SCHED;
            PG8_STAGE(PG8_SB(1, 1), b3 + hstep, voffB);
            PG8_WAIT_V(6); PG8_BAR; PG8_MMA(1, 1, At, B1); PG8_BAR;
            }
        }
        if constexpr (ALIGN_EPI) { if (wr == 0) PG8_BAR; }
        if constexpr (!Epi::AFTER_DRAIN) { E(acc, cur, wr, wc, fr, fq); S.done(cur); }
        if (!has_next) break;
#pragma unroll
        for (int a = 0; a < 2; ++a)
#pragma unroll
            for (int b = 0; b < 2; ++b)
#pragma unroll
                for (int m = 0; m < 4; ++m)
#pragma unroll
                    for (int n = 0; n < 2; ++n) acc[a][b][m][n] = (f32x4){0.f, 0.f, 0.f, 0.f};
        cur = nxt; cA = nA; cB = nB; ++ui;
        if constexpr (ALIGN_EPI) { if (wr == 1) PG8_BAR; }
    }
    PG8_WAIT_V(0);
    if constexpr (!ALIGN_EPI) { if (wr == 0) PG8_BAR; }
    PG8_BAR;
    if constexpr (Epi::AFTER_DRAIN) { E.fused(acc, cur, wr, wc, fr, fq, lds, wid, lane); S.done(cur); }
#undef PG8_SA
#undef PG8_SB
#undef PG8_STAGE
#undef PG8_LDA
#undef PG8_LDB
#undef PG8_MMA
#undef PG8_WAIT_V
#undef PG8_WAIT_L
#undef PG8_BAR
#undef PG8_SCHED
}
}

struct Params {
    const float* in[22];
    float* out;
    unsigned char* ws;
    int ph_lo, ph_hi;
};
struct Ctx { LAS unsigned char* lds; int tid, lane, wave, vcu, G, gw, ngw; };

__device__ __forceinline__ void p0_transpose_item(const float* W, int K, int Nreal, int thresh, const float* ksc, bf16_t* WT, LAS float* scr, int item, int nblk, int lane) {
    const int kb = item / nblk, nb = item % nblk, k0 = 64 * kb, n0 = 32 * nb;
    const int nr0 = n0 + (n0 >= thresh ? 8 : 0);
#pragma unroll 8
    for (int i = 0; i < 32; ++i) {
        const int kk = 2 * i + (lane >> 5);
        const float sc = ksc ? ksc[k0 + kk] : 1.f;
        scr[kk * 33 + (lane & 31)] = W[(size_t)(k0 + kk) * Nreal + nr0 + (lane & 31)] * sc;
    }
    LDS_WAIT(); asm volatile("" ::: "memory");
    const int c = lane & 7;
#pragma unroll
    for (int j = 0; j < 4; ++j) {
        const int n = (lane >> 3) + 8 * j; const LAS float* s = scr + (8 * c) * 33 + n;
        u32x4 o; o.x = pk2(s[0 * 33], s[1 * 33]); o.y = pk2(s[2 * 33], s[3 * 33]); o.z = pk2(s[4 * 33], s[5 * 33]); o.w = pk2(s[6 * 33], s[7 * 33]);
        *(u32x4*)(WT + (size_t)(n0 + n) * K + k0 + 8 * c) = o;
    }
    LDS_WAIT(); asm volatile("" ::: "memory");
}

__device__ __forceinline__ void phase0(const Params& p, Ctx& F) {
    const float* x = p.in[0]; const float* mixw = p.in[1]; const float* w_in = p.in[2];
    const float* w_out = p.in[16]; const float* ffnw = p.in[17]; const float* w_q = p.in[18]; const float* keys = p.in[19];
    const float* pu = p.in[20]; const float* pv = p.in[21];
    unsigned char* ws = p.ws;
    LAS float* scr = (LAS float*)(F.lds + F.wave * 8448);
    LAS float* wdt = (LAS float*)(F.lds + 69632);
    for (int k = F.tid; k < DM; k += 512) {
        const float s = mixw[k];
        const f32x4 a = *(const f32x4*)(w_in + (size_t)k * 3080 + 1536), b = *(const f32x4*)(w_in + (size_t)k * 3080 + 1540);
        *(LAS f32x4*)(wdt + k * 8) = a * s; *(LAS f32x4*)(wdt + k * 8 + 4) = b * s;
    }
    __syncthreads();
    constexpr int I_IN = 16 * 96, I_OUT = 16 * 32, I_Q = 16 * 64;
    for (int it = F.gw; it < I_IN + I_OUT + I_Q; it += F.ngw) {
        int r = it;
        if (r < I_IN) { p0_transpose_item(w_in, DM, 3080, 1536, mixw, (bf16_t*)(ws + WS_WINT), scr, r, 96, F.lane); continue; } r -= I_IN;
        if (r < I_OUT) { p0_transpose_item(w_out, DM, DM, 1 << 30, nullptr, (bf16_t*)(ws + WS_WOUTT), scr, r, 32, F.lane); continue; } r -= I_OUT;
        p0_transpose_item(w_q, DM, 2048, 1 << 30, ffnw, (bf16_t*)(ws + WS_WQT), scr, r, 64, F.lane);
    }
    const int gtid = F.vcu * 512 + F.tid, nthr = F.G * 512;
    for (int i = gtid; i < 16 * 128 * 128 / 8; i += nthr) {
        const f32x4 a = *(const f32x4*)(keys + (size_t)i * 8), b = *(const f32x4*)(keys + (size_t)i * 8 + 4);
        u32x4 o; o.x = pk2(a[0], a[1]); o.y = pk2(a[2], a[3]); o.z = pk2(b[0], b[1]); o.w = pk2(b[2], b[3]);
        *(u32x4*)((bf16_t*)(ws + WS_KEYS) + (size_t)i * 8) = o;
    }
    for (int i = gtid; i < SEQ * 8; i += nthr) {
        const int pos = i >> 3, f = i & 7;
        const float inv = powf(500000.0f, -(float)(2 * f) / 16.0f);
        const float ang = (float)pos * inv;
        ((float*)(ws + WS_ROPE))[i] = cosf(ang);
        ((float*)(ws + WS_ROPE))[SEQ * 8 + i] = sinf(ang);
    }
    if (F.gw == 0) {
        const float a = p.in[11][F.lane] * p.in[12][F.lane], b = p.in[13][F.lane] * p.in[14][F.lane];
        const float sa = wave_sum(a), sb = wave_sum(b);
        if (F.lane == 0) ((float*)(ws + WS_MISC))[0] = expf(sa) - expf(sb) + LAMBDA_INIT;
    }
    {
        constexpr int N8 = 16384 * 1024 / 8;
        for (int i = gtid; i < 2 * N8; i += nthr) {
            const bool isU = i < N8; const int j = isU ? i : i - N8;
            const float* src = (isU ? pu : pv) + (size_t)j * 8;
            const f32x4 a = *(const f32x4*)src, b = *(const f32x4*)(src + 4);
            u32x4 o; o.x = pk2(a[0], a[1]); o.y = pk2(a[2], a[3]); o.z = pk2(b[0], b[1]); o.w = pk2(b[2], b[3]);
            *(u32x4*)((bf16_t*)(ws + (isU ? WS_UB : WS_VB)) + (size_t)j * 8) = o;
        }
    }
    bf16_t* xb = (bf16_t*)(ws + WS_XB); float* dtraw = (float*)(ws + WS_DTRAW);
    for (int m = F.gw; m < TOK; m += F.ngw) {
        const f32x4* xr = (const f32x4*)(x + (size_t)m * DM) + F.lane;
        f32x4 v[4]; float ss = 0.f;
#pragma unroll
        for (int j = 0; j < 4; ++j) { v[j] = xr[64 * j]; ss += (v[j][0] * v[j][0] + v[j][1] * v[j][1]) + (v[j][2] * v[j][2] + v[j][3] * v[j][3]); }
        const float r = rsqrtf(wave_sum(ss) * (1.f / DM) + EPSN);
        f32x4 d0 = {0.f, 0.f, 0.f, 0.f}, d1 = {0.f, 0.f, 0.f, 0.f};
#pragma unroll
        for (int j = 0; j < 4; ++j)
#pragma unroll
            for (int e = 0; e < 4; ++e) {
                const int k = 256 * j + 4 * F.lane + e;
                const f32x4 w0 = *(const LAS f32x4*)(wdt + k * 8), w1 = *(const LAS f32x4*)(wdt + k * 8 + 4);
                d0 += w0 * v[j][e]; d1 += w1 * v[j][e];
            }
#pragma unroll
        for (int e = 0; e < 4; ++e) { d0[e] = wave_sum(d0[e]); d1[e] = wave_sum(d1[e]); }
        if (F.lane == 0) { *(f32x4*)(dtraw + (size_t)m * 8) = d0 * r; *(f32x4*)(dtraw + (size_t)m * 8 + 4) = d1 * r; }
        unsigned long long* o8 = (unsigned long long*)(xb + (size_t)m * DM) + F.lane;
#pragma unroll
        for (int j = 0; j < 4; ++j) o8[64 * j] = (unsigned long long)pk2(v[j][0] * r, v[j][1] * r) | ((unsigned long long)pk2(v[j][2] * r, v[j][3] * r) << 32);
    }
}

__device__ __forceinline__ void p2_qk_prepass(const Params& p, Ctx& F) {
    bf16_t* proj = (bf16_t*)(p.ws + WS_PROJ);
    const float* qnw = p.in[9]; const float* knw = p.in[10];
    const float* cosT = (const float*)(p.ws + WS_ROPE); const float* sinT = cosT + SEQ * 8;
    const int sub = F.lane & 7;
    for (int wsi = F.gw; wsi < TOK * 2; wsi += F.ngw) {
        const int t = wsi >> 1, which = wsi & 1;
        bf16_t* ptr = proj + (size_t)t * NIN + (which ? PK : PQ) + F.lane * 8;
        const u32x4 raw = *(const u32x4*)ptr;
        float v[8];
#pragma unroll
        for (int e = 0; e < 4; ++e) { v[2 * e] = bf2f(raw[e] & 0xffffu); v[2 * e + 1] = bf2f(raw[e] >> 16); }
        float ss = 0.f;
#pragma unroll
        for (int e = 0; e < 8; ++e) ss += v[e] * v[e];
        ss += __shfl_xor(ss, 1); ss += __shfl_xor(ss, 2); ss += __shfl_xor(ss, 4);
        const float rs = rsqrtf(ss * (1.f / 64.f) + EPSN);
        const float* w = which ? knw : qnw;
        const int pos = t & (SEQ - 1);
        float o[8];
#pragma unroll
        for (int e = 0; e < 8; ++e) {
            const float y = v[e] * rs * w[sub * 8 + e];
            const float other = __shfl_xor(y, 1);
            const float c = cosT[pos * 8 + e], s = sinT[pos * 8 + e];
            float r = y;
            if (sub == 0) r = y * c - other * s;
            else if (sub == 1) r = other * s + y * c;
            o[e] = r;
        }
        u32x4 ov; ov.x = pk2(o[0], o[1]); ov.y = pk2(o[2], o[3]); ov.z = pk2(o[4], o[5]); ov.w = pk2(o[6], o[7]);
        *(u32x4*)ptr = ov;
    }
}

constexpr int P2_XS = 0, P2_BM = 33792, P2_CM = 51200, P2_CB = 68608, P2_MH = 85248, P2_XW = 122112, P2_ACS = 155904, P2_DT = 156928, P2_FAC = 157952;
constexpr int XS_LD = 264, BM_LD = 136, MH_LD = 72, CB_LD = 65;
static_assert(P2_FAC + 1024 <= LDS_BYTES, "P2 LDS");

__device__ __forceinline__ void p2_ssd_unit(const Params& p, Ctx& F, int b, int c, int g) {
    unsigned char* ws = p.ws;
    const bf16_t* proj = (const bf16_t*)(ws + WS_PROJ);
    bf16_t* ycat = (bf16_t*)(ws + WS_YCAT); bf16_t* cmc = (bf16_t*)(ws + WS_CMC);
    float* states = (float*)(ws + WS_STATES); float* acs_g = (float*)(ws + WS_ACS); float* cdec = (float*)(ws + WS_CDEC);
    const float* dtraw = (const float*)(ws + WS_DTRAW);
    const float* conv_w = p.in[3]; const float* conv_b = p.in[4]; const float* dt_bias = p.in[5]; const float* a_log = p.in[6]; const float* d_skip = p.in[7];
    LAS bf16_t* XS = (LAS bf16_t*)(F.lds + P2_XS); LAS bf16_t* BM = (LAS bf16_t*)(F.lds + P2_BM); LAS bf16_t* CM = (LAS bf16_t*)(F.lds + P2_CM);
    LAS float* CB = (LAS float*)(F.lds + P2_CB); LAS bf16_t* MH = (LAS bf16_t*)(F.lds + P2_MH); LAS bf16_t* XW = (LAS bf16_t*)(F.lds + P2_XW);
    LAS float* ACS = (LAS float*)(F.lds + P2_ACS); LAS float* DT = (LAS float*)(F.lds + P2_DT); LAS float* FAC = (LAS float*)(F.lds + P2_FAC);
    const int tid = F.tid, lane = F.lane, wave = F.wave, fr = lane & 15, fq = lane >> 4;
    const size_t tbase = (size_t)b * SEQ + (size_t)c * CHUNK;
#ifndef SKIP_A
    {
        const int cg = tid & 63, rg = tid >> 6, lc = cg * 8;
        int pcol, dld, dcol, kind;
        if (lc < 256) { pcol = PXS + g * 256 + lc; dld = XS_LD; dcol = lc; kind = 0; }
        else if (lc < 384) { pcol = PBM + g * 128 + (lc - 256); dld = BM_LD; dcol = lc - 256; kind = 1; }
        else { pcol = PCM + g * 128 + (lc - 384); dld = BM_LD; dcol = lc - 384; kind = 2; }
        LAS bf16_t* dst = kind == 0 ? XS : (kind == 1 ? BM : CM);
        const int ch = pcol - 512;
        float cw[4][8], cbv[8];
#pragma unroll
        for (int w = 0; w < 4; ++w) {
            const f32x4 a = *(const f32x4*)(conv_w + w * 1024 + ch), bq = *(const f32x4*)(conv_w + w * 1024 + ch + 4);
#pragma unroll
            for (int e = 0; e < 4; ++e) { cw[w][e] = a[e]; cw[w][4 + e] = bq[e]; }
        }
        { const f32x4 a = *(const f32x4*)(conv_b + ch), bq = *(const f32x4*)(conv_b + ch + 4);
#pragma unroll
          for (int e = 0; e < 4; ++e) { cbv[e] = a[e]; cbv[4 + e] = bq[e]; } }
        u32x4 rv[11];
#pragma unroll
        for (int i = 0; i < 11; ++i) {
            const int f = c * CHUNK + rg * 8 - 3 + i;
            u32x4 v = {0u, 0u, 0u, 0u};
            if (f >= 0) v = *(const u32x4*)(proj + ((size_t)b * SEQ + f) * NIN + pcol);
            rv[i] = v;
        }
#pragma unroll
        for (int r = 0; r < 8; ++r) {
            const int l = rg * 8 + r;
            float o[8];
#pragma unroll
            for (int e = 0; e < 8; ++e) o[e] = cbv[e];
#pragma unroll
            for (int w = 0; w < 4; ++w)
#pragma unroll
                for (int e = 0; e < 4; ++e) {
                    o[2 * e] += cw[w][2 * e] * bf2f(rv[r + w][e] & 0xffffu);
                    o[2 * e + 1] += cw[w][2 * e + 1] * bf2f(rv[r + w][e] >> 16);
                }
#pragma unroll
            for (int e = 0; e < 8; ++e) o[e] = silu_f(o[e]);
            u32x4 ov; ov.x = pk2(o[0], o[1]); ov.y = pk2(o[2], o[3]); ov.z = pk2(o[4], o[5]); ov.w = pk2(o[6], o[7]);
            *(LAS u32x4*)(dst + l * dld + dcol) = ov;
            if (kind == 2) *(u32x4*)(cmc + (tbase + l) * 256 + g * 128 + dcol) = ov;
        }
    }
#endif
    if (tid < 256) {
        const int l = tid >> 2, h = tid & 3, hh = g * 4 + h;
        const float v = dtraw[(tbase + l) * 8 + hh] + dt_bias[hh];
        const float dt = v > 20.f ? v : log1pf(expf(v));
        DT[l * 4 + h] = dt;
        ACS[l * 4 + h] = dt * (-expf(a_log[hh]));
    }
    __syncthreads();
    if (tid < 4) {
        float s = 0.f;
        for (int l = 0; l < 64; ++l) { s += ACS[l * 4 + tid]; ACS[l * 4 + tid] = s; }
        cdec[((size_t)b * NCH + c) * 8 + g * 4 + tid] = expf(s);
    }
    __syncthreads();
    if (tid < 256) {
        const int l = tid >> 2, h = tid & 3;
        acs_g[(tbase + l) * 8 + g * 4 + h] = ACS[l * 4 + h];
        FAC[l * 4 + h] = DT[l * 4 + h] * expf(ACS[63 * 4 + h] - ACS[l * 4 + h]);
    }
#pragma unroll
    for (int q = 0; q < 2; ++q) {
        const int tile = wave * 2 + q, mt = tile >> 2, nt = tile & 3;
        f32x4 acc = {0.f, 0.f, 0.f, 0.f};
#pragma unroll
        for (int ks = 0; ks < 4; ++ks) {
            const bf16x8 a = *(const LAS bf16x8*)(CM + (mt * 16 + fr) * BM_LD + ks * 32 + fq * 8);
            const bf16x8 bq = *(const LAS bf16x8*)(BM + (nt * 16 + fr) * BM_LD + ks * 32 + fq * 8);
            acc = mfma16(a, bq, acc);
        }
#pragma unroll
        for (int j = 0; j < 4; ++j) CB[(mt * 16 + 4 * fq + j) * CB_LD + nt * 16 + fr] = acc[j];
    }
    __syncthreads();
#pragma unroll 2
    for (int i = 0; i < 32; ++i) {
        const int e = tid + 512 * i, h = e >> 12, l = (e >> 6) & 63, s = e & 63;
        float v = 0.f;
        if (s <= l) v = CB[l * CB_LD + s] * __expf(ACS[l * 4 + h] - ACS[s * 4 + h]) * DT[s * 4 + h];
        MH[(h * 64 + l) * MH_LD + s] = (bf16_t)f2bf(v);
    }
#pragma unroll 2
    for (int i = 0; i < 32; ++i) {
        const int e = tid + 512 * i, l = e >> 8, col = e & 255;
        XW[l * XS_LD + col] = (bf16_t)f2bf(bf2f(XS[l * XS_LD + col]) * FAC[l * 4 + (col >> 6)]);
    }
    __syncthreads();
#ifndef SKIP_E
    {
        const int h = wave >> 1, hh = g * 4 + h; const float dsk = d_skip[hh];
#pragma unroll 1
        for (int mq = 0; mq < 2; ++mq) {
            const int mt = 2 * (wave & 1) + mq;
            bf16x8 a[2];
#pragma unroll
            for (int ks = 0; ks < 2; ++ks) a[ks] = *(const LAS bf16x8*)(MH + (h * 64 + mt * 16 + fr) * MH_LD + ks * 32 + fq * 8);
#pragma unroll 1
            for (int nt = 0; nt < 4; ++nt) {
                f32x4 acc = {0.f, 0.f, 0.f, 0.f};
#pragma unroll
                for (int ks = 0; ks < 2; ++ks) {
                    bf16x8 bq;
#pragma unroll
                    for (int jj = 0; jj < 8; ++jj) bq[jj] = (short)XS[(ks * 32 + 8 * fq + jj) * XS_LD + h * 64 + nt * 16 + fr];
                    acc = mfma16(a[ks], bq, acc);
                }
#pragma unroll
                for (int j = 0; j < 4; ++j) {
                    const int l = mt * 16 + 4 * fq + j, pp = nt * 16 + fr;
                    const float val = acc[j] + bf2f(XS[l * XS_LD + h * 64 + pp]) * dsk;
                    ycat[(tbase + l) * DM + g * 256 + h * 64 + pp] = (bf16_t)f2bf(val);
                }
            }
        }
    }
#endif
#ifndef SKIP_F
    {
        const int h = wave >> 1, hh = g * 4 + h;
        float* sbase = states + (((size_t)b * NCH + c) * 8 + hh) * 64 * 128;
#pragma unroll 1
        for (int mq = 0; mq < 2; ++mq) {
            const int mt = 2 * (wave & 1) + mq;
            bf16x8 a[2];
#pragma unroll
            for (int ks = 0; ks < 2; ++ks)
#pragma unroll
                for (int jj = 0; jj < 8; ++jj) a[ks][jj] = (short)XW[(ks * 32 + 8 * fq + jj) * XS_LD + h * 64 + mt * 16 + fr];
#pragma unroll 1
            for (int nt = 0; nt < 8; ++nt) {
                f32x4 acc = {0.f, 0.f, 0.f, 0.f};
#pragma unroll
                for (int ks = 0; ks < 2; ++ks) {
                    bf16x8 bq;
#pragma unroll
                    for (int jj = 0; jj < 8; ++jj) bq[jj] = (short)BM[(ks * 32 + 8 * fq + jj) * BM_LD + nt * 16 + fr];
                    acc = mfma16(a[ks], bq, acc);
                }
#pragma unroll
                for (int j = 0; j < 4; ++j) sbase[(size_t)(mt * 16 + 4 * fq + j) * 128 + nt * 16 + fr] = acc[j];
            }
        }
    }
#endif
    __syncthreads();
}

__device__ __forceinline__ void phase2(const Params& p, Ctx& F) {
    p2_qk_prepass(p, F);
    for (int u = F.vcu; u < NB * NCH * 2; u += F.G) {
        const int g = u & 1, c = (u >> 1) & 63, b = u >> 7;
        p2_ssd_unit(p, F, b, c, g);
    }
}

__device__ __forceinline__ void p3_scan(const Params& p, Ctx& F) {
    float* states = (float*)(p.ws + WS_STATES); const float* cdec = (const float*)(p.ws + WS_CDEC);
    const int gtid = F.vcu * 512 + F.tid, nthr = F.G * 512;
    for (int e = gtid; e < NB * 8 * 64 * 32; e += nthr) {
        const int n4 = e & 31, pp = (e >> 5) & 63, hh = (e >> 11) & 7, b = e >> 14;
        f32x4 carry = {0.f, 0.f, 0.f, 0.f};
        for (int c0 = 0; c0 < NCH; c0 += 8) {
            f32x4 s[8]; float dc[8];
#pragma unroll
            for (int i = 0; i < 8; ++i) {
                s[i] = *(const f32x4*)(states + ((((size_t)b * NCH + c0 + i) * 8 + hh) * 64 + pp) * 128 + n4 * 4);
                dc[i] = cdec[((size_t)b * NCH + c0 + i) * 8 + hh];
            }
#pragma unroll
            for (int i = 0; i < 8; ++i) {
                *(f32x4*)(states + ((((size_t)b * NCH + c0 + i) * 8 + hh) * 64 + pp) * 128 + n4 * 4) = carry;
                carry = carry * dc[i] + s[i];
            }
        }
    }
}

namespace att {
constexpr int NW = 8, QBLK = 32, KVBLK = 64;
constexpr float SCALE = 0.125f, THR = 8.f;
constexpr int SHM_V = KVBLK * 128 * 2, SHM_K = KVBLK * 64 * 2;
constexpr int LDS_V = 0, LDS_K = 2 * SHM_V, LDS_WS = LDS_K + 2 * SHM_K, LDS_END = LDS_WS + NW * 64 * 4;
#define KSWZ64(row, colB) ((row) * 128 + ((colB) ^ ((((row) >> 1) & 7) << 4)))
#define SBAR() __builtin_amdgcn_sched_barrier(0)
__device__ __forceinline__ int crow(int r, int hi) { return (r & 3) + 8 * (r >> 2) + 4 * hi; }
__device__ __forceinline__ unsigned cvtpk(float lo, float hi) { unsigned r; asm volatile("v_cvt_pk_bf16_f32 %0, %1, %2" : "=v"(r) : "v"(lo), "v"(hi)); return r; }

__device__ __forceinline__ void partialSM(f32x16& p0, f32x16& p1, float& m_reg, float& mn, float& alpha) {
    constexpr float C = SCALE * 1.4426950408889634f;
    float pmax = p0[0];
#pragma unroll
    for (int r = 1; r < 16; ++r) pmax = fmaxf(pmax, p0[r]);
#pragma unroll
    for (int r = 0; r < 16; ++r) pmax = fmaxf(pmax, p1[r]);
    { auto rr = __builtin_amdgcn_permlane32_swap(__float_as_uint(pmax), __float_as_uint(pmax), false, false);
      pmax = fmaxf(__uint_as_float(rr[0]), __uint_as_float(rr[1])); }
    if (__builtin_expect(__all(pmax - m_reg <= THR / SCALE), 1)) { mn = m_reg; alpha = 1.f; }
    else { mn = fmaxf(m_reg, pmax); alpha = __builtin_amdgcn_exp2f((m_reg - mn) * C); m_reg = mn; }
    const float mnC = -mn * C;
#pragma unroll
    for (int r = 0; r < 16; ++r) p0[r] = fmaf(p0[r], C, mnC);
#pragma unroll
    for (int r = 0; r < 16; ++r) p1[r] = fmaf(p1[r], C, mnC);
#pragma unroll
    for (int r = 0; r < 16; ++r) p0[r] = __builtin_amdgcn_exp2f(p0[r]);
}
__device__ __forceinline__ void finishSM(f32x16& p0, f32x16& p1, float alpha, float& l_reg, bf16x8& pa0, bf16x8& pa1, bf16x8& pa2, bf16x8& pa3) {
#pragma unroll
    for (int r = 0; r < 16; ++r) p1[r] = __builtin_amdgcn_exp2f(p1[r]);
    float ps = 0;
#pragma unroll
    for (int r = 0; r < 16; ++r) ps += p0[r];
#pragma unroll
    for (int r = 0; r < 16; ++r) ps += p1[r];
    { auto rr = __builtin_amdgcn_permlane32_swap(__float_as_uint(ps), __float_as_uint(ps), false, false);
      ps = __uint_as_float(rr[0]) + __uint_as_float(rr[1]); }
    l_reg = l_reg * alpha + ps;
#define PK4(P, BASE, OUT) do { unsigned a0 = cvtpk(P[BASE + 0], P[BASE + 1]), a1 = cvtpk(P[BASE + 2], P[BASE + 3]);   \
    unsigned b0 = cvtpk(P[BASE + 4], P[BASE + 5]), b1 = cvtpk(P[BASE + 6], P[BASE + 7]);                              \
    auto r0 = __builtin_amdgcn_permlane32_swap(a0, b0, false, false); auto r1 = __builtin_amdgcn_permlane32_swap(a1, b1, false, false); \
    u32x4 w = {r0[0], r1[0], r0[1], r1[1]}; OUT = *reinterpret_cast<bf16x8*>(&w); } while (0)
    PK4(p0, 0, pa0); PK4(p0, 8, pa1); PK4(p1, 0, pa2); PK4(p1, 8, pa3);
#undef PK4
}
__device__ __forceinline__ void qkt(f32x16& p0, f32x16& p1, const char* Ks, const bf16x8* qr, int r32, int hi) {
    p0 = f32x16{}; p1 = f32x16{};
#pragma unroll
    for (int d0 = 0; d0 < 4; ++d0) {
        const int cb = (d0 * 16 + hi * 8) * 2;
        const bf16x8 b0 = *reinterpret_cast<const bf16x8*>(Ks + KSWZ64(r32, cb));
        const bf16x8 b1 = *reinterpret_cast<const bf16x8*>(Ks + KSWZ64(32 + r32, cb));
        p0 = mfma32(b0, qr[d0], p0);
        p1 = mfma32(b1, qr[d0], p1);
    }
}
__device__ __forceinline__ void maskfill(f32x16& p0, f32x16& p1, bool m) {
#pragma unroll
    for (int r = 0; r < 16; ++r) { p0[r] = m ? -1e30f : p0[r]; p1[r] = m ? -1e30f : p1[r]; }
}
__device__ __forceinline__ int v_st(int k, int c) { const int kk = (k & ~0xC) | ((k & 4) << 1) | ((k & 8) >> 1); return ((kk >> 3) * 4 + (c >> 5)) * 512 + ((kk & 7) * 32 + (c & 31)) * 2; }
__device__ __forceinline__ int v_rd_base(int lane) { return ((lane & 3) << 3) | (((lane >> 2) & 3) << 6) | (((lane >> 4) & 1) << 5) | (((lane >> 5) & 1) << 8); }
constexpr int v_rd_off(int d0, int ks, int half) { return d0 * 512 + ks * 4096 + half * 2048; }
template <int OFF> __device__ __forceinline__ s16x4 tr_read(int vb) {
    s16x4 r; asm volatile("ds_read_b64_tr_b16 %0, %1 offset:%2" : "=&v"(r) : "v"(vb), "i"(OFF) : "memory"); return r;
}
template <int D0> __device__ __forceinline__ void pv_one(f32x16& od, int vb, bf16x8 pa0, bf16x8 pa1, bf16x8 pa2, bf16x8 pa3) {
    const s16x4 l0 = tr_read<v_rd_off(D0, 0, 0)>(vb), h0 = tr_read<v_rd_off(D0, 0, 1)>(vb), l1 = tr_read<v_rd_off(D0, 1, 0)>(vb), h1 = tr_read<v_rd_off(D0, 1, 1)>(vb);
    const s16x4 l2 = tr_read<v_rd_off(D0, 2, 0)>(vb), h2 = tr_read<v_rd_off(D0, 2, 1)>(vb), l3 = tr_read<v_rd_off(D0, 3, 0)>(vb), h3 = tr_read<v_rd_off(D0, 3, 1)>(vb);
    asm volatile("s_waitcnt lgkmcnt(0)" ::: "memory"); SBAR();
#define PKV(L, H) (bf16x8){L[0], L[1], L[2], L[3], H[0], H[1], H[2], H[3]}
    od = mfma32(pa0, PKV(l0, h0), od);
    od = mfma32(pa1, PKV(l1, h1), od);
    od = mfma32(pa2, PKV(l2, h2), od);
    od = mfma32(pa3, PKV(l3, h3), od);
#undef PKV
}
__device__ __forceinline__ void pv_d0(f32x16* o, int vb, bf16x8 pa0, bf16x8 pa1, bf16x8 pa2, bf16x8 pa3) {
    pv_one<0>(o[0], vb, pa0, pa1, pa2, pa3); pv_one<1>(o[1], vb, pa0, pa1, pa2, pa3); pv_one<2>(o[2], vb, pa0, pa1, pa2, pa3); pv_one<3>(o[3], vb, pa0, pa1, pa2, pa3);
}

__device__ __forceinline__ void attn_pass(const bf16_t* __restrict__ Qb, const bf16_t* __restrict__ Kh, const bf16_t* __restrict__ Vh, int NT, int my_last, char* lds, f32x16 (&o)[4]) {
    const int tid = threadIdx.x, wid = tid >> 6, lane = tid & 63, r32 = lane & 31, hi = lane >> 5;
    char* V_lds = lds + LDS_V; char* K_lds = lds + LDS_K;
    float* wsf = (float*)(lds + LDS_WS) + wid * 64; float* li_l = wsf; float* al_l = wsf + 32;
    float m_reg = -1e30f, l_reg = 0.f;
#pragma unroll
    for (int d = 0; d < 4; ++d) o[d] = f32x16{};
    bf16x8 qr[4];
    const bf16_t* Qw = Qb + (size_t)(wid * QBLK + r32) * NIN + hi * 8;
#pragma unroll
    for (int d0 = 0; d0 < 4; ++d0) qr[d0] = *reinterpret_cast<const bf16x8*>(Qw + d0 * 16);
    const int sr = tid >> 4, sc = (tid & 15) * 8, vst0 = v_st(sr, sc), vst1 = v_st(32 + sr, sc);
    const int krow = tid >> 3, kc8 = (tid & 7) * 8, kst = KSWZ64(krow, kc8 * 2);
    const int vb0 = (int)(uintptr_t)V_lds + v_rd_base(lane);
    struct { bf16x8 vs0, vs1, ks; } sr_[2];
#define SLOAD(i, k0) do { sr_[i].vs0 = *reinterpret_cast<const bf16x8*>(&Vh[(size_t)((k0) + sr) * NIN + sc]); sr_[i].vs1 = *reinterpret_cast<const bf16x8*>(&Vh[(size_t)((k0) + 32 + sr) * NIN + sc]); \
    sr_[i].ks = *reinterpret_cast<const bf16x8*>(&Kh[(size_t)((k0) + krow) * NIN + kc8]); } while (0)
#define SWRITE(b, i) do { *(bf16x8*)(V_lds + (b) * SHM_V + vst0) = sr_[i].vs0; *(bf16x8*)(V_lds + (b) * SHM_V + vst1) = sr_[i].vs1; \
    *(bf16x8*)(K_lds + (b) * SHM_K + kst) = sr_[i].ks; } while (0)
#define SWAIT() asm volatile("s_waitcnt vmcnt(3)" ::: "memory")
#define RESC(a) do { if (__any((a) < 1.f)) { if (hi == 0) al_l[r32] = (a); asm volatile("s_waitcnt lgkmcnt(0)" ::: "memory"); \
    _Pragma("unroll") for (int d = 0; d < 4; ++d) _Pragma("unroll") for (int r = 0; r < 16; ++r) o[d][r] *= al_l[crow(r, hi)]; } } while (0)
    f32x16 pA0, pA1, pB0, pB1; float mnA, mnB, alA, alB; bf16x8 pa0, pa1, pa2, pa3;
    constexpr int SE = 0, SO = 1;
    __syncthreads();
    SLOAD(SE, 0); asm volatile("s_waitcnt vmcnt(0)" ::: "memory"); SWRITE(0, SE); __syncthreads();
    qkt(pA0, pA1, K_lds, qr, r32, hi); partialSM(pA0, pA1, m_reg, mnA, alA);
    SLOAD(SO, KVBLK); if (2 < NT) SLOAD(SE, 2 * KVBLK);
    SWAIT(); SWRITE(1, SO); __syncthreads();
    for (int j = 1; j + 1 < NT; j += 2) {
        SBAR(); qkt(pB0, pB1, K_lds + SHM_K, qr, r32, hi); maskfill(pB0, pB1, j > my_last);
        finishSM(pA0, pA1, alA, l_reg, pa0, pa1, pa2, pa3); SBAR();
        SLOAD(SO, (j + 2) * KVBLK); SBAR();
        pv_d0(o, vb0, pa0, pa1, pa2, pa3); partialSM(pB0, pB1, m_reg, mnB, alB);
        __syncthreads(); SWAIT(); SWRITE(0, SE);
        RESC(alB); __syncthreads();
        SBAR(); qkt(pA0, pA1, K_lds, qr, r32, hi); maskfill(pA0, pA1, j + 1 > my_last);
        finishSM(pB0, pB1, alB, l_reg, pa0, pa1, pa2, pa3); SBAR();
        if (j + 3 < NT) SLOAD(SE, (j + 3) * KVBLK); SBAR();
        pv_d0(o, vb0 + SHM_V, pa0, pa1, pa2, pa3); partialSM(pA0, pA1, m_reg, mnA, alA);
        __syncthreads(); SWAIT(); SWRITE(1, SO);
        RESC(alA); __syncthreads();
    }
    SBAR(); qkt(pB0, pB1, K_lds + SHM_K, qr, r32, hi); maskfill(pB0, pB1, NT - 1 > my_last);
    finishSM(pA0, pA1, alA, l_reg, pa0, pa1, pa2, pa3); SBAR();
    pv_d0(o, vb0, pa0, pa1, pa2, pa3); partialSM(pB0, pB1, m_reg, mnB, alB);
    __syncthreads(); RESC(alB);
    finishSM(pB0, pB1, alB, l_reg, pa0, pa1, pa2, pa3); SBAR();
    pv_d0(o, vb0 + SHM_V, pa0, pa1, pa2, pa3);
    if (hi == 0) li_l[r32] = l_reg;
    asm volatile("s_waitcnt lgkmcnt(0)" ::: "memory");
#pragma unroll
    for (int r = 0; r < 16; ++r) {
        const float rl = __builtin_amdgcn_rcpf(li_l[crow(r, hi)]);
#pragma unroll
        for (int d = 0; d < 4; ++d) o[d][r] *= rl;
    }
    asm volatile("s_waitcnt vmcnt(0)" ::: "memory");
    __syncthreads();
#undef SLOAD
#undef SWRITE
#undef SWAIT
#undef RESC
}
}

__device__ __forceinline__ void p3_attn_unit(const Params& p, Ctx& F, int b, int h, int qb, float* oscr) {
    const bf16_t* proj = (const bf16_t*)(p.ws + WS_PROJ);
    bf16_t* ycat = (bf16_t*)(p.ws + WS_YCAT);
    const float lam = ((const float*)(p.ws + WS_MISC))[0];
    const float* subw = p.in[15];
    const int tid = F.tid, wid = F.wave, lane = F.lane, r32 = lane & 31, hi = lane >> 5;
    const size_t rowbase = (size_t)b * SEQ; const int q0 = qb * 256;
    const int NT = (q0 + 256) / 64, my_last = (q0 + 32 * wid) / 64;
    f32x16 o[4];
    for (int j = 0; j < 2; ++j) {
        const bf16_t* Qb = proj + (rowbase + q0) * NIN + PQ + h * 128 + j * 64;
        const bf16_t* Kh = proj + rowbase * NIN + PK + h * 128 + j * 64;
        const bf16_t* Vh = proj + rowbase * NIN + PV + h * 128;
        att::attn_pass(Qb, Kh, Vh, NT, my_last, (char*)F.lds, o);
        if (j == 0) {
            float* my = oscr + tid * 64;
#pragma unroll
            for (int d = 0; d < 4; ++d)
#pragma unroll
                for (int r4 = 0; r4 < 4; ++r4) *(f32x4*)(my + d * 16 + r4 * 4) = (f32x4){o[d][4 * r4], o[d][4 * r4 + 1], o[d][4 * r4 + 2], o[d][4 * r4 + 3]};
        }
    }
    float wv[4];
#pragma unroll
    for (int d = 0; d < 4; ++d) wv[d] = subw[d * 32 + r32] * (1.f - LAMBDA_INIT);
#pragma unroll
    for (int r = 0; r < 16; ++r) {
        float v[4]; float ss = 0.f;
#pragma unroll
        for (int d = 0; d < 4; ++d) { v[d] = oscr[tid * 64 + d * 16 + r] - lam * o[d][r]; ss += v[d] * v[d]; }
        ss += __shfl_xor(ss, 1); ss += __shfl_xor(ss, 2); ss += __shfl_xor(ss, 4); ss += __shfl_xor(ss, 8); ss += __shfl_xor(ss, 16);
        const float rs = rsqrtf(ss * (1.f / 128.f) + EPSN);
        const size_t row = rowbase + q0 + wid * 32 + att::crow(r, hi);
#pragma unroll
        for (int d = 0; d < 4; ++d) ycat[row * DM + 512 + h * 128 + d * 32 + r32] = (bf16_t)f2bf(v[d] * rs * wv[d]);
    }
}

__device__ __forceinline__ void phase3(const Params& p, Ctx& F) {
#ifndef NO_SCAN
    p3_scan(p, F);
#endif
    float* oscr = p.out + (size_t)F.vcu * (64 * 512);
    for (int ui = F.vcu; ui < 512; ui += F.G) {
        const int pi = ui & 255, bh = pi >> 3, s = pi & 7, b = bh >> 2, h = bh & 3;
        p3_attn_unit(p, F, b, h, ui < 256 ? 15 - s : s, oscr);
    }
}

constexpr int P4_PREV = 0, P4_CM = 69632, P4_ACS = 87040, P4_Y = 88064, Y_LD = 257;
static_assert(P4_Y + 64 * Y_LD * 4 <= LDS_BYTES, "P4 LDS");
__device__ __forceinline__ void p4_unit(const Params& p, Ctx& F, int b, int c, int g) {
    unsigned char* ws = p.ws;
    const bf16_t* proj = (const bf16_t*)(ws + WS_PROJ);
    bf16_t* ycat = (bf16_t*)(ws + WS_YCAT); const bf16_t* cmc = (const bf16_t*)(ws + WS_CMC);
    const float* states = (const float*)(ws + WS_STATES); const float* acs_g = (const float*)(ws + WS_ACS);
    const float* normw = p.in[8];
    LAS bf16_t* PREV = (LAS bf16_t*)(F.lds + P4_PREV); LAS bf16_t* CM = (LAS bf16_t*)(F.lds + P4_CM);
    LAS float* ACS = (LAS float*)(F.lds + P4_ACS); LAS float* Y = (LAS float*)(F.lds + P4_Y);
    const int tid = F.tid, lane = F.lane, wave = F.wave, fr = lane & 15, fq = lane >> 4;
    const size_t tbase = (size_t)b * SEQ + (size_t)c * CHUNK;
    for (int i = 0; i < 16; ++i) {
        const int e = tid + 512 * i, n4 = e & 31, pp = (e >> 5) & 63, h = e >> 11;
        const f32x4 v = *(const f32x4*)(states + ((((size_t)b * NCH + c) * 8 + g * 4 + h) * 64 + pp) * 128 + n4 * 4);
        u32x2 w; w.x = pk2(v[0], v[1]); w.y = pk2(v[2], v[3]);
        *(LAS u32x2*)(PREV + (h * 64 + pp) * BM_LD + n4 * 4) = w;
    }
    for (int i = 0; i < 2; ++i) {
        const int e = tid + 512 * i, l = e >> 4, c8 = e & 15;
        *(LAS u32x4*)(CM + l * BM_LD + c8 * 8) = *(const u32x4*)(cmc + (tbase + l) * 256 + g * 128 + c8 * 8);
    }
    if (tid < 256) { const int l = tid >> 2, h = tid & 3; ACS[l * 4 + h] = acs_g[(tbase + l) * 8 + g * 4 + h]; }
    __syncthreads();
    {
        const int h = wave >> 1;
#pragma unroll
        for (int mq = 0; mq < 2; ++mq) {
            const int mt = 2 * (wave & 1) + mq;
            bf16x8 a[4];
#pragma unroll
            for (int ks = 0; ks < 4; ++ks) a[ks] = *(const LAS bf16x8*)(CM + (mt * 16 + fr) * BM_LD + ks * 32 + fq * 8);
#pragma unroll
            for (int nt = 0; nt < 4; ++nt) {
                f32x4 acc = {0.f, 0.f, 0.f, 0.f};
#pragma unroll
                for (int ks = 0; ks < 4; ++ks) {
                    const bf16x8 bq = *(const LAS bf16x8*)(PREV + (h * 64 + nt * 16 + fr) * BM_LD + ks * 32 + fq * 8);
                    acc = mfma16(a[ks], bq, acc);
                }
#pragma unroll
                for (int j = 0; j < 4; ++j) {
                    const int l = mt * 16 + 4 * fq + j, col = h * 64 + nt * 16 + fr;
                    const size_t t = tbase + l;
                    const float yo = acc[j] * __expf(ACS[l * 4 + h]);
                    const float yl = bf2f(ycat[t * DM + g * 256 + col]);
                    const float z = bf2f(proj[t * NIN + PZ + g * 256 + col]);
                    Y[l * Y_LD + col] = (yl + yo) * silu_f(z);
                }
            }
        }
    }
    __syncthreads();
    for (int r = 0; r < 8; ++r) {
        const int l = wave * 8 + r;
        float v[4]; float ss = 0.f;
#pragma unroll
        for (int e = 0; e < 4; ++e) { v[e] = Y[l * Y_LD + 4 * lane + e]; ss += v[e] * v[e]; }
        const float rs = rsqrtf(wave_sum(ss) * (1.f / 256.f) + EPSN);
        const f32x4 nw = *(const f32x4*)(normw + g * 256 + 4 * lane);
        u32x2 w; w.x = pk2(v[0] * rs * nw[0], v[1] * rs * nw[1]); w.y = pk2(v[2] * rs * nw[2], v[3] * rs * nw[3]);
        *(u32x2*)(ycat + (tbase + l) * DM + g * 256 + 4 * lane) = w;
    }
    __syncthreads();
}
__device__ __forceinline__ void phase4(const Params& p, Ctx& F) {
    for (int u = F.vcu; u < NB * NCH * 2; u += F.G) {
        const int g = u & 1, c = (u >> 1) & 63, b = u >> 7;
        p4_unit(p, F, b, c, g);
    }
}

__device__ __forceinline__ unsigned f2ord(float f) { const unsigned u = __float_as_uint(f); return (u >> 31) ? ~u : (u | 0x80000000u); }
__device__ __forceinline__ float ord2f(unsigned u) { return __uint_as_float((u >> 31) ? (u & 0x7fffffffu) : ~u); }
#define TOPK_INSERT(R, X) do { unsigned x_ = (X); _Pragma("unroll") for (int k_ = 0; k_ < 16; ++k_) { const unsigned hi_ = R[k_] > x_ ? R[k_] : x_; x_ = R[k_] > x_ ? x_ : R[k_]; R[k_] = hi_; } } while (0)

__device__ __forceinline__ void phase7(const Params& p, Ctx& F) {
    unsigned char* ws = p.ws;
    const bf16_t* qp = (const bf16_t*)(ws + WS_QP); const bf16_t* keys = (const bf16_t*)(ws + WS_KEYS);
    const float* rowsq = (const float*)(ws + WS_CTL) + CW_ROWSQ;
    int* idxo = (int*)(ws + WS_IDX); float* gwo = (float*)(ws + WS_GW);
    LAS unsigned* scr = (LAS unsigned*)(F.lds + F.wave * 18560);
    LAS unsigned* lists = scr + 32 * 129;
    const int lane = F.lane, fr = lane & 15, fq = lane >> 4;
    for (int task = F.gw; task < (TOK / 16) * 8; task += F.ngw) {
        const int tg = task >> 3, h = task & 7; const size_t t0 = (size_t)tg * 16;
        float r2[4];
#pragma unroll
        for (int jj = 0; jj < 4; ++jj) r2[jj] = rsqrtf(rowsq[t0 + 4 * fq + jj] * (1.f / DM) + EPSN);
#pragma unroll
        for (int j = 0; j < 2; ++j) {
            bf16x8 a[4];
#pragma unroll
            for (int ks = 0; ks < 4; ++ks) a[ks] = *(const bf16x8*)(qp + (t0 + fr) * 2048 + h * 256 + j * 128 + ks * 32 + fq * 8);
#pragma unroll
            for (int nt = 0; nt < 8; ++nt) {
                f32x4 acc = {0.f, 0.f, 0.f, 0.f};
#pragma unroll
                for (int ks = 0; ks < 4; ++ks) {
                    const bf16x8 bq = *(const bf16x8*)(keys + ((size_t)(h * 2 + j) * 128 + nt * 16 + fr) * 128 + ks * 32 + fq * 8);
                    acc = mfma16(a[ks], bq, acc);
                }
#pragma unroll
                for (int jj = 0; jj < 4; ++jj) {
                    const unsigned key = (f2ord(acc[jj] * r2[jj]) & ~127u) | (unsigned)(nt * 16 + fr);
                    scr[((4 * fq + jj) * 2 + j) * 129 + nt * 16 + fr] = key;
                }
            }
        }
        LDS_WAIT(); __builtin_amdgcn_wave_barrier();
        if (lane < 32) {
            unsigned r[16];
#pragma unroll
            for (int k = 0; k < 16; ++k) r[k] = 0u;
#pragma unroll 4
            for (int i = 0; i < 128; ++i) { const unsigned x = scr[lane * 129 + i]; TOPK_INSERT(r, x); }
#pragma unroll
            for (int k = 0; k < 16; ++k) lists[lane * 16 + k] = r[k];
        }
        LDS_WAIT(); __builtin_amdgcn_wave_barrier();
        if (lane < 16) {
            float f0[16], f1[16];
#pragma unroll
            for (int k = 0; k < 16; ++k) { f0[k] = ord2f(lists[(2 * lane) * 16 + k] & ~127u); f1[k] = ord2f(lists[(2 * lane + 1) * 16 + k] & ~127u); }
            unsigned r[16];
#pragma unroll
            for (int k = 0; k < 16; ++k) r[k] = 0u;
#pragma unroll
            for (int a = 0; a < 16; ++a)
#pragma unroll
                for (int bb = 0; bb < 16; ++bb)
                    if ((a + 1) * (bb + 1) <= 16) { const unsigned key = (f2ord(f0[a] + f1[bb]) & ~255u) | (unsigned)(a * 16 + bb); TOPK_INSERT(r, key); }
            float val[16]; int ex[16]; float mx = -1e30f;
#pragma unroll
            for (int k = 0; k < 16; ++k) {
                const unsigned pos = r[k] & 255u, a = pos >> 4, bb = pos & 15u;
                const unsigned w0 = lists[(2 * lane) * 16 + a], w1 = lists[(2 * lane + 1) * 16 + bb];
                ex[k] = (int)((w0 & 127u) * 128u + (w1 & 127u));
                val[k] = ord2f(w0 & ~127u) + ord2f(w1 & ~127u);
                mx = fmaxf(mx, val[k]);
            }
            float sum = 0.f;
#pragma unroll
            for (int k = 0; k < 16; ++k) { val[k] = __expf(val[k] - mx); sum += val[k]; }
            const float inv = 1.f / sum;
            int* io = idxo + ((t0 + lane) * 8 + h) * 16; float* go = gwo + ((t0 + lane) * 8 + h) * 16;
#pragma unroll
            for (int k = 0; k < 16; ++k) { io[k] = ex[k]; go[k] = val[k] * inv; }
        }
        LDS_WAIT(); __builtin_amdgcn_wave_barrier();
    }
}

__device__ __forceinline__ float gelu_erf(float x) { return 0.5f * x * (1.f + erff(x * 0.70710678118654752f)); }
__device__ __forceinline__ void phase8(const Params& p, Ctx& F) {
    unsigned char* ws = p.ws;
    const bf16_t* ub = (const bf16_t*)(ws + WS_UB); const bf16_t* vb = (const bf16_t*)(ws + WS_VB);
    const float* rowsq = (const float*)(ws + WS_CTL) + CW_ROWSQ;
    const int* idxi = (const int*)(ws + WS_IDX); const float* gwi = (const float*)(ws + WS_GW);
    const float* w2 = p.in[17];
    float* out = p.out;
    const int lane = F.lane;
    float w2v[16];
#pragma unroll
    for (int e = 0; e < 8; ++e) { w2v[e] = w2[8 * lane + e]; w2v[8 + e] = w2[512 + 8 * lane + e]; }
    for (int t = F.gw; t < TOK; t += F.ngw) {
        const float r2 = rsqrtf(rowsq[t] * (1.f / DM) + EPSN);
        float x1[16], xn[16], acc[16];
        {
            const float* xr = out + (size_t)t * DM;
            const f32x4 a = *(const f32x4*)(xr + 8 * lane), b = *(const f32x4*)(xr + 8 * lane + 4), c = *(const f32x4*)(xr + 512 + 8 * lane), d = *(const f32x4*)(xr + 512 + 8 * lane + 4);
#pragma unroll
            for (int e = 0; e < 4; ++e) { x1[e] = a[e]; x1[4 + e] = b[e]; x1[8 + e] = c[e]; x1[12 + e] = d[e]; }
        }
#pragma unroll
        for (int e = 0; e < 16; ++e) { xn[e] = x1[e] * r2 * w2v[e]; acc[e] = 0.f; }
        const int idA = idxi[(size_t)t * 128 + lane], idB = idxi[(size_t)t * 128 + 64 + lane];
        const float gA = gwi[(size_t)t * 128 + lane], gB = gwi[(size_t)t * 128 + 64 + lane];
        for (int i0 = 0; i0 < 128; i0 += 4) {
            u32x4 uu[4][2], vv[4][2]; float gg[4];
#pragma unroll
            for (int q = 0; q < 4; ++q) {
                const int i = i0 + q;
                const int e = __shfl(i0 < 64 ? idA : idB, i & 63);
                gg[q] = __shfl(i0 < 64 ? gA : gB, i & 63);
                const bf16_t* ur = ub + (size_t)e * DM; const bf16_t* vr = vb + (size_t)e * DM;
                uu[q][0] = *(const u32x4*)(ur + 8 * lane); uu[q][1] = *(const u32x4*)(ur + 512 + 8 * lane);
                vv[q][0] = *(const u32x4*)(vr + 8 * lane); vv[q][1] = *(const u32x4*)(vr + 512 + 8 * lane);
            }
#pragma unroll
            for (int q = 0; q < 4; ++q) {
                float dot = 0.f;
#pragma unroll
                for (int hf = 0; hf < 2; ++hf)
#pragma unroll
                    for (int e = 0; e < 4; ++e) {
                        const unsigned w = uu[q][hf][e];
                        dot += xn[hf * 8 + 2 * e] * bf2f(w & 0xffffu) + xn[hf * 8 + 2 * e + 1] * bf2f(w >> 16);
                    }
                dot = wave_sum(dot);
                const float coef = gg[q] * gelu_erf(dot);
#pragma unroll
                for (int hf = 0; hf < 2; ++hf)
#pragma unroll
                    for (int e = 0; e < 4; ++e) {
                        const unsigned w = vv[q][hf][e];
                        acc[hf * 8 + 2 * e] += coef * bf2f(w & 0xffffu);
                        acc[hf * 8 + 2 * e + 1] += coef * bf2f(w >> 16);
                    }
            }
        }
        float* orow = out + (size_t)t * DM;
        f32x4 a, b, c, d;
#pragma unroll
        for (int e = 0; e < 4; ++e) { a[e] = x1[e] + acc[e]; b[e] = x1[4 + e] + acc[4 + e]; c[e] = x1[8 + e] + acc[8 + e]; d[e] = x1[12 + e] + acc[12 + e]; }
        *(f32x4*)(orow + 8 * lane) = a; *(f32x4*)(orow + 8 * lane + 4) = b; *(f32x4*)(orow + 512 + 8 * lane) = c; *(f32x4*)(orow + 512 + 8 * lane + 4) = d;
    }
}

constexpr int NPHASE = 9;
__global__ void __launch_bounds__(512, 2) fwd_kernel(Params p) {
    extern __shared__ __attribute__((aligned(16))) unsigned char lds_raw[];
    Ctx F;
    F.lds = (LAS unsigned char*)lds_raw;
    F.tid = threadIdx.x; F.lane = F.tid & 63; F.wave = __builtin_amdgcn_readfirstlane(F.tid >> 6);
    F.G = gridDim.x; { const int bx = blockIdx.x; F.vcu = (F.G % 8 == 0) ? (bx % 8) * (F.G / 8) + bx / 8 : bx; }
    F.gw = F.vcu * 8 + F.wave; F.ngw = F.G * 8;
    unsigned char* ws = p.ws;
    const int lo = p.ph_lo, hi = p.ph_hi;
#ifdef ONLY_PHASE
#define IN(k) ((k)==ONLY_PHASE)
#else
#define IN(k) (lo <= (k) && (k) < hi)
#endif
    if (IN(0)) phase0(p, F);
    if (IN(1)) {
        pg8::Gemm g{(const pg8::bf16_t*)(ws + WS_XB), (const pg8::bf16_t*)(ws + WS_WINT), TOK, NIN, DM};
        pg8::StaticOrder S; S.init(TOK, NIN, F.G, (int)blockIdx.x);
        pg8::EpiBf16<0> E{(pg8::bf16_t*)(ws + WS_PROJ), NIN, nullptr, 0, 0, 1.f};
        pg8::gemm_phase<pg8::EpiBf16<0>, pg8::StaticOrder, true, true>(F.lds, g, S, E);
    }
    if (IN(2)) phase2(p, F);
    if (IN(3)) phase3(p, F);
    if (IN(4)) phase4(p, F);
    if (IN(5)) {
        pg8::Gemm g{(const pg8::bf16_t*)(ws + WS_YCAT), (const pg8::bf16_t*)(ws + WS_WOUTT), TOK, DM, DM};
        pg8::StaticOrder S; S.init(TOK, DM, F.G, (int)blockIdx.x);
        pg8::EpiResid E{p.in[0], p.out, (pg8::bf16_t*)(ws + WS_X1B), (float*)(ws + WS_CTL) + CW_ROWSQ, DM};
        pg8::gemm_phase<pg8::EpiResid, pg8::StaticOrder, true, true>(F.lds, g, S, E);
    }
    if (IN(6)) {
        pg8::Gemm g{(const pg8::bf16_t*)(ws + WS_X1B), (const pg8::bf16_t*)(ws + WS_WQT), TOK, 2048, DM};
        pg8::StaticOrder S; S.init(TOK, 2048, F.G, (int)blockIdx.x);
        pg8::EpiBf16<0> E{(pg8::bf16_t*)(ws + WS_QP), 2048, nullptr, 0, 0, 1.f};
        pg8::gemm_phase<pg8::EpiBf16<0>, pg8::StaticOrder, true, true>(F.lds, g, S, E);
    }
    if (IN(7)) phase7(p, F);
    if (IN(8)) phase8(p, F);
#undef IN
}

extern "C" void kernel_launch(void* const* d_in, const int* in_sizes, int n_in, void* d_out, int out_size, void* d_ws, size_t ws_size, hipStream_t stream) {
    static int grid = 0;
    if (grid == 0) {
        if (n_in != 22 || in_sizes[0] != TOK * DM || out_size != TOK * DM || ws_size < WS_END) {
            fprintf(stderr, "kernel_launch: unexpected shapes: n_in %d in0 %d out %d ws %zu\n", n_in, n_in > 0 ? in_sizes[0] : -1, out_size, ws_size); grid = -1; return; }
        if (hipFuncSetAttribute((const void*)fwd_kernel, hipFuncAttributeMaxDynamicSharedMemorySize, LDS_BYTES) != hipSuccess) { fprintf(stderr, "kernel_launch: hipFuncSetAttribute failed\n"); grid = -1; return; }
        int dev = 0, cus = 0;
        if (hipGetDevice(&dev) != hipSuccess || hipDeviceGetAttribute(&cus, hipDeviceAttributeMultiprocessorCount, dev) != hipSuccess) { grid = -1; return; }
        grid = cus;
    }
    if (grid < 0) return;
    (void)hipMemsetAsync((char*)d_ws + WS_CTL, 0, CTL_BYTES, stream);
    Params a{};
    for (int i = 0; i < 22; ++i) a.in[i] = (const float*)d_in[i];
    a.out = (float*)d_out; a.ws = (unsigned char*)d_ws;
    for (int ph = 0; ph < NPHASE; ++ph) {
        a.ph_lo = ph; a.ph_hi = ph + 1;
        hipLaunchKernelGGL(fwd_kernel, dim3(grid), dim3(512), LDS_BYTES, stream, a);
    }
    const hipError_t le = hipPeekAtLastError();
    if (le != hipSuccess) fprintf(stderr, "kernel_launch: launch failed: %s\n", hipGetErrorName(le));
}
```

```cpp
#include <hip/hip_runtime.h>
#include <cstdio>
#include <cstdint>

#define LAS __attribute__((address_space(3)))
#define GAS __attribute__((address_space(1)))
typedef unsigned short bf16_t;
typedef short bf16x8 __attribute__((ext_vector_type(8)));
typedef short s16x4 __attribute__((ext_vector_type(4)));
typedef float f32x4 __attribute__((ext_vector_type(4)));
typedef float f32x8 __attribute__((ext_vector_type(8)));
typedef float f32x16 __attribute__((ext_vector_type(16)));
typedef unsigned u32x4 __attribute__((ext_vector_type(4)));
typedef unsigned u32x2 __attribute__((ext_vector_type(2)));

constexpr int NB = 8, SEQ = 4096, TOK = NB * SEQ, DM = 1024;
constexpr int NIN = 3072;
constexpr int PZ = 0, PXS = 512, PBM = 1024, PCM = 1280, PQ = 1536, PK = 2048, PV = 2560;
constexpr int CHUNK = 64, NCH = SEQ / CHUNK;
constexpr int NHS = 8;
constexpr float EPSN = 1e-6f;
constexpr int PEER_H = 8, NKEYS = 128, TOPK = 16;
constexpr float LAMBDA_INIT = 0.2f;

constexpr size_t MiB = 1u << 20;
constexpr size_t WS_CTL = 0, CTL_BYTES = 1 * MiB;
constexpr size_t WS_WINT = 1 * MiB;
constexpr size_t WS_WOUTT = 7 * MiB;
constexpr size_t WS_WQT = 9 * MiB;
constexpr size_t WS_KEYS = 13 * MiB;
constexpr size_t WS_ROPE = 13 * MiB + 512 * 1024;
constexpr size_t WS_MISC = 13 * MiB + 768 * 1024;
constexpr size_t WS_DTRAW = 14 * MiB;
constexpr size_t WS_ACS = 15 * MiB;
constexpr size_t WS_CDEC = 16 * MiB;
constexpr size_t WS_UB = 20 * MiB;
constexpr size_t WS_VB = 52 * MiB;
constexpr size_t WS_XB = 84 * MiB;
constexpr size_t WS_YCAT = WS_XB;
constexpr size_t WS_PROJ = 148 * MiB;
constexpr size_t WS_QP = WS_PROJ;
constexpr size_t WS_IDX = 276 * MiB;
constexpr size_t WS_GW = 292 * MiB;
constexpr size_t WS_CMC = 340 * MiB;
constexpr size_t WS_STATES = 356 * MiB;
constexpr size_t WS_X1B = WS_STATES;
constexpr size_t WS_END = 484 * MiB;
constexpr int CW_BAR = 4096;
constexpr int CW_ROWSQ = 131072;
static_assert((CW_ROWSQ + TOK) * 4 <= (int)CTL_BYTES, "ctl");

constexpr int LDS_BYTES = 163840;

__device__ __forceinline__ float bf2f(unsigned h) { return __uint_as_float(h << 16); }
__device__ __forceinline__ unsigned f2bf(float f) { unsigned u = __float_as_uint(f); return (u + 0x7fffu + ((u >> 16) & 1u)) >> 16; }
__device__ __forceinline__ unsigned pk2(float lo, float hi) { return f2bf(lo) | (f2bf(hi) << 16); }
__device__ __forceinline__ float wave_sum(float v) {
#pragma unroll
    for (int o = 1; o < 64; o <<= 1) v += __shfl_xor(v, o);
    return v;
}
__device__ __forceinline__ float silu_f(float x) { return x / (1.f + __expf(-x)); }
__device__ __forceinline__ f32x4 mfma16(bf16x8 a, bf16x8 b, f32x4 c) { return __builtin_amdgcn_mfma_f32_16x16x32_bf16(a, b, c, 0, 0, 0); }
__device__ __forceinline__ f32x16 mfma32(bf16x8 a, bf16x8 b, f32x16 c) { return __builtin_amdgcn_mfma_f32_32x32x16_bf16(a, b, c, 0, 0, 0); }
#define LDS_WAIT() asm volatile("s_waitcnt lgkmcnt(0)" ::: "memory")
#define VM_WAIT() asm volatile("s_waitcnt vmcnt(0)" ::: "memory")

#define XB_TMO      128
#define XB_XCNT(j)  (256  + 64 * (j))
#define XB_XSUB(j)  (1280 + 64 * (j))
#define XB_XGEN(j)  (2304 + 64 * (j))
#define XB_TOP      3328
#define XB_TOPGEN   3392
#define XCD_BAR_WORDS 3456
#define XB_SPIN_CAP (1u << 21)

__device__ __forceinline__ unsigned xb_ld(unsigned* p)              { return __hip_atomic_load(p, __ATOMIC_RELAXED, __HIP_MEMORY_SCOPE_AGENT); }
__device__ __forceinline__ unsigned xb_add(unsigned* p, unsigned v) { return __hip_atomic_fetch_add(p, v, __ATOMIC_RELAXED, __HIP_MEMORY_SCOPE_AGENT); }
__device__ __forceinline__ unsigned xb_xcc_id() { return (unsigned)__builtin_amdgcn_s_getreg((3 << 11) | 20) & 0xFu; }
#define XB_SPIN(cond, bar) do { unsigned _sp = 0; while (cond) { __builtin_amdgcn_s_sleep(1); \
    if ((++_sp & 255u) == 0u) { if (xb_ld(&(bar)[XB_TMO])) break; if (_sp > XB_SPIN_CAP) { atomicAdd(&(bar)[XB_TMO], 1u); break; } } } } while (0)

struct XcdBarrier {
    unsigned* bar; unsigned x;
    volatile LAS unsigned* st;
};

__device__ __forceinline__ XcdBarrier xcd_barrier_post(unsigned* bar, volatile LAS unsigned* st) {
    XcdBarrier b; b.bar = bar; b.x = xb_xcc_id(); b.st = st;
    if (threadIdx.x == 0) (void)xb_add(&bar[XB_XCNT(b.x)], 1u);
    return b;
}
__device__ __forceinline__ void xcd_barrier_complete(unsigned* bar, unsigned x, unsigned& nloc, unsigned& nx) {
    const unsigned G = gridDim.x * gridDim.y * gridDim.z;
    unsigned sum, cnt, mine, sp = 0u;
    for (;;) {
        sum = 0u; cnt = 0u; mine = 0u;
#pragma unroll
        for (unsigned j = 0; j < 16; ++j) { const unsigned c = xb_ld(&bar[XB_XCNT(j)]); sum += c; cnt += (c > 0u) ? 1u : 0u; mine = (j == x) ? c : mine; }
        if (sum == G) break;
        __builtin_amdgcn_s_sleep(1);
        if ((++sp & 255u) == 0u) { if (xb_ld(&bar[XB_TMO])) break; if (sp > XB_SPIN_CAP) { atomicAdd(&bar[XB_TMO], 1u); break; } }
    }
    nloc = mine > 0u ? mine : 1u; nx = cnt > 0u ? cnt : 1u;
}

__device__ __forceinline__ void xcd_barrier(const XcdBarrier& b) {
    asm volatile("s_waitcnt vmcnt(0)" ::: "memory");
    __syncthreads();
    if (threadIdx.x == 0) {
        unsigned* bar = b.bar;
        __builtin_amdgcn_s_waitcnt(0);
        unsigned nloc = b.st[0], nx = b.st[1];
        if (nloc == 0u) { xcd_barrier_complete(bar, b.x, nloc, nx); b.st[0] = nloc; b.st[1] = nx; }
        const unsigned old = xb_add(&bar[XB_XSUB(b.x)], 1u);
        const unsigned gen = old / nloc;
        if (old + 1u == (gen + 1u) * nloc) {
            __builtin_amdgcn_fence(__ATOMIC_RELEASE, "agent");
            asm volatile("s_waitcnt vmcnt(0)" ::: "memory");
            const unsigned og = xb_add(&bar[XB_TOP], 1u);
            const unsigned tg = og / nx;
            if (og + 1u == (tg + 1u) * nx) xb_add(&bar[XB_TOPGEN], 1u);
            else XB_SPIN(xb_ld(&bar[XB_TOPGEN]) == tg, bar);
            __builtin_amdgcn_fence(__ATOMIC_ACQUIRE, "agent");
            xb_add(&bar[XB_XGEN(b.x)], 1u);
            asm volatile("s_waitcnt vmcnt(0)" ::: "memory");
        } else {
            XB_SPIN(xb_ld(&bar[XB_XGEN(b.x)]) == gen, bar);
            __builtin_amdgcn_fence(__ATOMIC_ACQUIRE, "agent");
            asm volatile("s_waitcnt vmcnt(0)" ::: "memory");
        }
    }
    __syncthreads();
}
namespace pg8 {
#define PG8_LAS __attribute__((address_space(3)))
typedef unsigned short bf16_t;
typedef short bf16x8 __attribute__((ext_vector_type(8)));
typedef float f32x4 __attribute__((ext_vector_type(4)));
typedef unsigned u32x4 __attribute__((ext_vector_type(4)));
constexpr int BM = 256, BK = 64, HALF = 128, HTB = HALF * BK * 2  , STAGE_BYTES = 8 * HTB, NXCD = 8, WGM = 8;

__host__ __device__ __forceinline__ int lds_byte(int r, int c) { const int st = (r >> 4) * 2 + (c >> 5), rr = r & 15, cc = c & 31, ob = rr * 64 + cc * 2; return st * 1024 + (ob ^ (((ob >> 9) & 1) << 5)); }
__host__ __device__ __forceinline__ void stage_rc(int b, int& R, int& C) { const int st = b / 1024, sb = b % 1024, swz = sb ^ (((sb >> 9) & 1) << 5); R = (st >> 1) * 16 + swz / 64; C = (st & 1) * 32 + (swz % 64) / 2; }
__host__ __device__ __forceinline__ int perm32(int rho) { const int n = rho >> 4, i = rho & 15; return 8 * (i >> 2) + 4 * n + (i & 3); }

struct Unit { int pm, pn; };
struct Gemm { const bf16_t* A; const bf16_t* Bt; int M, N, K; };

struct StaticOrder {
    int nM, nN, nwg, G, c;
    __host__ __device__ void init(int M, int N, int G_, int c_) { nM = M / BM; nN = N / BM; nwg = nM * nN; G = G_; c = c_; }
    __host__ __device__ bool next(int i, Unit& u) const {
        const long L = (long)i * G + c; if (L >= nwg) return false;
        int wgid = (int)L; { const int q = nwg / NXCD, r = nwg % NXCD, xcd = wgid % NXCD, off = wgid / NXCD; wgid = (xcd < r ? xcd * (q + 1) : r * (q + 1) + (xcd - r) * q) + off; }
        const int nig = WGM * nN, gid = wgid / nig, fm = gid * WGM, gsz = (nM - fm) < WGM ? (nM - fm) : WGM;
        u.pm = fm + ((wgid % nig) % gsz); u.pn = (wgid % nig) / gsz; return true;
    }
    __device__ __forceinline__ void a_ready(const Unit&) const {}
    __device__ __forceinline__ void done(const Unit&) const {}
};

__device__ __forceinline__ unsigned cvt_pk_bf16(float lo, float hi) { unsigned r; asm volatile("v_cvt_pk_bf16_f32 %0, %1, %2" : "=v"(r) : "v"(lo), "v"(hi)); return r; }
typedef float f32x2 __attribute__((ext_vector_type(2)));
__device__ __forceinline__ f32x2 gelu_pk(f32x2 v) {
    const f32x2 av = __builtin_elementwise_abs(v), d = av * 0.2316418882f + 1.0f;
    f32x2 t; t.x = __builtin_amdgcn_rcpf(d.x); t.y = __builtin_amdgcn_rcpf(d.y);
    f32x2 q = t * 0.5307027145f + (-0.7265760135f); q = q * t + 0.7107068705f; q = q * t + (-0.142248368f); q = q * t + 0.127414796f; q = q * t;
    const f32x2 s = (v * v) * (-0.72134752044f);
    f32x2 e; e.x = __builtin_amdgcn_exp2f(s.x); e.y = __builtin_amdgcn_exp2f(s.y);
    const f32x2 m = v * (q * e), r = v - m;
    f32x2 o; o.x = v.x < 0.f ? m.x : r.x; o.y = v.y < 0.f ? m.y : r.y; return o;
}

template <int ACT  > struct EpiBf16 {
    static constexpr bool PERM = true, AFTER_DRAIN = false; static_assert(ACT == 0 || ACT == 1, "EpiBf16: ACT is 0 (none) or 1 (gelu_pk)");
    bf16_t* O; int ldc; const float* bias; int split_cols; size_t split_stride; float scale0;
    __device__ __forceinline__ void operator()(const f32x4 (&acc)[2][2][4][2], const Unit& u, int wr, int wc, int fr, int fq) const {
        const int row0 = u.pm * BM + wr * 64 + fr; int colt = u.pn * BM; bf16_t* base = O;
        float sc = 1.f; if (split_cols) { const int t = colt / split_cols; base += (size_t)t * split_stride; colt -= t * split_cols; if (t == 0) sc = scale0; }
        const int col0 = colt + wc * 32 + 8 * fq, bcol0 = u.pn * BM + wc * 32 + 8 * fq;
        f32x4 bv[2][2];
#pragma unroll
        for (int bj = 0; bj < 2; ++bj)
#pragma unroll
            for (int n = 0; n < 2; ++n) bv[bj][n] = bias ? *(const f32x4*)(bias + bcol0 + bj * HALF + 4 * n) : (f32x4){0.f, 0.f, 0.f, 0.f};
#pragma unroll
        for (int ai = 0; ai < 2; ++ai)
#pragma unroll
            for (int m = 0; m < 4; ++m) { bf16_t* rowp = base + (size_t)(row0 + ai * HALF + m * 16) * ldc + col0;
#pragma unroll
                for (int bj = 0; bj < 2; ++bj) { f32x4 v0 = acc[ai][bj][m][0] + bv[bj][0], v1 = acc[ai][bj][m][1] + bv[bj][1];
                    if (ACT == 1) { f32x2 a = gelu_pk((f32x2){v0[0], v0[1]}), b = gelu_pk((f32x2){v0[2], v0[3]}), c = gelu_pk((f32x2){v1[0], v1[1]}), d = gelu_pk((f32x2){v1[2], v1[3]});
                        v0 = (f32x4){a.x, a.y, b.x, b.y}; v1 = (f32x4){c.x, c.y, d.x, d.y}; }
                    v0 = v0 * sc; v1 = v1 * sc; u32x4 w; w.x = cvt_pk_bf16(v0[0], v0[1]); w.y = cvt_pk_bf16(v0[2], v0[3]); w.z = cvt_pk_bf16(v1[0], v1[1]); w.w = cvt_pk_bf16(v1[2], v1[3]);
                    *(u32x4*)(rowp + bj * HALF) = w; } }
    }
};

struct EpiResid {
    static constexpr bool PERM = false, AFTER_DRAIN = false;
    const float* x; float* out; bf16_t* xb; float* rowsq; int ldc;
    __device__ __forceinline__ void operator()(const f32x4 (&acc)[2][2][4][2], const Unit& u, int wr, int wc, int fr, int fq) const {
        const int col0 = u.pn * BM + wc * 32 + 4 * fq;
#pragma unroll
        for (int ai = 0; ai < 2; ++ai)
#pragma unroll
            for (int m = 0; m < 4; ++m) {
                const int row = u.pm * BM + ai * HALF + wr * 64 + m * 16 + fr;
                const size_t off = (size_t)row * ldc + col0;
                float ss = 0.f;
#pragma unroll
                for (int bj = 0; bj < 2; ++bj)
#pragma unroll
                    for (int n = 0; n < 2; ++n) {
                        const size_t c = off + bj * HALF + n * 16;
                        const f32x4 xv = *(const f32x4*)(x + c);
                        const f32x4 o = xv + acc[ai][bj][m][n];
                        *(f32x4*)(out + c) = o;
                        ss += (o[0] * o[0] + o[1] * o[1]) + (o[2] * o[2] + o[3] * o[3]);
                        typedef unsigned u32x2v __attribute__((ext_vector_type(2)));
                        u32x2v w; w.x = cvt_pk_bf16(o[0], o[1]); w.y = cvt_pk_bf16(o[2], o[3]);
                        *(u32x2v*)(xb + c) = w;
                    }
                ss += __shfl_xor(ss, 16); ss += __shfl_xor(ss, 32);
                if (fq == 0) atomicAdd(rowsq + row, ss);
            }
    }
};

template <class Epi, class Sched, bool ALIGN_EPI = false, bool SP2 = false>
__device__ __forceinline__ void gemm_phase(PG8_LAS unsigned char* lds, const Gemm g, const Sched& S, const Epi& E) {
    const int tid = threadIdx.x, wid = __builtin_amdgcn_readfirstlane(tid >> 6), lane = tid & 63, wr = wid >> 2, wc = wid & 3, fr = lane & 15, fq = lane >> 4;
    const int K = g.K, nt = K / BK;
    unsigned voffA[2], voffB[2];
#pragma unroll
    for (int i = 0; i < 2; ++i) { int R, C; stage_rc(tid * 16 + i * 8192, R, C); const int Rb = Epi::PERM ? ((R & ~31) + perm32(R & 31)) : R;
        voffA[i] = (unsigned)(R * K + C) * 2u; voffB[i] = (unsigned)(Rb * K + C) * 2u; }
    const size_t kstep = (size_t)(BK * 2);
    const size_t hstep = (size_t)HALF * K * 2;
    const size_t tstep = 2 * hstep;
    const unsigned ldsw = (unsigned)wid * 1024u;
    const int aoff = lds_byte(wr * 64 + fr, fq * 8), boff = lds_byte(wc * 32 + fr, fq * 8);
#define PG8_SA(b, h) (((b) * 2 + (h)) * HTB)
#define PG8_SB(b, h) ((4 + (b) * 2 + (h)) * HTB)
#define PG8_STAGE(bufoff, gbase, voff) do { _Pragma("unroll") for (int _i = 0; _i < 2; ++_i) \
        __builtin_amdgcn_global_load_lds((const unsigned*)((const char*)(gbase) + (voff)[_i]), (PG8_LAS unsigned*)(lds + (bufoff) + ldsw + _i * 8192), 16, 0, 0); } while (0)
#define PG8_LDA(dst, b, h) do { _Pragma("unroll") for (int m = 0; m < 4; ++m) _Pragma("unroll") for (int k = 0; k < 2; ++k) dst[m][k] = *(const PG8_LAS bf16x8*)(lds + PG8_SA(b, h) + aoff + m * 2048 + k * 1024); } while (0)
#define PG8_LDB(dst, b, h) do { _Pragma("unroll") for (int n = 0; n < 2; ++n) _Pragma("unroll") for (int k = 0; k < 2; ++k) dst[n][k] = *(const PG8_LAS bf16x8*)(lds + PG8_SB(b, h) + boff + n * 2048 + k * 1024); } while (0)
#define PG8_MMA(ai, bj, At, Bt) do { __builtin_amdgcn_s_setprio(1); _Pragma("unroll") for (int m = 0; m < 4; ++m) _Pragma("unroll") for (int n = 0; n < 2; ++n) _Pragma("unroll") for (int k = 0; k < 2; ++k) \
        acc[ai][bj][m][n] = __builtin_amdgcn_mfma_f32_16x16x32_bf16(Bt[n][k], At[m][k], acc[ai][bj][m][n], 0, 0, 0); __builtin_amdgcn_s_setprio(0); } while (0)
#define PG8_WAIT_V(n) asm volatile("s_waitcnt vmcnt(" #n ")" ::: "memory")
#define PG8_WAIT_L(n) asm volatile("s_waitcnt lgkmcnt(" #n ")" ::: "memory")
#define PG8_BAR __builtin_amdgcn_s_barrier()
#define PG8_SCHED __builtin_amdgcn_sched_barrier(0)
    Unit cur, nxt; int ui = 0;
    if (!S.next(0, cur)) return;
    f32x4 acc[2][2][4][2];
#pragma unroll
    for (int a = 0; a < 2; ++a)
#pragma unroll
        for (int b = 0; b < 2; ++b)
#pragma unroll
            for (int m = 0; m < 4; ++m)
#pragma unroll
                for (int n = 0; n < 2; ++n) acc[a][b][m][n] = (f32x4){0.f, 0.f, 0.f, 0.f};
    bf16x8 At[4][2], B0[2][2], B1[2][2];
    const char* cA = (const char*)g.A + (size_t)cur.pm * tstep; const char* cB = (const char*)g.Bt + (size_t)cur.pn * tstep;
    S.a_ready(cur);
    if constexpr (SP2) {
        PG8_STAGE(PG8_SB(0, 0), cB, voffB); PG8_STAGE(PG8_SB(0, 1), cB + hstep, voffB); PG8_STAGE(PG8_SA(0, 0), cA, voffA); PG8_STAGE(PG8_SA(0, 1), cA + hstep, voffA);
        if (wr == 1) PG8_BAR;
        PG8_WAIT_V(2); PG8_BAR;
        PG8_STAGE(PG8_SB(1, 0), cB + kstep, voffB); PG8_STAGE(PG8_SA(1, 0), cA + kstep, voffA); PG8_STAGE(PG8_SB(1, 1), cB + hstep + kstep, voffB);
        PG8_WAIT_V(6); PG8_BAR;
    } else {
        PG8_STAGE(PG8_SB(0, 0), cB, voffB); PG8_STAGE(PG8_SA(0, 0), cA, voffA); PG8_STAGE(PG8_SB(0, 1), cB + hstep, voffB); PG8_STAGE(PG8_SA(0, 1), cA + hstep, voffA);
        if (wr == 1) PG8_BAR;
        PG8_WAIT_V(4); PG8_BAR;
        PG8_STAGE(PG8_SB(1, 0), cB + kstep, voffB); PG8_STAGE(PG8_SA(1, 0), cA + kstep, voffA); PG8_STAGE(PG8_SB(1, 1), cB + hstep + kstep, voffB);
        PG8_WAIT_V(6); PG8_BAR;
    }
    for (;;) {
        const bool has_next = S.next(ui + 1, nxt);
        const char* nA = has_next ? (const char*)g.A + (size_t)nxt.pm * tstep : cA; const char* nB = has_next ? (const char*)g.Bt + (size_t)nxt.pn * tstep : cB;
        for (int t = 0; t < nt; t += 2) {
            const bool last = (t == nt - 2);
            const char* a1 = cA + (size_t)(t + 1) * kstep;
            const char* a2 = last ? nA : cA + (size_t)(t + 2) * kstep; const char* b2 = last ? nB : cB + (size_t)(t + 2) * kstep;
            const char* a3 = a2 + kstep; const char* b3 = b2 + kstep;
            if (last && has_next) S.a_ready(nxt);
            if constexpr (SP2) {
            PG8_LDB(B0, 0, 0); PG8_LDB(B1, 0, 1); PG8_SCHED; PG8_LDA(At, 0, 0); PG8_STAGE(PG8_SA(1, 1), a1 + hstep, voffA);
            PG8_WAIT_V(8); PG8_WAIT_L(0); PG8_BAR; PG8_MMA(0, 0, At, B0); PG8_MMA(0, 1, At, B1); PG8_BAR; PG8_SCHED;
            PG8_LDA(At, 0, 1); PG8_STAGE(PG8_SB(0, 0), b2, voffB); PG8_STAGE(PG8_SB(0, 1), b2 + hstep, voffB); PG8_STAGE(PG8_SA(0, 0), a2, voffA);
            PG8_WAIT_V(8); PG8_WAIT_L(0); PG8_BAR; PG8_MMA(1, 0, At, B0); PG8_MMA(1, 1, At, B1); PG8_BAR; PG8_SCHED;
            PG8_LDB(B0, 1, 0); PG8_LDB(B1, 1, 1); PG8_SCHED; PG8_LDA(At, 1, 0); PG8_STAGE(PG8_SA(0, 1), a2 + hstep, voffA);
            PG8_WAIT_V(8); PG8_WAIT_L(0); PG8_BAR; PG8_MMA(0, 0, At, B0); PG8_MMA(0, 1, At, B1); PG8_BAR; PG8_SCHED;
            PG8_LDA(At, 1, 1); PG8_STAGE(PG8_SB(1, 0), b3, voffB); PG8_STAGE(PG8_SB(1, 1), b3 + hstep, voffB); PG8_STAGE(PG8_SA(1, 0), a3, voffA);
            PG8_WAIT_V(8); PG8_WAIT_L(0); PG8_BAR; PG8_MMA(1, 0, At, B0); PG8_MMA(1, 1, At, B1); PG8_BAR; PG8_SCHED;
            } else {
            PG8_LDB(B0, 0, 0); PG8_SCHED; PG8_LDA(At, 0, 0); PG8_STAGE(PG8_SA(1, 1), a1 + hstep, voffA);
            PG8_WAIT_L(8); PG8_BAR; PG8_WAIT_L(0); PG8_MMA(0, 0, At, B0); PG8_BAR; PG8_SCHED;
            PG8_LDB(B1, 0, 1); PG8_STAGE(PG8_SB(0, 0), b2, voffB);
            PG8_BAR; PG8_WAIT_L(0); PG8_MMA(0, 1, At, B1); PG8_BAR;
            PG8_LDA(At, 0, 1); PG8_STAGE(PG8_SA(0, 0), a2, voffA);
            PG8_BAR; PG8_WAIT_L(0); PG8_MMA(1, 0, At, B0); PG8_BAR; PG8_SCHED;
            PG8_STAGE(PG8_SB(0, 1), b2 + hstep, voffB);
            PG8_WAIT_V(6); PG8_BAR; PG8_MMA(1, 1, At, B1); PG8_BAR;
            PG8_LDB(B0, 1, 0); PG8_SCHED; PG8_LDA(At, 1, 0); PG8_STAGE(PG8_SA(0, 1), a2 + hstep, voffA);
            PG8_WAIT_L(8); PG8_BAR; PG8_WAIT_L(0); PG8_MMA(0, 0, At, B0); PG8_BAR; PG8_SCHED;
            PG8_LDB(B1, 1, 1); PG8_STAGE(PG8_SB(1, 0), b3, voffB);
            PG8_BAR; PG8_WAIT_L(0); PG8_MMA(0, 1, At, B1); PG8_BAR;
            PG8_LDA(At, 1, 1); PG8_STAGE(PG8_SA(1, 0), a3, voffA);
            PG8_BAR; PG8_WAIT_L(0); PG8_MMA(1, 0, At, B0); PG8_BAR; PG8_SCHED;
            PG8_STAGE(PG8_SB(1, 1), b3 + hstep, voffB);
            PG8_WAIT_V(6); PG8_BAR; PG8_MMA(1, 1, At, B1); PG8_BAR;
            }
        }
        if constexpr (ALIGN_EPI) { if (wr == 0) PG8_BAR; }
        if constexpr (!Epi::AFTER_DRAIN) { E(acc, cur, wr, wc, fr, fq); S.done(cur); }
        if (!has_next) break;
#pragma unroll
        for (int a = 0; a < 2; ++a)
#pragma unroll
            for (int b = 0; b < 2; ++b)
#pragma unroll
                for (int m = 0; m < 4; ++m)
#pragma unroll
                    for (int n = 0; n < 2; ++n) acc[a][b][m][n] = (f32x4){0.f, 0.f, 0.f, 0.f};
        cur = nxt; cA = nA; cB = nB; ++ui;
        if constexpr (ALIGN_EPI) { if (wr == 1) PG8_BAR; }
    }
    PG8_WAIT_V(0);
    if constexpr (!ALIGN_EPI) { if (wr == 0) PG8_BAR; }
    PG8_BAR;
    if constexpr (Epi::AFTER_DRAIN) { E.fused(acc, cur, wr, wc, fr, fq, lds, wid, lane); S.done(cur); }
#undef PG8_SA
#undef PG8_SB
#undef PG8_STAGE
#undef PG8_LDA
#undef PG8_LDB
#undef PG8_MMA
#undef PG8_WAIT_V
#undef PG8_WAIT_L
#undef PG8_BAR
#undef PG8_SCHED
}
}

struct Params {
    const float* in[22];
    float* out;
    unsigned char* ws;
    int ph_lo, ph_hi;
};
struct Ctx { LAS unsigned char* lds; int tid, lane, wave, vcu, G, gw, ngw; };

__device__ __forceinline__ void p0_transpose_item(const float* W, int K, int Nreal, int thresh, const float* ksc, bf16_t* WT, LAS float* scr, int item, int nblk, int lane) {
    const int kb = item / nblk, nb = item % nblk, k0 = 64 * kb, n0 = 32 * nb;
    const int nr0 = n0 + (n0 >= thresh ? 8 : 0);
#pragma unroll 8
    for (int i = 0; i < 32; ++i) {
        const int kk = 2 * i + (lane >> 5);
        const float sc = ksc ? ksc[k0 + kk] : 1.f;
        scr[kk * 33 + (lane & 31)] = W[(size_t)(k0 + kk) * Nreal + nr0 + (lane & 31)] * sc;
    }
    LDS_WAIT(); asm volatile("" ::: "memory");
    const int c = lane & 7;
#pragma unroll
    for (int j = 0; j < 4; ++j) {
        const int n = (lane >> 3) + 8 * j; const LAS float* s = scr + (8 * c) * 33 + n;
        u32x4 o; o.x = pk2(s[0 * 33], s[1 * 33]); o.y = pk2(s[2 * 33], s[3 * 33]); o.z = pk2(s[4 * 33], s[5 * 33]); o.w = pk2(s[6 * 33], s[7 * 33]);
        *(u32x4*)(WT + (size_t)(n0 + n) * K + k0 + 8 * c) = o;
    }
    LDS_WAIT(); asm volatile("" ::: "memory");
}

__device__ __forceinline__ void phase0(const Params& p, Ctx& F) {
    const float* x = p.in[0]; const float* mixw = p.in[1]; const float* w_in = p.in[2];
    const float* w_out = p.in[16]; const float* ffnw = p.in[17]; const float* w_q = p.in[18]; const float* keys = p.in[19];
    const float* pu = p.in[20]; const float* pv = p.in[21];
    unsigned char* ws = p.ws;
    LAS float* scr = (LAS float*)(F.lds + F.wave * 8448);
    LAS float* wdt = (LAS float*)(F.lds + 69632);
    for (int k = F.tid; k < DM; k += 512) {
        const float s = mixw[k];
        const f32x4 a = *(const f32x4*)(w_in + (size_t)k * 3080 + 1536), b = *(const f32x4*)(w_in + (size_t)k * 3080 + 1540);
        *(LAS f32x4*)(wdt + k * 8) = a * s; *(LAS f32x4*)(wdt + k * 8 + 4) = b * s;
    }
    __syncthreads();
    constexpr int I_IN = 16 * 96, I_OUT = 16 * 32, I_Q = 16 * 64;
    for (int it = F.gw; it < I_IN + I_OUT + I_Q; it += F.ngw) {
        int r = it;
        if (r < I_IN) { p0_transpose_item(w_in, DM, 3080, 1536, mixw, (bf16_t*)(ws + WS_WINT), scr, r, 96, F.lane); continue; } r -= I_IN;
        if (r < I_OUT) { p0_transpose_item(w_out, DM, DM, 1 << 30, nullptr, (bf16_t*)(ws + WS_WOUTT), scr, r, 32, F.lane); continue; } r -= I_OUT;
        p0_transpose_item(w_q, DM, 2048, 1 << 30, ffnw, (bf16_t*)(ws + WS_WQT), scr, r, 64, F.lane);
    }
    const int gtid = F.vcu * 512 + F.tid, nthr = F.G * 512;
    for (int i = gtid; i < 16 * 128 * 128 / 8; i += nthr) {
        const f32x4 a = *(const f32x4*)(keys + (size_t)i * 8), b = *(const f32x4*)(keys + (size_t)i * 8 + 4);
        u32x4 o; o.x = pk2(a[0], a[1]); o.y = pk2(a[2], a[3]); o.z = pk2(b[0], b[1]); o.w = pk2(b[2], b[3]);
        *(u32x4*)((bf16_t*)(ws + WS_KEYS) + (size_t)i * 8) = o;
    }
    for (int i = gtid; i < SEQ * 8; i += nthr) {
        const int pos = i >> 3, f = i & 7;
        const float inv = powf(500000.0f, -(float)(2 * f) / 16.0f);
        const float ang = (float)pos * inv;
        ((float*)(ws + WS_ROPE))[i] = cosf(ang);
        ((float*)(ws + WS_ROPE))[SEQ * 8 + i] = sinf(ang);
    }
    if (F.gw == 0) {
        const float a = p.in[11][F.lane] * p.in[12][F.lane], b = p.in[13][F.lane] * p.in[14][F.lane];
        const float sa = wave_sum(a), sb = wave_sum(b);
        if (F.lane == 0) ((float*)(ws + WS_MISC))[0] = expf(sa) - expf(sb) + LAMBDA_INIT;
    }
    {
        constexpr int N8 = 16384 * 1024 / 8;
        for (int i = gtid; i < 2 * N8; i += nthr) {
            const bool isU = i < N8; const int j = isU ? i : i - N8;
            const float* src = (isU ? pu : pv) + (size_t)j * 8;
            const f32x4 a = *(const f32x4*)src, b = *(const f32x4*)(src + 4);
            u32x4 o; o.x = pk2(a[0], a[1]); o.y = pk2(a[2], a[3]); o.z = pk2(b[0], b[1]); o.w = pk2(b[2], b[3]);
            *(u32x4*)((bf16_t*)(ws + (isU ? WS_UB : WS_VB)) + (size_t)j * 8) = o;
        }
    }
    bf16_t* xb = (bf16_t*)(ws + WS_XB); float* dtraw = (float*)(ws + WS_DTRAW);
    for (int m = F.gw; m < TOK; m += F.ngw) {
        const f32x4* xr = (const f32x4*)(x + (size_t)m * DM) + F.lane;
        f32x4 v[4]; float ss = 0.f;
#pragma unroll
        for (int j = 0; j < 4; ++j) { v[j] = xr[64 * j]; ss += (v[j][0] * v[j][0] + v[j][1] * v[j][1]) + (v[j][2] * v[j][2] + v[j][3] * v[j][3]); }
        const float r = rsqrtf(wave_sum(ss) * (1.f / DM) + EPSN);
        f32x4 d0 = {0.f, 0.f, 0.f, 0.f}, d1 = {0.f, 0.f, 0.f, 0.f};
#pragma unroll
        for (int j = 0; j < 4; ++j)
#pragma unroll
            for (int e = 0; e < 4; ++e) {
                const int k = 256 * j + 4 * F.lane + e;
                const f32x4 w0 = *(const LAS f32x4*)(wdt + k * 8), w1 = *(const LAS f32x4*)(wdt + k * 8 + 4);
                d0 += w0 * v[j][e]; d1 += w1 * v[j][e];
            }
#pragma unroll
        for (int e = 0; e < 4; ++e) { d0[e] = wave_sum(d0[e]); d1[e] = wave_sum(d1[e]); }
        if (F.lane == 0) { *(f32x4*)(dtraw + (size_t)m * 8) = d0 * r; *(f32x4*)(dtraw + (size_t)m * 8 + 4) = d1 * r; }
        unsigned long long* o8 = (unsigned long long*)(xb + (size_t)m * DM) + F.lane;
#pragma unroll
        for (int j = 0; j < 4; ++j) o8[64 * j] = (unsigned long long)pk2(v[j][0] * r, v[j][1] * r) | ((unsigned long long)pk2(v[j][2] * r, v[j][3] * r) << 32);
    }
}

__device__ __forceinline__ void p2_qk_prepass(const Params& p, Ctx& F) {
    bf16_t* proj = (bf16_t*)(p.ws + WS_PROJ);
    const float* qnw = p.in[9]; const float* knw = p.in[10];
    const float* cosT = (const float*)(p.ws + WS_ROPE); const float* sinT = cosT + SEQ * 8;
    const int sub = F.lane & 7;
    for (int wsi = F.gw; wsi < TOK * 2; wsi += F.ngw) {
        const int t = wsi >> 1, which = wsi & 1;
        bf16_t* ptr = proj + (size_t)t * NIN + (which ? PK : PQ) + F.lane * 8;
        const u32x4 raw = *(const u32x4*)ptr;
        float v[8];
#pragma unroll
        for (int e = 0; e < 4; ++e) { v[2 * e] = bf2f(raw[e] & 0xffffu); v[2 * e + 1] = bf2f(raw[e] >> 16); }
        float ss = 0.f;
#pragma unroll
        for (int e = 0; e < 8; ++e) ss += v[e] * v[e];
        ss += __shfl_xor(ss, 1); ss += __shfl_xor(ss, 2); ss += __shfl_xor(ss, 4);
        const float rs = rsqrtf(ss * (1.f / 64.f) + EPSN);
        const float* w = which ? knw : qnw;
        const int pos = t & (SEQ - 1);
        float o[8];
#pragma unroll
        for (int e = 0; e < 8; ++e) {
            const float y = v[e] * rs * w[sub * 8 + e];
            const float other = __shfl_xor(y, 1);
            const float c = cosT[pos * 8 + e], s = sinT[pos * 8 + e];
            float r = y;
            if (sub == 0) r = y * c - other * s;
            else if (sub == 1) r = other * s + y * c;
            o[e] = r;
        }
        u32x4 ov; ov.x = pk2(o[0], o[1]); ov.y = pk2(o[2], o[3]); ov.z = pk2(o[4], o[5]); ov.w = pk2(o[6], o[7]);
        *(u32x4*)ptr = ov;
    }
}

constexpr int P2_XS = 0, P2_BM = 33792, P2_CM = 51200, P2_CB = 68608, P2_MH = 85248, P2_XW = 122112, P2_ACS = 155904, P2_DT = 156928, P2_FAC = 157952;
constexpr int XS_LD = 264, BM_LD = 136, MH_LD = 72, CB_LD = 65;
static_assert(P2_FAC + 1024 <= LDS_BYTES, "P2 LDS");

__device__ __forceinline__ void p2_ssd_unit(const Params& p, Ctx& F, int b, int c, int g) {
    unsigned char* ws = p.ws;
    const bf16_t* proj = (const bf16_t*)(ws + WS_PROJ);
    bf16_t* ycat = (bf16_t*)(ws + WS_YCAT); bf16_t* cmc = (bf16_t*)(ws + WS_CMC);
    float* states = (float*)(ws + WS_STATES); float* acs_g = (float*)(ws + WS_ACS); float* cdec = (float*)(ws + WS_CDEC);
    const float* dtraw = (const float*)(ws + WS_DTRAW);
    const float* conv_w = p.in[3]; const float* conv_b = p.in[4]; const float* dt_bias = p.in[5]; const float* a_log = p.in[6]; const float* d_skip = p.in[7];
    LAS bf16_t* XS = (LAS bf16_t*)(F.lds + P2_XS); LAS bf16_t* BM = (LAS bf16_t*)(F.lds + P2_BM); LAS bf16_t* CM = (LAS bf16_t*)(F.lds + P2_CM);
    LAS float* CB = (LAS float*)(F.lds + P2_CB); LAS bf16_t* MH = (LAS bf16_t*)(F.lds + P2_MH); LAS bf16_t* XW = (LAS bf16_t*)(F.lds + P2_XW);
    LAS float* ACS = (LAS float*)(F.lds + P2_ACS); LAS float* DT = (LAS float*)(F.lds + P2_DT); LAS float* FAC = (LAS float*)(F.lds + P2_FAC);
    const int tid = F.tid, lane = F.lane, wave = F.wave, fr = lane & 15, fq = lane >> 4;
    const size_t tbase = (size_t)b * SEQ + (size_t)c * CHUNK;
#ifndef SKIP_A
    {
        const int cg = tid & 63, rg = tid >> 6, lc = cg * 8;
        int pcol, dld, dcol, kind;
        if (lc < 256) { pcol = PXS + g * 256 + lc; dld = XS_LD; dcol = lc; kind = 0; }
        else if (lc < 384) { pcol = PBM + g * 128 + (lc - 256); dld = BM_LD; dcol = lc - 256; kind = 1; }
        else { pcol = PCM + g * 128 + (lc - 384); dld = BM_LD; dcol = lc - 384; kind = 2; }
        LAS bf16_t* dst = kind == 0 ? XS : (kind == 1 ? BM : CM);
        const int ch = pcol - 512;
        float cw[4][8], cbv[8];
#pragma unroll
        for (int w = 0; w < 4; ++w) {
            const f32x4 a = *(const f32x4*)(conv_w + w * 1024 + ch), bq = *(const f32x4*)(conv_w + w * 1024 + ch + 4);
#pragma unroll
            for (int e = 0; e < 4; ++e) { cw[w][e] = a[e]; cw[w][4 + e] = bq[e]; }
        }
        { const f32x4 a = *(const f32x4*)(conv_b + ch), bq = *(const f32x4*)(conv_b + ch + 4);
#pragma unroll
          for (int e = 0; e < 4; ++e) { cbv[e] = a[e]; cbv[4 + e] = bq[e]; } }
        u32x4 rv[11];
#pragma unroll
        for (int i = 0; i < 11; ++i) {
            const int f = c * CHUNK + rg * 8 - 3 + i;
            u32x4 v = {0u, 0u, 0u, 0u};
            if (f >= 0) v = *(const u32x4*)(proj + ((size_t)b * SEQ + f) * NIN + pcol);
            rv[i] = v;
        }
#pragma unroll
        for (int r = 0; r < 8; ++r) {
            const int l = rg * 8 + r;
            float o[8];
#pragma unroll
            for (int e = 0; e < 8; ++e) o[e] = cbv[e];
#pragma unroll
            for (int w = 0; w < 4; ++w)
#pragma unroll
                for (int e = 0; e < 4; ++e) {
                    o[2 * e] += cw[w][2 * e] * bf2f(rv[r + w][e] & 0xffffu);
                    o[2 * e + 1] += cw[w][2 * e + 1] * bf2f(rv[r + w][e] >> 16);
                }
#pragma unroll
            for (int e = 0; e < 8; ++e) o[e] = silu_f(o[e]);
            u32x4 ov; ov.x = pk2(o[0], o[1]); ov.y = pk2(o[2], o[3]); ov.z = pk2(o[4], o[5]); ov.w = pk2(o[6], o[7]);
            *(LAS u32x4*)(dst + l * dld + dcol) = ov;
            if (kind == 2) *(u32x4*)(cmc + (tbase + l) * 256 + g * 128 + dcol) = ov;
        }
    }
#endif
    if (tid < 256) {
        const int l = tid >> 2, h = tid & 3, hh = g * 4 + h;
        const float v = dtraw[(tbase + l) * 8 + hh] + dt_bias[hh];
        const float dt = v > 20.f ? v : log1pf(expf(v));
        DT[l * 4 + h] = dt;
        ACS[l * 4 + h] = dt * (-expf(a_log[hh]));
    }
    __syncthreads();
    if (tid < 4) {
        float s = 0.f;
        for (int l = 0; l < 64; ++l) { s += ACS[l * 4 + tid]; ACS[l * 4 + tid] = s; }
        cdec[((size_t)b * NCH + c) * 8 + g * 4 + tid] = expf(s);
    }
    __syncthreads();
    if (tid < 256) {
        const int l = tid >> 2, h = tid & 3;
        acs_g[(tbase + l) * 8 + g * 4 + h] = ACS[l * 4 + h];
        FAC[l * 4 + h] = DT[l * 4 + h] * expf(ACS[63 * 4 + h] - ACS[l * 4 + h]);
    }
#pragma unroll
    for (int q = 0; q < 2; ++q) {
        const int tile = wave * 2 + q, mt = tile >> 2, nt = tile & 3;
        f32x4 acc = {0.f, 0.f, 0.f, 0.f};
#pragma unroll
        for (int ks = 0; ks < 4; ++ks) {
            const bf16x8 a = *(const LAS bf16x8*)(CM + (mt * 16 + fr) * BM_LD + ks * 32 + fq * 8);
            const bf16x8 bq = *(const LAS bf16x8*)(BM + (nt * 16 + fr) * BM_LD + ks * 32 + fq * 8);
            acc = mfma16(a, bq, acc);
        }
#pragma unroll
        for (int j = 0; j < 4; ++j) CB[(mt * 16 + 4 * fq + j) * CB_LD + nt * 16 + fr] = acc[j];
    }
    __syncthreads();
#pragma unroll 2
    for (int i = 0; i < 32; ++i) {
        const int e = tid + 512 * i, h = e >> 12, l = (e >> 6) & 63, s = e & 63;
        float v = 0.f;
        if (s <= l) v = CB[l * CB_LD + s] * __expf(ACS[l * 4 + h] - ACS[s * 4 + h]) * DT[s * 4 + h];
        MH[(h * 64 + l) * MH_LD + s] = (bf16_t)f2bf(v);
    }
#pragma unroll 2
    for (int i = 0; i < 32; ++i) {
        const int e = tid + 512 * i, l = e >> 8, col = e & 255;
        XW[l * XS_LD + col] = (bf16_t)f2bf(bf2f(XS[l * XS_LD + col]) * FAC[l * 4 + (col >> 6)]);
    }
    __syncthreads();
#ifndef SKIP_E
    {
        const int h = wave >> 1, hh = g * 4 + h; const float dsk = d_skip[hh];
#pragma unroll 1
        for (int mq = 0; mq < 2; ++mq) {
            const int mt = 2 * (wave & 1) + mq;
            bf16x8 a[2];
#pragma unroll
            for (int ks = 0; ks < 2; ++ks) a[ks] = *(const LAS bf16x8*)(MH + (h * 64 + mt * 16 + fr) * MH_LD + ks * 32 + fq * 8);
#pragma unroll 1
            for (int nt = 0; nt < 4; ++nt) {
                f32x4 acc = {0.f, 0.f, 0.f, 0.f};
#pragma unroll
                for (int ks = 0; ks < 2; ++ks) {
                    bf16x8 bq;
#pragma unroll
                    for (int jj = 0; jj < 8; ++jj) bq[jj] = (short)XS[(ks * 32 + 8 * fq + jj) * XS_LD + h * 64 + nt * 16 + fr];
                    acc = mfma16(a[ks], bq, acc);
                }
#pragma unroll
                for (int j = 0; j < 4; ++j) {
                    const int l = mt * 16 + 4 * fq + j, pp = nt * 16 + fr;
                    const float val = acc[j] + bf2f(XS[l * XS_LD + h * 64 + pp]) * dsk;
                    ycat[(tbase + l) * DM + g * 256 + h * 64 + pp] = (bf16_t)f2bf(val);
                }
            }
        }
    }
#endif
#ifndef SKIP_F
    {
        const int h = wave >> 1, hh = g * 4 + h;
        float* sbase = states + (((size_t)b * NCH + c) * 8 + hh) * 64 * 128;
#pragma unroll 1
        for (int mq = 0; mq < 2; ++mq) {
            const int mt = 2 * (wave & 1) + mq;
            bf16x8 a[2];
#pragma unroll
            for (int ks = 0; ks < 2; ++ks)
#pragma unroll
                for (int jj = 0; jj < 8; ++jj) a[ks][jj] = (short)XW[(ks * 32 + 8 * fq + jj) * XS_LD + h * 64 + mt * 16 + fr];
#pragma unroll 1
            for (int nt = 0; nt < 8; ++nt) {
                f32x4 acc = {0.f, 0.f, 0.f, 0.f};
#pragma unroll
                for (int ks = 0; ks < 2; ++ks) {
                    bf16x8 bq;
#pragma unroll
                    for (int jj = 0; jj < 8; ++jj) bq[jj] = (short)BM[(ks * 32 + 8 * fq + jj) * BM_LD + nt * 16 + fr];
                    acc = mfma16(a[ks], bq, acc);
                }
#pragma unroll
                for (int j = 0; j < 4; ++j) sbase[(size_t)(mt * 16 + 4 * fq + j) * 128 + nt * 16 + fr] = acc[j];
            }
        }
    }
#endif
    __syncthreads();
}

__device__ __forceinline__ void phase2(const Params& p, Ctx& F) {
    p2_qk_prepass(p, F);
    for (int u = F.vcu; u < NB * NCH * 2; u += F.G) {
        const int g = u & 1, c = (u >> 1) & 63, b = u >> 7;
        p2_ssd_unit(p, F, b, c, g);
    }
}

__device__ __forceinline__ void p3_scan(const Params& p, Ctx& F) {
    float* states = (float*)(p.ws + WS_STATES); const float* cdec = (const float*)(p.ws + WS_CDEC);
    const int gtid = F.vcu * 512 + F.tid, nthr = F.G * 512;
    for (int e = gtid; e < NB * 8 * 64 * 32; e += nthr) {
        const int n4 = e & 31, pp = (e >> 5) & 63, hh = (e >> 11) & 7, b = e >> 14;
        f32x4 carry = {0.f, 0.f, 0.f, 0.f};
        for (int c0 = 0; c0 < NCH; c0 += 8) {
            f32x4 s[8]; float dc[8];
#pragma unroll
            for (int i = 0; i < 8; ++i) {
                s[i] = *(const f32x4*)(states + ((((size_t)b * NCH + c0 + i) * 8 + hh) * 64 + pp) * 128 + n4 * 4);
                dc[i] = cdec[((size_t)b * NCH + c0 + i) * 8 + hh];
            }
#pragma unroll
            for (int i = 0; i < 8; ++i) {
                *(f32x4*)(states + ((((size_t)b * NCH + c0 + i) * 8 + hh) * 64 + pp) * 128 + n4 * 4) = carry;
                carry = carry * dc[i] + s[i];
            }
        }
    }
}

namespace att {
constexpr int NW = 8, QBLK = 32, KVBLK = 64;
constexpr float SCALE = 0.125f, THR = 8.f;
constexpr int SHM_V = KVBLK * 128 * 2, SHM_K = KVBLK * 64 * 2;
constexpr int LDS_V = 0, LDS_K = 2 * SHM_V, LDS_WS = LDS_K + 2 * SHM_K, LDS_END = LDS_WS + NW * 64 * 4;
#define KSWZ64(row, colB) ((row) * 128 + ((colB) ^ ((((row) >> 1) & 7) << 4)))
#define SBAR() __builtin_amdgcn_sched_barrier(0)
__device__ __forceinline__ int crow(int r, int hi) { return (r & 3) + 8 * (r >> 2) + 4 * hi; }
__device__ __forceinline__ unsigned cvtpk(float lo, float hi) { unsigned r; asm volatile("v_cvt_pk_bf16_f32 %0, %1, %2" : "=v"(r) : "v"(lo), "v"(hi)); return r; }

__device__ __forceinline__ void partialSM(f32x16& p0, f32x16& p1, float& m_reg, float& mn, float& alpha) {
    constexpr float C = SCALE * 1.4426950408889634f;
    float pmax = p0[0];
#pragma unroll
    for (int r = 1; r < 16; ++r) pmax = fmaxf(pmax, p0[r]);
#pragma unroll
    for (int r = 0; r < 16; ++r) pmax = fmaxf(pmax, p1[r]);
    { auto rr = __builtin_amdgcn_permlane32_swap(__float_as_uint(pmax), __float_as_uint(pmax), false, false);
      pmax = fmaxf(__uint_as_float(rr[0]), __uint_as_float(rr[1])); }
    if (__builtin_expect(__all(pmax - m_reg <= THR / SCALE), 1)) { mn = m_reg; alpha = 1.f; }
    else { mn = fmaxf(m_reg, pmax); alpha = __builtin_amdgcn_exp2f((m_reg - mn) * C); m_reg = mn; }
    const float mnC = -mn * C;
#pragma unroll
    for (int r = 0; r < 16; ++r) p0[r] = fmaf(p0[r], C, mnC);
#pragma unroll
    for (int r = 0; r < 16; ++r) p1[r] = fmaf(p1[r], C, mnC);
#pragma unroll
    for (int r = 0; r < 16; ++r) p0[r] = __builtin_amdgcn_exp2f(p0[r]);
}
__device__ __forceinline__ void finishSM(f32x16& p0, f32x16& p1, float alpha, float& l_reg, bf16x8& pa0, bf16x8& pa1, bf16x8& pa2, bf16x8& pa3) {
#pragma unroll
    for (int r = 0; r < 16; ++r) p1[r] = __builtin_amdgcn_exp2f(p1[r]);
    float ps = 0;
#pragma unroll
    for (int r = 0; r < 16; ++r) ps += p0[r];
#pragma unroll
    for (int r = 0; r < 16; ++r) ps += p1[r];
    { auto rr = __builtin_amdgcn_permlane32_swap(__float_as_uint(ps), __float_as_uint(ps), false, false);
      ps = __uint_as_float(rr[0]) + __uint_as_float(rr[1]); }
    l_reg = l_reg * alpha + ps;
#define PK4(P, BASE, OUT) do { unsigned a0 = cvtpk(P[BASE + 0], P[BASE + 1]), a1 = cvtpk(P[BASE + 2], P[BASE + 3]);   \
    unsigned b0 = cvtpk(P[BASE + 4], P[BASE + 5]), b1 = cvtpk(P[BASE + 6], P[BASE + 7]);                              \
    auto r0 = __builtin_amdgcn_permlane32_swap(a0, b0, false, false); auto r1 = __builtin_amdgcn_permlane32_swap(a1, b1, false, false); \
    u32x4 w = {r0[0], r1[0], r0[1], r1[1]}; OUT = *reinterpret_cast<bf16x8*>(&w); } while (0)
    PK4(p0, 0, pa0); PK4(p0, 8, pa1); PK4(p1, 0, pa2); PK4(p1, 8, pa3);
#undef PK4
}
__device__ __forceinline__ void qkt(f32x16& p0, f32x16& p1, const char* Ks, const bf16x8* qr, int r32, int hi) {
    p0 = f32x16{}; p1 = f32x16{};
#pragma unroll
    for (int d0 = 0; d0 < 4; ++d0) {
        const int cb = (d0 * 16 + hi * 8) * 2;
        const bf16x8 b0 = *reinterpret_cast<const bf16x8*>(Ks + KSWZ64(r32, cb));
        const bf16x8 b1 = *reinterpret_cast<const bf16x8*>(Ks + KSWZ64(32 + r32, cb));
        p0 = mfma32(b0, qr[d0], p0);
        p1 = mfma32(b1, qr[d0], p1);
    }
}
__device__ __forceinline__ void maskfill(f32x16& p0, f32x16& p1, bool m) {
#pragma unroll
    for (int r = 0; r < 16; ++r) { p0[r] = m ? -1e30f : p0[r]; p1[r] = m ? -1e30f : p1[r]; }
}
__device__ __forceinline__ int v_st(int k, int c) { const int kk = (k & ~0xC) | ((k & 4) << 1) | ((k & 8) >> 1); return ((kk >> 3) * 4 + (c >> 5)) * 512 + ((kk & 7) * 32 + (c & 31)) * 2; }
__device__ __forceinline__ int v_rd_base(int lane) { return ((lane & 3) << 3) | (((lane >> 2) & 3) << 6) | (((lane >> 4) & 1) << 5) | (((lane >> 5) & 1) << 8); }
constexpr int v_rd_off(int d0, int ks, int half) { return d0 * 512 + ks * 4096 + half * 2048; }
template <int OFF> __device__ __forceinline__ s16x4 tr_read(int vb) {
    s16x4 r; asm volatile("ds_read_b64_tr_b16 %0, %1 offset:%2" : "=&v"(r) : "v"(vb), "i"(OFF) : "memory"); return r;
}
template <int D0> __device__ __forceinline__ void pv_one(f32x16& od, int vb, bf16x8 pa0, bf16x8 pa1, bf16x8 pa2, bf16x8 pa3) {
    const s16x4 l0 = tr_read<v_rd_off(D0, 0, 0)>(vb), h0 = tr_read<v_rd_off(D0, 0, 1)>(vb), l1 = tr_read<v_rd_off(D0, 1, 0)>(vb), h1 = tr_read<v_rd_off(D0, 1, 1)>(vb);
    const s16x4 l2 = tr_read<v_rd_off(D0, 2, 0)>(vb), h2 = tr_read<v_rd_off(D0, 2, 1)>(vb), l3 = tr_read<v_rd_off(D0, 3, 0)>(vb), h3 = tr_read<v_rd_off(D0, 3, 1)>(vb);
    asm volatile("s_waitcnt lgkmcnt(0)" ::: "memory"); SBAR();
#define PKV(L, H) (bf16x8){L[0], L[1], L[2], L[3], H[0], H[1], H[2], H[3]}
    od = mfma32(pa0, PKV(l0, h0), od);
    od = mfma32(pa1, PKV(l1, h1), od);
    od = mfma32(pa2, PKV(l2, h2), od);
    od = mfma32(pa3, PKV(l3, h3), od);
#undef PKV
}
__device__ __forceinline__ void pv_d0(f32x16* o, int vb, bf16x8 pa0, bf16x8 pa1, bf16x8 pa2, bf16x8 pa3) {
    pv_one<0>(o[0], vb, pa0, pa1, pa2, pa3); pv_one<1>(o[1], vb, pa0, pa1, pa2, pa3); pv_one<2>(o[2], vb, pa0, pa1, pa2, pa3); pv_one<3>(o[3], vb, pa0, pa1, pa2, pa3);
}

__device__ __forceinline__ void attn_pass(const bf16_t* __restrict__ Qb, const bf16_t* __restrict__ Kh, const bf16_t* __restrict__ Vh, int NT, int my_last, char* lds, f32x16 (&o)[4]) {
    const int tid = threadIdx.x, wid = tid >> 6, lane = tid & 63, r32 = lane & 31, hi = lane >> 5;
    char* V_lds = lds + LDS_V; char* K_lds = lds + LDS_K;
    float* wsf = (float*)(lds + LDS_WS) + wid * 64; float* li_l = wsf; float* al_l = wsf + 32;
    float m_reg = -1e30f, l_reg = 0.f;
#pragma unroll
    for (int d = 0; d < 4; ++d) o[d] = f32x16{};
    bf16x8 qr[4];
    const bf16_t* Qw = Qb + (size_t)(wid * QBLK + r32) * NIN + hi * 8;
#pragma unroll
    for (int d0 = 0; d0 < 4; ++d0) qr[d0] = *reinterpret_cast<const bf16x8*>(Qw + d0 * 16);
    const int sr = tid >> 4, sc = (tid & 15) * 8, vst0 = v_st(sr, sc), vst1 = v_st(32 + sr, sc);
    const int krow = tid >> 3, kc8 = (tid & 7) * 8, kst = KSWZ64(krow, kc8 * 2);
    const int vb0 = (int)(uintptr_t)V_lds + v_rd_base(lane);
    struct { bf16x8 vs0, vs1, ks; } sr_[2];
#define SLOAD(i, k0) do { sr_[i].vs0 = *reinterpret_cast<const bf16x8*>(&Vh[(size_t)((k0) + sr) * NIN + sc]); sr_[i].vs1 = *reinterpret_cast<const bf16x8*>(&Vh[(size_t)((k0) + 32 + sr) * NIN + sc]); \
    sr_[i].ks = *reinterpret_cast<const bf16x8*>(&Kh[(size_t)((k0) + krow) * NIN + kc8]); } while (0)
#define SWRITE(b, i) do { *(bf16x8*)(V_lds + (b) * SHM_V + vst0) = sr_[i].vs0; *(bf16x8*)(V_lds + (b) * SHM_V + vst1) = sr_[i].vs1; \
    *(bf16x8*)(K_lds + (b) * SHM_K + kst) = sr_[i].ks; } while (0)
#define SWAIT() asm volatile("s_waitcnt vmcnt(3)" ::: "memory")
#define RESC(a) do { if (__any((a) < 1.f)) { if (hi == 0) al_l[r32] = (a); asm volatile("s_waitcnt lgkmcnt(0)" ::: "memory"); \
    _Pragma("unroll") for (int d = 0; d < 4; ++d) _Pragma("unroll") for (int r = 0; r < 16; ++r) o[d][r] *= al_l[crow(r, hi)]; } } while (0)
    f32x16 pA0, pA1, pB0, pB1; float mnA, mnB, alA, alB; bf16x8 pa0, pa1, pa2, pa3;
    constexpr int SE = 0, SO = 1;
    __syncthreads();
    SLOAD(SE, 0); asm volatile("s_waitcnt vmcnt(0)" ::: "memory"); SWRITE(0, SE); __syncthreads();
    qkt(pA0, pA1, K_lds, qr, r32, hi); partialSM(pA0, pA1, m_reg, mnA, alA);
    SLOAD(SO, KVBLK); if (2 < NT) SLOAD(SE, 2 * KVBLK);
    SWAIT(); SWRITE(1, SO); __syncthreads();
    for (int j = 1; j + 1 < NT; j += 2) {
        SBAR(); qkt(pB0, pB1, K_lds + SHM_K, qr, r32, hi); maskfill(pB0, pB1, j > my_last);
        finishSM(pA0, pA1, alA, l_reg, pa0, pa1, pa2, pa3); SBAR();
        SLOAD(SO, (j + 2) * KVBLK); SBAR();
        pv_d0(o, vb0, pa0, pa1, pa2, pa3); partialSM(pB0, pB1, m_reg, mnB, alB);
        __syncthreads(); SWAIT(); SWRITE(0, SE);
        RESC(alB); __syncthreads();
        SBAR(); qkt(pA0, pA1, K_lds, qr, r32, hi); maskfill(pA0, pA1, j + 1 > my_last);
        finishSM(pB0, pB1, alB, l_reg, pa0, pa1, pa2, pa3); SBAR();
        if (j + 3 < NT) SLOAD(SE, (j + 3) * KVBLK); SBAR();
        pv_d0(o, vb0 + SHM_V, pa0, pa1, pa2, pa3); partialSM(pA0, pA1, m_reg, mnA, alA);
        __syncthreads(); SWAIT(); SWRITE(1, SO);
        RESC(alA); __syncthreads();
    }
    SBAR(); qkt(pB0, pB1, K_lds + SHM_K, qr, r32, hi); maskfill(pB0, pB1, NT - 1 > my_last);
    finishSM(pA0, pA1, alA, l_reg, pa0, pa1, pa2, pa3); SBAR();
    pv_d0(o, vb0, pa0, pa1, pa2, pa3); partialSM(pB0, pB1, m_reg, mnB, alB);
    __syncthreads(); RESC(alB);
    finishSM(pB0, pB1, alB, l_reg, pa0, pa1, pa2, pa3); SBAR();
    pv_d0(o, vb0 + SHM_V, pa0, pa1, pa2, pa3);
    if (hi == 0) li_l[r32] = l_reg;
    asm volatile("s_waitcnt lgkmcnt(0)" ::: "memory");
#pragma unroll
    for (int r = 0; r < 16; ++r) {
        const float rl = __builtin_amdgcn_rcpf(li_l[crow(r, hi)]);
#pragma unroll
        for (int d = 0; d < 4; ++d) o[d][r] *= rl;
    }
    asm volatile("s_waitcnt vmcnt(0)" ::: "memory");
    __syncthreads();
#undef SLOAD
#undef SWRITE
#undef SWAIT
#undef RESC
}
}

__device__ __forceinline__ void p3_attn_unit(const Params& p, Ctx& F, int b, int h, int qb, float* oscr) {
    const bf16_t* proj = (const bf16_t*)(p.ws + WS_PROJ);
    bf16_t* ycat = (bf16_t*)(p.ws + WS_YCAT);
    const float lam = ((const float*)(p.ws + WS_MISC))[0];
    const float* subw = p.in[15];
    const int tid = F.tid, wid = F.wave, lane = F.lane, r32 = lane & 31, hi = lane >> 5;
    const size_t rowbase = (size_t)b * SEQ; const int q0 = qb * 256;
    const int NT = (q0 + 256) / 64, my_last = (q0 + 32 * wid) / 64;
    f32x16 o[4];
    for (int j = 0; j < 2; ++j) {
        const bf16_t* Qb = proj + (rowbase + q0) * NIN + PQ + h * 128 + j * 64;
        const bf16_t* Kh = proj + rowbase * NIN + PK + h * 128 + j * 64;
        const bf16_t* Vh = proj + rowbase * NIN + PV + h * 128;
        att::attn_pass(Qb, Kh, Vh, NT, my_last, (char*)F.lds, o);
        if (j == 0) {
            float* my = oscr + tid * 64;
#pragma unroll
            for (int d = 0; d < 4; ++d)
#pragma unroll
                for (int r4 = 0; r4 < 4; ++r4) *(f32x4*)(my + d * 16 + r4 * 4) = (f32x4){o[d][4 * r4], o[d][4 * r4 + 1], o[d][4 * r4 + 2], o[d][4 * r4 + 3]};
        }
    }
    float wv[4];
#pragma unroll
    for (int d = 0; d < 4; ++d) wv[d] = subw[d * 32 + r32] * (1.f - LAMBDA_INIT);
#pragma unroll
    for (int r = 0; r < 16; ++r) {
        float v[4]; float ss = 0.f;
#pragma unroll
        for (int d = 0; d < 4; ++d) { v[d] = oscr[tid * 64 + d * 16 + r] - lam * o[d][r]; ss += v[d] * v[d]; }
        ss += __shfl_xor(ss, 1); ss += __shfl_xor(ss, 2); ss += __shfl_xor(ss, 4); ss += __shfl_xor(ss, 8); ss += __shfl_xor(ss, 16);
        const float rs = rsqrtf(ss * (1.f / 128.f) + EPSN);
        const size_t row = rowbase + q0 + wid * 32 + att::crow(r, hi);
#pragma unroll
        for (int d = 0; d < 4; ++d) ycat[row * DM + 512 + h * 128 + d * 32 + r32] = (bf16_t)f2bf(v[d] * rs * wv[d]);
    }
}

__device__ __forceinline__ void phase3(const Params& p, Ctx& F) {
#ifndef NO_SCAN
    p3_scan(p, F);
#endif
    float* oscr = p.out + (size_t)F.vcu * (64 * 512);
    for (int ui = F.vcu; ui < 512; ui += F.G) {
        const int pi = ui & 255, bh = pi >> 3, s = pi & 7, b = bh >> 2, h = bh & 3;
        p3_attn_unit(p, F, b, h, ui < 256 ? 15 - s : s, oscr);
    }
}

constexpr int P4_PREV = 0, P4_CM = 69632, P4_ACS = 87040, P4_Y = 88064, Y_LD = 257;
static_assert(P4_Y + 64 * Y_LD * 4 <= LDS_BYTES, "P4 LDS");
__device__ __forceinline__ void p4_unit(const Params& p, Ctx& F, int b, int c, int g) {
    unsigned char* ws = p.ws;
    const bf16_t* proj = (const bf16_t*)(ws + WS_PROJ);
    bf16_t* ycat = (bf16_t*)(ws + WS_YCAT); const bf16_t* cmc = (const bf16_t*)(ws + WS_CMC);
    const float* states = (const float*)(ws + WS_STATES); const float* acs_g = (const float*)(ws + WS_ACS);
    const float* normw = p.in[8];
    LAS bf16_t* PREV = (LAS bf16_t*)(F.lds + P4_PREV); LAS bf16_t* CM = (LAS bf16_t*)(F.lds + P4_CM);
    LAS float* ACS = (LAS float*)(F.lds + P4_ACS); LAS float* Y = (LAS float*)(F.lds + P4_Y);
    const int tid = F.tid, lane = F.lane, wave = F.wave, fr = lane & 15, fq = lane >> 4;
    const size_t tbase = (size_t)b * SEQ + (size_t)c * CHUNK;
    for (int i = 0; i < 16; ++i) {
        const int e = tid + 512 * i, n4 = e & 31, pp = (e >> 5) & 63, h = e >> 11;
        const f32x4 v = *(const f32x4*)(states + ((((size_t)b * NCH + c) * 8 + g * 4 + h) * 64 + pp) * 128 + n4 * 4);
        u32x2 w; w.x = pk2(v[0], v[1]); w.y = pk2(v[2], v[3]);
        *(LAS u32x2*)(PREV + (h * 64 + pp) * BM_LD + n4 * 4) = w;
    }
    for (int i = 0; i < 2; ++i) {
        const int e = tid + 512 * i, l = e >> 4, c8 = e & 15;
        *(LAS u32x4*)(CM + l * BM_LD + c8 * 8) = *(const u32x4*)(cmc + (tbase + l) * 256 + g * 128 + c8 * 8);
    }
    if (tid < 256) { const int l = tid >> 2, h = tid & 3; ACS[l * 4 + h] = acs_g[(tbase + l) * 8 + g * 4 + h]; }
    __syncthreads();
    {
        const int h = wave >> 1;
#pragma unroll
        for (int mq = 0; mq < 2; ++mq) {
            const int mt = 2 * (wave & 1) + mq;
            bf16x8 a[4];
#pragma unroll
            for (int ks = 0; ks < 4; ++ks) a[ks] = *(const LAS bf16x8*)(CM + (mt * 16 + fr) * BM_LD + ks * 32 + fq * 8);
#pragma unroll
            for (int nt = 0; nt < 4; ++nt) {
                f32x4 acc = {0.f, 0.f, 0.f, 0.f};
#pragma unroll
                for (int ks = 0; ks < 4; ++ks) {
                    const bf16x8 bq = *(const LAS bf16x8*)(PREV + (h * 64 + nt * 16 + fr) * BM_LD + ks * 32 + fq * 8);
                    acc = mfma16(a[ks], bq, acc);
                }
#pragma unroll
                for (int j = 0; j < 4; ++j) {
                    const int l = mt * 16 + 4 * fq + j, col = h * 64 + nt * 16 + fr;
                    const size_t t = tbase + l;
                    const float yo = acc[j] * __expf(ACS[l * 4 + h]);
                    const float yl = bf2f(ycat[t * DM + g * 256 + col]);
                    const float z = bf2f(proj[t * NIN + PZ + g * 256 + col]);
                    Y[l * Y_LD + col] = (yl + yo) * silu_f(z);
                }
            }
        }
    }
    __syncthreads();
    for (int r = 0; r < 8; ++r) {
        const int l = wave * 8 + r;
        float v[4]; float ss = 0.f;
#pragma unroll
        for (int e = 0; e < 4; ++e) { v[e] = Y[l * Y_LD + 4 * lane + e]; ss += v[e] * v[e]; }
        const float rs = rsqrtf(wave_sum(ss) * (1.f / 256.f) + EPSN);
        const f32x4 nw = *(const f32x4*)(normw + g * 256 + 4 * lane);
        u32x2 w; w.x = pk2(v[0] * rs * nw[0], v[1] * rs * nw[1]); w.y = pk2(v[2] * rs * nw[2], v[3] * rs * nw[3]);
        *(u32x2*)(ycat + (tbase + l) * DM + g * 256 + 4 * lane) = w;
    }
    __syncthreads();
}
__device__ __forceinline__ void phase4(const Params& p, Ctx& F) {
    for (int u = F.vcu; u < NB * NCH * 2; u += F.G) {
        const int g = u & 1, c = (u >> 1) & 63, b = u >> 7;
        p4_unit(p, F, b, c, g);
    }
}

__device__ __forceinline__ unsigned f2ord(float f) { const unsigned u = __float_as_uint(f); return (u >> 31) ? ~u : (u | 0x80000000u); }
__device__ __forceinline__ float ord2f(unsigned u) { return __uint_as_float((u >> 31) ? (u & 0x7fffffffu) : ~u); }
#define TOPK_INSERT(R, X) do { unsigned x_ = (X); _Pragma("unroll") for (int k_ = 0; k_ < 16; ++k_) { const unsigned hi_ = R[k_] > x_ ? R[k_] : x_; x_ = R[k_] > x_ ? x_ : R[k_]; R[k_] = hi_; } } while (0)

__device__ __forceinline__ void phase7(const Params& p, Ctx& F) {
    unsigned char* ws = p.ws;
    const bf16_t* qp = (const bf16_t*)(ws + WS_QP); const bf16_t* keys = (const bf16_t*)(ws + WS_KEYS);
    const float* rowsq = (const float*)(ws + WS_CTL) + CW_ROWSQ;
    int* idxo = (int*)(ws + WS_IDX); float* gwo = (float*)(ws + WS_GW);
    LAS unsigned* scr = (LAS unsigned*)(F.lds + F.wave * 18560);
    LAS unsigned* lists = scr + 32 * 129;
    const int lane = F.lane, fr = lane & 15, fq = lane >> 4;
    for (int task = F.gw; task < (TOK / 16) * 8; task += F.ngw) {
        const int tg = task >> 3, h = task & 7; const size_t t0 = (size_t)tg * 16;
        float r2[4];
#pragma unroll
        for (int jj = 0; jj < 4; ++jj) r2[jj] = rsqrtf(rowsq[t0 + 4 * fq + jj] * (1.f / DM) + EPSN);
#pragma unroll
        for (int j = 0; j < 2; ++j) {
            bf16x8 a[4];
#pragma unroll
            for (int ks = 0; ks < 4; ++ks) a[ks] = *(const bf16x8*)(qp + (t0 + fr) * 2048 + h * 256 + j * 128 + ks * 32 + fq * 8);
#pragma unroll
            for (int nt = 0; nt < 8; ++nt) {
                f32x4 acc = {0.f, 0.f, 0.f, 0.f};
#pragma unroll
                for (int ks = 0; ks < 4; ++ks) {
                    const bf16x8 bq = *(const bf16x8*)(keys + ((size_t)(h * 2 + j) * 128 + nt * 16 + fr) * 128 + ks * 32 + fq * 8);
                    acc = mfma16(a[ks], bq, acc);
                }
#pragma unroll
                for (int jj = 0; jj < 4; ++jj) {
                    const unsigned key = (f2ord(acc[jj] * r2[jj]) & ~127u) | (unsigned)(nt * 16 + fr);
                    scr[((4 * fq + jj) * 2 + j) * 129 + nt * 16 + fr] = key;
                }
            }
        }
        LDS_WAIT(); __builtin_amdgcn_wave_barrier();
        if (lane < 32) {
            unsigned r[16];
#pragma unroll
            for (int k = 0; k < 16; ++k) r[k] = 0u;
#pragma unroll 4
            for (int i = 0; i < 128; ++i) { const unsigned x = scr[lane * 129 + i]; TOPK_INSERT(r, x); }
#pragma unroll
            for (int k = 0; k < 16; ++k) lists[lane * 16 + k] = r[k];
        }
        LDS_WAIT(); __builtin_amdgcn_wave_barrier();
        if (lane < 16) {
            float f0[16], f1[16];
#pragma unroll
            for (int k = 0; k < 16; ++k) { f0[k] = ord2f(lists[(2 * lane) * 16 + k] & ~127u); f1[k] = ord2f(lists[(2 * lane + 1) * 16 + k] & ~127u); }
            unsigned r[16];
#pragma unroll
            for (int k = 0; k < 16; ++k) r[k] = 0u;
#pragma unroll
            for (int a = 0; a < 16; ++a)
#pragma unroll
                for (int bb = 0; bb < 16; ++bb)
                    if ((a + 1) * (bb + 1) <= 16) { const unsigned key = (f2ord(f0[a] + f1[bb]) & ~255u) | (unsigned)(a * 16 + bb); TOPK_INSERT(r, key); }
            float val[16]; int ex[16]; float mx = -1e30f;
#pragma unroll
            for (int k = 0; k < 16; ++k) {
                const unsigned pos = r[k] & 255u, a = pos >> 4, bb = pos & 15u;
                const unsigned w0 = lists[(2 * lane) * 16 + a], w1 = lists[(2 * lane + 1) * 16 + bb];
                ex[k] = (int)((w0 & 127u) * 128u + (w1 & 127u));
                val[k] = ord2f(w0 & ~127u) + ord2f(w1 & ~127u);
                mx = fmaxf(mx, val[k]);
            }
            float sum = 0.f;
#pragma unroll
            for (int k = 0; k < 16; ++k) { val[k] = __expf(val[k] - mx); sum += val[k]; }
            const float inv = 1.f / sum;
            int* io = idxo + ((t0 + lane) * 8 + h) * 16; float* go = gwo + ((t0 + lane) * 8 + h) * 16;
#pragma unroll
            for (int k = 0; k < 16; ++k) { io[k] = ex[k]; go[k] = val[k] * inv; }
        }
        LDS_WAIT(); __builtin_amdgcn_wave_barrier();
    }
}

__device__ __forceinline__ float gelu_erf(float x) { return 0.5f * x * (1.f + erff(x * 0.70710678118654752f)); }
__device__ __forceinline__ void phase8(const Params& p, Ctx& F) {
    unsigned char* ws = p.ws;
    const bf16_t* ub = (const bf16_t*)(ws + WS_UB); const bf16_t* vb = (const bf16_t*)(ws + WS_VB);
    const float* rowsq = (const float*)(ws + WS_CTL) + CW_ROWSQ;
    const int* idxi = (const int*)(ws + WS_IDX); const float* gwi = (const float*)(ws + WS_GW);
    const float* w2 = p.in[17];
    float* out = p.out;
    const int lane = F.lane;
    float w2v[16];
#pragma unroll
    for (int e = 0; e < 8; ++e) { w2v[e] = w2[8 * lane + e]; w2v[8 + e] = w2[512 + 8 * lane + e]; }
    for (int t = F.gw; t < TOK; t += F.ngw) {
        const float r2 = rsqrtf(rowsq[t] * (1.f / DM) + EPSN);
        float x1[16], xn[16], acc[16];
        {
            const float* xr = out + (size_t)t * DM;
            const f32x4 a = *(const f32x4*)(xr + 8 * lane), b = *(const f32x4*)(xr + 8 * lane + 4), c = *(const f32x4*)(xr + 512 + 8 * lane), d = *(const f32x4*)(xr + 512 + 8 * lane + 4);
#pragma unroll
            for (int e = 0; e < 4; ++e) { x1[e] = a[e]; x1[4 + e] = b[e]; x1[8 + e] = c[e]; x1[12 + e] = d[e]; }
        }
#pragma unroll
        for (int e = 0; e < 16; ++e) { xn[e] = x1[e] * r2 * w2v[e]; acc[e] = 0.f; }
        const int idA = idxi[(size_t)t * 128 + lane], idB = idxi[(size_t)t * 128 + 64 + lane];
        const float gA = gwi[(size_t)t * 128 + lane], gB = gwi[(size_t)t * 128 + 64 + lane];
        for (int i0 = 0; i0 < 128; i0 += 4) {
            u32x4 uu[4][2], vv[4][2]; float gg[4];
#pragma unroll
            for (int q = 0; q < 4; ++q) {
                const int i = i0 + q;
                const int e = __shfl(i0 < 64 ? idA : idB, i & 63);
                gg[q] = __shfl(i0 < 64 ? gA : gB, i & 63);
                const bf16_t* ur = ub + (size_t)e * DM; const bf16_t* vr = vb + (size_t)e * DM;
                uu[q][0] = *(const u32x4*)(ur + 8 * lane); uu[q][1] = *(const u32x4*)(ur + 512 + 8 * lane);
                vv[q][0] = *(const u32x4*)(vr + 8 * lane); vv[q][1] = *(const u32x4*)(vr + 512 + 8 * lane);
            }
#pragma unroll
            for (int q = 0; q < 4; ++q) {
                float dot = 0.f;
#pragma unroll
                for (int hf = 0; hf < 2; ++hf)
#pragma unroll
                    for (int e = 0; e < 4; ++e) {
                        const unsigned w = uu[q][hf][e];
                        dot += xn[hf * 8 + 2 * e] * bf2f(w & 0xffffu) + xn[hf * 8 + 2 * e + 1] * bf2f(w >> 16);
                    }
                dot = wave_sum(dot);
                const float coef = gg[q] * gelu_erf(dot);
#pragma unroll
                for (int hf = 0; hf < 2; ++hf)
#pragma unroll
                    for (int e = 0; e < 4; ++e) {
                        const unsigned w = vv[q][hf][e];
                        acc[hf * 8 + 2 * e] += coef * bf2f(w & 0xffffu);
                        acc[hf * 8 + 2 * e + 1] += coef * bf2f(w >> 16);
                    }
            }
        }
        float* orow = out + (size_t)t * DM;
        f32x4 a, b, c, d;
#pragma unroll
        for (int e = 0; e < 4; ++e) { a[e] = x1[e] + acc[e]; b[e] = x1[4 + e] + acc[4 + e]; c[e] = x1[8 + e] + acc[8 + e]; d[e] = x1[12 + e] + acc[12 + e]; }
        *(f32x4*)(orow + 8 * lane) = a; *(f32x4*)(orow + 8 * lane + 4) = b; *(f32x4*)(orow + 512 + 8 * lane) = c; *(f32x4*)(orow + 512 + 8 * lane + 4) = d;
    }
}

constexpr int NPHASE = 9;
#ifndef N_LAUNCHES
#define N_LAUNCHES 1
#endif
constexpr int MISC_OFF = LDS_BYTES - 128;
__global__ void __launch_bounds__(512, 2) fwd_kernel(Params p) {
    extern __shared__ __attribute__((aligned(16))) unsigned char lds_raw[];
    Ctx F;
    F.lds = (LAS unsigned char*)lds_raw;
    F.tid = threadIdx.x; F.lane = F.tid & 63; F.wave = __builtin_amdgcn_readfirstlane(F.tid >> 6);
    F.G = gridDim.x; { const int bx = blockIdx.x; F.vcu = (F.G % 8 == 0) ? (bx % 8) * (F.G / 8) + bx / 8 : bx; }
    F.gw = F.vcu * 8 + F.wave; F.ngw = F.G * 8;
    unsigned char* ws = p.ws;
    const int lo = p.ph_lo, hi = p.ph_hi;
    volatile LAS unsigned* MISC = (volatile LAS unsigned*)(F.lds + MISC_OFF);
    if (F.tid < 32) MISC[F.tid] = 0u;
    __syncthreads();
    XcdBarrier bar = xcd_barrier_post((unsigned*)(ws + WS_CTL) + CW_BAR, MISC + 8);
#ifdef ONLY_PHASE
#define IN(k) ((k)==ONLY_PHASE)
#else
#define IN(k) (lo <= (k) && (k) < hi)
#endif
#define SEAM(k) do { if (IN(k) && IN((k) + 1)) xcd_barrier(bar); } while (0)
    if (IN(0)) phase0(p, F);
    SEAM(0);
    if (IN(1)) {
        pg8::Gemm g{(const pg8::bf16_t*)(ws + WS_XB), (const pg8::bf16_t*)(ws + WS_WINT), TOK, NIN, DM};
        pg8::StaticOrder S; S.init(TOK, NIN, F.G, (int)blockIdx.x);
        pg8::EpiBf16<0> E{(pg8::bf16_t*)(ws + WS_PROJ), NIN, nullptr, 0, 0, 1.f};
        pg8::gemm_phase<pg8::EpiBf16<0>, pg8::StaticOrder, true, true>(F.lds, g, S, E);
    }
    SEAM(1);
    if (IN(2)) phase2(p, F);
    SEAM(2);
    if (IN(3)) phase3(p, F);
    SEAM(3);
    if (IN(4)) phase4(p, F);
    SEAM(4);
    if (IN(5)) {
        pg8::Gemm g{(const pg8::bf16_t*)(ws + WS_YCAT), (const pg8::bf16_t*)(ws + WS_WOUTT), TOK, DM, DM};
        pg8::StaticOrder S; S.init(TOK, DM, F.G, (int)blockIdx.x);
        pg8::EpiResid E{p.in[0], p.out, (pg8::bf16_t*)(ws + WS_X1B), (float*)(ws + WS_CTL) + CW_ROWSQ, DM};
        pg8::gemm_phase<pg8::EpiResid, pg8::StaticOrder, true, true>(F.lds, g, S, E);
    }
    SEAM(5);
    if (IN(6)) {
        pg8::Gemm g{(const pg8::bf16_t*)(ws + WS_X1B), (const pg8::bf16_t*)(ws + WS_WQT), TOK, 2048, DM};
        pg8::StaticOrder S; S.init(TOK, 2048, F.G, (int)blockIdx.x);
        pg8::EpiBf16<0> E{(pg8::bf16_t*)(ws + WS_QP), 2048, nullptr, 0, 0, 1.f};
        pg8::gemm_phase<pg8::EpiBf16<0>, pg8::StaticOrder, true, true>(F.lds, g, S, E);
    }
    SEAM(6);
    if (IN(7)) phase7(p, F);
    SEAM(7);
    if (IN(8)) phase8(p, F);
#undef IN
#undef SEAM
}

extern "C" void kernel_launch(void* const* d_in, const int* in_sizes, int n_in, void* d_out, int out_size, void* d_ws, size_t ws_size, hipStream_t stream) {
    static int grid = 0;
    if (grid == 0) {
        if (n_in != 22 || in_sizes[0] != TOK * DM || out_size != TOK * DM || ws_size < WS_END) {
            fprintf(stderr, "kernel_launch: unexpected shapes: n_in %d in0 %d out %d ws %zu\n", n_in, n_in > 0 ? in_sizes[0] : -1, out_size, ws_size); grid = -1; return; }
        if (hipFuncSetAttribute((const void*)fwd_kernel, hipFuncAttributeMaxDynamicSharedMemorySize, LDS_BYTES) != hipSuccess) { fprintf(stderr, "kernel_launch: hipFuncSetAttribute failed\n"); grid = -1; return; }
        int dev = 0, cus = 0, per_cu = 0;
        if (hipGetDevice(&dev) != hipSuccess || hipDeviceGetAttribute(&cus, hipDeviceAttributeMultiprocessorCount, dev) != hipSuccess) { grid = -1; return; }
        if (hipOccupancyMaxActiveBlocksPerMultiprocessor(&per_cu, (const void*)fwd_kernel, 512, LDS_BYTES) != hipSuccess || per_cu < 1) { fprintf(stderr, "kernel_launch: occupancy query failed (%d)\n", per_cu); (void)hipGetLastError(); per_cu = 1; }
        grid = cus * (per_cu > 1 ? 1 : per_cu);
    }
    if (grid < 0) return;
    (void)hipMemsetAsync((char*)d_ws + WS_CTL, 0, CTL_BYTES, stream);
    Params a{};
    for (int i = 0; i < 22; ++i) a.in[i] = (const float*)d_in[i];
    a.out = (float*)d_out; a.ws = (unsigned char*)d_ws;
#if N_LAUNCHES == 1
    a.ph_lo = 0; a.ph_hi = NPHASE;
    { void* args[] = {&a};
      hipError_t e = hipLaunchCooperativeKernel((const void*)fwd_kernel, dim3(grid), dim3(512), args, LDS_BYTES, stream);
      if (e != hipSuccess) fprintf(stderr, "kernel_launch: cooperative launch failed: %s (grid %d)\n", hipGetErrorString(e), grid); }
#else
    for (int ph = 0; ph < NPHASE; ++ph) {
        a.ph_lo = ph; a.ph_hi = ph + 1;
        hipLaunchKernelGGL(fwd_kernel, dim3(grid), dim3(512), LDS_BYTES, stream, a);
    }
#endif
    const hipError_t le = hipPeekAtLastError();
    if (le != hipSuccess) fprintf(stderr, "kernel_launch: launch failed: %s\n", hipGetErrorName(le));
}
```

```cpp
#include <hip/hip_runtime.h>
#include <hip/hip_cooperative_groups.h>
#include <cstdio>
#include <cstdint>
#define USE_COOP_LAUNCH 1
#define U_FP4 1
#define V_FP4 1

#define LAS __attribute__((address_space(3)))
#define GAS __attribute__((address_space(1)))
typedef unsigned short bf16_t;
typedef short bf16x8 __attribute__((ext_vector_type(8)));
typedef short s16x4 __attribute__((ext_vector_type(4)));
typedef float f32x4 __attribute__((ext_vector_type(4)));
typedef float f32x8 __attribute__((ext_vector_type(8)));
typedef float f32x16 __attribute__((ext_vector_type(16)));
typedef unsigned u32x4 __attribute__((ext_vector_type(4)));
typedef unsigned u32x2 __attribute__((ext_vector_type(2)));

constexpr int NB = 8, SEQ = 4096, TOK = NB * SEQ, DM = 1024;
constexpr int NIN = 3072;
constexpr int PZ = 0, PXS = 512, PBM = 1024, PCM = 1280, PQ = 1536, PK = 2048, PV = 2560;
constexpr int CHUNK = 64, NCH = SEQ / CHUNK;
constexpr int NHS = 8;
constexpr float EPSN = 1e-6f;
constexpr int PEER_H = 8, NKEYS = 128, TOPK = 16;
constexpr float LAMBDA_INIT = 0.2f;

constexpr size_t MiB = 1u << 20;
constexpr size_t WS_CTL = 0, CTL_BYTES = 1 * MiB;
constexpr size_t WS_WINT = 1 * MiB;
constexpr size_t WS_WOUTT = 7 * MiB;
constexpr size_t WS_WQT = 9 * MiB;
constexpr size_t WS_KEYS = 13 * MiB;
constexpr size_t WS_ROPE = 13 * MiB + 512 * 1024;
constexpr size_t WS_MISC = 13 * MiB + 768 * 1024;
constexpr size_t WS_RSU = WS_MISC + 64 * 1024;
constexpr size_t WS_RSV = WS_MISC + 128 * 1024;
constexpr size_t WS_DTRAW = 14 * MiB;
constexpr size_t WS_ACS = 15 * MiB;
constexpr size_t WS_CDEC = 16 * MiB;
constexpr size_t WS_UB = 20 * MiB;
constexpr size_t WS_VB = 52 * MiB;
constexpr size_t WS_XB = 84 * MiB;
constexpr size_t WS_YCAT = WS_XB;
constexpr size_t WS_PROJ = 148 * MiB;
constexpr size_t WS_QP = WS_PROJ;
constexpr size_t WS_IDX = 276 * MiB;
constexpr size_t WS_GW = 292 * MiB;
constexpr size_t WS_CMC = 340 * MiB;
constexpr size_t WS_STATES = 356 * MiB;
constexpr size_t WS_X1B = WS_STATES;
constexpr size_t WS_END = 484 * MiB;
constexpr int CW_BAR = 4096;
constexpr int CW_ROWSQ = 131072;
static_assert((CW_ROWSQ + TOK) * 4 <= (int)CTL_BYTES, "ctl");

constexpr int LDS_BYTES = 163840;

__device__ __forceinline__ float bf2f(unsigned h) { return __uint_as_float(h << 16); }
__device__ __forceinline__ unsigned f2bf(float f) { unsigned u = __float_as_uint(f); return (u + 0x7fffu + ((u >> 16) & 1u)) >> 16; }
__device__ __forceinline__ unsigned pk2(float lo, float hi) { return f2bf(lo) | (f2bf(hi) << 16); }
__device__ __forceinline__ float wave_sum(float v) {
#pragma unroll
    for (int o = 1; o < 64; o <<= 1) v += __shfl_xor(v, o);
    return v;
}
__device__ __forceinline__ float wave_max(float v) {
#pragma unroll
    for (int o = 1; o < 64; o <<= 1) v = fmaxf(v, __shfl_xor(v, o));
    return v;
}
__device__ __forceinline__ float silu_f(float x) { return x / (1.f + __expf(-x)); }
__device__ __forceinline__ f32x4 mfma16(bf16x8 a, bf16x8 b, f32x4 c) { return __builtin_amdgcn_mfma_f32_16x16x32_bf16(a, b, c, 0, 0, 0); }
__device__ __forceinline__ f32x16 mfma32(bf16x8 a, bf16x8 b, f32x16 c) { return __builtin_amdgcn_mfma_f32_32x32x16_bf16(a, b, c, 0, 0, 0); }
#define LDS_WAIT() asm volatile("s_waitcnt lgkmcnt(0)" ::: "memory")
#define VM_WAIT() asm volatile("s_waitcnt vmcnt(0)" ::: "memory")

#define XB_TMO      128
#define XB_XCNT(j)  (256  + 64 * (j))
#define XB_XSUB(j)  (1280 + 64 * (j))
#define XB_XGEN(j)  (2304 + 64 * (j))
#define XB_TOP      3328
#define XB_TOPGEN   3392
#define XCD_BAR_WORDS 3456
#define XB_SPIN_CAP (1u << 21)

__device__ __forceinline__ unsigned xb_ld(unsigned* p)              { return __hip_atomic_load(p, __ATOMIC_RELAXED, __HIP_MEMORY_SCOPE_AGENT); }
__device__ __forceinline__ unsigned xb_add(unsigned* p, unsigned v) { return __hip_atomic_fetch_add(p, v, __ATOMIC_RELAXED, __HIP_MEMORY_SCOPE_AGENT); }
__device__ __forceinline__ unsigned xb_xcc_id() { return (unsigned)__builtin_amdgcn_s_getreg((3 << 11) | 20) & 0xFu; }
#define XB_SPIN(cond, bar) do { unsigned _sp = 0; while (cond) { __builtin_amdgcn_s_sleep(1); \
    if ((++_sp & 255u) == 0u) { if (xb_ld(&(bar)[XB_TMO])) break; if (_sp > XB_SPIN_CAP) { atomicAdd(&(bar)[XB_TMO], 1u); break; } } } } while (0)

struct XcdBarrier {
    unsigned* bar; unsigned x;
    volatile LAS unsigned* st;
};

__device__ __forceinline__ XcdBarrier xcd_barrier_post(unsigned* bar, volatile LAS unsigned* st) {
    XcdBarrier b; b.bar = bar; b.x = xb_xcc_id(); b.st = st;
    if (threadIdx.x == 0) (void)xb_add(&bar[XB_XCNT(b.x)], 1u);
    return b;
}
__device__ __forceinline__ void xcd_barrier_complete(unsigned* bar, unsigned x, unsigned& nloc, unsigned& nx) {
    const unsigned G = gridDim.x * gridDim.y * gridDim.z;
    unsigned sum, cnt, mine, sp = 0u;
    for (;;) {
        sum = 0u; cnt = 0u; mine = 0u;
#pragma unroll
        for (unsigned j = 0; j < 16; ++j) { const unsigned c = xb_ld(&bar[XB_XCNT(j)]); sum += c; cnt += (c > 0u) ? 1u : 0u; mine = (j == x) ? c : mine; }
        if (sum == G) break;
        __builtin_amdgcn_s_sleep(1);
        if ((++sp & 255u) == 0u) { if (xb_ld(&bar[XB_TMO])) break; if (sp > XB_SPIN_CAP) { atomicAdd(&bar[XB_TMO], 1u); break; } }
    }
    nloc = mine > 0u ? mine : 1u; nx = cnt > 0u ? cnt : 1u;
}

__device__ __forceinline__ void xcd_barrier(const XcdBarrier& b) {
    asm volatile("s_waitcnt vmcnt(0)" ::: "memory");
    __syncthreads();
    if (threadIdx.x == 0) {
        unsigned* bar = b.bar;
        __builtin_amdgcn_s_waitcnt(0);
        unsigned nloc = b.st[0], nx = b.st[1];
        if (nloc == 0u) { xcd_barrier_complete(bar, b.x, nloc, nx); b.st[0] = nloc; b.st[1] = nx; }
        const unsigned old = xb_add(&bar[XB_XSUB(b.x)], 1u);
        const unsigned gen = old / nloc;
        if (old + 1u == (gen + 1u) * nloc) {
            __builtin_amdgcn_fence(__ATOMIC_RELEASE, "agent");
            asm volatile("s_waitcnt vmcnt(0)" ::: "memory");
            const unsigned og = xb_add(&bar[XB_TOP], 1u);
            const unsigned tg = og / nx;
            if (og + 1u == (tg + 1u) * nx) xb_add(&bar[XB_TOPGEN], 1u);
            else XB_SPIN(xb_ld(&bar[XB_TOPGEN]) == tg, bar);
            __builtin_amdgcn_fence(__ATOMIC_ACQUIRE, "agent");
            xb_add(&bar[XB_XGEN(b.x)], 1u);
            asm volatile("s_waitcnt vmcnt(0)" ::: "memory");
        } else {
            XB_SPIN(xb_ld(&bar[XB_XGEN(b.x)]) == gen, bar);
            __builtin_amdgcn_fence(__ATOMIC_ACQUIRE, "agent");
            asm volatile("s_waitcnt vmcnt(0)" ::: "memory");
        }
    }
    __syncthreads();
}
namespace pg8 {
#define PG8_LAS __attribute__((address_space(3)))
typedef unsigned short bf16_t;
typedef short bf16x8 __attribute__((ext_vector_type(8)));
typedef float f32x4 __attribute__((ext_vector_type(4)));
typedef unsigned u32x4 __attribute__((ext_vector_type(4)));
constexpr int BM = 256, BK = 64, HALF = 128, HTB = HALF * BK * 2  , STAGE_BYTES = 8 * HTB, NXCD = 8, WGM = 8;

__host__ __device__ __forceinline__ int lds_byte(int r, int c) { const int st = (r >> 4) * 2 + (c >> 5), rr = r & 15, cc = c & 31, ob = rr * 64 + cc * 2; return st * 1024 + (ob ^ (((ob >> 9) & 1) << 5)); }
__host__ __device__ __forceinline__ void stage_rc(int b, int& R, int& C) { const int st = b / 1024, sb = b % 1024, swz = sb ^ (((sb >> 9) & 1) << 5); R = (st >> 1) * 16 + swz / 64; C = (st & 1) * 32 + (swz % 64) / 2; }
__host__ __device__ __forceinline__ int perm32(int rho) { const int n = rho >> 4, i = rho & 15; return 8 * (i >> 2) + 4 * n + (i & 3); }

struct Unit { int pm, pn; };
struct Gemm { const bf16_t* A; const bf16_t* Bt; int M, N, K; };

struct StaticOrder {
    int nM, nN, nwg, G, c;
    __host__ __device__ void init(int M, int N, int G_, int c_) { nM = M / BM; nN = N / BM; nwg = nM * nN; G = G_; c = c_; }
    __host__ __device__ bool next(int i, Unit& u) const {
        const long L = (long)i * G + c; if (L >= nwg) return false;
        int wgid = (int)L; { const int q = nwg / NXCD, r = nwg % NXCD, xcd = wgid % NXCD, off = wgid / NXCD; wgid = (xcd < r ? xcd * (q + 1) : r * (q + 1) + (xcd - r) * q) + off; }
        const int nig = WGM * nN, gid = wgid / nig, fm = gid * WGM, gsz = (nM - fm) < WGM ? (nM - fm) : WGM;
        u.pm = fm + ((wgid % nig) % gsz); u.pn = (wgid % nig) / gsz; return true;
    }
    __device__ __forceinline__ void a_ready(const Unit&) const {}
    __device__ __forceinline__ void done(const Unit&) const {}
};

__device__ __forceinline__ unsigned cvt_pk_bf16(float lo, float hi) { unsigned r; asm volatile("v_cvt_pk_bf16_f32 %0, %1, %2" : "=v"(r) : "v"(lo), "v"(hi)); return r; }
typedef float f32x2 __attribute__((ext_vector_type(2)));
__device__ __forceinline__ f32x2 gelu_pk(f32x2 v) {
    const f32x2 av = __builtin_elementwise_abs(v), d = av * 0.2316418882f + 1.0f;
    f32x2 t; t.x = __builtin_amdgcn_rcpf(d.x); t.y = __builtin_amdgcn_rcpf(d.y);
    f32x2 q = t * 0.5307027145f + (-0.7265760135f); q = q * t + 0.7107068705f; q = q * t + (-0.142248368f); q = q * t + 0.127414796f; q = q * t;
    const f32x2 s = (v * v) * (-0.72134752044f);
    f32x2 e; e.x = __builtin_amdgcn_exp2f(s.x); e.y = __builtin_amdgcn_exp2f(s.y);
    const f32x2 m = v * (q * e), r = v - m;
    f32x2 o; o.x = v.x < 0.f ? m.x : r.x; o.y = v.y < 0.f ? m.y : r.y; return o;
}

template <int ACT  > struct EpiBf16 {
    static constexpr bool PERM = true, AFTER_DRAIN = false; static_assert(ACT == 0 || ACT == 1, "EpiBf16: ACT is 0 (none) or 1 (gelu_pk)");
    bf16_t* O; int ldc; const float* bias; int split_cols; size_t split_stride; float scale0;
    __device__ __forceinline__ void operator()(const f32x4 (&acc)[2][2][4][2], const Unit& u, int wr, int wc, int fr, int fq) const {
        const int row0 = u.pm * BM + wr * 64 + fr; int colt = u.pn * BM; bf16_t* base = O;
        float sc = 1.f; if (split_cols) { const int t = colt / split_cols; base += (size_t)t * split_stride; colt -= t * split_cols; if (t == 0) sc = scale0; }
        const int col0 = colt + wc * 32 + 8 * fq, bcol0 = u.pn * BM + wc * 32 + 8 * fq;
        f32x4 bv[2][2];
#pragma unroll
        for (int bj = 0; bj < 2; ++bj)
#pragma unroll
            for (int n = 0; n < 2; ++n) bv[bj][n] = bias ? *(const f32x4*)(bias + bcol0 + bj * HALF + 4 * n) : (f32x4){0.f, 0.f, 0.f, 0.f};
#pragma unroll
        for (int ai = 0; ai < 2; ++ai)
#pragma unroll
            for (int m = 0; m < 4; ++m) { bf16_t* rowp = base + (size_t)(row0 + ai * HALF + m * 16) * ldc + col0;
#pragma unroll
                for (int bj = 0; bj < 2; ++bj) { f32x4 v0 = acc[ai][bj][m][0] + bv[bj][0], v1 = acc[ai][bj][m][1] + bv[bj][1];
                    if (ACT == 1) { f32x2 a = gelu_pk((f32x2){v0[0], v0[1]}), b = gelu_pk((f32x2){v0[2], v0[3]}), c = gelu_pk((f32x2){v1[0], v1[1]}), d = gelu_pk((f32x2){v1[2], v1[3]});
                        v0 = (f32x4){a.x, a.y, b.x, b.y}; v1 = (f32x4){c.x, c.y, d.x, d.y}; }
                    v0 = v0 * sc; v1 = v1 * sc; u32x4 w; w.x = cvt_pk_bf16(v0[0], v0[1]); w.y = cvt_pk_bf16(v0[2], v0[3]); w.z = cvt_pk_bf16(v1[0], v1[1]); w.w = cvt_pk_bf16(v1[2], v1[3]);
                    *(u32x4*)(rowp + bj * HALF) = w; } }
    }
};

struct EpiResid {
    static constexpr bool PERM = false, AFTER_DRAIN = false;
    const float* x; float* out; bf16_t* xb; float* rowsq; int ldc;
    __device__ __forceinline__ void operator()(const f32x4 (&acc)[2][2][4][2], const Unit& u, int wr, int wc, int fr, int fq) const {
        const int col0 = u.pn * BM + wc * 32 + 4 * fq;
#pragma unroll
        for (int ai = 0; ai < 2; ++ai)
#pragma unroll
            for (int m = 0; m < 4; ++m) {
                const int row = u.pm * BM + ai * HALF + wr * 64 + m * 16 + fr;
                const size_t off = (size_t)row * ldc + col0;
                float ss = 0.f;
#pragma unroll
                for (int bj = 0; bj < 2; ++bj)
#pragma unroll
                    for (int n = 0; n < 2; ++n) {
                        const size_t c = off + bj * HALF + n * 16;
                        const f32x4 xv = __builtin_nontemporal_load((const f32x4*)(x + c));
                        const f32x4 o = xv + acc[ai][bj][m][n];
                        ss += (o[0] * o[0] + o[1] * o[1]) + (o[2] * o[2] + o[3] * o[3]);
                        typedef unsigned u32x2v __attribute__((ext_vector_type(2)));
                        u32x2v w; w.x = cvt_pk_bf16(o[0], o[1]); w.y = cvt_pk_bf16(o[2], o[3]);
                        *(u32x2v*)(xb + c) = w;
                    }
                ss += __shfl_xor(ss, 16); ss += __shfl_xor(ss, 32);
                if (fq == 0) atomicAdd(rowsq + row, ss);
            }
    }
};

struct EpiProj {
    static constexpr bool PERM = true, AFTER_DRAIN = false;
    bf16_t* O; int ldc; const float* qnw; const float* knw; const float* cosT; const float* sinT; PG8_LAS float* xch; int q_lo, k_lo, k_hi, seq_mask; float eps;
    __device__ __forceinline__ void operator()(const f32x4 (&acc)[2][2][4][2], const Unit& u, int wr, int wc, int fr, int fq) const {
        const int colt = u.pn * BM, row0 = u.pm * BM + wr * 64 + fr, col0 = colt + wc * 32 + 8 * fq;
        if (colt < q_lo || colt >= k_hi) {
#pragma unroll
            for (int ai = 0; ai < 2; ++ai)
#pragma unroll
                for (int m = 0; m < 4; ++m) { bf16_t* rowp = O + (size_t)(row0 + ai * HALF + m * 16) * ldc + col0;
#pragma unroll
                    for (int bj = 0; bj < 2; ++bj) { const f32x4 v0 = acc[ai][bj][m][0], v1 = acc[ai][bj][m][1];
                        u32x4 w; w.x = cvt_pk_bf16(v0[0], v0[1]); w.y = cvt_pk_bf16(v0[2], v0[3]); w.z = cvt_pk_bf16(v1[0], v1[1]); w.w = cvt_pk_bf16(v1[2], v1[3]);
                        *(u32x4*)(rowp + bj * HALF) = w; } }
            return;
        }
        const float* nw = colt < k_lo ? qnw : knw;
#pragma unroll
        for (int ai = 0; ai < 2; ++ai)
#pragma unroll
            for (int m = 0; m < 4; ++m)
#pragma unroll
                for (int bj = 0; bj < 2; ++bj) {
                    const f32x4 a = acc[ai][bj][m][0], b = acc[ai][bj][m][1];
                    float ss = ((a[0] * a[0] + a[1] * a[1]) + (a[2] * a[2] + a[3] * a[3])) + ((b[0] * b[0] + b[1] * b[1]) + (b[2] * b[2] + b[3] * b[3]));
                    ss += __shfl_xor(ss, 16); ss += __shfl_xor(ss, 32);
                    if (fq == 0) xch[((ai * HALF + wr * 64 + m * 16 + fr) * 4 + bj * 2 + (wc >> 1)) * 2 + (wc & 1)] = ss;
                }
        asm volatile("s_waitcnt lgkmcnt(0)" ::: "memory"); __builtin_amdgcn_s_barrier(); asm volatile("" ::: "memory");
        float wv[8];
#pragma unroll
        for (int n = 0; n < 2; ++n)
#pragma unroll
            for (int j = 0; j < 4; ++j) wv[4 * n + j] = nw[32 * (wc & 1) + 8 * fq + 4 * n + j];
        const bool rot = ((wc & 1) == 0) && (fq < 2);
#pragma unroll
        for (int ai = 0; ai < 2; ++ai)
#pragma unroll
            for (int m = 0; m < 4; ++m) {
                const int rl = ai * HALF + wr * 64 + m * 16 + fr, row = u.pm * BM + rl, pos = row & seq_mask;
                f32x4 cs0 = {1.f, 1.f, 1.f, 1.f}, cs1 = cs0, sn0 = {0.f, 0.f, 0.f, 0.f}, sn1 = sn0;
                if (rot) { cs0 = *(const f32x4*)(cosT + pos * 8); cs1 = *(const f32x4*)(cosT + pos * 8 + 4); sn0 = *(const f32x4*)(sinT + pos * 8); sn1 = *(const f32x4*)(sinT + pos * 8 + 4); }
                bf16_t* rowp = O + (size_t)row * ldc + col0;
#pragma unroll
                for (int bj = 0; bj < 2; ++bj) {
                    const int xi = (rl * 4 + bj * 2 + (wc >> 1)) * 2;
                    const float rs = 1.0f / sqrtf((xch[xi] + xch[xi + 1]) * (1.f / 64.f) + eps);
                    f32x4 y0 = acc[ai][bj][m][0] * rs, y1 = acc[ai][bj][m][1] * rs;
#pragma unroll
                    for (int j = 0; j < 4; ++j) { y0[j] *= wv[j]; y1[j] *= wv[4 + j]; }
                    f32x4 p0, p1;
#pragma unroll
                    for (int j = 0; j < 4; ++j) { p0[j] = __shfl_xor(y0[j], 16); p1[j] = __shfl_xor(y1[j], 16); }
                    if (rot) {
                        if (fq == 0) { y0 = y0 * cs0 - p0 * sn0; y1 = y1 * cs1 - p1 * sn1; }
                        else { y0 = p0 * sn0 + y0 * cs0; y1 = p1 * sn1 + y1 * cs1; }
                    }
                    u32x4 w; w.x = cvt_pk_bf16(y0[0], y0[1]); w.y = cvt_pk_bf16(y0[2], y0[3]); w.z = cvt_pk_bf16(y1[0], y1[1]); w.w = cvt_pk_bf16(y1[2], y1[3]);
                    *(u32x4*)(rowp + bj * HALF) = w;
                }
            }
    }
};

template <class Epi, class Sched, bool ALIGN_EPI = false, bool SP2 = false>
__device__ __forceinline__ void gemm_phase(PG8_LAS unsigned char* lds, const Gemm g, const Sched& S, const Epi& E) {
    const int tid = threadIdx.x, wid = __builtin_amdgcn_readfirstlane(tid >> 6), lane = tid & 63, wr = wid >> 2, wc = wid & 3, fr = lane & 15, fq = lane >> 4;
    const int K = g.K, nt = K / BK;
    unsigned voffA[2], voffB[2];
#pragma unroll
    for (int i = 0; i < 2; ++i) { int R, C; stage_rc(tid * 16 + i * 8192, R, C); const int Rb = Epi::PERM ? ((R & ~31) + perm32(R & 31)) : R;
        voffA[i] = (unsigned)(R * K + C) * 2u; voffB[i] = (unsigned)(Rb * K + C) * 2u; }
    const size_t kstep = (size_t)(BK * 2);
    const size_t hstep = (size_t)HALF * K * 2;
    const size_t tstep = 2 * hstep;
    const unsigned ldsw = (unsigned)wid * 1024u;
    const int aoff = lds_byte(wr * 64 + fr, fq * 8), boff = lds_byte(wc * 32 + fr, fq * 8);
#define PG8_SA(b, h) (((b) * 2 + (h)) * HTB)
#define PG8_SB(b, h) ((4 + (b) * 2 + (h)) * HTB)
#define PG8_STAGE(bufoff, gbase, voff) do { _Pragma("unroll") for (int _i = 0; _i < 2; ++_i) \
        __builtin_amdgcn_global_load_lds((const unsigned*)((const char*)(gbase) + (voff)[_i]), (PG8_LAS unsigned*)(lds + (bufoff) + ldsw + _i * 8192), 16, 0, 0); } while (0)
#define PG8_LDA(dst, b, h) do { _Pragma("unroll") for (int m = 0; m < 4; ++m) _Pragma("unroll") for (int k = 0; k < 2; ++k) dst[m][k] = *(const PG8_LAS bf16x8*)(lds + PG8_SA(b, h) + aoff + m * 2048 + k * 1024); } while (0)
#define PG8_LDB(dst, b, h) do { _Pragma("unroll") for (int n = 0; n < 2; ++n) _Pragma("unroll") for (int k = 0; k < 2; ++k) dst[n][k] = *(const PG8_LAS bf16x8*)(lds + PG8_SB(b, h) + boff + n * 2048 + k * 1024); } while (0)
#define PG8_MMA(ai, bj, At, Bt) do { __builtin_amdgcn_s_setprio(1); _Pragma("unroll") for (int m = 0; m < 4; ++m) _Pragma("unroll") for (int n = 0; n < 2; ++n) _Pragma("unroll") for (int k = 0; k < 2; ++k) \
        acc[ai][bj][m][n] = __builtin_amdgcn_mfma_f32_16x16x32_bf16(Bt[n][k], At[m][k], acc[ai][bj][m][n], 0, 0, 0); __builtin_amdgcn_s_setprio(0); } while (0)
#define PG8_WAIT_V(n) asm volatile("s_waitcnt vmcnt(" #n ")" ::: "memory")
#define PG8_WAIT_L(n) asm volatile("s_waitcnt lgkmcnt(" #n ")" ::: "memory")
#define PG8_BAR __builtin_amdgcn_s_barrier()
#define PG8_SCHED __builtin_amdgcn_sched_barrier(0)
    Unit cur, nxt; int ui = 0;
    if (!S.next(0, cur)) return;
    f32x4 acc[2][2][4][2];
#pragma unroll
    for (int a = 0; a < 2; ++a)
#pragma unroll
        for (int b = 0; b < 2; ++b)
#pragma unroll
            for (int m = 0; m < 4; ++m)
#pragma unroll
                for (int n = 0; n < 2; ++n) acc[a][b][m][n] = (f32x4){0.f, 0.f, 0.f, 0.f};
    bf16x8 At[4][2], B0[2][2], B1[2][2];
    const char* cA = (const char*)g.A + (size_t)cur.pm * tstep; const char* cB = (const char*)g.Bt + (size_t)cur.pn * tstep;
    S.a_ready(cur);
    if constexpr (SP2) {
        PG8_STAGE(PG8_SB(0, 0), cB, voffB); PG8_STAGE(PG8_SB(0, 1), cB + hstep, voffB); PG8_STAGE(PG8_SA(0, 0), cA, voffA); PG8_STAGE(PG8_SA(0, 1), cA + hstep, voffA);
        if (wr == 1) PG8_BAR;
        PG8_WAIT_V(2); PG8_BAR;
        PG8_STAGE(PG8_SB(1, 0), cB + kstep, voffB); PG8_STAGE(PG8_SA(1, 0), cA + kstep, voffA); PG8_STAGE(PG8_SB(1, 1), cB + hstep + kstep, voffB);
        PG8_WAIT_V(6); PG8_BAR;
    } else {
        PG8_STAGE(PG8_SB(0, 0), cB, voffB); PG8_STAGE(PG8_SA(0, 0), cA, voffA); PG8_STAGE(PG8_SB(0, 1), cB + hstep, voffB); PG8_STAGE(PG8_SA(0, 1), cA + hstep, voffA);
        if (wr == 1) PG8_BAR;
        PG8_WAIT_V(4); PG8_BAR;
        PG8_STAGE(PG8_SB(1, 0), cB + kstep, voffB); PG8_STAGE(PG8_SA(1, 0), cA + kstep, voffA); PG8_STAGE(PG8_SB(1, 1), cB + hstep + kstep, voffB);
        PG8_WAIT_V(6); PG8_BAR;
    }
    for (;;) {
        const bool has_next = S.next(ui + 1, nxt);
        const char* nA = has_next ? (const char*)g.A + (size_t)nxt.pm * tstep : cA; const char* nB = has_next ? (const char*)g.Bt + (size_t)nxt.pn * tstep : cB;
        for (int t = 0; t < nt; t += 2) {
            const bool last = (t == nt - 2);
            const char* a1 = cA + (size_t)(t + 1) * kstep;
            const char* a2 = last ? nA : cA + (size_t)(t + 2) * kstep; const char* b2 = last ? nB : cB + (size_t)(t + 2) * kstep;
            const char* a3 = a2 + kstep; const char* b3 = b2 + kstep;
            if (last && has_next) S.a_ready(nxt);
            if constexpr (SP2) {
            PG8_LDB(B0, 0, 0); PG8_LDB(B1, 0, 1); PG8_SCHED; PG8_LDA(At, 0, 0); PG8_STAGE(PG8_SA(1, 1), a1 + hstep, voffA);
            PG8_WAIT_V(8); PG8_WAIT_L(0); PG8_BAR; PG8_MMA(0, 0, At, B0); PG8_MMA(0, 1, At, B1); PG8_BAR; PG8_SCHED;
            PG8_LDA(At, 0, 1); PG8_STAGE(PG8_SB(0, 0), b2, voffB); PG8_STAGE(PG8_SB(0, 1), b2 + hstep, voffB); PG8_STAGE(PG8_SA(0, 0), a2, voffA);
            PG8_WAIT_V(8); PG8_WAIT_L(0); PG8_BAR; PG8_MMA(1, 0, At, B0); PG8_MMA(1, 1, At, B1); PG8_BAR; PG8_SCHED;
            PG8_LDB(B0, 1, 0); PG8_LDB(B1, 1, 1); PG8_SCHED; PG8_LDA(At, 1, 0); PG8_STAGE(PG8_SA(0, 1), a2 + hstep, voffA);
            PG8_WAIT_V(8); PG8_WAIT_L(0); PG8_BAR; PG8_MMA(0, 0, At, B0); PG8_MMA(0, 1, At, B1); PG8_BAR; PG8_SCHED;
            PG8_LDA(At, 1, 1); PG8_STAGE(PG8_SB(1, 0), b3, voffB); PG8_STAGE(PG8_SB(1, 1), b3 + hstep, voffB); PG8_STAGE(PG8_SA(1, 0), a3, voffA);
            PG8_WAIT_V(8); PG8_WAIT_L(0); PG8_BAR; PG8_MMA(1, 0, At, B0); PG8_MMA(1, 1, At, B1); PG8_BAR; PG8_SCHED;
            } else {
            PG8_LDB(B0, 0, 0); PG8_SCHED; PG8_LDA(At, 0, 0); PG8_STAGE(PG8_SA(1, 1), a1 + hstep, voffA);
            PG8_WAIT_L(8); PG8_BAR; PG8_WAIT_L(0); PG8_MMA(0, 0, At, B0); PG8_BAR; PG8_SCHED;
            PG8_LDB(B1, 0, 1); PG8_STAGE(PG8_SB(0, 0), b2, voffB);
            PG8_BAR; PG8_WAIT_L(0); PG8_MMA(0, 1, At, B1); PG8_BAR;
            PG8_LDA(At, 0, 1); PG8_STAGE(PG8_SA(0, 0), a2, voffA);
            PG8_BAR; PG8_WAIT_L(0); PG8_MMA(1, 0, At, B0); PG8_BAR; PG8_SCHED;
            PG8_STAGE(PG8_SB(0, 1), b2 + hstep, voffB);
            PG8_WAIT_V(6); PG8_BAR; PG8_MMA(1, 1, At, B1); PG8_BAR;
            PG8_LDB(B0, 1, 0); PG8_SCHED; PG8_LDA(At, 1, 0); PG8_STAGE(PG8_SA(0, 1), a2 + hstep, voffA);
            PG8_WAIT_L(8); PG8_BAR; PG8_WAIT_L(0); PG8_MMA(0, 0, At, B0); PG8_BAR; PG8_SCHED;
            PG8_LDB(B1, 1, 1); PG8_STAGE(PG8_SB(1, 0), b3, voffB);
            PG8_BAR; PG8_WAIT_L(0); PG8_MMA(0, 1, At, B1); PG8_BAR;
            PG8_LDA(At, 1, 1); PG8_STAGE(PG8_SA(1, 0), a3, voffA);
            PG8_BAR; PG8_WAIT_L(0); PG8_MMA(1, 0, At, B0); PG8_BAR; PG8_SCHED;
            PG8_STAGE(PG8_SB(1, 1), b3 + hstep, voffB);
            PG8_WAIT_V(6); PG8_BAR; PG8_MMA(1, 1, At, B1); PG8_BAR;
            }
        }
        if constexpr (ALIGN_EPI) { if (wr == 0) PG8_BAR; }
        if constexpr (!Epi::AFTER_DRAIN) { E(acc, cur, wr, wc, fr, fq); S.done(cur); }
        if (!has_next) break;
#pragma unroll
        for (int a = 0; a < 2; ++a)
#pragma unroll
            for (int b = 0; b < 2; ++b)
#pragma unroll
                for (int m = 0; m < 4; ++m)
#pragma unroll
                    for (int n = 0; n < 2; ++n) acc[a][b][m][n] = (f32x4){0.f, 0.f, 0.f, 0.f};
        cur = nxt; cA = nA; cB = nB; ++ui;
        if constexpr (ALIGN_EPI) { if (wr == 1) PG8_BAR; }
    }
    PG8_WAIT_V(0);
    if constexpr (!ALIGN_EPI) { if (wr == 0) PG8_BAR; }
    PG8_BAR;
    if constexpr (Epi::AFTER_DRAIN) { E.fused(acc, cur, wr, wc, fr, fq, lds, wid, lane); S.done(cur); }
#undef PG8_SA
#undef PG8_SB
#undef PG8_STAGE
#undef PG8_LDA
#undef PG8_LDB
#undef PG8_MMA
#undef PG8_WAIT_V
#undef PG8_WAIT_L
#undef PG8_BAR
#undef PG8_SCHED
}
}

struct Params {
    const float* in[22];
    float* out;
    unsigned char* ws;
    int ph_lo, ph_hi;
};
struct Ctx { LAS unsigned char* lds; int tid, lane, wave, vcu, G, gw, ngw; unsigned long long ta, tb, tc; };

__device__ __forceinline__ void p0_transpose_item(const float* W, int K, int Nreal, int thresh, const float* ksc, bf16_t* WT, LAS float* scr, int item, int nblk, int lane) {
    const int kb = item / nblk, nb = item % nblk, k0 = 64 * kb, n0 = 32 * nb;
    const int nr0 = n0 + (n0 >= thresh ? 8 : 0);
#pragma unroll 8
    for (int i = 0; i < 32; ++i) {
        const int kk = 2 * i + (lane >> 5);
        const float sc = ksc ? ksc[k0 + kk] : 1.f;
        scr[kk * 33 + (lane & 31)] = W[(size_t)(k0 + kk) * Nreal + nr0 + (lane & 31)] * sc;
    }
    LDS_WAIT(); asm volatile("" ::: "memory");
    const int c = lane & 7;
#pragma unroll
    for (int j = 0; j < 4; ++j) {
        const int n = (lane >> 3) + 8 * j; const LAS float* s = scr + (8 * c) * 33 + n;
        u32x4 o; o.x = pk2(s[0 * 33], s[1 * 33]); o.y = pk2(s[2 * 33], s[3 * 33]); o.z = pk2(s[4 * 33], s[5 * 33]); o.w = pk2(s[6 * 33], s[7 * 33]);
        *(u32x4*)(WT + (size_t)(n0 + n) * K + k0 + 8 * c) = o;
    }
    LDS_WAIT(); asm volatile("" ::: "memory");
}

__device__ __forceinline__ void phase0(const Params& p, Ctx& F) {
    const float* x = p.in[0]; const float* mixw = p.in[1]; const float* w_in = p.in[2];
    const float* w_out = p.in[16]; const float* ffnw = p.in[17]; const float* w_q = p.in[18]; const float* keys = p.in[19];
    const float* pu = p.in[20]; const float* pv = p.in[21];
    unsigned char* ws = p.ws;
    LAS float* scr = (LAS float*)(F.lds + F.wave * 8448);
    LAS float* wdt = (LAS float*)(F.lds + 69632);
    {
        constexpr int WLD = 132;
        LAS float* WQS = (LAS float*)F.lds;
        LAS float* KYS = (LAS float*)(F.lds + 64 * WLD * 4);
        bf16_t* wefft = (bf16_t*)(ws + WS_WQT);
        for (int u = F.vcu; u < 256; u += F.G) {
            const int hj = u >> 4, kt = u & 15;
            __syncthreads();
#pragma unroll
            for (int i = 0; i < 4; ++i) {
                const int pc = F.tid + 512 * i, k = pc >> 5, d4 = pc & 31;
                const f32x4 v = *(const f32x4*)(w_q + (size_t)(64 * kt + k) * 2048 + hj * 128 + d4 * 4);
                *(LAS f32x4*)(WQS + k * WLD + d4 * 4) = v * ffnw[64 * kt + k];
            }
#pragma unroll
            for (int i = 0; i < 8; ++i) {
                const int pc = F.tid + 512 * i, n = pc >> 5, d4 = pc & 31;
                *(LAS f32x4*)(KYS + n * WLD + d4 * 4) = *(const f32x4*)(keys + ((size_t)hj * 128 + n) * 128 + d4 * 4);
            }
            __syncthreads();
            const int fr_ = F.lane & 15, fq_ = F.lane >> 4, mt = F.wave >> 1, nt0 = (F.wave & 1) * 4;
            f32x4 acc[4];
#pragma unroll
            for (int q = 0; q < 4; ++q) acc[q] = (f32x4){0.f, 0.f, 0.f, 0.f};
#pragma unroll 4
            for (int ks = 0; ks < 32; ++ks) {
                const float av = WQS[(mt * 16 + fr_) * WLD + 4 * ks + fq_];
#pragma unroll
                for (int q = 0; q < 4; ++q) {
                    const float bv = KYS[((nt0 + q) * 16 + fr_) * WLD + 4 * ks + fq_];
                    acc[q] = __builtin_amdgcn_mfma_f32_16x16x4f32(av, bv, acc[q], 0, 0, 0);
                }
            }
#pragma unroll
            for (int q = 0; q < 4; ++q) {
                u32x2 w; w.x = pk2(acc[q][0], acc[q][1]); w.y = pk2(acc[q][2], acc[q][3]);
                *(u32x2*)(wefft + ((size_t)hj * 128 + (nt0 + q) * 16 + fr_) * DM + 64 * kt + mt * 16 + 4 * fq_) = w;
            }
        }
        __syncthreads();
    }
    for (int k = F.tid; k < DM; k += 512) {
        const float s = mixw[k];
        const f32x4 a = *(const f32x4*)(w_in + (size_t)k * 3080 + 1536), b = *(const f32x4*)(w_in + (size_t)k * 3080 + 1540);
        *(LAS f32x4*)(wdt + k * 8) = a * s; *(LAS f32x4*)(wdt + k * 8 + 4) = b * s;
    }
    __syncthreads();
    constexpr int I_IN = 16 * 96, I_OUT = 16 * 32;
    for (int it = F.gw; it < I_IN + I_OUT; it += F.ngw) {
        int r = it;
        if (r < I_IN) { p0_transpose_item(w_in, DM, 3080, 1536, mixw, (bf16_t*)(ws + WS_WINT), scr, r, 96, F.lane); continue; } r -= I_IN;
        p0_transpose_item(w_out, DM, DM, 1 << 30, nullptr, (bf16_t*)(ws + WS_WOUTT), scr, r, 32, F.lane);
    }
    const int gtid = F.vcu * 512 + F.tid, nthr = F.G * 512;
    for (int i = gtid; i < TOK; i += nthr) ((float*)(ws + WS_CTL) + CW_ROWSQ)[i] = 0.f;
    for (int i = gtid; i < SEQ * 8; i += nthr) {
        const int pos = i >> 3, f = i & 7;
        const float inv = powf(500000.0f, -(float)(2 * f) / 16.0f);
        const float ang = (float)pos * inv;
        ((float*)(ws + WS_ROPE))[i] = cosf(ang);
        ((float*)(ws + WS_ROPE))[SEQ * 8 + i] = sinf(ang);
    }
    if (F.gw == 0) {
        const float a = p.in[11][F.lane] * p.in[12][F.lane], b = p.in[13][F.lane] * p.in[14][F.lane];
        const float sa = wave_sum(a), sb = wave_sum(b);
        if (F.lane == 0) ((float*)(ws + WS_MISC))[0] = expf(sa) - expf(sb) + LAMBDA_INIT;
    }
    {
        float* rsu = (float*)(ws + WS_RSU); float* rsv = (float*)(ws + WS_RSV);
        for (int r0 = F.gw; r0 < 2 * 16384; r0 += 4 * F.ngw) {
            f32x4 a[4][4]; float amax[4];
#pragma unroll
            for (int u = 0; u < 4; ++u) {
                const int r = min(r0 + u * F.ngw, 2 * 16384 - 1); const bool isU = r < 16384; const int e = r & 16383;
                const float* src = (isU ? pu : pv) + (size_t)e * DM + 16 * F.lane;
#pragma unroll
                for (int q = 0; q < 4; ++q) a[u][q] = __builtin_nontemporal_load((const f32x4*)(src + 4 * q));
            }
#pragma unroll
            for (int u = 0; u < 4; ++u) {
                const int r = min(r0 + u * F.ngw, 2 * 16384 - 1); const bool isU = r < 16384;
                amax[u] = 0.f;
#pragma unroll
                for (int q = 0; q < 4; ++q) {
                    if (isU) a[u][q] = a[u][q] * *(const f32x4*)(ffnw + 16 * F.lane + 4 * q);
                    amax[u] = fmaxf(amax[u], fmaxf(fmaxf(fabsf(a[u][q][0]), fabsf(a[u][q][1])), fmaxf(fabsf(a[u][q][2]), fabsf(a[u][q][3]))));
                }
            }
#pragma unroll
            for (int u = 0; u < 4; ++u) amax[u] = wave_max(amax[u]);
#pragma unroll
            for (int u = 0; u < 4; ++u) {
                const int r = min(r0 + u * F.ngw, 2 * 16384 - 1); const bool isU = r < 16384; const int e = r & 16383;
#ifdef U_FP4
#ifdef V_FP4
#define V_FP4_ON 1
#else
#define V_FP4_ON 0
#endif
#ifndef FP4_NIB_SWAP
#define FP4_NIB_SWAP 0
#endif
                if (isU || V_FP4_ON) {
                    const float s4 = amax[u] > 0.f ? 6.f / amax[u] : 1.f;
                    if (F.lane == 0) (isU ? rsu : rsv)[e] = amax[u] > 0.f ? amax[u] * (1.f / 6.f) : 1.f;
                    u32x2 o4;
#pragma unroll
                    for (int hq = 0; hq < 2; ++hq) {
                        unsigned w = 0u;
#pragma unroll
                        for (int q2 = 0; q2 < 2; ++q2)
#pragma unroll
                            for (int el = 0; el < 4; ++el) {
                                const float qv = a[u][hq * 2 + q2][el] * s4, m = fabsf(qv);
                                const unsigned c = (unsigned)(m > 0.25f) + (unsigned)(m > 0.75f) + (unsigned)(m > 1.25f) + (unsigned)(m > 1.75f) + (unsigned)(m > 2.5f) + (unsigned)(m > 3.5f) + (unsigned)(m > 5.0f)
                                                 + (qv < 0.f ? 8u : 0u);
                                w |= c << (4 * ((q2 * 4 + el) ^ FP4_NIB_SWAP));
                            }
                        o4[hq] = w;
                    }
                    *(u32x2*)(ws + (isU ? WS_UB : WS_VB) + (size_t)e * (DM / 2) + 8 * F.lane) = o4;
                    continue;
                }
#endif
                const float sc = amax[u] > 0.f ? 240.f / amax[u] : 1.f;
                if (F.lane == 0) (isU ? rsu : rsv)[e] = amax[u] > 0.f ? amax[u] * (1.f / 240.f) : 1.f;
                u32x4 o;
#pragma unroll
                for (int q = 0; q < 4; ++q) {
                    int pk = 0;
                    pk = __builtin_amdgcn_cvt_pk_fp8_f32(a[u][q][0] * sc, a[u][q][1] * sc, pk, false);
                    pk = __builtin_amdgcn_cvt_pk_fp8_f32(a[u][q][2] * sc, a[u][q][3] * sc, pk, true);
                    o[q] = (unsigned)pk;
                }
                *(u32x4*)(ws + (isU ? WS_UB : WS_VB) + (size_t)e * DM + 16 * F.lane) = o;
            }
        }
    }
    bf16_t* xb = (bf16_t*)(ws + WS_XB); float* dtraw = (float*)(ws + WS_DTRAW);
    for (int m0 = F.gw; m0 < TOK; m0 += 2 * F.ngw) {
        f32x4 v[2][4]; float ss[2];
#pragma unroll
        for (int u = 0; u < 2; ++u) {
            const int m = m0 + u * F.ngw; ss[u] = 0.f;
            const f32x4* xr = (const f32x4*)(x + (size_t)(m < TOK ? m : m0) * DM) + F.lane;
#pragma unroll
            for (int j = 0; j < 4; ++j) v[u][j] = __builtin_nontemporal_load(xr + 64 * j);
        }
#pragma unroll
        for (int u = 0; u < 2; ++u)
#pragma unroll
            for (int j = 0; j < 4; ++j) ss[u] += (v[u][j][0] * v[u][j][0] + v[u][j][1] * v[u][j][1]) + (v[u][j][2] * v[u][j][2] + v[u][j][3] * v[u][j][3]);
        f32x4 d0[2], d1[2];
#pragma unroll
        for (int u = 0; u < 2; ++u) { d0[u] = (f32x4){0.f, 0.f, 0.f, 0.f}; d1[u] = (f32x4){0.f, 0.f, 0.f, 0.f}; }
#pragma unroll
        for (int j = 0; j < 4; ++j)
#pragma unroll
            for (int e = 0; e < 4; ++e) {
                const int k = 256 * j + 4 * F.lane + e;
                const f32x4 w0 = *(const LAS f32x4*)(wdt + k * 8), w1 = *(const LAS f32x4*)(wdt + k * 8 + 4);
#pragma unroll
                for (int u = 0; u < 2; ++u) { d0[u] += w0 * v[u][j][e]; d1[u] += w1 * v[u][j][e]; }
            }
#pragma unroll
        for (int u = 0; u < 2; ++u) {
            ss[u] = wave_sum(ss[u]);
#pragma unroll
            for (int e = 0; e < 4; ++e) { d0[u][e] = wave_sum(d0[u][e]); d1[u][e] = wave_sum(d1[u][e]); }
        }
#pragma unroll
        for (int u = 0; u < 2; ++u) {
            const int m = m0 + u * F.ngw;
            if (m < TOK) {
                const float r = rsqrtf(ss[u] * (1.f / DM) + EPSN);
                if (F.lane == 0) { *(f32x4*)(dtraw + (size_t)m * 8) = d0[u] * r; *(f32x4*)(dtraw + (size_t)m * 8 + 4) = d1[u] * r; }
                unsigned long long* o8 = (unsigned long long*)(xb + (size_t)m * DM) + F.lane;
#pragma unroll
                for (int j = 0; j < 4; ++j) o8[64 * j] = (unsigned long long)pk2(v[u][j][0] * r, v[u][j][1] * r) | ((unsigned long long)pk2(v[u][j][2] * r, v[u][j][3] * r) << 32);
            }
        }
    }
}

__device__ __forceinline__ void p2_qk_prepass(const Params& p, Ctx& F) {
    bf16_t* proj = (bf16_t*)(p.ws + WS_PROJ);
    const float* qnw = p.in[9]; const float* knw = p.in[10];
    const float* cosT = (const float*)(p.ws + WS_ROPE); const float* sinT = cosT + SEQ * 8;
    const int sub = F.lane & 7;
    float wq[8], wk[8];
#pragma unroll
    for (int e = 0; e < 8; ++e) { wq[e] = qnw[sub * 8 + e]; wk[e] = knw[sub * 8 + e]; }
    for (int base = F.gw; base < TOK * 2; base += 8 * F.ngw) {
        u32x4 raw[8];
#pragma unroll
        for (int u = 0; u < 8; ++u) {
            const int wsi = base + u * F.ngw;
            raw[u] = (wsi < TOK * 2) ? *(const u32x4*)(proj + (size_t)(wsi >> 1) * NIN + ((wsi & 1) ? PK : PQ) + F.lane * 8) : (u32x4){0u, 0u, 0u, 0u};
        }
#pragma unroll
        for (int u = 0; u < 8; ++u) {
            const int wsi = base + u * F.ngw;
            const int t = wsi >> 1, which = wsi & 1;
            float v[8];
#pragma unroll
            for (int e = 0; e < 4; ++e) { v[2 * e] = bf2f(raw[u][e] & 0xffffu); v[2 * e + 1] = bf2f(raw[u][e] >> 16); }
            float ss = 0.f;
#pragma unroll
            for (int e = 0; e < 8; ++e) ss += v[e] * v[e];
            ss += __shfl_xor(ss, 1); ss += __shfl_xor(ss, 2); ss += __shfl_xor(ss, 4);
            const float rs = rsqrtf(ss * (1.f / 64.f) + EPSN);
            const int pos = t & (SEQ - 1);
            float o[8];
#pragma unroll
            for (int e = 0; e < 8; ++e) {
                const float y = v[e] * rs * (which ? wk[e] : wq[e]);
                const float other = __shfl_xor(y, 1);
                float r = y;
                if (sub < 2) {
                    const float c = cosT[pos * 8 + e], sn = sinT[pos * 8 + e];
                    r = (sub == 0) ? (y * c - other * sn) : (other * sn + y * c);
                }
                o[e] = r;
            }
            u32x4 ov; ov.x = pk2(o[0], o[1]); ov.y = pk2(o[2], o[3]); ov.z = pk2(o[4], o[5]); ov.w = pk2(o[6], o[7]);
            if (wsi < TOK * 2) *(u32x4*)(proj + (size_t)t * NIN + (which ? PK : PQ) + F.lane * 8) = ov;
        }
    }
}

constexpr int P2_XS = 0, P2_BM = 33792, P2_CM = 51200, P2_CB = 68608, P2_MH = 85248, P2_XW = 122112, P2_ACS = 155904, P2_DT = 156928, P2_FAC = 157952;
constexpr int XS_LD = 264, BM_LD = 136, MH_LD = 72, CB_LD = 65;
static_assert(P2_FAC + 1024 <= LDS_BYTES, "P2 LDS");

__device__ __forceinline__ void p2_load_raw(const bf16_t* proj, int tid, int b, int c, int g, u32x4 (&rv)[11]) {
    const int cg = tid & 63, rg = tid >> 6, lc = cg * 8;
    const int pcol = lc < 256 ? PXS + g * 256 + lc : (lc < 384 ? PBM + g * 128 + (lc - 256) : PCM + g * 128 + (lc - 384));
#pragma unroll
    for (int i = 0; i < 11; ++i) {
        const int f = c * CHUNK + rg * 8 - 3 + i;
        u32x4 v = {0u, 0u, 0u, 0u};
        if (f >= 0) v = *(const u32x4*)(proj + ((size_t)b * SEQ + f) * NIN + pcol);
        rv[i] = v;
    }
}
__device__ __forceinline__ void p2_ssd_unit(const Params& p, Ctx& F, int b, int c, int g, u32x4 (&rv)[11], bool has_next, int nb, int nc, int ng) {
    unsigned char* ws = p.ws;
    const bf16_t* proj = (const bf16_t*)(ws + WS_PROJ);
    bf16_t* ycat = (bf16_t*)(ws + WS_YCAT); bf16_t* cmc = (bf16_t*)(ws + WS_CMC);
    bf16_t* states = (bf16_t*)(ws + WS_STATES); float* acs_g = (float*)(ws + WS_ACS); float* cdec = (float*)(ws + WS_CDEC);
    const float* dtraw = (const float*)(ws + WS_DTRAW);
    const float* conv_w = p.in[3]; const float* conv_b = p.in[4]; const float* dt_bias = p.in[5]; const float* a_log = p.in[6]; const float* d_skip = p.in[7];
    LAS bf16_t* XS = (LAS bf16_t*)(F.lds + P2_XS); LAS bf16_t* BM = (LAS bf16_t*)(F.lds + P2_BM); LAS bf16_t* CM = (LAS bf16_t*)(F.lds + P2_CM);
    LAS float* CB = (LAS float*)(F.lds + P2_CB); LAS bf16_t* MH = (LAS bf16_t*)(F.lds + P2_MH); LAS bf16_t* XW = (LAS bf16_t*)(F.lds + P2_XW);
    LAS float* ACS = (LAS float*)(F.lds + P2_ACS); LAS float* DT = (LAS float*)(F.lds + P2_DT); LAS float* FAC = (LAS float*)(F.lds + P2_FAC);
    const int tid = F.tid, lane = F.lane, wave = F.wave, fr = lane & 15, fq = lane >> 4;
    const size_t tbase = (size_t)b * SEQ + (size_t)c * CHUNK;
#ifndef SKIP_A
    {
        const int cg = tid & 63, rg = tid >> 6, lc = cg * 8;
        int pcol, dld, dcol, kind;
        if (lc < 256) { pcol = PXS + g * 256 + lc; dld = XS_LD; dcol = lc; kind = 0; }
        else if (lc < 384) { pcol = PBM + g * 128 + (lc - 256); dld = BM_LD; dcol = lc - 256; kind = 1; }
        else { pcol = PCM + g * 128 + (lc - 384); dld = BM_LD; dcol = lc - 384; kind = 2; }
        LAS bf16_t* dst = kind == 0 ? XS : (kind == 1 ? BM : CM);
        const int ch = pcol - 512;
        float cw[4][8], cbv[8];
#pragma unroll
        for (int w = 0; w < 4; ++w) {
            const f32x4 a = *(const f32x4*)(conv_w + w * 1024 + ch), bq = *(const f32x4*)(conv_w + w * 1024 + ch + 4);
#pragma unroll
            for (int e = 0; e < 4; ++e) { cw[w][e] = a[e]; cw[w][4 + e] = bq[e]; }
        }
        { const f32x4 a = *(const f32x4*)(conv_b + ch), bq = *(const f32x4*)(conv_b + ch + 4);
#pragma unroll
          for (int e = 0; e < 4; ++e) { cbv[e] = a[e]; cbv[4 + e] = bq[e]; } }
#pragma unroll
        for (int r = 0; r < 8; ++r) {
            const int l = rg * 8 + r;
            float o[8];
#pragma unroll
            for (int e = 0; e < 8; ++e) o[e] = cbv[e];
#pragma unroll
            for (int w = 0; w < 4; ++w)
#pragma unroll
                for (int e = 0; e < 4; ++e) {
                    o[2 * e] += cw[w][2 * e] * bf2f(rv[r + w][e] & 0xffffu);
                    o[2 * e + 1] += cw[w][2 * e + 1] * bf2f(rv[r + w][e] >> 16);
                }
#pragma unroll
            for (int e = 0; e < 8; ++e) o[e] = silu_f(o[e]);
            u32x4 ov; ov.x = pk2(o[0], o[1]); ov.y = pk2(o[2], o[3]); ov.z = pk2(o[4], o[5]); ov.w = pk2(o[6], o[7]);
            *(LAS u32x4*)(dst + l * dld + dcol) = ov;
            if (kind == 2) *(u32x4*)(cmc + (tbase + l) * 256 + g * 128 + dcol) = ov;
        }
    }
#endif
    if (has_next) p2_load_raw(proj, tid, nb, nc, ng, rv);
    if (tid < 256) {
        const int l = tid >> 2, h = tid & 3, hh = g * 4 + h;
        const float v = dtraw[(tbase + l) * 8 + hh] + dt_bias[hh];
        const float dt = v > 20.f ? v : log1pf(expf(v));
        DT[l * 4 + h] = dt;
        ACS[l * 4 + h] = dt * (-expf(a_log[hh]));
    }
    __syncthreads();
    if (wave < 4) {
        float s = ACS[lane * 4 + wave];
#pragma unroll
        for (int o = 1; o < 64; o <<= 1) { const float t = __shfl_up(s, o); if (lane >= o) s += t; }
        ACS[lane * 4 + wave] = s;
        if (lane == 63) cdec[((size_t)b * NCH + c) * 8 + g * 4 + wave] = expf(s);
    }
    __syncthreads();
    if (tid < 256) {
        const int l = tid >> 2, h = tid & 3;
        acs_g[(tbase + l) * 8 + g * 4 + h] = ACS[l * 4 + h];
        FAC[l * 4 + h] = DT[l * 4 + h] * expf(ACS[63 * 4 + h] - ACS[l * 4 + h]);
    }
#pragma unroll
    for (int q = 0; q < 2; ++q) {
        const int tile = wave * 2 + q, mt = tile >> 2, nt = tile & 3;
        f32x4 acc = {0.f, 0.f, 0.f, 0.f};
#pragma unroll
        for (int ks = 0; ks < 4; ++ks) {
            const bf16x8 a = *(const LAS bf16x8*)(CM + (mt * 16 + fr) * BM_LD + ks * 32 + fq * 8);
            const bf16x8 bq = *(const LAS bf16x8*)(BM + (nt * 16 + fr) * BM_LD + ks * 32 + fq * 8);
            acc = mfma16(a, bq, acc);
        }
#pragma unroll
        for (int j = 0; j < 4; ++j) CB[(mt * 16 + 4 * fq + j) * CB_LD + nt * 16 + fr] = acc[j];
    }
    __syncthreads();
    {
        const int sI = lane;
        float as_[4], ds_[4];
#pragma unroll
        for (int h = 0; h < 4; ++h) { as_[h] = ACS[sI * 4 + h]; ds_[h] = DT[sI * 4 + h]; }
#pragma unroll 2
        for (int li = 0; li < 8; ++li) {
            const int l = li * 8 + wave;
            const float cb = CB[l * CB_LD + sI];
#pragma unroll
            for (int h = 0; h < 4; ++h) {
                const float v = (sI <= l) ? cb * __expf(ACS[l * 4 + h] - as_[h]) * ds_[h] : 0.f;
                MH[(h * 64 + l) * MH_LD + sI] = (bf16_t)f2bf(v);
            }
        }
#pragma unroll
        for (int i = 0; i < 4; ++i) {
            const int pc = tid + 512 * i, l = pc >> 5, c8 = pc & 31;
            const u32x4 xv = *(const LAS u32x4*)(XS + l * XS_LD + c8 * 8);
            const float f = FAC[l * 4 + (c8 >> 3)];
            u32x4 o;
#pragma unroll
            for (int e = 0; e < 4; ++e) o[e] = pk2(bf2f(xv[e] & 0xffffu) * f, bf2f(xv[e] >> 16) * f);
            *(LAS u32x4*)(XW + l * XS_LD + c8 * 8) = o;
        }
    }
    __syncthreads();
    typedef short v4i16 __attribute__((ext_vector_type(4)));
#define TR16(PTR) __builtin_amdgcn_ds_read_tr16_b64_v4i16((LAS v4i16*)(PTR))
#define CAT8(LO, HI) (bf16x8){LO[0], LO[1], LO[2], LO[3], HI[0], HI[1], HI[2], HI[3]}
    const int trr = fr >> 2, trc = 4 * (fr & 3);
#ifndef SKIP_E
    {
        const int h = wave >> 1, hh = g * 4 + h; const float dsk = d_skip[hh];
#pragma unroll 1
        for (int mq = 0; mq < 2; ++mq) {
            const int lt = 2 * (wave & 1) + mq;
            bf16x8 bmh[2];
#pragma unroll
            for (int ks = 0; ks < 2; ++ks) bmh[ks] = *(const LAS bf16x8*)(MH + (h * 64 + lt * 16 + fr) * MH_LD + ks * 32 + fq * 8);
#pragma unroll 1
            for (int pt = 0; pt < 4; ++pt) {
                f32x4 acc = {0.f, 0.f, 0.f, 0.f};
#pragma unroll
                for (int ks = 0; ks < 2; ++ks) {
                    const LAS bf16_t* bp = XS + (ks * 32 + 8 * fq + trr) * XS_LD + h * 64 + pt * 16 + trc;
                    const v4i16 lo = TR16(bp), hi = TR16(bp + 4 * XS_LD);
                    acc = mfma16(CAT8(lo, hi), bmh[ks], acc);
                }
                const int l = lt * 16 + fr, pp = pt * 16 + 4 * fq;
                const u32x2 xv = *(const LAS u32x2*)(XS + l * XS_LD + h * 64 + pp);
                u32x2 w;
                w.x = pk2(acc[0] + bf2f(xv.x & 0xffffu) * dsk, acc[1] + bf2f(xv.x >> 16) * dsk);
                w.y = pk2(acc[2] + bf2f(xv.y & 0xffffu) * dsk, acc[3] + bf2f(xv.y >> 16) * dsk);
                *(u32x2*)(ycat + (tbase + l) * DM + g * 256 + h * 64 + pp) = w;
            }
        }
    }
#endif
#ifndef SKIP_F
    {
        const int h = wave >> 1, hh = g * 4 + h;
        bf16_t* sbase = states + (((size_t)b * NCH + c) * 8 + hh) * 64 * 128;
#pragma unroll 1
        for (int mq = 0; mq < 2; ++mq) {
            const int mt = 2 * (wave & 1) + mq;
            bf16x8 xw[2];
#pragma unroll
            for (int ks = 0; ks < 2; ++ks) {
                const LAS bf16_t* bp = XW + (ks * 32 + 8 * fq + trr) * XS_LD + h * 64 + mt * 16 + trc;
                const v4i16 lo = TR16(bp), hi = TR16(bp + 4 * XS_LD);
                xw[ks] = CAT8(lo, hi);
            }
#pragma unroll 1
            for (int nt = 0; nt < 8; ++nt) {
                f32x4 acc = {0.f, 0.f, 0.f, 0.f};
#pragma unroll
                for (int ks = 0; ks < 2; ++ks) {
                    const LAS bf16_t* ap = BM + (ks * 32 + 8 * fq + trr) * BM_LD + nt * 16 + trc;
                    const v4i16 lo = TR16(ap), hi = TR16(ap + 4 * BM_LD);
                    acc = mfma16(CAT8(lo, hi), xw[ks], acc);
                }
                u32x2 w; w.x = pk2(acc[0], acc[1]); w.y = pk2(acc[2], acc[3]);
                *(u32x2*)(sbase + (size_t)(mt * 16 + fr) * 128 + nt * 16 + 4 * fq) = w;
            }
        }
    }
#undef TR16
#undef CAT8
#endif
    __syncthreads();
}

__device__ __forceinline__ void phase2(const Params& p, Ctx& F) {
#if defined(PROBE_PHASE) && (PROBE_PHASE == 20 || PROBE_PHASE == 21)
    F.ta = __builtin_amdgcn_s_memrealtime();
#endif
#ifdef USE_QK_PREPASS
    p2_qk_prepass(p, F);
#endif
#if defined(PROBE_PHASE) && (PROBE_PHASE == 20 || PROBE_PHASE == 21)
    VM_WAIT(); F.tb = __builtin_amdgcn_s_memrealtime();
#endif
    {
        const bf16_t* proj = (const bf16_t*)(p.ws + WS_PROJ);
        u32x4 rv[11];
        if (F.vcu < NB * NCH * 2) p2_load_raw(proj, F.tid, F.vcu >> 7, (F.vcu >> 1) & 63, F.vcu & 1, rv);
        for (int u = F.vcu; u < NB * NCH * 2; u += F.G) {
            const int g = u & 1, c = (u >> 1) & 63, b = u >> 7;
            const int un = u + F.G;
            p2_ssd_unit(p, F, b, c, g, rv, un < NB * NCH * 2, un >> 7, (un >> 1) & 63, un & 1);
        }
    }
#if defined(PROBE_PHASE) && (PROBE_PHASE == 20 || PROBE_PHASE == 21)
    VM_WAIT(); F.tc = __builtin_amdgcn_s_memrealtime();
#endif
}

__device__ __forceinline__ void p3_scan(const Params& p, Ctx& F) {
    bf16_t* states = (bf16_t*)(p.ws + WS_STATES); const float* cdec = (const float*)(p.ws + WS_CDEC);
    const int gtid = F.vcu * 512 + F.tid, nthr = F.G * 512;
    for (int e = gtid; e < NB * 8 * 64 * 32; e += nthr) {
        const int n4 = e & 31, pp = (e >> 5) & 63, hh = (e >> 11) & 7, b = e >> 14;
        f32x4 carry = {0.f, 0.f, 0.f, 0.f};
        for (int c0 = 0; c0 < NCH; c0 += 16) {
            u32x2 s[16]; float dc[16];
#pragma unroll
            for (int i = 0; i < 16; ++i) {
                s[i] = *(const u32x2*)(states + ((((size_t)b * NCH + c0 + i) * 8 + hh) * 64 + pp) * 128 + n4 * 4);
                dc[i] = cdec[((size_t)b * NCH + c0 + i) * 8 + hh];
            }
#pragma unroll
            for (int i = 0; i < 16; ++i) {
                u32x2 w; w.x = pk2(carry[0], carry[1]); w.y = pk2(carry[2], carry[3]);
                *(u32x2*)(states + ((((size_t)b * NCH + c0 + i) * 8 + hh) * 64 + pp) * 128 + n4 * 4) = w;
                const f32x4 sv = {bf2f(s[i].x & 0xffffu), bf2f(s[i].x >> 16), bf2f(s[i].y & 0xffffu), bf2f(s[i].y >> 16)};
                carry = carry * dc[i] + sv;
            }
        }
    }
}

namespace att {
constexpr int NW = 8, QBLK = 32, KVBLK = 64;
constexpr float SCALE = 0.125f, THR = 8.f;
constexpr int SHM_V = KVBLK * 128 * 2, SHM_K = KVBLK * 64 * 2;
constexpr int LDS_V = 0, LDS_K = 2 * SHM_V, LDS_WS = LDS_K + 2 * SHM_K, LDS_END = LDS_WS + NW * 64 * 4;
#define KSWZ64(row, colB) ((row) * 128 + ((colB) ^ ((((row) >> 1) & 7) << 4)))
#define SBAR() __builtin_amdgcn_sched_barrier(0)
__device__ __forceinline__ int crow(int r, int hi) { return (r & 3) + 8 * (r >> 2) + 4 * hi; }
__device__ __forceinline__ unsigned cvtpk(float lo, float hi) { unsigned r; asm volatile("v_cvt_pk_bf16_f32 %0, %1, %2" : "=v"(r) : "v"(lo), "v"(hi)); return r; }

__device__ __forceinline__ void partialSM(f32x16& p0, f32x16& p1, float& m_reg, float& mn, float& alpha) {
    constexpr float C = SCALE * 1.4426950408889634f;
    float pmax = p0[0];
#pragma unroll
    for (int r = 1; r < 16; ++r) pmax = fmaxf(pmax, p0[r]);
#pragma unroll
    for (int r = 0; r < 16; ++r) pmax = fmaxf(pmax, p1[r]);
    { auto rr = __builtin_amdgcn_permlane32_swap(__float_as_uint(pmax), __float_as_uint(pmax), false, false);
      pmax = fmaxf(__uint_as_float(rr[0]), __uint_as_float(rr[1])); }
    if (__builtin_expect(__all(pmax - m_reg <= THR / SCALE), 1)) { mn = m_reg; alpha = 1.f; }
    else { mn = fmaxf(m_reg, pmax); alpha = __builtin_amdgcn_exp2f((m_reg - mn) * C); m_reg = mn; }
    const float mnC = -mn * C;
#pragma unroll
    for (int r = 0; r < 16; ++r) p0[r] = fmaf(p0[r], C, mnC);
#pragma unroll
    for (int r = 0; r < 16; ++r) p1[r] = fmaf(p1[r], C, mnC);
#pragma unroll
    for (int r = 0; r < 16; ++r) p0[r] = __builtin_amdgcn_exp2f(p0[r]);
}
__device__ __forceinline__ void finishSM(f32x16& p0, f32x16& p1, float alpha, float& l_reg, bf16x8& pa0, bf16x8& pa1, bf16x8& pa2, bf16x8& pa3) {
#pragma unroll
    for (int r = 0; r < 16; ++r) p1[r] = __builtin_amdgcn_exp2f(p1[r]);
    float ps = 0;
#pragma unroll
    for (int r = 0; r < 16; ++r) ps += p0[r];
#pragma unroll
    for (int r = 0; r < 16; ++r) ps += p1[r];
    { auto rr = __builtin_amdgcn_permlane32_swap(__float_as_uint(ps), __float_as_uint(ps), false, false);
      ps = __uint_as_float(rr[0]) + __uint_as_float(rr[1]); }
    l_reg = l_reg * alpha + ps;
#define PK4(P, BASE, OUT) do { unsigned a0 = cvtpk(P[BASE + 0], P[BASE + 1]), a1 = cvtpk(P[BASE + 2], P[BASE + 3]);   \
    unsigned b0 = cvtpk(P[BASE + 4], P[BASE + 5]), b1 = cvtpk(P[BASE + 6], P[BASE + 7]);                              \
    auto r0 = __builtin_amdgcn_permlane32_swap(a0, b0, false, false); auto r1 = __builtin_amdgcn_permlane32_swap(a1, b1, false, false); \
    u32x4 w = {r0[0], r1[0], r0[1], r1[1]}; OUT = *reinterpret_cast<bf16x8*>(&w); } while (0)
    PK4(p0, 0, pa0); PK4(p0, 8, pa1); PK4(p1, 0, pa2); PK4(p1, 8, pa3);
#undef PK4
}
__device__ __forceinline__ void qkt(f32x16& p0, f32x16& p1, const char* Ks, const bf16x8* qr, int r32, int hi) {
    p0 = f32x16{}; p1 = f32x16{};
#pragma unroll
    for (int d0 = 0; d0 < 4; ++d0) {
        const int cb = (d0 * 16 + hi * 8) * 2;
        const bf16x8 b0 = *reinterpret_cast<const bf16x8*>(Ks + KSWZ64(r32, cb));
        const bf16x8 b1 = *reinterpret_cast<const bf16x8*>(Ks + KSWZ64(32 + r32, cb));
        p0 = mfma32(b0, qr[d0], p0);
        p1 = mfma32(b1, qr[d0], p1);
    }
}
__device__ __forceinline__ void maskfill(f32x16& p0, f32x16& p1, bool m) {
    if (m) {
        asm volatile("; masked tile");
#pragma unroll
        for (int r = 0; r < 16; ++r) { p0[r] = -1e30f; p1[r] = -1e30f; }
    }
}
__device__ __forceinline__ int v_st(int k, int c) { const int kk = (k & ~0xC) | ((k & 4) << 1) | ((k & 8) >> 1); return ((kk >> 3) * 4 + (c >> 5)) * 512 + ((kk & 7) * 32 + (c & 31)) * 2; }
__device__ __forceinline__ int v_rd_base(int lane) { return ((lane & 3) << 3) | (((lane >> 2) & 3) << 6) | (((lane >> 4) & 1) << 5) | (((lane >> 5) & 1) << 8); }
constexpr int v_rd_off(int d0, int ks, int half) { return d0 * 512 + ks * 4096 + half * 2048; }
template <int OFF> __device__ __forceinline__ s16x4 tr_read(int vb) {
    s16x4 r; asm volatile("ds_read_b64_tr_b16 %0, %1 offset:%2" : "=&v"(r) : "v"(vb), "i"(OFF) : "memory"); return r;
}
template <int D0> __device__ __forceinline__ void pv_one(f32x16& od, int vb, bf16x8 pa0, bf16x8 pa1, bf16x8 pa2, bf16x8 pa3) {
    const s16x4 l0 = tr_read<v_rd_off(D0, 0, 0)>(vb), h0 = tr_read<v_rd_off(D0, 0, 1)>(vb), l1 = tr_read<v_rd_off(D0, 1, 0)>(vb), h1 = tr_read<v_rd_off(D0, 1, 1)>(vb);
    const s16x4 l2 = tr_read<v_rd_off(D0, 2, 0)>(vb), h2 = tr_read<v_rd_off(D0, 2, 1)>(vb), l3 = tr_read<v_rd_off(D0, 3, 0)>(vb), h3 = tr_read<v_rd_off(D0, 3, 1)>(vb);
    asm volatile("s_waitcnt lgkmcnt(0)" ::: "memory"); SBAR();
#define PKV(L, H) (bf16x8){L[0], L[1], L[2], L[3], H[0], H[1], H[2], H[3]}
    od = mfma32(pa0, PKV(l0, h0), od);
    od = mfma32(pa1, PKV(l1, h1), od);
    od = mfma32(pa2, PKV(l2, h2), od);
    od = mfma32(pa3, PKV(l3, h3), od);
#undef PKV
}
__device__ __forceinline__ void pv_d0(f32x16* o, int vb, bf16x8 pa0, bf16x8 pa1, bf16x8 pa2, bf16x8 pa3) {
    pv_one<0>(o[0], vb, pa0, pa1, pa2, pa3); pv_one<1>(o[1], vb, pa0, pa1, pa2, pa3); pv_one<2>(o[2], vb, pa0, pa1, pa2, pa3); pv_one<3>(o[3], vb, pa0, pa1, pa2, pa3);
}

__device__ __forceinline__ void attn_pass(const bf16_t* __restrict__ Qb, const bf16_t* __restrict__ Kh, const bf16_t* __restrict__ Vh, int NT, int my_last, char* lds, f32x16 (&o)[4]) {
    const int tid = threadIdx.x, wid = tid >> 6, lane = tid & 63, r32 = lane & 31, hi = lane >> 5;
    char* V_lds = lds + LDS_V; char* K_lds = lds + LDS_K;
    float* wsf = (float*)(lds + LDS_WS) + wid * 64; float* li_l = wsf; float* al_l = wsf + 32;
    float m_reg = -1e30f, l_reg = 0.f;
#pragma unroll
    for (int d = 0; d < 4; ++d) o[d] = f32x16{};
    bf16x8 qr[4];
    const bf16_t* Qw = Qb + (size_t)(wid * QBLK + r32) * NIN + hi * 8;
#pragma unroll
    for (int d0 = 0; d0 < 4; ++d0) qr[d0] = *reinterpret_cast<const bf16x8*>(Qw + d0 * 16);
    const int sr = tid >> 4, sc = (tid & 15) * 8, vst0 = v_st(sr, sc), vst1 = v_st(32 + sr, sc);
    const int krow = tid >> 3, kc8 = (tid & 7) * 8, kst = KSWZ64(krow, kc8 * 2);
    const int vb0 = (int)(uintptr_t)V_lds + v_rd_base(lane);
    struct { bf16x8 vs0, vs1, ks; } sr_[2];
#define SLOAD(i, k0) do { sr_[i].vs0 = *reinterpret_cast<const bf16x8*>(&Vh[(size_t)((k0) + sr) * NIN + sc]); sr_[i].vs1 = *reinterpret_cast<const bf16x8*>(&Vh[(size_t)((k0) + 32 + sr) * NIN + sc]); \
    sr_[i].ks = *reinterpret_cast<const bf16x8*>(&Kh[(size_t)((k0) + krow) * NIN + kc8]); } while (0)
#define SWRITE(b, i) do { *(bf16x8*)(V_lds + (b) * SHM_V + vst0) = sr_[i].vs0; *(bf16x8*)(V_lds + (b) * SHM_V + vst1) = sr_[i].vs1; \
    *(bf16x8*)(K_lds + (b) * SHM_K + kst) = sr_[i].ks; } while (0)
#define SWAIT() asm volatile("s_waitcnt vmcnt(3)" ::: "memory")
#define RESC(a) do { if (__any((a) < 1.f)) { if (hi == 0) al_l[r32] = (a); asm volatile("s_waitcnt lgkmcnt(0)" ::: "memory"); \
    _Pragma("unroll") for (int d = 0; d < 4; ++d) _Pragma("unroll") for (int r = 0; r < 16; ++r) o[d][r] *= al_l[crow(r, hi)]; } } while (0)
    f32x16 pA0, pA1, pB0, pB1; float mnA, mnB, alA, alB; bf16x8 pa0, pa1, pa2, pa3;
    constexpr int SE = 0, SO = 1;
    __syncthreads();
    SLOAD(SE, 0); asm volatile("s_waitcnt vmcnt(0)" ::: "memory"); SWRITE(0, SE); __syncthreads();
    qkt(pA0, pA1, K_lds, qr, r32, hi); partialSM(pA0, pA1, m_reg, mnA, alA);
    SLOAD(SO, KVBLK); if (2 < NT) SLOAD(SE, 2 * KVBLK);
    SWAIT(); SWRITE(1, SO); __syncthreads();
    for (int j = 1; j + 1 < NT; j += 2) {
        qkt(pB0, pB1, K_lds + SHM_K, qr, r32, hi); maskfill(pB0, pB1, j > my_last);
        finishSM(pA0, pA1, alA, l_reg, pa0, pa1, pa2, pa3);
        SLOAD(SO, (j + 2) * KVBLK);
        pv_d0(o, vb0, pa0, pa1, pa2, pa3); partialSM(pB0, pB1, m_reg, mnB, alB);
        __syncthreads(); SWAIT(); SWRITE(0, SE);
        RESC(alB); __syncthreads();
        qkt(pA0, pA1, K_lds, qr, r32, hi); maskfill(pA0, pA1, j + 1 > my_last);
        finishSM(pB0, pB1, alB, l_reg, pa0, pa1, pa2, pa3);
        if (j + 3 < NT) SLOAD(SE, (j + 3) * KVBLK);
        pv_d0(o, vb0 + SHM_V, pa0, pa1, pa2, pa3); partialSM(pA0, pA1, m_reg, mnA, alA);
        __syncthreads(); SWAIT(); SWRITE(1, SO);
        RESC(alA); __syncthreads();
    }
    SBAR(); qkt(pB0, pB1, K_lds + SHM_K, qr, r32, hi); maskfill(pB0, pB1, NT - 1 > my_last);
    finishSM(pA0, pA1, alA, l_reg, pa0, pa1, pa2, pa3); SBAR();
    pv_d0(o, vb0, pa0, pa1, pa2, pa3); partialSM(pB0, pB1, m_reg, mnB, alB);
    __syncthreads(); RESC(alB);
    finishSM(pB0, pB1, alB, l_reg, pa0, pa1, pa2, pa3); SBAR();
    pv_d0(o, vb0 + SHM_V, pa0, pa1, pa2, pa3);
    if (hi == 0) li_l[r32] = l_reg;
    asm volatile("s_waitcnt lgkmcnt(0)" ::: "memory");
#pragma unroll
    for (int r = 0; r < 16; ++r) {
        const float rl = __builtin_amdgcn_rcpf(li_l[crow(r, hi)]);
#pragma unroll
        for (int d = 0; d < 4; ++d) o[d][r] *= rl;
    }
    asm volatile("s_waitcnt vmcnt(0)" ::: "memory");
    __syncthreads();
#undef SLOAD
#undef SWRITE
#undef SWAIT
#undef RESC
}
}

__device__ __forceinline__ void p3_attn_unit(const Params& p, Ctx& F, int b, int h, int qb, float* oscr) {
    const bf16_t* proj = (const bf16_t*)(p.ws + WS_PROJ);
    bf16_t* ycat = (bf16_t*)(p.ws + WS_YCAT);
    const float lam = ((const float*)(p.ws + WS_MISC))[0];
    const float* subw = p.in[15];
    const int tid = F.tid, wid = F.wave, lane = F.lane, r32 = lane & 31, hi = lane >> 5;
    const size_t rowbase = (size_t)b * SEQ; const int q0 = qb * 256;
    const int NT = (q0 + 256) / 64, my_last = (q0 + 32 * wid) / 64;
    f32x16 o[4];
    for (int j = 0; j < 2; ++j) {
        const bf16_t* Qb = proj + (rowbase + q0) * NIN + PQ + h * 128 + j * 64;
        const bf16_t* Kh = proj + rowbase * NIN + PK + h * 128 + j * 64;
        const bf16_t* Vh = proj + rowbase * NIN + PV + h * 128;
        att::attn_pass(Qb, Kh, Vh, NT, my_last, (char*)F.lds, o);
        if (j == 0) {
            float* my = oscr + tid * 64;
#pragma unroll
            for (int d = 0; d < 4; ++d)
#pragma unroll
                for (int r4 = 0; r4 < 4; ++r4) *(f32x4*)(my + d * 16 + r4 * 4) = (f32x4){o[d][4 * r4], o[d][4 * r4 + 1], o[d][4 * r4 + 2], o[d][4 * r4 + 3]};
        }
    }
    float wv[4];
#pragma unroll
    for (int d = 0; d < 4; ++d) wv[d] = subw[d * 32 + r32] * (1.f - LAMBDA_INIT);
#pragma unroll
    for (int r = 0; r < 16; ++r) {
        float v[4]; float ss = 0.f;
#pragma unroll
        for (int d = 0; d < 4; ++d) { v[d] = oscr[tid * 64 + d * 16 + r] - lam * o[d][r]; ss += v[d] * v[d]; }
        ss += __shfl_xor(ss, 1); ss += __shfl_xor(ss, 2); ss += __shfl_xor(ss, 4); ss += __shfl_xor(ss, 8); ss += __shfl_xor(ss, 16);
        const float rs = rsqrtf(ss * (1.f / 128.f) + EPSN);
        const size_t row = rowbase + q0 + wid * 32 + att::crow(r, hi);
#pragma unroll
        for (int d = 0; d < 4; ++d) ycat[row * DM + 512 + h * 128 + d * 32 + r32] = (bf16_t)f2bf(v[d] * rs * wv[d]);
    }
}

__device__ __forceinline__ void phase3(const Params& p, Ctx& F) {
#ifndef NO_SCAN
    p3_scan(p, F);
#endif
    float* oscr = p.out + (size_t)F.vcu * (64 * 512);
    for (int ui = F.vcu; ui < 512; ui += F.G) {
        const int pi = ui & 255, bh = pi >> 3, s = pi & 7, b = bh >> 2, h = bh & 3;
        p3_attn_unit(p, F, b, h, ui < 256 ? 15 - s : s, oscr);
    }
}

constexpr int P4_PREV = 0, P4_CM = 69632, P4_ACS = 87040, P4_Y = 88064, Y_LD = 257;
static_assert(P4_Y + 64 * Y_LD * 4 <= LDS_BYTES, "P4 LDS");
__device__ __forceinline__ void p4_load(const bf16_t* states, const bf16_t* cmc, int tid, int b, int c, int g, u32x4 (&pv)[8], u32x4 (&cv)[2]) {
    const size_t tbase = (size_t)b * SEQ + (size_t)c * CHUNK;
#pragma unroll
    for (int i = 0; i < 8; ++i) {
        const int e = tid + 512 * i, n8 = e & 15, pp = (e >> 4) & 63, h = e >> 10;
        pv[i] = *(const u32x4*)(states + ((((size_t)b * NCH + c) * 8 + g * 4 + h) * 64 + pp) * 128 + n8 * 8);
    }
#pragma unroll
    for (int i = 0; i < 2; ++i) {
        const int e = tid + 512 * i, l = e >> 4, c8 = e & 15;
        cv[i] = *(const u32x4*)(cmc + (tbase + l) * 256 + g * 128 + c8 * 8);
    }
}
__device__ __forceinline__ void p4_unit(const Params& p, Ctx& F, int b, int c, int g, u32x4 (&pv)[8], u32x4 (&cv)[2], bool has_next, int nb, int nc, int ng) {
    unsigned char* ws = p.ws;
    const bf16_t* proj = (const bf16_t*)(ws + WS_PROJ);
    bf16_t* ycat = (bf16_t*)(ws + WS_YCAT); const bf16_t* cmc = (const bf16_t*)(ws + WS_CMC);
    const bf16_t* states = (const bf16_t*)(ws + WS_STATES); const float* acs_g = (const float*)(ws + WS_ACS);
    const float* normw = p.in[8];
    LAS bf16_t* PREV = (LAS bf16_t*)(F.lds + P4_PREV); LAS bf16_t* CM = (LAS bf16_t*)(F.lds + P4_CM);
    LAS float* ACS = (LAS float*)(F.lds + P4_ACS); LAS float* Y = (LAS float*)(F.lds + P4_Y);
    const int tid = F.tid, lane = F.lane, wave = F.wave, fr = lane & 15, fq = lane >> 4;
    const size_t tbase = (size_t)b * SEQ + (size_t)c * CHUNK;
#pragma unroll
    for (int i = 0; i < 8; ++i) {
        const int e = tid + 512 * i, n8 = e & 15, pp = (e >> 4) & 63, h = e >> 10;
        *(LAS u32x4*)(PREV + (h * 64 + pp) * BM_LD + n8 * 8) = pv[i];
    }
#pragma unroll
    for (int i = 0; i < 2; ++i) {
        const int e = tid + 512 * i, l = e >> 4, c8 = e & 15;
        *(LAS u32x4*)(CM + l * BM_LD + c8 * 8) = cv[i];
    }
    if (has_next) p4_load(states, cmc, tid, nb, nc, ng, pv, cv);
    if (tid < 256) { const int l = tid >> 2, h = tid & 3; ACS[l * 4 + h] = acs_g[(tbase + l) * 8 + g * 4 + h]; }
    __syncthreads();
    {
        const int h = wave >> 1;
#pragma unroll
        for (int mq = 0; mq < 2; ++mq) {
            const int mt = 2 * (wave & 1) + mq;
            bf16x8 a[4];
#pragma unroll
            for (int ks = 0; ks < 4; ++ks) a[ks] = *(const LAS bf16x8*)(CM + (mt * 16 + fr) * BM_LD + ks * 32 + fq * 8);
#pragma unroll
            for (int nt = 0; nt < 4; ++nt) {
                f32x4 acc = {0.f, 0.f, 0.f, 0.f};
#pragma unroll
                for (int ks = 0; ks < 4; ++ks) {
                    const bf16x8 bq = *(const LAS bf16x8*)(PREV + (h * 64 + nt * 16 + fr) * BM_LD + ks * 32 + fq * 8);
                    acc = mfma16(a[ks], bq, acc);
                }
#pragma unroll
                for (int j = 0; j < 4; ++j) {
                    const int l = mt * 16 + 4 * fq + j, col = h * 64 + nt * 16 + fr;
                    Y[l * Y_LD + col] = acc[j] * __expf(ACS[l * 4 + h]);
                }
            }
        }
    }
    __syncthreads();
    {
        const int c8 = lane & 31, hr = lane >> 5;
        const f32x4 nw0 = *(const f32x4*)(normw + g * 256 + c8 * 8), nw1 = *(const f32x4*)(normw + g * 256 + c8 * 8 + 4);
#pragma unroll 2
        for (int r = 0; r < 4; ++r) {
            const int l = wave * 8 + r * 2 + hr;
            const size_t t = tbase + l;
            const u32x4 yl = *(const u32x4*)(ycat + t * DM + g * 256 + c8 * 8);
            const u32x4 zz = *(const u32x4*)(proj + t * NIN + PZ + g * 256 + c8 * 8);
            float v[8]; float ss = 0.f;
#pragma unroll
            for (int e = 0; e < 4; ++e) {
                const float y0 = bf2f(yl[e] & 0xffffu) + Y[l * Y_LD + c8 * 8 + 2 * e], y1 = bf2f(yl[e] >> 16) + Y[l * Y_LD + c8 * 8 + 2 * e + 1];
                v[2 * e] = y0 * silu_f(bf2f(zz[e] & 0xffffu)); v[2 * e + 1] = y1 * silu_f(bf2f(zz[e] >> 16));
                ss += v[2 * e] * v[2 * e] + v[2 * e + 1] * v[2 * e + 1];
            }
            ss += __shfl_xor(ss, 1); ss += __shfl_xor(ss, 2); ss += __shfl_xor(ss, 4); ss += __shfl_xor(ss, 8); ss += __shfl_xor(ss, 16);
            const float rs = rsqrtf(ss * (1.f / 256.f) + EPSN);
            u32x4 o;
            o.x = pk2(v[0] * rs * nw0[0], v[1] * rs * nw0[1]); o.y = pk2(v[2] * rs * nw0[2], v[3] * rs * nw0[3]);
            o.z = pk2(v[4] * rs * nw1[0], v[5] * rs * nw1[1]); o.w = pk2(v[6] * rs * nw1[2], v[7] * rs * nw1[3]);
            *(u32x4*)(ycat + t * DM + g * 256 + c8 * 8) = o;
        }
    }
    __syncthreads();
}
__device__ __forceinline__ void phase4(const Params& p, Ctx& F) {
    const bf16_t* states = (const bf16_t*)(p.ws + WS_STATES); const bf16_t* cmc = (const bf16_t*)(p.ws + WS_CMC);
    u32x4 pv[8], cv[2];
    if (F.vcu < NB * NCH * 2) p4_load(states, cmc, F.tid, F.vcu >> 7, (F.vcu >> 1) & 63, F.vcu & 1, pv, cv);
    for (int u = F.vcu; u < NB * NCH * 2; u += F.G) {
        const int g = u & 1, c = (u >> 1) & 63, b = u >> 7;
        const int un = u + F.G;
        p4_unit(p, F, b, c, g, pv, cv, un < NB * NCH * 2, un >> 7, (un >> 1) & 63, un & 1);
    }
}

__device__ __forceinline__ unsigned f2ord(float f) { const unsigned u = __float_as_uint(f); return (u >> 31) ? ~u : (u | 0x80000000u); }
__device__ __forceinline__ float ord2f(unsigned u) { return __uint_as_float((u >> 31) ? (u & 0x7fffffffu) : ~u); }
#define CE_DESC(A, B) do { const unsigned hi_ = (A) > (B) ? (A) : (B); const unsigned lo_ = (A) > (B) ? (B) : (A); (A) = hi_; (B) = lo_; } while (0)
template <int K, int J> __device__ __forceinline__ void bstage(unsigned (&r)[16]) {
#pragma unroll
    for (int i = 0; i < 16; ++i) { const int l = i ^ J; if (l > i) { if ((i & K) == 0) CE_DESC(r[i], r[l]); else CE_DESC(r[l], r[i]); } }
}
__device__ __forceinline__ void bitonic_merge16(unsigned (&r)[16]) { bstage<16, 8>(r); bstage<16, 4>(r); bstage<16, 2>(r); bstage<16, 1>(r); }
__device__ __forceinline__ void bitonic_sort16(unsigned (&r)[16]) {
    bstage<2, 1>(r); bstage<4, 2>(r); bstage<4, 1>(r); bstage<8, 4>(r); bstage<8, 2>(r); bstage<8, 1>(r); bitonic_merge16(r);
}
__device__ __forceinline__ void top16_merge(unsigned (&r)[16], const unsigned (&n)[16]) {
#pragma unroll
    for (int i = 0; i < 16; ++i) r[i] = r[i] > n[15 - i] ? r[i] : n[15 - i];
    bitonic_merge16(r);
}
__device__ __forceinline__ void top16_merge_lane(unsigned (&r)[16], int xm) {
    unsigned n[16];
#pragma unroll
    for (int i = 0; i < 16; ++i) n[i] = (unsigned)__shfl_xor((int)r[i], xm);
    top16_merge(r, n);
}
__device__ __forceinline__ void p7_cand_table(LAS unsigned char* CAND, int tid) {
    if (tid < 52) {
        int c = 0; unsigned char v = 255;
        for (int a = 0; a < 16; ++a) for (int b = 0; b < 16 / (a + 1); ++b) { if (c == tid) v = (unsigned char)(a * 16 + b); ++c; }
        CAND[tid] = v;
    }
}
__device__ __forceinline__ void route16(const bf16_t* qp, const float* rowsq, float* gwo, size_t t0, int lane, LAS unsigned* lists, const LAS unsigned char* CAND, LAS unsigned short* IDX) {
    const int tok = lane >> 2, part = lane & 3;
    const float r2 = rsqrtf(rowsq[t0 + tok] * (1.f / DM) + EPSN);
#pragma unroll 1
    for (int h = 0; h < 8; ++h) {
        u32x4 raw[2][4];
#pragma unroll
        for (int j = 0; j < 2; ++j)
#pragma unroll
            for (int q = 0; q < 4; ++q) raw[j][q] = __builtin_nontemporal_load((const u32x4*)(qp + (t0 + tok) * 2048 + h * 256 + j * 128 + part * 32 + q * 8));
#pragma unroll
        for (int j = 0; j < 2; ++j) {
            unsigned r[16], n[16];
#pragma unroll
            for (int q = 0; q < 2; ++q)
#pragma unroll
                for (int e = 0; e < 4; ++e) {
                    r[q * 8 + 2 * e]     = (f2ord(bf2f(raw[j][q][e] & 0xffffu) * r2) & ~127u) | (unsigned)(part * 32 + q * 8 + 2 * e);
                    r[q * 8 + 2 * e + 1] = (f2ord(bf2f(raw[j][q][e] >> 16) * r2) & ~127u) | (unsigned)(part * 32 + q * 8 + 2 * e + 1);
                    n[q * 8 + 2 * e]     = (f2ord(bf2f(raw[j][2 + q][e] & 0xffffu) * r2) & ~127u) | (unsigned)(part * 32 + 16 + q * 8 + 2 * e);
                    n[q * 8 + 2 * e + 1] = (f2ord(bf2f(raw[j][2 + q][e] >> 16) * r2) & ~127u) | (unsigned)(part * 32 + 16 + q * 8 + 2 * e + 1);
                }
            bitonic_sort16(r); bitonic_sort16(n);
            top16_merge(r, n);
            top16_merge_lane(r, 1);
            top16_merge_lane(r, 2);
            if (part == 0) {
#pragma unroll
                for (int k = 0; k < 16; ++k) lists[(tok * 2 + j) * 16 + k] = r[k];
            }
        }
        LDS_WAIT(); __builtin_amdgcn_wave_barrier();
        {
            const LAS unsigned* l0 = lists + (2 * tok) * 16; const LAS unsigned* l1 = lists + (2 * tok + 1) * 16;
            unsigned r[16];
#pragma unroll
            for (int m = 0; m < 13; ++m) {
                const unsigned ab = CAND[part + 4 * m];
                const unsigned a = (ab >> 4) & 15u, bb = ab & 15u;
                const float sum = ord2f(l0[a] & ~127u) + ord2f(l1[bb] & ~127u);
                r[m] = ab == 255u ? 0u : ((f2ord(sum) & ~255u) | ab);
            }
            r[13] = 0u; r[14] = 0u; r[15] = 0u;
            bitonic_sort16(r);
            top16_merge_lane(r, 1);
            top16_merge_lane(r, 2);
            float val[16]; unsigned ex[16]; float mx = -1e30f;
#pragma unroll
            for (int k = 0; k < 16; ++k) {
                const unsigned pos = r[k] & 255u, a = pos >> 4, bb = pos & 15u;
                const unsigned w0 = l0[a], w1 = l1[bb];
                ex[k] = (w0 & 127u) * 128u + (w1 & 127u);
                val[k] = ord2f(w0 & ~127u) + ord2f(w1 & ~127u);
                mx = fmaxf(mx, val[k]);
            }
            float sum = 0.f;
#pragma unroll
            for (int k = 0; k < 16; ++k) { val[k] = __expf(val[k] - mx); sum += val[k]; }
            const float inv = 1.f / sum;
            float* go = gwo + ((t0 + tok) * 8 + h) * 16;
            if (part == 0) {
#pragma unroll
                for (int k = 0; k < 16; ++k) { IDX[tok * 128 + h * 16 + k] = (unsigned short)ex[k]; go[k] = val[k] * inv; }
            }
        }
        LDS_WAIT(); __builtin_amdgcn_wave_barrier();
    }
}

constexpr int PACE_WORDS = 32 * 16 * 16;
__device__ __forceinline__ void xcd_pace(const XcdBarrier& b, int slot) {
    __syncthreads();
    if (threadIdx.x == 0) {
        const unsigned nloc = b.st[0];
        unsigned* w = b.bar + XCD_BAR_WORDS + (slot * 16 + (int)b.x) * 16;
        (void)xb_add(w, 1u);
        unsigned sp = 0;
        while (xb_ld(w) < nloc && ++sp < 3000u) __builtin_amdgcn_s_sleep(1);
    }
    __syncthreads();
}
__device__ __forceinline__ float gelu_erf(float x) { return 0.5f * x * (1.f + erff(x * 0.70710678118654752f)); }
typedef float f32x2 __attribute__((ext_vector_type(2)));
constexpr int P8_NSL = 8, P8_SLC = DM / P8_NSL, P8_KS = P8_SLC / 32;
constexpr float P8_XS = 32.f;
static_assert(P8_SLC == 128, "lane mappings assume 128-column (128-byte) slices");
__device__ __forceinline__ void phase8(const Params& p, Ctx& F, const XcdBarrier& bar) {
    const bool pace = false;
    unsigned char* ws = p.ws;
    const unsigned char* uq = ws + WS_UB; const unsigned char* vq = ws + WS_VB;
    const float* rsu = (const float*)(ws + WS_RSU); const float* rsv = (const float*)(ws + WS_RSV);
    const bf16_t* x1b = (const bf16_t*)(ws + WS_X1B);
    const float* rowsq = (const float*)(ws + WS_CTL) + CW_ROWSQ;
    const float* gwi = (const float*)(ws + WS_GW);
    float* out = p.out;
    const int lane = F.lane, fr = lane & 15, fq = lane >> 4;
    LAS unsigned short* IDX = (LAS unsigned short*)(F.lds + F.wave * 20480);
    LAS float* COEF = (LAS float*)(F.lds + F.wave * 20480 + 4096);
    LAS unsigned char* STG = (LAS unsigned char*)COEF;
    LAS unsigned char* CAND = STG + 2048;
    __syncthreads();
    p7_cand_table(CAND, lane);
    LDS_WAIT(); __builtin_amdgcn_wave_barrier();
    for (int task = F.gw; task < TOK / 16; task += F.ngw) {
        const size_t t0 = (size_t)task * 16;
        route16((const bf16_t*)(ws + WS_QP), rowsq, (float*)(ws + WS_GW), t0, lane, (LAS unsigned*)STG, CAND, IDX);
        const float r2 = rsqrtf(rowsq[t0 + fr] * (1.f / DM) + EPSN);
        VM_WAIT(); LDS_WAIT(); __builtin_amdgcn_wave_barrier();
#if defined(PROBE_PHASE) && PROBE_PHASE >= 80
        F.ta = __builtin_amdgcn_s_memrealtime();
#endif
        f32x4 accU[8];
#pragma unroll
        for (int h = 0; h < 8; ++h) accU[h] = (f32x4){0.f, 0.f, 0.f, 0.f};
        const int lrow = lane >> 3, lch = lane & 7;
        const int wofs0 = lrow * 128 + ((lch ^ (lrow & 7)) << 4), wofs1 = wofs0 + 1024;
        const float xsc = r2 * P8_XS;
#ifdef U_FP4
        typedef int v8i __attribute__((ext_vector_type(8)));
        int rofs4[2];
#pragma unroll
        for (int m = 0; m < 2; ++m) rofs4[m] = fr * 128 + (((4 * m + fq) ^ (fr & 7)) << 4);
#pragma unroll 1
        for (int sl = 0; sl < 4; ++sl) {
            v8i xf[2];
#pragma unroll
            for (int m = 0; m < 2; ++m) {
                const bf16_t* xp = x1b + (t0 + fr) * DM + sl * 256 + 128 * m + 16 * fq;
#pragma unroll
                for (int q = 0; q < 4; ++q) {
                    const u32x4 xv = *(const u32x4*)(xp + 64 * (q >> 1) + 8 * (q & 1));
                    int lo = 0, hi = 0;
                    lo = __builtin_amdgcn_cvt_pk_fp8_f32(bf2f(xv[0] & 0xffffu) * xsc, bf2f(xv[0] >> 16) * xsc, lo, false);
                    lo = __builtin_amdgcn_cvt_pk_fp8_f32(bf2f(xv[1] & 0xffffu) * xsc, bf2f(xv[1] >> 16) * xsc, lo, true);
                    hi = __builtin_amdgcn_cvt_pk_fp8_f32(bf2f(xv[2] & 0xffffu) * xsc, bf2f(xv[2] >> 16) * xsc, hi, false);
                    hi = __builtin_amdgcn_cvt_pk_fp8_f32(bf2f(xv[3] & 0xffffu) * xsc, bf2f(xv[3] >> 16) * xsc, hi, true);
                    xf[m][2 * q] = lo; xf[m][2 * q + 1] = hi;
                }
            }
            const unsigned char* ubs = uq + sl * 128 + lch * 16;
#pragma unroll 1
            for (int j0 = 0; j0 < 16; ++j0) {
                const bool mine = (fr == j0);
                v8i bm[2];
#pragma unroll
                for (int m = 0; m < 2; ++m)
#pragma unroll
                    for (int q = 0; q < 8; ++q) bm[m][q] = mine ? xf[m][q] : 0;
                u32x4 g0[8], g1[8];
#pragma unroll
                for (int h = 0; h < 8; ++h) {
                    const unsigned e0 = IDX[j0 * 128 + h * 16 + lrow], e1 = IDX[j0 * 128 + h * 16 + lrow + 8];
                    g0[h] = *(const u32x4*)(ubs + (size_t)e0 * (DM / 2));
                    g1[h] = *(const u32x4*)(ubs + (size_t)e1 * (DM / 2));
                }
#pragma unroll
                for (int hg = 0; hg < 2; ++hg) {
#pragma unroll
                    for (int h = 0; h < 4; ++h) {
                        *(LAS u32x4*)(STG + h * 2048 + wofs0) = g0[hg * 4 + h];
                        *(LAS u32x4*)(STG + h * 2048 + wofs1) = g1[hg * 4 + h];
                    }
                    __builtin_amdgcn_wave_barrier();
#pragma unroll
                    for (int h = 0; h < 4; ++h)
#pragma unroll
                        for (int m = 0; m < 2; ++m) {
                            const u32x4 a16 = *(const LAS u32x4*)(STG + h * 2048 + rofs4[m]);
                            const v8i av = {(int)a16.x, (int)a16.y, (int)a16.z, (int)a16.w, 0, 0, 0, 0};
                            accU[hg * 4 + h] = __builtin_amdgcn_mfma_scale_f32_16x16x128_f8f6f4(av, bm[m], accU[hg * 4 + h], 4, 0, 0, 0, 0, 0);
                        }
                    __builtin_amdgcn_wave_barrier();
                }
            }
        }
#else
        int rofs[P8_KS];
#pragma unroll
        for (int ks = 0; ks < P8_KS; ++ks) rofs[ks] = fr * 128 + (((2 * ks + (fq >> 1)) ^ (fr & 7)) << 4) + (fq & 1) * 8;
#pragma unroll 1
        for (int sl = 0; sl < P8_NSL; ++sl) {
            if (pace) xcd_pace(bar, sl);
            long xf[P8_KS];
#pragma unroll
            for (int ks = 0; ks < P8_KS; ++ks) {
                const u32x4 xv = *(const u32x4*)(x1b + (t0 + fr) * DM + sl * P8_SLC + ks * 32 + 8 * fq);
                int lo = 0, hi = 0;
                lo = __builtin_amdgcn_cvt_pk_fp8_f32(bf2f(xv[0] & 0xffffu) * xsc, bf2f(xv[0] >> 16) * xsc, lo, false);
                lo = __builtin_amdgcn_cvt_pk_fp8_f32(bf2f(xv[1] & 0xffffu) * xsc, bf2f(xv[1] >> 16) * xsc, lo, true);
                hi = __builtin_amdgcn_cvt_pk_fp8_f32(bf2f(xv[2] & 0xffffu) * xsc, bf2f(xv[2] >> 16) * xsc, hi, false);
                hi = __builtin_amdgcn_cvt_pk_fp8_f32(bf2f(xv[3] & 0xffffu) * xsc, bf2f(xv[3] >> 16) * xsc, hi, true);
                xf[ks] = (long)(((unsigned long long)(unsigned)hi << 32) | (unsigned long long)(unsigned)lo);
            }
            const unsigned char* ubs = uq + sl * P8_SLC + lch * 16;
#pragma unroll 1
            for (int j0 = 0; j0 < 16; ++j0) {
                const bool mine = (fr == j0);
                long bm[P8_KS];
#pragma unroll
                for (int ks = 0; ks < P8_KS; ++ks) bm[ks] = mine ? xf[ks] : 0l;
                u32x4 g0[8], g1[8];
#pragma unroll
                for (int h = 0; h < 8; ++h) {
                    const unsigned e0 = IDX[j0 * 128 + h * 16 + lrow], e1 = IDX[j0 * 128 + h * 16 + lrow + 8];
                    g0[h] = *(const u32x4*)(ubs + (size_t)e0 * DM);
                    g1[h] = *(const u32x4*)(ubs + (size_t)e1 * DM);
                }
#pragma unroll
                for (int hg = 0; hg < 2; ++hg) {
#pragma unroll
                    for (int h = 0; h < 4; ++h) {
                        *(LAS u32x4*)(STG + h * 2048 + wofs0) = g0[hg * 4 + h];
                        *(LAS u32x4*)(STG + h * 2048 + wofs1) = g1[hg * 4 + h];
                    }
                    __builtin_amdgcn_wave_barrier();
#pragma unroll
                    for (int h = 0; h < 4; ++h)
#pragma unroll
                        for (int ks = 0; ks < P8_KS; ++ks) {
                            const long a = *(const LAS long*)(STG + h * 2048 + rofs[ks]);
                            accU[hg * 4 + h] = __builtin_amdgcn_mfma_f32_16x16x32_fp8_fp8(a, bm[ks], accU[hg * 4 + h], 0, 0, 0);
                        }
                    __builtin_amdgcn_wave_barrier();
                }
            }
        }
#endif
        LDS_WAIT(); __builtin_amdgcn_wave_barrier();
#pragma unroll
        for (int h = 0; h < 8; ++h) {
            const f32x4 gv = *(const f32x4*)(gwi + (t0 + fr) * 128 + h * 16 + 4 * fq);
#pragma unroll
            for (int jj = 0; jj < 4; ++jj) {
                const int slot = h * 16 + 4 * fq + jj;
                const unsigned e = IDX[fr * 128 + slot];
                const float hv = accU[h][jj] * rsu[e] * (1.f / P8_XS);
                COEF[fr * 128 + slot] = gv[jj] * gelu_erf(hv) * rsv[e];
            }
        }
        LDS_WAIT(); __builtin_amdgcn_wave_barrier();
#if defined(PROBE_PHASE) && PROBE_PHASE >= 80
        F.tb = __builtin_amdgcn_s_memrealtime();
#endif
#ifdef V_VALU
        const int sub = lane & 7, rg = lane >> 3;
#pragma unroll 1
        for (int sl = 0; sl < P8_NSL; ++sl) {
            const unsigned char* vbs = vq + sl * P8_SLC + sub * 16;
#pragma unroll 1
            for (int j0 = 0; j0 < 16; ++j0) {
                f32x2 acc[8];
#pragma unroll
                for (int q = 0; q < 8; ++q) acc[q] = (f32x2){0.f, 0.f};
#pragma unroll
                for (int ib = 0; ib < 2; ++ib) {
                    u32x4 w[8]; float cf[8];
#pragma unroll
                    for (int it = 0; it < 8; ++it) {
                        const int slot = (ib * 8 + it) * 8 + rg;
                        const unsigned e = IDX[j0 * 128 + slot];
                        cf[it] = COEF[j0 * 128 + slot];
                        w[it] = *(const u32x4*)(vbs + (size_t)e * DM);
                    }
#pragma unroll
                    for (int it = 0; it < 8; ++it)
#pragma unroll
                        for (int q = 0; q < 4; ++q) {
                            acc[2 * q] += __builtin_amdgcn_cvt_pk_f32_fp8((int)w[it][q], false) * cf[it];
                            acc[2 * q + 1] += __builtin_amdgcn_cvt_pk_f32_fp8((int)w[it][q], true) * cf[it];
                        }
                }
#pragma unroll
                for (int q = 0; q < 8; ++q) {
                    acc[q].x += __shfl_xor(acc[q].x, 8); acc[q].y += __shfl_xor(acc[q].y, 8);
                    acc[q].x += __shfl_xor(acc[q].x, 16); acc[q].y += __shfl_xor(acc[q].y, 16);
                    acc[q].x += __shfl_xor(acc[q].x, 32); acc[q].y += __shfl_xor(acc[q].y, 32);
                }
                if (rg == 0) {
                    float* orow = out + (t0 + j0) * DM + sl * P8_SLC + sub * 16;
                    const bf16_t* xrow = x1b + (t0 + j0) * DM + sl * P8_SLC + sub * 16;
#pragma unroll
                    for (int q = 0; q < 4; ++q) {
                        const u32x2 xv = *(const u32x2*)(xrow + 4 * q);
                        f32x4 o = {bf2f(xv.x & 0xffffu), bf2f(xv.x >> 16), bf2f(xv.y & 0xffffu), bf2f(xv.y >> 16)};
                        o[0] += acc[2 * q].x; o[1] += acc[2 * q].y; o[2] += acc[2 * q + 1].x; o[3] += acc[2 * q + 1].y;
                        *(f32x4*)(orow + 4 * q) = o;
                    }
                }
            }
        }
#elif defined(V_FP4)
        typedef int v2i __attribute__((ext_vector_type(2)));
        typedef int v8i __attribute__((ext_vector_type(8)));
        v8i cq8; float inv_cs;
        {
            f32x4 cv[2][4]; float cmax = 0.f;
#pragma unroll
            for (int hf = 0; hf < 2; ++hf)
#pragma unroll
                for (int q = 0; q < 4; ++q) {
                    cv[hf][q] = *(const LAS f32x4*)(COEF + fr * 128 + hf * 64 + 16 * fq + 4 * q);
                    cmax = fmaxf(cmax, fmaxf(fmaxf(fabsf(cv[hf][q][0]), fabsf(cv[hf][q][1])), fmaxf(fabsf(cv[hf][q][2]), fabsf(cv[hf][q][3]))));
                }
            cmax = fmaxf(cmax, __shfl_xor(cmax, 16)); cmax = fmaxf(cmax, __shfl_xor(cmax, 32));
            const float cs = cmax > 0.f ? 240.f / cmax : 1.f; inv_cs = cmax > 0.f ? cmax * (1.f / 240.f) : 1.f;
#pragma unroll
            for (int hf = 0; hf < 2; ++hf)
#pragma unroll
                for (int q = 0; q < 4; ++q) {
                    int pk = 0;
                    pk = __builtin_amdgcn_cvt_pk_fp8_f32(cv[hf][q][0] * cs, cv[hf][q][1] * cs, pk, false);
                    pk = __builtin_amdgcn_cvt_pk_fp8_f32(cv[hf][q][2] * cs, cv[hf][q][3] * cs, pk, true);
                    cq8[hf * 4 + q] = pk;
                }
        }
        LDS_WAIT(); __builtin_amdgcn_wave_barrier();
        int vwofs[16];
#pragma unroll
        for (int i = 0; i < 16; ++i) { const int rr = lrow + 8 * i; vwofs[i] = rr * 128 + ((lch ^ ((rr >> 1) & 7)) << 4); }
        int vrow_[2], vsw_[2];
#pragma unroll
        for (int t = 0; t < 2; ++t) { vrow_[t] = 32 * fq + 16 * t + fr; vsw_[t] = (vrow_[t] >> 1) & 7; }
#pragma unroll 1
        for (int sl = 0; sl < 4; ++sl) {
            f32x4 accV[16];
#pragma unroll
            for (int ct = 0; ct < 16; ++ct) accV[ct] = (f32x4){0.f, 0.f, 0.f, 0.f};
            const unsigned char* vbs = vq + sl * 128 + lch * 16;
#pragma unroll 1
            for (int j0 = 0; j0 < 16; ++j0) {
                const bool mine = (fr == j0);
                u32x4 g[16];
#pragma unroll
                for (int i = 0; i < 16; ++i) {
                    const unsigned e = IDX[j0 * 128 + lrow + 8 * i];
                    g[i] = *(const u32x4*)(vbs + (size_t)e * (DM / 2));
                }
#pragma unroll
                for (int i = 0; i < 16; ++i) *(LAS u32x4*)(STG + vwofs[i]) = g[i];
                __builtin_amdgcn_wave_barrier();
                v8i bmq;
#pragma unroll
                for (int q = 0; q < 8; ++q) bmq[q] = mine ? cq8[q] : 0;
#pragma unroll
                for (int ct = 0; ct < 16; ++ct) {
                    const v2i r0 = __builtin_amdgcn_ds_read_tr4_b64_v2i32((LAS v2i*)(STG + vrow_[0] * 128 + (((ct >> 1) ^ vsw_[0]) << 4) + (ct & 1) * 8));
                    const v2i r1 = __builtin_amdgcn_ds_read_tr4_b64_v2i32((LAS v2i*)(STG + vrow_[1] * 128 + (((ct >> 1) ^ vsw_[1]) << 4) + (ct & 1) * 8));
                    const v8i av = {r0.x, r0.y, r1.x, r1.y, 0, 0, 0, 0};
                    accV[ct] = __builtin_amdgcn_mfma_scale_f32_16x16x128_f8f6f4(av, bmq, accV[ct], 4, 0, 0, 0, 0, 0);
                }
                __builtin_amdgcn_wave_barrier();
            }
            float* orow = out + (t0 + fr) * DM + sl * 256 + 4 * fq;
            const bf16_t* xrow = x1b + (t0 + fr) * DM + sl * 256 + 4 * fq;
#pragma unroll
            for (int ct = 0; ct < 16; ++ct) {
                const u32x2 xv = *(const u32x2*)(xrow + ct * 16);
                f32x4 o = {bf2f(xv.x & 0xffffu), bf2f(xv.x >> 16), bf2f(xv.y & 0xffffu), bf2f(xv.y >> 16)};
                o += accV[ct] * inv_cs;
                __builtin_nontemporal_store(o, (f32x4*)(orow + ct * 16));
            }
        }
#else
        typedef int v2i __attribute__((ext_vector_type(2)));
        long cq[4]; float inv_cs;
        {
            f32x4 cv[4][2]; float cmax = 0.f;
#pragma unroll
            for (int kk = 0; kk < 4; ++kk)
#pragma unroll
                for (int q = 0; q < 2; ++q) {
                    cv[kk][q] = *(const LAS f32x4*)(COEF + fr * 128 + kk * 32 + 8 * fq + 4 * q);
                    cmax = fmaxf(cmax, fmaxf(fmaxf(fabsf(cv[kk][q][0]), fabsf(cv[kk][q][1])), fmaxf(fabsf(cv[kk][q][2]), fabsf(cv[kk][q][3]))));
                }
            cmax = fmaxf(cmax, __shfl_xor(cmax, 16)); cmax = fmaxf(cmax, __shfl_xor(cmax, 32));
            const float cs = cmax > 0.f ? 240.f / cmax : 1.f; inv_cs = cmax > 0.f ? cmax * (1.f / 240.f) : 1.f;
#pragma unroll
            for (int kk = 0; kk < 4; ++kk) {
                int lo = 0, hi = 0;
                lo = __builtin_amdgcn_cvt_pk_fp8_f32(cv[kk][0][0] * cs, cv[kk][0][1] * cs, lo, false);
                lo = __builtin_amdgcn_cvt_pk_fp8_f32(cv[kk][0][2] * cs, cv[kk][0][3] * cs, lo, true);
                hi = __builtin_amdgcn_cvt_pk_fp8_f32(cv[kk][1][0] * cs, cv[kk][1][1] * cs, hi, false);
                hi = __builtin_amdgcn_cvt_pk_fp8_f32(cv[kk][1][2] * cs, cv[kk][1][3] * cs, hi, true);
                cq[kk] = (long)(((unsigned long long)(unsigned)hi << 32) | (unsigned long long)(unsigned)lo);
            }
        }
        LDS_WAIT(); __builtin_amdgcn_wave_barrier();
        const int vrow = 8 * fq + (fr >> 1);
        const int vrd0 = vrow * 128 + (fr & 1) * 8, vsw = (vrow >> 1) & 7;
        int vwofs[4];
#pragma unroll
        for (int i = 0; i < 4; ++i) { const int rr = lrow + 8 * i; vwofs[i] = rr * 128 + ((lch ^ ((rr >> 1) & 7)) << 4); }
#pragma unroll 1
        for (int sl = 0; sl < P8_NSL; ++sl) {
            if (pace) xcd_pace(bar, P8_NSL + sl);
            f32x4 accV[8];
#pragma unroll
            for (int ct = 0; ct < 8; ++ct) accV[ct] = (f32x4){0.f, 0.f, 0.f, 0.f};
            const unsigned char* vbs = vq + sl * P8_SLC + lch * 16;
#pragma unroll 1
            for (int j0 = 0; j0 < 16; ++j0) {
                const bool mine = (fr == j0);
                u32x4 g[4][4];
#pragma unroll
                for (int kk = 0; kk < 4; ++kk)
#pragma unroll
                    for (int i = 0; i < 4; ++i) {
                        const unsigned e = IDX[j0 * 128 + kk * 32 + lrow + 8 * i];
                        g[kk][i] = *(const u32x4*)(vbs + (size_t)e * DM);
                    }
#pragma unroll
                for (int kk = 0; kk < 4; ++kk) {
                    LAS unsigned char* T = STG + (kk & 1) * 4096;
#pragma unroll
                    for (int i = 0; i < 4; ++i) *(LAS u32x4*)(T + vwofs[i]) = g[kk][i];
                    __builtin_amdgcn_wave_barrier();
                    const long bmq = mine ? cq[kk] : 0l;
#pragma unroll
                    for (int ct = 0; ct < 8; ++ct) {
                        const v2i av = __builtin_amdgcn_ds_read_tr8_b64_v2i32((LAS v2i*)(T + vrd0 + ((ct ^ vsw) << 4)));
                        const long a = (long)(((unsigned long long)(unsigned)av.y << 32) | (unsigned long long)(unsigned)av.x);
                        accV[ct] = __builtin_amdgcn_mfma_f32_16x16x32_fp8_fp8(a, bmq, accV[ct], 0, 0, 0);
                    }
                    __builtin_amdgcn_wave_barrier();
                }
            }
            float* orow = out + (t0 + fr) * DM + sl * P8_SLC + 4 * fq;
            const bf16_t* xrow = x1b + (t0 + fr) * DM + sl * P8_SLC + 4 * fq;
#pragma unroll
            for (int ct = 0; ct < 8; ++ct) {
                const u32x2 xv = *(const u32x2*)(xrow + ct * 16);
                f32x4 o = {bf2f(xv.x & 0xffffu), bf2f(xv.x >> 16), bf2f(xv.y & 0xffffu), bf2f(xv.y >> 16)};
                o += accV[ct] * inv_cs;
                __builtin_nontemporal_store(o, (f32x4*)(orow + ct * 16));
            }
        }
#endif
#if defined(PROBE_PHASE) && PROBE_PHASE >= 80
        F.tc = __builtin_amdgcn_s_memrealtime();
#endif
        LDS_WAIT(); __builtin_amdgcn_wave_barrier();
    }
}

constexpr int NPHASE = 9;
#ifndef N_LAUNCHES
#define N_LAUNCHES 1
#endif
constexpr int MISC_OFF = LDS_BYTES - 128;
__global__ void __launch_bounds__(512, 2) fwd_kernel(Params p) {
    extern __shared__ __attribute__((aligned(16))) unsigned char lds_raw[];
    Ctx F; F.ta = F.tb = F.tc = 0;
    F.lds = (LAS unsigned char*)lds_raw;
    F.tid = threadIdx.x; F.lane = F.tid & 63; F.wave = __builtin_amdgcn_readfirstlane(F.tid >> 6);
    F.G = gridDim.x; { const int bx = blockIdx.x; F.vcu = (F.G % 8 == 0) ? (bx % 8) * (F.G / 8) + bx / 8 : bx; }
    F.gw = F.vcu * 8 + F.wave; F.ngw = F.G * 8;
    unsigned char* ws = p.ws;
    const int lo = p.ph_lo, hi = p.ph_hi;
    volatile LAS unsigned* MISC = (volatile LAS unsigned*)(F.lds + MISC_OFF);
    if (F.tid < 32) MISC[F.tid] = 0u;
    __syncthreads();
#ifdef CG_FIRST_SYNC
    XcdBarrier bar; bar.bar = (unsigned*)(ws + WS_CTL) + CW_BAR; bar.x = 0; bar.st = MISC + 8;
    for (int i = blockIdx.x * 512 + F.tid; i < XCD_BAR_WORDS + PACE_WORDS; i += F.G * 512) __hip_atomic_store(bar.bar + i, 0u, __ATOMIC_RELAXED, __HIP_MEMORY_SCOPE_AGENT);
#else
    XcdBarrier bar = xcd_barrier_post((unsigned*)(ws + WS_CTL) + CW_BAR, MISC + 8);
#endif
#ifdef ONLY_PHASE
#define IN(k) ((k)==ONLY_PHASE)
#else
#define IN(k) (lo <= (k) && (k) < hi)
#endif
#ifdef PROBE_PHASE
    unsigned long long tp0 = __builtin_amdgcn_s_memrealtime(), tp1 = 0; const unsigned long long tstart = tp0;
#define PSTAMP(k) do { if ((k) + 1 == PROBE_PHASE) tp0 = __builtin_amdgcn_s_memrealtime(); if ((k) == PROBE_PHASE) tp1 = __builtin_amdgcn_s_memrealtime(); } while (0)
#else
#define PSTAMP(k) do {} while (0)
#endif
#define SEAM(k) do { if (IN(k) && ((k) == 6 ? IN(8) : IN((k) + 1))) xcd_barrier(bar); PSTAMP(k); } while (0)
    if (IN(0)) phase0(p, F);
#ifdef CG_FIRST_SYNC
    if (IN(0) && IN(1)) { cooperative_groups::this_grid().sync(); bar = xcd_barrier_post((unsigned*)(ws + WS_CTL) + CW_BAR, MISC + 8); }
    PSTAMP(0);
#else
    SEAM(0);
#endif
    if (IN(1)) {
        pg8::Gemm g{(const pg8::bf16_t*)(ws + WS_XB), (const pg8::bf16_t*)(ws + WS_WINT), TOK, NIN, DM};
        pg8::StaticOrder S; S.init(TOK, NIN, F.G, (int)blockIdx.x);
        pg8::EpiProj E{(pg8::bf16_t*)(ws + WS_PROJ), NIN, p.in[9], p.in[10], (const float*)(ws + WS_ROPE), (const float*)(ws + WS_ROPE) + SEQ * 8,
                       (LAS float*)(F.lds + pg8::STAGE_BYTES), PQ, PK, PV, SEQ - 1, EPSN};
        pg8::gemm_phase<pg8::EpiProj, pg8::StaticOrder, true, true>(F.lds, g, S, E);
    }
    SEAM(1);
    if (IN(2)) phase2(p, F);
    SEAM(2);
    if (IN(3)) phase3(p, F);
    SEAM(3);
    if (IN(4)) phase4(p, F);
    SEAM(4);
    if (IN(5)) {
        pg8::Gemm g{(const pg8::bf16_t*)(ws + WS_YCAT), (const pg8::bf16_t*)(ws + WS_WOUTT), TOK, DM, DM};
        pg8::StaticOrder S; S.init(TOK, DM, F.G, (int)blockIdx.x);
        pg8::EpiResid E{p.in[0], p.out, (pg8::bf16_t*)(ws + WS_X1B), (float*)(ws + WS_CTL) + CW_ROWSQ, DM};
        pg8::gemm_phase<pg8::EpiResid, pg8::StaticOrder, true, true>(F.lds, g, S, E);
    }
    SEAM(5);
    if (IN(6)) {
        pg8::Gemm g{(const pg8::bf16_t*)(ws + WS_X1B), (const pg8::bf16_t*)(ws + WS_WQT), TOK, 2048, DM};
        pg8::StaticOrder S; S.init(TOK, 2048, F.G, (int)blockIdx.x);
        pg8::EpiBf16<0> E{(pg8::bf16_t*)(ws + WS_QP), 2048, nullptr, 0, 0, 1.f};
        pg8::gemm_phase<pg8::EpiBf16<0>, pg8::StaticOrder, true, true>(F.lds, g, S, E);
    }
    SEAM(6);
    PSTAMP(7);
#ifdef PROBE_PHASE
    const unsigned sv_nloc = MISC[8], sv_nx = MISC[9];
#endif
    if (IN(8)) phase8(p, F, bar);
#ifdef PROBE_PHASE
    __syncthreads(); if (F.tid == 0) { MISC[8] = sv_nloc; MISC[9] = sv_nx; } __syncthreads();
#endif
#ifdef PROBE_PHASE
    xcd_barrier(bar);
    PSTAMP(8);
#if PROBE_PHASE == 9
    tp0 = tstart; tp1 = __builtin_amdgcn_s_memrealtime();
#elif PROBE_PHASE == 80 || PROBE_PHASE == 20
    tp0 = F.ta; tp1 = F.tb;
#elif PROBE_PHASE == 81 || PROBE_PHASE == 21
    tp0 = F.tb; tp1 = F.tc;
#endif
#if PROBE_PHASE == 98
    {
        typedef int v2i __attribute__((ext_vector_type(2)));
        float result = 0.f;
        __syncthreads();
        if (blockIdx.x == 0 && F.wave == 0) {
            LAS unsigned char* T = (LAS unsigned char*)F.lds;
            if (F.lane < 16) {
                unsigned long long w = 0ull;
                for (int c = 0; c < 16; ++c) { const unsigned long long nib = (PROBE_SUB == 0) ? (unsigned long long)F.lane : (unsigned long long)c; w |= nib << (4 * c); }
                *(LAS unsigned long long*)(T + F.lane * 8) = w;
            }
            LDS_WAIT(); __builtin_amdgcn_wave_barrier();
            const v2i rv_ = __builtin_amdgcn_ds_read_tr4_b64_v2i32((LAS v2i*)(T + (F.lane & 15) * 8));
            const unsigned long long got = ((unsigned long long)(unsigned)rv_.y << 32) | (unsigned long long)(unsigned)rv_.x;
            unsigned long long want = 0ull;
            for (int j = 0; j < 16; ++j) { const unsigned long long nib = (PROBE_SUB == 0) ? (unsigned long long)j : (unsigned long long)(F.lane & 15); want |= nib << (4 * j); }
            const unsigned long long bal = __ballot(got == want);
            result = (float)__popcll(bal);
        }
        if (blockIdx.x == 0 && F.tid == 0) { VM_WAIT(); p.out[0] += result; }
    }
#elif PROBE_PHASE == 99
    {
        typedef int v8i __attribute__((ext_vector_type(8)));
        float result = 0.f;
        if (blockIdx.x == 0 && F.wave == 0) {
            const int fr_ = F.lane & 15, fq_ = F.lane >> 4;
            v8i bv;
#pragma unroll
            for (int q = 0; q < 8; ++q) { unsigned w = 0; for (int bb = 0; bb < 4; ++bb) { unsigned pcode = (unsigned)(32 * fq_ + 4 * q + bb); if (pcode == 127u) pcode = 126u; w |= pcode << (8 * bb); } bv[q] = (int)w; }
            int matches = 0, firstbad = -1, firstbadval = -1;
            for (int ga = 0; ga < 4; ++ga)
                for (int ja = 0; ja < 32; ++ja) {
                    v8i av = {0, 0, 0, 0, 0, 0, 0, 0};
                    if (fr_ == 0 && fq_ == ga) { const unsigned nib = 2u << (4 * (ja & 7)); const int wsel = ja >> 3;
                        av[0] = wsel == 0 ? (int)nib : 0; av[1] = wsel == 1 ? (int)nib : 0; av[2] = wsel == 2 ? (int)nib : 0; av[3] = wsel == 3 ? (int)nib : 0; }
                    f32x4 c = {0.f, 0.f, 0.f, 0.f};
                    c = __builtin_amdgcn_mfma_scale_f32_16x16x128_f8f6f4(av, bv, c, 4, 0, 0, 0, 0, 0);
                    int pk = 0; pk = __builtin_amdgcn_cvt_pk_fp8_f32(c[0], 0.f, pk, false);
                    const int got = __shfl(pk & 255, 0);
                    int want = 32 * ga + ja; if (want == 127) want = 126;
                    if (got == want) ++matches; else if (firstbad < 0) { firstbad = 32 * ga + ja; firstbadval = got; }
                }
#if PROBE_SUB == 0
            result = (float)matches;
#elif PROBE_SUB == 1
            result = (float)firstbad;
#else
            result = (float)firstbadval;
#endif
        }
        if (blockIdx.x == 0 && F.tid == 0) { VM_WAIT(); p.out[0] += result; }
    }
#else
    if (blockIdx.x == 0 && F.tid == 0) { VM_WAIT(); p.out[0] += (float)(tp1 - tp0) * (1.0f / (float)(PROBE_DIV)); }
#endif
#endif
#undef IN
#undef SEAM
}

extern "C" void kernel_launch(void* const* d_in, const int* in_sizes, int n_in, void* d_out, int out_size, void* d_ws, size_t ws_size, hipStream_t stream) {
    static int grid = 0;
    if (grid == 0) {
        if (n_in != 22 || in_sizes[0] != TOK * DM || out_size != TOK * DM || ws_size < WS_END) {
            fprintf(stderr, "kernel_launch: unexpected shapes: n_in %d in0 %d out %d ws %zu\n", n_in, n_in > 0 ? in_sizes[0] : -1, out_size, ws_size); grid = -1; return; }
        if (hipFuncSetAttribute((const void*)fwd_kernel, hipFuncAttributeMaxDynamicSharedMemorySize, LDS_BYTES) != hipSuccess) { fprintf(stderr, "kernel_launch: hipFuncSetAttribute failed\n"); grid = -1; return; }
        int dev = 0, cus = 0, per_cu = 0;
        if (hipGetDevice(&dev) != hipSuccess || hipDeviceGetAttribute(&cus, hipDeviceAttributeMultiprocessorCount, dev) != hipSuccess) { grid = -1; return; }
        if (hipOccupancyMaxActiveBlocksPerMultiprocessor(&per_cu, (const void*)fwd_kernel, 512, LDS_BYTES) != hipSuccess || per_cu < 1) { fprintf(stderr, "kernel_launch: occupancy query failed (%d)\n", per_cu); (void)hipGetLastError(); per_cu = 1; }
        grid = cus * (per_cu > 1 ? 1 : per_cu);
    }
    if (grid < 0) return;
#ifndef CG_FIRST_SYNC
    (void)hipMemsetAsync((char*)d_ws + WS_CTL + (size_t)CW_BAR * 4, 0, (size_t)(XCD_BAR_WORDS + PACE_WORDS) * 4, stream);
#endif
    Params a{};
    for (int i = 0; i < 22; ++i) a.in[i] = (const float*)d_in[i];
    a.out = (float*)d_out; a.ws = (unsigned char*)d_ws;
#if N_LAUNCHES == 1
    a.ph_lo = 0; a.ph_hi = NPHASE;
#ifdef USE_COOP_LAUNCH
    { void* args[] = {&a};
      hipError_t e = hipLaunchCooperativeKernel((const void*)fwd_kernel, dim3(grid), dim3(512), args, LDS_BYTES, stream);
      if (e != hipSuccess) fprintf(stderr, "kernel_launch: cooperative launch failed: %s (grid %d)\n", hipGetErrorString(e), grid); }
#else
    hipLaunchKernelGGL(fwd_kernel, dim3(grid), dim3(512), LDS_BYTES, stream, a);
#endif
#else
    for (int ph = 0; ph < NPHASE; ++ph) {
        a.ph_lo = ph; a.ph_hi = ph + 1;
        hipLaunchKernelGGL(fwd_kernel, dim3(grid), dim3(512), LDS_BYTES, stream, a);
    }
#endif
    const hipError_t le = hipPeekAtLastError();
    if (le != hipSuccess) fprintf(stderr, "kernel_launch: launch failed: %s\n", hipGetErrorName(le));
}
```

```cpp
#include <hip/hip_runtime.h>
#include <hip/hip_cooperative_groups.h>
#include <cstdio>
#include <cstdint>
#define USE_COOP_LAUNCH 1
#define U_FP4 1
#define V_FP4 1

#define LAS __attribute__((address_space(3)))
#define GAS __attribute__((address_space(1)))
typedef unsigned short bf16_t;
typedef short bf16x8 __attribute__((ext_vector_type(8)));
typedef short s16x4 __attribute__((ext_vector_type(4)));
typedef float f32x4 __attribute__((ext_vector_type(4)));
typedef float f32x8 __attribute__((ext_vector_type(8)));
typedef float f32x16 __attribute__((ext_vector_type(16)));
typedef unsigned u32x4 __attribute__((ext_vector_type(4)));
typedef unsigned u32x2 __attribute__((ext_vector_type(2)));

constexpr int NB = 8, SEQ = 4096, TOK = NB * SEQ, DM = 1024;
constexpr int NIN = 3072;
constexpr int PZ = 0, PXS = 512, PBM = 1024, PCM = 1280, PQ = 1536, PK = 2048, PV = 2560;
constexpr int CHUNK = 64, NCH = SEQ / CHUNK;
constexpr int NHS = 8;
constexpr float EPSN = 1e-6f;
constexpr int PEER_H = 8, NKEYS = 128, TOPK = 16;
constexpr float LAMBDA_INIT = 0.2f;

constexpr size_t MiB = 1u << 20;
constexpr size_t WS_CTL = 0, CTL_BYTES = 1 * MiB;
constexpr size_t WS_WINT = 1 * MiB;
constexpr size_t WS_WOUTT = 7 * MiB;
constexpr size_t WS_WQT = 9 * MiB;
constexpr size_t WS_KEYS = 13 * MiB;
constexpr size_t WS_ROPE = 13 * MiB + 512 * 1024;
constexpr size_t WS_MISC = 13 * MiB + 768 * 1024;
constexpr size_t WS_RSU = WS_MISC + 64 * 1024;
constexpr size_t WS_RSV = WS_MISC + 128 * 1024;
constexpr size_t WS_DTRAW = 14 * MiB;
constexpr size_t WS_ACS = 15 * MiB;
constexpr size_t WS_CDEC = 16 * MiB;
constexpr size_t WS_UB = 20 * MiB;
constexpr size_t WS_VB = 52 * MiB;
constexpr size_t WS_XB = 84 * MiB;
constexpr size_t WS_YCAT = WS_XB;
constexpr size_t WS_PROJ = 148 * MiB;
constexpr size_t WS_QP = WS_PROJ;
constexpr size_t WS_IDX = 276 * MiB;
constexpr size_t WS_GW = 292 * MiB;
constexpr size_t WS_CMC = 340 * MiB;
constexpr size_t WS_STATES = 356 * MiB;
constexpr size_t WS_X1B = WS_STATES;
constexpr size_t WS_END = 484 * MiB;
constexpr int CW_BAR = 4096;
constexpr int CW_ROWSQ = 131072;
static_assert((CW_ROWSQ + TOK) * 4 <= (int)CTL_BYTES, "ctl");

constexpr int LDS_BYTES = 163840;

__device__ __forceinline__ float bf2f(unsigned h) { return __uint_as_float(h << 16); }
__device__ __forceinline__ unsigned f2bf(float f) { unsigned u = __float_as_uint(f); return (u + 0x7fffu + ((u >> 16) & 1u)) >> 16; }
__device__ __forceinline__ unsigned pk2(float lo, float hi) { return f2bf(lo) | (f2bf(hi) << 16); }
__device__ __forceinline__ float wave_sum(float v) {
#pragma unroll
    for (int o = 1; o < 64; o <<= 1) v += __shfl_xor(v, o);
    return v;
}
__device__ __forceinline__ float wave_max(float v) {
#pragma unroll
    for (int o = 1; o < 64; o <<= 1) v = fmaxf(v, __shfl_xor(v, o));
    return v;
}
__device__ __forceinline__ float silu_f(float x) { return x / (1.f + __expf(-x)); }
__device__ __forceinline__ f32x4 mfma16(bf16x8 a, bf16x8 b, f32x4 c) { return __builtin_amdgcn_mfma_f32_16x16x32_bf16(a, b, c, 0, 0, 0); }
__device__ __forceinline__ f32x16 mfma32(bf16x8 a, bf16x8 b, f32x16 c) { return __builtin_amdgcn_mfma_f32_32x32x16_bf16(a, b, c, 0, 0, 0); }
#define LDS_WAIT() asm volatile("s_waitcnt lgkmcnt(0)" ::: "memory")
#define VM_WAIT() asm volatile("s_waitcnt vmcnt(0)" ::: "memory")

#define XB_TMO      128
#define XB_XCNT(j)  (256  + 64 * (j))
#define XB_XSUB(j)  (1280 + 64 * (j))
#define XB_XGEN(j)  (2304 + 64 * (j))
#define XB_TOP      3328
#define XB_TOPGEN   3392
#define XCD_BAR_WORDS 3456
#define XB_SPIN_CAP (1u << 21)

__device__ __forceinline__ unsigned xb_ld(unsigned* p)              { return __hip_atomic_load(p, __ATOMIC_RELAXED, __HIP_MEMORY_SCOPE_AGENT); }
__device__ __forceinline__ unsigned xb_add(unsigned* p, unsigned v) { return __hip_atomic_fetch_add(p, v, __ATOMIC_RELAXED, __HIP_MEMORY_SCOPE_AGENT); }
__device__ __forceinline__ unsigned xb_xcc_id() { return (unsigned)__builtin_amdgcn_s_getreg((3 << 11) | 20) & 0xFu; }
#define XB_SPIN(cond, bar) do { unsigned _sp = 0; while (cond) { __builtin_amdgcn_s_sleep(1); \
    if ((++_sp & 255u) == 0u) { if (xb_ld(&(bar)[XB_TMO])) break; if (_sp > XB_SPIN_CAP) { atomicAdd(&(bar)[XB_TMO], 1u); break; } } } } while (0)

struct XcdBarrier {
    unsigned* bar; unsigned x;
    volatile LAS unsigned* st;
};

__device__ __forceinline__ XcdBarrier xcd_barrier_post(unsigned* bar, volatile LAS unsigned* st) {
    XcdBarrier b; b.bar = bar; b.x = xb_xcc_id(); b.st = st;
    if (threadIdx.x == 0) (void)xb_add(&bar[XB_XCNT(b.x)], 1u);
    return b;
}
__device__ __forceinline__ void xcd_barrier_complete(unsigned* bar, unsigned x, unsigned& nloc, unsigned& nx) {
    const unsigned G = gridDim.x * gridDim.y * gridDim.z;
    unsigned sum, cnt, mine, sp = 0u;
    for (;;) {
        sum = 0u; cnt = 0u; mine = 0u;
#pragma unroll
        for (unsigned j = 0; j < 16; ++j) { const unsigned c = xb_ld(&bar[XB_XCNT(j)]); sum += c; cnt += (c > 0u) ? 1u : 0u; mine = (j == x) ? c : mine; }
        if (sum == G) break;
        __builtin_amdgcn_s_sleep(1);
        if ((++sp & 255u) == 0u) { if (xb_ld(&bar[XB_TMO])) break; if (sp > XB_SPIN_CAP) { atomicAdd(&bar[XB_TMO], 1u); break; } }
    }
    nloc = mine > 0u ? mine : 1u; nx = cnt > 0u ? cnt : 1u;
}

__device__ __forceinline__ void xcd_barrier(const XcdBarrier& b) {
    asm volatile("s_waitcnt vmcnt(0)" ::: "memory");
    __syncthreads();
    if (threadIdx.x == 0) {
        unsigned* bar = b.bar;
        __builtin_amdgcn_s_waitcnt(0);
        unsigned nloc = b.st[0], nx = b.st[1];
        if (nloc == 0u) { xcd_barrier_complete(bar, b.x, nloc, nx); b.st[0] = nloc; b.st[1] = nx; }
        const unsigned old = xb_add(&bar[XB_XSUB(b.x)], 1u);
        const unsigned gen = old / nloc;
        if (old + 1u == (gen + 1u) * nloc) {
            __builtin_amdgcn_fence(__ATOMIC_RELEASE, "agent");
            asm volatile("s_waitcnt vmcnt(0)" ::: "memory");
            const unsigned og = xb_add(&bar[XB_TOP], 1u);
            const unsigned tg = og / nx;
            if (og + 1u == (tg + 1u) * nx) xb_add(&bar[XB_TOPGEN], 1u);
            else XB_SPIN(xb_ld(&bar[XB_TOPGEN]) == tg, bar);
            __builtin_amdgcn_fence(__ATOMIC_ACQUIRE, "agent");
            xb_add(&bar[XB_XGEN(b.x)], 1u);
            asm volatile("s_waitcnt vmcnt(0)" ::: "memory");
        } else {
            XB_SPIN(xb_ld(&bar[XB_XGEN(b.x)]) == gen, bar);
            __builtin_amdgcn_fence(__ATOMIC_ACQUIRE, "agent");
            asm volatile("s_waitcnt vmcnt(0)" ::: "memory");
        }
    }
    __syncthreads();
}
namespace pg8 {
#define PG8_LAS __attribute__((address_space(3)))
typedef unsigned short bf16_t;
typedef short bf16x8 __attribute__((ext_vector_type(8)));
typedef float f32x4 __attribute__((ext_vector_type(4)));
typedef unsigned u32x4 __attribute__((ext_vector_type(4)));
constexpr int BM = 256, BK = 64, HALF = 128, HTB = HALF * BK * 2  , STAGE_BYTES = 8 * HTB, NXCD = 8, WGM = 8;

__host__ __device__ __forceinline__ int lds_byte(int r, int c) { const int st = (r >> 4) * 2 + (c >> 5), rr = r & 15, cc = c & 31, ob = rr * 64 + cc * 2; return st * 1024 + (ob ^ (((ob >> 9) & 1) << 5)); }
__host__ __device__ __forceinline__ void stage_rc(int b, int& R, int& C) { const int st = b / 1024, sb = b % 1024, swz = sb ^ (((sb >> 9) & 1) << 5); R = (st >> 1) * 16 + swz / 64; C = (st & 1) * 32 + (swz % 64) / 2; }
__host__ __device__ __forceinline__ int perm32(int rho) { const int n = rho >> 4, i = rho & 15; return 8 * (i >> 2) + 4 * n + (i & 3); }

struct Unit { int pm, pn; };
struct Gemm { const bf16_t* A; const bf16_t* Bt; int M, N, K; };

struct StaticOrder {
    int nM, nN, nwg, G, c;
    __host__ __device__ void init(int M, int N, int G_, int c_) { nM = M / BM; nN = N / BM; nwg = nM * nN; G = G_; c = c_; }
    __host__ __device__ bool next(int i, Unit& u) const {
        const long L = (long)i * G + c; if (L >= nwg) return false;
        int wgid = (int)L; { const int q = nwg / NXCD, r = nwg % NXCD, xcd = wgid % NXCD, off = wgid / NXCD; wgid = (xcd < r ? xcd * (q + 1) : r * (q + 1) + (xcd - r) * q) + off; }
        const int nig = WGM * nN, gid = wgid / nig, fm = gid * WGM, gsz = (nM - fm) < WGM ? (nM - fm) : WGM;
        u.pm = fm + ((wgid % nig) % gsz); u.pn = (wgid % nig) / gsz; return true;
    }
    __device__ __forceinline__ void a_ready(const Unit&) const {}
    __device__ __forceinline__ void done(const Unit&) const {}
};

__device__ __forceinline__ unsigned cvt_pk_bf16(float lo, float hi) { unsigned r; asm volatile("v_cvt_pk_bf16_f32 %0, %1, %2" : "=v"(r) : "v"(lo), "v"(hi)); return r; }
typedef float f32x2 __attribute__((ext_vector_type(2)));
__device__ __forceinline__ f32x2 gelu_pk(f32x2 v) {
    const f32x2 av = __builtin_elementwise_abs(v), d = av * 0.2316418882f + 1.0f;
    f32x2 t; t.x = __builtin_amdgcn_rcpf(d.x); t.y = __builtin_amdgcn_rcpf(d.y);
    f32x2 q = t * 0.5307027145f + (-0.7265760135f); q = q * t + 0.7107068705f; q = q * t + (-0.142248368f); q = q * t + 0.127414796f; q = q * t;
    const f32x2 s = (v * v) * (-0.72134752044f);
    f32x2 e; e.x = __builtin_amdgcn_exp2f(s.x); e.y = __builtin_amdgcn_exp2f(s.y);
    const f32x2 m = v * (q * e), r = v - m;
    f32x2 o; o.x = v.x < 0.f ? m.x : r.x; o.y = v.y < 0.f ? m.y : r.y; return o;
}

template <int ACT  > struct EpiBf16 {
    static constexpr bool PERM = true, AFTER_DRAIN = false; static_assert(ACT == 0 || ACT == 1, "EpiBf16: ACT is 0 (none) or 1 (gelu_pk)");
    bf16_t* O; int ldc; const float* bias; int split_cols; size_t split_stride; float scale0;
    __device__ __forceinline__ void operator()(const f32x4 (&acc)[2][2][4][2], const Unit& u, int wr, int wc, int fr, int fq) const {
        const int row0 = u.pm * BM + wr * 64 + fr; int colt = u.pn * BM; bf16_t* base = O;
        float sc = 1.f; if (split_cols) { const int t = colt / split_cols; base += (size_t)t * split_stride; colt -= t * split_cols; if (t == 0) sc = scale0; }
        const int col0 = colt + wc * 32 + 8 * fq, bcol0 = u.pn * BM + wc * 32 + 8 * fq;
        f32x4 bv[2][2];
#pragma unroll
        for (int bj = 0; bj < 2; ++bj)
#pragma unroll
            for (int n = 0; n < 2; ++n) bv[bj][n] = bias ? *(const f32x4*)(bias + bcol0 + bj * HALF + 4 * n) : (f32x4){0.f, 0.f, 0.f, 0.f};
#pragma unroll
        for (int ai = 0; ai < 2; ++ai)
#pragma unroll
            for (int m = 0; m < 4; ++m) { bf16_t* rowp = base + (size_t)(row0 + ai * HALF + m * 16) * ldc + col0;
#pragma unroll
                for (int bj = 0; bj < 2; ++bj) { f32x4 v0 = acc[ai][bj][m][0] + bv[bj][0], v1 = acc[ai][bj][m][1] + bv[bj][1];
                    if (ACT == 1) { f32x2 a = gelu_pk((f32x2){v0[0], v0[1]}), b = gelu_pk((f32x2){v0[2], v0[3]}), c = gelu_pk((f32x2){v1[0], v1[1]}), d = gelu_pk((f32x2){v1[2], v1[3]});
                        v0 = (f32x4){a.x, a.y, b.x, b.y}; v1 = (f32x4){c.x, c.y, d.x, d.y}; }
                    v0 = v0 * sc; v1 = v1 * sc; u32x4 w; w.x = cvt_pk_bf16(v0[0], v0[1]); w.y = cvt_pk_bf16(v0[2], v0[3]); w.z = cvt_pk_bf16(v1[0], v1[1]); w.w = cvt_pk_bf16(v1[2], v1[3]);
                    *(u32x4*)(rowp + bj * HALF) = w; } }
    }
};

struct EpiResid {
    static constexpr bool PERM = false, AFTER_DRAIN = false;
    const float* x; float* out; bf16_t* xb; float* rowsq; int ldc;
    __device__ __forceinline__ void operator()(const f32x4 (&acc)[2][2][4][2], const Unit& u, int wr, int wc, int fr, int fq) const {
        const int col0 = u.pn * BM + wc * 32 + 4 * fq;
        const size_t base = (size_t)(u.pm * BM + wr * 64 + fr) * ldc + col0;
        f32x4 xv[2][4];
#define EPR_LOAD(SET, G) do { const size_t off_ = base + (size_t)(((G) >> 2) * HALF + ((G) & 3) * 16) * ldc; \
        _Pragma("unroll") for (int bj = 0; bj < 2; ++bj) _Pragma("unroll") for (int n = 0; n < 2; ++n) xv[SET][bj * 2 + n] = __builtin_nontemporal_load((const f32x4*)(x + off_ + bj * HALF + n * 16)); } while (0)
        EPR_LOAD(0, 0);
#pragma unroll
        for (int g = 0; g < 8; ++g) {
            const int ai = g >> 2, m = g & 3;
            if (g + 1 < 8) { if ((g & 1) == 0) EPR_LOAD(1, g + 1); else EPR_LOAD(0, g + 1); }
            const int row = u.pm * BM + ai * HALF + wr * 64 + m * 16 + fr;
            const size_t off = base + (size_t)(ai * HALF + m * 16) * ldc;
            float ss = 0.f;
#pragma unroll
            for (int bj = 0; bj < 2; ++bj)
#pragma unroll
                for (int n = 0; n < 2; ++n) {
                    const size_t c = off + bj * HALF + n * 16;
                    const f32x4 o = xv[g & 1][bj * 2 + n] + acc[ai][bj][m][n];
                    ss += (o[0] * o[0] + o[1] * o[1]) + (o[2] * o[2] + o[3] * o[3]);
                    typedef unsigned u32x2v __attribute__((ext_vector_type(2)));
                    u32x2v w; w.x = cvt_pk_bf16(o[0], o[1]); w.y = cvt_pk_bf16(o[2], o[3]);
                    *(u32x2v*)(xb + c) = w;
                }
            ss += __shfl_xor(ss, 16); ss += __shfl_xor(ss, 32);
            if (fq == 0) atomicAdd(rowsq + row, ss);
        }
#undef EPR_LOAD
    }
};

struct EpiProj {
    static constexpr bool PERM = true, AFTER_DRAIN = false;
    bf16_t* O; int ldc; const float* qnw; const float* knw; const float* cosT; const float* sinT; PG8_LAS float* xch; int q_lo, k_lo, k_hi, seq_mask; float eps;
    __device__ __forceinline__ void operator()(const f32x4 (&acc)[2][2][4][2], const Unit& u, int wr, int wc, int fr, int fq) const {
        const int colt = u.pn * BM, row0 = u.pm * BM + wr * 64 + fr, col0 = colt + wc * 32 + 8 * fq;
        if (colt < q_lo || colt >= k_hi) {
#pragma unroll
            for (int ai = 0; ai < 2; ++ai)
#pragma unroll
                for (int m = 0; m < 4; ++m) { bf16_t* rowp = O + (size_t)(row0 + ai * HALF + m * 16) * ldc + col0;
#pragma unroll
                    for (int bj = 0; bj < 2; ++bj) { const f32x4 v0 = acc[ai][bj][m][0], v1 = acc[ai][bj][m][1];
                        u32x4 w; w.x = cvt_pk_bf16(v0[0], v0[1]); w.y = cvt_pk_bf16(v0[2], v0[3]); w.z = cvt_pk_bf16(v1[0], v1[1]); w.w = cvt_pk_bf16(v1[2], v1[3]);
                        *(u32x4*)(rowp + bj * HALF) = w; } }
            return;
        }
        const float* nw = colt < k_lo ? qnw : knw;
#pragma unroll
        for (int ai = 0; ai < 2; ++ai)
#pragma unroll
            for (int m = 0; m < 4; ++m)
#pragma unroll
                for (int bj = 0; bj < 2; ++bj) {
                    const f32x4 a = acc[ai][bj][m][0], b = acc[ai][bj][m][1];
                    float ss = ((a[0] * a[0] + a[1] * a[1]) + (a[2] * a[2] + a[3] * a[3])) + ((b[0] * b[0] + b[1] * b[1]) + (b[2] * b[2] + b[3] * b[3]));
                    ss += __shfl_xor(ss, 16); ss += __shfl_xor(ss, 32);
                    if (fq == 0) xch[((ai * HALF + wr * 64 + m * 16 + fr) * 4 + bj * 2 + (wc >> 1)) * 2 + (wc & 1)] = ss;
                }
        asm volatile("s_waitcnt lgkmcnt(0)" ::: "memory"); __builtin_amdgcn_s_barrier(); asm volatile("" ::: "memory");
        float wv[8];
#pragma unroll
        for (int n = 0; n < 2; ++n)
#pragma unroll
            for (int j = 0; j < 4; ++j) wv[4 * n + j] = nw[32 * (wc & 1) + 8 * fq + 4 * n + j];
        const bool rot = ((wc & 1) == 0) && (fq < 2);
#pragma unroll
        for (int ai = 0; ai < 2; ++ai)
#pragma unroll
            for (int m = 0; m < 4; ++m) {
                const int rl = ai * HALF + wr * 64 + m * 16 + fr, row = u.pm * BM + rl, pos = row & seq_mask;
                f32x4 cs0 = {1.f, 1.f, 1.f, 1.f}, cs1 = cs0, sn0 = {0.f, 0.f, 0.f, 0.f}, sn1 = sn0;
                if (rot) { cs0 = *(const f32x4*)(cosT + pos * 8); cs1 = *(const f32x4*)(cosT + pos * 8 + 4); sn0 = *(const f32x4*)(sinT + pos * 8); sn1 = *(const f32x4*)(sinT + pos * 8 + 4); }
                bf16_t* rowp = O + (size_t)row * ldc + col0;
#pragma unroll
                for (int bj = 0; bj < 2; ++bj) {
                    const int xi = (rl * 4 + bj * 2 + (wc >> 1)) * 2;
                    const float rs = 1.0f / sqrtf((xch[xi] + xch[xi + 1]) * (1.f / 64.f) + eps);
                    f32x4 y0 = acc[ai][bj][m][0] * rs, y1 = acc[ai][bj][m][1] * rs;
#pragma unroll
                    for (int j = 0; j < 4; ++j) { y0[j] *= wv[j]; y1[j] *= wv[4 + j]; }
                    f32x4 p0, p1;
#pragma unroll
                    for (int j = 0; j < 4; ++j) { p0[j] = __shfl_xor(y0[j], 16); p1[j] = __shfl_xor(y1[j], 16); }
                    if (rot) {
                        if (fq == 0) { y0 = y0 * cs0 - p0 * sn0; y1 = y1 * cs1 - p1 * sn1; }
                        else { y0 = p0 * sn0 + y0 * cs0; y1 = p1 * sn1 + y1 * cs1; }
                    }
                    u32x4 w; w.x = cvt_pk_bf16(y0[0], y0[1]); w.y = cvt_pk_bf16(y0[2], y0[3]); w.z = cvt_pk_bf16(y1[0], y1[1]); w.w = cvt_pk_bf16(y1[2], y1[3]);
                    *(u32x4*)(rowp + bj * HALF) = w;
                }
            }
    }
};

template <class Epi, class Sched, bool ALIGN_EPI = false, bool SP2 = false>
__device__ __forceinline__ void gemm_phase(PG8_LAS unsigned char* lds, const Gemm g, const Sched& S, const Epi& E) {
    const int tid = threadIdx.x, wid = __builtin_amdgcn_readfirstlane(tid >> 6), lane = tid & 63, wr = wid >> 2, wc = wid & 3, fr = lane & 15, fq = lane >> 4;
    const int K = g.K, nt = K / BK;
    unsigned voffA[2], voffB[2];
#pragma unroll
    for (int i = 0; i < 2; ++i) { int R, C; stage_rc(tid * 16 + i * 8192, R, C); const int Rb = Epi::PERM ? ((R & ~31) + perm32(R & 31)) : R;
        voffA[i] = (unsigned)(R * K + C) * 2u; voffB[i] = (unsigned)(Rb * K + C) * 2u; }
    const size_t kstep = (size_t)(BK * 2);
    const size_t hstep = (size_t)HALF * K * 2;
    const size_t tstep = 2 * hstep;
    const unsigned ldsw = (unsigned)wid * 1024u;
    const int aoff = lds_byte(wr * 64 + fr, fq * 8), boff = lds_byte(wc * 32 + fr, fq * 8);
#define PG8_SA(b, h) (((b) * 2 + (h)) * HTB)
#define PG8_SB(b, h) ((4 + (b) * 2 + (h)) * HTB)
#define PG8_STAGE(bufoff, gbase, voff) do { _Pragma("unroll") for (int _i = 0; _i < 2; ++_i) \
        __builtin_amdgcn_global_load_lds((const unsigned*)((const char*)(gbase) + (voff)[_i]), (PG8_LAS unsigned*)(lds + (bufoff) + ldsw + _i * 8192), 16, 0, 0); } while (0)
#define PG8_LDA(dst, b, h) do { _Pragma("unroll") for (int m = 0; m < 4; ++m) _Pragma("unroll") for (int k = 0; k < 2; ++k) dst[m][k] = *(const PG8_LAS bf16x8*)(lds + PG8_SA(b, h) + aoff + m * 2048 + k * 1024); } while (0)
#define PG8_LDB(dst, b, h) do { _Pragma("unroll") for (int n = 0; n < 2; ++n) _Pragma("unroll") for (int k = 0; k < 2; ++k) dst[n][k] = *(const PG8_LAS bf16x8*)(lds + PG8_SB(b, h) + boff + n * 2048 + k * 1024); } while (0)
#define PG8_MMA(ai, bj, At, Bt) do { __builtin_amdgcn_s_setprio(1); _Pragma("unroll") for (int m = 0; m < 4; ++m) _Pragma("unroll") for (int n = 0; n < 2; ++n) _Pragma("unroll") for (int k = 0; k < 2; ++k) \
        acc[ai][bj][m][n] = __builtin_amdgcn_mfma_f32_16x16x32_bf16(Bt[n][k], At[m][k], acc[ai][bj][m][n], 0, 0, 0); __builtin_amdgcn_s_setprio(0); } while (0)
#define PG8_WAIT_V(n) asm volatile("s_waitcnt vmcnt(" #n ")" ::: "memory")
#define PG8_WAIT_L(n) asm volatile("s_waitcnt lgkmcnt(" #n ")" ::: "memory")
#define PG8_BAR __builtin_amdgcn_s_barrier()
#define PG8_SCHED __builtin_amdgcn_sched_barrier(0)
    Unit cur, nxt; int ui = 0;
    if (!S.next(0, cur)) return;
    f32x4 acc[2][2][4][2];
#pragma unroll
    for (int a = 0; a < 2; ++a)
#pragma unroll
        for (int b = 0; b < 2; ++b)
#pragma unroll
            for (int m = 0; m < 4; ++m)
#pragma unroll
                for (int n = 0; n < 2; ++n) acc[a][b][m][n] = (f32x4){0.f, 0.f, 0.f, 0.f};
    bf16x8 At[4][2], B0[2][2], B1[2][2];
    const char* cA = (const char*)g.A + (size_t)cur.pm * tstep; const char* cB = (const char*)g.Bt + (size_t)cur.pn * tstep;
    S.a_ready(cur);
    if constexpr (SP2) {
        PG8_STAGE(PG8_SB(0, 0), cB, voffB); PG8_STAGE(PG8_SB(0, 1), cB + hstep, voffB); PG8_STAGE(PG8_SA(0, 0), cA, voffA); PG8_STAGE(PG8_SA(0, 1), cA + hstep, voffA);
        if (wr == 1) PG8_BAR;
        PG8_WAIT_V(2); PG8_BAR;
        PG8_STAGE(PG8_SB(1, 0), cB + kstep, voffB); PG8_STAGE(PG8_SA(1, 0), cA + kstep, voffA); PG8_STAGE(PG8_SB(1, 1), cB + hstep + kstep, voffB);
        PG8_WAIT_V(6); PG8_BAR;
    } else {
        PG8_STAGE(PG8_SB(0, 0), cB, voffB); PG8_STAGE(PG8_SA(0, 0), cA, voffA); PG8_STAGE(PG8_SB(0, 1), cB + hstep, voffB); PG8_STAGE(PG8_SA(0, 1), cA + hstep, voffA);
        if (wr == 1) PG8_BAR;
        PG8_WAIT_V(4); PG8_BAR;
        PG8_STAGE(PG8_SB(1, 0), cB + kstep, voffB); PG8_STAGE(PG8_SA(1, 0), cA + kstep, voffA); PG8_STAGE(PG8_SB(1, 1), cB + hstep + kstep, voffB);
        PG8_WAIT_V(6); PG8_BAR;
    }
    for (;;) {
        const bool has_next = S.next(ui + 1, nxt);
        const char* nA = has_next ? (const char*)g.A + (size_t)nxt.pm * tstep : cA; const char* nB = has_next ? (const char*)g.Bt + (size_t)nxt.pn * tstep : cB;
        for (int t = 0; t < nt; t += 2) {
            const bool last = (t == nt - 2);
            const char* a1 = cA + (size_t)(t + 1) * kstep;
            const char* a2 = last ? nA : cA + (size_t)(t + 2) * kstep; const char* b2 = last ? nB : cB + (size_t)(t + 2) * kstep;
            const char* a3 = a2 + kstep; const char* b3 = b2 + kstep;
            if (last && has_next) S.a_ready(nxt);
            if constexpr (SP2) {
            PG8_LDB(B0, 0, 0); PG8_LDB(B1, 0, 1); PG8_SCHED; PG8_LDA(At, 0, 0); PG8_STAGE(PG8_SA(1, 1), a1 + hstep, voffA);
            PG8_WAIT_V(8); PG8_WAIT_L(0); PG8_BAR; PG8_MMA(0, 0, At, B0); PG8_MMA(0, 1, At, B1); PG8_BAR; PG8_SCHED;
            PG8_LDA(At, 0, 1); PG8_STAGE(PG8_SB(0, 0), b2, voffB); PG8_STAGE(PG8_SB(0, 1), b2 + hstep, voffB); PG8_STAGE(PG8_SA(0, 0), a2, voffA);
            PG8_WAIT_V(8); PG8_WAIT_L(0); PG8_BAR; PG8_MMA(1, 0, At, B0); PG8_MMA(1, 1, At, B1); PG8_BAR; PG8_SCHED;
            PG8_LDB(B0, 1, 0); PG8_LDB(B1, 1, 1); PG8_SCHED; PG8_LDA(At, 1, 0); PG8_STAGE(PG8_SA(0, 1), a2 + hstep, voffA);
            PG8_WAIT_V(8); PG8_WAIT_L(0); PG8_BAR; PG8_MMA(0, 0, At, B0); PG8_MMA(0, 1, At, B1); PG8_BAR; PG8_SCHED;
            PG8_LDA(At, 1, 1); PG8_STAGE(PG8_SB(1, 0), b3, voffB); PG8_STAGE(PG8_SB(1, 1), b3 + hstep, voffB); PG8_STAGE(PG8_SA(1, 0), a3, voffA);
            PG8_WAIT_V(8); PG8_WAIT_L(0); PG8_BAR; PG8_MMA(1, 0, At, B0); PG8_MMA(1, 1, At, B1); PG8_BAR; PG8_SCHED;
            } else {
            PG8_LDB(B0, 0, 0); PG8_SCHED; PG8_LDA(At, 0, 0); PG8_STAGE(PG8_SA(1, 1), a1 + hstep, voffA);
            PG8_WAIT_L(8); PG8_BAR; PG8_WAIT_L(0); PG8_MMA(0, 0, At, B0); PG8_BAR; PG8_SCHED;
            PG8_LDB(B1, 0, 1); PG8_STAGE(PG8_SB(0, 0), b2, voffB);
            PG8_BAR; PG8_WAIT_L(0); PG8_MMA(0, 1, At, B1); PG8_BAR;
            PG8_LDA(At, 0, 1); PG8_STAGE(PG8_SA(0, 0), a2, voffA);
            PG8_BAR; PG8_WAIT_L(0); PG8_MMA(1, 0, At, B0); PG8_BAR; PG8_SCHED;
            PG8_STAGE(PG8_SB(0, 1), b2 + hstep, voffB);
            PG8_WAIT_V(6); PG8_BAR; PG8_MMA(1, 1, At, B1); PG8_BAR;
            PG8_LDB(B0, 1, 0); PG8_SCHED; PG8_LDA(At, 1, 0); PG8_STAGE(PG8_SA(0, 1), a2 + hstep, voffA);
            PG8_WAIT_L(8); PG8_BAR; PG8_WAIT_L(0); PG8_MMA(0, 0, At, B0); PG8_BAR; PG8_SCHED;
            PG8_LDB(B1, 1, 1); PG8_STAGE(PG8_SB(1, 0), b3, voffB);
            PG8_BAR; PG8_WAIT_L(0); PG8_MMA(0, 1, At, B1); PG8_BAR;
            PG8_LDA(At, 1, 1); PG8_STAGE(PG8_SA(1, 0), a3, voffA);
            PG8_BAR; PG8_WAIT_L(0); PG8_MMA(1, 0, At, B0); PG8_BAR; PG8_SCHED;
            PG8_STAGE(PG8_SB(1, 1), b3 + hstep, voffB);
            PG8_WAIT_V(6); PG8_BAR; PG8_MMA(1, 1, At, B1); PG8_BAR;
            }
        }
        if constexpr (ALIGN_EPI) { if (wr == 0) PG8_BAR; }
        if constexpr (!Epi::AFTER_DRAIN) { E(acc, cur, wr, wc, fr, fq); S.done(cur); }
        if (!has_next) break;
#pragma unroll
        for (int a = 0; a < 2; ++a)
#pragma unroll
            for (int b = 0; b < 2; ++b)
#pragma unroll
                for (int m = 0; m < 4; ++m)
#pragma unroll
                    for (int n = 0; n < 2; ++n) acc[a][b][m][n] = (f32x4){0.f, 0.f, 0.f, 0.f};
        cur = nxt; cA = nA; cB = nB; ++ui;
        if constexpr (ALIGN_EPI) { if (wr == 1) PG8_BAR; }
    }
    PG8_WAIT_V(0);
    if constexpr (!ALIGN_EPI) { if (wr == 0) PG8_BAR; }
    PG8_BAR;
    if constexpr (Epi::AFTER_DRAIN) { E.fused(acc, cur, wr, wc, fr, fq, lds, wid, lane); S.done(cur); }
#undef PG8_SA
#undef PG8_SB
#undef PG8_STAGE
#undef PG8_LDA
#undef PG8_LDB
#undef PG8_MMA
#undef PG8_WAIT_V
#undef PG8_WAIT_L
#undef PG8_BAR
#undef PG8_SCHED
}
}

struct Params {
    const float* in[22];
    float* out;
    unsigned char* ws;
    int ph_lo, ph_hi;
};
struct Ctx { LAS unsigned char* lds; int tid, lane, wave, vcu, G, gw, ngw; unsigned long long ta, tb, tc; };

__device__ __forceinline__ void p0_transpose_item(const float* W, int K, int Nreal, int thresh, const float* ksc, bf16_t* WT, LAS float* scr, int item, int nblk, int lane) {
    const int kb = item / nblk, nb = item % nblk, k0 = 64 * kb, n0 = 32 * nb;
    const int nr0 = n0 + (n0 >= thresh ? 8 : 0);
#pragma unroll 8
    for (int i = 0; i < 32; ++i) {
        const int kk = 2 * i + (lane >> 5);
        const float sc = ksc ? ksc[k0 + kk] : 1.f;
        scr[kk * 33 + (lane & 31)] = W[(size_t)(k0 + kk) * Nreal + nr0 + (lane & 31)] * sc;
    }
    LDS_WAIT(); asm volatile("" ::: "memory");
    const int c = lane & 7;
#pragma unroll
    for (int j = 0; j < 4; ++j) {
        const int n = (lane >> 3) + 8 * j; const LAS float* s = scr + (8 * c) * 33 + n;
        u32x4 o; o.x = pk2(s[0 * 33], s[1 * 33]); o.y = pk2(s[2 * 33], s[3 * 33]); o.z = pk2(s[4 * 33], s[5 * 33]); o.w = pk2(s[6 * 33], s[7 * 33]);
        *(u32x4*)(WT + (size_t)(n0 + n) * K + k0 + 8 * c) = o;
    }
    LDS_WAIT(); asm volatile("" ::: "memory");
}

__device__ __forceinline__ void phase0(const Params& p, Ctx& F) {
    const float* x = p.in[0]; const float* mixw = p.in[1]; const float* w_in = p.in[2];
    const float* w_out = p.in[16]; const float* ffnw = p.in[17]; const float* w_q = p.in[18]; const float* keys = p.in[19];
    const float* pu = p.in[20]; const float* pv = p.in[21];
    unsigned char* ws = p.ws;
    LAS float* scr = (LAS float*)(F.lds + F.wave * 8448);
    LAS float* wdt = (LAS float*)(F.lds + 69632);
    {
        constexpr int WLD = 132;
        LAS float* WQS = (LAS float*)F.lds;
        LAS float* KYS = (LAS float*)(F.lds + 64 * WLD * 4);
        bf16_t* wefft = (bf16_t*)(ws + WS_WQT);
        for (int u = F.vcu; u < 256; u += F.G) {
            const int hj = u >> 4, kt = u & 15;
            __syncthreads();
#pragma unroll
            for (int i = 0; i < 4; ++i) {
                const int pc = F.tid + 512 * i, k = pc >> 5, d4 = pc & 31;
                const f32x4 v = *(const f32x4*)(w_q + (size_t)(64 * kt + k) * 2048 + hj * 128 + d4 * 4);
                *(LAS f32x4*)(WQS + k * WLD + d4 * 4) = v * ffnw[64 * kt + k];
            }
#pragma unroll
            for (int i = 0; i < 8; ++i) {
                const int pc = F.tid + 512 * i, n = pc >> 5, d4 = pc & 31;
                *(LAS f32x4*)(KYS + n * WLD + d4 * 4) = *(const f32x4*)(keys + ((size_t)hj * 128 + n) * 128 + d4 * 4);
            }
            __syncthreads();
            const int fr_ = F.lane & 15, fq_ = F.lane >> 4, mt = F.wave >> 1, nt0 = (F.wave & 1) * 4;
            f32x4 acc[4];
#pragma unroll
            for (int q = 0; q < 4; ++q) acc[q] = (f32x4){0.f, 0.f, 0.f, 0.f};
#pragma unroll 4
            for (int ks = 0; ks < 32; ++ks) {
                const float av = WQS[(mt * 16 + fr_) * WLD + 4 * ks + fq_];
#pragma unroll
                for (int q = 0; q < 4; ++q) {
                    const float bv = KYS[((nt0 + q) * 16 + fr_) * WLD + 4 * ks + fq_];
                    acc[q] = __builtin_amdgcn_mfma_f32_16x16x4f32(av, bv, acc[q], 0, 0, 0);
                }
            }
#pragma unroll
            for (int q = 0; q < 4; ++q) {
                u32x2 w; w.x = pk2(acc[q][0], acc[q][1]); w.y = pk2(acc[q][2], acc[q][3]);
                *(u32x2*)(wefft + ((size_t)hj * 128 + (nt0 + q) * 16 + fr_) * DM + 64 * kt + mt * 16 + 4 * fq_) = w;
            }
        }
        __syncthreads();
    }
    for (int k = F.tid; k < DM; k += 512) {
        const float s = mixw[k];
        const f32x4 a = *(const f32x4*)(w_in + (size_t)k * 3080 + 1536), b = *(const f32x4*)(w_in + (size_t)k * 3080 + 1540);
        *(LAS f32x4*)(wdt + k * 8) = a * s; *(LAS f32x4*)(wdt + k * 8 + 4) = b * s;
    }
    __syncthreads();
    constexpr int I_IN = 16 * 96, I_OUT = 16 * 32;
    for (int it = F.gw; it < I_IN + I_OUT; it += F.ngw) {
        int r = it;
        if (r < I_IN) { p0_transpose_item(w_in, DM, 3080, 1536, mixw, (bf16_t*)(ws + WS_WINT), scr, r, 96, F.lane); continue; } r -= I_IN;
        p0_transpose_item(w_out, DM, DM, 1 << 30, nullptr, (bf16_t*)(ws + WS_WOUTT), scr, r, 32, F.lane);
    }
    const int gtid = F.vcu * 512 + F.tid, nthr = F.G * 512;
    for (int i = gtid; i < TOK; i += nthr) ((float*)(ws + WS_CTL) + CW_ROWSQ)[i] = 0.f;
    for (int i = gtid; i < SEQ * 8; i += nthr) {
        const int pos = i >> 3, f = i & 7;
        const float inv = powf(500000.0f, -(float)(2 * f) / 16.0f);
        const float ang = (float)pos * inv;
        ((float*)(ws + WS_ROPE))[i] = cosf(ang);
        ((float*)(ws + WS_ROPE))[SEQ * 8 + i] = sinf(ang);
    }
    if (F.gw == 0) {
        const float a = p.in[11][F.lane] * p.in[12][F.lane], b = p.in[13][F.lane] * p.in[14][F.lane];
        const float sa = wave_sum(a), sb = wave_sum(b);
        if (F.lane == 0) ((float*)(ws + WS_MISC))[0] = expf(sa) - expf(sb) + LAMBDA_INIT;
    }
    {
        float* rsu = (float*)(ws + WS_RSU); float* rsv = (float*)(ws + WS_RSV);
        for (int r0 = F.gw; r0 < 2 * 16384; r0 += 4 * F.ngw) {
            f32x4 a[4][4]; float amax[4];
#pragma unroll
            for (int u = 0; u < 4; ++u) {
                const int r = min(r0 + u * F.ngw, 2 * 16384 - 1); const bool isU = r < 16384; const int e = r & 16383;
                const float* src = (isU ? pu : pv) + (size_t)e * DM + 16 * F.lane;
#pragma unroll
                for (int q = 0; q < 4; ++q) a[u][q] = __builtin_nontemporal_load((const f32x4*)(src + 4 * q));
            }
#pragma unroll
            for (int u = 0; u < 4; ++u) {
                const int r = min(r0 + u * F.ngw, 2 * 16384 - 1); const bool isU = r < 16384;
                amax[u] = 0.f;
#pragma unroll
                for (int q = 0; q < 4; ++q) {
                    if (isU) a[u][q] = a[u][q] * *(const f32x4*)(ffnw + 16 * F.lane + 4 * q);
                    amax[u] = fmaxf(amax[u], fmaxf(fmaxf(fabsf(a[u][q][0]), fabsf(a[u][q][1])), fmaxf(fabsf(a[u][q][2]), fabsf(a[u][q][3]))));
                }
            }
#pragma unroll
            for (int u = 0; u < 4; ++u) amax[u] = wave_max(amax[u]);
#pragma unroll
            for (int u = 0; u < 4; ++u) {
                const int r = min(r0 + u * F.ngw, 2 * 16384 - 1); const bool isU = r < 16384; const int e = r & 16383;
#ifdef U_FP4
#ifdef V_FP4
#define V_FP4_ON 1
#else
#define V_FP4_ON 0
#endif
#ifndef FP4_NIB_SWAP
#define FP4_NIB_SWAP 0
#endif
                if (isU || V_FP4_ON) {
                    const float s4 = amax[u] > 0.f ? 6.f / amax[u] : 1.f;
                    if (F.lane == 0) (isU ? rsu : rsv)[e] = amax[u] > 0.f ? amax[u] * (1.f / 6.f) : 1.f;
                    u32x2 o4;
#pragma unroll
                    for (int hq = 0; hq < 2; ++hq) {
                        unsigned w = 0u;
#pragma unroll
                        for (int q2 = 0; q2 < 2; ++q2)
#pragma unroll
                            for (int el = 0; el < 4; ++el) {
                                const float qv = a[u][hq * 2 + q2][el] * s4, m = fabsf(qv);
                                const unsigned c = (unsigned)(m > 0.25f) + (unsigned)(m > 0.75f) + (unsigned)(m > 1.25f) + (unsigned)(m > 1.75f) + (unsigned)(m > 2.5f) + (unsigned)(m > 3.5f) + (unsigned)(m > 5.0f)
                                                 + (qv < 0.f ? 8u : 0u);
                                w |= c << (4 * ((q2 * 4 + el) ^ FP4_NIB_SWAP));
                            }
                        o4[hq] = w;
                    }
                    *(u32x2*)(ws + (isU ? WS_UB : WS_VB) + (size_t)e * (DM / 2) + 8 * F.lane) = o4;
                    continue;
                }
#endif
                const float sc = amax[u] > 0.f ? 240.f / amax[u] : 1.f;
                if (F.lane == 0) (isU ? rsu : rsv)[e] = amax[u] > 0.f ? amax[u] * (1.f / 240.f) : 1.f;
                u32x4 o;
#pragma unroll
                for (int q = 0; q < 4; ++q) {
                    int pk = 0;
                    pk = __builtin_amdgcn_cvt_pk_fp8_f32(a[u][q][0] * sc, a[u][q][1] * sc, pk, false);
                    pk = __builtin_amdgcn_cvt_pk_fp8_f32(a[u][q][2] * sc, a[u][q][3] * sc, pk, true);
                    o[q] = (unsigned)pk;
                }
                *(u32x4*)(ws + (isU ? WS_UB : WS_VB) + (size_t)e * DM + 16 * F.lane) = o;
            }
        }
    }
    bf16_t* xb = (bf16_t*)(ws + WS_XB); float* dtraw = (float*)(ws + WS_DTRAW);
    for (int m0 = F.gw; m0 < TOK; m0 += 2 * F.ngw) {
        f32x4 v[2][4]; float ss[2];
#pragma unroll
        for (int u = 0; u < 2; ++u) {
            const int m = m0 + u * F.ngw; ss[u] = 0.f;
            const f32x4* xr = (const f32x4*)(x + (size_t)(m < TOK ? m : m0) * DM) + F.lane;
#pragma unroll
            for (int j = 0; j < 4; ++j) v[u][j] = __builtin_nontemporal_load(xr + 64 * j);
        }
#pragma unroll
        for (int u = 0; u < 2; ++u)
#pragma unroll
            for (int j = 0; j < 4; ++j) ss[u] += (v[u][j][0] * v[u][j][0] + v[u][j][1] * v[u][j][1]) + (v[u][j][2] * v[u][j][2] + v[u][j][3] * v[u][j][3]);
        f32x4 d0[2], d1[2];
#pragma unroll
        for (int u = 0; u < 2; ++u) { d0[u] = (f32x4){0.f, 0.f, 0.f, 0.f}; d1[u] = (f32x4){0.f, 0.f, 0.f, 0.f}; }
#pragma unroll
        for (int j = 0; j < 4; ++j)
#pragma unroll
            for (int e = 0; e < 4; ++e) {
                const int k = 256 * j + 4 * F.lane + e;
                const f32x4 w0 = *(const LAS f32x4*)(wdt + k * 8), w1 = *(const LAS f32x4*)(wdt + k * 8 + 4);
#pragma unroll
                for (int u = 0; u < 2; ++u) { d0[u] += w0 * v[u][j][e]; d1[u] += w1 * v[u][j][e]; }
            }
#pragma unroll
        for (int u = 0; u < 2; ++u) {
            ss[u] = wave_sum(ss[u]);
#pragma unroll
            for (int e = 0; e < 4; ++e) { d0[u][e] = wave_sum(d0[u][e]); d1[u][e] = wave_sum(d1[u][e]); }
        }
#pragma unroll
        for (int u = 0; u < 2; ++u) {
            const int m = m0 + u * F.ngw;
            if (m < TOK) {
                const float r = rsqrtf(ss[u] * (1.f / DM) + EPSN);
                if (F.lane == 0) { *(f32x4*)(dtraw + (size_t)m * 8) = d0[u] * r; *(f32x4*)(dtraw + (size_t)m * 8 + 4) = d1[u] * r; }
                unsigned long long* o8 = (unsigned long long*)(xb + (size_t)m * DM) + F.lane;
#pragma unroll
                for (int j = 0; j < 4; ++j) o8[64 * j] = (unsigned long long)pk2(v[u][j][0] * r, v[u][j][1] * r) | ((unsigned long long)pk2(v[u][j][2] * r, v[u][j][3] * r) << 32);
            }
        }
    }
}

__device__ __forceinline__ void p2_qk_prepass(const Params& p, Ctx& F) {
    bf16_t* proj = (bf16_t*)(p.ws + WS_PROJ);
    const float* qnw = p.in[9]; const float* knw = p.in[10];
    const float* cosT = (const float*)(p.ws + WS_ROPE); const float* sinT = cosT + SEQ * 8;
    const int sub = F.lane & 7;
    float wq[8], wk[8];
#pragma unroll
    for (int e = 0; e < 8; ++e) { wq[e] = qnw[sub * 8 + e]; wk[e] = knw[sub * 8 + e]; }
    for (int base = F.gw; base < TOK * 2; base += 8 * F.ngw) {
        u32x4 raw[8];
#pragma unroll
        for (int u = 0; u < 8; ++u) {
            const int wsi = base + u * F.ngw;
            raw[u] = (wsi < TOK * 2) ? *(const u32x4*)(proj + (size_t)(wsi >> 1) * NIN + ((wsi & 1) ? PK : PQ) + F.lane * 8) : (u32x4){0u, 0u, 0u, 0u};
        }
#pragma unroll
        for (int u = 0; u < 8; ++u) {
            const int wsi = base + u * F.ngw;
            const int t = wsi >> 1, which = wsi & 1;
            float v[8];
#pragma unroll
            for (int e = 0; e < 4; ++e) { v[2 * e] = bf2f(raw[u][e] & 0xffffu); v[2 * e + 1] = bf2f(raw[u][e] >> 16); }
            float ss = 0.f;
#pragma unroll
            for (int e = 0; e < 8; ++e) ss += v[e] * v[e];
            ss += __shfl_xor(ss, 1); ss += __shfl_xor(ss, 2); ss += __shfl_xor(ss, 4);
            const float rs = rsqrtf(ss * (1.f / 64.f) + EPSN);
            const int pos = t & (SEQ - 1);
            float o[8];
#pragma unroll
            for (int e = 0; e < 8; ++e) {
                const float y = v[e] * rs * (which ? wk[e] : wq[e]);
                const float other = __shfl_xor(y, 1);
                float r = y;
                if (sub < 2) {
                    const float c = cosT[pos * 8 + e], sn = sinT[pos * 8 + e];
                    r = (sub == 0) ? (y * c - other * sn) : (other * sn + y * c);
                }
                o[e] = r;
            }
            u32x4 ov; ov.x = pk2(o[0], o[1]); ov.y = pk2(o[2], o[3]); ov.z = pk2(o[4], o[5]); ov.w = pk2(o[6], o[7]);
            if (wsi < TOK * 2) *(u32x4*)(proj + (size_t)t * NIN + (which ? PK : PQ) + F.lane * 8) = ov;
        }
    }
}

constexpr int P2_XS = 0, P2_BM = 33792, P2_CM = 51200, P2_CB = 68608, P2_MH = 85248, P2_XW = 122112, P2_ACS = 155904, P2_DT = 156928, P2_FAC = 157952;
constexpr int XS_LD = 264, BM_LD = 136, MH_LD = 72, CB_LD = 65;
static_assert(P2_FAC + 1024 <= LDS_BYTES, "P2 LDS");

__device__ __forceinline__ void p2_load_raw(const bf16_t* proj, int tid, int b, int c, int g, u32x4 (&rv)[11]) {
    const int cg = tid & 63, rg = tid >> 6, lc = cg * 8;
    const int pcol = lc < 256 ? PXS + g * 256 + lc : (lc < 384 ? PBM + g * 128 + (lc - 256) : PCM + g * 128 + (lc - 384));
#pragma unroll
    for (int i = 0; i < 11; ++i) {
        const int f = c * CHUNK + rg * 8 - 3 + i;
        u32x4 v = {0u, 0u, 0u, 0u};
        if (f >= 0) v = *(const u32x4*)(proj + ((size_t)b * SEQ + f) * NIN + pcol);
        rv[i] = v;
    }
}
__device__ __forceinline__ void p2_ssd_unit(const Params& p, Ctx& F, int b, int c, int g, u32x4 (&rv)[11], bool has_next, int nb, int nc, int ng) {
    unsigned char* ws = p.ws;
    const bf16_t* proj = (const bf16_t*)(ws + WS_PROJ);
    bf16_t* ycat = (bf16_t*)(ws + WS_YCAT); bf16_t* cmc = (bf16_t*)(ws + WS_CMC);
    bf16_t* states = (bf16_t*)(ws + WS_STATES); float* acs_g = (float*)(ws + WS_ACS); float* cdec = (float*)(ws + WS_CDEC);
    const float* dtraw = (const float*)(ws + WS_DTRAW);
    const float* conv_w = p.in[3]; const float* conv_b = p.in[4]; const float* dt_bias = p.in[5]; const float* a_log = p.in[6]; const float* d_skip = p.in[7];
    LAS bf16_t* XS = (LAS bf16_t*)(F.lds + P2_XS); LAS bf16_t* BM = (LAS bf16_t*)(F.lds + P2_BM); LAS bf16_t* CM = (LAS bf16_t*)(F.lds + P2_CM);
    LAS float* CB = (LAS float*)(F.lds + P2_CB); LAS bf16_t* MH = (LAS bf16_t*)(F.lds + P2_MH); LAS bf16_t* XW = (LAS bf16_t*)(F.lds + P2_XW);
    LAS float* ACS = (LAS float*)(F.lds + P2_ACS); LAS float* DT = (LAS float*)(F.lds + P2_DT); LAS float* FAC = (LAS float*)(F.lds + P2_FAC);
    const int tid = F.tid, lane = F.lane, wave = F.wave, fr = lane & 15, fq = lane >> 4;
    const size_t tbase = (size_t)b * SEQ + (size_t)c * CHUNK;
#ifndef SKIP_A
    {
        const int cg = tid & 63, rg = tid >> 6, lc = cg * 8;
        int pcol, dld, dcol, kind;
        if (lc < 256) { pcol = PXS + g * 256 + lc; dld = XS_LD; dcol = lc; kind = 0; }
        else if (lc < 384) { pcol = PBM + g * 128 + (lc - 256); dld = BM_LD; dcol = lc - 256; kind = 1; }
        else { pcol = PCM + g * 128 + (lc - 384); dld = BM_LD; dcol = lc - 384; kind = 2; }
        LAS bf16_t* dst = kind == 0 ? XS : (kind == 1 ? BM : CM);
        const int ch = pcol - 512;
        float cw[4][8], cbv[8];
#pragma unroll
        for (int w = 0; w < 4; ++w) {
            const f32x4 a = *(const f32x4*)(conv_w + w * 1024 + ch), bq = *(const f32x4*)(conv_w + w * 1024 + ch + 4);
#pragma unroll
            for (int e = 0; e < 4; ++e) { cw[w][e] = a[e]; cw[w][4 + e] = bq[e]; }
        }
        { const f32x4 a = *(const f32x4*)(conv_b + ch), bq = *(const f32x4*)(conv_b + ch + 4);
#pragma unroll
          for (int e = 0; e < 4; ++e) { cbv[e] = a[e]; cbv[4 + e] = bq[e]; } }
#pragma unroll
        for (int r = 0; r < 8; ++r) {
            const int l = rg * 8 + r;
            float o[8];
#pragma unroll
            for (int e = 0; e < 8; ++e) o[e] = cbv[e];
#pragma unroll
            for (int w = 0; w < 4; ++w)
#pragma unroll
                for (int e = 0; e < 4; ++e) {
                    o[2 * e] += cw[w][2 * e] * bf2f(rv[r + w][e] & 0xffffu);
                    o[2 * e + 1] += cw[w][2 * e + 1] * bf2f(rv[r + w][e] >> 16);
                }
#pragma unroll
            for (int e = 0; e < 8; ++e) o[e] = silu_f(o[e]);
            u32x4 ov; ov.x = pk2(o[0], o[1]); ov.y = pk2(o[2], o[3]); ov.z = pk2(o[4], o[5]); ov.w = pk2(o[6], o[7]);
            *(LAS u32x4*)(dst + l * dld + dcol) = ov;
            if (kind == 2) *(u32x4*)(cmc + (tbase + l) * 256 + g * 128 + dcol) = ov;
        }
    }
#endif
    if (has_next) p2_load_raw(proj, tid, nb, nc, ng, rv);
    if (tid < 256) {
        const int l = tid >> 2, h = tid & 3, hh = g * 4 + h;
        const float v = dtraw[(tbase + l) * 8 + hh] + dt_bias[hh];
        const float dt = v > 20.f ? v : log1pf(expf(v));
        DT[l * 4 + h] = dt;
        ACS[l * 4 + h] = dt * (-expf(a_log[hh]));
    }
    __syncthreads();
    if (wave < 4) {
        float s = ACS[lane * 4 + wave];
#pragma unroll
        for (int o = 1; o < 64; o <<= 1) { const float t = __shfl_up(s, o); if (lane >= o) s += t; }
        ACS[lane * 4 + wave] = s;
        if (lane == 63) cdec[((size_t)b * NCH + c) * 8 + g * 4 + wave] = expf(s);
    }
    __syncthreads();
    if (tid < 256) {
        const int l = tid >> 2, h = tid & 3;
        acs_g[(tbase + l) * 8 + g * 4 + h] = ACS[l * 4 + h];
        FAC[l * 4 + h] = DT[l * 4 + h] * expf(ACS[63 * 4 + h] - ACS[l * 4 + h]);
    }
#pragma unroll
    for (int q = 0; q < 2; ++q) {
        const int tile = wave * 2 + q, mt = tile >> 2, nt = tile & 3;
        f32x4 acc = {0.f, 0.f, 0.f, 0.f};
#pragma unroll
        for (int ks = 0; ks < 4; ++ks) {
            const bf16x8 a = *(const LAS bf16x8*)(CM + (mt * 16 + fr) * BM_LD + ks * 32 + fq * 8);
            const bf16x8 bq = *(const LAS bf16x8*)(BM + (nt * 16 + fr) * BM_LD + ks * 32 + fq * 8);
            acc = mfma16(a, bq, acc);
        }
#pragma unroll
        for (int j = 0; j < 4; ++j) CB[(mt * 16 + 4 * fq + j) * CB_LD + nt * 16 + fr] = acc[j];
    }
    __syncthreads();
    {
        const int sI = lane;
        float as_[4], ds_[4];
#pragma unroll
        for (int h = 0; h < 4; ++h) { as_[h] = ACS[sI * 4 + h]; ds_[h] = DT[sI * 4 + h]; }
#pragma unroll 2
        for (int li = 0; li < 8; ++li) {
            const int l = li * 8 + wave;
            const float cb = CB[l * CB_LD + sI];
#pragma unroll
            for (int h = 0; h < 4; ++h) {
                const float v = (sI <= l) ? cb * __expf(ACS[l * 4 + h] - as_[h]) * ds_[h] : 0.f;
                MH[(h * 64 + l) * MH_LD + sI] = (bf16_t)f2bf(v);
            }
        }
#pragma unroll
        for (int i = 0; i < 4; ++i) {
            const int pc = tid + 512 * i, l = pc >> 5, c8 = pc & 31;
            const u32x4 xv = *(const LAS u32x4*)(XS + l * XS_LD + c8 * 8);
            const float f = FAC[l * 4 + (c8 >> 3)];
            u32x4 o;
#pragma unroll
            for (int e = 0; e < 4; ++e) o[e] = pk2(bf2f(xv[e] & 0xffffu) * f, bf2f(xv[e] >> 16) * f);
            *(LAS u32x4*)(XW + l * XS_LD + c8 * 8) = o;
        }
    }
    __syncthreads();
    typedef short v4i16 __attribute__((ext_vector_type(4)));
#define TR16(PTR) __builtin_amdgcn_ds_read_tr16_b64_v4i16((LAS v4i16*)(PTR))
#define CAT8(LO, HI) (bf16x8){LO[0], LO[1], LO[2], LO[3], HI[0], HI[1], HI[2], HI[3]}
    const int trr = fr >> 2, trc = 4 * (fr & 3);
#ifndef SKIP_E
    {
        const int h = wave >> 1, hh = g * 4 + h; const float dsk = d_skip[hh];
#pragma unroll 1
        for (int mq = 0; mq < 2; ++mq) {
            const int lt = 2 * (wave & 1) + mq;
            bf16x8 bmh[2];
#pragma unroll
            for (int ks = 0; ks < 2; ++ks) bmh[ks] = *(const LAS bf16x8*)(MH + (h * 64 + lt * 16 + fr) * MH_LD + ks * 32 + fq * 8);
#pragma unroll 1
            for (int pt = 0; pt < 4; ++pt) {
                f32x4 acc = {0.f, 0.f, 0.f, 0.f};
#pragma unroll
                for (int ks = 0; ks < 2; ++ks) {
                    const LAS bf16_t* bp = XS + (ks * 32 + 8 * fq + trr) * XS_LD + h * 64 + pt * 16 + trc;
                    const v4i16 lo = TR16(bp), hi = TR16(bp + 4 * XS_LD);
                    acc = mfma16(CAT8(lo, hi), bmh[ks], acc);
                }
                const int l = lt * 16 + fr, pp = pt * 16 + 4 * fq;
                const u32x2 xv = *(const LAS u32x2*)(XS + l * XS_LD + h * 64 + pp);
                u32x2 w;
                w.x = pk2(acc[0] + bf2f(xv.x & 0xffffu) * dsk, acc[1] + bf2f(xv.x >> 16) * dsk);
                w.y = pk2(acc[2] + bf2f(xv.y & 0xffffu) * dsk, acc[3] + bf2f(xv.y >> 16) * dsk);
                *(u32x2*)(ycat + (tbase + l) * DM + g * 256 + h * 64 + pp) = w;
            }
        }
    }
#endif
#ifndef SKIP_F
    {
        const int h = wave >> 1, hh = g * 4 + h;
        bf16_t* sbase = states + (((size_t)b * NCH + c) * 8 + hh) * 64 * 128;
#pragma unroll 1
        for (int mq = 0; mq < 2; ++mq) {
            const int mt = 2 * (wave & 1) + mq;
            bf16x8 xw[2];
#pragma unroll
            for (int ks = 0; ks < 2; ++ks) {
                const LAS bf16_t* bp = XW + (ks * 32 + 8 * fq + trr) * XS_LD + h * 64 + mt * 16 + trc;
                const v4i16 lo = TR16(bp), hi = TR16(bp + 4 * XS_LD);
                xw[ks] = CAT8(lo, hi);
            }
#pragma unroll 1
            for (int nt = 0; nt < 8; ++nt) {
                f32x4 acc = {0.f, 0.f, 0.f, 0.f};
#pragma unroll
                for (int ks = 0; ks < 2; ++ks) {
                    const LAS bf16_t* ap = BM + (ks * 32 + 8 * fq + trr) * BM_LD + nt * 16 + trc;
                    const v4i16 lo = TR16(ap), hi = TR16(ap + 4 * BM_LD);
                    acc = mfma16(CAT8(lo, hi), xw[ks], acc);
                }
                u32x2 w; w.x = pk2(acc[0], acc[1]); w.y = pk2(acc[2], acc[3]);
                *(u32x2*)(sbase + (size_t)(mt * 16 + fr) * 128 + nt * 16 + 4 * fq) = w;
            }
        }
    }
#undef TR16
#undef CAT8
#endif
    __syncthreads();
}

__device__ __forceinline__ void phase2(const Params& p, Ctx& F) {
#if defined(PROBE_PHASE) && (PROBE_PHASE == 20 || PROBE_PHASE == 21)
    F.ta = __builtin_amdgcn_s_memrealtime();
#endif
#ifdef USE_QK_PREPASS
    p2_qk_prepass(p, F);
#endif
#if defined(PROBE_PHASE) && (PROBE_PHASE == 20 || PROBE_PHASE == 21)
    VM_WAIT(); F.tb = __builtin_amdgcn_s_memrealtime();
#endif
    {
        const bf16_t* proj = (const bf16_t*)(p.ws + WS_PROJ);
        u32x4 rv[11];
        if (F.vcu < NB * NCH * 2) p2_load_raw(proj, F.tid, F.vcu >> 7, (F.vcu >> 1) & 63, F.vcu & 1, rv);
        for (int u = F.vcu; u < NB * NCH * 2; u += F.G) {
            const int g = u & 1, c = (u >> 1) & 63, b = u >> 7;
            const int un = u + F.G;
            p2_ssd_unit(p, F, b, c, g, rv, un < NB * NCH * 2, un >> 7, (un >> 1) & 63, un & 1);
        }
    }
#if defined(PROBE_PHASE) && (PROBE_PHASE == 20 || PROBE_PHASE == 21)
    VM_WAIT(); F.tc = __builtin_amdgcn_s_memrealtime();
#endif
}

__device__ __forceinline__ void p3_scan(const Params& p, Ctx& F) {
    bf16_t* states = (bf16_t*)(p.ws + WS_STATES); const float* cdec = (const float*)(p.ws + WS_CDEC);
    const int gtid = F.vcu * 512 + F.tid, nthr = F.G * 512;
    for (int e = gtid; e < NB * 8 * 64 * 32; e += nthr) {
        const int n4 = e & 31, pp = (e >> 5) & 63, hh = (e >> 11) & 7, b = e >> 14;
        f32x4 carry = {0.f, 0.f, 0.f, 0.f};
        for (int c0 = 0; c0 < NCH; c0 += 16) {
            u32x2 s[16]; float dc[16];
#pragma unroll
            for (int i = 0; i < 16; ++i) {
                s[i] = *(const u32x2*)(states + ((((size_t)b * NCH + c0 + i) * 8 + hh) * 64 + pp) * 128 + n4 * 4);
                dc[i] = cdec[((size_t)b * NCH + c0 + i) * 8 + hh];
            }
#pragma unroll
            for (int i = 0; i < 16; ++i) {
                u32x2 w; w.x = pk2(carry[0], carry[1]); w.y = pk2(carry[2], carry[3]);
                *(u32x2*)(states + ((((size_t)b * NCH + c0 + i) * 8 + hh) * 64 + pp) * 128 + n4 * 4) = w;
                const f32x4 sv = {bf2f(s[i].x & 0xffffu), bf2f(s[i].x >> 16), bf2f(s[i].y & 0xffffu), bf2f(s[i].y >> 16)};
                carry = carry * dc[i] + sv;
            }
        }
    }
}

namespace att {
constexpr int NW = 8, QBLK = 32, KVBLK = 64;
constexpr float SCALE = 0.125f, THR = 8.f;
constexpr int SHM_V = KVBLK * 128 * 2, SHM_K = KVBLK * 64 * 2;
constexpr int LDS_V = 0, LDS_K = 2 * SHM_V, LDS_WS = LDS_K + 2 * SHM_K, LDS_END = LDS_WS + NW * 64 * 4;
#define KSWZ64(row, colB) ((row) * 128 + ((colB) ^ ((((row) >> 1) & 7) << 4)))
#define SBAR() __builtin_amdgcn_sched_barrier(0)
__device__ __forceinline__ int crow(int r, int hi) { return (r & 3) + 8 * (r >> 2) + 4 * hi; }
__device__ __forceinline__ unsigned cvtpk(float lo, float hi) { unsigned r; asm volatile("v_cvt_pk_bf16_f32 %0, %1, %2" : "=v"(r) : "v"(lo), "v"(hi)); return r; }

__device__ __forceinline__ void partialSM(f32x16& p0, f32x16& p1, float& m_reg, float& mn, float& alpha) {
    constexpr float C = SCALE * 1.4426950408889634f;
    float pmax = p0[0];
#pragma unroll
    for (int r = 1; r < 16; ++r) pmax = fmaxf(pmax, p0[r]);
#pragma unroll
    for (int r = 0; r < 16; ++r) pmax = fmaxf(pmax, p1[r]);
    { auto rr = __builtin_amdgcn_permlane32_swap(__float_as_uint(pmax), __float_as_uint(pmax), false, false);
      pmax = fmaxf(__uint_as_float(rr[0]), __uint_as_float(rr[1])); }
    if (__builtin_expect(__all(pmax - m_reg <= THR / SCALE), 1)) { mn = m_reg; alpha = 1.f; }
    else { mn = fmaxf(m_reg, pmax); alpha = __builtin_amdgcn_exp2f((m_reg - mn) * C); m_reg = mn; }
    const float mnC = -mn * C;
#pragma unroll
    for (int r = 0; r < 16; ++r) p0[r] = fmaf(p0[r], C, mnC);
#pragma unroll
    for (int r = 0; r < 16; ++r) p1[r] = fmaf(p1[r], C, mnC);
#pragma unroll
    for (int r = 0; r < 16; ++r) p0[r] = __builtin_amdgcn_exp2f(p0[r]);
}
__device__ __forceinline__ void finishSM(f32x16& p0, f32x16& p1, float alpha, float& l_reg, bf16x8& pa0, bf16x8& pa1, bf16x8& pa2, bf16x8& pa3) {
#pragma unroll
    for (int r = 0; r < 16; ++r) p1[r] = __builtin_amdgcn_exp2f(p1[r]);
    float ps = 0;
#pragma unroll
    for (int r = 0; r < 16; ++r) ps += p0[r];
#pragma unroll
    for (int r = 0; r < 16; ++r) ps += p1[r];
    { auto rr = __builtin_amdgcn_permlane32_swap(__float_as_uint(ps), __float_as_uint(ps), false, false);
      ps = __uint_as_float(rr[0]) + __uint_as_float(rr[1]); }
    l_reg = l_reg * alpha + ps;
#define PK4(P, BASE, OUT) do { unsigned a0 = cvtpk(P[BASE + 0], P[BASE + 1]), a1 = cvtpk(P[BASE + 2], P[BASE + 3]);   \
    unsigned b0 = cvtpk(P[BASE + 4], P[BASE + 5]), b1 = cvtpk(P[BASE + 6], P[BASE + 7]);                              \
    auto r0 = __builtin_amdgcn_permlane32_swap(a0, b0, false, false); auto r1 = __builtin_amdgcn_permlane32_swap(a1, b1, false, false); \
    u32x4 w = {r0[0], r1[0], r0[1], r1[1]}; OUT = *reinterpret_cast<bf16x8*>(&w); } while (0)
    PK4(p0, 0, pa0); PK4(p0, 8, pa1); PK4(p1, 0, pa2); PK4(p1, 8, pa3);
#undef PK4
}
__device__ __forceinline__ void qkt(f32x16& p0, f32x16& p1, const char* Ks, const bf16x8* qr, int r32, int hi) {
    p0 = f32x16{}; p1 = f32x16{};
#pragma unroll
    for (int d0 = 0; d0 < 4; ++d0) {
        const int cb = (d0 * 16 + hi * 8) * 2;
        const bf16x8 b0 = *reinterpret_cast<const bf16x8*>(Ks + KSWZ64(r32, cb));
        const bf16x8 b1 = *reinterpret_cast<const bf16x8*>(Ks + KSWZ64(32 + r32, cb));
        p0 = mfma32(b0, qr[d0], p0);
        p1 = mfma32(b1, qr[d0], p1);
    }
}
__device__ __forceinline__ void maskfill(f32x16& p0, f32x16& p1, bool m) {
    if (m) {
        asm volatile("; masked tile");
#pragma unroll
        for (int r = 0; r < 16; ++r) { p0[r] = -1e30f; p1[r] = -1e30f; }
    }
}
__device__ __forceinline__ int v_st(int k, int c) { const int kk = (k & ~0xC) | ((k & 4) << 1) | ((k & 8) >> 1); return ((kk >> 3) * 4 + (c >> 5)) * 512 + ((kk & 7) * 32 + (c & 31)) * 2; }
__device__ __forceinline__ int v_rd_base(int lane) { return ((lane & 3) << 3) | (((lane >> 2) & 3) << 6) | (((lane >> 4) & 1) << 5) | (((lane >> 5) & 1) << 8); }
constexpr int v_rd_off(int d0, int ks, int half) { return d0 * 512 + ks * 4096 + half * 2048; }
template <int OFF> __device__ __forceinline__ s16x4 tr_read(int vb) {
    s16x4 r; asm volatile("ds_read_b64_tr_b16 %0, %1 offset:%2" : "=&v"(r) : "v"(vb), "i"(OFF) : "memory"); return r;
}
template <int D0> __device__ __forceinline__ void pv_one(f32x16& od, int vb, bf16x8 pa0, bf16x8 pa1, bf16x8 pa2, bf16x8 pa3) {
    const s16x4 l0 = tr_read<v_rd_off(D0, 0, 0)>(vb), h0 = tr_read<v_rd_off(D0, 0, 1)>(vb), l1 = tr_read<v_rd_off(D0, 1, 0)>(vb), h1 = tr_read<v_rd_off(D0, 1, 1)>(vb);
    const s16x4 l2 = tr_read<v_rd_off(D0, 2, 0)>(vb), h2 = tr_read<v_rd_off(D0, 2, 1)>(vb), l3 = tr_read<v_rd_off(D0, 3, 0)>(vb), h3 = tr_read<v_rd_off(D0, 3, 1)>(vb);
    asm volatile("s_waitcnt lgkmcnt(0)" ::: "memory"); SBAR();
#define PKV(L, H) (bf16x8){L[0], L[1], L[2], L[3], H[0], H[1], H[2], H[3]}
    od = mfma32(pa0, PKV(l0, h0), od);
    od = mfma32(pa1, PKV(l1, h1), od);
    od = mfma32(pa2, PKV(l2, h2), od);
    od = mfma32(pa3, PKV(l3, h3), od);
#undef PKV
}
__device__ __forceinline__ void pv_d0(f32x16* o, int vb, bf16x8 pa0, bf16x8 pa1, bf16x8 pa2, bf16x8 pa3) {
    pv_one<0>(o[0], vb, pa0, pa1, pa2, pa3); pv_one<1>(o[1], vb, pa0, pa1, pa2, pa3); pv_one<2>(o[2], vb, pa0, pa1, pa2, pa3); pv_one<3>(o[3], vb, pa0, pa1, pa2, pa3);
}

__device__ __forceinline__ void attn_pass(const bf16_t* __restrict__ Qb, const bf16_t* __restrict__ Kh, const bf16_t* __restrict__ Vh, int NT, int my_last, char* lds, f32x16 (&o)[4]) {
    const int tid = threadIdx.x, wid = tid >> 6, lane = tid & 63, r32 = lane & 31, hi = lane >> 5;
    char* V_lds = lds + LDS_V; char* K_lds = lds + LDS_K;
    float* wsf = (float*)(lds + LDS_WS) + wid * 64; float* li_l = wsf; float* al_l = wsf + 32;
    float m_reg = -1e30f, l_reg = 0.f;
#pragma unroll
    for (int d = 0; d < 4; ++d) o[d] = f32x16{};
    bf16x8 qr[4];
    const bf16_t* Qw = Qb + (size_t)(wid * QBLK + r32) * NIN + hi * 8;
#pragma unroll
    for (int d0 = 0; d0 < 4; ++d0) qr[d0] = *reinterpret_cast<const bf16x8*>(Qw + d0 * 16);
    const int sr = tid >> 4, sc = (tid & 15) * 8, vst0 = v_st(sr, sc), vst1 = v_st(32 + sr, sc);
    const int krow = tid >> 3, kc8 = (tid & 7) * 8, kst = KSWZ64(krow, kc8 * 2);
    const int vb0 = (int)(uintptr_t)V_lds + v_rd_base(lane);
    struct { bf16x8 vs0, vs1, ks; } sr_[2];
#define SLOAD(i, k0) do { sr_[i].vs0 = *reinterpret_cast<const bf16x8*>(&Vh[(size_t)((k0) + sr) * NIN + sc]); sr_[i].vs1 = *reinterpret_cast<const bf16x8*>(&Vh[(size_t)((k0) + 32 + sr) * NIN + sc]); \
    sr_[i].ks = *reinterpret_cast<const bf16x8*>(&Kh[(size_t)((k0) + krow) * NIN + kc8]); } while (0)
#define SWRITE(b, i) do { *(bf16x8*)(V_lds + (b) * SHM_V + vst0) = sr_[i].vs0; *(bf16x8*)(V_lds + (b) * SHM_V + vst1) = sr_[i].vs1; \
    *(bf16x8*)(K_lds + (b) * SHM_K + kst) = sr_[i].ks; } while (0)
#define SWAIT() asm volatile("s_waitcnt vmcnt(3)" ::: "memory")
#define RESC(a) do { if (__any((a) < 1.f)) { if (hi == 0) al_l[r32] = (a); asm volatile("s_waitcnt lgkmcnt(0)" ::: "memory"); \
    _Pragma("unroll") for (int d = 0; d < 4; ++d) _Pragma("unroll") for (int r = 0; r < 16; ++r) o[d][r] *= al_l[crow(r, hi)]; } } while (0)
    f32x16 pA0, pA1, pB0, pB1; float mnA, mnB, alA, alB; bf16x8 pa0, pa1, pa2, pa3;
    constexpr int SE = 0, SO = 1;
    __syncthreads();
    SLOAD(SE, 0); asm volatile("s_waitcnt vmcnt(0)" ::: "memory"); SWRITE(0, SE); __syncthreads();
    qkt(pA0, pA1, K_lds, qr, r32, hi); partialSM(pA0, pA1, m_reg, mnA, alA);
    SLOAD(SO, KVBLK); if (2 < NT) SLOAD(SE, 2 * KVBLK);
    SWAIT(); SWRITE(1, SO); __syncthreads();
    for (int j = 1; j + 1 < NT; j += 2) {
        qkt(pB0, pB1, K_lds + SHM_K, qr, r32, hi); maskfill(pB0, pB1, j > my_last);
        finishSM(pA0, pA1, alA, l_reg, pa0, pa1, pa2, pa3);
        SLOAD(SO, (j + 2) * KVBLK);
        pv_d0(o, vb0, pa0, pa1, pa2, pa3); partialSM(pB0, pB1, m_reg, mnB, alB);
        __syncthreads(); SWAIT(); SWRITE(0, SE);
        RESC(alB); __syncthreads();
        qkt(pA0, pA1, K_lds, qr, r32, hi); maskfill(pA0, pA1, j + 1 > my_last);
        finishSM(pB0, pB1, alB, l_reg, pa0, pa1, pa2, pa3);
        if (j + 3 < NT) SLOAD(SE, (j + 3) * KVBLK);
        pv_d0(o, vb0 + SHM_V, pa0, pa1, pa2, pa3); partialSM(pA0, pA1, m_reg, mnA, alA);
        __syncthreads(); SWAIT(); SWRITE(1, SO);
        RESC(alA); __syncthreads();
    }
    SBAR(); qkt(pB0, pB1, K_lds + SHM_K, qr, r32, hi); maskfill(pB0, pB1, NT - 1 > my_last);
    finishSM(pA0, pA1, alA, l_reg, pa0, pa1, pa2, pa3); SBAR();
    pv_d0(o, vb0, pa0, pa1, pa2, pa3); partialSM(pB0, pB1, m_reg, mnB, alB);
    __syncthreads(); RESC(alB);
    finishSM(pB0, pB1, alB, l_reg, pa0, pa1, pa2, pa3); SBAR();
    pv_d0(o, vb0 + SHM_V, pa0, pa1, pa2, pa3);
    if (hi == 0) li_l[r32] = l_reg;
    asm volatile("s_waitcnt lgkmcnt(0)" ::: "memory");
#pragma unroll
    for (int r = 0; r < 16; ++r) {
        const float rl = __builtin_amdgcn_rcpf(li_l[crow(r, hi)]);
#pragma unroll
        for (int d = 0; d < 4; ++d) o[d][r] *= rl;
    }
    asm volatile("s_waitcnt vmcnt(0)" ::: "memory");
    __syncthreads();
#undef SLOAD
#undef SWRITE
#undef SWAIT
#undef RESC
}
}

__device__ __forceinline__ void p3_attn_unit(const Params& p, Ctx& F, int b, int h, int qb, float* oscr) {
    const bf16_t* proj = (const bf16_t*)(p.ws + WS_PROJ);
    bf16_t* ycat = (bf16_t*)(p.ws + WS_YCAT);
    const float lam = ((const float*)(p.ws + WS_MISC))[0];
    const float* subw = p.in[15];
    const int tid = F.tid, wid = F.wave, lane = F.lane, r32 = lane & 31, hi = lane >> 5;
    const size_t rowbase = (size_t)b * SEQ; const int q0 = qb * 256;
    const int NT = (q0 + 256) / 64, my_last = (q0 + 32 * wid) / 64;
    f32x16 o[4];
    for (int j = 0; j < 2; ++j) {
        const bf16_t* Qb = proj + (rowbase + q0) * NIN + PQ + h * 128 + j * 64;
        const bf16_t* Kh = proj + rowbase * NIN + PK + h * 128 + j * 64;
        const bf16_t* Vh = proj + rowbase * NIN + PV + h * 128;
        att::attn_pass(Qb, Kh, Vh, NT, my_last, (char*)F.lds, o);
        if (j == 0) {
            float* my = oscr + tid * 64;
#pragma unroll
            for (int d = 0; d < 4; ++d)
#pragma unroll
                for (int r4 = 0; r4 < 4; ++r4) *(f32x4*)(my + d * 16 + r4 * 4) = (f32x4){o[d][4 * r4], o[d][4 * r4 + 1], o[d][4 * r4 + 2], o[d][4 * r4 + 3]};
        }
    }
    float wv[4];
#pragma unroll
    for (int d = 0; d < 4; ++d) wv[d] = subw[d * 32 + r32] * (1.f - LAMBDA_INIT);
#pragma unroll
    for (int r = 0; r < 16; ++r) {
        float v[4]; float ss = 0.f;
#pragma unroll
        for (int d = 0; d < 4; ++d) { v[d] = oscr[tid * 64 + d * 16 + r] - lam * o[d][r]; ss += v[d] * v[d]; }
        ss += __shfl_xor(ss, 1); ss += __shfl_xor(ss, 2); ss += __shfl_xor(ss, 4); ss += __shfl_xor(ss, 8); ss += __shfl_xor(ss, 16);
        const float rs = rsqrtf(ss * (1.f / 128.f) + EPSN);
        const size_t row = rowbase + q0 + wid * 32 + att::crow(r, hi);
#pragma unroll
        for (int d = 0; d < 4; ++d) ycat[row * DM + 512 + h * 128 + d * 32 + r32] = (bf16_t)f2bf(v[d] * rs * wv[d]);
    }
}

__device__ __forceinline__ void phase3(const Params& p, Ctx& F) {
#ifndef NO_SCAN
    p3_scan(p, F);
#endif
    float* oscr = p.out + (size_t)F.vcu * (64 * 512);
    for (int ui = F.vcu; ui < 512; ui += F.G) {
        const int pi = ui & 255, bh = pi >> 3, s = pi & 7, b = bh >> 2, h = bh & 3;
        p3_attn_unit(p, F, b, h, ui < 256 ? 15 - s : s, oscr);
    }
}

constexpr int P4_PREV = 0, P4_CM = 69632, P4_ACS = 87040, P4_Y = 88064, Y_LD = 257;
static_assert(P4_Y + 64 * Y_LD * 4 <= LDS_BYTES, "P4 LDS");
__device__ __forceinline__ void p4_load(const bf16_t* states, const bf16_t* cmc, int tid, int b, int c, int g, u32x4 (&pv)[8], u32x4 (&cv)[2]) {
    const size_t tbase = (size_t)b * SEQ + (size_t)c * CHUNK;
#pragma unroll
    for (int i = 0; i < 8; ++i) {
        const int e = tid + 512 * i, n8 = e & 15, pp = (e >> 4) & 63, h = e >> 10;
        pv[i] = *(const u32x4*)(states + ((((size_t)b * NCH + c) * 8 + g * 4 + h) * 64 + pp) * 128 + n8 * 8);
    }
#pragma unroll
    for (int i = 0; i < 2; ++i) {
        const int e = tid + 512 * i, l = e >> 4, c8 = e & 15;
        cv[i] = *(const u32x4*)(cmc + (tbase + l) * 256 + g * 128 + c8 * 8);
    }
}
__device__ __forceinline__ void p4_unit(const Params& p, Ctx& F, int b, int c, int g, u32x4 (&pv)[8], u32x4 (&cv)[2], bool has_next, int nb, int nc, int ng) {
    unsigned char* ws = p.ws;
    const bf16_t* proj = (const bf16_t*)(ws + WS_PROJ);
    bf16_t* ycat = (bf16_t*)(ws + WS_YCAT); const bf16_t* cmc = (const bf16_t*)(ws + WS_CMC);
    const bf16_t* states = (const bf16_t*)(ws + WS_STATES); const float* acs_g = (const float*)(ws + WS_ACS);
    const float* normw = p.in[8];
    LAS bf16_t* PREV = (LAS bf16_t*)(F.lds + P4_PREV); LAS bf16_t* CM = (LAS bf16_t*)(F.lds + P4_CM);
    LAS float* ACS = (LAS float*)(F.lds + P4_ACS); LAS float* Y = (LAS float*)(F.lds + P4_Y);
    const int tid = F.tid, lane = F.lane, wave = F.wave, fr = lane & 15, fq = lane >> 4;
    const size_t tbase = (size_t)b * SEQ + (size_t)c * CHUNK;
#pragma unroll
    for (int i = 0; i < 8; ++i) {
        const int e = tid + 512 * i, n8 = e & 15, pp = (e >> 4) & 63, h = e >> 10;
        *(LAS u32x4*)(PREV + (h * 64 + pp) * BM_LD + n8 * 8) = pv[i];
    }
#pragma unroll
    for (int i = 0; i < 2; ++i) {
        const int e = tid + 512 * i, l = e >> 4, c8 = e & 15;
        *(LAS u32x4*)(CM + l * BM_LD + c8 * 8) = cv[i];
    }
    if (has_next) p4_load(states, cmc, tid, nb, nc, ng, pv, cv);
    if (tid < 256) { const int l = tid >> 2, h = tid & 3; ACS[l * 4 + h] = acs_g[(tbase + l) * 8 + g * 4 + h]; }
    __syncthreads();
    {
        const int h = wave >> 1;
#pragma unroll
        for (int mq = 0; mq < 2; ++mq) {
            const int mt = 2 * (wave & 1) + mq;
            bf16x8 a[4];
#pragma unroll
            for (int ks = 0; ks < 4; ++ks) a[ks] = *(const LAS bf16x8*)(CM + (mt * 16 + fr) * BM_LD + ks * 32 + fq * 8);
#pragma unroll
            for (int nt = 0; nt < 4; ++nt) {
                f32x4 acc = {0.f, 0.f, 0.f, 0.f};
#pragma unroll
                for (int ks = 0; ks < 4; ++ks) {
                    const bf16x8 bq = *(const LAS bf16x8*)(PREV + (h * 64 + nt * 16 + fr) * BM_LD + ks * 32 + fq * 8);
                    acc = mfma16(a[ks], bq, acc);
                }
#pragma unroll
                for (int j = 0; j < 4; ++j) {
                    const int l = mt * 16 + 4 * fq + j, col = h * 64 + nt * 16 + fr;
                    Y[l * Y_LD + col] = acc[j] * __expf(ACS[l * 4 + h]);
                }
            }
        }
    }
    __syncthreads();
    {
        const int c8 = lane & 31, hr = lane >> 5;
        const f32x4 nw0 = *(const f32x4*)(normw + g * 256 + c8 * 8), nw1 = *(const f32x4*)(normw + g * 256 + c8 * 8 + 4);
#pragma unroll 2
        for (int r = 0; r < 4; ++r) {
            const int l = wave * 8 + r * 2 + hr;
            const size_t t = tbase + l;
            const u32x4 yl = *(const u32x4*)(ycat + t * DM + g * 256 + c8 * 8);
            const u32x4 zz = *(const u32x4*)(proj + t * NIN + PZ + g * 256 + c8 * 8);
            float v[8]; float ss = 0.f;
#pragma unroll
            for (int e = 0; e < 4; ++e) {
                const float y0 = bf2f(yl[e] & 0xffffu) + Y[l * Y_LD + c8 * 8 + 2 * e], y1 = bf2f(yl[e] >> 16) + Y[l * Y_LD + c8 * 8 + 2 * e + 1];
                v[2 * e] = y0 * silu_f(bf2f(zz[e] & 0xffffu)); v[2 * e + 1] = y1 * silu_f(bf2f(zz[e] >> 16));
                ss += v[2 * e] * v[2 * e] + v[2 * e + 1] * v[2 * e + 1];
            }
            ss += __shfl_xor(ss, 1); ss += __shfl_xor(ss, 2); ss += __shfl_xor(ss, 4); ss += __shfl_xor(ss, 8); ss += __shfl_xor(ss, 16);
            const float rs = rsqrtf(ss * (1.f / 256.f) + EPSN);
            u32x4 o;
            o.x = pk2(v[0] * rs * nw0[0], v[1] * rs * nw0[1]); o.y = pk2(v[2] * rs * nw0[2], v[3] * rs * nw0[3]);
            o.z = pk2(v[4] * rs * nw1[0], v[5] * rs * nw1[1]); o.w = pk2(v[6] * rs * nw1[2], v[7] * rs * nw1[3]);
            *(u32x4*)(ycat + t * DM + g * 256 + c8 * 8) = o;
        }
    }
    __syncthreads();
}
__device__ __forceinline__ void phase4(const Params& p, Ctx& F) {
    const bf16_t* states = (const bf16_t*)(p.ws + WS_STATES); const bf16_t* cmc = (const bf16_t*)(p.ws + WS_CMC);
    u32x4 pv[8], cv[2];
    if (F.vcu < NB * NCH * 2) p4_load(states, cmc, F.tid, F.vcu >> 7, (F.vcu >> 1) & 63, F.vcu & 1, pv, cv);
    for (int u = F.vcu; u < NB * NCH * 2; u += F.G) {
        const int g = u & 1, c = (u >> 1) & 63, b = u >> 7;
        const int un = u + F.G;
        p4_unit(p, F, b, c, g, pv, cv, un < NB * NCH * 2, un >> 7, (un >> 1) & 63, un & 1);
    }
}

__device__ __forceinline__ unsigned f2ord(float f) { const unsigned u = __float_as_uint(f); return (u >> 31) ? ~u : (u | 0x80000000u); }
__device__ __forceinline__ float ord2f(unsigned u) { return __uint_as_float((u >> 31) ? (u & 0x7fffffffu) : ~u); }
#define CE_DESC(A, B) do { const unsigned hi_ = (A) > (B) ? (A) : (B); const unsigned lo_ = (A) > (B) ? (B) : (A); (A) = hi_; (B) = lo_; } while (0)
template <int K, int J> __device__ __forceinline__ void bstage(unsigned (&r)[16]) {
#pragma unroll
    for (int i = 0; i < 16; ++i) { const int l = i ^ J; if (l > i) { if ((i & K) == 0) CE_DESC(r[i], r[l]); else CE_DESC(r[l], r[i]); } }
}
__device__ __forceinline__ void bitonic_merge16(unsigned (&r)[16]) { bstage<16, 8>(r); bstage<16, 4>(r); bstage<16, 2>(r); bstage<16, 1>(r); }
__device__ __forceinline__ void bitonic_sort16(unsigned (&r)[16]) {
    bstage<2, 1>(r); bstage<4, 2>(r); bstage<4, 1>(r); bstage<8, 4>(r); bstage<8, 2>(r); bstage<8, 1>(r); bitonic_merge16(r);
}
__device__ __forceinline__ void top16_merge(unsigned (&r)[16], const unsigned (&n)[16]) {
#pragma unroll
    for (int i = 0; i < 16; ++i) r[i] = r[i] > n[15 - i] ? r[i] : n[15 - i];
    bitonic_merge16(r);
}
__device__ __forceinline__ void top16_merge_lane(unsigned (&r)[16], int xm) {
    unsigned n[16];
#pragma unroll
    for (int i = 0; i < 16; ++i) n[i] = (unsigned)__shfl_xor((int)r[i], xm);
    top16_merge(r, n);
}
__device__ __forceinline__ void p7_cand_table(LAS unsigned char* CAND, int tid) {
    if (tid < 52) {
        int c = 0; unsigned char v = 255;
        for (int a = 0; a < 16; ++a) for (int b = 0; b < 16 / (a + 1); ++b) { if (c == tid) v = (unsigned char)(a * 16 + b); ++c; }
        CAND[tid] = v;
    }
}
__device__ __forceinline__ void route16(const bf16_t* qp, const float* rowsq, float* gwo, size_t t0, int lane, LAS unsigned* lists, const LAS unsigned char* CAND, LAS unsigned short* IDX) {
    const int tok = lane >> 2, part = lane & 3;
    const float r2 = rsqrtf(rowsq[t0 + tok] * (1.f / DM) + EPSN);
    u32x4 nxt[2][4];
#pragma unroll
    for (int j = 0; j < 2; ++j)
#pragma unroll
        for (int q = 0; q < 4; ++q) nxt[j][q] = __builtin_nontemporal_load((const u32x4*)(qp + (t0 + tok) * 2048 + j * 128 + part * 32 + q * 8));
#pragma unroll 1
    for (int h = 0; h < 8; ++h) {
        u32x4 raw[2][4];
#pragma unroll
        for (int j = 0; j < 2; ++j)
#pragma unroll
            for (int q = 0; q < 4; ++q) raw[j][q] = nxt[j][q];
        if (h < 7) {
#pragma unroll
            for (int j = 0; j < 2; ++j)
#pragma unroll
                for (int q = 0; q < 4; ++q) nxt[j][q] = __builtin_nontemporal_load((const u32x4*)(qp + (t0 + tok) * 2048 + (h + 1) * 256 + j * 128 + part * 32 + q * 8));
        }
#pragma unroll
        for (int j = 0; j < 2; ++j) {
            unsigned r[16], n[16];
#pragma unroll
            for (int q = 0; q < 2; ++q)
#pragma unroll
                for (int e = 0; e < 4; ++e) {
                    r[q * 8 + 2 * e]     = (f2ord(bf2f(raw[j][q][e] & 0xffffu) * r2) & ~127u) | (unsigned)(part * 32 + q * 8 + 2 * e);
                    r[q * 8 + 2 * e + 1] = (f2ord(bf2f(raw[j][q][e] >> 16) * r2) & ~127u) | (unsigned)(part * 32 + q * 8 + 2 * e + 1);
                    n[q * 8 + 2 * e]     = (f2ord(bf2f(raw[j][2 + q][e] & 0xffffu) * r2) & ~127u) | (unsigned)(part * 32 + 16 + q * 8 + 2 * e);
                    n[q * 8 + 2 * e + 1] = (f2ord(bf2f(raw[j][2 + q][e] >> 16) * r2) & ~127u) | (unsigned)(part * 32 + 16 + q * 8 + 2 * e + 1);
                }
            bitonic_sort16(r); bitonic_sort16(n);
            top16_merge(r, n);
            top16_merge_lane(r, 1);
            top16_merge_lane(r, 2);
            if (part == 0) {
#pragma unroll
                for (int k = 0; k < 16; ++k) lists[(tok * 2 + j) * 16 + k] = r[k];
            }
        }
        LDS_WAIT(); __builtin_amdgcn_wave_barrier();
        {
            const LAS unsigned* l0 = lists + (2 * tok) * 16; const LAS unsigned* l1 = lists + (2 * tok + 1) * 16;
            unsigned r[16];
#pragma unroll
            for (int m = 0; m < 13; ++m) {
                const unsigned ab = CAND[part + 4 * m];
                const unsigned a = (ab >> 4) & 15u, bb = ab & 15u;
                const float sum = ord2f(l0[a] & ~127u) + ord2f(l1[bb] & ~127u);
                r[m] = ab == 255u ? 0u : ((f2ord(sum) & ~255u) | ab);
            }
            r[13] = 0u; r[14] = 0u; r[15] = 0u;
            bitonic_sort16(r);
            top16_merge_lane(r, 1);
            top16_merge_lane(r, 2);
            float val[16]; unsigned ex[16]; float mx = -1e30f;
#pragma unroll
            for (int k = 0; k < 16; ++k) {
                const unsigned pos = r[k] & 255u, a = pos >> 4, bb = pos & 15u;
                const unsigned w0 = l0[a], w1 = l1[bb];
                ex[k] = (w0 & 127u) * 128u + (w1 & 127u);
                val[k] = ord2f(w0 & ~127u) + ord2f(w1 & ~127u);
                mx = fmaxf(mx, val[k]);
            }
            float sum = 0.f;
#pragma unroll
            for (int k = 0; k < 16; ++k) { val[k] = __expf(val[k] - mx); sum += val[k]; }
            const float inv = 1.f / sum;
            float* go = gwo + ((t0 + tok) * 8 + h) * 16;
            if (part == 0) {
#pragma unroll
                for (int k = 0; k < 16; ++k) { IDX[tok * 128 + h * 16 + k] = (unsigned short)ex[k]; go[k] = val[k] * inv; }
            }
        }
        LDS_WAIT(); __builtin_amdgcn_wave_barrier();
    }
}

constexpr int PACE_WORDS = 32 * 16 * 16;
__device__ __forceinline__ void xcd_pace(const XcdBarrier& b, int slot) {
    __syncthreads();
    if (threadIdx.x == 0) {
        const unsigned nloc = b.st[0];
        unsigned* w = b.bar + XCD_BAR_WORDS + (slot * 16 + (int)b.x) * 16;
        (void)xb_add(w, 1u);
        unsigned sp = 0;
        while (xb_ld(w) < nloc && ++sp < 3000u) __builtin_amdgcn_s_sleep(1);
    }
    __syncthreads();
}
__device__ __forceinline__ float gelu_erf(float x) { return 0.5f * x * (1.f + erff(x * 0.70710678118654752f)); }
typedef float f32x2 __attribute__((ext_vector_type(2)));
constexpr int P8_NSL = 8, P8_SLC = DM / P8_NSL, P8_KS = P8_SLC / 32;
constexpr float P8_XS = 32.f;
static_assert(P8_SLC == 128, "lane mappings assume 128-column (128-byte) slices");
__device__ __forceinline__ void phase8(const Params& p, Ctx& F, const XcdBarrier& bar) {
    const bool pace = false;
    unsigned char* ws = p.ws;
    const unsigned char* uq = ws + WS_UB; const unsigned char* vq = ws + WS_VB;
    const float* rsu = (const float*)(ws + WS_RSU); const float* rsv = (const float*)(ws + WS_RSV);
    const bf16_t* x1b = (const bf16_t*)(ws + WS_X1B);
    const float* rowsq = (const float*)(ws + WS_CTL) + CW_ROWSQ;
    const float* gwi = (const float*)(ws + WS_GW);
    float* out = p.out;
    const int lane = F.lane, fr = lane & 15, fq = lane >> 4;
    LAS unsigned short* IDX = (LAS unsigned short*)(F.lds + F.wave * 20480);
    LAS float* COEF = (LAS float*)(F.lds + F.wave * 20480 + 4096);
    LAS unsigned char* STG = (LAS unsigned char*)COEF;
    LAS unsigned char* CAND = STG + 2048;
    __syncthreads();
    p7_cand_table(CAND, lane);
    LDS_WAIT(); __builtin_amdgcn_wave_barrier();
    for (int task = F.gw; task < TOK / 16; task += F.ngw) {
        const size_t t0 = (size_t)task * 16;
        route16((const bf16_t*)(ws + WS_QP), rowsq, (float*)(ws + WS_GW), t0, lane, (LAS unsigned*)STG, CAND, IDX);
        const float r2 = rsqrtf(rowsq[t0 + fr] * (1.f / DM) + EPSN);
        VM_WAIT(); LDS_WAIT(); __builtin_amdgcn_wave_barrier();
#if defined(PROBE_PHASE) && PROBE_PHASE >= 80
        F.ta = __builtin_amdgcn_s_memrealtime();
#endif
        f32x4 accU[8];
#pragma unroll
        for (int h = 0; h < 8; ++h) accU[h] = (f32x4){0.f, 0.f, 0.f, 0.f};
        const int lrow = lane >> 3, lch = lane & 7;
        const int wofs0 = lrow * 128 + ((lch ^ (lrow & 7)) << 4), wofs1 = wofs0 + 1024;
        const float xsc = r2 * P8_XS;
#ifdef U_FP4
        typedef int v8i __attribute__((ext_vector_type(8)));
        int rofs4[2];
#pragma unroll
        for (int m = 0; m < 2; ++m) rofs4[m] = fr * 128 + (((4 * m + fq) ^ (fr & 7)) << 4);
#pragma unroll 1
        for (int sl = 0; sl < 4; ++sl) {
            v8i xf[2];
#pragma unroll
            for (int m = 0; m < 2; ++m) {
                const bf16_t* xp = x1b + (t0 + fr) * DM + sl * 256 + 128 * m + 16 * fq;
#pragma unroll
                for (int q = 0; q < 4; ++q) {
                    const u32x4 xv = *(const u32x4*)(xp + 64 * (q >> 1) + 8 * (q & 1));
                    int lo = 0, hi = 0;
                    lo = __builtin_amdgcn_cvt_pk_fp8_f32(bf2f(xv[0] & 0xffffu) * xsc, bf2f(xv[0] >> 16) * xsc, lo, false);
                    lo = __builtin_amdgcn_cvt_pk_fp8_f32(bf2f(xv[1] & 0xffffu) * xsc, bf2f(xv[1] >> 16) * xsc, lo, true);
                    hi = __builtin_amdgcn_cvt_pk_fp8_f32(bf2f(xv[2] & 0xffffu) * xsc, bf2f(xv[2] >> 16) * xsc, hi, false);
                    hi = __builtin_amdgcn_cvt_pk_fp8_f32(bf2f(xv[3] & 0xffffu) * xsc, bf2f(xv[3] >> 16) * xsc, hi, true);
                    xf[m][2 * q] = lo; xf[m][2 * q + 1] = hi;
                }
            }
            const unsigned char* ubs = uq + sl * 128 + lch * 16;
#pragma unroll 1
            for (int j0 = 0; j0 < 16; ++j0) {
                const bool mine = (fr == j0);
                v8i bm[2];
#pragma unroll
                for (int m = 0; m < 2; ++m)
#pragma unroll
                    for (int q = 0; q < 8; ++q) bm[m][q] = mine ? xf[m][q] : 0;
                u32x4 g0[8], g1[8];
#pragma unroll
                for (int h = 0; h < 8; ++h) {
                    const unsigned e0 = IDX[j0 * 128 + h * 16 + lrow], e1 = IDX[j0 * 128 + h * 16 + lrow + 8];
                    g0[h] = *(const u32x4*)(ubs + (size_t)e0 * (DM / 2));
                    g1[h] = *(const u32x4*)(ubs + (size_t)e1 * (DM / 2));
                }
#pragma unroll
                for (int hg = 0; hg < 2; ++hg) {
#pragma unroll
                    for (int h = 0; h < 4; ++h) {
                        *(LAS u32x4*)(STG + h * 2048 + wofs0) = g0[hg * 4 + h];
                        *(LAS u32x4*)(STG + h * 2048 + wofs1) = g1[hg * 4 + h];
                    }
                    __builtin_amdgcn_wave_barrier();
#pragma unroll
                    for (int h = 0; h < 4; ++h)
#pragma unroll
                        for (int m = 0; m < 2; ++m) {
                            const u32x4 a16 = *(const LAS u32x4*)(STG + h * 2048 + rofs4[m]);
                            const v8i av = {(int)a16.x, (int)a16.y, (int)a16.z, (int)a16.w, 0, 0, 0, 0};
                            accU[hg * 4 + h] = __builtin_amdgcn_mfma_scale_f32_16x16x128_f8f6f4(av, bm[m], accU[hg * 4 + h], 4, 0, 0, 0, 0, 0);
                        }
                    __builtin_amdgcn_wave_barrier();
                }
            }
        }
#else
        int rofs[P8_KS];
#pragma unroll
        for (int ks = 0; ks < P8_KS; ++ks) rofs[ks] = fr * 128 + (((2 * ks + (fq >> 1)) ^ (fr & 7)) << 4) + (fq & 1) * 8;
#pragma unroll 1
        for (int sl = 0; sl < P8_NSL; ++sl) {
            if (pace) xcd_pace(bar, sl);
            long xf[P8_KS];
#pragma unroll
            for (int ks = 0; ks < P8_KS; ++ks) {
                const u32x4 xv = *(const u32x4*)(x1b + (t0 + fr) * DM + sl * P8_SLC + ks * 32 + 8 * fq);
                int lo = 0, hi = 0;
                lo = __builtin_amdgcn_cvt_pk_fp8_f32(bf2f(xv[0] & 0xffffu) * xsc, bf2f(xv[0] >> 16) * xsc, lo, false);
                lo = __builtin_amdgcn_cvt_pk_fp8_f32(bf2f(xv[1] & 0xffffu) * xsc, bf2f(xv[1] >> 16) * xsc, lo, true);
                hi = __builtin_amdgcn_cvt_pk_fp8_f32(bf2f(xv[2] & 0xffffu) * xsc, bf2f(xv[2] >> 16) * xsc, hi, false);
                hi = __builtin_amdgcn_cvt_pk_fp8_f32(bf2f(xv[3] & 0xffffu) * xsc, bf2f(xv[3] >> 16) * xsc, hi, true);
                xf[ks] = (long)(((unsigned long long)(unsigned)hi << 32) | (unsigned long long)(unsigned)lo);
            }
            const unsigned char* ubs = uq + sl * P8_SLC + lch * 16;
#pragma unroll 1
            for (int j0 = 0; j0 < 16; ++j0) {
                const bool mine = (fr == j0);
                long bm[P8_KS];
#pragma unroll
                for (int ks = 0; ks < P8_KS; ++ks) bm[ks] = mine ? xf[ks] : 0l;
                u32x4 g0[8], g1[8];
#pragma unroll
                for (int h = 0; h < 8; ++h) {
                    const unsigned e0 = IDX[j0 * 128 + h * 16 + lrow], e1 = IDX[j0 * 128 + h * 16 + lrow + 8];
                    g0[h] = *(const u32x4*)(ubs + (size_t)e0 * DM);
                    g1[h] = *(const u32x4*)(ubs + (size_t)e1 * DM);
                }
#pragma unroll
                for (int hg = 0; hg < 2; ++hg) {
#pragma unroll
                    for (int h = 0; h < 4; ++h) {
                        *(LAS u32x4*)(STG + h * 2048 + wofs0) = g0[hg * 4 + h];
                        *(LAS u32x4*)(STG + h * 2048 + wofs1) = g1[hg * 4 + h];
                    }
                    __builtin_amdgcn_wave_barrier();
#pragma unroll
                    for (int h = 0; h < 4; ++h)
#pragma unroll
                        for (int ks = 0; ks < P8_KS; ++ks) {
                            const long a = *(const LAS long*)(STG + h * 2048 + rofs[ks]);
                            accU[hg * 4 + h] = __builtin_amdgcn_mfma_f32_16x16x32_fp8_fp8(a, bm[ks], accU[hg * 4 + h], 0, 0, 0);
                        }
                    __builtin_amdgcn_wave_barrier();
                }
            }
        }
#endif
        LDS_WAIT(); __builtin_amdgcn_wave_barrier();
#pragma unroll
        for (int h = 0; h < 8; ++h) {
            const f32x4 gv = *(const f32x4*)(gwi + (t0 + fr) * 128 + h * 16 + 4 * fq);
#pragma unroll
            for (int jj = 0; jj < 4; ++jj) {
                const int slot = h * 16 + 4 * fq + jj;
                const unsigned e = IDX[fr * 128 + slot];
                const float hv = accU[h][jj] * rsu[e] * (1.f / P8_XS);
                COEF[fr * 128 + slot] = gv[jj] * gelu_erf(hv) * rsv[e];
            }
        }
        LDS_WAIT(); __builtin_amdgcn_wave_barrier();
#if defined(PROBE_PHASE) && PROBE_PHASE >= 80
        F.tb = __builtin_amdgcn_s_memrealtime();
#endif
#ifdef V_VALU
        const int sub = lane & 7, rg = lane >> 3;
#pragma unroll 1
        for (int sl = 0; sl < P8_NSL; ++sl) {
            const unsigned char* vbs = vq + sl * P8_SLC + sub * 16;
#pragma unroll 1
            for (int j0 = 0; j0 < 16; ++j0) {
                f32x2 acc[8];
#pragma unroll
                for (int q = 0; q < 8; ++q) acc[q] = (f32x2){0.f, 0.f};
#pragma unroll
                for (int ib = 0; ib < 2; ++ib) {
                    u32x4 w[8]; float cf[8];
#pragma unroll
                    for (int it = 0; it < 8; ++it) {
                        const int slot = (ib * 8 + it) * 8 + rg;
                        const unsigned e = IDX[j0 * 128 + slot];
                        cf[it] = COEF[j0 * 128 + slot];
                        w[it] = *(const u32x4*)(vbs + (size_t)e * DM);
                    }
#pragma unroll
                    for (int it = 0; it < 8; ++it)
#pragma unroll
                        for (int q = 0; q < 4; ++q) {
                            acc[2 * q] += __builtin_amdgcn_cvt_pk_f32_fp8((int)w[it][q], false) * cf[it];
                            acc[2 * q + 1] += __builtin_amdgcn_cvt_pk_f32_fp8((int)w[it][q], true) * cf[it];
                        }
                }
#pragma unroll
                for (int q = 0; q < 8; ++q) {
                    acc[q].x += __shfl_xor(acc[q].x, 8); acc[q].y += __shfl_xor(acc[q].y, 8);
                    acc[q].x += __shfl_xor(acc[q].x, 16); acc[q].y += __shfl_xor(acc[q].y, 16);
                    acc[q].x += __shfl_xor(acc[q].x, 32); acc[q].y += __shfl_xor(acc[q].y, 32);
                }
                if (rg == 0) {
                    float* orow = out + (t0 + j0) * DM + sl * P8_SLC + sub * 16;
                    const bf16_t* xrow = x1b + (t0 + j0) * DM + sl * P8_SLC + sub * 16;
#pragma unroll
                    for (int q = 0; q < 4; ++q) {
                        const u32x2 xv = *(const u32x2*)(xrow + 4 * q);
                        f32x4 o = {bf2f(xv.x & 0xffffu), bf2f(xv.x >> 16), bf2f(xv.y & 0xffffu), bf2f(xv.y >> 16)};
                        o[0] += acc[2 * q].x; o[1] += acc[2 * q].y; o[2] += acc[2 * q + 1].x; o[3] += acc[2 * q + 1].y;
                        *(f32x4*)(orow + 4 * q) = o;
                    }
                }
            }
        }
#elif defined(V_FP4)
        typedef int v2i __attribute__((ext_vector_type(2)));
        typedef int v8i __attribute__((ext_vector_type(8)));
        v8i cq8; float inv_cs;
        {
            f32x4 cv[2][4]; float cmax = 0.f;
#pragma unroll
            for (int hf = 0; hf < 2; ++hf)
#pragma unroll
                for (int q = 0; q < 4; ++q) {
                    cv[hf][q] = *(const LAS f32x4*)(COEF + fr * 128 + hf * 64 + 16 * fq + 4 * q);
                    cmax = fmaxf(cmax, fmaxf(fmaxf(fabsf(cv[hf][q][0]), fabsf(cv[hf][q][1])), fmaxf(fabsf(cv[hf][q][2]), fabsf(cv[hf][q][3]))));
                }
            cmax = fmaxf(cmax, __shfl_xor(cmax, 16)); cmax = fmaxf(cmax, __shfl_xor(cmax, 32));
            const float cs = cmax > 0.f ? 240.f / cmax : 1.f; inv_cs = cmax > 0.f ? cmax * (1.f / 240.f) : 1.f;
#pragma unroll
            for (int hf = 0; hf < 2; ++hf)
#pragma unroll
                for (int q = 0; q < 4; ++q) {
                    int pk = 0;
                    pk = __builtin_amdgcn_cvt_pk_fp8_f32(cv[hf][q][0] * cs, cv[hf][q][1] * cs, pk, false);
                    pk = __builtin_amdgcn_cvt_pk_fp8_f32(cv[hf][q][2] * cs, cv[hf][q][3] * cs, pk, true);
                    cq8[hf * 4 + q] = pk;
                }
        }
        LDS_WAIT(); __builtin_amdgcn_wave_barrier();
        int vwofs[16];
#pragma unroll
        for (int i = 0; i < 16; ++i) { const int rr = lrow + 8 * i; vwofs[i] = rr * 128 + ((lch ^ ((rr >> 1) & 7)) << 4); }
        int vrow_[2], vsw_[2];
#pragma unroll
        for (int t = 0; t < 2; ++t) { vrow_[t] = 32 * fq + 16 * t + fr; vsw_[t] = (vrow_[t] >> 1) & 7; }
#pragma unroll 1
        for (int sl = 0; sl < 4; ++sl) {
            f32x4 accV[16];
#pragma unroll
            for (int ct = 0; ct < 16; ++ct) accV[ct] = (f32x4){0.f, 0.f, 0.f, 0.f};
            const unsigned char* vbs = vq + sl * 128 + lch * 16;
#pragma unroll 1
            for (int j0 = 0; j0 < 16; ++j0) {
                const bool mine = (fr == j0);
                u32x4 g[16];
#pragma unroll
                for (int i = 0; i < 16; ++i) {
                    const unsigned e = IDX[j0 * 128 + lrow + 8 * i];
                    g[i] = *(const u32x4*)(vbs + (size_t)e * (DM / 2));
                }
#pragma unroll
                for (int i = 0; i < 16; ++i) *(LAS u32x4*)(STG + vwofs[i]) = g[i];
                __builtin_amdgcn_wave_barrier();
                v8i bmq;
#pragma unroll
                for (int q = 0; q < 8; ++q) bmq[q] = mine ? cq8[q] : 0;
#pragma unroll
                for (int ct = 0; ct < 16; ++ct) {
                    const v2i r0 = __builtin_amdgcn_ds_read_tr4_b64_v2i32((LAS v2i*)(STG + vrow_[0] * 128 + (((ct >> 1) ^ vsw_[0]) << 4) + (ct & 1) * 8));
                    const v2i r1 = __builtin_amdgcn_ds_read_tr4_b64_v2i32((LAS v2i*)(STG + vrow_[1] * 128 + (((ct >> 1) ^ vsw_[1]) << 4) + (ct & 1) * 8));
                    const v8i av = {r0.x, r0.y, r1.x, r1.y, 0, 0, 0, 0};
                    accV[ct] = __builtin_amdgcn_mfma_scale_f32_16x16x128_f8f6f4(av, bmq, accV[ct], 4, 0, 0, 0, 0, 0);
                }
                __builtin_amdgcn_wave_barrier();
            }
            float* orow = out + (t0 + fr) * DM + sl * 256 + 4 * fq;
            const bf16_t* xrow = x1b + (t0 + fr) * DM + sl * 256 + 4 * fq;
#pragma unroll
            for (int ct = 0; ct < 16; ++ct) {
                const u32x2 xv = *(const u32x2*)(xrow + ct * 16);
                f32x4 o = {bf2f(xv.x & 0xffffu), bf2f(xv.x >> 16), bf2f(xv.y & 0xffffu), bf2f(xv.y >> 16)};
                o += accV[ct] * inv_cs;
                __builtin_nontemporal_store(o, (f32x4*)(orow + ct * 16));
            }
        }
#else
        typedef int v2i __attribute__((ext_vector_type(2)));
        long cq[4]; float inv_cs;
        {
            f32x4 cv[4][2]; float cmax = 0.f;
#pragma unroll
            for (int kk = 0; kk < 4; ++kk)
#pragma unroll
                for (int q = 0; q < 2; ++q) {
                    cv[kk][q] = *(const LAS f32x4*)(COEF + fr * 128 + kk * 32 + 8 * fq + 4 * q);
                    cmax = fmaxf(cmax, fmaxf(fmaxf(fabsf(cv[kk][q][0]), fabsf(cv[kk][q][1])), fmaxf(fabsf(cv[kk][q][2]), fabsf(cv[kk][q][3]))));
                }
            cmax = fmaxf(cmax, __shfl_xor(cmax, 16)); cmax = fmaxf(cmax, __shfl_xor(cmax, 32));
            const float cs = cmax > 0.f ? 240.f / cmax : 1.f; inv_cs = cmax > 0.f ? cmax * (1.f / 240.f) : 1.f;
#pragma unroll
            for (int kk = 0; kk < 4; ++kk) {
                int lo = 0, hi = 0;
                lo = __builtin_amdgcn_cvt_pk_fp8_f32(cv[kk][0][0] * cs, cv[kk][0][1] * cs, lo, false);
                lo = __builtin_amdgcn_cvt_pk_fp8_f32(cv[kk][0][2] * cs, cv[kk][0][3] * cs, lo, true);
                hi = __builtin_amdgcn_cvt_pk_fp8_f32(cv[kk][1][0] * cs, cv[kk][1][1] * cs, hi, false);
                hi = __builtin_amdgcn_cvt_pk_fp8_f32(cv[kk][1][2] * cs, cv[kk][1][3] * cs, hi, true);
                cq[kk] = (long)(((unsigned long long)(unsigned)hi << 32) | (unsigned long long)(unsigned)lo);
            }
        }
        LDS_WAIT(); __builtin_amdgcn_wave_barrier();
        const int vrow = 8 * fq + (fr >> 1);
        const int vrd0 = vrow * 128 + (fr & 1) * 8, vsw = (vrow >> 1) & 7;
        int vwofs[4];
#pragma unroll
        for (int i = 0; i < 4; ++i) { const int rr = lrow + 8 * i; vwofs[i] = rr * 128 + ((lch ^ ((rr >> 1) & 7)) << 4); }
#pragma unroll 1
        for (int sl = 0; sl < P8_NSL; ++sl) {
            if (pace) xcd_pace(bar, P8_NSL + sl);
            f32x4 accV[8];
#pragma unroll
            for (int ct = 0; ct < 8; ++ct) accV[ct] = (f32x4){0.f, 0.f, 0.f, 0.f};
            const unsigned char* vbs = vq + sl * P8_SLC + lch * 16;
#pragma unroll 1
            for (int j0 = 0; j0 < 16; ++j0) {
                const bool mine = (fr == j0);
                u32x4 g[4][4];
#pragma unroll
                for (int kk = 0; kk < 4; ++kk)
#pragma unroll
                    for (int i = 0; i < 4; ++i) {
                        const unsigned e = IDX[j0 * 128 + kk * 32 + lrow + 8 * i];
                        g[kk][i] = *(const u32x4*)(vbs + (size_t)e * DM);
                    }
#pragma unroll
                for (int kk = 0; kk < 4; ++kk) {
                    LAS unsigned char* T = STG + (kk & 1) * 4096;
#pragma unroll
                    for (int i = 0; i < 4; ++i) *(LAS u32x4*)(T + vwofs[i]) = g[kk][i];
                    __builtin_amdgcn_wave_barrier();
                    const long bmq = mine ? cq[kk] : 0l;
#pragma unroll
                    for (int ct = 0; ct < 8; ++ct) {
                        const v2i av = __builtin_amdgcn_ds_read_tr8_b64_v2i32((LAS v2i*)(T + vrd0 + ((ct ^ vsw) << 4)));
                        const long a = (long)(((unsigned long long)(unsigned)av.y << 32) | (unsigned long long)(unsigned)av.x);
                        accV[ct] = __builtin_amdgcn_mfma_f32_16x16x32_fp8_fp8(a, bmq, accV[ct], 0, 0, 0);
                    }
                    __builtin_amdgcn_wave_barrier();
                }
            }
            float* orow = out + (t0 + fr) * DM + sl * P8_SLC + 4 * fq;
            const bf16_t* xrow = x1b + (t0 + fr) * DM + sl * P8_SLC + 4 * fq;
#pragma unroll
            for (int ct = 0; ct < 8; ++ct) {
                const u32x2 xv = *(const u32x2*)(xrow + ct * 16);
                f32x4 o = {bf2f(xv.x & 0xffffu), bf2f(xv.x >> 16), bf2f(xv.y & 0xffffu), bf2f(xv.y >> 16)};
                o += accV[ct] * inv_cs;
                __builtin_nontemporal_store(o, (f32x4*)(orow + ct * 16));
            }
        }
#endif
#if defined(PROBE_PHASE) && PROBE_PHASE >= 80
        F.tc = __builtin_amdgcn_s_memrealtime();
#endif
        LDS_WAIT(); __builtin_amdgcn_wave_barrier();
    }
}

constexpr int NPHASE = 9;
#ifndef N_LAUNCHES
#define N_LAUNCHES 1
#endif
constexpr int MISC_OFF = LDS_BYTES - 128;
__global__ void __launch_bounds__(512, 2) fwd_kernel(Params p) {
    extern __shared__ __attribute__((aligned(16))) unsigned char lds_raw[];
    Ctx F; F.ta = F.tb = F.tc = 0;
    F.lds = (LAS unsigned char*)lds_raw;
    F.tid = threadIdx.x; F.lane = F.tid & 63; F.wave = __builtin_amdgcn_readfirstlane(F.tid >> 6);
    F.G = gridDim.x; { const int bx = blockIdx.x; F.vcu = (F.G % 8 == 0) ? (bx % 8) * (F.G / 8) + bx / 8 : bx; }
    F.gw = F.vcu * 8 + F.wave; F.ngw = F.G * 8;
    unsigned char* ws = p.ws;
    const int lo = p.ph_lo, hi = p.ph_hi;
    volatile LAS unsigned* MISC = (volatile LAS unsigned*)(F.lds + MISC_OFF);
    if (F.tid < 32) MISC[F.tid] = 0u;
    __syncthreads();
#ifdef CG_FIRST_SYNC
    XcdBarrier bar; bar.bar = (unsigned*)(ws + WS_CTL) + CW_BAR; bar.x = 0; bar.st = MISC + 8;
    for (int i = blockIdx.x * 512 + F.tid; i < XCD_BAR_WORDS + PACE_WORDS; i += F.G * 512) __hip_atomic_store(bar.bar + i, 0u, __ATOMIC_RELAXED, __HIP_MEMORY_SCOPE_AGENT);
#else
    XcdBarrier bar = xcd_barrier_post((unsigned*)(ws + WS_CTL) + CW_BAR, MISC + 8);
#endif
#ifdef ONLY_PHASE
#define IN(k) ((k)==ONLY_PHASE)
#else
#define IN(k) (lo <= (k) && (k) < hi)
#endif
#ifdef PROBE_PHASE
    unsigned long long tp0 = __builtin_amdgcn_s_memrealtime(), tp1 = 0; const unsigned long long tstart = tp0;
#define PSTAMP(k) do { if ((k) + 1 == PROBE_PHASE) tp0 = __builtin_amdgcn_s_memrealtime(); if ((k) == PROBE_PHASE) tp1 = __builtin_amdgcn_s_memrealtime(); } while (0)
#else
#define PSTAMP(k) do {} while (0)
#endif
#define SEAM(k) do { if (IN(k) && ((k) == 6 ? IN(8) : IN((k) + 1))) xcd_barrier(bar); PSTAMP(k); } while (0)
    if (IN(0)) phase0(p, F);
#ifdef CG_FIRST_SYNC
    if (IN(0) && IN(1)) { cooperative_groups::this_grid().sync(); bar = xcd_barrier_post((unsigned*)(ws + WS_CTL) + CW_BAR, MISC + 8); }
    PSTAMP(0);
#else
    SEAM(0);
#endif
    if (IN(1)) {
        pg8::Gemm g{(const pg8::bf16_t*)(ws + WS_XB), (const pg8::bf16_t*)(ws + WS_WINT), TOK, NIN, DM};
        pg8::StaticOrder S; S.init(TOK, NIN, F.G, (int)blockIdx.x);
        pg8::EpiProj E{(pg8::bf16_t*)(ws + WS_PROJ), NIN, p.in[9], p.in[10], (const float*)(ws + WS_ROPE), (const float*)(ws + WS_ROPE) + SEQ * 8,
                       (LAS float*)(F.lds + pg8::STAGE_BYTES), PQ, PK, PV, SEQ - 1, EPSN};
        pg8::gemm_phase<pg8::EpiProj, pg8::StaticOrder, true, true>(F.lds, g, S, E);
    }
    SEAM(1);
    if (IN(2)) phase2(p, F);
    SEAM(2);
    if (IN(3)) phase3(p, F);
    SEAM(3);
    if (IN(4)) phase4(p, F);
    SEAM(4);
    if (IN(5)) {
        pg8::Gemm g{(const pg8::bf16_t*)(ws + WS_YCAT), (const pg8::bf16_t*)(ws + WS_WOUTT), TOK, DM, DM};
        pg8::StaticOrder S; S.init(TOK, DM, F.G, (int)blockIdx.x);
        pg8::EpiResid E{p.in[0], p.out, (pg8::bf16_t*)(ws + WS_X1B), (float*)(ws + WS_CTL) + CW_ROWSQ, DM};
        pg8::gemm_phase<pg8::EpiResid, pg8::StaticOrder, true, true>(F.lds, g, S, E);
    }
    SEAM(5);
    if (IN(6)) {
        pg8::Gemm g{(const pg8::bf16_t*)(ws + WS_X1B), (const pg8::bf16_t*)(ws + WS_WQT), TOK, 2048, DM};
        pg8::StaticOrder S; S.init(TOK, 2048, F.G, (int)blockIdx.x);
        pg8::EpiBf16<0> E{(pg8::bf16_t*)(ws + WS_QP), 2048, nullptr, 0, 0, 1.f};
        pg8::gemm_phase<pg8::EpiBf16<0>, pg8::StaticOrder, true, true>(F.lds, g, S, E);
    }
    SEAM(6);
    PSTAMP(7);
#ifdef PROBE_PHASE
    const unsigned sv_nloc = MISC[8], sv_nx = MISC[9];
#endif
    if (IN(8)) phase8(p, F, bar);
#ifdef PROBE_PHASE
    __syncthreads(); if (F.tid == 0) { MISC[8] = sv_nloc; MISC[9] = sv_nx; } __syncthreads();
#endif
#ifdef PROBE_PHASE
    xcd_barrier(bar);
    PSTAMP(8);
#if PROBE_PHASE == 9
    tp0 = tstart; tp1 = __builtin_amdgcn_s_memrealtime();
#elif PROBE_PHASE == 80 || PROBE_PHASE == 20
    tp0 = F.ta; tp1 = F.tb;
#elif PROBE_PHASE == 81 || PROBE_PHASE == 21
    tp0 = F.tb; tp1 = F.tc;
#endif
#if PROBE_PHASE == 98
    {
        typedef int v2i __attribute__((ext_vector_type(2)));
        float result = 0.f;
        __syncthreads();
        if (blockIdx.x == 0 && F.wave == 0) {
            LAS unsigned char* T = (LAS unsigned char*)F.lds;
            if (F.lane < 16) {
                unsigned long long w = 0ull;
                for (int c = 0; c < 16; ++c) { const unsigned long long nib = (PROBE_SUB == 0) ? (unsigned long long)F.lane : (unsigned long long)c; w |= nib << (4 * c); }
                *(LAS unsigned long long*)(T + F.lane * 8) = w;
            }
            LDS_WAIT(); __builtin_amdgcn_wave_barrier();
            const v2i rv_ = __builtin_amdgcn_ds_read_tr4_b64_v2i32((LAS v2i*)(T + (F.lane & 15) * 8));
            const unsigned long long got = ((unsigned long long)(unsigned)rv_.y << 32) | (unsigned long long)(unsigned)rv_.x;
            unsigned long long want = 0ull;
            for (int j = 0; j < 16; ++j) { const unsigned long long nib = (PROBE_SUB == 0) ? (unsigned long long)j : (unsigned long long)(F.lane & 15); want |= nib << (4 * j); }
            const unsigned long long bal = __ballot(got == want);
            result = (float)__popcll(bal);
        }
        if (blockIdx.x == 0 && F.tid == 0) { VM_WAIT(); p.out[0] += result; }
    }
#elif PROBE_PHASE == 99
    {
        typedef int v8i __attribute__((ext_vector_type(8)));
        float result = 0.f;
        if (blockIdx.x == 0 && F.wave == 0) {
            const int fr_ = F.lane & 15, fq_ = F.lane >> 4;
            v8i bv;
#pragma unroll
            for (int q = 0; q < 8; ++q) { unsigned w = 0; for (int bb = 0; bb < 4; ++bb) { unsigned pcode = (unsigned)(32 * fq_ + 4 * q + bb); if (pcode == 127u) pcode = 126u; w |= pcode << (8 * bb); } bv[q] = (int)w; }
            int matches = 0, firstbad = -1, firstbadval = -1;
            for (int ga = 0; ga < 4; ++ga)
                for (int ja = 0; ja < 32; ++ja) {
                    v8i av = {0, 0, 0, 0, 0, 0, 0, 0};
                    if (fr_ == 0 && fq_ == ga) { const unsigned nib = 2u << (4 * (ja & 7)); const int wsel = ja >> 3;
                        av[0] = wsel == 0 ? (int)nib : 0; av[1] = wsel == 1 ? (int)nib : 0; av[2] = wsel == 2 ? (int)nib : 0; av[3] = wsel == 3 ? (int)nib : 0; }
                    f32x4 c = {0.f, 0.f, 0.f, 0.f};
                    c = __builtin_amdgcn_mfma_scale_f32_16x16x128_f8f6f4(av, bv, c, 4, 0, 0, 0, 0, 0);
                    int pk = 0; pk = __builtin_amdgcn_cvt_pk_fp8_f32(c[0], 0.f, pk, false);
                    const int got = __shfl(pk & 255, 0);
                    int want = 32 * ga + ja; if (want == 127) want = 126;
                    if (got == want) ++matches; else if (firstbad < 0) { firstbad = 32 * ga + ja; firstbadval = got; }
                }
#if PROBE_SUB == 0
            result = (float)matches;
#elif PROBE_SUB == 1
            result = (float)firstbad;
#else
            result = (float)firstbadval;
#endif
        }
        if (blockIdx.x == 0 && F.tid == 0) { VM_WAIT(); p.out[0] += result; }
    }
#else
    if (blockIdx.x == 0 && F.tid == 0) { VM_WAIT(); p.out[0] += (float)(tp1 - tp0) * (1.0f / (float)(PROBE_DIV)); }
#endif
#endif
#undef IN
#undef SEAM
}

extern "C" void kernel_launch(void* const* d_in, const int* in_sizes, int n_in, void* d_out, int out_size, void* d_ws, size_t ws_size, hipStream_t stream) {
    static int grid = 0;
    if (grid == 0) {
        if (n_in != 22 || in_sizes[0] != TOK * DM || out_size != TOK * DM || ws_size < WS_END) {
            fprintf(stderr, "kernel_launch: unexpected shapes: n_in %d in0 %d out %d ws %zu\n", n_in, n_in > 0 ? in_sizes[0] : -1, out_size, ws_size); grid = -1; return; }
        if (hipFuncSetAttribute((const void*)fwd_kernel, hipFuncAttributeMaxDynamicSharedMemorySize, LDS_BYTES) != hipSuccess) { fprintf(stderr, "kernel_launch: hipFuncSetAttribute failed\n"); grid = -1; return; }
        int dev = 0, cus = 0, per_cu = 0;
        if (hipGetDevice(&dev) != hipSuccess || hipDeviceGetAttribute(&cus, hipDeviceAttributeMultiprocessorCount, dev) != hipSuccess) { grid = -1; return; }
        if (hipOccupancyMaxActiveBlocksPerMultiprocessor(&per_cu, (const void*)fwd_kernel, 512, LDS_BYTES) != hipSuccess || per_cu < 1) { fprintf(stderr, "kernel_launch: occupancy query failed (%d)\n", per_cu); (void)hipGetLastError(); per_cu = 1; }
        grid = cus * (per_cu > 1 ? 1 : per_cu);
    }
    if (grid < 0) return;
#ifndef CG_FIRST_SYNC
    (void)hipMemsetAsync((char*)d_ws + WS_CTL + (size_t)CW_BAR * 4, 0, (size_t)(XCD_BAR_WORDS + PACE_WORDS) * 4, stream);
#endif
    Params a{};
    for (int i = 0; i < 22; ++i) a.in[i] = (const float*)d_in[i];
    a.out = (float*)d_out; a.ws = (unsigned char*)d_ws;
#if N_LAUNCHES == 1
    a.ph_lo = 0; a.ph_hi = NPHASE;
#ifdef USE_COOP_LAUNCH
    { void* args[] = {&a};
      hipError_t e = hipLaunchCooperativeKernel((const void*)fwd_kernel, dim3(grid), dim3(512), args, LDS_BYTES, stream);
      if (e != hipSuccess) fprintf(stderr, "kernel_launch: cooperative launch failed: %s (grid %d)\n", hipGetErrorString(e), grid); }
#else
    hipLaunchKernelGGL(fwd_kernel, dim3(grid), dim3(512), LDS_BYTES, stream, a);
#endif
#else
    for (int ph = 0; ph < NPHASE; ++ph) {
        a.ph_lo = ph; a.ph_hi = ph + 1;
        hipLaunchKernelGGL(fwd_kernel, dim3(grid), dim3(512), LDS_BYTES, stream, a);
    }
#endif
    const hipError_t le = hipPeekAtLastError();
    if (le != hipSuccess) fprintf(stderr, "kernel_launch: launch failed: %s\n", hipGetErrorName(le));
}
```

```cpp
#include <hip/hip_runtime.h>
#include <hip/hip_cooperative_groups.h>
#include <cstdio>
#include <cstdint>
#define USE_COOP_LAUNCH 1
#define U_FP4 1
#define V_FP4 1

#define LAS __attribute__((address_space(3)))
#define GAS __attribute__((address_space(1)))
typedef unsigned short bf16_t;
typedef short bf16x8 __attribute__((ext_vector_type(8)));
typedef short s16x4 __attribute__((ext_vector_type(4)));
typedef float f32x4 __attribute__((ext_vector_type(4)));
typedef float f32x8 __attribute__((ext_vector_type(8)));
typedef float f32x16 __attribute__((ext_vector_type(16)));
typedef unsigned u32x4 __attribute__((ext_vector_type(4)));
typedef unsigned u32x2 __attribute__((ext_vector_type(2)));

constexpr int NB = 8, SEQ = 4096, TOK = NB * SEQ, DM = 1024;
constexpr int NIN = 3072;
constexpr int PZ = 0, PXS = 512, PBM = 1024, PCM = 1280, PQ = 1536, PK = 2048, PV = 2560;
constexpr int CHUNK = 64, NCH = SEQ / CHUNK;
constexpr int NHS = 8;
constexpr float EPSN = 1e-6f;
constexpr int PEER_H = 8, NKEYS = 128, TOPK = 16;
constexpr float LAMBDA_INIT = 0.2f;

constexpr size_t MiB = 1u << 20;
constexpr size_t WS_CTL = 0, CTL_BYTES = 1 * MiB;
constexpr size_t WS_WINT = 1 * MiB;
constexpr size_t WS_WOUTT = 7 * MiB;
constexpr size_t WS_WQT = 9 * MiB;
constexpr size_t WS_KEYS = 13 * MiB;
constexpr size_t WS_ROPE = 13 * MiB + 512 * 1024;
constexpr size_t WS_MISC = 13 * MiB + 768 * 1024;
constexpr size_t WS_RSU = WS_MISC + 64 * 1024;
constexpr size_t WS_RSV = WS_MISC + 128 * 1024;
constexpr size_t WS_DTRAW = 14 * MiB;
constexpr size_t WS_ACS = 15 * MiB;
constexpr size_t WS_CDEC = 16 * MiB;
constexpr size_t WS_UB = 20 * MiB;
constexpr size_t WS_VB = 52 * MiB;
constexpr size_t WS_XB = 84 * MiB;
constexpr size_t WS_YCAT = WS_XB;
constexpr size_t WS_PROJ = 148 * MiB;
constexpr size_t WS_QP = WS_PROJ;
constexpr size_t WS_IDX = 276 * MiB;
constexpr size_t WS_GW = 292 * MiB;
constexpr size_t WS_CMC = 340 * MiB;
constexpr size_t WS_STATES = 356 * MiB;
constexpr size_t WS_X1B = WS_STATES;
constexpr size_t WS_END = 484 * MiB;
constexpr int CW_BAR = 4096;
constexpr int CW_ROWSQ = 131072;
static_assert((CW_ROWSQ + TOK) * 4 <= (int)CTL_BYTES, "ctl");

constexpr int LDS_BYTES = 163840;

__device__ __forceinline__ float bf2f(unsigned h) { return __uint_as_float(h << 16); }
__device__ __forceinline__ unsigned f2bf(float f) { unsigned u = __float_as_uint(f); return (u + 0x7fffu + ((u >> 16) & 1u)) >> 16; }
__device__ __forceinline__ unsigned pk2(float lo, float hi) { return f2bf(lo) | (f2bf(hi) << 16); }
__device__ __forceinline__ float wave_sum(float v) {
#pragma unroll
    for (int o = 1; o < 64; o <<= 1) v += __shfl_xor(v, o);
    return v;
}
__device__ __forceinline__ float wave_max(float v) {
#pragma unroll
    for (int o = 1; o < 64; o <<= 1) v = fmaxf(v, __shfl_xor(v, o));
    return v;
}
__device__ __forceinline__ float silu_f(float x) { return x * __builtin_amdgcn_rcpf(1.f + __expf(-x)); }
__device__ __forceinline__ f32x4 mfma16(bf16x8 a, bf16x8 b, f32x4 c) { return __builtin_amdgcn_mfma_f32_16x16x32_bf16(a, b, c, 0, 0, 0); }
__device__ __forceinline__ f32x16 mfma32(bf16x8 a, bf16x8 b, f32x16 c) { return __builtin_amdgcn_mfma_f32_32x32x16_bf16(a, b, c, 0, 0, 0); }
#define LDS_WAIT() asm volatile("s_waitcnt lgkmcnt(0)" ::: "memory")
#define VM_WAIT() asm volatile("s_waitcnt vmcnt(0)" ::: "memory")

#define XB_TMO      128
#define XB_XCNT(j)  (256  + 64 * (j))
#define XB_XSUB(j)  (1280 + 64 * (j))
#define XB_XGEN(j)  (2304 + 64 * (j))
#define XB_TOP      3328
#define XB_TOPGEN   3392
#define XCD_BAR_WORDS 3456
#define XB_SPIN_CAP (1u << 21)

__device__ __forceinline__ unsigned xb_ld(unsigned* p)              { return __hip_atomic_load(p, __ATOMIC_RELAXED, __HIP_MEMORY_SCOPE_AGENT); }
__device__ __forceinline__ unsigned xb_add(unsigned* p, unsigned v) { return __hip_atomic_fetch_add(p, v, __ATOMIC_RELAXED, __HIP_MEMORY_SCOPE_AGENT); }
__device__ __forceinline__ unsigned xb_xcc_id() { return (unsigned)__builtin_amdgcn_s_getreg((3 << 11) | 20) & 0xFu; }
#define XB_SPIN(cond, bar) do { unsigned _sp = 0; while (cond) { __builtin_amdgcn_s_sleep(1); \
    if ((++_sp & 255u) == 0u) { if (xb_ld(&(bar)[XB_TMO])) break; if (_sp > XB_SPIN_CAP) { atomicAdd(&(bar)[XB_TMO], 1u); break; } } } } while (0)

struct XcdBarrier {
    unsigned* bar; unsigned x;
    volatile LAS unsigned* st;
};

__device__ __forceinline__ XcdBarrier xcd_barrier_post(unsigned* bar, volatile LAS unsigned* st) {
    XcdBarrier b; b.bar = bar; b.x = xb_xcc_id(); b.st = st;
    if (threadIdx.x == 0) (void)xb_add(&bar[XB_XCNT(b.x)], 1u);
    return b;
}
__device__ __forceinline__ void xcd_barrier_complete(unsigned* bar, unsigned x, unsigned& nloc, unsigned& nx) {
    const unsigned G = gridDim.x * gridDim.y * gridDim.z;
    unsigned sum, cnt, mine, sp = 0u;
    for (;;) {
        sum = 0u; cnt = 0u; mine = 0u;
#pragma unroll
        for (unsigned j = 0; j < 16; ++j) { const unsigned c = xb_ld(&bar[XB_XCNT(j)]); sum += c; cnt += (c > 0u) ? 1u : 0u; mine = (j == x) ? c : mine; }
        if (sum == G) break;
        __builtin_amdgcn_s_sleep(1);
        if ((++sp & 255u) == 0u) { if (xb_ld(&bar[XB_TMO])) break; if (sp > XB_SPIN_CAP) { atomicAdd(&bar[XB_TMO], 1u); break; } }
    }
    nloc = mine > 0u ? mine : 1u; nx = cnt > 0u ? cnt : 1u;
}

__device__ __forceinline__ void xcd_barrier(const XcdBarrier& b) {
    asm volatile("s_waitcnt vmcnt(0)" ::: "memory");
    __syncthreads();
    if (threadIdx.x == 0) {
        unsigned* bar = b.bar;
        __builtin_amdgcn_s_waitcnt(0);
        unsigned nloc = b.st[0], nx = b.st[1];
        if (nloc == 0u) { xcd_barrier_complete(bar, b.x, nloc, nx); b.st[0] = nloc; b.st[1] = nx; }
        const unsigned old = xb_add(&bar[XB_XSUB(b.x)], 1u);
        const unsigned gen = old / nloc;
        if (old + 1u == (gen + 1u) * nloc) {
            __builtin_amdgcn_fence(__ATOMIC_RELEASE, "agent");
            asm volatile("s_waitcnt vmcnt(0)" ::: "memory");
            const unsigned og = xb_add(&bar[XB_TOP], 1u);
            const unsigned tg = og / nx;
            if (og + 1u == (tg + 1u) * nx) xb_add(&bar[XB_TOPGEN], 1u);
            else XB_SPIN(xb_ld(&bar[XB_TOPGEN]) == tg, bar);
            __builtin_amdgcn_fence(__ATOMIC_ACQUIRE, "agent");
            xb_add(&bar[XB_XGEN(b.x)], 1u);
            asm volatile("s_waitcnt vmcnt(0)" ::: "memory");
        } else {
            XB_SPIN(xb_ld(&bar[XB_XGEN(b.x)]) == gen, bar);
            __builtin_amdgcn_fence(__ATOMIC_ACQUIRE, "agent");
            asm volatile("s_waitcnt vmcnt(0)" ::: "memory");
        }
    }
    __syncthreads();
}
namespace pg8 {
#define PG8_LAS __attribute__((address_space(3)))
typedef unsigned short bf16_t;
typedef short bf16x8 __attribute__((ext_vector_type(8)));
typedef float f32x4 __attribute__((ext_vector_type(4)));
typedef unsigned u32x4 __attribute__((ext_vector_type(4)));
constexpr int BM = 256, BK = 64, HALF = 128, HTB = HALF * BK * 2  , STAGE_BYTES = 8 * HTB, NXCD = 8, WGM = 8;

__host__ __device__ __forceinline__ int lds_byte(int r, int c) { const int st = (r >> 4) * 2 + (c >> 5), rr = r & 15, cc = c & 31, ob = rr * 64 + cc * 2; return st * 1024 + (ob ^ (((ob >> 9) & 1) << 5)); }
__host__ __device__ __forceinline__ void stage_rc(int b, int& R, int& C) { const int st = b / 1024, sb = b % 1024, swz = sb ^ (((sb >> 9) & 1) << 5); R = (st >> 1) * 16 + swz / 64; C = (st & 1) * 32 + (swz % 64) / 2; }
__host__ __device__ __forceinline__ int perm32(int rho) { const int n = rho >> 4, i = rho & 15; return 8 * (i >> 2) + 4 * n + (i & 3); }

struct Unit { int pm, pn; };
struct Gemm { const bf16_t* A; const bf16_t* Bt; int M, N, K; };

struct StaticOrder {
    int nM, nN, nwg, G, c;
    __host__ __device__ void init(int M, int N, int G_, int c_) { nM = M / BM; nN = N / BM; nwg = nM * nN; G = G_; c = c_; }
    __host__ __device__ bool next(int i, Unit& u) const {
        const long L = (long)i * G + c; if (L >= nwg) return false;
        int wgid = (int)L; { const int q = nwg / NXCD, r = nwg % NXCD, xcd = wgid % NXCD, off = wgid / NXCD; wgid = (xcd < r ? xcd * (q + 1) : r * (q + 1) + (xcd - r) * q) + off; }
        const int nig = WGM * nN, gid = wgid / nig, fm = gid * WGM, gsz = (nM - fm) < WGM ? (nM - fm) : WGM;
        u.pm = fm + ((wgid % nig) % gsz); u.pn = (wgid % nig) / gsz; return true;
    }
    __device__ __forceinline__ void a_ready(const Unit&) const {}
    __device__ __forceinline__ void done(const Unit&) const {}
};

__device__ __forceinline__ unsigned cvt_pk_bf16(float lo, float hi) { unsigned r; asm volatile("v_cvt_pk_bf16_f32 %0, %1, %2" : "=v"(r) : "v"(lo), "v"(hi)); return r; }
typedef float f32x2 __attribute__((ext_vector_type(2)));
__device__ __forceinline__ f32x2 gelu_pk(f32x2 v) {
    const f32x2 av = __builtin_elementwise_abs(v), d = av * 0.2316418882f + 1.0f;
    f32x2 t; t.x = __builtin_amdgcn_rcpf(d.x); t.y = __builtin_amdgcn_rcpf(d.y);
    f32x2 q = t * 0.5307027145f + (-0.7265760135f); q = q * t + 0.7107068705f; q = q * t + (-0.142248368f); q = q * t + 0.127414796f; q = q * t;
    const f32x2 s = (v * v) * (-0.72134752044f);
    f32x2 e; e.x = __builtin_amdgcn_exp2f(s.x); e.y = __builtin_amdgcn_exp2f(s.y);
    const f32x2 m = v * (q * e), r = v - m;
    f32x2 o; o.x = v.x < 0.f ? m.x : r.x; o.y = v.y < 0.f ? m.y : r.y; return o;
}

template <int ACT  > struct EpiBf16 {
    static constexpr bool PERM = true, AFTER_DRAIN = false; static_assert(ACT == 0 || ACT == 1, "EpiBf16: ACT is 0 (none) or 1 (gelu_pk)");
    bf16_t* O; int ldc; const float* bias; int split_cols; size_t split_stride; float scale0;
    __device__ __forceinline__ void operator()(const f32x4 (&acc)[2][2][4][2], const Unit& u, int wr, int wc, int fr, int fq) const {
        const int row0 = u.pm * BM + wr * 64 + fr; int colt = u.pn * BM; bf16_t* base = O;
        float sc = 1.f; if (split_cols) { const int t = colt / split_cols; base += (size_t)t * split_stride; colt -= t * split_cols; if (t == 0) sc = scale0; }
        const int col0 = colt + wc * 32 + 8 * fq, bcol0 = u.pn * BM + wc * 32 + 8 * fq;
        f32x4 bv[2][2];
#pragma unroll
        for (int bj = 0; bj < 2; ++bj)
#pragma unroll
            for (int n = 0; n < 2; ++n) bv[bj][n] = bias ? *(const f32x4*)(bias + bcol0 + bj * HALF + 4 * n) : (f32x4){0.f, 0.f, 0.f, 0.f};
#pragma unroll
        for (int ai = 0; ai < 2; ++ai)
#pragma unroll
            for (int m = 0; m < 4; ++m) { bf16_t* rowp = base + (size_t)(row0 + ai * HALF + m * 16) * ldc + col0;
#pragma unroll
                for (int bj = 0; bj < 2; ++bj) { f32x4 v0 = acc[ai][bj][m][0] + bv[bj][0], v1 = acc[ai][bj][m][1] + bv[bj][1];
                    if (ACT == 1) { f32x2 a = gelu_pk((f32x2){v0[0], v0[1]}), b = gelu_pk((f32x2){v0[2], v0[3]}), c = gelu_pk((f32x2){v1[0], v1[1]}), d = gelu_pk((f32x2){v1[2], v1[3]});
                        v0 = (f32x4){a.x, a.y, b.x, b.y}; v1 = (f32x4){c.x, c.y, d.x, d.y}; }
                    v0 = v0 * sc; v1 = v1 * sc; u32x4 w; w.x = cvt_pk_bf16(v0[0], v0[1]); w.y = cvt_pk_bf16(v0[2], v0[3]); w.z = cvt_pk_bf16(v1[0], v1[1]); w.w = cvt_pk_bf16(v1[2], v1[3]);
                    *(u32x4*)(rowp + bj * HALF) = w; } }
    }
};

struct EpiResid {
    static constexpr bool PERM = false, AFTER_DRAIN = false;
    const float* x; float* out; bf16_t* xb; float* rowsq; int ldc;
    __device__ __forceinline__ void operator()(const f32x4 (&acc)[2][2][4][2], const Unit& u, int wr, int wc, int fr, int fq) const {
        const int col0 = u.pn * BM + wc * 32 + 4 * fq;
        const size_t base = (size_t)(u.pm * BM + wr * 64 + fr) * ldc + col0;
        f32x4 xv[2][4];
#define EPR_LOAD(SET, G) do { const size_t off_ = base + (size_t)(((G) >> 2) * HALF + ((G) & 3) * 16) * ldc; \
        _Pragma("unroll") for (int bj = 0; bj < 2; ++bj) _Pragma("unroll") for (int n = 0; n < 2; ++n) xv[SET][bj * 2 + n] = __builtin_nontemporal_load((const f32x4*)(x + off_ + bj * HALF + n * 16)); } while (0)
        EPR_LOAD(0, 0);
#pragma unroll
        for (int g = 0; g < 8; ++g) {
            const int ai = g >> 2, m = g & 3;
            if (g + 1 < 8) { if ((g & 1) == 0) EPR_LOAD(1, g + 1); else EPR_LOAD(0, g + 1); }
            const int row = u.pm * BM + ai * HALF + wr * 64 + m * 16 + fr;
            const size_t off = base + (size_t)(ai * HALF + m * 16) * ldc;
            float ss = 0.f;
#pragma unroll
            for (int bj = 0; bj < 2; ++bj)
#pragma unroll
                for (int n = 0; n < 2; ++n) {
                    const size_t c = off + bj * HALF + n * 16;
                    const f32x4 o = xv[g & 1][bj * 2 + n] + acc[ai][bj][m][n];
                    ss += (o[0] * o[0] + o[1] * o[1]) + (o[2] * o[2] + o[3] * o[3]);
                    typedef unsigned u32x2v __attribute__((ext_vector_type(2)));
                    u32x2v w; w.x = cvt_pk_bf16(o[0], o[1]); w.y = cvt_pk_bf16(o[2], o[3]);
                    *(u32x2v*)(xb + c) = w;
                }
            ss += __shfl_xor(ss, 16); ss += __shfl_xor(ss, 32);
            if (fq == 0) atomicAdd(rowsq + row, ss);
        }
#undef EPR_LOAD
    }
};

struct EpiProj {
    static constexpr bool PERM = true, AFTER_DRAIN = false;
    bf16_t* O; int ldc; const float* qnw; const float* knw; const float* cosT; const float* sinT; PG8_LAS float* xch; int q_lo, k_lo, k_hi, seq_mask; float eps;
    __device__ __forceinline__ void operator()(const f32x4 (&acc)[2][2][4][2], const Unit& u, int wr, int wc, int fr, int fq) const {
        const int colt = u.pn * BM, row0 = u.pm * BM + wr * 64 + fr, col0 = colt + wc * 32 + 8 * fq;
        if (colt < q_lo || colt >= k_hi) {
#pragma unroll
            for (int ai = 0; ai < 2; ++ai)
#pragma unroll
                for (int m = 0; m < 4; ++m) { bf16_t* rowp = O + (size_t)(row0 + ai * HALF + m * 16) * ldc + col0;
#pragma unroll
                    for (int bj = 0; bj < 2; ++bj) { const f32x4 v0 = acc[ai][bj][m][0], v1 = acc[ai][bj][m][1];
                        u32x4 w; w.x = cvt_pk_bf16(v0[0], v0[1]); w.y = cvt_pk_bf16(v0[2], v0[3]); w.z = cvt_pk_bf16(v1[0], v1[1]); w.w = cvt_pk_bf16(v1[2], v1[3]);
                        *(u32x4*)(rowp + bj * HALF) = w; } }
            return;
        }
        const float* nw = colt < k_lo ? qnw : knw;
#pragma unroll
        for (int ai = 0; ai < 2; ++ai)
#pragma unroll
            for (int m = 0; m < 4; ++m)
#pragma unroll
                for (int bj = 0; bj < 2; ++bj) {
                    const f32x4 a = acc[ai][bj][m][0], b = acc[ai][bj][m][1];
                    float ss = ((a[0] * a[0] + a[1] * a[1]) + (a[2] * a[2] + a[3] * a[3])) + ((b[0] * b[0] + b[1] * b[1]) + (b[2] * b[2] + b[3] * b[3]));
                    ss += __shfl_xor(ss, 16); ss += __shfl_xor(ss, 32);
                    if (fq == 0) xch[((ai * HALF + wr * 64 + m * 16 + fr) * 4 + bj * 2 + (wc >> 1)) * 2 + (wc & 1)] = ss;
                }
        asm volatile("s_waitcnt lgkmcnt(0)" ::: "memory"); __builtin_amdgcn_s_barrier(); asm volatile("" ::: "memory");
        float wv[8];
#pragma unroll
        for (int n = 0; n < 2; ++n)
#pragma unroll
            for (int j = 0; j < 4; ++j) wv[4 * n + j] = nw[32 * (wc & 1) + 8 * fq + 4 * n + j];
        const bool rot = ((wc & 1) == 0) && (fq < 2);
#pragma unroll
        for (int ai = 0; ai < 2; ++ai)
#pragma unroll
            for (int m = 0; m < 4; ++m) {
                const int rl = ai * HALF + wr * 64 + m * 16 + fr, row = u.pm * BM + rl, pos = row & seq_mask;
                f32x4 cs0 = {1.f, 1.f, 1.f, 1.f}, cs1 = cs0, sn0 = {0.f, 0.f, 0.f, 0.f}, sn1 = sn0;
                if (rot) { cs0 = *(const f32x4*)(cosT + pos * 8); cs1 = *(const f32x4*)(cosT + pos * 8 + 4); sn0 = *(const f32x4*)(sinT + pos * 8); sn1 = *(const f32x4*)(sinT + pos * 8 + 4); }
                bf16_t* rowp = O + (size_t)row * ldc + col0;
#pragma unroll
                for (int bj = 0; bj < 2; ++bj) {
                    const int xi = (rl * 4 + bj * 2 + (wc >> 1)) * 2;
                    const float rs = rsqrtf((xch[xi] + xch[xi + 1]) * (1.f / 64.f) + eps);
                    f32x4 y0 = acc[ai][bj][m][0] * rs, y1 = acc[ai][bj][m][1] * rs;
#pragma unroll
                    for (int j = 0; j < 4; ++j) { y0[j] *= wv[j]; y1[j] *= wv[4 + j]; }
                    f32x4 p0, p1;
#pragma unroll
                    for (int j = 0; j < 4; ++j) { p0[j] = __shfl_xor(y0[j], 16); p1[j] = __shfl_xor(y1[j], 16); }
                    if (rot) {
                        if (fq == 0) { y0 = y0 * cs0 - p0 * sn0; y1 = y1 * cs1 - p1 * sn1; }
                        else { y0 = p0 * sn0 + y0 * cs0; y1 = p1 * sn1 + y1 * cs1; }
                    }
                    u32x4 w; w.x = cvt_pk_bf16(y0[0], y0[1]); w.y = cvt_pk_bf16(y0[2], y0[3]); w.z = cvt_pk_bf16(y1[0], y1[1]); w.w = cvt_pk_bf16(y1[2], y1[3]);
                    *(u32x4*)(rowp + bj * HALF) = w;
                }
            }
    }
};

template <class Epi, class Sched, bool ALIGN_EPI = false, bool SP2 = false>
__device__ __forceinline__ void gemm_phase(PG8_LAS unsigned char* lds, const Gemm g, const Sched& S, const Epi& E) {
    const int tid = threadIdx.x, wid = __builtin_amdgcn_readfirstlane(tid >> 6), lane = tid & 63, wr = wid >> 2, wc = wid & 3, fr = lane & 15, fq = lane >> 4;
    const int K = g.K, nt = K / BK;
    unsigned voffA[2], voffB[2];
#pragma unroll
    for (int i = 0; i < 2; ++i) { int R, C; stage_rc(tid * 16 + i * 8192, R, C); const int Rb = Epi::PERM ? ((R & ~31) + perm32(R & 31)) : R;
        voffA[i] = (unsigned)(R * K + C) * 2u; voffB[i] = (unsigned)(Rb * K + C) * 2u; }
    const size_t kstep = (size_t)(BK * 2);
    const size_t hstep = (size_t)HALF * K * 2;
    const size_t tstep = 2 * hstep;
    const unsigned ldsw = (unsigned)wid * 1024u;
    const int aoff = lds_byte(wr * 64 + fr, fq * 8), boff = lds_byte(wc * 32 + fr, fq * 8);
#define PG8_SA(b, h) (((b) * 2 + (h)) * HTB)
#define PG8_SB(b, h) ((4 + (b) * 2 + (h)) * HTB)
#define PG8_STAGE(bufoff, gbase, voff) do { _Pragma("unroll") for (int _i = 0; _i < 2; ++_i) \
        __builtin_amdgcn_global_load_lds((const unsigned*)((const char*)(gbase) + (voff)[_i]), (PG8_LAS unsigned*)(lds + (bufoff) + ldsw + _i * 8192), 16, 0, 0); } while (0)
#define PG8_LDA(dst, b, h) do { _Pragma("unroll") for (int m = 0; m < 4; ++m) _Pragma("unroll") for (int k = 0; k < 2; ++k) dst[m][k] = *(const PG8_LAS bf16x8*)(lds + PG8_SA(b, h) + aoff + m * 2048 + k * 1024); } while (0)
#define PG8_LDB(dst, b, h) do { _Pragma("unroll") for (int n = 0; n < 2; ++n) _Pragma("unroll") for (int k = 0; k < 2; ++k) dst[n][k] = *(const PG8_LAS bf16x8*)(lds + PG8_SB(b, h) + boff + n * 2048 + k * 1024); } while (0)
#define PG8_MMA(ai, bj, At, Bt) do { __builtin_amdgcn_s_setprio(1); _Pragma("unroll") for (int m = 0; m < 4; ++m) _Pragma("unroll") for (int n = 0; n < 2; ++n) _Pragma("unroll") for (int k = 0; k < 2; ++k) \
        acc[ai][bj][m][n] = __builtin_amdgcn_mfma_f32_16x16x32_bf16(Bt[n][k], At[m][k], acc[ai][bj][m][n], 0, 0, 0); __builtin_amdgcn_s_setprio(0); } while (0)
#define PG8_WAIT_V(n) asm volatile("s_waitcnt vmcnt(" #n ")" ::: "memory")
#define PG8_WAIT_L(n) asm volatile("s_waitcnt lgkmcnt(" #n ")" ::: "memory")
#define PG8_BAR __builtin_amdgcn_s_barrier()
#define PG8_SCHED __builtin_amdgcn_sched_barrier(0)
    Unit cur, nxt; int ui = 0;
    if (!S.next(0, cur)) return;
    f32x4 acc[2][2][4][2];
#pragma unroll
    for (int a = 0; a < 2; ++a)
#pragma unroll
        for (int b = 0; b < 2; ++b)
#pragma unroll
            for (int m = 0; m < 4; ++m)
#pragma unroll
                for (int n = 0; n < 2; ++n) acc[a][b][m][n] = (f32x4){0.f, 0.f, 0.f, 0.f};
    bf16x8 At[4][2], B0[2][2], B1[2][2];
    const char* cA = (const char*)g.A + (size_t)cur.pm * tstep; const char* cB = (const char*)g.Bt + (size_t)cur.pn * tstep;
    S.a_ready(cur);
    if constexpr (SP2) {
        PG8_STAGE(PG8_SB(0, 0), cB, voffB); PG8_STAGE(PG8_SB(0, 1), cB + hstep, voffB); PG8_STAGE(PG8_SA(0, 0), cA, voffA); PG8_STAGE(PG8_SA(0, 1), cA + hstep, voffA);
        if (wr == 1) PG8_BAR;
        PG8_WAIT_V(2); PG8_BAR;
        PG8_STAGE(PG8_SB(1, 0), cB + kstep, voffB); PG8_STAGE(PG8_SA(1, 0), cA + kstep, voffA); PG8_STAGE(PG8_SB(1, 1), cB + hstep + kstep, voffB);
        PG8_WAIT_V(6); PG8_BAR;
    } else {
        PG8_STAGE(PG8_SB(0, 0), cB, voffB); PG8_STAGE(PG8_SA(0, 0), cA, voffA); PG8_STAGE(PG8_SB(0, 1), cB + hstep, voffB); PG8_STAGE(PG8_SA(0, 1), cA + hstep, voffA);
        if (wr == 1) PG8_BAR;
        PG8_WAIT_V(4); PG8_BAR;
        PG8_STAGE(PG8_SB(1, 0), cB + kstep, voffB); PG8_STAGE(PG8_SA(1, 0), cA + kstep, voffA); PG8_STAGE(PG8_SB(1, 1), cB + hstep + kstep, voffB);
        PG8_WAIT_V(6); PG8_BAR;
    }
    for (;;) {
        const bool has_next = S.next(ui + 1, nxt);
        const char* nA = has_next ? (const char*)g.A + (size_t)nxt.pm * tstep : cA; const char* nB = has_next ? (const char*)g.Bt + (size_t)nxt.pn * tstep : cB;
        for (int t = 0; t < nt; t += 2) {
            const bool last = (t == nt - 2);
            const char* a1 = cA + (size_t)(t + 1) * kstep;
            const char* a2 = last ? nA : cA + (size_t)(t + 2) * kstep; const char* b2 = last ? nB : cB + (size_t)(t + 2) * kstep;
            const char* a3 = a2 + kstep; const char* b3 = b2 + kstep;
            if (last && has_next) S.a_ready(nxt);
            if constexpr (SP2) {
            PG8_LDB(B0, 0, 0); PG8_LDB(B1, 0, 1); PG8_SCHED; PG8_LDA(At, 0, 0); PG8_STAGE(PG8_SA(1, 1), a1 + hstep, voffA);
            PG8_WAIT_V(8); PG8_WAIT_L(0); PG8_BAR; PG8_MMA(0, 0, At, B0); PG8_MMA(0, 1, At, B1); PG8_BAR; PG8_SCHED;
            PG8_LDA(At, 0, 1); PG8_STAGE(PG8_SB(0, 0), b2, voffB); PG8_STAGE(PG8_SB(0, 1), b2 + hstep, voffB); PG8_STAGE(PG8_SA(0, 0), a2, voffA);
            PG8_WAIT_V(8); PG8_WAIT_L(0); PG8_BAR; PG8_MMA(1, 0, At, B0); PG8_MMA(1, 1, At, B1); PG8_BAR; PG8_SCHED;
            PG8_LDB(B0, 1, 0); PG8_LDB(B1, 1, 1); PG8_SCHED; PG8_LDA(At, 1, 0); PG8_STAGE(PG8_SA(0, 1), a2 + hstep, voffA);
            PG8_WAIT_V(8); PG8_WAIT_L(0); PG8_BAR; PG8_MMA(0, 0, At, B0); PG8_MMA(0, 1, At, B1); PG8_BAR; PG8_SCHED;
            PG8_LDA(At, 1, 1); PG8_STAGE(PG8_SB(1, 0), b3, voffB); PG8_STAGE(PG8_SB(1, 1), b3 + hstep, voffB); PG8_STAGE(PG8_SA(1, 0), a3, voffA);
            PG8_WAIT_V(8); PG8_WAIT_L(0); PG8_BAR; PG8_MMA(1, 0, At, B0); PG8_MMA(1, 1, At, B1); PG8_BAR; PG8_SCHED;
            } else {
            PG8_LDB(B0, 0, 0); PG8_SCHED; PG8_LDA(At, 0, 0); PG8_STAGE(PG8_SA(1, 1), a1 + hstep, voffA);
            PG8_WAIT_L(8); PG8_BAR; PG8_WAIT_L(0); PG8_MMA(0, 0, At, B0); PG8_BAR; PG8_SCHED;
            PG8_LDB(B1, 0, 1); PG8_STAGE(PG8_SB(0, 0), b2, voffB);
            PG8_BAR; PG8_WAIT_L(0); PG8_MMA(0, 1, At, B1); PG8_BAR;
            PG8_LDA(At, 0, 1); PG8_STAGE(PG8_SA(0, 0), a2, voffA);
            PG8_BAR; PG8_WAIT_L(0); PG8_MMA(1, 0, At, B0); PG8_BAR; PG8_SCHED;
            PG8_STAGE(PG8_SB(0, 1), b2 + hstep, voffB);
            PG8_WAIT_V(6); PG8_BAR; PG8_MMA(1, 1, At, B1); PG8_BAR;
            PG8_LDB(B0, 1, 0); PG8_SCHED; PG8_LDA(At, 1, 0); PG8_STAGE(PG8_SA(0, 1), a2 + hstep, voffA);
            PG8_WAIT_L(8); PG8_BAR; PG8_WAIT_L(0); PG8_MMA(0, 0, At, B0); PG8_BAR; PG8_SCHED;
            PG8_LDB(B1, 1, 1); PG8_STAGE(PG8_SB(1, 0), b3, voffB);
            PG8_BAR; PG8_WAIT_L(0); PG8_MMA(0, 1, At, B1); PG8_BAR;
            PG8_LDA(At, 1, 1); PG8_STAGE(PG8_SA(1, 0), a3, voffA);
            PG8_BAR; PG8_WAIT_L(0); PG8_MMA(1, 0, At, B0); PG8_BAR; PG8_SCHED;
            PG8_STAGE(PG8_SB(1, 1), b3 + hstep, voffB);
            PG8_WAIT_V(6); PG8_BAR; PG8_MMA(1, 1, At, B1); PG8_BAR;
            }
        }
        if constexpr (ALIGN_EPI) { if (wr == 0) PG8_BAR; }
        if constexpr (!Epi::AFTER_DRAIN) { E(acc, cur, wr, wc, fr, fq); S.done(cur); }
        if (!has_next) break;
#pragma unroll
        for (int a = 0; a < 2; ++a)
#pragma unroll
            for (int b = 0; b < 2; ++b)
#pragma unroll
                for (int m = 0; m < 4; ++m)
#pragma unroll
                    for (int n = 0; n < 2; ++n) acc[a][b][m][n] = (f32x4){0.f, 0.f, 0.f, 0.f};
        cur = nxt; cA = nA; cB = nB; ++ui;
        if constexpr (ALIGN_EPI) { if (wr == 1) PG8_BAR; }
    }
    PG8_WAIT_V(0);
    if constexpr (!ALIGN_EPI) { if (wr == 0) PG8_BAR; }
    PG8_BAR;
    if constexpr (Epi::AFTER_DRAIN) { E.fused(acc, cur, wr, wc, fr, fq, lds, wid, lane); S.done(cur); }
#undef PG8_SA
#undef PG8_SB
#undef PG8_STAGE
#undef PG8_LDA
#undef PG8_LDB
#undef PG8_MMA
#undef PG8_WAIT_V
#undef PG8_WAIT_L
#undef PG8_BAR
#undef PG8_SCHED
}
}

struct Params {
    const float* in[22];
    float* out;
    unsigned char* ws;
    int ph_lo, ph_hi;
};
struct Ctx { LAS unsigned char* lds; int tid, lane, wave, vcu, G, gw, ngw; unsigned long long ta, tb, tc; };

__device__ __forceinline__ void p0_transpose_item(const float* W, int K, int Nreal, int thresh, const float* ksc, bf16_t* WT, LAS float* scr, int item, int nblk, int lane) {
    const int kb = item / nblk, nb = item % nblk, k0 = 64 * kb, n0 = 32 * nb;
    const int nr0 = n0 + (n0 >= thresh ? 8 : 0);
#pragma unroll 8
    for (int i = 0; i < 32; ++i) {
        const int kk = 2 * i + (lane >> 5);
        const float sc = ksc ? ksc[k0 + kk] : 1.f;
        scr[kk * 33 + (lane & 31)] = W[(size_t)(k0 + kk) * Nreal + nr0 + (lane & 31)] * sc;
    }
    LDS_WAIT(); asm volatile("" ::: "memory");
    const int c = lane & 7;
#pragma unroll
    for (int j = 0; j < 4; ++j) {
        const int n = (lane >> 3) + 8 * j; const LAS float* s = scr + (8 * c) * 33 + n;
        u32x4 o; o.x = pk2(s[0 * 33], s[1 * 33]); o.y = pk2(s[2 * 33], s[3 * 33]); o.z = pk2(s[4 * 33], s[5 * 33]); o.w = pk2(s[6 * 33], s[7 * 33]);
        *(u32x4*)(WT + (size_t)(n0 + n) * K + k0 + 8 * c) = o;
    }
    LDS_WAIT(); asm volatile("" ::: "memory");
}

__device__ __forceinline__ void phase0(const Params& p, Ctx& F) {
    const float* x = p.in[0]; const float* mixw = p.in[1]; const float* w_in = p.in[2];
    const float* w_out = p.in[16]; const float* ffnw = p.in[17]; const float* w_q = p.in[18]; const float* keys = p.in[19];
    const float* pu = p.in[20]; const float* pv = p.in[21];
    unsigned char* ws = p.ws;
    LAS float* scr = (LAS float*)(F.lds + F.wave * 8448);
    LAS float* wdt = (LAS float*)(F.lds + 69632);
    {
        constexpr int WLD = 132;
        LAS float* WQS = (LAS float*)F.lds;
        LAS float* KYS = (LAS float*)(F.lds + 64 * WLD * 4);
        bf16_t* wefft = (bf16_t*)(ws + WS_WQT);
        for (int u = F.vcu; u < 256; u += F.G) {
            const int hj = u >> 4, kt = u & 15;
            __syncthreads();
#pragma unroll
            for (int i = 0; i < 4; ++i) {
                const int pc = F.tid + 512 * i, k = pc >> 5, d4 = pc & 31;
                const f32x4 v = *(const f32x4*)(w_q + (size_t)(64 * kt + k) * 2048 + hj * 128 + d4 * 4);
                *(LAS f32x4*)(WQS + k * WLD + d4 * 4) = v * ffnw[64 * kt + k];
            }
#pragma unroll
            for (int i = 0; i < 8; ++i) {
                const int pc = F.tid + 512 * i, n = pc >> 5, d4 = pc & 31;
                *(LAS f32x4*)(KYS + n * WLD + d4 * 4) = *(const f32x4*)(keys + ((size_t)hj * 128 + n) * 128 + d4 * 4);
            }
            __syncthreads();
            const int fr_ = F.lane & 15, fq_ = F.lane >> 4, mt = F.wave >> 1, nt0 = (F.wave & 1) * 4;
            f32x4 acc[4];
#pragma unroll
            for (int q = 0; q < 4; ++q) acc[q] = (f32x4){0.f, 0.f, 0.f, 0.f};
#pragma unroll 4
            for (int ks = 0; ks < 32; ++ks) {
                const float av = WQS[(mt * 16 + fr_) * WLD + 4 * ks + fq_];
#pragma unroll
                for (int q = 0; q < 4; ++q) {
                    const float bv = KYS[((nt0 + q) * 16 + fr_) * WLD + 4 * ks + fq_];
                    acc[q] = __builtin_amdgcn_mfma_f32_16x16x4f32(av, bv, acc[q], 0, 0, 0);
                }
            }
#pragma unroll
            for (int q = 0; q < 4; ++q) {
                u32x2 w; w.x = pk2(acc[q][0], acc[q][1]); w.y = pk2(acc[q][2], acc[q][3]);
                *(u32x2*)(wefft + ((size_t)hj * 128 + (nt0 + q) * 16 + fr_) * DM + 64 * kt + mt * 16 + 4 * fq_) = w;
            }
        }
        __syncthreads();
    }
    for (int k = F.tid; k < DM; k += 512) {
        const float s = mixw[k];
        const f32x4 a = *(const f32x4*)(w_in + (size_t)k * 3080 + 1536), b = *(const f32x4*)(w_in + (size_t)k * 3080 + 1540);
        *(LAS f32x4*)(wdt + k * 8) = a * s; *(LAS f32x4*)(wdt + k * 8 + 4) = b * s;
    }
    __syncthreads();
    constexpr int I_IN = 16 * 96, I_OUT = 16 * 32;
    for (int it = F.gw; it < I_IN + I_OUT; it += F.ngw) {
        int r = it;
        if (r < I_IN) { p0_transpose_item(w_in, DM, 3080, 1536, mixw, (bf16_t*)(ws + WS_WINT), scr, r, 96, F.lane); continue; } r -= I_IN;
        p0_transpose_item(w_out, DM, DM, 1 << 30, nullptr, (bf16_t*)(ws + WS_WOUTT), scr, r, 32, F.lane);
    }
    const int gtid = F.vcu * 512 + F.tid, nthr = F.G * 512;
    for (int i = gtid; i < TOK; i += nthr) ((float*)(ws + WS_CTL) + CW_ROWSQ)[i] = 0.f;
    for (int i = gtid; i < SEQ * 8; i += nthr) {
        const int pos = i >> 3, f = i & 7;
        const float inv = powf(500000.0f, -(float)(2 * f) / 16.0f);
        const float ang = (float)pos * inv;
        ((float*)(ws + WS_ROPE))[i] = cosf(ang);
        ((float*)(ws + WS_ROPE))[SEQ * 8 + i] = sinf(ang);
    }
#if defined(PROBE_PHASE) && (PROBE_PHASE == 83 || PROBE_PHASE == 84)
    if (F.gw == 0 && F.lane == 0) { unsigned* mw = (unsigned*)(ws + WS_MISC); mw[2] = 0u; mw[3] = 0xffffffffu; mw[4] = 0u; }
#endif
    if (F.gw == 0) {
        const float a = p.in[11][F.lane] * p.in[12][F.lane], b = p.in[13][F.lane] * p.in[14][F.lane];
        const float sa = wave_sum(a), sb = wave_sum(b);
        if (F.lane == 0) ((float*)(ws + WS_MISC))[0] = expf(sa) - expf(sb) + LAMBDA_INIT;
    }
    {
        float* rsu = (float*)(ws + WS_RSU); float* rsv = (float*)(ws + WS_RSV);
        for (int r0 = F.gw; r0 < 2 * 16384; r0 += 4 * F.ngw) {
            f32x4 a[4][4]; float amax[4];
#pragma unroll
            for (int u = 0; u < 4; ++u) {
                const int r = min(r0 + u * F.ngw, 2 * 16384 - 1); const bool isU = r < 16384; const int e = r & 16383;
                const float* src = (isU ? pu : pv) + (size_t)e * DM + 16 * F.lane;
#pragma unroll
                for (int q = 0; q < 4; ++q) a[u][q] = __builtin_nontemporal_load((const f32x4*)(src + 4 * q));
            }
#pragma unroll
            for (int u = 0; u < 4; ++u) {
                const int r = min(r0 + u * F.ngw, 2 * 16384 - 1); const bool isU = r < 16384;
                amax[u] = 0.f;
#pragma unroll
                for (int q = 0; q < 4; ++q) {
                    if (isU) a[u][q] = a[u][q] * *(const f32x4*)(ffnw + 16 * F.lane + 4 * q);
                    amax[u] = fmaxf(amax[u], fmaxf(fmaxf(fabsf(a[u][q][0]), fabsf(a[u][q][1])), fmaxf(fabsf(a[u][q][2]), fabsf(a[u][q][3]))));
                }
            }
#pragma unroll
            for (int u = 0; u < 4; ++u) amax[u] = wave_max(amax[u]);
#pragma unroll
            for (int u = 0; u < 4; ++u) {
                const int r = min(r0 + u * F.ngw, 2 * 16384 - 1); const bool isU = r < 16384; const int e = r & 16383;
#ifdef U_FP4
#ifdef V_FP4
#define V_FP4_ON 1
#else
#define V_FP4_ON 0
#endif
#ifndef FP4_NIB_SWAP
#define FP4_NIB_SWAP 0
#endif
                if (isU || V_FP4_ON) {
                    const float s4 = amax[u] > 0.f ? 6.f / amax[u] : 1.f;
                    if (F.lane == 0) (isU ? rsu : rsv)[e] = amax[u] > 0.f ? amax[u] * (1.f / 6.f) : 1.f;
                    u32x2 o4;
#pragma unroll
                    for (int hq = 0; hq < 2; ++hq) {
                        unsigned w = 0u;
#pragma unroll
                        for (int q2 = 0; q2 < 2; ++q2)
#pragma unroll
                            for (int el = 0; el < 4; ++el) {
                                const float qv = a[u][hq * 2 + q2][el] * s4, m = fabsf(qv);
                                const unsigned c = (unsigned)(m > 0.25f) + (unsigned)(m > 0.75f) + (unsigned)(m > 1.25f) + (unsigned)(m > 1.75f) + (unsigned)(m > 2.5f) + (unsigned)(m > 3.5f) + (unsigned)(m > 5.0f)
                                                 + (qv < 0.f ? 8u : 0u);
                                w |= c << (4 * ((q2 * 4 + el) ^ FP4_NIB_SWAP));
                            }
                        o4[hq] = w;
                    }
                    *(u32x2*)(ws + (isU ? WS_UB : WS_VB) + (size_t)e * (DM / 2) + 8 * F.lane) = o4;
                    continue;
                }
#endif
                const float sc = amax[u] > 0.f ? 240.f / amax[u] : 1.f;
                if (F.lane == 0) (isU ? rsu : rsv)[e] = amax[u] > 0.f ? amax[u] * (1.f / 240.f) : 1.f;
                u32x4 o;
#pragma unroll
                for (int q = 0; q < 4; ++q) {
                    int pk = 0;
                    pk = __builtin_amdgcn_cvt_pk_fp8_f32(a[u][q][0] * sc, a[u][q][1] * sc, pk, false);
                    pk = __builtin_amdgcn_cvt_pk_fp8_f32(a[u][q][2] * sc, a[u][q][3] * sc, pk, true);
                    o[q] = (unsigned)pk;
                }
                *(u32x4*)(ws + (isU ? WS_UB : WS_VB) + (size_t)e * DM + 16 * F.lane) = o;
            }
        }
    }
    bf16_t* xb = (bf16_t*)(ws + WS_XB); float* dtraw = (float*)(ws + WS_DTRAW);
    for (int m0 = F.gw; m0 < TOK; m0 += 2 * F.ngw) {
        f32x4 v[2][4]; float ss[2];
#pragma unroll
        for (int u = 0; u < 2; ++u) {
            const int m = m0 + u * F.ngw; ss[u] = 0.f;
            const f32x4* xr = (const f32x4*)(x + (size_t)(m < TOK ? m : m0) * DM) + F.lane;
#pragma unroll
            for (int j = 0; j < 4; ++j) v[u][j] = __builtin_nontemporal_load(xr + 64 * j);
        }
#pragma unroll
        for (int u = 0; u < 2; ++u)
#pragma unroll
            for (int j = 0; j < 4; ++j) ss[u] += (v[u][j][0] * v[u][j][0] + v[u][j][1] * v[u][j][1]) + (v[u][j][2] * v[u][j][2] + v[u][j][3] * v[u][j][3]);
        f32x4 d0[2], d1[2];
#pragma unroll
        for (int u = 0; u < 2; ++u) { d0[u] = (f32x4){0.f, 0.f, 0.f, 0.f}; d1[u] = (f32x4){0.f, 0.f, 0.f, 0.f}; }
#pragma unroll
        for (int j = 0; j < 4; ++j)
#pragma unroll
            for (int e = 0; e < 4; ++e) {
                const int k = 256 * j + 4 * F.lane + e;
                const f32x4 w0 = *(const LAS f32x4*)(wdt + k * 8), w1 = *(const LAS f32x4*)(wdt + k * 8 + 4);
#pragma unroll
                for (int u = 0; u < 2; ++u) { d0[u] += w0 * v[u][j][e]; d1[u] += w1 * v[u][j][e]; }
            }
#pragma unroll
        for (int u = 0; u < 2; ++u) {
            ss[u] = wave_sum(ss[u]);
#pragma unroll
            for (int e = 0; e < 4; ++e) { d0[u][e] = wave_sum(d0[u][e]); d1[u][e] = wave_sum(d1[u][e]); }
        }
#pragma unroll
        for (int u = 0; u < 2; ++u) {
            const int m = m0 + u * F.ngw;
            if (m < TOK) {
                const float r = rsqrtf(ss[u] * (1.f / DM) + EPSN);
                if (F.lane == 0) { *(f32x4*)(dtraw + (size_t)m * 8) = d0[u] * r; *(f32x4*)(dtraw + (size_t)m * 8 + 4) = d1[u] * r; }
                unsigned long long* o8 = (unsigned long long*)(xb + (size_t)m * DM) + F.lane;
#pragma unroll
                for (int j = 0; j < 4; ++j) o8[64 * j] = (unsigned long long)pk2(v[u][j][0] * r, v[u][j][1] * r) | ((unsigned long long)pk2(v[u][j][2] * r, v[u][j][3] * r) << 32);
            }
        }
    }
}

__device__ __forceinline__ void p2_qk_prepass(const Params& p, Ctx& F) {
    bf16_t* proj = (bf16_t*)(p.ws + WS_PROJ);
    const float* qnw = p.in[9]; const float* knw = p.in[10];
    const float* cosT = (const float*)(p.ws + WS_ROPE); const float* sinT = cosT + SEQ * 8;
    const int sub = F.lane & 7;
    float wq[8], wk[8];
#pragma unroll
    for (int e = 0; e < 8; ++e) { wq[e] = qnw[sub * 8 + e]; wk[e] = knw[sub * 8 + e]; }
    for (int base = F.gw; base < TOK * 2; base += 8 * F.ngw) {
        u32x4 raw[8];
#pragma unroll
        for (int u = 0; u < 8; ++u) {
            const int wsi = base + u * F.ngw;
            raw[u] = (wsi < TOK * 2) ? *(const u32x4*)(proj + (size_t)(wsi >> 1) * NIN + ((wsi & 1) ? PK : PQ) + F.lane * 8) : (u32x4){0u, 0u, 0u, 0u};
        }
#pragma unroll
        for (int u = 0; u < 8; ++u) {
            const int wsi = base + u * F.ngw;
            const int t = wsi >> 1, which = wsi & 1;
            float v[8];
#pragma unroll
            for (int e = 0; e < 4; ++e) { v[2 * e] = bf2f(raw[u][e] & 0xffffu); v[2 * e + 1] = bf2f(raw[u][e] >> 16); }
            float ss = 0.f;
#pragma unroll
            for (int e = 0; e < 8; ++e) ss += v[e] * v[e];
            ss += __shfl_xor(ss, 1); ss += __shfl_xor(ss, 2); ss += __shfl_xor(ss, 4);
            const float rs = rsqrtf(ss * (1.f / 64.f) + EPSN);
            const int pos = t & (SEQ - 1);
            float o[8];
#pragma unroll
            for (int e = 0; e < 8; ++e) {
                const float y = v[e] * rs * (which ? wk[e] : wq[e]);
                const float other = __shfl_xor(y, 1);
                float r = y;
                if (sub < 2) {
                    const float c = cosT[pos * 8 + e], sn = sinT[pos * 8 + e];
                    r = (sub == 0) ? (y * c - other * sn) : (other * sn + y * c);
                }
                o[e] = r;
            }
            u32x4 ov; ov.x = pk2(o[0], o[1]); ov.y = pk2(o[2], o[3]); ov.z = pk2(o[4], o[5]); ov.w = pk2(o[6], o[7]);
            if (wsi < TOK * 2) *(u32x4*)(proj + (size_t)t * NIN + (which ? PK : PQ) + F.lane * 8) = ov;
        }
    }
}

constexpr int P2_XS = 0, P2_BM = 33792, P2_CM = 51200, P2_CB = 68608, P2_MH = 85248, P2_XW = 122112, P2_ACS = 155904, P2_DT = 156928, P2_FAC = 157952;
constexpr int XS_LD = 264, BM_LD = 136, MH_LD = 72, CB_LD = 65;
static_assert(P2_FAC + 1024 <= LDS_BYTES, "P2 LDS");

__device__ __forceinline__ void p2_load_raw(const bf16_t* proj, int tid, int b, int c, int g, u32x4 (&rv)[11]) {
    const int cg = tid & 63, rg = tid >> 6, lc = cg * 8;
    const int pcol = lc < 256 ? PXS + g * 256 + lc : (lc < 384 ? PBM + g * 128 + (lc - 256) : PCM + g * 128 + (lc - 384));
#pragma unroll
    for (int i = 0; i < 11; ++i) {
        const int f = c * CHUNK + rg * 8 - 3 + i;
        u32x4 v = {0u, 0u, 0u, 0u};
        if (f >= 0) v = *(const u32x4*)(proj + ((size_t)b * SEQ + f) * NIN + pcol);
        rv[i] = v;
    }
}
__device__ __forceinline__ void p2_ssd_unit(const Params& p, Ctx& F, int b, int c, int g, u32x4 (&rv)[11], bool has_next, int nb, int nc, int ng) {
    unsigned char* ws = p.ws;
    const bf16_t* proj = (const bf16_t*)(ws + WS_PROJ);
    bf16_t* ycat = (bf16_t*)(ws + WS_YCAT); bf16_t* cmc = (bf16_t*)(ws + WS_CMC);
    bf16_t* states = (bf16_t*)(ws + WS_STATES); float* acs_g = (float*)(ws + WS_ACS); float* cdec = (float*)(ws + WS_CDEC);
    const float* dtraw = (const float*)(ws + WS_DTRAW);
    const float* conv_w = p.in[3]; const float* conv_b = p.in[4]; const float* dt_bias = p.in[5]; const float* a_log = p.in[6]; const float* d_skip = p.in[7];
    LAS bf16_t* XS = (LAS bf16_t*)(F.lds + P2_XS); LAS bf16_t* BM = (LAS bf16_t*)(F.lds + P2_BM); LAS bf16_t* CM = (LAS bf16_t*)(F.lds + P2_CM);
    LAS float* CB = (LAS float*)(F.lds + P2_CB); LAS bf16_t* MH = (LAS bf16_t*)(F.lds + P2_MH); LAS bf16_t* XW = (LAS bf16_t*)(F.lds + P2_XW);
    LAS float* ACS = (LAS float*)(F.lds + P2_ACS); LAS float* DT = (LAS float*)(F.lds + P2_DT); LAS float* FAC = (LAS float*)(F.lds + P2_FAC);
    const int tid = F.tid, lane = F.lane, wave = F.wave, fr = lane & 15, fq = lane >> 4;
    const size_t tbase = (size_t)b * SEQ + (size_t)c * CHUNK;
#ifndef SKIP_A
    {
        const int cg = tid & 63, rg = tid >> 6, lc = cg * 8;
        int pcol, dld, dcol, kind;
        if (lc < 256) { pcol = PXS + g * 256 + lc; dld = XS_LD; dcol = lc; kind = 0; }
        else if (lc < 384) { pcol = PBM + g * 128 + (lc - 256); dld = BM_LD; dcol = lc - 256; kind = 1; }
        else { pcol = PCM + g * 128 + (lc - 384); dld = BM_LD; dcol = lc - 384; kind = 2; }
        LAS bf16_t* dst = kind == 0 ? XS : (kind == 1 ? BM : CM);
        const int ch = pcol - 512;
        float cw[4][8], cbv[8];
#pragma unroll
        for (int w = 0; w < 4; ++w) {
            const f32x4 a = *(const f32x4*)(conv_w + w * 1024 + ch), bq = *(const f32x4*)(conv_w + w * 1024 + ch + 4);
#pragma unroll
            for (int e = 0; e < 4; ++e) { cw[w][e] = a[e]; cw[w][4 + e] = bq[e]; }
        }
        { const f32x4 a = *(const f32x4*)(conv_b + ch), bq = *(const f32x4*)(conv_b + ch + 4);
#pragma unroll
          for (int e = 0; e < 4; ++e) { cbv[e] = a[e]; cbv[4 + e] = bq[e]; } }
#pragma unroll
        for (int r = 0; r < 8; ++r) {
            const int l = rg * 8 + r;
            float o[8];
#pragma unroll
            for (int e = 0; e < 8; ++e) o[e] = cbv[e];
#pragma unroll
            for (int w = 0; w < 4; ++w)
#pragma unroll
                for (int e = 0; e < 4; ++e) {
                    o[2 * e] += cw[w][2 * e] * bf2f(rv[r + w][e] & 0xffffu);
                    o[2 * e + 1] += cw[w][2 * e + 1] * bf2f(rv[r + w][e] >> 16);
                }
#pragma unroll
            for (int e = 0; e < 8; ++e) o[e] = silu_f(o[e]);
            u32x4 ov; ov.x = pk2(o[0], o[1]); ov.y = pk2(o[2], o[3]); ov.z = pk2(o[4], o[5]); ov.w = pk2(o[6], o[7]);
            *(LAS u32x4*)(dst + l * dld + dcol) = ov;
            if (kind == 2) *(u32x4*)(cmc + (tbase + l) * 256 + g * 128 + dcol) = ov;
        }
    }
#endif
    if (has_next) p2_load_raw(proj, tid, nb, nc, ng, rv);
    if (tid < 256) {
        const int l = tid >> 2, h = tid & 3, hh = g * 4 + h;
        const float v = dtraw[(tbase + l) * 8 + hh] + dt_bias[hh];
        const float dt = v > 20.f ? v : log1pf(expf(v));
        DT[l * 4 + h] = dt;
        ACS[l * 4 + h] = dt * (-expf(a_log[hh]));
    }
    __syncthreads();
    if (wave < 4) {
        float s = ACS[lane * 4 + wave];
#pragma unroll
        for (int o = 1; o < 64; o <<= 1) { const float t = __shfl_up(s, o); if (lane >= o) s += t; }
        ACS[lane * 4 + wave] = s;
        if (lane == 63) cdec[((size_t)b * NCH + c) * 8 + g * 4 + wave] = expf(s);
    }
    __syncthreads();
    if (tid < 256) {
        const int l = tid >> 2, h = tid & 3;
        acs_g[(tbase + l) * 8 + g * 4 + h] = ACS[l * 4 + h];
        FAC[l * 4 + h] = DT[l * 4 + h] * expf(ACS[63 * 4 + h] - ACS[l * 4 + h]);
    }
#pragma unroll
    for (int q = 0; q < 2; ++q) {
        const int tile = wave * 2 + q, mt = tile >> 2, nt = tile & 3;
        f32x4 acc = {0.f, 0.f, 0.f, 0.f};
#pragma unroll
        for (int ks = 0; ks < 4; ++ks) {
            const bf16x8 a = *(const LAS bf16x8*)(CM + (mt * 16 + fr) * BM_LD + ks * 32 + fq * 8);
            const bf16x8 bq = *(const LAS bf16x8*)(BM + (nt * 16 + fr) * BM_LD + ks * 32 + fq * 8);
            acc = mfma16(a, bq, acc);
        }
#pragma unroll
        for (int j = 0; j < 4; ++j) CB[(mt * 16 + 4 * fq + j) * CB_LD + nt * 16 + fr] = acc[j];
    }
    __syncthreads();
    {
        const int sI = lane;
        float as_[4], ds_[4];
#pragma unroll
        for (int h = 0; h < 4; ++h) { as_[h] = ACS[sI * 4 + h]; ds_[h] = DT[sI * 4 + h]; }
#pragma unroll 2
        for (int li = 0; li < 8; ++li) {
            const int l = li * 8 + wave;
            const float cb = CB[l * CB_LD + sI];
#pragma unroll
            for (int h = 0; h < 4; ++h) {
                const float v = (sI <= l) ? cb * __expf(ACS[l * 4 + h] - as_[h]) * ds_[h] : 0.f;
                MH[(h * 64 + l) * MH_LD + sI] = (bf16_t)f2bf(v);
            }
        }
#pragma unroll
        for (int i = 0; i < 4; ++i) {
            const int pc = tid + 512 * i, l = pc >> 5, c8 = pc & 31;
            const u32x4 xv = *(const LAS u32x4*)(XS + l * XS_LD + c8 * 8);
            const float f = FAC[l * 4 + (c8 >> 3)];
            u32x4 o;
#pragma unroll
            for (int e = 0; e < 4; ++e) o[e] = pk2(bf2f(xv[e] & 0xffffu) * f, bf2f(xv[e] >> 16) * f);
            *(LAS u32x4*)(XW + l * XS_LD + c8 * 8) = o;
        }
    }
    __syncthreads();
    typedef short v4i16 __attribute__((ext_vector_type(4)));
#define TR16(PTR) __builtin_amdgcn_ds_read_tr16_b64_v4i16((LAS v4i16*)(PTR))
#define CAT8(LO, HI) (bf16x8){LO[0], LO[1], LO[2], LO[3], HI[0], HI[1], HI[2], HI[3]}
    const int trr = fr >> 2, trc = 4 * (fr & 3);
#ifndef SKIP_E
    {
        const int h = wave >> 1, hh = g * 4 + h; const float dsk = d_skip[hh];
#pragma unroll 1
        for (int mq = 0; mq < 2; ++mq) {
            const int lt = 2 * (wave & 1) + mq;
            bf16x8 bmh[2];
#pragma unroll
            for (int ks = 0; ks < 2; ++ks) bmh[ks] = *(const LAS bf16x8*)(MH + (h * 64 + lt * 16 + fr) * MH_LD + ks * 32 + fq * 8);
#pragma unroll 1
            for (int pt = 0; pt < 4; ++pt) {
                f32x4 acc = {0.f, 0.f, 0.f, 0.f};
#pragma unroll
                for (int ks = 0; ks < 2; ++ks) {
                    const LAS bf16_t* bp = XS + (ks * 32 + 8 * fq + trr) * XS_LD + h * 64 + pt * 16 + trc;
                    const v4i16 lo = TR16(bp), hi = TR16(bp + 4 * XS_LD);
                    acc = mfma16(CAT8(lo, hi), bmh[ks], acc);
                }
                const int l = lt * 16 + fr, pp = pt * 16 + 4 * fq;
                const u32x2 xv = *(const LAS u32x2*)(XS + l * XS_LD + h * 64 + pp);
                u32x2 w;
                w.x = pk2(acc[0] + bf2f(xv.x & 0xffffu) * dsk, acc[1] + bf2f(xv.x >> 16) * dsk);
                w.y = pk2(acc[2] + bf2f(xv.y & 0xffffu) * dsk, acc[3] + bf2f(xv.y >> 16) * dsk);
                *(u32x2*)(ycat + (tbase + l) * DM + g * 256 + h * 64 + pp) = w;
            }
        }
    }
#endif
#ifndef SKIP_F
    {
        const int h = wave >> 1, hh = g * 4 + h;
        bf16_t* sbase = states + (((size_t)b * NCH + c) * 8 + hh) * 64 * 128;
#pragma unroll 1
        for (int mq = 0; mq < 2; ++mq) {
            const int mt = 2 * (wave & 1) + mq;
            bf16x8 xw[2];
#pragma unroll
            for (int ks = 0; ks < 2; ++ks) {
                const LAS bf16_t* bp = XW + (ks * 32 + 8 * fq + trr) * XS_LD + h * 64 + mt * 16 + trc;
                const v4i16 lo = TR16(bp), hi = TR16(bp + 4 * XS_LD);
                xw[ks] = CAT8(lo, hi);
            }
#pragma unroll 1
            for (int nt = 0; nt < 8; ++nt) {
                f32x4 acc = {0.f, 0.f, 0.f, 0.f};
#pragma unroll
                for (int ks = 0; ks < 2; ++ks) {
                    const LAS bf16_t* ap = BM + (ks * 32 + 8 * fq + trr) * BM_LD + nt * 16 + trc;
                    const v4i16 lo = TR16(ap), hi = TR16(ap + 4 * BM_LD);
                    acc = mfma16(CAT8(lo, hi), xw[ks], acc);
                }
                u32x2 w; w.x = pk2(acc[0], acc[1]); w.y = pk2(acc[2], acc[3]);
                *(u32x2*)(sbase + (size_t)(mt * 16 + fr) * 128 + nt * 16 + 4 * fq) = w;
            }
        }
    }
#undef TR16
#undef CAT8
#endif
    __syncthreads();
}

__device__ __forceinline__ void phase2(const Params& p, Ctx& F) {
#if defined(PROBE_PHASE) && (PROBE_PHASE == 20 || PROBE_PHASE == 21)
    F.ta = __builtin_amdgcn_s_memrealtime();
#endif
#ifdef USE_QK_PREPASS
    p2_qk_prepass(p, F);
#endif
#if defined(PROBE_PHASE) && (PROBE_PHASE == 20 || PROBE_PHASE == 21)
    VM_WAIT(); F.tb = __builtin_amdgcn_s_memrealtime();
#endif
    {
        const bf16_t* proj = (const bf16_t*)(p.ws + WS_PROJ);
        u32x4 rv[11];
        if (F.vcu < NB * NCH * 2) p2_load_raw(proj, F.tid, F.vcu >> 7, (F.vcu >> 1) & 63, F.vcu & 1, rv);
        for (int u = F.vcu; u < NB * NCH * 2; u += F.G) {
            const int g = u & 1, c = (u >> 1) & 63, b = u >> 7;
            const int un = u + F.G;
            p2_ssd_unit(p, F, b, c, g, rv, un < NB * NCH * 2, un >> 7, (un >> 1) & 63, un & 1);
        }
    }
#if defined(PROBE_PHASE) && (PROBE_PHASE == 20 || PROBE_PHASE == 21)
    VM_WAIT(); F.tc = __builtin_amdgcn_s_memrealtime();
#endif
}

__device__ __forceinline__ void p3_scan(const Params& p, Ctx& F) {
    bf16_t* states = (bf16_t*)(p.ws + WS_STATES); const float* cdec = (const float*)(p.ws + WS_CDEC);
    const int gtid = F.vcu * 512 + F.tid, nthr = F.G * 512;
    for (int e = gtid; e < NB * 8 * 64 * 32; e += nthr) {
        const int n4 = e & 31, pp = (e >> 5) & 63, hh = (e >> 11) & 7, b = e >> 14;
        f32x4 carry = {0.f, 0.f, 0.f, 0.f};
        for (int c0 = 0; c0 < NCH; c0 += 16) {
            u32x2 s[16]; float dc[16];
#pragma unroll
            for (int i = 0; i < 16; ++i) {
                s[i] = *(const u32x2*)(states + ((((size_t)b * NCH + c0 + i) * 8 + hh) * 64 + pp) * 128 + n4 * 4);
                dc[i] = cdec[((size_t)b * NCH + c0 + i) * 8 + hh];
            }
#pragma unroll
            for (int i = 0; i < 16; ++i) {
                u32x2 w; w.x = pk2(carry[0], carry[1]); w.y = pk2(carry[2], carry[3]);
                *(u32x2*)(states + ((((size_t)b * NCH + c0 + i) * 8 + hh) * 64 + pp) * 128 + n4 * 4) = w;
                const f32x4 sv = {bf2f(s[i].x & 0xffffu), bf2f(s[i].x >> 16), bf2f(s[i].y & 0xffffu), bf2f(s[i].y >> 16)};
                carry = carry * dc[i] + sv;
            }
        }
    }
}

namespace att {
constexpr int NW = 8, QBLK = 32, KVBLK = 64;
constexpr float SCALE = 0.125f, THR = 8.f;
constexpr int SHM_V = KVBLK * 128 * 2, SHM_K = KVBLK * 64 * 2;
constexpr int LDS_V = 0, LDS_K = 2 * SHM_V, LDS_WS = LDS_K + 2 * SHM_K, LDS_END = LDS_WS + NW * 64 * 4;
#define KSWZ64(row, colB) ((row) * 128 + ((colB) ^ ((((row) >> 1) & 7) << 4)))
#define SBAR() __builtin_amdgcn_sched_barrier(0)
__device__ __forceinline__ int crow(int r, int hi) { return (r & 3) + 8 * (r >> 2) + 4 * hi; }
__device__ __forceinline__ unsigned cvtpk(float lo, float hi) { unsigned r; asm volatile("v_cvt_pk_bf16_f32 %0, %1, %2" : "=v"(r) : "v"(lo), "v"(hi)); return r; }

__device__ __forceinline__ void partialSM(f32x16& p0, f32x16& p1, float& m_reg, float& mn, float& alpha) {
    constexpr float C = SCALE * 1.4426950408889634f;
    float pmax = p0[0];
#pragma unroll
    for (int r = 1; r < 16; ++r) pmax = fmaxf(pmax, p0[r]);
#pragma unroll
    for (int r = 0; r < 16; ++r) pmax = fmaxf(pmax, p1[r]);
    { auto rr = __builtin_amdgcn_permlane32_swap(__float_as_uint(pmax), __float_as_uint(pmax), false, false);
      pmax = fmaxf(__uint_as_float(rr[0]), __uint_as_float(rr[1])); }
    if (__builtin_expect(__all(pmax - m_reg <= THR / SCALE), 1)) { mn = m_reg; alpha = 1.f; }
    else { mn = fmaxf(m_reg, pmax); alpha = __builtin_amdgcn_exp2f((m_reg - mn) * C); m_reg = mn; }
    const float mnC = -mn * C;
#pragma unroll
    for (int r = 0; r < 16; ++r) p0[r] = fmaf(p0[r], C, mnC);
#pragma unroll
    for (int r = 0; r < 16; ++r) p1[r] = fmaf(p1[r], C, mnC);
#pragma unroll
    for (int r = 0; r < 16; ++r) p0[r] = __builtin_amdgcn_exp2f(p0[r]);
}
__device__ __forceinline__ void finishSM(f32x16& p0, f32x16& p1, float alpha, float& l_reg, bf16x8& pa0, bf16x8& pa1, bf16x8& pa2, bf16x8& pa3) {
#pragma unroll
    for (int r = 0; r < 16; ++r) p1[r] = __builtin_amdgcn_exp2f(p1[r]);
    float ps = 0;
#pragma unroll
    for (int r = 0; r < 16; ++r) ps += p0[r];
#pragma unroll
    for (int r = 0; r < 16; ++r) ps += p1[r];
    { auto rr = __builtin_amdgcn_permlane32_swap(__float_as_uint(ps), __float_as_uint(ps), false, false);
      ps = __uint_as_float(rr[0]) + __uint_as_float(rr[1]); }
    l_reg = l_reg * alpha + ps;
#define PK4(P, BASE, OUT) do { unsigned a0 = cvtpk(P[BASE + 0], P[BASE + 1]), a1 = cvtpk(P[BASE + 2], P[BASE + 3]);   \
    unsigned b0 = cvtpk(P[BASE + 4], P[BASE + 5]), b1 = cvtpk(P[BASE + 6], P[BASE + 7]);                              \
    auto r0 = __builtin_amdgcn_permlane32_swap(a0, b0, false, false); auto r1 = __builtin_amdgcn_permlane32_swap(a1, b1, false, false); \
    u32x4 w = {r0[0], r1[0], r0[1], r1[1]}; OUT = *reinterpret_cast<bf16x8*>(&w); } while (0)
    PK4(p0, 0, pa0); PK4(p0, 8, pa1); PK4(p1, 0, pa2); PK4(p1, 8, pa3);
#undef PK4
}
__device__ __forceinline__ void qkt(f32x16& p0, f32x16& p1, const char* Ks, const bf16x8* qr, int r32, int hi) {
    p0 = f32x16{}; p1 = f32x16{};
#pragma unroll
    for (int d0 = 0; d0 < 4; ++d0) {
        const int cb = (d0 * 16 + hi * 8) * 2;
        const bf16x8 b0 = *reinterpret_cast<const bf16x8*>(Ks + KSWZ64(r32, cb));
        const bf16x8 b1 = *reinterpret_cast<const bf16x8*>(Ks + KSWZ64(32 + r32, cb));
        p0 = mfma32(b0, qr[d0], p0);
        p1 = mfma32(b1, qr[d0], p1);
    }
}
__device__ __forceinline__ void maskfill(f32x16& p0, f32x16& p1, bool m) {
    if (m) {
        asm volatile("; masked tile");
#pragma unroll
        for (int r = 0; r < 16; ++r) { p0[r] = -1e30f; p1[r] = -1e30f; }
    }
}
__device__ __forceinline__ int v_st(int k, int c) { const int kk = (k & ~0xC) | ((k & 4) << 1) | ((k & 8) >> 1); return ((kk >> 3) * 4 + (c >> 5)) * 512 + ((kk & 7) * 32 + (c & 31)) * 2; }
__device__ __forceinline__ int v_rd_base(int lane) { return ((lane & 3) << 3) | (((lane >> 2) & 3) << 6) | (((lane >> 4) & 1) << 5) | (((lane >> 5) & 1) << 8); }
constexpr int v_rd_off(int d0, int ks, int half) { return d0 * 512 + ks * 4096 + half * 2048; }
template <int OFF> __device__ __forceinline__ s16x4 tr_read(int vb) {
    s16x4 r; asm volatile("ds_read_b64_tr_b16 %0, %1 offset:%2" : "=&v"(r) : "v"(vb), "i"(OFF) : "memory"); return r;
}
template <int D0> __device__ __forceinline__ void pv_one(f32x16& od, int vb, bf16x8 pa0, bf16x8 pa1, bf16x8 pa2, bf16x8 pa3) {
    const s16x4 l0 = tr_read<v_rd_off(D0, 0, 0)>(vb), h0 = tr_read<v_rd_off(D0, 0, 1)>(vb), l1 = tr_read<v_rd_off(D0, 1, 0)>(vb), h1 = tr_read<v_rd_off(D0, 1, 1)>(vb);
    const s16x4 l2 = tr_read<v_rd_off(D0, 2, 0)>(vb), h2 = tr_read<v_rd_off(D0, 2, 1)>(vb), l3 = tr_read<v_rd_off(D0, 3, 0)>(vb), h3 = tr_read<v_rd_off(D0, 3, 1)>(vb);
    asm volatile("s_waitcnt lgkmcnt(0)" ::: "memory"); SBAR();
#define PKV(L, H) (bf16x8){L[0], L[1], L[2], L[3], H[0], H[1], H[2], H[3]}
    od = mfma32(pa0, PKV(l0, h0), od);
    od = mfma32(pa1, PKV(l1, h1), od);
    od = mfma32(pa2, PKV(l2, h2), od);
    od = mfma32(pa3, PKV(l3, h3), od);
#undef PKV
}
__device__ __forceinline__ void pv_d0(f32x16* o, int vb, bf16x8 pa0, bf16x8 pa1, bf16x8 pa2, bf16x8 pa3) {
    pv_one<0>(o[0], vb, pa0, pa1, pa2, pa3); pv_one<1>(o[1], vb, pa0, pa1, pa2, pa3); pv_one<2>(o[2], vb, pa0, pa1, pa2, pa3); pv_one<3>(o[3], vb, pa0, pa1, pa2, pa3);
}

__device__ __forceinline__ void attn_pass(const bf16_t* __restrict__ Qb, const bf16_t* __restrict__ Kh, const bf16_t* __restrict__ Vh, int NT, int my_last, char* lds, f32x16 (&o)[4]) {
    const int tid = threadIdx.x, wid = tid >> 6, lane = tid & 63, r32 = lane & 31, hi = lane >> 5;
    char* V_lds = lds + LDS_V; char* K_lds = lds + LDS_K;
    float* wsf = (float*)(lds + LDS_WS) + wid * 64; float* li_l = wsf; float* al_l = wsf + 32;
    float m_reg = -1e30f, l_reg = 0.f;
#pragma unroll
    for (int d = 0; d < 4; ++d) o[d] = f32x16{};
    bf16x8 qr[4];
    const bf16_t* Qw = Qb + (size_t)(wid * QBLK + r32) * NIN + hi * 8;
#pragma unroll
    for (int d0 = 0; d0 < 4; ++d0) qr[d0] = *reinterpret_cast<const bf16x8*>(Qw + d0 * 16);
    const int sr = tid >> 4, sc = (tid & 15) * 8, vst0 = v_st(sr, sc), vst1 = v_st(32 + sr, sc);
    const int krow = tid >> 3, kc8 = (tid & 7) * 8, kst = KSWZ64(krow, kc8 * 2);
    const int vb0 = (int)(uintptr_t)V_lds + v_rd_base(lane);
    struct { bf16x8 vs0, vs1, ks; } sr_[2];
#define SLOAD(i, k0) do { sr_[i].vs0 = *reinterpret_cast<const bf16x8*>(&Vh[(size_t)((k0) + sr) * NIN + sc]); sr_[i].vs1 = *reinterpret_cast<const bf16x8*>(&Vh[(size_t)((k0) + 32 + sr) * NIN + sc]); \
    sr_[i].ks = *reinterpret_cast<const bf16x8*>(&Kh[(size_t)((k0) + krow) * NIN + kc8]); } while (0)
#define SWRITE(b, i) do { *(bf16x8*)(V_lds + (b) * SHM_V + vst0) = sr_[i].vs0; *(bf16x8*)(V_lds + (b) * SHM_V + vst1) = sr_[i].vs1; \
    *(bf16x8*)(K_lds + (b) * SHM_K + kst) = sr_[i].ks; } while (0)
#define SWAIT() asm volatile("s_waitcnt vmcnt(3)" ::: "memory")
#define RESC(a) do { if (__any((a) < 1.f)) { if (hi == 0) al_l[r32] = (a); asm volatile("s_waitcnt lgkmcnt(0)" ::: "memory"); \
    _Pragma("unroll") for (int d = 0; d < 4; ++d) _Pragma("unroll") for (int r = 0; r < 16; ++r) o[d][r] *= al_l[crow(r, hi)]; } } while (0)
    f32x16 pA0, pA1, pB0, pB1; float mnA, mnB, alA, alB; bf16x8 pa0, pa1, pa2, pa3;
    constexpr int SE = 0, SO = 1;
    __syncthreads();
    SLOAD(SE, 0); asm volatile("s_waitcnt vmcnt(0)" ::: "memory"); SWRITE(0, SE); __syncthreads();
    qkt(pA0, pA1, K_lds, qr, r32, hi); partialSM(pA0, pA1, m_reg, mnA, alA);
    SLOAD(SO, KVBLK); if (2 < NT) SLOAD(SE, 2 * KVBLK);
    SWAIT(); SWRITE(1, SO); __syncthreads();
    for (int j = 1; j + 1 < NT; j += 2) {
        qkt(pB0, pB1, K_lds + SHM_K, qr, r32, hi); maskfill(pB0, pB1, j > my_last);
        finishSM(pA0, pA1, alA, l_reg, pa0, pa1, pa2, pa3);
        SLOAD(SO, (j + 2) * KVBLK);
        pv_d0(o, vb0, pa0, pa1, pa2, pa3); partialSM(pB0, pB1, m_reg, mnB, alB);
        __syncthreads(); SWAIT(); SWRITE(0, SE);
        RESC(alB); __syncthreads();
        qkt(pA0, pA1, K_lds, qr, r32, hi); maskfill(pA0, pA1, j + 1 > my_last);
        finishSM(pB0, pB1, alB, l_reg, pa0, pa1, pa2, pa3);
        if (j + 3 < NT) SLOAD(SE, (j + 3) * KVBLK);
        pv_d0(o, vb0 + SHM_V, pa0, pa1, pa2, pa3); partialSM(pA0, pA1, m_reg, mnA, alA);
        __syncthreads(); SWAIT(); SWRITE(1, SO);
        RESC(alA); __syncthreads();
    }
    SBAR(); qkt(pB0, pB1, K_lds + SHM_K, qr, r32, hi); maskfill(pB0, pB1, NT - 1 > my_last);
    finishSM(pA0, pA1, alA, l_reg, pa0, pa1, pa2, pa3); SBAR();
    pv_d0(o, vb0, pa0, pa1, pa2, pa3); partialSM(pB0, pB1, m_reg, mnB, alB);
    __syncthreads(); RESC(alB);
    finishSM(pB0, pB1, alB, l_reg, pa0, pa1, pa2, pa3); SBAR();
    pv_d0(o, vb0 + SHM_V, pa0, pa1, pa2, pa3);
    if (hi == 0) li_l[r32] = l_reg;
    asm volatile("s_waitcnt lgkmcnt(0)" ::: "memory");
#pragma unroll
    for (int r = 0; r < 16; ++r) {
        const float rl = __builtin_amdgcn_rcpf(li_l[crow(r, hi)]);
#pragma unroll
        for (int d = 0; d < 4; ++d) o[d][r] *= rl;
    }
    asm volatile("s_waitcnt vmcnt(0)" ::: "memory");
    __syncthreads();
#undef SLOAD
#undef SWRITE
#undef SWAIT
#undef RESC
}
}

__device__ __forceinline__ void p3_attn_unit(const Params& p, Ctx& F, int b, int h, int qb, float* oscr) {
    const bf16_t* proj = (const bf16_t*)(p.ws + WS_PROJ);
    bf16_t* ycat = (bf16_t*)(p.ws + WS_YCAT);
    const float lam = ((const float*)(p.ws + WS_MISC))[0];
    const float* subw = p.in[15];
    const int tid = F.tid, wid = F.wave, lane = F.lane, r32 = lane & 31, hi = lane >> 5;
    const size_t rowbase = (size_t)b * SEQ; const int q0 = qb * 256;
    const int NT = (q0 + 256) / 64, my_last = (q0 + 32 * wid) / 64;
    f32x16 o[4];
    for (int j = 0; j < 2; ++j) {
        const bf16_t* Qb = proj + (rowbase + q0) * NIN + PQ + h * 128 + j * 64;
        const bf16_t* Kh = proj + rowbase * NIN + PK + h * 128 + j * 64;
        const bf16_t* Vh = proj + rowbase * NIN + PV + h * 128;
        att::attn_pass(Qb, Kh, Vh, NT, my_last, (char*)F.lds, o);
        if (j == 0) {
            float* my = oscr + tid * 64;
#pragma unroll
            for (int d = 0; d < 4; ++d)
#pragma unroll
                for (int r4 = 0; r4 < 4; ++r4) *(f32x4*)(my + d * 16 + r4 * 4) = (f32x4){o[d][4 * r4], o[d][4 * r4 + 1], o[d][4 * r4 + 2], o[d][4 * r4 + 3]};
        }
    }
    float wv[4];
#pragma unroll
    for (int d = 0; d < 4; ++d) wv[d] = subw[d * 32 + r32] * (1.f - LAMBDA_INIT);
#pragma unroll
    for (int r = 0; r < 16; ++r) {
        float v[4]; float ss = 0.f;
#pragma unroll
        for (int d = 0; d < 4; ++d) { v[d] = oscr[tid * 64 + d * 16 + r] - lam * o[d][r]; ss += v[d] * v[d]; }
        ss += __shfl_xor(ss, 1); ss += __shfl_xor(ss, 2); ss += __shfl_xor(ss, 4); ss += __shfl_xor(ss, 8); ss += __shfl_xor(ss, 16);
        const float rs = rsqrtf(ss * (1.f / 128.f) + EPSN);
        const size_t row = rowbase + q0 + wid * 32 + att::crow(r, hi);
#pragma unroll
        for (int d = 0; d < 4; ++d) ycat[row * DM + 512 + h * 128 + d * 32 + r32] = (bf16_t)f2bf(v[d] * rs * wv[d]);
    }
}

__device__ __forceinline__ void phase3(const Params& p, Ctx& F) {
#if defined(PROBE_PHASE) && (PROBE_PHASE == 30 || PROBE_PHASE == 31)
    F.ta = __builtin_amdgcn_s_memrealtime();
#endif
    p3_scan(p, F);
#if defined(PROBE_PHASE) && (PROBE_PHASE == 30 || PROBE_PHASE == 31)
    VM_WAIT(); F.tb = __builtin_amdgcn_s_memrealtime();
#endif
    float* oscr = p.out + (size_t)F.vcu * (64 * 512);
    for (int ui = F.vcu; ui < 512; ui += F.G) {
        const int pi = ui & 255, bh = pi >> 3, s = pi & 7, b = bh >> 2, h = bh & 3;
        p3_attn_unit(p, F, b, h, ui < 256 ? 15 - s : s, oscr);
    }
#if defined(PROBE_PHASE) && (PROBE_PHASE == 30 || PROBE_PHASE == 31)
    VM_WAIT(); F.tc = __builtin_amdgcn_s_memrealtime();
#endif
}

constexpr int P4_PREV = 0, P4_CM = 69632, P4_ACS = 87040, P4_Y = 88064, Y_LD = 257;
static_assert(P4_Y + 64 * Y_LD * 4 <= LDS_BYTES, "P4 LDS");
__device__ __forceinline__ void p4_load(const bf16_t* states, const bf16_t* cmc, int tid, int b, int c, int g, u32x4 (&pv)[8], u32x4 (&cv)[2]) {
    const size_t tbase = (size_t)b * SEQ + (size_t)c * CHUNK;
#pragma unroll
    for (int i = 0; i < 8; ++i) {
        const int e = tid + 512 * i, n8 = e & 15, pp = (e >> 4) & 63, h = e >> 10;
        pv[i] = *(const u32x4*)(states + ((((size_t)b * NCH + c) * 8 + g * 4 + h) * 64 + pp) * 128 + n8 * 8);
    }
#pragma unroll
    for (int i = 0; i < 2; ++i) {
        const int e = tid + 512 * i, l = e >> 4, c8 = e & 15;
        cv[i] = *(const u32x4*)(cmc + (tbase + l) * 256 + g * 128 + c8 * 8);
    }
}
__device__ __forceinline__ void p4_unit(const Params& p, Ctx& F, int b, int c, int g, u32x4 (&pv)[8], u32x4 (&cv)[2], bool has_next, int nb, int nc, int ng) {
    unsigned char* ws = p.ws;
    const bf16_t* proj = (const bf16_t*)(ws + WS_PROJ);
    bf16_t* ycat = (bf16_t*)(ws + WS_YCAT); const bf16_t* cmc = (const bf16_t*)(ws + WS_CMC);
    const bf16_t* states = (const bf16_t*)(ws + WS_STATES); const float* acs_g = (const float*)(ws + WS_ACS);
    const float* normw = p.in[8];
    LAS bf16_t* PREV = (LAS bf16_t*)(F.lds + P4_PREV); LAS bf16_t* CM = (LAS bf16_t*)(F.lds + P4_CM);
    LAS float* ACS = (LAS float*)(F.lds + P4_ACS); LAS float* Y = (LAS float*)(F.lds + P4_Y);
    const int tid = F.tid, lane = F.lane, wave = F.wave, fr = lane & 15, fq = lane >> 4;
    const size_t tbase = (size_t)b * SEQ + (size_t)c * CHUNK;
#pragma unroll
    for (int i = 0; i < 8; ++i) {
        const int e = tid + 512 * i, n8 = e & 15, pp = (e >> 4) & 63, h = e >> 10;
        *(LAS u32x4*)(PREV + (h * 64 + pp) * BM_LD + n8 * 8) = pv[i];
    }
#pragma unroll
    for (int i = 0; i < 2; ++i) {
        const int e = tid + 512 * i, l = e >> 4, c8 = e & 15;
        *(LAS u32x4*)(CM + l * BM_LD + c8 * 8) = cv[i];
    }
    if (has_next) p4_load(states, cmc, tid, nb, nc, ng, pv, cv);
    if (tid < 256) { const int l = tid >> 2, h = tid & 3; ACS[l * 4 + h] = acs_g[(tbase + l) * 8 + g * 4 + h]; }
    __syncthreads();
    {
        const int h = wave >> 1;
#pragma unroll
        for (int mq = 0; mq < 2; ++mq) {
            const int mt = 2 * (wave & 1) + mq;
            bf16x8 a[4];
#pragma unroll
            for (int ks = 0; ks < 4; ++ks) a[ks] = *(const LAS bf16x8*)(CM + (mt * 16 + fr) * BM_LD + ks * 32 + fq * 8);
#pragma unroll
            for (int nt = 0; nt < 4; ++nt) {
                f32x4 acc = {0.f, 0.f, 0.f, 0.f};
#pragma unroll
                for (int ks = 0; ks < 4; ++ks) {
                    const bf16x8 bq = *(const LAS bf16x8*)(PREV + (h * 64 + nt * 16 + fr) * BM_LD + ks * 32 + fq * 8);
                    acc = mfma16(a[ks], bq, acc);
                }
#pragma unroll
                for (int j = 0; j < 4; ++j) {
                    const int l = mt * 16 + 4 * fq + j, col = h * 64 + nt * 16 + fr;
                    Y[l * Y_LD + col] = acc[j] * __expf(ACS[l * 4 + h]);
                }
            }
        }
    }
    __syncthreads();
    {
        const int c8 = lane & 31, hr = lane >> 5;
        const f32x4 nw0 = *(const f32x4*)(normw + g * 256 + c8 * 8), nw1 = *(const f32x4*)(normw + g * 256 + c8 * 8 + 4);
#pragma unroll 2
        for (int r = 0; r < 4; ++r) {
            const int l = wave * 8 + r * 2 + hr;
            const size_t t = tbase + l;
            const u32x4 yl = *(const u32x4*)(ycat + t * DM + g * 256 + c8 * 8);
            const u32x4 zz = *(const u32x4*)(proj + t * NIN + PZ + g * 256 + c8 * 8);
            float v[8]; float ss = 0.f;
#pragma unroll
            for (int e = 0; e < 4; ++e) {
                const float y0 = bf2f(yl[e] & 0xffffu) + Y[l * Y_LD + c8 * 8 + 2 * e], y1 = bf2f(yl[e] >> 16) + Y[l * Y_LD + c8 * 8 + 2 * e + 1];
                v[2 * e] = y0 * silu_f(bf2f(zz[e] & 0xffffu)); v[2 * e + 1] = y1 * silu_f(bf2f(zz[e] >> 16));
                ss += v[2 * e] * v[2 * e] + v[2 * e + 1] * v[2 * e + 1];
            }
            ss += __shfl_xor(ss, 1); ss += __shfl_xor(ss, 2); ss += __shfl_xor(ss, 4); ss += __shfl_xor(ss, 8); ss += __shfl_xor(ss, 16);
            const float rs = rsqrtf(ss * (1.f / 256.f) + EPSN);
            u32x4 o;
            o.x = pk2(v[0] * rs * nw0[0], v[1] * rs * nw0[1]); o.y = pk2(v[2] * rs * nw0[2], v[3] * rs * nw0[3]);
            o.z = pk2(v[4] * rs * nw1[0], v[5] * rs * nw1[1]); o.w = pk2(v[6] * rs * nw1[2], v[7] * rs * nw1[3]);
            *(u32x4*)(ycat + t * DM + g * 256 + c8 * 8) = o;
        }
    }
    __syncthreads();
}
__device__ __forceinline__ void phase4(const Params& p, Ctx& F) {
    const bf16_t* states = (const bf16_t*)(p.ws + WS_STATES); const bf16_t* cmc = (const bf16_t*)(p.ws + WS_CMC);
    u32x4 pv[8], cv[2];
    if (F.vcu < NB * NCH * 2) p4_load(states, cmc, F.tid, F.vcu >> 7, (F.vcu >> 1) & 63, F.vcu & 1, pv, cv);
    for (int u = F.vcu; u < NB * NCH * 2; u += F.G) {
        const int g = u & 1, c = (u >> 1) & 63, b = u >> 7;
        const int un = u + F.G;
        p4_unit(p, F, b, c, g, pv, cv, un < NB * NCH * 2, un >> 7, (un >> 1) & 63, un & 1);
    }
}

__device__ __forceinline__ unsigned f2ord(float f) { const unsigned u = __float_as_uint(f); return (u >> 31) ? ~u : (u | 0x80000000u); }
__device__ __forceinline__ float ord2f(unsigned u) { return __uint_as_float((u >> 31) ? (u & 0x7fffffffu) : ~u); }
#define CE_DESC(A, B) do { const unsigned hi_ = (A) > (B) ? (A) : (B); const unsigned lo_ = (A) > (B) ? (B) : (A); (A) = hi_; (B) = lo_; } while (0)
template <int K, int J> __device__ __forceinline__ void bstage(unsigned (&r)[16]) {
#pragma unroll
    for (int i = 0; i < 16; ++i) { const int l = i ^ J; if (l > i) { if ((i & K) == 0) CE_DESC(r[i], r[l]); else CE_DESC(r[l], r[i]); } }
}
__device__ __forceinline__ void bitonic_merge16(unsigned (&r)[16]) { bstage<16, 8>(r); bstage<16, 4>(r); bstage<16, 2>(r); bstage<16, 1>(r); }
__device__ __forceinline__ void bitonic_sort16(unsigned (&r)[16]) {
    bstage<2, 1>(r); bstage<4, 2>(r); bstage<4, 1>(r); bstage<8, 4>(r); bstage<8, 2>(r); bstage<8, 1>(r); bitonic_merge16(r);
}
__device__ __forceinline__ void top16_merge(unsigned (&r)[16], const unsigned (&n)[16]) {
#pragma unroll
    for (int i = 0; i < 16; ++i) r[i] = r[i] > n[15 - i] ? r[i] : n[15 - i];
    bitonic_merge16(r);
}
__device__ __forceinline__ void top16_merge_lane(unsigned (&r)[16], int xm) {
    unsigned n[16];
#pragma unroll
    for (int i = 0; i < 16; ++i) n[i] = (unsigned)__shfl_xor((int)r[i], xm);
    top16_merge(r, n);
}
__device__ __forceinline__ void p7_cand_table(LAS unsigned char* CAND, int tid) {
    if (tid < 52) {
        int c = 0; unsigned char v = 255;
        for (int a = 0; a < 16; ++a) for (int b = 0; b < 16 / (a + 1); ++b) { if (c == tid) v = (unsigned char)(a * 16 + b); ++c; }
        CAND[tid] = v;
    }
}
__device__ __forceinline__ void route16(const bf16_t* qp, const float* rowsq, float* gwo, size_t t0, int lane, LAS unsigned* lists, const LAS unsigned char* CAND, LAS unsigned short* IDX) {
    const int tok = lane >> 2, part = lane & 3;
    const float r2 = rsqrtf(rowsq[t0 + tok] * (1.f / DM) + EPSN);
    u32x4 nxt[2][4];
#pragma unroll
    for (int j = 0; j < 2; ++j)
#pragma unroll
        for (int q = 0; q < 4; ++q) nxt[j][q] = __builtin_nontemporal_load((const u32x4*)(qp + (t0 + tok) * 2048 + j * 128 + part * 32 + q * 8));
#pragma unroll 1
    for (int h = 0; h < 8; ++h) {
        u32x4 raw[2][4];
#pragma unroll
        for (int j = 0; j < 2; ++j)
#pragma unroll
            for (int q = 0; q < 4; ++q) raw[j][q] = nxt[j][q];
        if (h < 7) {
#pragma unroll
            for (int j = 0; j < 2; ++j)
#pragma unroll
                for (int q = 0; q < 4; ++q) nxt[j][q] = __builtin_nontemporal_load((const u32x4*)(qp + (t0 + tok) * 2048 + (h + 1) * 256 + j * 128 + part * 32 + q * 8));
        }
#pragma unroll
        for (int j = 0; j < 2; ++j) {
            unsigned r[16], n[16];
#pragma unroll
            for (int q = 0; q < 2; ++q)
#pragma unroll
                for (int e = 0; e < 4; ++e) {
                    r[q * 8 + 2 * e]     = (f2ord(bf2f(raw[j][q][e] & 0xffffu) * r2) & ~127u) | (unsigned)(part * 32 + q * 8 + 2 * e);
                    r[q * 8 + 2 * e + 1] = (f2ord(bf2f(raw[j][q][e] >> 16) * r2) & ~127u) | (unsigned)(part * 32 + q * 8 + 2 * e + 1);
                    n[q * 8 + 2 * e]     = (f2ord(bf2f(raw[j][2 + q][e] & 0xffffu) * r2) & ~127u) | (unsigned)(part * 32 + 16 + q * 8 + 2 * e);
                    n[q * 8 + 2 * e + 1] = (f2ord(bf2f(raw[j][2 + q][e] >> 16) * r2) & ~127u) | (unsigned)(part * 32 + 16 + q * 8 + 2 * e + 1);
                }
            bitonic_sort16(r); bitonic_sort16(n);
            top16_merge(r, n);
            top16_merge_lane(r, 1);
            top16_merge_lane(r, 2);
            if (part == 0) {
#pragma unroll
                for (int k = 0; k < 16; ++k) lists[(tok * 2 + j) * 16 + k] = r[k];
            }
        }
        LDS_WAIT(); __builtin_amdgcn_wave_barrier();
        {
            const LAS unsigned* l0 = lists + (2 * tok) * 16; const LAS unsigned* l1 = lists + (2 * tok + 1) * 16;
            unsigned r[16];
#pragma unroll
            for (int m = 0; m < 13; ++m) {
                const unsigned ab = CAND[part + 4 * m];
                const unsigned a = (ab >> 4) & 15u, bb = ab & 15u;
                const float sum = ord2f(l0[a] & ~127u) + ord2f(l1[bb] & ~127u);
                r[m] = ab == 255u ? 0u : ((f2ord(sum) & ~255u) | ab);
            }
            r[13] = 0u; r[14] = 0u; r[15] = 0u;
            bitonic_sort16(r);
            top16_merge_lane(r, 1);
            top16_merge_lane(r, 2);
            float val[16]; unsigned ex[16]; float mx = -1e30f;
#pragma unroll
            for (int k = 0; k < 16; ++k) {
                const unsigned pos = r[k] & 255u, a = pos >> 4, bb = pos & 15u;
                const unsigned w0 = l0[a], w1 = l1[bb];
                ex[k] = (w0 & 127u) * 128u + (w1 & 127u);
                val[k] = ord2f(w0 & ~127u) + ord2f(w1 & ~127u);
                mx = fmaxf(mx, val[k]);
            }
            float sum = 0.f;
#pragma unroll
            for (int k = 0; k < 16; ++k) { val[k] = __expf(val[k] - mx); sum += val[k]; }
            const float inv = __builtin_amdgcn_rcpf(sum);
            float* go = gwo + ((t0 + tok) * 8 + h) * 16;
            if (part == 0) {
#pragma unroll
                for (int k = 0; k < 16; ++k) { IDX[tok * 128 + h * 16 + k] = (unsigned short)ex[k]; go[k] = val[k] * inv; }
            }
        }
        LDS_WAIT(); __builtin_amdgcn_wave_barrier();
    }
}

constexpr int PACE_WORDS = 32 * 16 * 16;
__device__ __forceinline__ void xcd_pace(const XcdBarrier& b, int slot) {
    __syncthreads();
    if (threadIdx.x == 0) {
        const unsigned nloc = b.st[0];
        unsigned* w = b.bar + XCD_BAR_WORDS + (slot * 16 + (int)b.x) * 16;
        (void)xb_add(w, 1u);
        unsigned sp = 0;
        while (xb_ld(w) < nloc && ++sp < 3000u) __builtin_amdgcn_s_sleep(1);
    }
    __syncthreads();
}
__device__ __forceinline__ float gelu_erf(float x) { return 0.5f * x * (1.f + erff(x * 0.70710678118654752f)); }
typedef float f32x2 __attribute__((ext_vector_type(2)));
constexpr int P8_NSL = 8, P8_SLC = DM / P8_NSL, P8_KS = P8_SLC / 32;
constexpr float P8_XS = 32.f;
static_assert(P8_SLC == 128, "lane mappings assume 128-column (128-byte) slices");
__device__ __forceinline__ void phase8(const Params& p, Ctx& F, const XcdBarrier& bar) {
    const bool pace = false;
    unsigned char* ws = p.ws;
    const unsigned char* uq = ws + WS_UB; const unsigned char* vq = ws + WS_VB;
    const float* rsu = (const float*)(ws + WS_RSU); const float* rsv = (const float*)(ws + WS_RSV);
    const bf16_t* x1b = (const bf16_t*)(ws + WS_X1B);
    const float* rowsq = (const float*)(ws + WS_CTL) + CW_ROWSQ;
    const float* gwi = (const float*)(ws + WS_GW);
    float* out = p.out;
    const int lane = F.lane, fr = lane & 15, fq = lane >> 4;
    LAS unsigned short* IDX = (LAS unsigned short*)(F.lds + F.wave * 20480);
    LAS float* COEF = (LAS float*)(F.lds + F.wave * 20480 + 4096);
    LAS unsigned char* STG = (LAS unsigned char*)COEF;
    LAS unsigned char* CAND = STG + 2048;
    __syncthreads();
    p7_cand_table(CAND, lane);
    LDS_WAIT(); __builtin_amdgcn_wave_barrier();
    for (int task = F.gw; task < TOK / 16; task += F.ngw) {
        const size_t t0 = (size_t)task * 16;
#if defined(PROBE_PHASE) && PROBE_PHASE == 82
        F.ta = __builtin_amdgcn_s_memrealtime();
#endif
        route16((const bf16_t*)(ws + WS_QP), rowsq, (float*)(ws + WS_GW), t0, lane, (LAS unsigned*)STG, CAND, IDX);
#if defined(PROBE_PHASE) && PROBE_PHASE == 82
        F.tb = __builtin_amdgcn_s_memrealtime();
#endif
        const float r2 = rsqrtf(rowsq[t0 + fr] * (1.f / DM) + EPSN);
        VM_WAIT(); LDS_WAIT(); __builtin_amdgcn_wave_barrier();
#if defined(PROBE_PHASE) && (PROBE_PHASE == 80 || PROBE_PHASE == 81)
        F.ta = __builtin_amdgcn_s_memrealtime();
#endif
        f32x4 accU[8];
#pragma unroll
        for (int h = 0; h < 8; ++h) accU[h] = (f32x4){0.f, 0.f, 0.f, 0.f};
        const int lrow = lane >> 3, lch = lane & 7;
        const int wofs0 = lrow * 128 + ((lch ^ (lrow & 7)) << 4), wofs1 = wofs0 + 1024;
        const float xsc = r2 * P8_XS;
#ifdef U_FP4
        typedef int v8i __attribute__((ext_vector_type(8)));
        int rofs4[2];
#pragma unroll
        for (int m = 0; m < 2; ++m) rofs4[m] = fr * 128 + (((4 * m + fq) ^ (fr & 7)) << 4);
#pragma unroll 1
        for (int sl = 0; sl < 4; ++sl) {
            v8i xf[2];
#pragma unroll
            for (int m = 0; m < 2; ++m) {
                const bf16_t* xp = x1b + (t0 + fr) * DM + sl * 256 + 128 * m + 16 * fq;
#pragma unroll
                for (int q = 0; q < 4; ++q) {
                    const u32x4 xv = *(const u32x4*)(xp + 64 * (q >> 1) + 8 * (q & 1));
                    int lo = 0, hi = 0;
                    lo = __builtin_amdgcn_cvt_pk_fp8_f32(bf2f(xv[0] & 0xffffu) * xsc, bf2f(xv[0] >> 16) * xsc, lo, false);
                    lo = __builtin_amdgcn_cvt_pk_fp8_f32(bf2f(xv[1] & 0xffffu) * xsc, bf2f(xv[1] >> 16) * xsc, lo, true);
                    hi = __builtin_amdgcn_cvt_pk_fp8_f32(bf2f(xv[2] & 0xffffu) * xsc, bf2f(xv[2] >> 16) * xsc, hi, false);
                    hi = __builtin_amdgcn_cvt_pk_fp8_f32(bf2f(xv[3] & 0xffffu) * xsc, bf2f(xv[3] >> 16) * xsc, hi, true);
                    xf[m][2 * q] = lo; xf[m][2 * q + 1] = hi;
                }
            }
            const unsigned char* ubs = uq + sl * 128 + lch * 16;
#pragma unroll 1
            for (int j0 = 0; j0 < 16; ++j0) {
                const bool mine = (fr == j0);
                v8i bm[2];
#pragma unroll
                for (int m = 0; m < 2; ++m)
#pragma unroll
                    for (int q = 0; q < 8; ++q) bm[m][q] = mine ? xf[m][q] : 0;
                u32x4 g0[8], g1[8];
#pragma unroll
                for (int h = 0; h < 8; ++h) {
                    const unsigned e0 = IDX[j0 * 128 + h * 16 + lrow], e1 = IDX[j0 * 128 + h * 16 + lrow + 8];
                    g0[h] = *(const u32x4*)(ubs + (size_t)e0 * (DM / 2));
                    g1[h] = *(const u32x4*)(ubs + (size_t)e1 * (DM / 2));
                }
#pragma unroll
                for (int hg = 0; hg < 2; ++hg) {
#pragma unroll
                    for (int h = 0; h < 4; ++h) {
                        *(LAS u32x4*)(STG + h * 2048 + wofs0) = g0[hg * 4 + h];
                        *(LAS u32x4*)(STG + h * 2048 + wofs1) = g1[hg * 4 + h];
                    }
                    __builtin_amdgcn_wave_barrier();
#pragma unroll
                    for (int h = 0; h < 4; ++h)
#pragma unroll
                        for (int m = 0; m < 2; ++m) {
                            const u32x4 a16 = *(const LAS u32x4*)(STG + h * 2048 + rofs4[m]);
                            const v8i av = {(int)a16.x, (int)a16.y, (int)a16.z, (int)a16.w, 0, 0, 0, 0};
                            accU[hg * 4 + h] = __builtin_amdgcn_mfma_scale_f32_16x16x128_f8f6f4(av, bm[m], accU[hg * 4 + h], 4, 0, 0, 0, 0, 0);
                        }
                    __builtin_amdgcn_wave_barrier();
                }
            }
        }
#else
        int rofs[P8_KS];
#pragma unroll
        for (int ks = 0; ks < P8_KS; ++ks) rofs[ks] = fr * 128 + (((2 * ks + (fq >> 1)) ^ (fr & 7)) << 4) + (fq & 1) * 8;
#pragma unroll 1
        for (int sl = 0; sl < P8_NSL; ++sl) {
            if (pace) xcd_pace(bar, sl);
            long xf[P8_KS];
#pragma unroll
            for (int ks = 0; ks < P8_KS; ++ks) {
                const u32x4 xv = *(const u32x4*)(x1b + (t0 + fr) * DM + sl * P8_SLC + ks * 32 + 8 * fq);
                int lo = 0, hi = 0;
                lo = __builtin_amdgcn_cvt_pk_fp8_f32(bf2f(xv[0] & 0xffffu) * xsc, bf2f(xv[0] >> 16) * xsc, lo, false);
                lo = __builtin_amdgcn_cvt_pk_fp8_f32(bf2f(xv[1] & 0xffffu) * xsc, bf2f(xv[1] >> 16) * xsc, lo, true);
                hi = __builtin_amdgcn_cvt_pk_fp8_f32(bf2f(xv[2] & 0xffffu) * xsc, bf2f(xv[2] >> 16) * xsc, hi, false);
                hi = __builtin_amdgcn_cvt_pk_fp8_f32(bf2f(xv[3] & 0xffffu) * xsc, bf2f(xv[3] >> 16) * xsc, hi, true);
                xf[ks] = (long)(((unsigned long long)(unsigned)hi << 32) | (unsigned long long)(unsigned)lo);
            }
            const unsigned char* ubs = uq + sl * P8_SLC + lch * 16;
#pragma unroll 1
            for (int j0 = 0; j0 < 16; ++j0) {
                const bool mine = (fr == j0);
                long bm[P8_KS];
#pragma unroll
                for (int ks = 0; ks < P8_KS; ++ks) bm[ks] = mine ? xf[ks] : 0l;
                u32x4 g0[8], g1[8];
#pragma unroll
                for (int h = 0; h < 8; ++h) {
                    const unsigned e0 = IDX[j0 * 128 + h * 16 + lrow], e1 = IDX[j0 * 128 + h * 16 + lrow + 8];
                    g0[h] = *(const u32x4*)(ubs + (size_t)e0 * DM);
                    g1[h] = *(const u32x4*)(ubs + (size_t)e1 * DM);
                }
#pragma unroll
                for (int hg = 0; hg < 2; ++hg) {
#pragma unroll
                    for (int h = 0; h < 4; ++h) {
                        *(LAS u32x4*)(STG + h * 2048 + wofs0) = g0[hg * 4 + h];
                        *(LAS u32x4*)(STG + h * 2048 + wofs1) = g1[hg * 4 + h];
                    }
                    __builtin_amdgcn_wave_barrier();
#pragma unroll
                    for (int h = 0; h < 4; ++h)
#pragma unroll
                        for (int ks = 0; ks < P8_KS; ++ks) {
                            const long a = *(const LAS long*)(STG + h * 2048 + rofs[ks]);
                            accU[hg * 4 + h] = __builtin_amdgcn_mfma_f32_16x16x32_fp8_fp8(a, bm[ks], accU[hg * 4 + h], 0, 0, 0);
                        }
                    __builtin_amdgcn_wave_barrier();
                }
            }
        }
#endif
        LDS_WAIT(); __builtin_amdgcn_wave_barrier();
#pragma unroll
        for (int h = 0; h < 8; ++h) {
            const f32x4 gv = *(const f32x4*)(gwi + (t0 + fr) * 128 + h * 16 + 4 * fq);
#pragma unroll
            for (int jj = 0; jj < 4; ++jj) {
                const int slot = h * 16 + 4 * fq + jj;
                const unsigned e = IDX[fr * 128 + slot];
                const float hv = accU[h][jj] * rsu[e] * (1.f / P8_XS);
                COEF[fr * 128 + slot] = gv[jj] * gelu_erf(hv) * rsv[e];
            }
        }
        LDS_WAIT(); __builtin_amdgcn_wave_barrier();
#if defined(PROBE_PHASE) && (PROBE_PHASE == 80 || PROBE_PHASE == 81)
        F.tb = __builtin_amdgcn_s_memrealtime();
#endif
#ifdef V_VALU
        const int sub = lane & 7, rg = lane >> 3;
#pragma unroll 1
        for (int sl = 0; sl < P8_NSL; ++sl) {
            const unsigned char* vbs = vq + sl * P8_SLC + sub * 16;
#pragma unroll 1
            for (int j0 = 0; j0 < 16; ++j0) {
                f32x2 acc[8];
#pragma unroll
                for (int q = 0; q < 8; ++q) acc[q] = (f32x2){0.f, 0.f};
#pragma unroll
                for (int ib = 0; ib < 2; ++ib) {
                    u32x4 w[8]; float cf[8];
#pragma unroll
                    for (int it = 0; it < 8; ++it) {
                        const int slot = (ib * 8 + it) * 8 + rg;
                        const unsigned e = IDX[j0 * 128 + slot];
                        cf[it] = COEF[j0 * 128 + slot];
                        w[it] = *(const u32x4*)(vbs + (size_t)e * DM);
                    }
#pragma unroll
                    for (int it = 0; it < 8; ++it)
#pragma unroll
                        for (int q = 0; q < 4; ++q) {
                            acc[2 * q] += __builtin_amdgcn_cvt_pk_f32_fp8((int)w[it][q], false) * cf[it];
                            acc[2 * q + 1] += __builtin_amdgcn_cvt_pk_f32_fp8((int)w[it][q], true) * cf[it];
                        }
                }
#pragma unroll
                for (int q = 0; q < 8; ++q) {
                    acc[q].x += __shfl_xor(acc[q].x, 8); acc[q].y += __shfl_xor(acc[q].y, 8);
                    acc[q].x += __shfl_xor(acc[q].x, 16); acc[q].y += __shfl_xor(acc[q].y, 16);
                    acc[q].x += __shfl_xor(acc[q].x, 32); acc[q].y += __shfl_xor(acc[q].y, 32);
                }
                if (rg == 0) {
                    float* orow = out + (t0 + j0) * DM + sl * P8_SLC + sub * 16;
                    const bf16_t* xrow = x1b + (t0 + j0) * DM + sl * P8_SLC + sub * 16;
#pragma unroll
                    for (int q = 0; q < 4; ++q) {
                        const u32x2 xv = *(const u32x2*)(xrow + 4 * q);
                        f32x4 o = {bf2f(xv.x & 0xffffu), bf2f(xv.x >> 16), bf2f(xv.y & 0xffffu), bf2f(xv.y >> 16)};
                        o[0] += acc[2 * q].x; o[1] += acc[2 * q].y; o[2] += acc[2 * q + 1].x; o[3] += acc[2 * q + 1].y;
                        *(f32x4*)(orow + 4 * q) = o;
                    }
                }
            }
        }
#elif defined(V_FP4)
        typedef int v2i __attribute__((ext_vector_type(2)));
        typedef int v8i __attribute__((ext_vector_type(8)));
        v8i cq8; float inv_cs;
        {
            f32x4 cv[2][4]; float cmax = 0.f;
#pragma unroll
            for (int hf = 0; hf < 2; ++hf)
#pragma unroll
                for (int q = 0; q < 4; ++q) {
                    cv[hf][q] = *(const LAS f32x4*)(COEF + fr * 128 + hf * 64 + 16 * fq + 4 * q);
                    cmax = fmaxf(cmax, fmaxf(fmaxf(fabsf(cv[hf][q][0]), fabsf(cv[hf][q][1])), fmaxf(fabsf(cv[hf][q][2]), fabsf(cv[hf][q][3]))));
                }
            cmax = fmaxf(cmax, __shfl_xor(cmax, 16)); cmax = fmaxf(cmax, __shfl_xor(cmax, 32));
            const float cs = cmax > 0.f ? 240.f / cmax : 1.f; inv_cs = cmax > 0.f ? cmax * (1.f / 240.f) : 1.f;
#pragma unroll
            for (int hf = 0; hf < 2; ++hf)
#pragma unroll
                for (int q = 0; q < 4; ++q) {
                    int pk = 0;
                    pk = __builtin_amdgcn_cvt_pk_fp8_f32(cv[hf][q][0] * cs, cv[hf][q][1] * cs, pk, false);
                    pk = __builtin_amdgcn_cvt_pk_fp8_f32(cv[hf][q][2] * cs, cv[hf][q][3] * cs, pk, true);
                    cq8[hf * 4 + q] = pk;
                }
        }
        LDS_WAIT(); __builtin_amdgcn_wave_barrier();
        int vwofs[16];
#pragma unroll
        for (int i = 0; i < 16; ++i) { const int rr = lrow + 8 * i; vwofs[i] = rr * 128 + ((lch ^ ((rr >> 1) & 7)) << 4); }
        int vrow_[2], vsw_[2];
#pragma unroll
        for (int t = 0; t < 2; ++t) { vrow_[t] = 32 * fq + 16 * t + fr; vsw_[t] = (vrow_[t] >> 1) & 7; }
#pragma unroll 1
        for (int sl = 0; sl < 4; ++sl) {
            f32x4 accV[16];
#pragma unroll
            for (int ct = 0; ct < 16; ++ct) accV[ct] = (f32x4){0.f, 0.f, 0.f, 0.f};
            const unsigned char* vbs = vq + sl * 128 + lch * 16;
#pragma unroll 1
            for (int j0 = 0; j0 < 16; ++j0) {
                const bool mine = (fr == j0);
                u32x4 g[16];
#pragma unroll
                for (int i = 0; i < 16; ++i) {
                    const unsigned e = IDX[j0 * 128 + lrow + 8 * i];
                    g[i] = *(const u32x4*)(vbs + (size_t)e * (DM / 2));
                }
#pragma unroll
                for (int i = 0; i < 16; ++i) *(LAS u32x4*)(STG + vwofs[i]) = g[i];
                __builtin_amdgcn_wave_barrier();
                v8i bmq;
#pragma unroll
                for (int q = 0; q < 8; ++q) bmq[q] = mine ? cq8[q] : 0;
#pragma unroll
                for (int ct = 0; ct < 16; ++ct) {
                    const v2i r0 = __builtin_amdgcn_ds_read_tr4_b64_v2i32((LAS v2i*)(STG + vrow_[0] * 128 + (((ct >> 1) ^ vsw_[0]) << 4) + (ct & 1) * 8));
                    const v2i r1 = __builtin_amdgcn_ds_read_tr4_b64_v2i32((LAS v2i*)(STG + vrow_[1] * 128 + (((ct >> 1) ^ vsw_[1]) << 4) + (ct & 1) * 8));
                    const v8i av = {r0.x, r0.y, r1.x, r1.y, 0, 0, 0, 0};
                    accV[ct] = __builtin_amdgcn_mfma_scale_f32_16x16x128_f8f6f4(av, bmq, accV[ct], 4, 0, 0, 0, 0, 0);
                }
                __builtin_amdgcn_wave_barrier();
            }
            float* orow = out + (t0 + fr) * DM + sl * 256 + 4 * fq;
            const bf16_t* xrow = x1b + (t0 + fr) * DM + sl * 256 + 4 * fq;
#pragma unroll
            for (int ct = 0; ct < 16; ++ct) {
                const u32x2 xv = *(const u32x2*)(xrow + ct * 16);
                f32x4 o = {bf2f(xv.x & 0xffffu), bf2f(xv.x >> 16), bf2f(xv.y & 0xffffu), bf2f(xv.y >> 16)};
                o += accV[ct] * inv_cs;
                __builtin_nontemporal_store(o, (f32x4*)(orow + ct * 16));
            }
        }
#else
        typedef int v2i __attribute__((ext_vector_type(2)));
        long cq[4]; float inv_cs;
        {
            f32x4 cv[4][2]; float cmax = 0.f;
#pragma unroll
            for (int kk = 0; kk < 4; ++kk)
#pragma unroll
                for (int q = 0; q < 2; ++q) {
                    cv[kk][q] = *(const LAS f32x4*)(COEF + fr * 128 + kk * 32 + 8 * fq + 4 * q);
                    cmax = fmaxf(cmax, fmaxf(fmaxf(fabsf(cv[kk][q][0]), fabsf(cv[kk][q][1])), fmaxf(fabsf(cv[kk][q][2]), fabsf(cv[kk][q][3]))));
                }
            cmax = fmaxf(cmax, __shfl_xor(cmax, 16)); cmax = fmaxf(cmax, __shfl_xor(cmax, 32));
            const float cs = cmax > 0.f ? 240.f / cmax : 1.f; inv_cs = cmax > 0.f ? cmax * (1.f / 240.f) : 1.f;
#pragma unroll
            for (int kk = 0; kk < 4; ++kk) {
                int lo = 0, hi = 0;
                lo = __builtin_amdgcn_cvt_pk_fp8_f32(cv[kk][0][0] * cs, cv[kk][0][1] * cs, lo, false);
                lo = __builtin_amdgcn_cvt_pk_fp8_f32(cv[kk][0][2] * cs, cv[kk][0][3] * cs, lo, true);
                hi = __builtin_amdgcn_cvt_pk_fp8_f32(cv[kk][1][0] * cs, cv[kk][1][1] * cs, hi, false);
                hi = __builtin_amdgcn_cvt_pk_fp8_f32(cv[kk][1][2] * cs, cv[kk][1][3] * cs, hi, true);
                cq[kk] = (long)(((unsigned long long)(unsigned)hi << 32) | (unsigned long long)(unsigned)lo);
            }
        }
        LDS_WAIT(); __builtin_amdgcn_wave_barrier();
        const int vrow = 8 * fq + (fr >> 1);
        const int vrd0 = vrow * 128 + (fr & 1) * 8, vsw = (vrow >> 1) & 7;
        int vwofs[4];
#pragma unroll
        for (int i = 0; i < 4; ++i) { const int rr = lrow + 8 * i; vwofs[i] = rr * 128 + ((lch ^ ((rr >> 1) & 7)) << 4); }
#pragma unroll 1
        for (int sl = 0; sl < P8_NSL; ++sl) {
            if (pace) xcd_pace(bar, P8_NSL + sl);
            f32x4 accV[8];
#pragma unroll
            for (int ct = 0; ct < 8; ++ct) accV[ct] = (f32x4){0.f, 0.f, 0.f, 0.f};
            const unsigned char* vbs = vq + sl * P8_SLC + lch * 16;
#pragma unroll 1
            for (int j0 = 0; j0 < 16; ++j0) {
                const bool mine = (fr == j0);
                u32x4 g[4][4];
#pragma unroll
                for (int kk = 0; kk < 4; ++kk)
#pragma unroll
                    for (int i = 0; i < 4; ++i) {
                        const unsigned e = IDX[j0 * 128 + kk * 32 + lrow + 8 * i];
                        g[kk][i] = *(const u32x4*)(vbs + (size_t)e * DM);
                    }
#pragma unroll
                for (int kk = 0; kk < 4; ++kk) {
                    LAS unsigned char* T = STG + (kk & 1) * 4096;
#pragma unroll
                    for (int i = 0; i < 4; ++i) *(LAS u32x4*)(T + vwofs[i]) = g[kk][i];
                    __builtin_amdgcn_wave_barrier();
                    const long bmq = mine ? cq[kk] : 0l;
#pragma unroll
                    for (int ct = 0; ct < 8; ++ct) {
                        const v2i av = __builtin_amdgcn_ds_read_tr8_b64_v2i32((LAS v2i*)(T + vrd0 + ((ct ^ vsw) << 4)));
                        const long a = (long)(((unsigned long long)(unsigned)av.y << 32) | (unsigned long long)(unsigned)av.x);
                        accV[ct] = __builtin_amdgcn_mfma_f32_16x16x32_fp8_fp8(a, bmq, accV[ct], 0, 0, 0);
                    }
                    __builtin_amdgcn_wave_barrier();
                }
            }
            float* orow = out + (t0 + fr) * DM + sl * P8_SLC + 4 * fq;
            const bf16_t* xrow = x1b + (t0 + fr) * DM + sl * P8_SLC + 4 * fq;
#pragma unroll
            for (int ct = 0; ct < 8; ++ct) {
                const u32x2 xv = *(const u32x2*)(xrow + ct * 16);
                f32x4 o = {bf2f(xv.x & 0xffffu), bf2f(xv.x >> 16), bf2f(xv.y & 0xffffu), bf2f(xv.y >> 16)};
                o += accV[ct] * inv_cs;
                __builtin_nontemporal_store(o, (f32x4*)(orow + ct * 16));
            }
        }
#endif
#if defined(PROBE_PHASE) && PROBE_PHASE >= 80
        F.tc = __builtin_amdgcn_s_memrealtime();
#endif
        LDS_WAIT(); __builtin_amdgcn_wave_barrier();
    }
}

constexpr int NPHASE = 9;
#ifndef N_LAUNCHES
#define N_LAUNCHES 1
#endif
constexpr int MISC_OFF = LDS_BYTES - 128;
__global__ void __launch_bounds__(512, 2) fwd_kernel(Params p) {
    extern __shared__ __attribute__((aligned(16))) unsigned char lds_raw[];
    Ctx F; F.ta = F.tb = F.tc = 0;
    F.lds = (LAS unsigned char*)lds_raw;
    F.tid = threadIdx.x; F.lane = F.tid & 63; F.wave = __builtin_amdgcn_readfirstlane(F.tid >> 6);
    F.G = gridDim.x; { const int bx = blockIdx.x; F.vcu = (F.G % 8 == 0) ? (bx % 8) * (F.G / 8) + bx / 8 : bx; }
    F.gw = F.vcu * 8 + F.wave; F.ngw = F.G * 8;
    unsigned char* ws = p.ws;
    const int lo = p.ph_lo, hi = p.ph_hi;
    volatile LAS unsigned* MISC = (volatile LAS unsigned*)(F.lds + MISC_OFF);
    if (F.tid < 32) MISC[F.tid] = 0u;
    __syncthreads();
#ifdef CG_FIRST_SYNC
    XcdBarrier bar; bar.bar = (unsigned*)(ws + WS_CTL) + CW_BAR; bar.x = 0; bar.st = MISC + 8;
    for (int i = blockIdx.x * 512 + F.tid; i < XCD_BAR_WORDS + PACE_WORDS; i += F.G * 512) __hip_atomic_store(bar.bar + i, 0u, __ATOMIC_RELAXED, __HIP_MEMORY_SCOPE_AGENT);
#else
    XcdBarrier bar = xcd_barrier_post((unsigned*)(ws + WS_CTL) + CW_BAR, MISC + 8);
#endif
#ifdef ONLY_PHASE
#define IN(k) ((k)==ONLY_PHASE)
#else
#define IN(k) (lo <= (k) && (k) < hi)
#endif
#ifdef PROBE_PHASE
    unsigned long long tp0 = __builtin_amdgcn_s_memrealtime(), tp1 = 0; const unsigned long long tstart = tp0;
#define PSTAMP(k) do { if ((k) + 1 == PROBE_PHASE) tp0 = __builtin_amdgcn_s_memrealtime(); if ((k) == PROBE_PHASE) tp1 = __builtin_amdgcn_s_memrealtime(); } while (0)
#else
#define PSTAMP(k) do {} while (0)
#endif
#define SEAM(k) do { if (IN(k) && ((k) == 6 ? IN(8) : IN((k) + 1))) xcd_barrier(bar); PSTAMP(k); } while (0)
    if (IN(0)) phase0(p, F);
#ifdef CG_FIRST_SYNC
    if (IN(0) && IN(1)) { cooperative_groups::this_grid().sync(); bar = xcd_barrier_post((unsigned*)(ws + WS_CTL) + CW_BAR, MISC + 8); }
    PSTAMP(0);
#else
    SEAM(0);
#endif
    if (IN(1)) {
        pg8::Gemm g{(const pg8::bf16_t*)(ws + WS_XB), (const pg8::bf16_t*)(ws + WS_WINT), TOK, NIN, DM};
        pg8::StaticOrder S; S.init(TOK, NIN, F.G, (int)blockIdx.x);
        pg8::EpiProj E{(pg8::bf16_t*)(ws + WS_PROJ), NIN, p.in[9], p.in[10], (const float*)(ws + WS_ROPE), (const float*)(ws + WS_ROPE) + SEQ * 8,
                       (LAS float*)(F.lds + pg8::STAGE_BYTES), PQ, PK, PV, SEQ - 1, EPSN};
        pg8::gemm_phase<pg8::EpiProj, pg8::StaticOrder, true, true>(F.lds, g, S, E);
    }
    SEAM(1);
    if (IN(2)) phase2(p, F);
    SEAM(2);
#if defined(PROBE_PHASE) && PROBE_PHASE == 84
    const unsigned long long t3s = __builtin_amdgcn_s_memrealtime();
#endif
    if (IN(3)) phase3(p, F);
#if defined(PROBE_PHASE) && PROBE_PHASE == 84
    { const unsigned long long tend = __builtin_amdgcn_s_memrealtime();
      if (F.tid == 0) { unsigned* mw = (unsigned*)(ws + WS_MISC); const unsigned d = (unsigned)(tend - t3s); atomicMax(mw + 2, d); atomicMin(mw + 3, d); atomicAdd(mw + 4, d >> 8); } }
#endif
    SEAM(3);
    if (IN(4)) phase4(p, F);
    SEAM(4);
    if (IN(5)) {
        pg8::Gemm g{(const pg8::bf16_t*)(ws + WS_YCAT), (const pg8::bf16_t*)(ws + WS_WOUTT), TOK, DM, DM};
        pg8::StaticOrder S; S.init(TOK, DM, F.G, (int)blockIdx.x);
        pg8::EpiResid E{p.in[0], p.out, (pg8::bf16_t*)(ws + WS_X1B), (float*)(ws + WS_CTL) + CW_ROWSQ, DM};
        pg8::gemm_phase<pg8::EpiResid, pg8::StaticOrder, true, true>(F.lds, g, S, E);
    }
    SEAM(5);
    if (IN(6)) {
        pg8::Gemm g{(const pg8::bf16_t*)(ws + WS_X1B), (const pg8::bf16_t*)(ws + WS_WQT), TOK, 2048, DM};
        pg8::StaticOrder S; S.init(TOK, 2048, F.G, (int)blockIdx.x);
        pg8::EpiBf16<0> E{(pg8::bf16_t*)(ws + WS_QP), 2048, nullptr, 0, 0, 1.f};
        pg8::gemm_phase<pg8::EpiBf16<0>, pg8::StaticOrder, true, true>(F.lds, g, S, E);
    }
    SEAM(6);
    PSTAMP(7);
#if defined(PROBE_PHASE) && PROBE_PHASE == 83
    tp0 = __builtin_amdgcn_s_memrealtime();
#endif
#ifdef PROBE_PHASE
    const unsigned sv_nloc = MISC[8], sv_nx = MISC[9];
#endif
    if (IN(8)) phase8(p, F, bar);
#ifdef PROBE_PHASE
    __syncthreads(); if (F.tid == 0) { MISC[8] = sv_nloc; MISC[9] = sv_nx; } __syncthreads();
#endif
#if defined(PROBE_PHASE) && PROBE_PHASE == 83
    {
        const unsigned long long tend = __builtin_amdgcn_s_memrealtime();
        if (F.tid == 0) { unsigned* mw = (unsigned*)(ws + WS_MISC); const unsigned d = (unsigned)(tend - tp0);
            atomicMax(mw + 2, d); atomicMin(mw + 3, d); atomicAdd(mw + 4, d >> 8); }
    }
#endif
#ifdef PROBE_PHASE
    xcd_barrier(bar);
    PSTAMP(8);
#if PROBE_PHASE == 83 || PROBE_PHASE == 84
    { const unsigned* mw = (const unsigned*)(ws + WS_MISC);
      const unsigned vmax = __hip_atomic_load(mw + 2, __ATOMIC_RELAXED, __HIP_MEMORY_SCOPE_AGENT), vmin = __hip_atomic_load(mw + 3, __ATOMIC_RELAXED, __HIP_MEMORY_SCOPE_AGENT), vsum = __hip_atomic_load(mw + 4, __ATOMIC_RELAXED, __HIP_MEMORY_SCOPE_AGENT);
      tp0 = 0; tp1 = PROBE_SUB == 0 ? vmax : (PROBE_SUB == 1 ? vmin : (unsigned)(((unsigned long long)vsum << 8) / gridDim.x)); }
#elif PROBE_PHASE == 9
    tp0 = tstart; tp1 = __builtin_amdgcn_s_memrealtime();
#elif PROBE_PHASE == 80 || PROBE_PHASE == 20 || PROBE_PHASE == 30 || PROBE_PHASE == 82
    tp0 = F.ta; tp1 = F.tb;
#elif PROBE_PHASE == 81 || PROBE_PHASE == 21 || PROBE_PHASE == 31
    tp0 = F.tb; tp1 = F.tc;
#endif
#if PROBE_PHASE == 98
    {
        typedef int v2i __attribute__((ext_vector_type(2)));
        float result = 0.f;
        __syncthreads();
        if (blockIdx.x == 0 && F.wave == 0) {
            LAS unsigned char* T = (LAS unsigned char*)F.lds;
            if (F.lane < 16) {
                unsigned long long w = 0ull;
                for (int c = 0; c < 16; ++c) { const unsigned long long nib = (PROBE_SUB == 0) ? (unsigned long long)F.lane : (unsigned long long)c; w |= nib << (4 * c); }
                *(LAS unsigned long long*)(T + F.lane * 8) = w;
            }
            LDS_WAIT(); __builtin_amdgcn_wave_barrier();
            const v2i rv_ = __builtin_amdgcn_ds_read_tr4_b64_v2i32((LAS v2i*)(T + (F.lane & 15) * 8));
            const unsigned long long got = ((unsigned long long)(unsigned)rv_.y << 32) | (unsigned long long)(unsigned)rv_.x;
            unsigned long long want = 0ull;
            for (int j = 0; j < 16; ++j) { const unsigned long long nib = (PROBE_SUB == 0) ? (unsigned long long)j : (unsigned long long)(F.lane & 15); want |= nib << (4 * j); }
            const unsigned long long bal = __ballot(got == want);
            result = (float)__popcll(bal);
        }
        if (blockIdx.x == 0 && F.tid == 0) { VM_WAIT(); p.out[0] += result; }
    }
#elif PROBE_PHASE == 99
    {
        typedef int v8i __attribute__((ext_vector_type(8)));
        float result = 0.f;
        if (blockIdx.x == 0 && F.wave == 0) {
            const int fr_ = F.lane & 15, fq_ = F.lane >> 4;
            v8i bv;
#pragma unroll
            for (int q = 0; q < 8; ++q) { unsigned w = 0; for (int bb = 0; bb < 4; ++bb) { unsigned pcode = (unsigned)(32 * fq_ + 4 * q + bb); if (pcode == 127u) pcode = 126u; w |= pcode << (8 * bb); } bv[q] = (int)w; }
            int matches = 0, firstbad = -1, firstbadval = -1;
            for (int ga = 0; ga < 4; ++ga)
                for (int ja = 0; ja < 32; ++ja) {
                    v8i av = {0, 0, 0, 0, 0, 0, 0, 0};
                    if (fr_ == 0 && fq_ == ga) { const unsigned nib = 2u << (4 * (ja & 7)); const int wsel = ja >> 3;
                        av[0] = wsel == 0 ? (int)nib : 0; av[1] = wsel == 1 ? (int)nib : 0; av[2] = wsel == 2 ? (int)nib : 0; av[3] = wsel == 3 ? (int)nib : 0; }
                    f32x4 c = {0.f, 0.f, 0.f, 0.f};
                    c = __builtin_amdgcn_mfma_scale_f32_16x16x128_f8f6f4(av, bv, c, 4, 0, 0, 0, 0, 0);
                    int pk = 0; pk = __builtin_amdgcn_cvt_pk_fp8_f32(c[0], 0.f, pk, false);
                    const int got = __shfl(pk & 255, 0);
                    int want = 32 * ga + ja; if (want == 127) want = 126;
                    if (got == want) ++matches; else if (firstbad < 0) { firstbad = 32 * ga + ja; firstbadval = got; }
                }
#if PROBE_SUB == 0
            result = (float)matches;
#elif PROBE_SUB == 1
            result = (float)firstbad;
#else
            result = (float)firstbadval;
#endif
        }
        if (blockIdx.x == 0 && F.tid == 0) { VM_WAIT(); p.out[0] += result; }
    }
#else
    if (blockIdx.x == 0 && F.tid == 0) { VM_WAIT(); p.out[0] += (float)(tp1 - tp0) * (1.0f / (float)(PROBE_DIV)); }
#endif
#endif
#undef IN
#undef SEAM
}

extern "C" void kernel_launch(void* const* d_in, const int* in_sizes, int n_in, void* d_out, int out_size, void* d_ws, size_t ws_size, hipStream_t stream) {
    static int grid = 0;
    if (grid == 0) {
        if (n_in != 22 || in_sizes[0] != TOK * DM || out_size != TOK * DM || ws_size < WS_END) {
            fprintf(stderr, "kernel_launch: unexpected shapes: n_in %d in0 %d out %d ws %zu\n", n_in, n_in > 0 ? in_sizes[0] : -1, out_size, ws_size); grid = -1; return; }
        if (hipFuncSetAttribute((const void*)fwd_kernel, hipFuncAttributeMaxDynamicSharedMemorySize, LDS_BYTES) != hipSuccess) { fprintf(stderr, "kernel_launch: hipFuncSetAttribute failed\n"); grid = -1; return; }
        int dev = 0, cus = 0, per_cu = 0;
        if (hipGetDevice(&dev) != hipSuccess || hipDeviceGetAttribute(&cus, hipDeviceAttributeMultiprocessorCount, dev) != hipSuccess) { grid = -1; return; }
        if (hipOccupancyMaxActiveBlocksPerMultiprocessor(&per_cu, (const void*)fwd_kernel, 512, LDS_BYTES) != hipSuccess || per_cu < 1) { fprintf(stderr, "kernel_launch: occupancy query failed (%d)\n", per_cu); (void)hipGetLastError(); per_cu = 1; }
        grid = cus * (per_cu > 1 ? 1 : per_cu);
    }
    if (grid < 0) return;
#ifndef CG_FIRST_SYNC
    (void)hipMemsetAsync((char*)d_ws + WS_CTL + (size_t)CW_BAR * 4, 0, (size_t)(XCD_BAR_WORDS + PACE_WORDS) * 4, stream);
#endif
    Params a{};
    for (int i = 0; i < 22; ++i) a.in[i] = (const float*)d_in[i];
    a.out = (float*)d_out; a.ws = (unsigned char*)d_ws;
#if N_LAUNCHES == 1
    a.ph_lo = 0; a.ph_hi = NPHASE;
#ifdef USE_COOP_LAUNCH
    { void* args[] = {&a};
      hipError_t e = hipLaunchCooperativeKernel((const void*)fwd_kernel, dim3(grid), dim3(512), args, LDS_BYTES, stream);
      if (e != hipSuccess) fprintf(stderr, "kernel_launch: cooperative launch failed: %s (grid %d)\n", hipGetErrorString(e), grid); }
#else
    hipLaunchKernelGGL(fwd_kernel, dim3(grid), dim3(512), LDS_BYTES, stream, a);
#endif
#else
    for (int ph = 0; ph < NPHASE; ++ph) {
        a.ph_lo = ph; a.ph_hi = ph + 1;
        hipLaunchKernelGGL(fwd_kernel, dim3(grid), dim3(512), LDS_BYTES, stream, a);
    }
#endif
    const hipError_t le = hipPeekAtLastError();
    if (le != hipSuccess) fprintf(stderr, "kernel_launch: launch failed: %s\n", hipGetErrorName(le));
}
```

```cpp
#include <hip/hip_runtime.h>
#include <hip/hip_cooperative_groups.h>
#include <cstdio>
#include <cstdint>
#define USE_COOP_LAUNCH 1
#define U_FP4 1
#define V_FP4 1

#define LAS __attribute__((address_space(3)))
#define GAS __attribute__((address_space(1)))
typedef unsigned short bf16_t;
typedef short bf16x8 __attribute__((ext_vector_type(8)));
typedef short s16x4 __attribute__((ext_vector_type(4)));
typedef float f32x4 __attribute__((ext_vector_type(4)));
typedef float f32x8 __attribute__((ext_vector_type(8)));
typedef float f32x16 __attribute__((ext_vector_type(16)));
typedef unsigned u32x4 __attribute__((ext_vector_type(4)));
typedef unsigned u32x2 __attribute__((ext_vector_type(2)));

constexpr int NB = 8, SEQ = 4096, TOK = NB * SEQ, DM = 1024;
constexpr int NIN = 3072;
constexpr int PZ = 0, PXS = 512, PBM = 1024, PCM = 1280, PQ = 1536, PK = 2048, PV = 2560;
constexpr int CHUNK = 64, NCH = SEQ / CHUNK;
constexpr int NHS = 8;
constexpr float EPSN = 1e-6f;
constexpr int PEER_H = 8, NKEYS = 128, TOPK = 16;
constexpr float LAMBDA_INIT = 0.2f;

constexpr size_t MiB = 1u << 20;
constexpr size_t WS_CTL = 0, CTL_BYTES = 1 * MiB;
constexpr size_t WS_WINT = 1 * MiB;
constexpr size_t WS_WOUTT = 7 * MiB;
constexpr size_t WS_WQT = 9 * MiB;
constexpr size_t WS_KEYS = 13 * MiB;
constexpr size_t WS_ROPE = 13 * MiB + 512 * 1024;
constexpr size_t WS_MISC = 13 * MiB + 768 * 1024;
constexpr size_t WS_RSU = WS_MISC + 64 * 1024;
constexpr size_t WS_RSV = WS_MISC + 128 * 1024;
constexpr size_t WS_DTRAW = 14 * MiB;
constexpr size_t WS_ACS = 15 * MiB;
constexpr size_t WS_CDEC = 16 * MiB;
constexpr size_t WS_UB = 20 * MiB;
constexpr size_t WS_VB = 52 * MiB;
constexpr size_t WS_XB = 84 * MiB;
constexpr size_t WS_YCAT = WS_XB;
constexpr size_t WS_PROJ = 148 * MiB;
constexpr size_t WS_QP = WS_PROJ;
constexpr size_t WS_IDX = 276 * MiB;
constexpr size_t WS_GW = 292 * MiB;
constexpr size_t WS_CMC = 340 * MiB;
constexpr size_t WS_STATES = 356 * MiB;
constexpr size_t WS_X1B = WS_STATES;
constexpr size_t WS_END = 484 * MiB;
constexpr int CW_BAR = 4096;
constexpr int CW_ROWSQ = 131072;
static_assert((CW_ROWSQ + TOK) * 4 <= (int)CTL_BYTES, "ctl");

constexpr int LDS_BYTES = 163840;

__device__ __forceinline__ float bf2f(unsigned h) { return __uint_as_float(h << 16); }
typedef float f32x2_cv __attribute__((ext_vector_type(2)));
typedef __bf16 bf16x2_cv __attribute__((ext_vector_type(2)));
__device__ __forceinline__ unsigned pk2(float lo, float hi) { const f32x2_cv v = {lo, hi}; return __builtin_bit_cast(unsigned, __builtin_convertvector(v, bf16x2_cv)); }
__device__ __forceinline__ unsigned f2bf(float f) { return pk2(f, 0.f) & 0xffffu; }
#define DPP_F(v, ctrl) __builtin_bit_cast(float, __builtin_amdgcn_mov_dpp(__builtin_bit_cast(int, (v)), (ctrl), 0xf, 0xf, true))
__device__ __forceinline__ float wave_sum(float v) {
    v += DPP_F(v, 0xB1); v += DPP_F(v, 0x4E);
    v += DPP_F(v, 0x124); v += DPP_F(v, 0x128);
    { auto r = __builtin_amdgcn_permlane16_swap(__float_as_uint(v), __float_as_uint(v), false, false); v = __uint_as_float(r[0]) + __uint_as_float(r[1]); }
    { auto r = __builtin_amdgcn_permlane32_swap(__float_as_uint(v), __float_as_uint(v), false, false); v = __uint_as_float(r[0]) + __uint_as_float(r[1]); }
    return v;
}
__device__ __forceinline__ float wave_max(float v) {
    v = fmaxf(v, DPP_F(v, 0xB1)); v = fmaxf(v, DPP_F(v, 0x4E));
    v = fmaxf(v, DPP_F(v, 0x124)); v = fmaxf(v, DPP_F(v, 0x128));
    { auto r = __builtin_amdgcn_permlane16_swap(__float_as_uint(v), __float_as_uint(v), false, false); v = fmaxf(__uint_as_float(r[0]), __uint_as_float(r[1])); }
    { auto r = __builtin_amdgcn_permlane32_swap(__float_as_uint(v), __float_as_uint(v), false, false); v = fmaxf(__uint_as_float(r[0]), __uint_as_float(r[1])); }
    return v;
}
__device__ __forceinline__ float silu_f(float x) { return x * __builtin_amdgcn_rcpf(1.f + __expf(-x)); }
__device__ __forceinline__ f32x4 mfma16(bf16x8 a, bf16x8 b, f32x4 c) { return __builtin_amdgcn_mfma_f32_16x16x32_bf16(a, b, c, 0, 0, 0); }
__device__ __forceinline__ f32x16 mfma32(bf16x8 a, bf16x8 b, f32x16 c) { return __builtin_amdgcn_mfma_f32_32x32x16_bf16(a, b, c, 0, 0, 0); }
#define LDS_WAIT() asm volatile("s_waitcnt lgkmcnt(0)" ::: "memory")
#define VM_WAIT() asm volatile("s_waitcnt vmcnt(0)" ::: "memory")

#define XB_TMO      128
#define XB_XCNT(j)  (256  + 64 * (j))
#define XB_XSUB(j)  (1280 + 64 * (j))
#define XB_XGEN(j)  (2304 + 64 * (j))
#define XB_TOP      3328
#define XB_TOPGEN   3392
#define XCD_BAR_WORDS 3456
#define XB_SPIN_CAP (1u << 21)

__device__ __forceinline__ unsigned xb_ld(unsigned* p)              { return __hip_atomic_load(p, __ATOMIC_RELAXED, __HIP_MEMORY_SCOPE_AGENT); }
__device__ __forceinline__ unsigned xb_add(unsigned* p, unsigned v) { return __hip_atomic_fetch_add(p, v, __ATOMIC_RELAXED, __HIP_MEMORY_SCOPE_AGENT); }
__device__ __forceinline__ unsigned xb_xcc_id() { return (unsigned)__builtin_amdgcn_s_getreg((3 << 11) | 20) & 0xFu; }
#define XB_SPIN(cond, bar) do { unsigned _sp = 0; while (cond) { __builtin_amdgcn_s_sleep(1); \
    if ((++_sp & 255u) == 0u) { if (xb_ld(&(bar)[XB_TMO])) break; if (_sp > XB_SPIN_CAP) { atomicAdd(&(bar)[XB_TMO], 1u); break; } } } } while (0)

struct XcdBarrier {
    unsigned* bar; unsigned x;
    volatile LAS unsigned* st;
};

__device__ __forceinline__ XcdBarrier xcd_barrier_post(unsigned* bar, volatile LAS unsigned* st) {
    XcdBarrier b; b.bar = bar; b.x = xb_xcc_id(); b.st = st;
    if (threadIdx.x == 0) (void)xb_add(&bar[XB_XCNT(b.x)], 1u);
    return b;
}
__device__ __forceinline__ void xcd_barrier_complete(unsigned* bar, unsigned x, unsigned& nloc, unsigned& nx) {
    const unsigned G = gridDim.x * gridDim.y * gridDim.z;
    unsigned sum, cnt, mine, sp = 0u;
    for (;;) {
        sum = 0u; cnt = 0u; mine = 0u;
#pragma unroll
        for (unsigned j = 0; j < 16; ++j) { const unsigned c = xb_ld(&bar[XB_XCNT(j)]); sum += c; cnt += (c > 0u) ? 1u : 0u; mine = (j == x) ? c : mine; }
        if (sum == G) break;
        __builtin_amdgcn_s_sleep(1);
        if ((++sp & 255u) == 0u) { if (xb_ld(&bar[XB_TMO])) break; if (sp > XB_SPIN_CAP) { atomicAdd(&bar[XB_TMO], 1u); break; } }
    }
    nloc = mine > 0u ? mine : 1u; nx = cnt > 0u ? cnt : 1u;
}

__device__ __forceinline__ void xcd_barrier(const XcdBarrier& b) {
    asm volatile("s_waitcnt vmcnt(0)" ::: "memory");
    __syncthreads();
    if (threadIdx.x == 0) {
        unsigned* bar = b.bar;
        __builtin_amdgcn_s_waitcnt(0);
        unsigned nloc = b.st[0], nx = b.st[1];
        if (nloc == 0u) { xcd_barrier_complete(bar, b.x, nloc, nx); b.st[0] = nloc; b.st[1] = nx; }
        const unsigned old = xb_add(&bar[XB_XSUB(b.x)], 1u);
        const unsigned gen = old / nloc;
        if (old + 1u == (gen + 1u) * nloc) {
            __builtin_amdgcn_fence(__ATOMIC_RELEASE, "agent");
            asm volatile("s_waitcnt vmcnt(0)" ::: "memory");
            const unsigned og = xb_add(&bar[XB_TOP], 1u);
            const unsigned tg = og / nx;
            if (og + 1u == (tg + 1u) * nx) xb_add(&bar[XB_TOPGEN], 1u);
            else XB_SPIN(xb_ld(&bar[XB_TOPGEN]) == tg, bar);
            __builtin_amdgcn_fence(__ATOMIC_ACQUIRE, "agent");
            xb_add(&bar[XB_XGEN(b.x)], 1u);
            asm volatile("s_waitcnt vmcnt(0)" ::: "memory");
        } else {
            XB_SPIN(xb_ld(&bar[XB_XGEN(b.x)]) == gen, bar);
            __builtin_amdgcn_fence(__ATOMIC_ACQUIRE, "agent");
            asm volatile("s_waitcnt vmcnt(0)" ::: "memory");
        }
    }
    __syncthreads();
}
namespace pg8 {
#define PG8_LAS __attribute__((address_space(3)))
typedef unsigned short bf16_t;
typedef short bf16x8 __attribute__((ext_vector_type(8)));
typedef float f32x4 __attribute__((ext_vector_type(4)));
typedef unsigned u32x4 __attribute__((ext_vector_type(4)));
constexpr int BM = 256, BK = 64, HALF = 128, HTB = HALF * BK * 2  , STAGE_BYTES = 8 * HTB, NXCD = 8, WGM = 8;

__host__ __device__ __forceinline__ int lds_byte(int r, int c) { const int st = (r >> 4) * 2 + (c >> 5), rr = r & 15, cc = c & 31, ob = rr * 64 + cc * 2; return st * 1024 + (ob ^ (((ob >> 9) & 1) << 5)); }
__host__ __device__ __forceinline__ void stage_rc(int b, int& R, int& C) { const int st = b / 1024, sb = b % 1024, swz = sb ^ (((sb >> 9) & 1) << 5); R = (st >> 1) * 16 + swz / 64; C = (st & 1) * 32 + (swz % 64) / 2; }
__host__ __device__ __forceinline__ int perm32(int rho) { const int n = rho >> 4, i = rho & 15; return 8 * (i >> 2) + 4 * n + (i & 3); }

struct Unit { int pm, pn; };
struct Gemm { const bf16_t* A; const bf16_t* Bt; int M, N, K; };

struct StaticOrder {
    int nM, nN, nwg, G, c;
    __host__ __device__ void init(int M, int N, int G_, int c_) { nM = M / BM; nN = N / BM; nwg = nM * nN; G = G_; c = c_; }
    __host__ __device__ bool next(int i, Unit& u) const {
        const long L = (long)i * G + c; if (L >= nwg) return false;
        int wgid = (int)L; { const int q = nwg / NXCD, r = nwg % NXCD, xcd = wgid % NXCD, off = wgid / NXCD; wgid = (xcd < r ? xcd * (q + 1) : r * (q + 1) + (xcd - r) * q) + off; }
        const int nig = WGM * nN, gid = wgid / nig, fm = gid * WGM, gsz = (nM - fm) < WGM ? (nM - fm) : WGM;
        u.pm = fm + ((wgid % nig) % gsz); u.pn = (wgid % nig) / gsz; return true;
    }
    __device__ __forceinline__ void a_ready(const Unit&) const {}
    __device__ __forceinline__ void done(const Unit&) const {}
};

__device__ __forceinline__ unsigned cvt_pk_bf16(float lo, float hi) { unsigned r; asm volatile("v_cvt_pk_bf16_f32 %0, %1, %2" : "=v"(r) : "v"(lo), "v"(hi)); return r; }
typedef float f32x2 __attribute__((ext_vector_type(2)));
__device__ __forceinline__ f32x2 gelu_pk(f32x2 v) {
    const f32x2 av = __builtin_elementwise_abs(v), d = av * 0.2316418882f + 1.0f;
    f32x2 t; t.x = __builtin_amdgcn_rcpf(d.x); t.y = __builtin_amdgcn_rcpf(d.y);
    f32x2 q = t * 0.5307027145f + (-0.7265760135f); q = q * t + 0.7107068705f; q = q * t + (-0.142248368f); q = q * t + 0.127414796f; q = q * t;
    const f32x2 s = (v * v) * (-0.72134752044f);
    f32x2 e; e.x = __builtin_amdgcn_exp2f(s.x); e.y = __builtin_amdgcn_exp2f(s.y);
    const f32x2 m = v * (q * e), r = v - m;
    f32x2 o; o.x = v.x < 0.f ? m.x : r.x; o.y = v.y < 0.f ? m.y : r.y; return o;
}

template <int ACT  > struct EpiBf16 {
    static constexpr bool PERM = true, AFTER_DRAIN = false; static_assert(ACT == 0 || ACT == 1, "EpiBf16: ACT is 0 (none) or 1 (gelu_pk)");
    bf16_t* O; int ldc; const float* bias; int split_cols; size_t split_stride; float scale0;
    __device__ __forceinline__ void operator()(const f32x4 (&acc)[2][2][4][2], const Unit& u, int wr, int wc, int fr, int fq) const {
        const int row0 = u.pm * BM + wr * 64 + fr; int colt = u.pn * BM; bf16_t* base = O;
        float sc = 1.f; if (split_cols) { const int t = colt / split_cols; base += (size_t)t * split_stride; colt -= t * split_cols; if (t == 0) sc = scale0; }
        const int col0 = colt + wc * 32 + 8 * fq, bcol0 = u.pn * BM + wc * 32 + 8 * fq;
        f32x4 bv[2][2];
#pragma unroll
        for (int bj = 0; bj < 2; ++bj)
#pragma unroll
            for (int n = 0; n < 2; ++n) bv[bj][n] = bias ? *(const f32x4*)(bias + bcol0 + bj * HALF + 4 * n) : (f32x4){0.f, 0.f, 0.f, 0.f};
#pragma unroll
        for (int ai = 0; ai < 2; ++ai)
#pragma unroll
            for (int m = 0; m < 4; ++m) { bf16_t* rowp = base + (size_t)(row0 + ai * HALF + m * 16) * ldc + col0;
#pragma unroll
                for (int bj = 0; bj < 2; ++bj) { f32x4 v0 = acc[ai][bj][m][0] + bv[bj][0], v1 = acc[ai][bj][m][1] + bv[bj][1];
                    if (ACT == 1) { f32x2 a = gelu_pk((f32x2){v0[0], v0[1]}), b = gelu_pk((f32x2){v0[2], v0[3]}), c = gelu_pk((f32x2){v1[0], v1[1]}), d = gelu_pk((f32x2){v1[2], v1[3]});
                        v0 = (f32x4){a.x, a.y, b.x, b.y}; v1 = (f32x4){c.x, c.y, d.x, d.y}; }
                    v0 = v0 * sc; v1 = v1 * sc; u32x4 w; w.x = cvt_pk_bf16(v0[0], v0[1]); w.y = cvt_pk_bf16(v0[2], v0[3]); w.z = cvt_pk_bf16(v1[0], v1[1]); w.w = cvt_pk_bf16(v1[2], v1[3]);
                    *(u32x4*)(rowp + bj * HALF) = w; } }
    }
};

struct EpiResid {
    static constexpr bool PERM = false, AFTER_DRAIN = false;
    const float* x; float* out; bf16_t* xb; float* rowsq; int ldc;
    __device__ __forceinline__ void operator()(const f32x4 (&acc)[2][2][4][2], const Unit& u, int wr, int wc, int fr, int fq) const {
        const int col0 = u.pn * BM + wc * 32 + 4 * fq;
        const size_t base = (size_t)(u.pm * BM + wr * 64 + fr) * ldc + col0;
        f32x4 xv[2][4];
#define EPR_LOAD(SET, G) do { const size_t off_ = base + (size_t)(((G) >> 2) * HALF + ((G) & 3) * 16) * ldc; \
        _Pragma("unroll") for (int bj = 0; bj < 2; ++bj) _Pragma("unroll") for (int n = 0; n < 2; ++n) xv[SET][bj * 2 + n] = __builtin_nontemporal_load((const f32x4*)(x + off_ + bj * HALF + n * 16)); } while (0)
        EPR_LOAD(0, 0);
#pragma unroll
        for (int g = 0; g < 8; ++g) {
            const int ai = g >> 2, m = g & 3;
            if (g + 1 < 8) { if ((g & 1) == 0) EPR_LOAD(1, g + 1); else EPR_LOAD(0, g + 1); }
            const int row = u.pm * BM + ai * HALF + wr * 64 + m * 16 + fr;
            const size_t off = base + (size_t)(ai * HALF + m * 16) * ldc;
            float ss = 0.f;
#pragma unroll
            for (int bj = 0; bj < 2; ++bj)
#pragma unroll
                for (int n = 0; n < 2; ++n) {
                    const size_t c = off + bj * HALF + n * 16;
                    const f32x4 o = xv[g & 1][bj * 2 + n] + acc[ai][bj][m][n];
                    ss += (o[0] * o[0] + o[1] * o[1]) + (o[2] * o[2] + o[3] * o[3]);
                    typedef unsigned u32x2v __attribute__((ext_vector_type(2)));
                    u32x2v w; w.x = cvt_pk_bf16(o[0], o[1]); w.y = cvt_pk_bf16(o[2], o[3]);
                    *(u32x2v*)(xb + c) = w;
                }
            ss += __shfl_xor(ss, 16); ss += __shfl_xor(ss, 32);
            if (fq == 0) atomicAdd(rowsq + row, ss);
        }
#undef EPR_LOAD
    }
};

struct EpiProj {
    static constexpr bool PERM = true, AFTER_DRAIN = false;
    bf16_t* O; int ldc; const float* qnw; const float* knw; const float* cosT; const float* sinT; PG8_LAS float* xch; int q_lo, k_lo, k_hi, seq_mask; float eps;
    __device__ __forceinline__ void operator()(const f32x4 (&acc)[2][2][4][2], const Unit& u, int wr, int wc, int fr, int fq) const {
        const int colt = u.pn * BM, row0 = u.pm * BM + wr * 64 + fr, col0 = colt + wc * 32 + 8 * fq;
        if (colt < q_lo || colt >= k_hi) {
#pragma unroll
            for (int ai = 0; ai < 2; ++ai)
#pragma unroll
                for (int m = 0; m < 4; ++m) { bf16_t* rowp = O + (size_t)(row0 + ai * HALF + m * 16) * ldc + col0;
#pragma unroll
                    for (int bj = 0; bj < 2; ++bj) { const f32x4 v0 = acc[ai][bj][m][0], v1 = acc[ai][bj][m][1];
                        u32x4 w; w.x = cvt_pk_bf16(v0[0], v0[1]); w.y = cvt_pk_bf16(v0[2], v0[3]); w.z = cvt_pk_bf16(v1[0], v1[1]); w.w = cvt_pk_bf16(v1[2], v1[3]);
                        *(u32x4*)(rowp + bj * HALF) = w; } }
            return;
        }
        const float* nw = colt < k_lo ? qnw : knw;
#pragma unroll
        for (int ai = 0; ai < 2; ++ai)
#pragma unroll
            for (int m = 0; m < 4; ++m)
#pragma unroll
                for (int bj = 0; bj < 2; ++bj) {
                    const f32x4 a = acc[ai][bj][m][0], b = acc[ai][bj][m][1];
                    float ss = ((a[0] * a[0] + a[1] * a[1]) + (a[2] * a[2] + a[3] * a[3])) + ((b[0] * b[0] + b[1] * b[1]) + (b[2] * b[2] + b[3] * b[3]));
                    ss += __shfl_xor(ss, 16); ss += __shfl_xor(ss, 32);
                    if (fq == 0) xch[((ai * HALF + wr * 64 + m * 16 + fr) * 4 + bj * 2 + (wc >> 1)) * 2 + (wc & 1)] = ss;
                }
        asm volatile("s_waitcnt lgkmcnt(0)" ::: "memory"); __builtin_amdgcn_s_barrier(); asm volatile("" ::: "memory");
        float wv[8];
#pragma unroll
        for (int n = 0; n < 2; ++n)
#pragma unroll
            for (int j = 0; j < 4; ++j) wv[4 * n + j] = nw[32 * (wc & 1) + 8 * fq + 4 * n + j];
        const bool rot = ((wc & 1) == 0) && (fq < 2);
#pragma unroll
        for (int ai = 0; ai < 2; ++ai)
#pragma unroll
            for (int m = 0; m < 4; ++m) {
                const int rl = ai * HALF + wr * 64 + m * 16 + fr, row = u.pm * BM + rl, pos = row & seq_mask;
                f32x4 cs0 = {1.f, 1.f, 1.f, 1.f}, cs1 = cs0, sn0 = {0.f, 0.f, 0.f, 0.f}, sn1 = sn0;
                if (rot) { cs0 = *(const f32x4*)(cosT + pos * 8); cs1 = *(const f32x4*)(cosT + pos * 8 + 4); sn0 = *(const f32x4*)(sinT + pos * 8); sn1 = *(const f32x4*)(sinT + pos * 8 + 4); }
                bf16_t* rowp = O + (size_t)row * ldc + col0;
#pragma unroll
                for (int bj = 0; bj < 2; ++bj) {
                    const int xi = (rl * 4 + bj * 2 + (wc >> 1)) * 2;
                    const float rs = rsqrtf((xch[xi] + xch[xi + 1]) * (1.f / 64.f) + eps);
                    f32x4 y0 = acc[ai][bj][m][0] * rs, y1 = acc[ai][bj][m][1] * rs;
#pragma unroll
                    for (int j = 0; j < 4; ++j) { y0[j] *= wv[j]; y1[j] *= wv[4 + j]; }
                    f32x4 p0, p1;
#pragma unroll
                    for (int j = 0; j < 4; ++j) { p0[j] = __shfl_xor(y0[j], 16); p1[j] = __shfl_xor(y1[j], 16); }
                    if (rot) {
                        if (fq == 0) { y0 = y0 * cs0 - p0 * sn0; y1 = y1 * cs1 - p1 * sn1; }
                        else { y0 = p0 * sn0 + y0 * cs0; y1 = p1 * sn1 + y1 * cs1; }
                    }
                    u32x4 w; w.x = cvt_pk_bf16(y0[0], y0[1]); w.y = cvt_pk_bf16(y0[2], y0[3]); w.z = cvt_pk_bf16(y1[0], y1[1]); w.w = cvt_pk_bf16(y1[2], y1[3]);
                    *(u32x4*)(rowp + bj * HALF) = w;
                }
            }
    }
};

template <class Epi, class Sched, bool ALIGN_EPI = false, bool SP2 = false>
__device__ __forceinline__ void gemm_phase(PG8_LAS unsigned char* lds, const Gemm g, const Sched& S, const Epi& E) {
    const int tid = threadIdx.x, wid = __builtin_amdgcn_readfirstlane(tid >> 6), lane = tid & 63, wr = wid >> 2, wc = wid & 3, fr = lane & 15, fq = lane >> 4;
    const int K = g.K, nt = K / BK;
    unsigned voffA[2], voffB[2];
#pragma unroll
    for (int i = 0; i < 2; ++i) { int R, C; stage_rc(tid * 16 + i * 8192, R, C); const int Rb = Epi::PERM ? ((R & ~31) + perm32(R & 31)) : R;
        voffA[i] = (unsigned)(R * K + C) * 2u; voffB[i] = (unsigned)(Rb * K + C) * 2u; }
    const size_t kstep = (size_t)(BK * 2);
    const size_t hstep = (size_t)HALF * K * 2;
    const size_t tstep = 2 * hstep;
    const unsigned ldsw = (unsigned)wid * 1024u;
    const int aoff = lds_byte(wr * 64 + fr, fq * 8), boff = lds_byte(wc * 32 + fr, fq * 8);
#define PG8_SA(b, h) (((b) * 2 + (h)) * HTB)
#define PG8_SB(b, h) ((4 + (b) * 2 + (h)) * HTB)
#define PG8_STAGE(bufoff, gbase, voff) do { _Pragma("unroll") for (int _i = 0; _i < 2; ++_i) \
        __builtin_amdgcn_global_load_lds((const unsigned*)((const char*)(gbase) + (voff)[_i]), (PG8_LAS unsigned*)(lds + (bufoff) + ldsw + _i * 8192), 16, 0, 0); } while (0)
#define PG8_LDA(dst, b, h) do { _Pragma("unroll") for (int m = 0; m < 4; ++m) _Pragma("unroll") for (int k = 0; k < 2; ++k) dst[m][k] = *(const PG8_LAS bf16x8*)(lds + PG8_SA(b, h) + aoff + m * 2048 + k * 1024); } while (0)
#define PG8_LDB(dst, b, h) do { _Pragma("unroll") for (int n = 0; n < 2; ++n) _Pragma("unroll") for (int k = 0; k < 2; ++k) dst[n][k] = *(const PG8_LAS bf16x8*)(lds + PG8_SB(b, h) + boff + n * 2048 + k * 1024); } while (0)
#define PG8_MMA(ai, bj, At, Bt) do { __builtin_amdgcn_s_setprio(1); _Pragma("unroll") for (int m = 0; m < 4; ++m) _Pragma("unroll") for (int n = 0; n < 2; ++n) _Pragma("unroll") for (int k = 0; k < 2; ++k) \
        acc[ai][bj][m][n] = __builtin_amdgcn_mfma_f32_16x16x32_bf16(Bt[n][k], At[m][k], acc[ai][bj][m][n], 0, 0, 0); __builtin_amdgcn_s_setprio(0); } while (0)
#define PG8_WAIT_V(n) asm volatile("s_waitcnt vmcnt(" #n ")" ::: "memory")
#define PG8_WAIT_L(n) asm volatile("s_waitcnt lgkmcnt(" #n ")" ::: "memory")
#define PG8_BAR __builtin_amdgcn_s_barrier()
#define PG8_SCHED __builtin_amdgcn_sched_barrier(0)
    Unit cur, nxt; int ui = 0;
    if (!S.next(0, cur)) return;
    f32x4 acc[2][2][4][2];
#pragma unroll
    for (int a = 0; a < 2; ++a)
#pragma unroll
        for (int b = 0; b < 2; ++b)
#pragma unroll
            for (int m = 0; m < 4; ++m)
#pragma unroll
                for (int n = 0; n < 2; ++n) acc[a][b][m][n] = (f32x4){0.f, 0.f, 0.f, 0.f};
    bf16x8 At[4][2], B0[2][2], B1[2][2];
    const char* cA = (const char*)g.A + (size_t)cur.pm * tstep; const char* cB = (const char*)g.Bt + (size_t)cur.pn * tstep;
    S.a_ready(cur);
    if constexpr (SP2) {
        PG8_STAGE(PG8_SB(0, 0), cB, voffB); PG8_STAGE(PG8_SB(0, 1), cB + hstep, voffB); PG8_STAGE(PG8_SA(0, 0), cA, voffA); PG8_STAGE(PG8_SA(0, 1), cA + hstep, voffA);
        if (wr == 1) PG8_BAR;
        PG8_WAIT_V(2); PG8_BAR;
        PG8_STAGE(PG8_SB(1, 0), cB + kstep, voffB); PG8_STAGE(PG8_SA(1, 0), cA + kstep, voffA); PG8_STAGE(PG8_SB(1, 1), cB + hstep + kstep, voffB);
        PG8_WAIT_V(6); PG8_BAR;
    } else {
        PG8_STAGE(PG8_SB(0, 0), cB, voffB); PG8_STAGE(PG8_SA(0, 0), cA, voffA); PG8_STAGE(PG8_SB(0, 1), cB + hstep, voffB); PG8_STAGE(PG8_SA(0, 1), cA + hstep, voffA);
        if (wr == 1) PG8_BAR;
        PG8_WAIT_V(4); PG8_BAR;
        PG8_STAGE(PG8_SB(1, 0), cB + kstep, voffB); PG8_STAGE(PG8_SA(1, 0), cA + kstep, voffA); PG8_STAGE(PG8_SB(1, 1), cB + hstep + kstep, voffB);
        PG8_WAIT_V(6); PG8_BAR;
    }
    for (;;) {
        const bool has_next = S.next(ui + 1, nxt);
        const char* nA = has_next ? (const char*)g.A + (size_t)nxt.pm * tstep : cA; const char* nB = has_next ? (const char*)g.Bt + (size_t)nxt.pn * tstep : cB;
        for (int t = 0; t < nt; t += 2) {
            const bool last = (t == nt - 2);
            const char* a1 = cA + (size_t)(t + 1) * kstep;
            const char* a2 = last ? nA : cA + (size_t)(t + 2) * kstep; const char* b2 = last ? nB : cB + (size_t)(t + 2) * kstep;
            const char* a3 = a2 + kstep; const char* b3 = b2 + kstep;
            if (last && has_next) S.a_ready(nxt);
            if constexpr (SP2) {
            PG8_LDB(B0, 0, 0); PG8_LDB(B1, 0, 1); PG8_SCHED; PG8_LDA(At, 0, 0); PG8_STAGE(PG8_SA(1, 1), a1 + hstep, voffA);
            PG8_WAIT_V(8); PG8_WAIT_L(0); PG8_BAR; PG8_MMA(0, 0, At, B0); PG8_MMA(0, 1, At, B1); PG8_BAR; PG8_SCHED;
            PG8_LDA(At, 0, 1); PG8_STAGE(PG8_SB(0, 0), b2, voffB); PG8_STAGE(PG8_SB(0, 1), b2 + hstep, voffB); PG8_STAGE(PG8_SA(0, 0), a2, voffA);
            PG8_WAIT_V(8); PG8_WAIT_L(0); PG8_BAR; PG8_MMA(1, 0, At, B0); PG8_MMA(1, 1, At, B1); PG8_BAR; PG8_SCHED;
            PG8_LDB(B0, 1, 0); PG8_LDB(B1, 1, 1); PG8_SCHED; PG8_LDA(At, 1, 0); PG8_STAGE(PG8_SA(0, 1), a2 + hstep, voffA);
            PG8_WAIT_V(8); PG8_WAIT_L(0); PG8_BAR; PG8_MMA(0, 0, At, B0); PG8_MMA(0, 1, At, B1); PG8_BAR; PG8_SCHED;
            PG8_LDA(At, 1, 1); PG8_STAGE(PG8_SB(1, 0), b3, voffB); PG8_STAGE(PG8_SB(1, 1), b3 + hstep, voffB); PG8_STAGE(PG8_SA(1, 0), a3, voffA);
            PG8_WAIT_V(8); PG8_WAIT_L(0); PG8_BAR; PG8_MMA(1, 0, At, B0); PG8_MMA(1, 1, At, B1); PG8_BAR; PG8_SCHED;
            } else {
            PG8_LDB(B0, 0, 0); PG8_SCHED; PG8_LDA(At, 0, 0); PG8_STAGE(PG8_SA(1, 1), a1 + hstep, voffA);
            PG8_WAIT_L(8); PG8_BAR; PG8_WAIT_L(0); PG8_MMA(0, 0, At, B0); PG8_BAR; PG8_SCHED;
            PG8_LDB(B1, 0, 1); PG8_STAGE(PG8_SB(0, 0), b2, voffB);
            PG8_BAR; PG8_WAIT_L(0); PG8_MMA(0, 1, At, B1); PG8_BAR;
            PG8_LDA(At, 0, 1); PG8_STAGE(PG8_SA(0, 0), a2, voffA);
            PG8_BAR; PG8_WAIT_L(0); PG8_MMA(1, 0, At, B0); PG8_BAR; PG8_SCHED;
            PG8_STAGE(PG8_SB(0, 1), b2 + hstep, voffB);
            PG8_WAIT_V(6); PG8_BAR; PG8_MMA(1, 1, At, B1); PG8_BAR;
            PG8_LDB(B0, 1, 0); PG8_SCHED; PG8_LDA(At, 1, 0); PG8_STAGE(PG8_SA(0, 1), a2 + hstep, voffA);
            PG8_WAIT_L(8); PG8_BAR; PG8_WAIT_L(0); PG8_MMA(0, 0, At, B0); PG8_BAR; PG8_SCHED;
            PG8_LDB(B1, 1, 1); PG8_STAGE(PG8_SB(1, 0), b3, voffB);
            PG8_BAR; PG8_WAIT_L(0); PG8_MMA(0, 1, At, B1); PG8_BAR;
            PG8_LDA(At, 1, 1); PG8_STAGE(PG8_SA(1, 0), a3, voffA);
            PG8_BAR; PG8_WAIT_L(0); PG8_MMA(1, 0, At, B0); PG8_BAR; PG8_SCHED;
            PG8_STAGE(PG8_SB(1, 1), b3 + hstep, voffB);
            PG8_WAIT_V(6); PG8_BAR; PG8_MMA(1, 1, At, B1); PG8_BAR;
            }
        }
        if constexpr (ALIGN_EPI) { if (wr == 0) PG8_BAR; }
        if constexpr (!Epi::AFTER_DRAIN) { E(acc, cur, wr, wc, fr, fq); S.done(cur); }
        if (!has_next) break;
#pragma unroll
        for (int a = 0; a < 2; ++a)
#pragma unroll
            for (int b = 0; b < 2; ++b)
#pragma unroll
                for (int m = 0; m < 4; ++m)
#pragma unroll
                    for (int n = 0; n < 2; ++n) acc[a][b][m][n] = (f32x4){0.f, 0.f, 0.f, 0.f};
        cur = nxt; cA = nA; cB = nB; ++ui;
        if constexpr (ALIGN_EPI) { if (wr == 1) PG8_BAR; }
    }
    PG8_WAIT_V(0);
    if constexpr (!ALIGN_EPI) { if (wr == 0) PG8_BAR; }
    PG8_BAR;
    if constexpr (Epi::AFTER_DRAIN) { E.fused(acc, cur, wr, wc, fr, fq, lds, wid, lane); S.done(cur); }
#undef PG8_SA
#undef PG8_SB
#undef PG8_STAGE
#undef PG8_LDA
#undef PG8_LDB
#undef PG8_MMA
#undef PG8_WAIT_V
#undef PG8_WAIT_L
#undef PG8_BAR
#undef PG8_SCHED
}
}

struct Params {
    const float* in[22];
    float* out;
    unsigned char* ws;
    int ph_lo, ph_hi;
};
struct Ctx { LAS unsigned char* lds; int tid, lane, wave, vcu, G, gw, ngw; unsigned long long ta, tb, tc; };

__device__ __forceinline__ void p0_transpose_item(const float* W, int K, int Nreal, int thresh, const float* ksc, bf16_t* WT, LAS float* scr, int item, int nblk, int lane) {
    const int kb = item / nblk, nb = item % nblk, k0 = 64 * kb, n0 = 32 * nb;
    const int nr0 = n0 + (n0 >= thresh ? 8 : 0);
#pragma unroll 8
    for (int i = 0; i < 32; ++i) {
        const int kk = 2 * i + (lane >> 5);
        const float sc = ksc ? ksc[k0 + kk] : 1.f;
        scr[kk * 33 + (lane & 31)] = W[(size_t)(k0 + kk) * Nreal + nr0 + (lane & 31)] * sc;
    }
    LDS_WAIT(); asm volatile("" ::: "memory");
    const int c = lane & 7;
#pragma unroll
    for (int j = 0; j < 4; ++j) {
        const int n = (lane >> 3) + 8 * j; const LAS float* s = scr + (8 * c) * 33 + n;
        u32x4 o; o.x = pk2(s[0 * 33], s[1 * 33]); o.y = pk2(s[2 * 33], s[3 * 33]); o.z = pk2(s[4 * 33], s[5 * 33]); o.w = pk2(s[6 * 33], s[7 * 33]);
        *(u32x4*)(WT + (size_t)(n0 + n) * K + k0 + 8 * c) = o;
    }
    LDS_WAIT(); asm volatile("" ::: "memory");
}

__device__ __forceinline__ void phase0(const Params& p, Ctx& F) {
    const float* x = p.in[0]; const float* mixw = p.in[1]; const float* w_in = p.in[2];
    const float* w_out = p.in[16]; const float* ffnw = p.in[17]; const float* w_q = p.in[18]; const float* keys = p.in[19];
    const float* pu = p.in[20]; const float* pv = p.in[21];
    unsigned char* ws = p.ws;
    LAS float* scr = (LAS float*)(F.lds + F.wave * 8448);
    LAS float* wdt = (LAS float*)(F.lds + 69632);
    {
        constexpr int WLD = 132;
        LAS float* WQS = (LAS float*)F.lds;
        LAS float* KYS = (LAS float*)(F.lds + 64 * WLD * 4);
        bf16_t* wefft = (bf16_t*)(ws + WS_WQT);
        for (int u = F.vcu; u < 256; u += F.G) {
            const int hj = u >> 4, kt = u & 15;
            __syncthreads();
#pragma unroll
            for (int i = 0; i < 4; ++i) {
                const int pc = F.tid + 512 * i, k = pc >> 5, d4 = pc & 31;
                const f32x4 v = *(const f32x4*)(w_q + (size_t)(64 * kt + k) * 2048 + hj * 128 + d4 * 4);
                *(LAS f32x4*)(WQS + k * WLD + d4 * 4) = v * ffnw[64 * kt + k];
            }
#pragma unroll
            for (int i = 0; i < 8; ++i) {
                const int pc = F.tid + 512 * i, n = pc >> 5, d4 = pc & 31;
                *(LAS f32x4*)(KYS + n * WLD + d4 * 4) = *(const f32x4*)(keys + ((size_t)hj * 128 + n) * 128 + d4 * 4);
            }
            __syncthreads();
            const int fr_ = F.lane & 15, fq_ = F.lane >> 4, mt = F.wave >> 1, nt0 = (F.wave & 1) * 4;
            f32x4 acc[4];
#pragma unroll
            for (int q = 0; q < 4; ++q) acc[q] = (f32x4){0.f, 0.f, 0.f, 0.f};
#pragma unroll 4
            for (int ks = 0; ks < 32; ++ks) {
                const float av = WQS[(mt * 16 + fr_) * WLD + 4 * ks + fq_];
#pragma unroll
                for (int q = 0; q < 4; ++q) {
                    const float bv = KYS[((nt0 + q) * 16 + fr_) * WLD + 4 * ks + fq_];
                    acc[q] = __builtin_amdgcn_mfma_f32_16x16x4f32(av, bv, acc[q], 0, 0, 0);
                }
            }
#pragma unroll
            for (int q = 0; q < 4; ++q) {
                u32x2 w; w.x = pk2(acc[q][0], acc[q][1]); w.y = pk2(acc[q][2], acc[q][3]);
                *(u32x2*)(wefft + ((size_t)hj * 128 + (nt0 + q) * 16 + fr_) * DM + 64 * kt + mt * 16 + 4 * fq_) = w;
            }
        }
        __syncthreads();
    }
    for (int k = F.tid; k < DM; k += 512) {
        const float s = mixw[k];
        const f32x4 a = *(const f32x4*)(w_in + (size_t)k * 3080 + 1536), b = *(const f32x4*)(w_in + (size_t)k * 3080 + 1540);
        *(LAS f32x4*)(wdt + k * 8) = a * s; *(LAS f32x4*)(wdt + k * 8 + 4) = b * s;
    }
    __syncthreads();
    constexpr int I_IN = 16 * 96, I_OUT = 16 * 32;
    for (int it = F.gw; it < I_IN + I_OUT; it += F.ngw) {
        int r = it;
        if (r < I_IN) { p0_transpose_item(w_in, DM, 3080, 1536, mixw, (bf16_t*)(ws + WS_WINT), scr, r, 96, F.lane); continue; } r -= I_IN;
        p0_transpose_item(w_out, DM, DM, 1 << 30, nullptr, (bf16_t*)(ws + WS_WOUTT), scr, r, 32, F.lane);
    }
    const int gtid = F.vcu * 512 + F.tid, nthr = F.G * 512;
    for (int i = gtid; i < TOK; i += nthr) ((float*)(ws + WS_CTL) + CW_ROWSQ)[i] = 0.f;
    for (int i = gtid; i < SEQ * 8; i += nthr) {
        const int pos = i >> 3, f = i & 7;
        const float inv = powf(500000.0f, -(float)(2 * f) / 16.0f);
        const float ang = (float)pos * inv;
        ((float*)(ws + WS_ROPE))[i] = cosf(ang);
        ((float*)(ws + WS_ROPE))[SEQ * 8 + i] = sinf(ang);
    }
#if defined(PROBE_PHASE) && (PROBE_PHASE == 83 || PROBE_PHASE == 84)
    if (F.gw == 0 && F.lane == 0) { unsigned* mw = (unsigned*)(ws + WS_MISC); mw[2] = 0u; mw[3] = 0xffffffffu; mw[4] = 0u; }
#endif
    if (F.gw == 0) {
        const float a = p.in[11][F.lane] * p.in[12][F.lane], b = p.in[13][F.lane] * p.in[14][F.lane];
        const float sa = wave_sum(a), sb = wave_sum(b);
        if (F.lane == 0) ((float*)(ws + WS_MISC))[0] = expf(sa) - expf(sb) + LAMBDA_INIT;
    }
    {
        float* rsu = (float*)(ws + WS_RSU); float* rsv = (float*)(ws + WS_RSV);
        for (int r0 = F.gw; r0 < 2 * 16384; r0 += 4 * F.ngw) {
            f32x4 a[4][4]; float amax[4];
#pragma unroll
            for (int u = 0; u < 4; ++u) {
                const int r = min(r0 + u * F.ngw, 2 * 16384 - 1); const bool isU = r < 16384; const int e = r & 16383;
                const float* src = (isU ? pu : pv) + (size_t)e * DM + 16 * F.lane;
#pragma unroll
                for (int q = 0; q < 4; ++q) a[u][q] = __builtin_nontemporal_load((const f32x4*)(src + 4 * q));
            }
#pragma unroll
            for (int u = 0; u < 4; ++u) {
                const int r = min(r0 + u * F.ngw, 2 * 16384 - 1); const bool isU = r < 16384;
                amax[u] = 0.f;
#pragma unroll
                for (int q = 0; q < 4; ++q) {
                    if (isU) a[u][q] = a[u][q] * *(const f32x4*)(ffnw + 16 * F.lane + 4 * q);
                    amax[u] = fmaxf(amax[u], fmaxf(fmaxf(fabsf(a[u][q][0]), fabsf(a[u][q][1])), fmaxf(fabsf(a[u][q][2]), fabsf(a[u][q][3]))));
                }
            }
#pragma unroll
            for (int u = 0; u < 4; ++u) amax[u] = wave_max(amax[u]);
#pragma unroll
            for (int u = 0; u < 4; ++u) {
                const int r = min(r0 + u * F.ngw, 2 * 16384 - 1); const bool isU = r < 16384; const int e = r & 16383;
#ifdef U_FP4
#ifdef V_FP4
#define V_FP4_ON 1
#else
#define V_FP4_ON 0
#endif
#ifndef FP4_NIB_SWAP
#define FP4_NIB_SWAP 0
#endif
                if (isU || V_FP4_ON) {
                    const float s4 = amax[u] > 0.f ? 6.f / amax[u] : 1.f;
                    if (F.lane == 0) (isU ? rsu : rsv)[e] = amax[u] > 0.f ? amax[u] * (1.f / 6.f) : 1.f;
                    u32x2 o4;
#pragma unroll
                    for (int hq = 0; hq < 2; ++hq) {
                        unsigned w = 0u;
#pragma unroll
                        for (int q2 = 0; q2 < 2; ++q2)
#pragma unroll
                            for (int el = 0; el < 4; ++el) {
                                const float qv = a[u][hq * 2 + q2][el] * s4, m = fabsf(qv);
                                const unsigned c = (unsigned)(m > 0.25f) + (unsigned)(m > 0.75f) + (unsigned)(m > 1.25f) + (unsigned)(m > 1.75f) + (unsigned)(m > 2.5f) + (unsigned)(m > 3.5f) + (unsigned)(m > 5.0f)
                                                 + (qv < 0.f ? 8u : 0u);
                                w |= c << (4 * ((q2 * 4 + el) ^ FP4_NIB_SWAP));
                            }
                        o4[hq] = w;
                    }
                    *(u32x2*)(ws + (isU ? WS_UB : WS_VB) + (size_t)e * (DM / 2) + 8 * F.lane) = o4;
                    continue;
                }
#endif
                const float sc = amax[u] > 0.f ? 240.f / amax[u] : 1.f;
                if (F.lane == 0) (isU ? rsu : rsv)[e] = amax[u] > 0.f ? amax[u] * (1.f / 240.f) : 1.f;
                u32x4 o;
#pragma unroll
                for (int q = 0; q < 4; ++q) {
                    int pk = 0;
                    pk = __builtin_amdgcn_cvt_pk_fp8_f32(a[u][q][0] * sc, a[u][q][1] * sc, pk, false);
                    pk = __builtin_amdgcn_cvt_pk_fp8_f32(a[u][q][2] * sc, a[u][q][3] * sc, pk, true);
                    o[q] = (unsigned)pk;
                }
                *(u32x4*)(ws + (isU ? WS_UB : WS_VB) + (size_t)e * DM + 16 * F.lane) = o;
            }
        }
    }
    bf16_t* xb = (bf16_t*)(ws + WS_XB); float* dtraw = (float*)(ws + WS_DTRAW);
    for (int m0 = F.gw; m0 < TOK; m0 += 2 * F.ngw) {
        f32x4 v[2][4]; float ss[2];
#pragma unroll
        for (int u = 0; u < 2; ++u) {
            const int m = m0 + u * F.ngw; ss[u] = 0.f;
            const f32x4* xr = (const f32x4*)(x + (size_t)(m < TOK ? m : m0) * DM) + F.lane;
#pragma unroll
            for (int j = 0; j < 4; ++j) v[u][j] = __builtin_nontemporal_load(xr + 64 * j);
        }
#pragma unroll
        for (int u = 0; u < 2; ++u)
#pragma unroll
            for (int j = 0; j < 4; ++j) ss[u] += (v[u][j][0] * v[u][j][0] + v[u][j][1] * v[u][j][1]) + (v[u][j][2] * v[u][j][2] + v[u][j][3] * v[u][j][3]);
        f32x4 d0[2], d1[2];
#pragma unroll
        for (int u = 0; u < 2; ++u) { d0[u] = (f32x4){0.f, 0.f, 0.f, 0.f}; d1[u] = (f32x4){0.f, 0.f, 0.f, 0.f}; }
#pragma unroll
        for (int j = 0; j < 4; ++j)
#pragma unroll
            for (int e = 0; e < 4; ++e) {
                const int k = 256 * j + 4 * F.lane + e;
                const f32x4 w0 = *(const LAS f32x4*)(wdt + k * 8), w1 = *(const LAS f32x4*)(wdt + k * 8 + 4);
#pragma unroll
                for (int u = 0; u < 2; ++u) { d0[u] += w0 * v[u][j][e]; d1[u] += w1 * v[u][j][e]; }
            }
#pragma unroll
        for (int u = 0; u < 2; ++u) {
            ss[u] = wave_sum(ss[u]);
#pragma unroll
            for (int e = 0; e < 4; ++e) { d0[u][e] = wave_sum(d0[u][e]); d1[u][e] = wave_sum(d1[u][e]); }
        }
#pragma unroll
        for (int u = 0; u < 2; ++u) {
            const int m = m0 + u * F.ngw;
            if (m < TOK) {
                const float r = rsqrtf(ss[u] * (1.f / DM) + EPSN);
                if (F.lane == 0) { *(f32x4*)(dtraw + (size_t)m * 8) = d0[u] * r; *(f32x4*)(dtraw + (size_t)m * 8 + 4) = d1[u] * r; }
                unsigned long long* o8 = (unsigned long long*)(xb + (size_t)m * DM) + F.lane;
#pragma unroll
                for (int j = 0; j < 4; ++j) o8[64 * j] = (unsigned long long)pk2(v[u][j][0] * r, v[u][j][1] * r) | ((unsigned long long)pk2(v[u][j][2] * r, v[u][j][3] * r) << 32);
            }
        }
    }
}

__device__ __forceinline__ void p2_qk_prepass(const Params& p, Ctx& F) {
    bf16_t* proj = (bf16_t*)(p.ws + WS_PROJ);
    const float* qnw = p.in[9]; const float* knw = p.in[10];
    const float* cosT = (const float*)(p.ws + WS_ROPE); const float* sinT = cosT + SEQ * 8;
    const int sub = F.lane & 7;
    float wq[8], wk[8];
#pragma unroll
    for (int e = 0; e < 8; ++e) { wq[e] = qnw[sub * 8 + e]; wk[e] = knw[sub * 8 + e]; }
    for (int base = F.gw; base < TOK * 2; base += 8 * F.ngw) {
        u32x4 raw[8];
#pragma unroll
        for (int u = 0; u < 8; ++u) {
            const int wsi = base + u * F.ngw;
            raw[u] = (wsi < TOK * 2) ? *(const u32x4*)(proj + (size_t)(wsi >> 1) * NIN + ((wsi & 1) ? PK : PQ) + F.lane * 8) : (u32x4){0u, 0u, 0u, 0u};
        }
#pragma unroll
        for (int u = 0; u < 8; ++u) {
            const int wsi = base + u * F.ngw;
            const int t = wsi >> 1, which = wsi & 1;
            float v[8];
#pragma unroll
            for (int e = 0; e < 4; ++e) { v[2 * e] = bf2f(raw[u][e] & 0xffffu); v[2 * e + 1] = bf2f(raw[u][e] >> 16); }
            float ss = 0.f;
#pragma unroll
            for (int e = 0; e < 8; ++e) ss += v[e] * v[e];
            ss += __shfl_xor(ss, 1); ss += __shfl_xor(ss, 2); ss += __shfl_xor(ss, 4);
            const float rs = rsqrtf(ss * (1.f / 64.f) + EPSN);
            const int pos = t & (SEQ - 1);
            float o[8];
#pragma unroll
            for (int e = 0; e < 8; ++e) {
                const float y = v[e] * rs * (which ? wk[e] : wq[e]);
                const float other = __shfl_xor(y, 1);
                float r = y;
                if (sub < 2) {
                    const float c = cosT[pos * 8 + e], sn = sinT[pos * 8 + e];
                    r = (sub == 0) ? (y * c - other * sn) : (other * sn + y * c);
                }
                o[e] = r;
            }
            u32x4 ov; ov.x = pk2(o[0], o[1]); ov.y = pk2(o[2], o[3]); ov.z = pk2(o[4], o[5]); ov.w = pk2(o[6], o[7]);
            if (wsi < TOK * 2) *(u32x4*)(proj + (size_t)t * NIN + (which ? PK : PQ) + F.lane * 8) = ov;
        }
    }
}

constexpr int P2_XS = 0, P2_BM = 33792, P2_CM = 51200, P2_CB = 68608, P2_MH = 85248, P2_XW = 122112, P2_ACS = 155904, P2_DT = 156928, P2_FAC = 157952;
constexpr int XS_LD = 264, BM_LD = 136, MH_LD = 72, CB_LD = 65;
static_assert(P2_FAC + 1024 <= LDS_BYTES, "P2 LDS");

__device__ __forceinline__ void p2_load_raw(const bf16_t* proj, int tid, int b, int c, int g, u32x4 (&rv)[11]) {
    const int cg = tid & 63, rg = tid >> 6, lc = cg * 8;
    const int pcol = lc < 256 ? PXS + g * 256 + lc : (lc < 384 ? PBM + g * 128 + (lc - 256) : PCM + g * 128 + (lc - 384));
#pragma unroll
    for (int i = 0; i < 11; ++i) {
        const int f = c * CHUNK + rg * 8 - 3 + i;
        u32x4 v = {0u, 0u, 0u, 0u};
        if (f >= 0) v = *(const u32x4*)(proj + ((size_t)b * SEQ + f) * NIN + pcol);
        rv[i] = v;
    }
}
__device__ __forceinline__ void p2_ssd_unit(const Params& p, Ctx& F, int b, int c, int g, u32x4 (&rv)[11], bool has_next, int nb, int nc, int ng) {
    unsigned char* ws = p.ws;
    const bf16_t* proj = (const bf16_t*)(ws + WS_PROJ);
    bf16_t* ycat = (bf16_t*)(ws + WS_YCAT); bf16_t* cmc = (bf16_t*)(ws + WS_CMC);
    bf16_t* states = (bf16_t*)(ws + WS_STATES); float* acs_g = (float*)(ws + WS_ACS); float* cdec = (float*)(ws + WS_CDEC);
    const float* dtraw = (const float*)(ws + WS_DTRAW);
    const float* conv_w = p.in[3]; const float* conv_b = p.in[4]; const float* dt_bias = p.in[5]; const float* a_log = p.in[6]; const float* d_skip = p.in[7];
    LAS bf16_t* XS = (LAS bf16_t*)(F.lds + P2_XS); LAS bf16_t* BM = (LAS bf16_t*)(F.lds + P2_BM); LAS bf16_t* CM = (LAS bf16_t*)(F.lds + P2_CM);
    LAS float* CB = (LAS float*)(F.lds + P2_CB); LAS bf16_t* MH = (LAS bf16_t*)(F.lds + P2_MH); LAS bf16_t* XW = (LAS bf16_t*)(F.lds + P2_XW);
    LAS float* ACS = (LAS float*)(F.lds + P2_ACS); LAS float* DT = (LAS float*)(F.lds + P2_DT); LAS float* FAC = (LAS float*)(F.lds + P2_FAC);
    const int tid = F.tid, lane = F.lane, wave = F.wave, fr = lane & 15, fq = lane >> 4;
    const size_t tbase = (size_t)b * SEQ + (size_t)c * CHUNK;
#ifndef SKIP_A
    {
        const int cg = tid & 63, rg = tid >> 6, lc = cg * 8;
        int pcol, dld, dcol, kind;
        if (lc < 256) { pcol = PXS + g * 256 + lc; dld = XS_LD; dcol = lc; kind = 0; }
        else if (lc < 384) { pcol = PBM + g * 128 + (lc - 256); dld = BM_LD; dcol = lc - 256; kind = 1; }
        else { pcol = PCM + g * 128 + (lc - 384); dld = BM_LD; dcol = lc - 384; kind = 2; }
        LAS bf16_t* dst = kind == 0 ? XS : (kind == 1 ? BM : CM);
        const int ch = pcol - 512;
        float cw[4][8], cbv[8];
#pragma unroll
        for (int w = 0; w < 4; ++w) {
            const f32x4 a = *(const f32x4*)(conv_w + w * 1024 + ch), bq = *(const f32x4*)(conv_w + w * 1024 + ch + 4);
#pragma unroll
            for (int e = 0; e < 4; ++e) { cw[w][e] = a[e]; cw[w][4 + e] = bq[e]; }
        }
        { const f32x4 a = *(const f32x4*)(conv_b + ch), bq = *(const f32x4*)(conv_b + ch + 4);
#pragma unroll
          for (int e = 0; e < 4; ++e) { cbv[e] = a[e]; cbv[4 + e] = bq[e]; } }
#pragma unroll
        for (int r = 0; r < 8; ++r) {
            const int l = rg * 8 + r;
            float o[8];
#pragma unroll
            for (int e = 0; e < 8; ++e) o[e] = cbv[e];
#pragma unroll
            for (int w = 0; w < 4; ++w)
#pragma unroll
                for (int e = 0; e < 4; ++e) {
                    o[2 * e] += cw[w][2 * e] * bf2f(rv[r + w][e] & 0xffffu);
                    o[2 * e + 1] += cw[w][2 * e + 1] * bf2f(rv[r + w][e] >> 16);
                }
#pragma unroll
            for (int e = 0; e < 8; ++e) o[e] = silu_f(o[e]);
            u32x4 ov; ov.x = pk2(o[0], o[1]); ov.y = pk2(o[2], o[3]); ov.z = pk2(o[4], o[5]); ov.w = pk2(o[6], o[7]);
            *(LAS u32x4*)(dst + l * dld + dcol) = ov;
            if (kind == 2) *(u32x4*)(cmc + (tbase + l) * 256 + g * 128 + dcol) = ov;
        }
    }
#endif
    if (has_next) p2_load_raw(proj, tid, nb, nc, ng, rv);
    if (tid < 256) {
        const int l = tid >> 2, h = tid & 3, hh = g * 4 + h;
        const float v = dtraw[(tbase + l) * 8 + hh] + dt_bias[hh];
        const float dt = v > 20.f ? v : log1pf(expf(v));
        DT[l * 4 + h] = dt;
        ACS[l * 4 + h] = dt * (-expf(a_log[hh]));
    }
    __syncthreads();
    if (wave < 4) {
        float s = ACS[lane * 4 + wave];
#pragma unroll
        for (int o = 1; o < 64; o <<= 1) { const float t = __shfl_up(s, o); if (lane >= o) s += t; }
        ACS[lane * 4 + wave] = s;
        if (lane == 63) cdec[((size_t)b * NCH + c) * 8 + g * 4 + wave] = expf(s);
    }
    __syncthreads();
    if (tid < 256) {
        const int l = tid >> 2, h = tid & 3;
        acs_g[(tbase + l) * 8 + g * 4 + h] = ACS[l * 4 + h];
        FAC[l * 4 + h] = DT[l * 4 + h] * expf(ACS[63 * 4 + h] - ACS[l * 4 + h]);
    }
#pragma unroll
    for (int q = 0; q < 2; ++q) {
        const int tile = wave * 2 + q, mt = tile >> 2, nt = tile & 3;
        f32x4 acc = {0.f, 0.f, 0.f, 0.f};
#pragma unroll
        for (int ks = 0; ks < 4; ++ks) {
            const bf16x8 a = *(const LAS bf16x8*)(CM + (mt * 16 + fr) * BM_LD + ks * 32 + fq * 8);
            const bf16x8 bq = *(const LAS bf16x8*)(BM + (nt * 16 + fr) * BM_LD + ks * 32 + fq * 8);
            acc = mfma16(a, bq, acc);
        }
#pragma unroll
        for (int j = 0; j < 4; ++j) CB[(mt * 16 + 4 * fq + j) * CB_LD + nt * 16 + fr] = acc[j];
    }
    __syncthreads();
    {
        const int sI = lane;
        float as_[4], ds_[4];
#pragma unroll
        for (int h = 0; h < 4; ++h) { as_[h] = ACS[sI * 4 + h]; ds_[h] = DT[sI * 4 + h]; }
#pragma unroll 2
        for (int li = 0; li < 8; ++li) {
            const int l = li * 8 + wave;
            const float cb = CB[l * CB_LD + sI];
#pragma unroll
            for (int h = 0; h < 4; ++h) {
                const float v = (sI <= l) ? cb * __expf(ACS[l * 4 + h] - as_[h]) * ds_[h] : 0.f;
                MH[(h * 64 + l) * MH_LD + sI] = (bf16_t)f2bf(v);
            }
        }
#pragma unroll
        for (int i = 0; i < 4; ++i) {
            const int pc = tid + 512 * i, l = pc >> 5, c8 = pc & 31;
            const u32x4 xv = *(const LAS u32x4*)(XS + l * XS_LD + c8 * 8);
            const float f = FAC[l * 4 + (c8 >> 3)];
            u32x4 o;
#pragma unroll
            for (int e = 0; e < 4; ++e) o[e] = pk2(bf2f(xv[e] & 0xffffu) * f, bf2f(xv[e] >> 16) * f);
            *(LAS u32x4*)(XW + l * XS_LD + c8 * 8) = o;
        }
    }
    __syncthreads();
    typedef short v4i16 __attribute__((ext_vector_type(4)));
#define TR16(PTR) __builtin_amdgcn_ds_read_tr16_b64_v4i16((LAS v4i16*)(PTR))
#define CAT8(LO, HI) (bf16x8){LO[0], LO[1], LO[2], LO[3], HI[0], HI[1], HI[2], HI[3]}
    const int trr = fr >> 2, trc = 4 * (fr & 3);
#ifndef SKIP_E
    {
        const int h = wave >> 1, hh = g * 4 + h; const float dsk = d_skip[hh];
#pragma unroll 1
        for (int mq = 0; mq < 2; ++mq) {
            const int lt = 2 * (wave & 1) + mq;
            bf16x8 bmh[2];
#pragma unroll
            for (int ks = 0; ks < 2; ++ks) bmh[ks] = *(const LAS bf16x8*)(MH + (h * 64 + lt * 16 + fr) * MH_LD + ks * 32 + fq * 8);
#pragma unroll 1
            for (int pt = 0; pt < 4; ++pt) {
                f32x4 acc = {0.f, 0.f, 0.f, 0.f};
#pragma unroll
                for (int ks = 0; ks < 2; ++ks) {
                    const LAS bf16_t* bp = XS + (ks * 32 + 8 * fq + trr) * XS_LD + h * 64 + pt * 16 + trc;
                    const v4i16 lo = TR16(bp), hi = TR16(bp + 4 * XS_LD);
                    acc = mfma16(CAT8(lo, hi), bmh[ks], acc);
                }
                const int l = lt * 16 + fr, pp = pt * 16 + 4 * fq;
                const u32x2 xv = *(const LAS u32x2*)(XS + l * XS_LD + h * 64 + pp);
                u32x2 w;
                w.x = pk2(acc[0] + bf2f(xv.x & 0xffffu) * dsk, acc[1] + bf2f(xv.x >> 16) * dsk);
                w.y = pk2(acc[2] + bf2f(xv.y & 0xffffu) * dsk, acc[3] + bf2f(xv.y >> 16) * dsk);
                *(u32x2*)(ycat + (tbase + l) * DM + g * 256 + h * 64 + pp) = w;
            }
        }
    }
#endif
#ifndef SKIP_F
    {
        const int h = wave >> 1, hh = g * 4 + h;
        bf16_t* sbase = states + (((size_t)b * NCH + c) * 8 + hh) * 64 * 128;
#pragma unroll 1
        for (int mq = 0; mq < 2; ++mq) {
            const int mt = 2 * (wave & 1) + mq;
            bf16x8 xw[2];
#pragma unroll
            for (int ks = 0; ks < 2; ++ks) {
                const LAS bf16_t* bp = XW + (ks * 32 + 8 * fq + trr) * XS_LD + h * 64 + mt * 16 + trc;
                const v4i16 lo = TR16(bp), hi = TR16(bp + 4 * XS_LD);
                xw[ks] = CAT8(lo, hi);
            }
#pragma unroll 1
            for (int nt = 0; nt < 8; ++nt) {
                f32x4 acc = {0.f, 0.f, 0.f, 0.f};
#pragma unroll
                for (int ks = 0; ks < 2; ++ks) {
                    const LAS bf16_t* ap = BM + (ks * 32 + 8 * fq + trr) * BM_LD + nt * 16 + trc;
                    const v4i16 lo = TR16(ap), hi = TR16(ap + 4 * BM_LD);
                    acc = mfma16(CAT8(lo, hi), xw[ks], acc);
                }
                u32x2 w; w.x = pk2(acc[0], acc[1]); w.y = pk2(acc[2], acc[3]);
                *(u32x2*)(sbase + (size_t)(mt * 16 + fr) * 128 + nt * 16 + 4 * fq) = w;
            }
        }
    }
#undef TR16
#undef CAT8
#endif
    __syncthreads();
}

__device__ __forceinline__ void phase2(const Params& p, Ctx& F) {
#if defined(PROBE_PHASE) && (PROBE_PHASE == 20 || PROBE_PHASE == 21)
    F.ta = __builtin_amdgcn_s_memrealtime();
#endif
#ifdef USE_QK_PREPASS
    p2_qk_prepass(p, F);
#endif
#if defined(PROBE_PHASE) && (PROBE_PHASE == 20 || PROBE_PHASE == 21)
    VM_WAIT(); F.tb = __builtin_amdgcn_s_memrealtime();
#endif
    {
        const bf16_t* proj = (const bf16_t*)(p.ws + WS_PROJ);
        u32x4 rv[11];
        if (F.vcu < NB * NCH * 2) p2_load_raw(proj, F.tid, F.vcu >> 7, (F.vcu >> 1) & 63, F.vcu & 1, rv);
        for (int u = F.vcu; u < NB * NCH * 2; u += F.G) {
            const int g = u & 1, c = (u >> 1) & 63, b = u >> 7;
            const int un = u + F.G;
            p2_ssd_unit(p, F, b, c, g, rv, un < NB * NCH * 2, un >> 7, (un >> 1) & 63, un & 1);
        }
    }
#if defined(PROBE_PHASE) && (PROBE_PHASE == 20 || PROBE_PHASE == 21)
    VM_WAIT(); F.tc = __builtin_amdgcn_s_memrealtime();
#endif
}

__device__ __forceinline__ void p3_scan(const Params& p, Ctx& F) {
    bf16_t* states = (bf16_t*)(p.ws + WS_STATES); const float* cdec = (const float*)(p.ws + WS_CDEC);
    const int gtid = F.vcu * 512 + F.tid, nthr = F.G * 512;
    for (int e = gtid; e < NB * 8 * 64 * 32; e += nthr) {
        const int n4 = e & 31, pp = (e >> 5) & 63, hh = (e >> 11) & 7, b = e >> 14;
        f32x4 carry = {0.f, 0.f, 0.f, 0.f};
        for (int c0 = 0; c0 < NCH; c0 += 16) {
            u32x2 s[16]; float dc[16];
#pragma unroll
            for (int i = 0; i < 16; ++i) {
                s[i] = *(const u32x2*)(states + ((((size_t)b * NCH + c0 + i) * 8 + hh) * 64 + pp) * 128 + n4 * 4);
                dc[i] = cdec[((size_t)b * NCH + c0 + i) * 8 + hh];
            }
#pragma unroll
            for (int i = 0; i < 16; ++i) {
                u32x2 w; w.x = pk2(carry[0], carry[1]); w.y = pk2(carry[2], carry[3]);
                *(u32x2*)(states + ((((size_t)b * NCH + c0 + i) * 8 + hh) * 64 + pp) * 128 + n4 * 4) = w;
                const f32x4 sv = {bf2f(s[i].x & 0xffffu), bf2f(s[i].x >> 16), bf2f(s[i].y & 0xffffu), bf2f(s[i].y >> 16)};
                carry = carry * dc[i] + sv;
            }
        }
    }
}

namespace att {
constexpr int NW = 8, QBLK = 32, KVBLK = 64;
constexpr float SCALE = 0.125f, THR = 8.f;
constexpr int SHM_V = KVBLK * 128 * 2, SHM_K = KVBLK * 64 * 2;
constexpr int LDS_V = 0, LDS_K = 2 * SHM_V, LDS_WS = LDS_K + 2 * SHM_K, LDS_END = LDS_WS + NW * 64 * 4;
#define KSWZ64(row, colB) ((row) * 128 + ((colB) ^ ((((row) >> 1) & 7) << 4)))
#define SBAR() __builtin_amdgcn_sched_barrier(0)
__device__ __forceinline__ int crow(int r, int hi) { return (r & 3) + 8 * (r >> 2) + 4 * hi; }
__device__ __forceinline__ unsigned cvtpk(float lo, float hi) { unsigned r; asm volatile("v_cvt_pk_bf16_f32 %0, %1, %2" : "=v"(r) : "v"(lo), "v"(hi)); return r; }

__device__ __forceinline__ void partialSM(f32x16& p0, f32x16& p1, float& m_reg, float& mn, float& alpha) {
    constexpr float C = SCALE * 1.4426950408889634f;
    float pmax = p0[0];
#pragma unroll
    for (int r = 1; r < 16; ++r) pmax = fmaxf(pmax, p0[r]);
#pragma unroll
    for (int r = 0; r < 16; ++r) pmax = fmaxf(pmax, p1[r]);
    { auto rr = __builtin_amdgcn_permlane32_swap(__float_as_uint(pmax), __float_as_uint(pmax), false, false);
      pmax = fmaxf(__uint_as_float(rr[0]), __uint_as_float(rr[1])); }
    if (__builtin_expect(__all(pmax - m_reg <= THR / SCALE), 1)) { mn = m_reg; alpha = 1.f; }
    else { mn = fmaxf(m_reg, pmax); alpha = __builtin_amdgcn_exp2f((m_reg - mn) * C); m_reg = mn; }
    const float mnC = -mn * C;
#pragma unroll
    for (int r = 0; r < 16; ++r) p0[r] = fmaf(p0[r], C, mnC);
#pragma unroll
    for (int r = 0; r < 16; ++r) p1[r] = fmaf(p1[r], C, mnC);
#pragma unroll
    for (int r = 0; r < 16; ++r) p0[r] = __builtin_amdgcn_exp2f(p0[r]);
}
__device__ __forceinline__ void finishSM(f32x16& p0, f32x16& p1, float alpha, float& l_reg, bf16x8& pa0, bf16x8& pa1, bf16x8& pa2, bf16x8& pa3) {
#pragma unroll
    for (int r = 0; r < 16; ++r) p1[r] = __builtin_amdgcn_exp2f(p1[r]);
    float ps = 0;
#pragma unroll
    for (int r = 0; r < 16; ++r) ps += p0[r];
#pragma unroll
    for (int r = 0; r < 16; ++r) ps += p1[r];
    { auto rr = __builtin_amdgcn_permlane32_swap(__float_as_uint(ps), __float_as_uint(ps), false, false);
      ps = __uint_as_float(rr[0]) + __uint_as_float(rr[1]); }
    l_reg = l_reg * alpha + ps;
#define PK4(P, BASE, OUT) do { unsigned a0 = cvtpk(P[BASE + 0], P[BASE + 1]), a1 = cvtpk(P[BASE + 2], P[BASE + 3]);   \
    unsigned b0 = cvtpk(P[BASE + 4], P[BASE + 5]), b1 = cvtpk(P[BASE + 6], P[BASE + 7]);                              \
    auto r0 = __builtin_amdgcn_permlane32_swap(a0, b0, false, false); auto r1 = __builtin_amdgcn_permlane32_swap(a1, b1, false, false); \
    u32x4 w = {r0[0], r1[0], r0[1], r1[1]}; OUT = *reinterpret_cast<bf16x8*>(&w); } while (0)
    PK4(p0, 0, pa0); PK4(p0, 8, pa1); PK4(p1, 0, pa2); PK4(p1, 8, pa3);
#undef PK4
}
__device__ __forceinline__ void qkt(f32x16& p0, f32x16& p1, const char* Ks, const bf16x8* qr, int r32, int hi) {
    p0 = f32x16{}; p1 = f32x16{};
#pragma unroll
    for (int d0 = 0; d0 < 4; ++d0) {
        const int cb = (d0 * 16 + hi * 8) * 2;
        const bf16x8 b0 = *reinterpret_cast<const bf16x8*>(Ks + KSWZ64(r32, cb));
        const bf16x8 b1 = *reinterpret_cast<const bf16x8*>(Ks + KSWZ64(32 + r32, cb));
        p0 = mfma32(b0, qr[d0], p0);
        p1 = mfma32(b1, qr[d0], p1);
    }
}
__device__ __forceinline__ void maskfill(f32x16& p0, f32x16& p1, bool m) {
    if (m) {
        asm volatile("; masked tile");
#pragma unroll
        for (int r = 0; r < 16; ++r) { p0[r] = -1e30f; p1[r] = -1e30f; }
    }
}
__device__ __forceinline__ int v_st(int k, int c) { const int kk = (k & ~0xC) | ((k & 4) << 1) | ((k & 8) >> 1); return ((kk >> 3) * 4 + (c >> 5)) * 512 + ((kk & 7) * 32 + (c & 31)) * 2; }
__device__ __forceinline__ int v_rd_base(int lane) { return ((lane & 3) << 3) | (((lane >> 2) & 3) << 6) | (((lane >> 4) & 1) << 5) | (((lane >> 5) & 1) << 8); }
constexpr int v_rd_off(int d0, int ks, int half) { return d0 * 512 + ks * 4096 + half * 2048; }
template <int OFF> __device__ __forceinline__ s16x4 tr_read(int vb) {
    s16x4 r; asm volatile("ds_read_b64_tr_b16 %0, %1 offset:%2" : "=&v"(r) : "v"(vb), "i"(OFF) : "memory"); return r;
}
template <int D0> __device__ __forceinline__ void pv_one(f32x16& od, int vb, bf16x8 pa0, bf16x8 pa1, bf16x8 pa2, bf16x8 pa3) {
    const s16x4 l0 = tr_read<v_rd_off(D0, 0, 0)>(vb), h0 = tr_read<v_rd_off(D0, 0, 1)>(vb), l1 = tr_read<v_rd_off(D0, 1, 0)>(vb), h1 = tr_read<v_rd_off(D0, 1, 1)>(vb);
    const s16x4 l2 = tr_read<v_rd_off(D0, 2, 0)>(vb), h2 = tr_read<v_rd_off(D0, 2, 1)>(vb), l3 = tr_read<v_rd_off(D0, 3, 0)>(vb), h3 = tr_read<v_rd_off(D0, 3, 1)>(vb);
    asm volatile("s_waitcnt lgkmcnt(0)" ::: "memory"); SBAR();
#define PKV(L, H) (bf16x8){L[0], L[1], L[2], L[3], H[0], H[1], H[2], H[3]}
    od = mfma32(pa0, PKV(l0, h0), od);
    od = mfma32(pa1, PKV(l1, h1), od);
    od = mfma32(pa2, PKV(l2, h2), od);
    od = mfma32(pa3, PKV(l3, h3), od);
#undef PKV
}
__device__ __forceinline__ void pv_d0(f32x16* o, int vb, bf16x8 pa0, bf16x8 pa1, bf16x8 pa2, bf16x8 pa3) {
    pv_one<0>(o[0], vb, pa0, pa1, pa2, pa3); pv_one<1>(o[1], vb, pa0, pa1, pa2, pa3); pv_one<2>(o[2], vb, pa0, pa1, pa2, pa3); pv_one<3>(o[3], vb, pa0, pa1, pa2, pa3);
}

__device__ __forceinline__ void attn_pass(const bf16_t* __restrict__ Qb, const bf16_t* __restrict__ Kh, const bf16_t* __restrict__ Vh, int NT, int my_last, char* lds, f32x16 (&o)[4]) {
    const int tid = threadIdx.x, wid = tid >> 6, lane = tid & 63, r32 = lane & 31, hi = lane >> 5;
    char* V_lds = lds + LDS_V; char* K_lds = lds + LDS_K;
    float* wsf = (float*)(lds + LDS_WS) + wid * 64; float* li_l = wsf; float* al_l = wsf + 32;
    float m_reg = -1e30f, l_reg = 0.f;
#pragma unroll
    for (int d = 0; d < 4; ++d) o[d] = f32x16{};
    bf16x8 qr[4];
    const bf16_t* Qw = Qb + (size_t)(wid * QBLK + r32) * NIN + hi * 8;
#pragma unroll
    for (int d0 = 0; d0 < 4; ++d0) qr[d0] = *reinterpret_cast<const bf16x8*>(Qw + d0 * 16);
    const int sr = tid >> 4, sc = (tid & 15) * 8, vst0 = v_st(sr, sc), vst1 = v_st(32 + sr, sc);
    const int krow = tid >> 3, kc8 = (tid & 7) * 8, kst = KSWZ64(krow, kc8 * 2);
    const int vb0 = (int)(uintptr_t)V_lds + v_rd_base(lane);
    struct { bf16x8 vs0, vs1, ks; } sr_[2];
#define SLOAD(i, k0) do { sr_[i].vs0 = *reinterpret_cast<const bf16x8*>(&Vh[(size_t)((k0) + sr) * NIN + sc]); sr_[i].vs1 = *reinterpret_cast<const bf16x8*>(&Vh[(size_t)((k0) + 32 + sr) * NIN + sc]); \
    sr_[i].ks = *reinterpret_cast<const bf16x8*>(&Kh[(size_t)((k0) + krow) * NIN + kc8]); } while (0)
#define SWRITE(b, i) do { *(bf16x8*)(V_lds + (b) * SHM_V + vst0) = sr_[i].vs0; *(bf16x8*)(V_lds + (b) * SHM_V + vst1) = sr_[i].vs1; \
    *(bf16x8*)(K_lds + (b) * SHM_K + kst) = sr_[i].ks; } while (0)
#define SWAIT() asm volatile("s_waitcnt vmcnt(3)" ::: "memory")
#define RESC(a) do { if (__any((a) < 1.f)) { if (hi == 0) al_l[r32] = (a); asm volatile("s_waitcnt lgkmcnt(0)" ::: "memory"); \
    _Pragma("unroll") for (int d = 0; d < 4; ++d) _Pragma("unroll") for (int r = 0; r < 16; ++r) o[d][r] *= al_l[crow(r, hi)]; } } while (0)
    f32x16 pA0, pA1, pB0, pB1; float mnA, mnB, alA, alB; bf16x8 pa0, pa1, pa2, pa3;
    constexpr int SE = 0, SO = 1;
    __syncthreads();
    SLOAD(SE, 0); asm volatile("s_waitcnt vmcnt(0)" ::: "memory"); SWRITE(0, SE); __syncthreads();
    qkt(pA0, pA1, K_lds, qr, r32, hi); partialSM(pA0, pA1, m_reg, mnA, alA);
    SLOAD(SO, KVBLK); if (2 < NT) SLOAD(SE, 2 * KVBLK);
    SWAIT(); SWRITE(1, SO); __syncthreads();
    for (int j = 1; j + 1 < NT; j += 2) {
        qkt(pB0, pB1, K_lds + SHM_K, qr, r32, hi); maskfill(pB0, pB1, j > my_last);
        finishSM(pA0, pA1, alA, l_reg, pa0, pa1, pa2, pa3);
        SLOAD(SO, (j + 2) * KVBLK);
        pv_d0(o, vb0, pa0, pa1, pa2, pa3); partialSM(pB0, pB1, m_reg, mnB, alB);
        __syncthreads(); SWAIT(); SWRITE(0, SE);
        RESC(alB); __syncthreads();
        qkt(pA0, pA1, K_lds, qr, r32, hi); maskfill(pA0, pA1, j + 1 > my_last);
        finishSM(pB0, pB1, alB, l_reg, pa0, pa1, pa2, pa3);
        if (j + 3 < NT) SLOAD(SE, (j + 3) * KVBLK);
        pv_d0(o, vb0 + SHM_V, pa0, pa1, pa2, pa3); partialSM(pA0, pA1, m_reg, mnA, alA);
        __syncthreads(); SWAIT(); SWRITE(1, SO);
        RESC(alA); __syncthreads();
    }
    SBAR(); qkt(pB0, pB1, K_lds + SHM_K, qr, r32, hi); maskfill(pB0, pB1, NT - 1 > my_last);
    finishSM(pA0, pA1, alA, l_reg, pa0, pa1, pa2, pa3); SBAR();
    pv_d0(o, vb0, pa0, pa1, pa2, pa3); partialSM(pB0, pB1, m_reg, mnB, alB);
    __syncthreads(); RESC(alB);
    finishSM(pB0, pB1, alB, l_reg, pa0, pa1, pa2, pa3); SBAR();
    pv_d0(o, vb0 + SHM_V, pa0, pa1, pa2, pa3);
    if (hi == 0) li_l[r32] = l_reg;
    asm volatile("s_waitcnt lgkmcnt(0)" ::: "memory");
#pragma unroll
    for (int r = 0; r < 16; ++r) {
        const float rl = __builtin_amdgcn_rcpf(li_l[crow(r, hi)]);
#pragma unroll
        for (int d = 0; d < 4; ++d) o[d][r] *= rl;
    }
    asm volatile("s_waitcnt vmcnt(0)" ::: "memory");
    __syncthreads();
#undef SLOAD
#undef SWRITE
#undef SWAIT
#undef RESC
}
}

__device__ __forceinline__ void p3_attn_unit(const Params& p, Ctx& F, int b, int h, int qb, float* oscr) {
    const bf16_t* proj = (const bf16_t*)(p.ws + WS_PROJ);
    bf16_t* ycat = (bf16_t*)(p.ws + WS_YCAT);
    const float lam = ((const float*)(p.ws + WS_MISC))[0];
    const float* subw = p.in[15];
    const int tid = F.tid, wid = F.wave, lane = F.lane, r32 = lane & 31, hi = lane >> 5;
    const size_t rowbase = (size_t)b * SEQ; const int q0 = qb * 256;
    const int NT = (q0 + 256) / 64, my_last = (q0 + 32 * wid) / 64;
    f32x16 o[4];
    for (int j = 0; j < 2; ++j) {
        const bf16_t* Qb = proj + (rowbase + q0) * NIN + PQ + h * 128 + j * 64;
        const bf16_t* Kh = proj + rowbase * NIN + PK + h * 128 + j * 64;
        const bf16_t* Vh = proj + rowbase * NIN + PV + h * 128;
        att::attn_pass(Qb, Kh, Vh, NT, my_last, (char*)F.lds, o);
        if (j == 0) {
            float* my = oscr + tid * 64;
#pragma unroll
            for (int d = 0; d < 4; ++d)
#pragma unroll
                for (int r4 = 0; r4 < 4; ++r4) *(f32x4*)(my + d * 16 + r4 * 4) = (f32x4){o[d][4 * r4], o[d][4 * r4 + 1], o[d][4 * r4 + 2], o[d][4 * r4 + 3]};
        }
    }
    float wv[4];
#pragma unroll
    for (int d = 0; d < 4; ++d) wv[d] = subw[d * 32 + r32] * (1.f - LAMBDA_INIT);
#pragma unroll
    for (int r = 0; r < 16; ++r) {
        float v[4]; float ss = 0.f;
#pragma unroll
        for (int d = 0; d < 4; ++d) { v[d] = oscr[tid * 64 + d * 16 + r] - lam * o[d][r]; ss += v[d] * v[d]; }
        ss += __shfl_xor(ss, 1); ss += __shfl_xor(ss, 2); ss += __shfl_xor(ss, 4); ss += __shfl_xor(ss, 8); ss += __shfl_xor(ss, 16);
        const float rs = rsqrtf(ss * (1.f / 128.f) + EPSN);
        const size_t row = rowbase + q0 + wid * 32 + att::crow(r, hi);
#pragma unroll
        for (int d = 0; d < 4; ++d) ycat[row * DM + 512 + h * 128 + d * 32 + r32] = (bf16_t)f2bf(v[d] * rs * wv[d]);
    }
}

__device__ __forceinline__ void phase3(const Params& p, Ctx& F) {
#if defined(PROBE_PHASE) && (PROBE_PHASE == 30 || PROBE_PHASE == 31)
    F.ta = __builtin_amdgcn_s_memrealtime();
#endif
    p3_scan(p, F);
#if defined(PROBE_PHASE) && (PROBE_PHASE == 30 || PROBE_PHASE == 31)
    VM_WAIT(); F.tb = __builtin_amdgcn_s_memrealtime();
#endif
    float* oscr = p.out + (size_t)F.vcu * (64 * 512);
    for (int ui = F.vcu; ui < 512; ui += F.G) {
        const int pi = ui & 255, bh = pi >> 3, s = pi & 7, b = bh >> 2, h = bh & 3;
        p3_attn_unit(p, F, b, h, ui < 256 ? 15 - s : s, oscr);
    }
#if defined(PROBE_PHASE) && (PROBE_PHASE == 30 || PROBE_PHASE == 31)
    VM_WAIT(); F.tc = __builtin_amdgcn_s_memrealtime();
#endif
}

constexpr int P4_PREV = 0, P4_CM = 69632, P4_ACS = 87040, P4_Y = 88064, Y_LD = 257;
static_assert(P4_Y + 64 * Y_LD * 4 <= LDS_BYTES, "P4 LDS");
__device__ __forceinline__ void p4_load(const bf16_t* states, const bf16_t* cmc, int tid, int b, int c, int g, u32x4 (&pv)[8], u32x4 (&cv)[2]) {
    const size_t tbase = (size_t)b * SEQ + (size_t)c * CHUNK;
#pragma unroll
    for (int i = 0; i < 8; ++i) {
        const int e = tid + 512 * i, n8 = e & 15, pp = (e >> 4) & 63, h = e >> 10;
        pv[i] = *(const u32x4*)(states + ((((size_t)b * NCH + c) * 8 + g * 4 + h) * 64 + pp) * 128 + n8 * 8);
    }
#pragma unroll
    for (int i = 0; i < 2; ++i) {
        const int e = tid + 512 * i, l = e >> 4, c8 = e & 15;
        cv[i] = *(const u32x4*)(cmc + (tbase + l) * 256 + g * 128 + c8 * 8);
    }
}
__device__ __forceinline__ void p4_unit(const Params& p, Ctx& F, int b, int c, int g, u32x4 (&pv)[8], u32x4 (&cv)[2], bool has_next, int nb, int nc, int ng) {
    unsigned char* ws = p.ws;
    const bf16_t* proj = (const bf16_t*)(ws + WS_PROJ);
    bf16_t* ycat = (bf16_t*)(ws + WS_YCAT); const bf16_t* cmc = (const bf16_t*)(ws + WS_CMC);
    const bf16_t* states = (const bf16_t*)(ws + WS_STATES); const float* acs_g = (const float*)(ws + WS_ACS);
    const float* normw = p.in[8];
    LAS bf16_t* PREV = (LAS bf16_t*)(F.lds + P4_PREV); LAS bf16_t* CM = (LAS bf16_t*)(F.lds + P4_CM);
    LAS float* ACS = (LAS float*)(F.lds + P4_ACS); LAS float* Y = (LAS float*)(F.lds + P4_Y);
    const int tid = F.tid, lane = F.lane, wave = F.wave, fr = lane & 15, fq = lane >> 4;
    const size_t tbase = (size_t)b * SEQ + (size_t)c * CHUNK;
#pragma unroll
    for (int i = 0; i < 8; ++i) {
        const int e = tid + 512 * i, n8 = e & 15, pp = (e >> 4) & 63, h = e >> 10;
        *(LAS u32x4*)(PREV + (h * 64 + pp) * BM_LD + n8 * 8) = pv[i];
    }
#pragma unroll
    for (int i = 0; i < 2; ++i) {
        const int e = tid + 512 * i, l = e >> 4, c8 = e & 15;
        *(LAS u32x4*)(CM + l * BM_LD + c8 * 8) = cv[i];
    }
    if (has_next) p4_load(states, cmc, tid, nb, nc, ng, pv, cv);
    if (tid < 256) { const int l = tid >> 2, h = tid & 3; ACS[l * 4 + h] = acs_g[(tbase + l) * 8 + g * 4 + h]; }
    __syncthreads();
    {
        const int h = wave >> 1;
#pragma unroll
        for (int mq = 0; mq < 2; ++mq) {
            const int mt = 2 * (wave & 1) + mq;
            bf16x8 a[4];
#pragma unroll
            for (int ks = 0; ks < 4; ++ks) a[ks] = *(const LAS bf16x8*)(CM + (mt * 16 + fr) * BM_LD + ks * 32 + fq * 8);
#pragma unroll
            for (int nt = 0; nt < 4; ++nt) {
                f32x4 acc = {0.f, 0.f, 0.f, 0.f};
#pragma unroll
                for (int ks = 0; ks < 4; ++ks) {
                    const bf16x8 bq = *(const LAS bf16x8*)(PREV + (h * 64 + nt * 16 + fr) * BM_LD + ks * 32 + fq * 8);
                    acc = mfma16(a[ks], bq, acc);
                }
#pragma unroll
                for (int j = 0; j < 4; ++j) {
                    const int l = mt * 16 + 4 * fq + j, col = h * 64 + nt * 16 + fr;
                    Y[l * Y_LD + col] = acc[j] * __expf(ACS[l * 4 + h]);
                }
            }
        }
    }
    __syncthreads();
    {
        const int c8 = lane & 31, hr = lane >> 5;
        const f32x4 nw0 = *(const f32x4*)(normw + g * 256 + c8 * 8), nw1 = *(const f32x4*)(normw + g * 256 + c8 * 8 + 4);
#pragma unroll 2
        for (int r = 0; r < 4; ++r) {
            const int l = wave * 8 + r * 2 + hr;
            const size_t t = tbase + l;
            const u32x4 yl = *(const u32x4*)(ycat + t * DM + g * 256 + c8 * 8);
            const u32x4 zz = *(const u32x4*)(proj + t * NIN + PZ + g * 256 + c8 * 8);
            float v[8]; float ss = 0.f;
#pragma unroll
            for (int e = 0; e < 4; ++e) {
                const float y0 = bf2f(yl[e] & 0xffffu) + Y[l * Y_LD + c8 * 8 + 2 * e], y1 = bf2f(yl[e] >> 16) + Y[l * Y_LD + c8 * 8 + 2 * e + 1];
                v[2 * e] = y0 * silu_f(bf2f(zz[e] & 0xffffu)); v[2 * e + 1] = y1 * silu_f(bf2f(zz[e] >> 16));
                ss += v[2 * e] * v[2 * e] + v[2 * e + 1] * v[2 * e + 1];
            }
            ss += __shfl_xor(ss, 1); ss += __shfl_xor(ss, 2); ss += __shfl_xor(ss, 4); ss += __shfl_xor(ss, 8); ss += __shfl_xor(ss, 16);
            const float rs = rsqrtf(ss * (1.f / 256.f) + EPSN);
            u32x4 o;
            o.x = pk2(v[0] * rs * nw0[0], v[1] * rs * nw0[1]); o.y = pk2(v[2] * rs * nw0[2], v[3] * rs * nw0[3]);
            o.z = pk2(v[4] * rs * nw1[0], v[5] * rs * nw1[1]); o.w = pk2(v[6] * rs * nw1[2], v[7] * rs * nw1[3]);
            *(u32x4*)(ycat + t * DM + g * 256 + c8 * 8) = o;
        }
    }
    __syncthreads();
}
__device__ __forceinline__ void phase4(const Params& p, Ctx& F) {
    const bf16_t* states = (const bf16_t*)(p.ws + WS_STATES); const bf16_t* cmc = (const bf16_t*)(p.ws + WS_CMC);
    u32x4 pv[8], cv[2];
    if (F.vcu < NB * NCH * 2) p4_load(states, cmc, F.tid, F.vcu >> 7, (F.vcu >> 1) & 63, F.vcu & 1, pv, cv);
    for (int u = F.vcu; u < NB * NCH * 2; u += F.G) {
        const int g = u & 1, c = (u >> 1) & 63, b = u >> 7;
        const int un = u + F.G;
        p4_unit(p, F, b, c, g, pv, cv, un < NB * NCH * 2, un >> 7, (un >> 1) & 63, un & 1);
    }
}

__device__ __forceinline__ unsigned f2ord(float f) { const unsigned u = __float_as_uint(f); return (u >> 31) ? ~u : (u | 0x80000000u); }
__device__ __forceinline__ float ord2f(unsigned u) { return __uint_as_float((u >> 31) ? (u & 0x7fffffffu) : ~u); }
#define CE_DESC(A, B) do { const unsigned hi_ = (A) > (B) ? (A) : (B); const unsigned lo_ = (A) > (B) ? (B) : (A); (A) = hi_; (B) = lo_; } while (0)
template <int K, int J> __device__ __forceinline__ void bstage(unsigned (&r)[16]) {
#pragma unroll
    for (int i = 0; i < 16; ++i) { const int l = i ^ J; if (l > i) { if ((i & K) == 0) CE_DESC(r[i], r[l]); else CE_DESC(r[l], r[i]); } }
}
__device__ __forceinline__ void bitonic_merge16(unsigned (&r)[16]) { bstage<16, 8>(r); bstage<16, 4>(r); bstage<16, 2>(r); bstage<16, 1>(r); }
__device__ __forceinline__ void bitonic_sort16(unsigned (&r)[16]) {
    bstage<2, 1>(r); bstage<4, 2>(r); bstage<4, 1>(r); bstage<8, 4>(r); bstage<8, 2>(r); bstage<8, 1>(r); bitonic_merge16(r);
}
__device__ __forceinline__ void top16_merge(unsigned (&r)[16], const unsigned (&n)[16]) {
#pragma unroll
    for (int i = 0; i < 16; ++i) r[i] = r[i] > n[15 - i] ? r[i] : n[15 - i];
    bitonic_merge16(r);
}
template <int XM> __device__ __forceinline__ unsigned quad_xor(unsigned v) {
    static_assert(XM == 1 || XM == 2, "quad permute");
    return (unsigned)__builtin_amdgcn_mov_dpp((int)v, XM == 1 ? 0xB1 : 0x4E, 0xf, 0xf, true);
}
template <int XM> __device__ __forceinline__ void top16_merge_lane_t(unsigned (&r)[16]) {
    unsigned n[16];
#pragma unroll
    for (int i = 0; i < 16; ++i) n[i] = quad_xor<XM>(r[i]);
    top16_merge(r, n);
}
__device__ __forceinline__ void top16_merge_lane(unsigned (&r)[16], int xm) {
    if (xm == 1) top16_merge_lane_t<1>(r); else top16_merge_lane_t<2>(r);
}
__device__ __forceinline__ void p7_cand_table(LAS unsigned char* CAND, int tid) {
    if (tid < 52) {
        int c = 0; unsigned char v = 255;
        for (int a = 0; a < 16; ++a) for (int b = 0; b < 16 / (a + 1); ++b) { if (c == tid) v = (unsigned char)(a * 16 + b); ++c; }
        CAND[tid] = v;
    }
}
__device__ __forceinline__ void route16(const bf16_t* qp, const float* rowsq, float* gwo, size_t t0, int lane, LAS unsigned* lists, const LAS unsigned char* CAND, LAS unsigned short* IDX) {
    const int tok = lane >> 2, part = lane & 3;
    const float r2 = rsqrtf(rowsq[t0 + tok] * (1.f / DM) + EPSN);
    u32x4 nxt[2][4];
#pragma unroll
    for (int j = 0; j < 2; ++j)
#pragma unroll
        for (int q = 0; q < 4; ++q) nxt[j][q] = __builtin_nontemporal_load((const u32x4*)(qp + (t0 + tok) * 2048 + j * 128 + part * 32 + q * 8));
#pragma unroll 1
    for (int h = 0; h < 8; ++h) {
        u32x4 raw[2][4];
#pragma unroll
        for (int j = 0; j < 2; ++j)
#pragma unroll
            for (int q = 0; q < 4; ++q) raw[j][q] = nxt[j][q];
        if (h < 7) {
#pragma unroll
            for (int j = 0; j < 2; ++j)
#pragma unroll
                for (int q = 0; q < 4; ++q) nxt[j][q] = __builtin_nontemporal_load((const u32x4*)(qp + (t0 + tok) * 2048 + (h + 1) * 256 + j * 128 + part * 32 + q * 8));
        }
#pragma unroll
        for (int j = 0; j < 2; ++j) {
            unsigned r[16], n[16];
#pragma unroll
            for (int q = 0; q < 2; ++q)
#pragma unroll
                for (int e = 0; e < 4; ++e) {
                    r[q * 8 + 2 * e]     = (f2ord(bf2f(raw[j][q][e] & 0xffffu) * r2) & ~127u) | (unsigned)(part * 32 + q * 8 + 2 * e);
                    r[q * 8 + 2 * e + 1] = (f2ord(bf2f(raw[j][q][e] >> 16) * r2) & ~127u) | (unsigned)(part * 32 + q * 8 + 2 * e + 1);
                    n[q * 8 + 2 * e]     = (f2ord(bf2f(raw[j][2 + q][e] & 0xffffu) * r2) & ~127u) | (unsigned)(part * 32 + 16 + q * 8 + 2 * e);
                    n[q * 8 + 2 * e + 1] = (f2ord(bf2f(raw[j][2 + q][e] >> 16) * r2) & ~127u) | (unsigned)(part * 32 + 16 + q * 8 + 2 * e + 1);
                }
            bitonic_sort16(r); bitonic_sort16(n);
            top16_merge(r, n);
            top16_merge_lane(r, 1);
            top16_merge_lane(r, 2);
            if (part == 0) {
#pragma unroll
                for (int k = 0; k < 16; ++k) lists[(tok * 2 + j) * 16 + k] = r[k];
            }
        }
        LDS_WAIT(); __builtin_amdgcn_wave_barrier();
        {
            const LAS unsigned* l0 = lists + (2 * tok) * 16; const LAS unsigned* l1 = lists + (2 * tok + 1) * 16;
            unsigned r[16];
#pragma unroll
            for (int m = 0; m < 13; ++m) {
                const unsigned ab = CAND[part + 4 * m];
                const unsigned a = (ab >> 4) & 15u, bb = ab & 15u;
                const float sum = ord2f(l0[a] & ~127u) + ord2f(l1[bb] & ~127u);
                r[m] = ab == 255u ? 0u : ((f2ord(sum) & ~255u) | ab);
            }
            r[13] = 0u; r[14] = 0u; r[15] = 0u;
            bitonic_sort16(r);
            top16_merge_lane(r, 1);
            top16_merge_lane(r, 2);
            float val[16]; unsigned ex[16]; float mx = -1e30f;
#pragma unroll
            for (int k = 0; k < 16; ++k) {
                const unsigned pos = r[k] & 255u, a = pos >> 4, bb = pos & 15u;
                const unsigned w0 = l0[a], w1 = l1[bb];
                ex[k] = (w0 & 127u) * 128u + (w1 & 127u);
                val[k] = ord2f(w0 & ~127u) + ord2f(w1 & ~127u);
                mx = fmaxf(mx, val[k]);
            }
            float sum = 0.f;
#pragma unroll
            for (int k = 0; k < 16; ++k) { val[k] = __expf(val[k] - mx); sum += val[k]; }
            const float inv = __builtin_amdgcn_rcpf(sum);
            float* go = gwo + ((t0 + tok) * 8 + h) * 16;
            if (part == 0) {
#pragma unroll
                for (int k = 0; k < 16; ++k) { IDX[tok * 128 + h * 16 + k] = (unsigned short)ex[k]; go[k] = val[k] * inv; }
            }
        }
        LDS_WAIT(); __builtin_amdgcn_wave_barrier();
    }
}

constexpr int PACE_WORDS = 32 * 16 * 16;
__device__ __forceinline__ void xcd_pace(const XcdBarrier& b, int slot) {
    __syncthreads();
    if (threadIdx.x == 0) {
        const unsigned nloc = b.st[0];
        unsigned* w = b.bar + XCD_BAR_WORDS + (slot * 16 + (int)b.x) * 16;
        (void)xb_add(w, 1u);
        unsigned sp = 0;
        while (xb_ld(w) < nloc && ++sp < 3000u) __builtin_amdgcn_s_sleep(1);
    }
    __syncthreads();
}
__device__ __forceinline__ float gelu_erf(float x) { return 0.5f * x * (1.f + erff(x * 0.70710678118654752f)); }
typedef float f32x2 __attribute__((ext_vector_type(2)));
constexpr int P8_NSL = 8, P8_SLC = DM / P8_NSL, P8_KS = P8_SLC / 32;
constexpr float P8_XS = 32.f;
static_assert(P8_SLC == 128, "lane mappings assume 128-column (128-byte) slices");
__device__ __forceinline__ void phase8(const Params& p, Ctx& F, const XcdBarrier& bar) {
    const bool pace = false;
    unsigned char* ws = p.ws;
    const unsigned char* uq = ws + WS_UB; const unsigned char* vq = ws + WS_VB;
    const float* rsu = (const float*)(ws + WS_RSU); const float* rsv = (const float*)(ws + WS_RSV);
    const bf16_t* x1b = (const bf16_t*)(ws + WS_X1B);
    const float* rowsq = (const float*)(ws + WS_CTL) + CW_ROWSQ;
    const float* gwi = (const float*)(ws + WS_GW);
    float* out = p.out;
    const int lane = F.lane, fr = lane & 15, fq = lane >> 4;
    LAS unsigned short* IDX = (LAS unsigned short*)(F.lds + F.wave * 20480);
    LAS float* COEF = (LAS float*)(F.lds + F.wave * 20480 + 4096);
    LAS unsigned char* STG = (LAS unsigned char*)COEF;
    LAS unsigned char* CAND = STG + 2048;
    __syncthreads();
    p7_cand_table(CAND, lane);
    LDS_WAIT(); __builtin_amdgcn_wave_barrier();
    for (int task = F.gw; task < TOK / 16; task += F.ngw) {
        const size_t t0 = (size_t)task * 16;
#if defined(PROBE_PHASE) && PROBE_PHASE == 82
        F.ta = __builtin_amdgcn_s_memrealtime();
#endif
        route16((const bf16_t*)(ws + WS_QP), rowsq, (float*)(ws + WS_GW), t0, lane, (LAS unsigned*)STG, CAND, IDX);
#if defined(PROBE_PHASE) && PROBE_PHASE == 82
        F.tb = __builtin_amdgcn_s_memrealtime();
#endif
        const float r2 = rsqrtf(rowsq[t0 + fr] * (1.f / DM) + EPSN);
        VM_WAIT(); LDS_WAIT(); __builtin_amdgcn_wave_barrier();
#if defined(PROBE_PHASE) && (PROBE_PHASE == 80 || PROBE_PHASE == 81)
        F.ta = __builtin_amdgcn_s_memrealtime();
#endif
        f32x4 accU[8];
#pragma unroll
        for (int h = 0; h < 8; ++h) accU[h] = (f32x4){0.f, 0.f, 0.f, 0.f};
        const int lrow = lane >> 3, lch = lane & 7;
        const int wofs0 = lrow * 128 + ((lch ^ (lrow & 7)) << 4), wofs1 = wofs0 + 1024;
        const float xsc = r2 * P8_XS;
#ifdef U_FP4
        typedef int v8i __attribute__((ext_vector_type(8)));
        int rofs4[2];
#pragma unroll
        for (int m = 0; m < 2; ++m) rofs4[m] = fr * 128 + (((4 * m + fq) ^ (fr & 7)) << 4);
#pragma unroll 1
        for (int sl = 0; sl < 4; ++sl) {
            v8i xf[2];
#pragma unroll
            for (int m = 0; m < 2; ++m) {
                const bf16_t* xp = x1b + (t0 + fr) * DM + sl * 256 + 128 * m + 16 * fq;
#pragma unroll
                for (int q = 0; q < 4; ++q) {
                    const u32x4 xv = *(const u32x4*)(xp + 64 * (q >> 1) + 8 * (q & 1));
                    int lo = 0, hi = 0;
                    lo = __builtin_amdgcn_cvt_pk_fp8_f32(bf2f(xv[0] & 0xffffu) * xsc, bf2f(xv[0] >> 16) * xsc, lo, false);
                    lo = __builtin_amdgcn_cvt_pk_fp8_f32(bf2f(xv[1] & 0xffffu) * xsc, bf2f(xv[1] >> 16) * xsc, lo, true);
                    hi = __builtin_amdgcn_cvt_pk_fp8_f32(bf2f(xv[2] & 0xffffu) * xsc, bf2f(xv[2] >> 16) * xsc, hi, false);
                    hi = __builtin_amdgcn_cvt_pk_fp8_f32(bf2f(xv[3] & 0xffffu) * xsc, bf2f(xv[3] >> 16) * xsc, hi, true);
                    xf[m][2 * q] = lo; xf[m][2 * q + 1] = hi;
                }
            }
            const unsigned char* ubs = uq + sl * 128 + lch * 16;
#pragma unroll 1
            for (int j0 = 0; j0 < 16; ++j0) {
                const bool mine = (fr == j0);
                v8i bm[2];
#pragma unroll
                for (int m = 0; m < 2; ++m)
#pragma unroll
                    for (int q = 0; q < 8; ++q) bm[m][q] = mine ? xf[m][q] : 0;
                u32x4 g0[8], g1[8];
#pragma unroll
                for (int h = 0; h < 8; ++h) {
                    const unsigned e0 = IDX[j0 * 128 + h * 16 + lrow], e1 = IDX[j0 * 128 + h * 16 + lrow + 8];
                    g0[h] = *(const u32x4*)(ubs + (size_t)e0 * (DM / 2));
                    g1[h] = *(const u32x4*)(ubs + (size_t)e1 * (DM / 2));
                }
#pragma unroll
                for (int hg = 0; hg < 2; ++hg) {
#pragma unroll
                    for (int h = 0; h < 4; ++h) {
                        *(LAS u32x4*)(STG + h * 2048 + wofs0) = g0[hg * 4 + h];
                        *(LAS u32x4*)(STG + h * 2048 + wofs1) = g1[hg * 4 + h];
                    }
                    __builtin_amdgcn_wave_barrier();
#pragma unroll
                    for (int h = 0; h < 4; ++h)
#pragma unroll
                        for (int m = 0; m < 2; ++m) {
                            const u32x4 a16 = *(const LAS u32x4*)(STG + h * 2048 + rofs4[m]);
                            const v8i av = {(int)a16.x, (int)a16.y, (int)a16.z, (int)a16.w, 0, 0, 0, 0};
                            accU[hg * 4 + h] = __builtin_amdgcn_mfma_scale_f32_16x16x128_f8f6f4(av, bm[m], accU[hg * 4 + h], 4, 0, 0, 0, 0, 0);
                        }
                    __builtin_amdgcn_wave_barrier();
                }
            }
        }
#else
        int rofs[P8_KS];
#pragma unroll
        for (int ks = 0; ks < P8_KS; ++ks) rofs[ks] = fr * 128 + (((2 * ks + (fq >> 1)) ^ (fr & 7)) << 4) + (fq & 1) * 8;
#pragma unroll 1
        for (int sl = 0; sl < P8_NSL; ++sl) {
            if (pace) xcd_pace(bar, sl);
            long xf[P8_KS];
#pragma unroll
            for (int ks = 0; ks < P8_KS; ++ks) {
                const u32x4 xv = *(const u32x4*)(x1b + (t0 + fr) * DM + sl * P8_SLC + ks * 32 + 8 * fq);
                int lo = 0, hi = 0;
                lo = __builtin_amdgcn_cvt_pk_fp8_f32(bf2f(xv[0] & 0xffffu) * xsc, bf2f(xv[0] >> 16) * xsc, lo, false);
                lo = __builtin_amdgcn_cvt_pk_fp8_f32(bf2f(xv[1] & 0xffffu) * xsc, bf2f(xv[1] >> 16) * xsc, lo, true);
                hi = __builtin_amdgcn_cvt_pk_fp8_f32(bf2f(xv[2] & 0xffffu) * xsc, bf2f(xv[2] >> 16) * xsc, hi, false);
                hi = __builtin_amdgcn_cvt_pk_fp8_f32(bf2f(xv[3] & 0xffffu) * xsc, bf2f(xv[3] >> 16) * xsc, hi, true);
                xf[ks] = (long)(((unsigned long long)(unsigned)hi << 32) | (unsigned long long)(unsigned)lo);
            }
            const unsigned char* ubs = uq + sl * P8_SLC + lch * 16;
#pragma unroll 1
            for (int j0 = 0; j0 < 16; ++j0) {
                const bool mine = (fr == j0);
                long bm[P8_KS];
#pragma unroll
                for (int ks = 0; ks < P8_KS; ++ks) bm[ks] = mine ? xf[ks] : 0l;
                u32x4 g0[8], g1[8];
#pragma unroll
                for (int h = 0; h < 8; ++h) {
                    const unsigned e0 = IDX[j0 * 128 + h * 16 + lrow], e1 = IDX[j0 * 128 + h * 16 + lrow + 8];
                    g0[h] = *(const u32x4*)(ubs + (size_t)e0 * DM);
                    g1[h] = *(const u32x4*)(ubs + (size_t)e1 * DM);
                }
#pragma unroll
                for (int hg = 0; hg < 2; ++hg) {
#pragma unroll
                    for (int h = 0; h < 4; ++h) {
                        *(LAS u32x4*)(STG + h * 2048 + wofs0) = g0[hg * 4 + h];
                        *(LAS u32x4*)(STG + h * 2048 + wofs1) = g1[hg * 4 + h];
                    }
                    __builtin_amdgcn_wave_barrier();
#pragma unroll
                    for (int h = 0; h < 4; ++h)
#pragma unroll
                        for (int ks = 0; ks < P8_KS; ++ks) {
                            const long a = *(const LAS long*)(STG + h * 2048 + rofs[ks]);
                            accU[hg * 4 + h] = __builtin_amdgcn_mfma_f32_16x16x32_fp8_fp8(a, bm[ks], accU[hg * 4 + h], 0, 0, 0);
                        }
                    __builtin_amdgcn_wave_barrier();
                }
            }
        }
#endif
        LDS_WAIT(); __builtin_amdgcn_wave_barrier();
#pragma unroll
        for (int h = 0; h < 8; ++h) {
            const f32x4 gv = *(const f32x4*)(gwi + (t0 + fr) * 128 + h * 16 + 4 * fq);
#pragma unroll
            for (int jj = 0; jj < 4; ++jj) {
                const int slot = h * 16 + 4 * fq + jj;
                const unsigned e = IDX[fr * 128 + slot];
                const float hv = accU[h][jj] * rsu[e] * (1.f / P8_XS);
                COEF[fr * 128 + slot] = gv[jj] * gelu_erf(hv) * rsv[e];
            }
        }
        LDS_WAIT(); __builtin_amdgcn_wave_barrier();
#if defined(PROBE_PHASE) && (PROBE_PHASE == 80 || PROBE_PHASE == 81)
        F.tb = __builtin_amdgcn_s_memrealtime();
#endif
#ifdef V_VALU
        const int sub = lane & 7, rg = lane >> 3;
#pragma unroll 1
        for (int sl = 0; sl < P8_NSL; ++sl) {
            const unsigned char* vbs = vq + sl * P8_SLC + sub * 16;
#pragma unroll 1
            for (int j0 = 0; j0 < 16; ++j0) {
                f32x2 acc[8];
#pragma unroll
                for (int q = 0; q < 8; ++q) acc[q] = (f32x2){0.f, 0.f};
#pragma unroll
                for (int ib = 0; ib < 2; ++ib) {
                    u32x4 w[8]; float cf[8];
#pragma unroll
                    for (int it = 0; it < 8; ++it) {
                        const int slot = (ib * 8 + it) * 8 + rg;
                        const unsigned e = IDX[j0 * 128 + slot];
                        cf[it] = COEF[j0 * 128 + slot];
                        w[it] = *(const u32x4*)(vbs + (size_t)e * DM);
                    }
#pragma unroll
                    for (int it = 0; it < 8; ++it)
#pragma unroll
                        for (int q = 0; q < 4; ++q) {
                            acc[2 * q] += __builtin_amdgcn_cvt_pk_f32_fp8((int)w[it][q], false) * cf[it];
                            acc[2 * q + 1] += __builtin_amdgcn_cvt_pk_f32_fp8((int)w[it][q], true) * cf[it];
                        }
                }
#pragma unroll
                for (int q = 0; q < 8; ++q) {
                    acc[q].x += __shfl_xor(acc[q].x, 8); acc[q].y += __shfl_xor(acc[q].y, 8);
                    acc[q].x += __shfl_xor(acc[q].x, 16); acc[q].y += __shfl_xor(acc[q].y, 16);
                    acc[q].x += __shfl_xor(acc[q].x, 32); acc[q].y += __shfl_xor(acc[q].y, 32);
                }
                if (rg == 0) {
                    float* orow = out + (t0 + j0) * DM + sl * P8_SLC + sub * 16;
                    const bf16_t* xrow = x1b + (t0 + j0) * DM + sl * P8_SLC + sub * 16;
#pragma unroll
                    for (int q = 0; q < 4; ++q) {
                        const u32x2 xv = *(const u32x2*)(xrow + 4 * q);
                        f32x4 o = {bf2f(xv.x & 0xffffu), bf2f(xv.x >> 16), bf2f(xv.y & 0xffffu), bf2f(xv.y >> 16)};
                        o[0] += acc[2 * q].x; o[1] += acc[2 * q].y; o[2] += acc[2 * q + 1].x; o[3] += acc[2 * q + 1].y;
                        *(f32x4*)(orow + 4 * q) = o;
                    }
                }
            }
        }
#elif defined(V_FP4)
        typedef int v2i __attribute__((ext_vector_type(2)));
        typedef int v8i __attribute__((ext_vector_type(8)));
        v8i cq8; float inv_cs;
        {
            f32x4 cv[2][4]; float cmax = 0.f;
#pragma unroll
            for (int hf = 0; hf < 2; ++hf)
#pragma unroll
                for (int q = 0; q < 4; ++q) {
                    cv[hf][q] = *(const LAS f32x4*)(COEF + fr * 128 + hf * 64 + 16 * fq + 4 * q);
                    cmax = fmaxf(cmax, fmaxf(fmaxf(fabsf(cv[hf][q][0]), fabsf(cv[hf][q][1])), fmaxf(fabsf(cv[hf][q][2]), fabsf(cv[hf][q][3]))));
                }
            cmax = fmaxf(cmax, __shfl_xor(cmax, 16)); cmax = fmaxf(cmax, __shfl_xor(cmax, 32));
            const float cs = cmax > 0.f ? 240.f / cmax : 1.f; inv_cs = cmax > 0.f ? cmax * (1.f / 240.f) : 1.f;
#pragma unroll
            for (int hf = 0; hf < 2; ++hf)
#pragma unroll
                for (int q = 0; q < 4; ++q) {
                    int pk = 0;
                    pk = __builtin_amdgcn_cvt_pk_fp8_f32(cv[hf][q][0] * cs, cv[hf][q][1] * cs, pk, false);
                    pk = __builtin_amdgcn_cvt_pk_fp8_f32(cv[hf][q][2] * cs, cv[hf][q][3] * cs, pk, true);
                    cq8[hf * 4 + q] = pk;
                }
        }
        LDS_WAIT(); __builtin_amdgcn_wave_barrier();
        int vwofs[16];
#pragma unroll
        for (int i = 0; i < 16; ++i) { const int rr = lrow + 8 * i; vwofs[i] = rr * 128 + ((lch ^ ((rr >> 1) & 7)) << 4); }
        int vrow_[2], vsw_[2];
#pragma unroll
        for (int t = 0; t < 2; ++t) { vrow_[t] = 32 * fq + 16 * t + fr; vsw_[t] = (vrow_[t] >> 1) & 7; }
#pragma unroll 1
        for (int sl = 0; sl < 4; ++sl) {
            f32x4 accV[16];
#pragma unroll
            for (int ct = 0; ct < 16; ++ct) accV[ct] = (f32x4){0.f, 0.f, 0.f, 0.f};
            const unsigned char* vbs = vq + sl * 128 + lch * 16;
#pragma unroll 1
            for (int j0 = 0; j0 < 16; ++j0) {
                const bool mine = (fr == j0);
                u32x4 g[16];
#pragma unroll
                for (int i = 0; i < 16; ++i) {
                    const unsigned e = IDX[j0 * 128 + lrow + 8 * i];
                    g[i] = *(const u32x4*)(vbs + (size_t)e * (DM / 2));
                }
#pragma unroll
                for (int i = 0; i < 16; ++i) *(LAS u32x4*)(STG + vwofs[i]) = g[i];
                __builtin_amdgcn_wave_barrier();
                v8i bmq;
#pragma unroll
                for (int q = 0; q < 8; ++q) bmq[q] = mine ? cq8[q] : 0;
#pragma unroll
                for (int ct = 0; ct < 16; ++ct) {
                    const v2i r0 = __builtin_amdgcn_ds_read_tr4_b64_v2i32((LAS v2i*)(STG + vrow_[0] * 128 + (((ct >> 1) ^ vsw_[0]) << 4) + (ct & 1) * 8));
                    const v2i r1 = __builtin_amdgcn_ds_read_tr4_b64_v2i32((LAS v2i*)(STG + vrow_[1] * 128 + (((ct >> 1) ^ vsw_[1]) << 4) + (ct & 1) * 8));
                    const v8i av = {r0.x, r0.y, r1.x, r1.y, 0, 0, 0, 0};
                    accV[ct] = __builtin_amdgcn_mfma_scale_f32_16x16x128_f8f6f4(av, bmq, accV[ct], 4, 0, 0, 0, 0, 0);
                }
                __builtin_amdgcn_wave_barrier();
            }
            float* orow = out + (t0 + fr) * DM + sl * 256 + 4 * fq;
            const bf16_t* xrow = x1b + (t0 + fr) * DM + sl * 256 + 4 * fq;
#pragma unroll
            for (int ct = 0; ct < 16; ++ct) {
                const u32x2 xv = *(const u32x2*)(xrow + ct * 16);
                f32x4 o = {bf2f(xv.x & 0xffffu), bf2f(xv.x >> 16), bf2f(xv.y & 0xffffu), bf2f(xv.y >> 16)};
                o += accV[ct] * inv_cs;
                __builtin_nontemporal_store(o, (f32x4*)(orow + ct * 16));
            }
        }
#else
        typedef int v2i __attribute__((ext_vector_type(2)));
        long cq[4]; float inv_cs;
        {
            f32x4 cv[4][2]; float cmax = 0.f;
#pragma unroll
            for (int kk = 0; kk < 4; ++kk)
#pragma unroll
                for (int q = 0; q < 2; ++q) {
                    cv[kk][q] = *(const LAS f32x4*)(COEF + fr * 128 + kk * 32 + 8 * fq + 4 * q);
                    cmax = fmaxf(cmax, fmaxf(fmaxf(fabsf(cv[kk][q][0]), fabsf(cv[kk][q][1])), fmaxf(fabsf(cv[kk][q][2]), fabsf(cv[kk][q][3]))));
                }
            cmax = fmaxf(cmax, __shfl_xor(cmax, 16)); cmax = fmaxf(cmax, __shfl_xor(cmax, 32));
            const float cs = cmax > 0.f ? 240.f / cmax : 1.f; inv_cs = cmax > 0.f ? cmax * (1.f / 240.f) : 1.f;
#pragma unroll
            for (int kk = 0; kk < 4; ++kk) {
                int lo = 0, hi = 0;
                lo = __builtin_amdgcn_cvt_pk_fp8_f32(cv[kk][0][0] * cs, cv[kk][0][1] * cs, lo, false);
                lo = __builtin_amdgcn_cvt_pk_fp8_f32(cv[kk][0][2] * cs, cv[kk][0][3] * cs, lo, true);
                hi = __builtin_amdgcn_cvt_pk_fp8_f32(cv[kk][1][0] * cs, cv[kk][1][1] * cs, hi, false);
                hi = __builtin_amdgcn_cvt_pk_fp8_f32(cv[kk][1][2] * cs, cv[kk][1][3] * cs, hi, true);
                cq[kk] = (long)(((unsigned long long)(unsigned)hi << 32) | (unsigned long long)(unsigned)lo);
            }
        }
        LDS_WAIT(); __builtin_amdgcn_wave_barrier();
        const int vrow = 8 * fq + (fr >> 1);
        const int vrd0 = vrow * 128 + (fr & 1) * 8, vsw = (vrow >> 1) & 7;
        int vwofs[4];
#pragma unroll
        for (int i = 0; i < 4; ++i) { const int rr = lrow + 8 * i; vwofs[i] = rr * 128 + ((lch ^ ((rr >> 1) & 7)) << 4); }
#pragma unroll 1
        for (int sl = 0; sl < P8_NSL; ++sl) {
            if (pace) xcd_pace(bar, P8_NSL + sl);
            f32x4 accV[8];
#pragma unroll
            for (int ct = 0; ct < 8; ++ct) accV[ct] = (f32x4){0.f, 0.f, 0.f, 0.f};
            const unsigned char* vbs = vq + sl * P8_SLC + lch * 16;
#pragma unroll 1
            for (int j0 = 0; j0 < 16; ++j0) {
                const bool mine = (fr == j0);
                u32x4 g[4][4];
#pragma unroll
                for (int kk = 0; kk < 4; ++kk)
#pragma unroll
                    for (int i = 0; i < 4; ++i) {
                        const unsigned e = IDX[j0 * 128 + kk * 32 + lrow + 8 * i];
                        g[kk][i] = *(const u32x4*)(vbs + (size_t)e * DM);
                    }
#pragma unroll
                for (int kk = 0; kk < 4; ++kk) {
                    LAS unsigned char* T = STG + (kk & 1) * 4096;
#pragma unroll
                    for (int i = 0; i < 4; ++i) *(LAS u32x4*)(T + vwofs[i]) = g[kk][i];
                    __builtin_amdgcn_wave_barrier();
                    const long bmq = mine ? cq[kk] : 0l;
#pragma unroll
                    for (int ct = 0; ct < 8; ++ct) {
                        const v2i av = __builtin_amdgcn_ds_read_tr8_b64_v2i32((LAS v2i*)(T + vrd0 + ((ct ^ vsw) << 4)));
                        const long a = (long)(((unsigned long long)(unsigned)av.y << 32) | (unsigned long long)(unsigned)av.x);
                        accV[ct] = __builtin_amdgcn_mfma_f32_16x16x32_fp8_fp8(a, bmq, accV[ct], 0, 0, 0);
                    }
                    __builtin_amdgcn_wave_barrier();
                }
            }
            float* orow = out + (t0 + fr) * DM + sl * P8_SLC + 4 * fq;
            const bf16_t* xrow = x1b + (t0 + fr) * DM + sl * P8_SLC + 4 * fq;
#pragma unroll
            for (int ct = 0; ct < 8; ++ct) {
                const u32x2 xv = *(const u32x2*)(xrow + ct * 16);
                f32x4 o = {bf2f(xv.x & 0xffffu), bf2f(xv.x >> 16), bf2f(xv.y & 0xffffu), bf2f(xv.y >> 16)};
                o += accV[ct] * inv_cs;
                __builtin_nontemporal_store(o, (f32x4*)(orow + ct * 16));
            }
        }
#endif
#if defined(PROBE_PHASE) && PROBE_PHASE >= 80
        F.tc = __builtin_amdgcn_s_memrealtime();
#endif
        LDS_WAIT(); __builtin_amdgcn_wave_barrier();
    }
}

constexpr int NPHASE = 9;
#ifndef N_LAUNCHES
#define N_LAUNCHES 1
#endif
constexpr int MISC_OFF = LDS_BYTES - 128;
__global__ void __launch_bounds__(512, 2) fwd_kernel(Params p) {
    extern __shared__ __attribute__((aligned(16))) unsigned char lds_raw[];
    Ctx F; F.ta = F.tb = F.tc = 0;
    F.lds = (LAS unsigned char*)lds_raw;
    F.tid = threadIdx.x; F.lane = F.tid & 63; F.wave = __builtin_amdgcn_readfirstlane(F.tid >> 6);
    F.G = gridDim.x; { const int bx = blockIdx.x; F.vcu = (F.G % 8 == 0) ? (bx % 8) * (F.G / 8) + bx / 8 : bx; }
    F.gw = F.vcu * 8 + F.wave; F.ngw = F.G * 8;
    unsigned char* ws = p.ws;
    const int lo = p.ph_lo, hi = p.ph_hi;
    volatile LAS unsigned* MISC = (volatile LAS unsigned*)(F.lds + MISC_OFF);
    if (F.tid < 32) MISC[F.tid] = 0u;
    __syncthreads();
#ifdef CG_FIRST_SYNC
    XcdBarrier bar; bar.bar = (unsigned*)(ws + WS_CTL) + CW_BAR; bar.x = 0; bar.st = MISC + 8;
    for (int i = blockIdx.x * 512 + F.tid; i < XCD_BAR_WORDS + PACE_WORDS; i += F.G * 512) __hip_atomic_store(bar.bar + i, 0u, __ATOMIC_RELAXED, __HIP_MEMORY_SCOPE_AGENT);
#else
    XcdBarrier bar = xcd_barrier_post((unsigned*)(ws + WS_CTL) + CW_BAR, MISC + 8);
#endif
#ifdef ONLY_PHASE
#define IN(k) ((k)==ONLY_PHASE)
#else
#define IN(k) (lo <= (k) && (k) < hi)
#endif
#ifdef PROBE_PHASE
    unsigned long long tp0 = __builtin_amdgcn_s_memrealtime(), tp1 = 0; const unsigned long long tstart = tp0;
#define PSTAMP(k) do { if ((k) + 1 == PROBE_PHASE) tp0 = __builtin_amdgcn_s_memrealtime(); if ((k) == PROBE_PHASE) tp1 = __builtin_amdgcn_s_memrealtime(); } while (0)
#else
#define PSTAMP(k) do {} while (0)
#endif
#define SEAM(k) do { if (IN(k) && ((k) == 6 ? IN(8) : IN((k) + 1))) xcd_barrier(bar); PSTAMP(k); } while (0)
    if (IN(0)) phase0(p, F);
#ifdef CG_FIRST_SYNC
    if (IN(0) && IN(1)) { cooperative_groups::this_grid().sync(); bar = xcd_barrier_post((unsigned*)(ws + WS_CTL) + CW_BAR, MISC + 8); }
    PSTAMP(0);
#else
    SEAM(0);
#endif
    if (IN(1)) {
        pg8::Gemm g{(const pg8::bf16_t*)(ws + WS_XB), (const pg8::bf16_t*)(ws + WS_WINT), TOK, NIN, DM};
        pg8::StaticOrder S; S.init(TOK, NIN, F.G, (int)blockIdx.x);
        pg8::EpiProj E{(pg8::bf16_t*)(ws + WS_PROJ), NIN, p.in[9], p.in[10], (const float*)(ws + WS_ROPE), (const float*)(ws + WS_ROPE) + SEQ * 8,
                       (LAS float*)(F.lds + pg8::STAGE_BYTES), PQ, PK, PV, SEQ - 1, EPSN};
        pg8::gemm_phase<pg8::EpiProj, pg8::StaticOrder, true, true>(F.lds, g, S, E);
    }
    SEAM(1);
    if (IN(2)) phase2(p, F);
    SEAM(2);
#if defined(PROBE_PHASE) && PROBE_PHASE == 84
    const unsigned long long t3s = __builtin_amdgcn_s_memrealtime();
#endif
    if (IN(3)) phase3(p, F);
#if defined(PROBE_PHASE) && PROBE_PHASE == 84
    { const unsigned long long tend = __builtin_amdgcn_s_memrealtime();
      if (F.tid == 0) { unsigned* mw = (unsigned*)(ws + WS_MISC); const unsigned d = (unsigned)(tend - t3s); atomicMax(mw + 2, d); atomicMin(mw + 3, d); atomicAdd(mw + 4, d >> 8); } }
#endif
    SEAM(3);
    if (IN(4)) phase4(p, F);
    SEAM(4);
    if (IN(5)) {
        pg8::Gemm g{(const pg8::bf16_t*)(ws + WS_YCAT), (const pg8::bf16_t*)(ws + WS_WOUTT), TOK, DM, DM};
        pg8::StaticOrder S; S.init(TOK, DM, F.G, (int)blockIdx.x);
        pg8::EpiResid E{p.in[0], p.out, (pg8::bf16_t*)(ws + WS_X1B), (float*)(ws + WS_CTL) + CW_ROWSQ, DM};
        pg8::gemm_phase<pg8::EpiResid, pg8::StaticOrder, true, true>(F.lds, g, S, E);
    }
    SEAM(5);
    if (IN(6)) {
        pg8::Gemm g{(const pg8::bf16_t*)(ws + WS_X1B), (const pg8::bf16_t*)(ws + WS_WQT), TOK, 2048, DM};
        pg8::StaticOrder S; S.init(TOK, 2048, F.G, (int)blockIdx.x);
        pg8::EpiBf16<0> E{(pg8::bf16_t*)(ws + WS_QP), 2048, nullptr, 0, 0, 1.f};
        pg8::gemm_phase<pg8::EpiBf16<0>, pg8::StaticOrder, true, true>(F.lds, g, S, E);
    }
    SEAM(6);
    PSTAMP(7);
#if defined(PROBE_PHASE) && PROBE_PHASE == 83
    tp0 = __builtin_amdgcn_s_memrealtime();
#endif
#ifdef PROBE_PHASE
    const unsigned sv_nloc = MISC[8], sv_nx = MISC[9];
#endif
    if (IN(8)) phase8(p, F, bar);
#ifdef PROBE_PHASE
    __syncthreads(); if (F.tid == 0) { MISC[8] = sv_nloc; MISC[9] = sv_nx; } __syncthreads();
#endif
#if defined(PROBE_PHASE) && PROBE_PHASE == 83
    {
        const unsigned long long tend = __builtin_amdgcn_s_memrealtime();
        if (F.tid == 0) { unsigned* mw = (unsigned*)(ws + WS_MISC); const unsigned d = (unsigned)(tend - tp0);
            atomicMax(mw + 2, d); atomicMin(mw + 3, d); atomicAdd(mw + 4, d >> 8); }
    }
#endif
#ifdef PROBE_PHASE
    xcd_barrier(bar);
    PSTAMP(8);
#if PROBE_PHASE == 83 || PROBE_PHASE == 84
    { const unsigned* mw = (const unsigned*)(ws + WS_MISC);
      const unsigned vmax = __hip_atomic_load(mw + 2, __ATOMIC_RELAXED, __HIP_MEMORY_SCOPE_AGENT), vmin = __hip_atomic_load(mw + 3, __ATOMIC_RELAXED, __HIP_MEMORY_SCOPE_AGENT), vsum = __hip_atomic_load(mw + 4, __ATOMIC_RELAXED, __HIP_MEMORY_SCOPE_AGENT);
      tp0 = 0; tp1 = PROBE_SUB == 0 ? vmax : (PROBE_SUB == 1 ? vmin : (unsigned)(((unsigned long long)vsum << 8) / gridDim.x)); }
#elif PROBE_PHASE == 9
    tp0 = tstart; tp1 = __builtin_amdgcn_s_memrealtime();
#elif PROBE_PHASE == 80 || PROBE_PHASE == 20 || PROBE_PHASE == 30 || PROBE_PHASE == 82
    tp0 = F.ta; tp1 = F.tb;
#elif PROBE_PHASE == 81 || PROBE_PHASE == 21 || PROBE_PHASE == 31
    tp0 = F.tb; tp1 = F.tc;
#endif
#if PROBE_PHASE == 98
    {
        typedef int v2i __attribute__((ext_vector_type(2)));
        float result = 0.f;
        __syncthreads();
        if (blockIdx.x == 0 && F.wave == 0) {
            LAS unsigned char* T = (LAS unsigned char*)F.lds;
            if (F.lane < 16) {
                unsigned long long w = 0ull;
                for (int c = 0; c < 16; ++c) { const unsigned long long nib = (PROBE_SUB == 0) ? (unsigned long long)F.lane : (unsigned long long)c; w |= nib << (4 * c); }
                *(LAS unsigned long long*)(T + F.lane * 8) = w;
            }
            LDS_WAIT(); __builtin_amdgcn_wave_barrier();
            const v2i rv_ = __builtin_amdgcn_ds_read_tr4_b64_v2i32((LAS v2i*)(T + (F.lane & 15) * 8));
            const unsigned long long got = ((unsigned long long)(unsigned)rv_.y << 32) | (unsigned long long)(unsigned)rv_.x;
            unsigned long long want = 0ull;
            for (int j = 0; j < 16; ++j) { const unsigned long long nib = (PROBE_SUB == 0) ? (unsigned long long)j : (unsigned long long)(F.lane & 15); want |= nib << (4 * j); }
            const unsigned long long bal = __ballot(got == want);
            result = (float)__popcll(bal);
        }
        if (blockIdx.x == 0 && F.tid == 0) { VM_WAIT(); p.out[0] += result; }
    }
#elif PROBE_PHASE == 99
    {
        typedef int v8i __attribute__((ext_vector_type(8)));
        float result = 0.f;
        if (blockIdx.x == 0 && F.wave == 0) {
            const int fr_ = F.lane & 15, fq_ = F.lane >> 4;
            v8i bv;
#pragma unroll
            for (int q = 0; q < 8; ++q) { unsigned w = 0; for (int bb = 0; bb < 4; ++bb) { unsigned pcode = (unsigned)(32 * fq_ + 4 * q + bb); if (pcode == 127u) pcode = 126u; w |= pcode << (8 * bb); } bv[q] = (int)w; }
            int matches = 0, firstbad = -1, firstbadval = -1;
            for (int ga = 0; ga < 4; ++ga)
                for (int ja = 0; ja < 32; ++ja) {
                    v8i av = {0, 0, 0, 0, 0, 0, 0, 0};
                    if (fr_ == 0 && fq_ == ga) { const unsigned nib = 2u << (4 * (ja & 7)); const int wsel = ja >> 3;
                        av[0] = wsel == 0 ? (int)nib : 0; av[1] = wsel == 1 ? (int)nib : 0; av[2] = wsel == 2 ? (int)nib : 0; av[3] = wsel == 3 ? (int)nib : 0; }
                    f32x4 c = {0.f, 0.f, 0.f, 0.f};
                    c = __builtin_amdgcn_mfma_scale_f32_16x16x128_f8f6f4(av, bv, c, 4, 0, 0, 0, 0, 0);
                    int pk = 0; pk = __builtin_amdgcn_cvt_pk_fp8_f32(c[0], 0.f, pk, false);
                    const int got = __shfl(pk & 255, 0);
                    int want = 32 * ga + ja; if (want == 127) want = 126;
                    if (got == want) ++matches; else if (firstbad < 0) { firstbad = 32 * ga + ja; firstbadval = got; }
                }
#if PROBE_SUB == 0
            result = (float)matches;
#elif PROBE_SUB == 1
            result = (float)firstbad;
#else
            result = (float)firstbadval;
#endif
        }
        if (blockIdx.x == 0 && F.tid == 0) { VM_WAIT(); p.out[0] += result; }
    }
#else
    if (blockIdx.x == 0 && F.tid == 0) { VM_WAIT(); p.out[0] += (float)(tp1 - tp0) * (1.0f / (float)(PROBE_DIV)); }
#endif
#endif
#undef IN
#undef SEAM
}

extern "C" void kernel_launch(void* const* d_in, const int* in_sizes, int n_in, void* d_out, int out_size, void* d_ws, size_t ws_size, hipStream_t stream) {
    static int grid = 0;
    if (grid == 0) {
        if (n_in != 22 || in_sizes[0] != TOK * DM || out_size != TOK * DM || ws_size < WS_END) {
            fprintf(stderr, "kernel_launch: unexpected shapes: n_in %d in0 %d out %d ws %zu\n", n_in, n_in > 0 ? in_sizes[0] : -1, out_size, ws_size); grid = -1; return; }
        if (hipFuncSetAttribute((const void*)fwd_kernel, hipFuncAttributeMaxDynamicSharedMemorySize, LDS_BYTES) != hipSuccess) { fprintf(stderr, "kernel_launch: hipFuncSetAttribute failed\n"); grid = -1; return; }
        int dev = 0, cus = 0, per_cu = 0;
        if (hipGetDevice(&dev) != hipSuccess || hipDeviceGetAttribute(&cus, hipDeviceAttributeMultiprocessorCount, dev) != hipSuccess) { grid = -1; return; }
        if (hipOccupancyMaxActiveBlocksPerMultiprocessor(&per_cu, (const void*)fwd_kernel, 512, LDS_BYTES) != hipSuccess || per_cu < 1) { fprintf(stderr, "kernel_launch: occupancy query failed (%d)\n", per_cu); (void)hipGetLastError(); per_cu = 1; }
        grid = cus * (per_cu > 1 ? 1 : per_cu);
    }
    if (grid < 0) return;
#ifndef CG_FIRST_SYNC
    (void)hipMemsetAsync((char*)d_ws + WS_CTL + (size_t)CW_BAR * 4, 0, (size_t)(XCD_BAR_WORDS + PACE_WORDS) * 4, stream);
#endif
    Params a{};
    for (int i = 0; i < 22; ++i) a.in[i] = (const float*)d_in[i];
    a.out = (float*)d_out; a.ws = (unsigned char*)d_ws;
#if N_LAUNCHES == 1
    a.ph_lo = 0; a.ph_hi = NPHASE;
#ifdef USE_COOP_LAUNCH
    { void* args[] = {&a};
      hipError_t e = hipLaunchCooperativeKernel((const void*)fwd_kernel, dim3(grid), dim3(512), args, LDS_BYTES, stream);
      if (e != hipSuccess) fprintf(stderr, "kernel_launch: cooperative launch failed: %s (grid %d)\n", hipGetErrorString(e), grid); }
#else
    hipLaunchKernelGGL(fwd_kernel, dim3(grid), dim3(512), LDS_BYTES, stream, a);
#endif
#else
    for (int ph = 0; ph < NPHASE; ++ph) {
        a.ph_lo = ph; a.ph_hi = ph + 1;
        hipLaunchKernelGGL(fwd_kernel, dim3(grid), dim3(512), LDS_BYTES, stream, a);
    }
#endif
    const hipError_t le = hipPeekAtLastError();
    if (le != hipSuccess) fprintf(stderr, "kernel_launch: launch failed: %s\n", hipGetErrorName(le));
}
```

```cpp
#include <hip/hip_runtime.h>
#include <hip/hip_cooperative_groups.h>
#include <cstdio>
#include <cstdint>
#define USE_COOP_LAUNCH 1
#define U_FP4 1
#define V_FP4 1

#define LAS __attribute__((address_space(3)))
#define GAS __attribute__((address_space(1)))
typedef unsigned short bf16_t;
typedef short bf16x8 __attribute__((ext_vector_type(8)));
typedef short s16x4 __attribute__((ext_vector_type(4)));
typedef float f32x4 __attribute__((ext_vector_type(4)));
typedef float f32x8 __attribute__((ext_vector_type(8)));
typedef float f32x16 __attribute__((ext_vector_type(16)));
typedef unsigned u32x4 __attribute__((ext_vector_type(4)));
typedef unsigned u32x2 __attribute__((ext_vector_type(2)));

constexpr int NB = 8, SEQ = 4096, TOK = NB * SEQ, DM = 1024;
constexpr int NIN = 3072;
constexpr int PZ = 0, PXS = 512, PBM = 1024, PCM = 1280, PQ = 1536, PK = 2048, PV = 2560;
constexpr int CHUNK = 64, NCH = SEQ / CHUNK;
constexpr int NHS = 8;
constexpr float EPSN = 1e-6f;
constexpr int PEER_H = 8, NKEYS = 128, TOPK = 16;
constexpr float LAMBDA_INIT = 0.2f;

constexpr size_t MiB = 1u << 20;
constexpr size_t WS_CTL = 0, CTL_BYTES = 1 * MiB;
constexpr size_t WS_WINT = 1 * MiB;
constexpr size_t WS_WOUTT = 7 * MiB;
constexpr size_t WS_WQT = 9 * MiB;
constexpr size_t WS_KEYS = 13 * MiB;
constexpr size_t WS_ROPE = 13 * MiB + 512 * 1024;
constexpr size_t WS_MISC = 13 * MiB + 768 * 1024;
constexpr size_t WS_RSU = WS_MISC + 64 * 1024;
constexpr size_t WS_RSV = WS_MISC + 128 * 1024;
constexpr size_t WS_DTRAW = 14 * MiB;
constexpr size_t WS_ACS = 15 * MiB;
constexpr size_t WS_CDEC = 16 * MiB;
constexpr size_t WS_RSTD = 17 * MiB;
constexpr size_t WS_UB = 20 * MiB;
constexpr size_t WS_VB = 52 * MiB;
constexpr size_t WS_XB = 84 * MiB;
constexpr size_t WS_YCAT = 420 * MiB;
constexpr size_t WS_PROJ = 148 * MiB;
constexpr size_t WS_QP = WS_PROJ;
constexpr size_t WS_IDX = 276 * MiB;
constexpr size_t WS_GW = 292 * MiB;
constexpr size_t WS_CMC = 340 * MiB;
constexpr size_t WS_STATES = 356 * MiB;
constexpr size_t WS_X1B = WS_STATES;
constexpr size_t WS_END = 484 * MiB;
constexpr int CW_BAR = 4096;
constexpr int CW_ROWSQ = 131072;
static_assert((CW_ROWSQ + TOK) * 4 <= (int)CTL_BYTES, "ctl");

constexpr int PACE_WORDS = 32 * 16 * 16;
constexpr int LDS_BYTES = 163840;

__device__ __forceinline__ float bf2f(unsigned h) { return __uint_as_float(h << 16); }
typedef float f32x2_cv __attribute__((ext_vector_type(2)));
typedef __bf16 bf16x2_cv __attribute__((ext_vector_type(2)));
__device__ __forceinline__ unsigned pk2(float lo, float hi) { const f32x2_cv v = {lo, hi}; return __builtin_bit_cast(unsigned, __builtin_convertvector(v, bf16x2_cv)); }
__device__ __forceinline__ unsigned f2bf(float f) { return pk2(f, 0.f) & 0xffffu; }
#define DPP_F(v, ctrl) __builtin_bit_cast(float, __builtin_amdgcn_mov_dpp(__builtin_bit_cast(int, (v)), (ctrl), 0xf, 0xf, true))
__device__ __forceinline__ float wave_sum(float v) {
    v += DPP_F(v, 0xB1); v += DPP_F(v, 0x4E);
    v += DPP_F(v, 0x124); v += DPP_F(v, 0x128);
    { auto r = __builtin_amdgcn_permlane16_swap(__float_as_uint(v), __float_as_uint(v), false, false); v = __uint_as_float(r[0]) + __uint_as_float(r[1]); }
    { auto r = __builtin_amdgcn_permlane32_swap(__float_as_uint(v), __float_as_uint(v), false, false); v = __uint_as_float(r[0]) + __uint_as_float(r[1]); }
    return v;
}
__device__ __forceinline__ float wave_max(float v) {
    v = fmaxf(v, DPP_F(v, 0xB1)); v = fmaxf(v, DPP_F(v, 0x4E));
    v = fmaxf(v, DPP_F(v, 0x124)); v = fmaxf(v, DPP_F(v, 0x128));
    { auto r = __builtin_amdgcn_permlane16_swap(__float_as_uint(v), __float_as_uint(v), false, false); v = fmaxf(__uint_as_float(r[0]), __uint_as_float(r[1])); }
    { auto r = __builtin_amdgcn_permlane32_swap(__float_as_uint(v), __float_as_uint(v), false, false); v = fmaxf(__uint_as_float(r[0]), __uint_as_float(r[1])); }
    return v;
}
__device__ __forceinline__ float silu_f(float x) { return x * __builtin_amdgcn_rcpf(1.f + __expf(-x)); }
__device__ __forceinline__ f32x4 mfma16(bf16x8 a, bf16x8 b, f32x4 c) { return __builtin_amdgcn_mfma_f32_16x16x32_bf16(a, b, c, 0, 0, 0); }
__device__ __forceinline__ f32x16 mfma32(bf16x8 a, bf16x8 b, f32x16 c) { return __builtin_amdgcn_mfma_f32_32x32x16_bf16(a, b, c, 0, 0, 0); }
#define LDS_WAIT() asm volatile("s_waitcnt lgkmcnt(0)" ::: "memory")
#define VM_WAIT() asm volatile("s_waitcnt vmcnt(0)" ::: "memory")

#define XB_TMO      128
#define XB_XCNT(j)  (256  + 64 * (j))
#define XB_XSUB(j)  (1280 + 64 * (j))
#define XB_XGEN(j)  (2304 + 64 * (j))
#define XB_TOP      3328
#define XB_TOPGEN   3392
#define XCD_BAR_WORDS 3456
#define XB_SPIN_CAP (1u << 21)

__device__ __forceinline__ unsigned xb_ld(unsigned* p)              { return __hip_atomic_load(p, __ATOMIC_RELAXED, __HIP_MEMORY_SCOPE_AGENT); }
__device__ __forceinline__ unsigned xb_add(unsigned* p, unsigned v) { return __hip_atomic_fetch_add(p, v, __ATOMIC_RELAXED, __HIP_MEMORY_SCOPE_AGENT); }
__device__ __forceinline__ unsigned xb_xcc_id() { return (unsigned)__builtin_amdgcn_s_getreg((3 << 11) | 20) & 0xFu; }
#define XB_SPIN(cond, bar) do { unsigned _sp = 0; while (cond) { __builtin_amdgcn_s_sleep(1); \
    if ((++_sp & 255u) == 0u) { if (xb_ld(&(bar)[XB_TMO])) break; if (_sp > XB_SPIN_CAP) { atomicAdd(&(bar)[XB_TMO], 1u); break; } } } } while (0)

struct XcdBarrier {
    unsigned* bar; unsigned x;
    volatile LAS unsigned* st;
};

__device__ __forceinline__ XcdBarrier xcd_barrier_post(unsigned* bar, volatile LAS unsigned* st) {
    XcdBarrier b; b.bar = bar; b.x = xb_xcc_id(); b.st = st;
    if (threadIdx.x == 0) (void)xb_add(&bar[XB_XCNT(b.x)], 1u);
    return b;
}
__device__ __forceinline__ void xcd_barrier_complete(unsigned* bar, unsigned x, unsigned& nloc, unsigned& nx) {
    const unsigned G = gridDim.x * gridDim.y * gridDim.z;
    unsigned sum, cnt, mine, sp = 0u;
    for (;;) {
        sum = 0u; cnt = 0u; mine = 0u;
#pragma unroll
        for (unsigned j = 0; j < 16; ++j) { const unsigned c = xb_ld(&bar[XB_XCNT(j)]); sum += c; cnt += (c > 0u) ? 1u : 0u; mine = (j == x) ? c : mine; }
        if (sum == G) break;
        __builtin_amdgcn_s_sleep(1);
        if ((++sp & 255u) == 0u) { if (xb_ld(&bar[XB_TMO])) break; if (sp > XB_SPIN_CAP) { atomicAdd(&bar[XB_TMO], 1u); break; } }
    }
    nloc = mine > 0u ? mine : 1u; nx = cnt > 0u ? cnt : 1u;
}

__device__ __forceinline__ void xcd_barrier(const XcdBarrier& b) {
    asm volatile("s_waitcnt vmcnt(0)" ::: "memory");
    __syncthreads();
    if (threadIdx.x == 0) {
        unsigned* bar = b.bar;
        __builtin_amdgcn_s_waitcnt(0);
        unsigned nloc = b.st[0], nx = b.st[1];
        if (nloc == 0u) { xcd_barrier_complete(bar, b.x, nloc, nx); b.st[0] = nloc; b.st[1] = nx; }
        const unsigned old = xb_add(&bar[XB_XSUB(b.x)], 1u);
        const unsigned gen = old / nloc;
        if (old + 1u == (gen + 1u) * nloc) {
            __builtin_amdgcn_fence(__ATOMIC_RELEASE, "agent");
            asm volatile("s_waitcnt vmcnt(0)" ::: "memory");
            const unsigned og = xb_add(&bar[XB_TOP], 1u);
            const unsigned tg = og / nx;
            if (og + 1u == (tg + 1u) * nx) xb_add(&bar[XB_TOPGEN], 1u);
            else XB_SPIN(xb_ld(&bar[XB_TOPGEN]) == tg, bar);
            __builtin_amdgcn_fence(__ATOMIC_ACQUIRE, "agent");
            xb_add(&bar[XB_XGEN(b.x)], 1u);
            asm volatile("s_waitcnt vmcnt(0)" ::: "memory");
        } else {
            XB_SPIN(xb_ld(&bar[XB_XGEN(b.x)]) == gen, bar);
            __builtin_amdgcn_fence(__ATOMIC_ACQUIRE, "agent");
            asm volatile("s_waitcnt vmcnt(0)" ::: "memory");
        }
    }
    __syncthreads();
}
namespace pg8 {
#define PG8_LAS __attribute__((address_space(3)))
typedef unsigned short bf16_t;
typedef short bf16x8 __attribute__((ext_vector_type(8)));
typedef float f32x4 __attribute__((ext_vector_type(4)));
typedef unsigned u32x4 __attribute__((ext_vector_type(4)));
constexpr int BM = 256, BK = 64, HALF = 128, HTB = HALF * BK * 2  , STAGE_BYTES = 8 * HTB, NXCD = 8, WGM = 8;

__host__ __device__ __forceinline__ int lds_byte(int r, int c) { const int st = (r >> 4) * 2 + (c >> 5), rr = r & 15, cc = c & 31, ob = rr * 64 + cc * 2; return st * 1024 + (ob ^ (((ob >> 9) & 1) << 5)); }
__host__ __device__ __forceinline__ void stage_rc(int b, int& R, int& C) { const int st = b / 1024, sb = b % 1024, swz = sb ^ (((sb >> 9) & 1) << 5); R = (st >> 1) * 16 + swz / 64; C = (st & 1) * 32 + (swz % 64) / 2; }
__host__ __device__ __forceinline__ int perm32(int rho) { const int n = rho >> 4, i = rho & 15; return 8 * (i >> 2) + 4 * n + (i & 3); }

struct Unit { int pm, pn; };
struct Gemm { const bf16_t* A; const bf16_t* Bt; int M, N, K; };

struct StaticOrder {
    int nM, nN, nwg, G, c;
    __host__ __device__ void init(int M, int N, int G_, int c_) { nM = M / BM; nN = N / BM; nwg = nM * nN; G = G_; c = c_; }
    __host__ __device__ bool next(int i, Unit& u) const {
        const long L = (long)i * G + c; if (L >= nwg) return false;
        int wgid = (int)L; { const int q = nwg / NXCD, r = nwg % NXCD, xcd = wgid % NXCD, off = wgid / NXCD; wgid = (xcd < r ? xcd * (q + 1) : r * (q + 1) + (xcd - r) * q) + off; }
        const int nig = WGM * nN, gid = wgid / nig, fm = gid * WGM, gsz = (nM - fm) < WGM ? (nM - fm) : WGM;
        u.pm = fm + ((wgid % nig) % gsz); u.pn = (wgid % nig) / gsz; return true;
    }
    __device__ __forceinline__ void a_ready(const Unit&) const {}
    __device__ __forceinline__ void done(const Unit&) const {}
};

__device__ __forceinline__ unsigned cvt_pk_bf16(float lo, float hi) { unsigned r; asm volatile("v_cvt_pk_bf16_f32 %0, %1, %2" : "=v"(r) : "v"(lo), "v"(hi)); return r; }
typedef float f32x2 __attribute__((ext_vector_type(2)));
__device__ __forceinline__ f32x2 gelu_pk(f32x2 v) {
    const f32x2 av = __builtin_elementwise_abs(v), d = av * 0.2316418882f + 1.0f;
    f32x2 t; t.x = __builtin_amdgcn_rcpf(d.x); t.y = __builtin_amdgcn_rcpf(d.y);
    f32x2 q = t * 0.5307027145f + (-0.7265760135f); q = q * t + 0.7107068705f; q = q * t + (-0.142248368f); q = q * t + 0.127414796f; q = q * t;
    const f32x2 s = (v * v) * (-0.72134752044f);
    f32x2 e; e.x = __builtin_amdgcn_exp2f(s.x); e.y = __builtin_amdgcn_exp2f(s.y);
    const f32x2 m = v * (q * e), r = v - m;
    f32x2 o; o.x = v.x < 0.f ? m.x : r.x; o.y = v.y < 0.f ? m.y : r.y; return o;
}

template <int ACT  > struct EpiBf16 {
    static constexpr bool PERM = true, AFTER_DRAIN = false; static_assert(ACT == 0 || ACT == 1, "EpiBf16: ACT is 0 (none) or 1 (gelu_pk)");
    bf16_t* O; int ldc; const float* bias; int split_cols; size_t split_stride; float scale0;
    __device__ __forceinline__ void operator()(const f32x4 (&acc)[2][2][4][2], const Unit& u, int wr, int wc, int fr, int fq) const {
        const int row0 = u.pm * BM + wr * 64 + fr; int colt = u.pn * BM; bf16_t* base = O;
        float sc = 1.f; if (split_cols) { const int t = colt / split_cols; base += (size_t)t * split_stride; colt -= t * split_cols; if (t == 0) sc = scale0; }
        const int col0 = colt + wc * 32 + 8 * fq, bcol0 = u.pn * BM + wc * 32 + 8 * fq;
        f32x4 bv[2][2];
#pragma unroll
        for (int bj = 0; bj < 2; ++bj)
#pragma unroll
            for (int n = 0; n < 2; ++n) bv[bj][n] = bias ? *(const f32x4*)(bias + bcol0 + bj * HALF + 4 * n) : (f32x4){0.f, 0.f, 0.f, 0.f};
#pragma unroll
        for (int ai = 0; ai < 2; ++ai)
#pragma unroll
            for (int m = 0; m < 4; ++m) { bf16_t* rowp = base + (size_t)(row0 + ai * HALF + m * 16) * ldc + col0;
#pragma unroll
                for (int bj = 0; bj < 2; ++bj) { f32x4 v0 = acc[ai][bj][m][0] + bv[bj][0], v1 = acc[ai][bj][m][1] + bv[bj][1];
                    if (ACT == 1) { f32x2 a = gelu_pk((f32x2){v0[0], v0[1]}), b = gelu_pk((f32x2){v0[2], v0[3]}), c = gelu_pk((f32x2){v1[0], v1[1]}), d = gelu_pk((f32x2){v1[2], v1[3]});
                        v0 = (f32x4){a.x, a.y, b.x, b.y}; v1 = (f32x4){c.x, c.y, d.x, d.y}; }
                    v0 = v0 * sc; v1 = v1 * sc; u32x4 w; w.x = cvt_pk_bf16(v0[0], v0[1]); w.y = cvt_pk_bf16(v0[2], v0[3]); w.z = cvt_pk_bf16(v1[0], v1[1]); w.w = cvt_pk_bf16(v1[2], v1[3]);
                    *(u32x4*)(rowp + bj * HALF) = w; } }
    }
};

struct EpiResid {
    static constexpr bool PERM = false, AFTER_DRAIN = false;
    const bf16_t* xn; const float* xscale; bf16_t* xb; float* rowsq; int ldc;
    __device__ __forceinline__ void operator()(const f32x4 (&acc)[2][2][4][2], const Unit& u, int wr, int wc, int fr, int fq) const {
        typedef unsigned u32x2v __attribute__((ext_vector_type(2)));
        const int col0 = u.pn * BM + wc * 32 + 4 * fq;
        const size_t base = (size_t)(u.pm * BM + wr * 64 + fr) * ldc + col0;
        u32x2v xv[2][4]; float xs[2];
#define EPR_LOAD(SET, G) do { const int r_ = ((G) >> 2) * HALF + ((G) & 3) * 16; const size_t off_ = base + (size_t)r_ * ldc; xs[SET] = xscale[u.pm * BM + wr * 64 + fr + r_]; \
        _Pragma("unroll") for (int bj = 0; bj < 2; ++bj) _Pragma("unroll") for (int n = 0; n < 2; ++n) xv[SET][bj * 2 + n] = __builtin_nontemporal_load((const u32x2v*)(xn + off_ + bj * HALF + n * 16)); } while (0)
        EPR_LOAD(0, 0);
#pragma unroll
        for (int g = 0; g < 8; ++g) {
            const int ai = g >> 2, m = g & 3;
            if (g + 1 < 8) { if ((g & 1) == 0) EPR_LOAD(1, g + 1); else EPR_LOAD(0, g + 1); }
            const int row = u.pm * BM + ai * HALF + wr * 64 + m * 16 + fr;
            const size_t off = base + (size_t)(ai * HALF + m * 16) * ldc;
            const float sc = xs[g & 1];
            float ss = 0.f;
#pragma unroll
            for (int bj = 0; bj < 2; ++bj)
#pragma unroll
                for (int n = 0; n < 2; ++n) {
                    const size_t c = off + bj * HALF + n * 16;
                    const u32x2v xr = xv[g & 1][bj * 2 + n];
                    f32x4 o = acc[ai][bj][m][n];
                    o[0] += __uint_as_float(xr.x << 16) * sc; o[1] += __uint_as_float(xr.x & 0xffff0000u) * sc;
                    o[2] += __uint_as_float(xr.y << 16) * sc; o[3] += __uint_as_float(xr.y & 0xffff0000u) * sc;
                    ss += (o[0] * o[0] + o[1] * o[1]) + (o[2] * o[2] + o[3] * o[3]);
                    u32x2v w; w.x = cvt_pk_bf16(o[0], o[1]); w.y = cvt_pk_bf16(o[2], o[3]);
                    *(u32x2v*)(xb + c) = w;
                }
            ss += __shfl_xor(ss, 16); ss += __shfl_xor(ss, 32);
            if (fq == 0) atomicAdd(rowsq + row, ss);
        }
#undef EPR_LOAD
    }
};

struct EpiProj {
    static constexpr bool PERM = true, AFTER_DRAIN = false;
    bf16_t* O; int ldc; const float* qnw; const float* knw; const float* cosT; const float* sinT; PG8_LAS float* xch; int q_lo, k_lo, k_hi, seq_mask; float eps;
    __device__ __forceinline__ void operator()(const f32x4 (&acc)[2][2][4][2], const Unit& u, int wr, int wc, int fr, int fq) const {
        const int colt = u.pn * BM, row0 = u.pm * BM + wr * 64 + fr, col0 = colt + wc * 32 + 8 * fq;
        if (colt < q_lo || colt >= k_hi) {
#pragma unroll
            for (int ai = 0; ai < 2; ++ai)
#pragma unroll
                for (int m = 0; m < 4; ++m) { bf16_t* rowp = O + (size_t)(row0 + ai * HALF + m * 16) * ldc + col0;
#pragma unroll
                    for (int bj = 0; bj < 2; ++bj) { const f32x4 v0 = acc[ai][bj][m][0], v1 = acc[ai][bj][m][1];
                        u32x4 w; w.x = cvt_pk_bf16(v0[0], v0[1]); w.y = cvt_pk_bf16(v0[2], v0[3]); w.z = cvt_pk_bf16(v1[0], v1[1]); w.w = cvt_pk_bf16(v1[2], v1[3]);
                        *(u32x4*)(rowp + bj * HALF) = w; } }
            return;
        }
        const float* nw = colt < k_lo ? qnw : knw;
#pragma unroll
        for (int ai = 0; ai < 2; ++ai)
#pragma unroll
            for (int m = 0; m < 4; ++m)
#pragma unroll
                for (int bj = 0; bj < 2; ++bj) {
                    const f32x4 a = acc[ai][bj][m][0], b = acc[ai][bj][m][1];
                    float ss = ((a[0] * a[0] + a[1] * a[1]) + (a[2] * a[2] + a[3] * a[3])) + ((b[0] * b[0] + b[1] * b[1]) + (b[2] * b[2] + b[3] * b[3]));
                    ss += __shfl_xor(ss, 16); ss += __shfl_xor(ss, 32);
                    if (fq == 0) xch[((ai * HALF + wr * 64 + m * 16 + fr) * 4 + bj * 2 + (wc >> 1)) * 2 + (wc & 1)] = ss;
                }
        asm volatile("s_waitcnt lgkmcnt(0)" ::: "memory"); __builtin_amdgcn_s_barrier(); asm volatile("" ::: "memory");
        float wv[8];
#pragma unroll
        for (int n = 0; n < 2; ++n)
#pragma unroll
            for (int j = 0; j < 4; ++j) wv[4 * n + j] = nw[32 * (wc & 1) + 8 * fq + 4 * n + j];
        const bool rot = ((wc & 1) == 0) && (fq < 2);
#pragma unroll
        for (int ai = 0; ai < 2; ++ai)
#pragma unroll
            for (int m = 0; m < 4; ++m) {
                const int rl = ai * HALF + wr * 64 + m * 16 + fr, row = u.pm * BM + rl, pos = row & seq_mask;
                f32x4 cs0 = {1.f, 1.f, 1.f, 1.f}, cs1 = cs0, sn0 = {0.f, 0.f, 0.f, 0.f}, sn1 = sn0;
                if (rot) { cs0 = *(const f32x4*)(cosT + pos * 8); cs1 = *(const f32x4*)(cosT + pos * 8 + 4); sn0 = *(const f32x4*)(sinT + pos * 8); sn1 = *(const f32x4*)(sinT + pos * 8 + 4); }
                bf16_t* rowp = O + (size_t)row * ldc + col0;
#pragma unroll
                for (int bj = 0; bj < 2; ++bj) {
                    const int xi = (rl * 4 + bj * 2 + (wc >> 1)) * 2;
                    const float rs = rsqrtf((xch[xi] + xch[xi + 1]) * (1.f / 64.f) + eps);
                    f32x4 y0 = acc[ai][bj][m][0] * rs, y1 = acc[ai][bj][m][1] * rs;
#pragma unroll
                    for (int j = 0; j < 4; ++j) { y0[j] *= wv[j]; y1[j] *= wv[4 + j]; }
                    f32x4 p0, p1;
#pragma unroll
                    for (int j = 0; j < 4; ++j) { p0[j] = __shfl_xor(y0[j], 16); p1[j] = __shfl_xor(y1[j], 16); }
                    if (rot) {
                        if (fq == 0) { y0 = y0 * cs0 - p0 * sn0; y1 = y1 * cs1 - p1 * sn1; }
                        else { y0 = p0 * sn0 + y0 * cs0; y1 = p1 * sn1 + y1 * cs1; }
                    }
                    u32x4 w; w.x = cvt_pk_bf16(y0[0], y0[1]); w.y = cvt_pk_bf16(y0[2], y0[3]); w.z = cvt_pk_bf16(y1[0], y1[1]); w.w = cvt_pk_bf16(y1[2], y1[3]);
                    *(u32x4*)(rowp + bj * HALF) = w;
                }
            }
    }
};

template <class Epi, class Sched, bool ALIGN_EPI = false, bool SP2 = false>
__device__ __forceinline__ void gemm_phase(PG8_LAS unsigned char* lds, const Gemm g, const Sched& S, const Epi& E) {
    const int tid = threadIdx.x, wid = __builtin_amdgcn_readfirstlane(tid >> 6), lane = tid & 63, wr = wid >> 2, wc = wid & 3, fr = lane & 15, fq = lane >> 4;
    const int K = g.K, nt = K / BK;
    unsigned voffA[2], voffB[2];
#pragma unroll
    for (int i = 0; i < 2; ++i) { int R, C; stage_rc(tid * 16 + i * 8192, R, C); const int Rb = Epi::PERM ? ((R & ~31) + perm32(R & 31)) : R;
        voffA[i] = (unsigned)(R * K + C) * 2u; voffB[i] = (unsigned)(Rb * K + C) * 2u; }
    const size_t kstep = (size_t)(BK * 2);
    const size_t hstep = (size_t)HALF * K * 2;
    const size_t tstep = 2 * hstep;
    const unsigned ldsw = (unsigned)wid * 1024u;
    const int aoff = lds_byte(wr * 64 + fr, fq * 8), boff = lds_byte(wc * 32 + fr, fq * 8);
#define PG8_SA(b, h) (((b) * 2 + (h)) * HTB)
#define PG8_SB(b, h) ((4 + (b) * 2 + (h)) * HTB)
#define PG8_STAGE(bufoff, gbase, voff) do { _Pragma("unroll") for (int _i = 0; _i < 2; ++_i) \
        __builtin_amdgcn_global_load_lds((const unsigned*)((const char*)(gbase) + (voff)[_i]), (PG8_LAS unsigned*)(lds + (bufoff) + ldsw + _i * 8192), 16, 0, 0); } while (0)
#define PG8_LDA(dst, b, h) do { _Pragma("unroll") for (int m = 0; m < 4; ++m) _Pragma("unroll") for (int k = 0; k < 2; ++k) dst[m][k] = *(const PG8_LAS bf16x8*)(lds + PG8_SA(b, h) + aoff + m * 2048 + k * 1024); } while (0)
#define PG8_LDB(dst, b, h) do { _Pragma("unroll") for (int n = 0; n < 2; ++n) _Pragma("unroll") for (int k = 0; k < 2; ++k) dst[n][k] = *(const PG8_LAS bf16x8*)(lds + PG8_SB(b, h) + boff + n * 2048 + k * 1024); } while (0)
#define PG8_MMA(ai, bj, At, Bt) do { __builtin_amdgcn_s_setprio(1); _Pragma("unroll") for (int m = 0; m < 4; ++m) _Pragma("unroll") for (int n = 0; n < 2; ++n) _Pragma("unroll") for (int k = 0; k < 2; ++k) \
        acc[ai][bj][m][n] = __builtin_amdgcn_mfma_f32_16x16x32_bf16(Bt[n][k], At[m][k], acc[ai][bj][m][n], 0, 0, 0); __builtin_amdgcn_s_setprio(0); } while (0)
#define PG8_WAIT_V(n) asm volatile("s_waitcnt vmcnt(" #n ")" ::: "memory")
#define PG8_WAIT_L(n) asm volatile("s_waitcnt lgkmcnt(" #n ")" ::: "memory")
#define PG8_BAR __builtin_amdgcn_s_barrier()
#define PG8_SCHED __builtin_amdgcn_sched_barrier(0)
    Unit cur, nxt; int ui = 0;
    if (!S.next(0, cur)) return;
    f32x4 acc[2][2][4][2];
#pragma unroll
    for (int a = 0; a < 2; ++a)
#pragma unroll
        for (int b = 0; b < 2; ++b)
#pragma unroll
            for (int m = 0; m < 4; ++m)
#pragma unroll
                for (int n = 0; n < 2; ++n) acc[a][b][m][n] = (f32x4){0.f, 0.f, 0.f, 0.f};
    bf16x8 At[4][2], B0[2][2], B1[2][2];
    const char* cA = (const char*)g.A + (size_t)cur.pm * tstep; const char* cB = (const char*)g.Bt + (size_t)cur.pn * tstep;
    S.a_ready(cur);
    if constexpr (SP2) {
        PG8_STAGE(PG8_SB(0, 0), cB, voffB); PG8_STAGE(PG8_SB(0, 1), cB + hstep, voffB); PG8_STAGE(PG8_SA(0, 0), cA, voffA); PG8_STAGE(PG8_SA(0, 1), cA + hstep, voffA);
        if (wr == 1) PG8_BAR;
        PG8_WAIT_V(2); PG8_BAR;
        PG8_STAGE(PG8_SB(1, 0), cB + kstep, voffB); PG8_STAGE(PG8_SA(1, 0), cA + kstep, voffA); PG8_STAGE(PG8_SB(1, 1), cB + hstep + kstep, voffB);
        PG8_WAIT_V(6); PG8_BAR;
    } else {
        PG8_STAGE(PG8_SB(0, 0), cB, voffB); PG8_STAGE(PG8_SA(0, 0), cA, voffA); PG8_STAGE(PG8_SB(0, 1), cB + hstep, voffB); PG8_STAGE(PG8_SA(0, 1), cA + hstep, voffA);
        if (wr == 1) PG8_BAR;
        PG8_WAIT_V(4); PG8_BAR;
        PG8_STAGE(PG8_SB(1, 0), cB + kstep, voffB); PG8_STAGE(PG8_SA(1, 0), cA + kstep, voffA); PG8_STAGE(PG8_SB(1, 1), cB + hstep + kstep, voffB);
        PG8_WAIT_V(6); PG8_BAR;
    }
    for (;;) {
        const bool has_next = S.next(ui + 1, nxt);
        const char* nA = has_next ? (const char*)g.A + (size_t)nxt.pm * tstep : cA; const char* nB = has_next ? (const char*)g.Bt + (size_t)nxt.pn * tstep : cB;
        for (int t = 0; t < nt; t += 2) {
            const bool last = (t == nt - 2);
            const char* a1 = cA + (size_t)(t + 1) * kstep;
            const char* a2 = last ? nA : cA + (size_t)(t + 2) * kstep; const char* b2 = last ? nB : cB + (size_t)(t + 2) * kstep;
            const char* a3 = a2 + kstep; const char* b3 = b2 + kstep;
            if (last && has_next) S.a_ready(nxt);
            if constexpr (SP2) {
            PG8_LDB(B0, 0, 0); PG8_LDB(B1, 0, 1); PG8_SCHED; PG8_LDA(At, 0, 0); PG8_STAGE(PG8_SA(1, 1), a1 + hstep, voffA);
            PG8_WAIT_V(8); PG8_WAIT_L(0); PG8_BAR; PG8_MMA(0, 0, At, B0); PG8_MMA(0, 1, At, B1); PG8_BAR; PG8_SCHED;
            PG8_LDA(At, 0, 1); PG8_STAGE(PG8_SB(0, 0), b2, voffB); PG8_STAGE(PG8_SB(0, 1), b2 + hstep, voffB); PG8_STAGE(PG8_SA(0, 0), a2, voffA);
            PG8_WAIT_V(8); PG8_WAIT_L(0); PG8_BAR; PG8_MMA(1, 0, At, B0); PG8_MMA(1, 1, At, B1); PG8_BAR; PG8_SCHED;
            PG8_LDB(B0, 1, 0); PG8_LDB(B1, 1, 1); PG8_SCHED; PG8_LDA(At, 1, 0); PG8_STAGE(PG8_SA(0, 1), a2 + hstep, voffA);
            PG8_WAIT_V(8); PG8_WAIT_L(0); PG8_BAR; PG8_MMA(0, 0, At, B0); PG8_MMA(0, 1, At, B1); PG8_BAR; PG8_SCHED;
            PG8_LDA(At, 1, 1); PG8_STAGE(PG8_SB(1, 0), b3, voffB); PG8_STAGE(PG8_SB(1, 1), b3 + hstep, voffB); PG8_STAGE(PG8_SA(1, 0), a3, voffA);
            PG8_WAIT_V(8); PG8_WAIT_L(0); PG8_BAR; PG8_MMA(1, 0, At, B0); PG8_MMA(1, 1, At, B1); PG8_BAR; PG8_SCHED;
            } else {
            PG8_LDB(B0, 0, 0); PG8_SCHED; PG8_LDA(At, 0, 0); PG8_STAGE(PG8_SA(1, 1), a1 + hstep, voffA);
            PG8_WAIT_L(8); PG8_BAR; PG8_WAIT_L(0); PG8_MMA(0, 0, At, B0); PG8_BAR; PG8_SCHED;
            PG8_LDB(B1, 0, 1); PG8_STAGE(PG8_SB(0, 0), b2, voffB);
            PG8_BAR; PG8_WAIT_L(0); PG8_MMA(0, 1, At, B1); PG8_BAR;
            PG8_LDA(At, 0, 1); PG8_STAGE(PG8_SA(0, 0), a2, voffA);
            PG8_BAR; PG8_WAIT_L(0); PG8_MMA(1, 0, At, B0); PG8_BAR; PG8_SCHED;
            PG8_STAGE(PG8_SB(0, 1), b2 + hstep, voffB);
            PG8_WAIT_V(6); PG8_BAR; PG8_MMA(1, 1, At, B1); PG8_BAR;
            PG8_LDB(B0, 1, 0); PG8_SCHED; PG8_LDA(At, 1, 0); PG8_STAGE(PG8_SA(0, 1), a2 + hstep, voffA);
            PG8_WAIT_L(8); PG8_BAR; PG8_WAIT_L(0); PG8_MMA(0, 0, At, B0); PG8_BAR; PG8_SCHED;
            PG8_LDB(B1, 1, 1); PG8_STAGE(PG8_SB(1, 0), b3, voffB);
            PG8_BAR; PG8_WAIT_L(0); PG8_MMA(0, 1, At, B1); PG8_BAR;
            PG8_LDA(At, 1, 1); PG8_STAGE(PG8_SA(1, 0), a3, voffA);
            PG8_BAR; PG8_WAIT_L(0); PG8_MMA(1, 0, At, B0); PG8_BAR; PG8_SCHED;
            PG8_STAGE(PG8_SB(1, 1), b3 + hstep, voffB);
            PG8_WAIT_V(6); PG8_BAR; PG8_MMA(1, 1, At, B1); PG8_BAR;
            }
        }
        if constexpr (ALIGN_EPI) { if (wr == 0) PG8_BAR; }
        if constexpr (!Epi::AFTER_DRAIN) { E(acc, cur, wr, wc, fr, fq); S.done(cur); }
        if (!has_next) break;
#pragma unroll
        for (int a = 0; a < 2; ++a)
#pragma unroll
            for (int b = 0; b < 2; ++b)
#pragma unroll
                for (int m = 0; m < 4; ++m)
#pragma unroll
                    for (int n = 0; n < 2; ++n) acc[a][b][m][n] = (f32x4){0.f, 0.f, 0.f, 0.f};
        cur = nxt; cA = nA; cB = nB; ++ui;
        if constexpr (ALIGN_EPI) { if (wr == 1) PG8_BAR; }
    }
    PG8_WAIT_V(0);
    if constexpr (!ALIGN_EPI) { if (wr == 0) PG8_BAR; }
    PG8_BAR;
    if constexpr (Epi::AFTER_DRAIN) { E.fused(acc, cur, wr, wc, fr, fq, lds, wid, lane); S.done(cur); }
#undef PG8_SA
#undef PG8_SB
#undef PG8_STAGE
#undef PG8_LDA
#undef PG8_LDB
#undef PG8_MMA
#undef PG8_WAIT_V
#undef PG8_WAIT_L
#undef PG8_BAR
#undef PG8_SCHED
}
}

struct Params {
    const float* in[22];
    float* out;
    unsigned char* ws;
    int ph_lo, ph_hi;
};
struct Ctx { LAS unsigned char* lds; int tid, lane, wave, vcu, G, gw, ngw; unsigned long long ta, tb, tc; };

__device__ __forceinline__ void p0_transpose_item(const float* W, int K, int Nreal, int thresh, const float* ksc, bf16_t* WT, LAS float* scr, int item, int nblk, int lane) {
    const int kb = item / nblk, nb = item % nblk, k0 = 64 * kb, n0 = 32 * nb;
    const int nr0 = n0 + (n0 >= thresh ? 8 : 0);
#pragma unroll 8
    for (int i = 0; i < 32; ++i) {
        const int kk = 2 * i + (lane >> 5);
        const float sc = ksc ? ksc[k0 + kk] : 1.f;
        scr[kk * 33 + (lane & 31)] = W[(size_t)(k0 + kk) * Nreal + nr0 + (lane & 31)] * sc;
    }
    LDS_WAIT(); asm volatile("" ::: "memory");
    const int c = lane & 7;
#pragma unroll
    for (int j = 0; j < 4; ++j) {
        const int n = (lane >> 3) + 8 * j; const LAS float* s = scr + (8 * c) * 33 + n;
        u32x4 o; o.x = pk2(s[0 * 33], s[1 * 33]); o.y = pk2(s[2 * 33], s[3 * 33]); o.z = pk2(s[4 * 33], s[5 * 33]); o.w = pk2(s[6 * 33], s[7 * 33]);
        *(u32x4*)(WT + (size_t)(n0 + n) * K + k0 + 8 * c) = o;
    }
    LDS_WAIT(); asm volatile("" ::: "memory");
}

__device__ __forceinline__ void phase0(const Params& p, Ctx& F) {
    const float* x = p.in[0]; const float* mixw = p.in[1]; const float* w_in = p.in[2];
    const float* w_out = p.in[16]; const float* ffnw = p.in[17]; const float* w_q = p.in[18]; const float* keys = p.in[19];
    const float* pu = p.in[20]; const float* pv = p.in[21];
    unsigned char* ws = p.ws;
    LAS float* scr = (LAS float*)(F.lds + F.wave * 8448);
    LAS float* wdt = (LAS float*)(F.lds + 69632);
    {
        constexpr int WLD = 132;
        LAS float* WQS = (LAS float*)F.lds;
        LAS float* KYS = (LAS float*)(F.lds + 64 * WLD * 4);
        bf16_t* wefft = (bf16_t*)(ws + WS_WQT);
        for (int u = F.vcu; u < 256; u += F.G) {
            const int hj = u >> 4, kt = u & 15;
            __syncthreads();
#pragma unroll
            for (int i = 0; i < 4; ++i) {
                const int pc = F.tid + 512 * i, k = pc >> 5, d4 = pc & 31;
                const f32x4 v = *(const f32x4*)(w_q + (size_t)(64 * kt + k) * 2048 + hj * 128 + d4 * 4);
                *(LAS f32x4*)(WQS + k * WLD + d4 * 4) = v * ffnw[64 * kt + k];
            }
#pragma unroll
            for (int i = 0; i < 8; ++i) {
                const int pc = F.tid + 512 * i, n = pc >> 5, d4 = pc & 31;
                *(LAS f32x4*)(KYS + n * WLD + d4 * 4) = *(const f32x4*)(keys + ((size_t)hj * 128 + n) * 128 + d4 * 4);
            }
            __syncthreads();
            const int fr_ = F.lane & 15, fq_ = F.lane >> 4, mt = F.wave >> 1, nt0 = (F.wave & 1) * 4;
            f32x4 acc[4];
#pragma unroll
            for (int q = 0; q < 4; ++q) acc[q] = (f32x4){0.f, 0.f, 0.f, 0.f};
#pragma unroll 4
            for (int ks = 0; ks < 32; ++ks) {
                const float av = WQS[(mt * 16 + fr_) * WLD + 4 * ks + fq_];
#pragma unroll
                for (int q = 0; q < 4; ++q) {
                    const float bv = KYS[((nt0 + q) * 16 + fr_) * WLD + 4 * ks + fq_];
                    acc[q] = __builtin_amdgcn_mfma_f32_16x16x4f32(av, bv, acc[q], 0, 0, 0);
                }
            }
#pragma unroll
            for (int q = 0; q < 4; ++q) {
                u32x2 w; w.x = pk2(acc[q][0], acc[q][1]); w.y = pk2(acc[q][2], acc[q][3]);
                *(u32x2*)(wefft + ((size_t)hj * 128 + (nt0 + q) * 16 + fr_) * DM + 64 * kt + mt * 16 + 4 * fq_) = w;
            }
        }
        __syncthreads();
    }
    for (int k = F.tid; k < DM; k += 512) {
        const float s = mixw[k];
        const f32x4 a = *(const f32x4*)(w_in + (size_t)k * 3080 + 1536), b = *(const f32x4*)(w_in + (size_t)k * 3080 + 1540);
        *(LAS f32x4*)(wdt + k * 8) = a * s; *(LAS f32x4*)(wdt + k * 8 + 4) = b * s;
    }
    __syncthreads();
    constexpr int I_IN = 16 * 96, I_OUT = 16 * 32;
    for (int it = F.gw; it < I_IN + I_OUT; it += F.ngw) {
        int r = it;
        if (r < I_IN) { p0_transpose_item(w_in, DM, 3080, 1536, mixw, (bf16_t*)(ws + WS_WINT), scr, r, 96, F.lane); continue; } r -= I_IN;
        p0_transpose_item(w_out, DM, DM, 1 << 30, nullptr, (bf16_t*)(ws + WS_WOUTT), scr, r, 32, F.lane);
    }
    const int gtid = F.vcu * 512 + F.tid, nthr = F.G * 512;
    for (int i = gtid; i < TOK; i += nthr) ((float*)(ws + WS_CTL) + CW_ROWSQ)[i] = 0.f;
    for (int i = gtid; i < SEQ * 8; i += nthr) {
        const int pos = i >> 3, f = i & 7;
        const float inv = powf(500000.0f, -(float)(2 * f) / 16.0f);
        const float ang = (float)pos * inv;
        ((float*)(ws + WS_ROPE))[i] = cosf(ang);
        ((float*)(ws + WS_ROPE))[SEQ * 8 + i] = sinf(ang);
    }
#if defined(PROBE_PHASE) && (PROBE_PHASE == 83 || PROBE_PHASE == 84)
    if (F.gw == 0 && F.lane == 0) { unsigned* mw = (unsigned*)(ws + WS_MISC); mw[2] = 0u; mw[3] = 0xffffffffu; mw[4] = 0u; }
#endif
    if (F.gw == 0) {
        const float a = p.in[11][F.lane] * p.in[12][F.lane], b = p.in[13][F.lane] * p.in[14][F.lane];
        const float sa = wave_sum(a), sb = wave_sum(b);
        if (F.lane == 0) ((float*)(ws + WS_MISC))[0] = expf(sa) - expf(sb) + LAMBDA_INIT;
    }
    {
        float* rsu = (float*)(ws + WS_RSU); float* rsv = (float*)(ws + WS_RSV);
        for (int r0 = F.gw; r0 < 2 * 16384; r0 += 4 * F.ngw) {
            f32x4 a[4][4]; float amax[4];
#pragma unroll
            for (int u = 0; u < 4; ++u) {
                const int r = min(r0 + u * F.ngw, 2 * 16384 - 1); const bool isU = r < 16384; const int e = r & 16383;
                const float* src = (isU ? pu : pv) + (size_t)e * DM + 16 * F.lane;
#pragma unroll
                for (int q = 0; q < 4; ++q) a[u][q] = __builtin_nontemporal_load((const f32x4*)(src + 4 * q));
            }
#pragma unroll
            for (int u = 0; u < 4; ++u) {
                const int r = min(r0 + u * F.ngw, 2 * 16384 - 1); const bool isU = r < 16384;
                amax[u] = 0.f;
#pragma unroll
                for (int q = 0; q < 4; ++q) {
                    if (isU) a[u][q] = a[u][q] * *(const f32x4*)(ffnw + 16 * F.lane + 4 * q);
                    amax[u] = fmaxf(amax[u], fmaxf(fmaxf(fabsf(a[u][q][0]), fabsf(a[u][q][1])), fmaxf(fabsf(a[u][q][2]), fabsf(a[u][q][3]))));
                }
            }
#pragma unroll
            for (int u = 0; u < 4; ++u) amax[u] = wave_max(amax[u]);
#pragma unroll
            for (int u = 0; u < 4; ++u) {
                const int r = min(r0 + u * F.ngw, 2 * 16384 - 1); const bool isU = r < 16384; const int e = r & 16383;
#ifdef U_FP4
#ifdef V_FP4
#define V_FP4_ON 1
#else
#define V_FP4_ON 0
#endif
#ifndef FP4_NIB_SWAP
#define FP4_NIB_SWAP 0
#endif
                if (isU || V_FP4_ON) {
                    const float s4 = amax[u] > 0.f ? 6.f / amax[u] : 1.f;
                    if (F.lane == 0) (isU ? rsu : rsv)[e] = amax[u] > 0.f ? amax[u] * (1.f / 6.f) : 1.f;
                    u32x2 o4;
#pragma unroll
                    for (int hq = 0; hq < 2; ++hq) {
                        unsigned w = 0u;
#pragma unroll
                        for (int q2 = 0; q2 < 2; ++q2)
#pragma unroll
                            for (int el = 0; el < 4; ++el) {
                                const float qv = a[u][hq * 2 + q2][el] * s4, m = fabsf(qv);
                                const unsigned c = (unsigned)(m > 0.25f) + (unsigned)(m > 0.75f) + (unsigned)(m > 1.25f) + (unsigned)(m > 1.75f) + (unsigned)(m > 2.5f) + (unsigned)(m > 3.5f) + (unsigned)(m > 5.0f)
                                                 + (qv < 0.f ? 8u : 0u);
                                w |= c << (4 * ((q2 * 4 + el) ^ FP4_NIB_SWAP));
                            }
                        o4[hq] = w;
                    }
                    *(u32x2*)(ws + (isU ? WS_UB : WS_VB) + (size_t)e * (DM / 2) + 8 * F.lane) = o4;
                    continue;
                }
#endif
                const float sc = amax[u] > 0.f ? 240.f / amax[u] : 1.f;
                if (F.lane == 0) (isU ? rsu : rsv)[e] = amax[u] > 0.f ? amax[u] * (1.f / 240.f) : 1.f;
                u32x4 o;
#pragma unroll
                for (int q = 0; q < 4; ++q) {
                    int pk = 0;
                    pk = __builtin_amdgcn_cvt_pk_fp8_f32(a[u][q][0] * sc, a[u][q][1] * sc, pk, false);
                    pk = __builtin_amdgcn_cvt_pk_fp8_f32(a[u][q][2] * sc, a[u][q][3] * sc, pk, true);
                    o[q] = (unsigned)pk;
                }
                *(u32x4*)(ws + (isU ? WS_UB : WS_VB) + (size_t)e * DM + 16 * F.lane) = o;
            }
        }
    }
    bf16_t* xb = (bf16_t*)(ws + WS_XB); float* dtraw = (float*)(ws + WS_DTRAW);
    for (int m0 = F.gw; m0 < TOK; m0 += 2 * F.ngw) {
        f32x4 v[2][4]; float ss[2];
#pragma unroll
        for (int u = 0; u < 2; ++u) {
            const int m = m0 + u * F.ngw; ss[u] = 0.f;
            const f32x4* xr = (const f32x4*)(x + (size_t)(m < TOK ? m : m0) * DM) + F.lane;
#pragma unroll
            for (int j = 0; j < 4; ++j) v[u][j] = __builtin_nontemporal_load(xr + 64 * j);
        }
#pragma unroll
        for (int u = 0; u < 2; ++u)
#pragma unroll
            for (int j = 0; j < 4; ++j) ss[u] += (v[u][j][0] * v[u][j][0] + v[u][j][1] * v[u][j][1]) + (v[u][j][2] * v[u][j][2] + v[u][j][3] * v[u][j][3]);
        f32x4 d0[2], d1[2];
#pragma unroll
        for (int u = 0; u < 2; ++u) { d0[u] = (f32x4){0.f, 0.f, 0.f, 0.f}; d1[u] = (f32x4){0.f, 0.f, 0.f, 0.f}; }
#pragma unroll
        for (int j = 0; j < 4; ++j)
#pragma unroll
            for (int e = 0; e < 4; ++e) {
                const int k = 256 * j + 4 * F.lane + e;
                const f32x4 w0 = *(const LAS f32x4*)(wdt + k * 8), w1 = *(const LAS f32x4*)(wdt + k * 8 + 4);
#pragma unroll
                for (int u = 0; u < 2; ++u) { d0[u] += w0 * v[u][j][e]; d1[u] += w1 * v[u][j][e]; }
            }
#pragma unroll
        for (int u = 0; u < 2; ++u) {
            ss[u] = wave_sum(ss[u]);
#pragma unroll
            for (int e = 0; e < 4; ++e) { d0[u][e] = wave_sum(d0[u][e]); d1[u][e] = wave_sum(d1[u][e]); }
        }
#pragma unroll
        for (int u = 0; u < 2; ++u) {
            const int m = m0 + u * F.ngw;
            if (m < TOK) {
                const float r = rsqrtf(ss[u] * (1.f / DM) + EPSN);
                if (F.lane == 0) ((float*)(ws + WS_RSTD))[m] = sqrtf(ss[u] * (1.f / DM) + EPSN);
                if (F.lane == 0) { *(f32x4*)(dtraw + (size_t)m * 8) = d0[u] * r; *(f32x4*)(dtraw + (size_t)m * 8 + 4) = d1[u] * r; }
                unsigned long long* o8 = (unsigned long long*)(xb + (size_t)m * DM) + F.lane;
#pragma unroll
                for (int j = 0; j < 4; ++j) o8[64 * j] = (unsigned long long)pk2(v[u][j][0] * r, v[u][j][1] * r) | ((unsigned long long)pk2(v[u][j][2] * r, v[u][j][3] * r) << 32);
            }
        }
    }
}

__device__ __forceinline__ void p2_qk_prepass(const Params& p, Ctx& F) {
    bf16_t* proj = (bf16_t*)(p.ws + WS_PROJ);
    const float* qnw = p.in[9]; const float* knw = p.in[10];
    const float* cosT = (const float*)(p.ws + WS_ROPE); const float* sinT = cosT + SEQ * 8;
    const int sub = F.lane & 7;
    float wq[8], wk[8];
#pragma unroll
    for (int e = 0; e < 8; ++e) { wq[e] = qnw[sub * 8 + e]; wk[e] = knw[sub * 8 + e]; }
    for (int base = F.gw; base < TOK * 2; base += 8 * F.ngw) {
        u32x4 raw[8];
#pragma unroll
        for (int u = 0; u < 8; ++u) {
            const int wsi = base + u * F.ngw;
            raw[u] = (wsi < TOK * 2) ? *(const u32x4*)(proj + (size_t)(wsi >> 1) * NIN + ((wsi & 1) ? PK : PQ) + F.lane * 8) : (u32x4){0u, 0u, 0u, 0u};
        }
#pragma unroll
        for (int u = 0; u < 8; ++u) {
            const int wsi = base + u * F.ngw;
            const int t = wsi >> 1, which = wsi & 1;
            float v[8];
#pragma unroll
            for (int e = 0; e < 4; ++e) { v[2 * e] = bf2f(raw[u][e] & 0xffffu); v[2 * e + 1] = bf2f(raw[u][e] >> 16); }
            float ss = 0.f;
#pragma unroll
            for (int e = 0; e < 8; ++e) ss += v[e] * v[e];
            ss += __shfl_xor(ss, 1); ss += __shfl_xor(ss, 2); ss += __shfl_xor(ss, 4);
            const float rs = rsqrtf(ss * (1.f / 64.f) + EPSN);
            const int pos = t & (SEQ - 1);
            float o[8];
#pragma unroll
            for (int e = 0; e < 8; ++e) {
                const float y = v[e] * rs * (which ? wk[e] : wq[e]);
                const float other = __shfl_xor(y, 1);
                float r = y;
                if (sub < 2) {
                    const float c = cosT[pos * 8 + e], sn = sinT[pos * 8 + e];
                    r = (sub == 0) ? (y * c - other * sn) : (other * sn + y * c);
                }
                o[e] = r;
            }
            u32x4 ov; ov.x = pk2(o[0], o[1]); ov.y = pk2(o[2], o[3]); ov.z = pk2(o[4], o[5]); ov.w = pk2(o[6], o[7]);
            if (wsi < TOK * 2) *(u32x4*)(proj + (size_t)t * NIN + (which ? PK : PQ) + F.lane * 8) = ov;
        }
    }
}

constexpr int P2_XS = 0, P2_BM = 33792, P2_CM = 51200, P2_CB = 68608, P2_MH = 85248, P2_XW = 122112, P2_ACS = 155904, P2_DT = 156928, P2_FAC = 157952;
constexpr int XS_LD = 264, BM_LD = 136, MH_LD = 72, CB_LD = 65;
static_assert(P2_FAC + 1024 <= LDS_BYTES, "P2 LDS");

__device__ __forceinline__ void p2_load_raw(const bf16_t* proj, int tid, int b, int c, int g, u32x4 (&rv)[11]) {
    const int cg = tid & 63, rg = tid >> 6, lc = cg * 8;
    const int pcol = lc < 256 ? PXS + g * 256 + lc : (lc < 384 ? PBM + g * 128 + (lc - 256) : PCM + g * 128 + (lc - 384));
#pragma unroll
    for (int i = 0; i < 11; ++i) {
        const int f = c * CHUNK + rg * 8 - 3 + i;
        u32x4 v = {0u, 0u, 0u, 0u};
        if (f >= 0) v = *(const u32x4*)(proj + ((size_t)b * SEQ + f) * NIN + pcol);
        rv[i] = v;
    }
}
__device__ __forceinline__ void p2_ssd_unit(const Params& p, Ctx& F, int b, int c, int g, u32x4 (&rv)[11], bool has_next, int nb, int nc, int ng) {
    unsigned char* ws = p.ws;
    const bf16_t* proj = (const bf16_t*)(ws + WS_PROJ);
    bf16_t* ycat = (bf16_t*)(ws + WS_YCAT); bf16_t* cmc = (bf16_t*)(ws + WS_CMC);
    bf16_t* states = (bf16_t*)(ws + WS_STATES); float* acs_g = (float*)(ws + WS_ACS); float* cdec = (float*)(ws + WS_CDEC);
    const float* dtraw = (const float*)(ws + WS_DTRAW);
    const float* conv_w = p.in[3]; const float* conv_b = p.in[4]; const float* dt_bias = p.in[5]; const float* a_log = p.in[6]; const float* d_skip = p.in[7];
    LAS bf16_t* XS = (LAS bf16_t*)(F.lds + P2_XS); LAS bf16_t* BM = (LAS bf16_t*)(F.lds + P2_BM); LAS bf16_t* CM = (LAS bf16_t*)(F.lds + P2_CM);
    LAS float* CB = (LAS float*)(F.lds + P2_CB); LAS bf16_t* MH = (LAS bf16_t*)(F.lds + P2_MH); LAS bf16_t* XW = (LAS bf16_t*)(F.lds + P2_XW);
    LAS float* ACS = (LAS float*)(F.lds + P2_ACS); LAS float* DT = (LAS float*)(F.lds + P2_DT); LAS float* FAC = (LAS float*)(F.lds + P2_FAC);
    const int tid = F.tid, lane = F.lane, wave = F.wave, fr = lane & 15, fq = lane >> 4;
    const size_t tbase = (size_t)b * SEQ + (size_t)c * CHUNK;
#ifndef SKIP_A
    {
        const int cg = tid & 63, rg = tid >> 6, lc = cg * 8;
        int pcol, dld, dcol, kind;
        if (lc < 256) { pcol = PXS + g * 256 + lc; dld = XS_LD; dcol = lc; kind = 0; }
        else if (lc < 384) { pcol = PBM + g * 128 + (lc - 256); dld = BM_LD; dcol = lc - 256; kind = 1; }
        else { pcol = PCM + g * 128 + (lc - 384); dld = BM_LD; dcol = lc - 384; kind = 2; }
        LAS bf16_t* dst = kind == 0 ? XS : (kind == 1 ? BM : CM);
        const int ch = pcol - 512;
        float cw[4][8], cbv[8];
#pragma unroll
        for (int w = 0; w < 4; ++w) {
            const f32x4 a = *(const f32x4*)(conv_w + w * 1024 + ch), bq = *(const f32x4*)(conv_w + w * 1024 + ch + 4);
#pragma unroll
            for (int e = 0; e < 4; ++e) { cw[w][e] = a[e]; cw[w][4 + e] = bq[e]; }
        }
        { const f32x4 a = *(const f32x4*)(conv_b + ch), bq = *(const f32x4*)(conv_b + ch + 4);
#pragma unroll
          for (int e = 0; e < 4; ++e) { cbv[e] = a[e]; cbv[4 + e] = bq[e]; } }
#pragma unroll
        for (int r = 0; r < 8; ++r) {
            const int l = rg * 8 + r;
            float o[8];
#pragma unroll
            for (int e = 0; e < 8; ++e) o[e] = cbv[e];
#pragma unroll
            for (int w = 0; w < 4; ++w)
#pragma unroll
                for (int e = 0; e < 4; ++e) {
                    o[2 * e] += cw[w][2 * e] * bf2f(rv[r + w][e] & 0xffffu);
                    o[2 * e + 1] += cw[w][2 * e + 1] * bf2f(rv[r + w][e] >> 16);
                }
#pragma unroll
            for (int e = 0; e < 8; ++e) o[e] = silu_f(o[e]);
            u32x4 ov; ov.x = pk2(o[0], o[1]); ov.y = pk2(o[2], o[3]); ov.z = pk2(o[4], o[5]); ov.w = pk2(o[6], o[7]);
            *(LAS u32x4*)(dst + l * dld + dcol) = ov;
            if (kind == 2) *(u32x4*)(cmc + (tbase + l) * 256 + g * 128 + dcol) = ov;
        }
    }
#endif
    if (has_next) p2_load_raw(proj, tid, nb, nc, ng, rv);
    if (tid < 256) {
        const int l = tid >> 2, h = tid & 3, hh = g * 4 + h;
        const float v = dtraw[(tbase + l) * 8 + hh] + dt_bias[hh];
        const float dt = v > 20.f ? v : log1pf(expf(v));
        DT[l * 4 + h] = dt;
        ACS[l * 4 + h] = dt * (-expf(a_log[hh]));
    }
    __syncthreads();
    if (wave < 4) {
        float s = ACS[lane * 4 + wave];
#pragma unroll
        for (int o = 1; o < 64; o <<= 1) { const float t = __shfl_up(s, o); if (lane >= o) s += t; }
        ACS[lane * 4 + wave] = s;
        if (lane == 63) cdec[((size_t)b * NCH + c) * 8 + g * 4 + wave] = expf(s);
    }
    __syncthreads();
    if (tid < 256) {
        const int l = tid >> 2, h = tid & 3;
        acs_g[(tbase + l) * 8 + g * 4 + h] = ACS[l * 4 + h];
        FAC[l * 4 + h] = DT[l * 4 + h] * expf(ACS[63 * 4 + h] - ACS[l * 4 + h]);
    }
#pragma unroll
    for (int q = 0; q < 2; ++q) {
        const int tile = wave * 2 + q, mt = tile >> 2, nt = tile & 3;
        f32x4 acc = {0.f, 0.f, 0.f, 0.f};
#pragma unroll
        for (int ks = 0; ks < 4; ++ks) {
            const bf16x8 a = *(const LAS bf16x8*)(CM + (mt * 16 + fr) * BM_LD + ks * 32 + fq * 8);
            const bf16x8 bq = *(const LAS bf16x8*)(BM + (nt * 16 + fr) * BM_LD + ks * 32 + fq * 8);
            acc = mfma16(a, bq, acc);
        }
#pragma unroll
        for (int j = 0; j < 4; ++j) CB[(mt * 16 + 4 * fq + j) * CB_LD + nt * 16 + fr] = acc[j];
    }
    __syncthreads();
    {
        const int sI = lane;
        float as_[4], ds_[4];
#pragma unroll
        for (int h = 0; h < 4; ++h) { as_[h] = ACS[sI * 4 + h]; ds_[h] = DT[sI * 4 + h]; }
#pragma unroll 2
        for (int li = 0; li < 8; ++li) {
            const int l = li * 8 + wave;
            const float cb = CB[l * CB_LD + sI];
#pragma unroll
            for (int h = 0; h < 4; ++h) {
                const float v = (sI <= l) ? cb * __expf(ACS[l * 4 + h] - as_[h]) * ds_[h] : 0.f;
                MH[(h * 64 + l) * MH_LD + sI] = (bf16_t)f2bf(v);
            }
        }
#pragma unroll
        for (int i = 0; i < 4; ++i) {
            const int pc = tid + 512 * i, l = pc >> 5, c8 = pc & 31;
            const u32x4 xv = *(const LAS u32x4*)(XS + l * XS_LD + c8 * 8);
            const float f = FAC[l * 4 + (c8 >> 3)];
            u32x4 o;
#pragma unroll
            for (int e = 0; e < 4; ++e) o[e] = pk2(bf2f(xv[e] & 0xffffu) * f, bf2f(xv[e] >> 16) * f);
            *(LAS u32x4*)(XW + l * XS_LD + c8 * 8) = o;
        }
    }
    __syncthreads();
    typedef short v4i16 __attribute__((ext_vector_type(4)));
#define TR16(PTR) __builtin_amdgcn_ds_read_tr16_b64_v4i16((LAS v4i16*)(PTR))
#define CAT8(LO, HI) (bf16x8){LO[0], LO[1], LO[2], LO[3], HI[0], HI[1], HI[2], HI[3]}
    const int trr = fr >> 2, trc = 4 * (fr & 3);
#ifndef SKIP_E
    {
        const int h = wave >> 1, hh = g * 4 + h; const float dsk = d_skip[hh];
#pragma unroll 1
        for (int mq = 0; mq < 2; ++mq) {
            const int lt = 2 * (wave & 1) + mq;
            bf16x8 bmh[2];
#pragma unroll
            for (int ks = 0; ks < 2; ++ks) bmh[ks] = *(const LAS bf16x8*)(MH + (h * 64 + lt * 16 + fr) * MH_LD + ks * 32 + fq * 8);
#pragma unroll 1
            for (int pt = 0; pt < 4; ++pt) {
                f32x4 acc = {0.f, 0.f, 0.f, 0.f};
#pragma unroll
                for (int ks = 0; ks < 2; ++ks) {
                    const LAS bf16_t* bp = XS + (ks * 32 + 8 * fq + trr) * XS_LD + h * 64 + pt * 16 + trc;
                    const v4i16 lo = TR16(bp), hi = TR16(bp + 4 * XS_LD);
                    acc = mfma16(CAT8(lo, hi), bmh[ks], acc);
                }
                const int l = lt * 16 + fr, pp = pt * 16 + 4 * fq;
                const u32x2 xv = *(const LAS u32x2*)(XS + l * XS_LD + h * 64 + pp);
                u32x2 w;
                w.x = pk2(acc[0] + bf2f(xv.x & 0xffffu) * dsk, acc[1] + bf2f(xv.x >> 16) * dsk);
                w.y = pk2(acc[2] + bf2f(xv.y & 0xffffu) * dsk, acc[3] + bf2f(xv.y >> 16) * dsk);
                *(u32x2*)(ycat + (tbase + l) * DM + g * 256 + h * 64 + pp) = w;
            }
        }
    }
#endif
#ifndef SKIP_F
    {
        const int h = wave >> 1, hh = g * 4 + h;
        bf16_t* sbase = states + (((size_t)b * NCH + c) * 8 + hh) * 64 * 128;
#pragma unroll 1
        for (int mq = 0; mq < 2; ++mq) {
            const int mt = 2 * (wave & 1) + mq;
            bf16x8 xw[2];
#pragma unroll
            for (int ks = 0; ks < 2; ++ks) {
                const LAS bf16_t* bp = XW + (ks * 32 + 8 * fq + trr) * XS_LD + h * 64 + mt * 16 + trc;
                const v4i16 lo = TR16(bp), hi = TR16(bp + 4 * XS_LD);
                xw[ks] = CAT8(lo, hi);
            }
#pragma unroll 1
            for (int nt = 0; nt < 8; ++nt) {
                f32x4 acc = {0.f, 0.f, 0.f, 0.f};
#pragma unroll
                for (int ks = 0; ks < 2; ++ks) {
                    const LAS bf16_t* ap = BM + (ks * 32 + 8 * fq + trr) * BM_LD + nt * 16 + trc;
                    const v4i16 lo = TR16(ap), hi = TR16(ap + 4 * BM_LD);
                    acc = mfma16(CAT8(lo, hi), xw[ks], acc);
                }
                u32x2 w; w.x = pk2(acc[0], acc[1]); w.y = pk2(acc[2], acc[3]);
                *(u32x2*)(sbase + (size_t)(mt * 16 + fr) * 128 + nt * 16 + 4 * fq) = w;
            }
        }
    }
#undef TR16
#undef CAT8
#endif
    __syncthreads();
}

__device__ __forceinline__ void phase2(const Params& p, Ctx& F) {
#if defined(PROBE_PHASE) && (PROBE_PHASE == 20 || PROBE_PHASE == 21)
    F.ta = __builtin_amdgcn_s_memrealtime();
#endif
#ifdef USE_QK_PREPASS
    p2_qk_prepass(p, F);
#endif
#if defined(PROBE_PHASE) && (PROBE_PHASE == 20 || PROBE_PHASE == 21)
    VM_WAIT(); F.tb = __builtin_amdgcn_s_memrealtime();
#endif
    {
        const bf16_t* proj = (const bf16_t*)(p.ws + WS_PROJ);
        u32x4 rv[11];
        if (F.vcu < NB * NCH * 2) p2_load_raw(proj, F.tid, F.vcu >> 7, (F.vcu >> 1) & 63, F.vcu & 1, rv);
        for (int u = F.vcu; u < NB * NCH * 2; u += F.G) {
            const int g = u & 1, c = (u >> 1) & 63, b = u >> 7;
            const int un = u + F.G;
            p2_ssd_unit(p, F, b, c, g, rv, un < NB * NCH * 2, un >> 7, (un >> 1) & 63, un & 1);
        }
    }
#if defined(PROBE_PHASE) && (PROBE_PHASE == 20 || PROBE_PHASE == 21)
    VM_WAIT(); F.tc = __builtin_amdgcn_s_memrealtime();
#endif
}

__device__ __forceinline__ void p3_scan(const Params& p, Ctx& F) {
    bf16_t* states = (bf16_t*)(p.ws + WS_STATES); const float* cdec = (const float*)(p.ws + WS_CDEC);
    const int gtid = F.vcu * 512 + F.tid, nthr = F.G * 512;
    for (int e = gtid; e < NB * 8 * 64 * 32; e += nthr) {
        const int n4 = e & 31, pp = (e >> 5) & 63, hh = (e >> 11) & 7, b = e >> 14;
        f32x4 carry = {0.f, 0.f, 0.f, 0.f};
        for (int c0 = 0; c0 < NCH; c0 += 16) {
            u32x2 s[16]; float dc[16];
#pragma unroll
            for (int i = 0; i < 16; ++i) {
                s[i] = *(const u32x2*)(states + ((((size_t)b * NCH + c0 + i) * 8 + hh) * 64 + pp) * 128 + n4 * 4);
                dc[i] = cdec[((size_t)b * NCH + c0 + i) * 8 + hh];
            }
#pragma unroll
            for (int i = 0; i < 16; ++i) {
                u32x2 w; w.x = pk2(carry[0], carry[1]); w.y = pk2(carry[2], carry[3]);
                *(u32x2*)(states + ((((size_t)b * NCH + c0 + i) * 8 + hh) * 64 + pp) * 128 + n4 * 4) = w;
                const f32x4 sv = {bf2f(s[i].x & 0xffffu), bf2f(s[i].x >> 16), bf2f(s[i].y & 0xffffu), bf2f(s[i].y >> 16)};
                carry = carry * dc[i] + sv;
            }
        }
    }
}

namespace att {
constexpr int NW = 8, QBLK = 32, KVBLK = 64;
constexpr float SCALE = 0.125f, THR = 8.f;
constexpr int SHM_V = KVBLK * 128 * 2, SHM_K = KVBLK * 64 * 2;
constexpr int LDS_V = 0, LDS_K = 2 * SHM_V, LDS_WS = LDS_K + 2 * SHM_K, LDS_END = LDS_WS + NW * 64 * 4;
#define KSWZ64(row, colB) ((row) * 128 + ((colB) ^ ((((row) >> 1) & 7) << 4)))
#define SBAR() __builtin_amdgcn_sched_barrier(0)
__device__ __forceinline__ int crow(int r, int hi) { return (r & 3) + 8 * (r >> 2) + 4 * hi; }
__device__ __forceinline__ unsigned cvtpk(float lo, float hi) { unsigned r; asm volatile("v_cvt_pk_bf16_f32 %0, %1, %2" : "=v"(r) : "v"(lo), "v"(hi)); return r; }

__device__ __forceinline__ void partialSM(f32x16& p0, f32x16& p1, float& m_reg, float& mn, float& alpha) {
    constexpr float C = SCALE * 1.4426950408889634f;
    float pmax = p0[0];
#pragma unroll
    for (int r = 1; r < 16; ++r) pmax = fmaxf(pmax, p0[r]);
#pragma unroll
    for (int r = 0; r < 16; ++r) pmax = fmaxf(pmax, p1[r]);
    { auto rr = __builtin_amdgcn_permlane32_swap(__float_as_uint(pmax), __float_as_uint(pmax), false, false);
      pmax = fmaxf(__uint_as_float(rr[0]), __uint_as_float(rr[1])); }
    if (__builtin_expect(__all(pmax - m_reg <= THR / SCALE), 1)) { mn = m_reg; alpha = 1.f; }
    else { mn = fmaxf(m_reg, pmax); alpha = __builtin_amdgcn_exp2f((m_reg - mn) * C); m_reg = mn; }
    const float mnC = -mn * C;
#pragma unroll
    for (int r = 0; r < 16; ++r) p0[r] = fmaf(p0[r], C, mnC);
#pragma unroll
    for (int r = 0; r < 16; ++r) p1[r] = fmaf(p1[r], C, mnC);
#pragma unroll
    for (int r = 0; r < 16; ++r) p0[r] = __builtin_amdgcn_exp2f(p0[r]);
}
__device__ __forceinline__ void finishSM(f32x16& p0, f32x16& p1, float alpha, float& l_reg, bf16x8& pa0, bf16x8& pa1, bf16x8& pa2, bf16x8& pa3) {
#pragma unroll
    for (int r = 0; r < 16; ++r) p1[r] = __builtin_amdgcn_exp2f(p1[r]);
    float ps = 0;
#pragma unroll
    for (int r = 0; r < 16; ++r) ps += p0[r];
#pragma unroll
    for (int r = 0; r < 16; ++r) ps += p1[r];
    { auto rr = __builtin_amdgcn_permlane32_swap(__float_as_uint(ps), __float_as_uint(ps), false, false);
      ps = __uint_as_float(rr[0]) + __uint_as_float(rr[1]); }
    l_reg = l_reg * alpha + ps;
#define PK4(P, BASE, OUT) do { unsigned a0 = cvtpk(P[BASE + 0], P[BASE + 1]), a1 = cvtpk(P[BASE + 2], P[BASE + 3]);   \
    unsigned b0 = cvtpk(P[BASE + 4], P[BASE + 5]), b1 = cvtpk(P[BASE + 6], P[BASE + 7]);                              \
    auto r0 = __builtin_amdgcn_permlane32_swap(a0, b0, false, false); auto r1 = __builtin_amdgcn_permlane32_swap(a1, b1, false, false); \
    u32x4 w = {r0[0], r1[0], r0[1], r1[1]}; OUT = *reinterpret_cast<bf16x8*>(&w); } while (0)
    PK4(p0, 0, pa0); PK4(p0, 8, pa1); PK4(p1, 0, pa2); PK4(p1, 8, pa3);
#undef PK4
}
__device__ __forceinline__ void qkt(f32x16& p0, f32x16& p1, const char* Ks, const bf16x8* qr, int r32, int hi) {
    p0 = f32x16{}; p1 = f32x16{};
#pragma unroll
    for (int d0 = 0; d0 < 4; ++d0) {
        const int cb = (d0 * 16 + hi * 8) * 2;
        const bf16x8 b0 = *reinterpret_cast<const bf16x8*>(Ks + KSWZ64(r32, cb));
        const bf16x8 b1 = *reinterpret_cast<const bf16x8*>(Ks + KSWZ64(32 + r32, cb));
        p0 = mfma32(b0, qr[d0], p0);
        p1 = mfma32(b1, qr[d0], p1);
    }
}
__device__ __forceinline__ void maskfill(f32x16& p0, f32x16& p1, bool m) {
    if (m) {
        asm volatile("; masked tile");
#pragma unroll
        for (int r = 0; r < 16; ++r) { p0[r] = -1e30f; p1[r] = -1e30f; }
    }
}
__device__ __forceinline__ int v_st(int k, int c) { const int kk = (k & ~0xC) | ((k & 4) << 1) | ((k & 8) >> 1); return ((kk >> 3) * 4 + (c >> 5)) * 512 + ((kk & 7) * 32 + (c & 31)) * 2; }
__device__ __forceinline__ int v_rd_base(int lane) { return ((lane & 3) << 3) | (((lane >> 2) & 3) << 6) | (((lane >> 4) & 1) << 5) | (((lane >> 5) & 1) << 8); }
constexpr int v_rd_off(int d0, int ks, int half) { return d0 * 512 + ks * 4096 + half * 2048; }
template <int OFF> __device__ __forceinline__ s16x4 tr_read(int vb) {
    s16x4 r; asm volatile("ds_read_b64_tr_b16 %0, %1 offset:%2" : "=&v"(r) : "v"(vb), "i"(OFF) : "memory"); return r;
}
template <int D0> __device__ __forceinline__ void pv_one(f32x16& od, int vb, bf16x8 pa0, bf16x8 pa1, bf16x8 pa2, bf16x8 pa3) {
    const s16x4 l0 = tr_read<v_rd_off(D0, 0, 0)>(vb), h0 = tr_read<v_rd_off(D0, 0, 1)>(vb), l1 = tr_read<v_rd_off(D0, 1, 0)>(vb), h1 = tr_read<v_rd_off(D0, 1, 1)>(vb);
    const s16x4 l2 = tr_read<v_rd_off(D0, 2, 0)>(vb), h2 = tr_read<v_rd_off(D0, 2, 1)>(vb), l3 = tr_read<v_rd_off(D0, 3, 0)>(vb), h3 = tr_read<v_rd_off(D0, 3, 1)>(vb);
    asm volatile("s_waitcnt lgkmcnt(0)" ::: "memory"); SBAR();
#define PKV(L, H) (bf16x8){L[0], L[1], L[2], L[3], H[0], H[1], H[2], H[3]}
    od = mfma32(pa0, PKV(l0, h0), od);
    od = mfma32(pa1, PKV(l1, h1), od);
    od = mfma32(pa2, PKV(l2, h2), od);
    od = mfma32(pa3, PKV(l3, h3), od);
#undef PKV
}
__device__ __forceinline__ void pv_d0(f32x16* o, int vb, bf16x8 pa0, bf16x8 pa1, bf16x8 pa2, bf16x8 pa3) {
    pv_one<0>(o[0], vb, pa0, pa1, pa2, pa3); pv_one<1>(o[1], vb, pa0, pa1, pa2, pa3); pv_one<2>(o[2], vb, pa0, pa1, pa2, pa3); pv_one<3>(o[3], vb, pa0, pa1, pa2, pa3);
}

__device__ __forceinline__ void attn_pass(const bf16_t* __restrict__ Qb, const bf16_t* __restrict__ Kh, const bf16_t* __restrict__ Vh, int NT, int my_last, char* lds, f32x16 (&o)[4]) {
    const int tid = threadIdx.x, wid = tid >> 6, lane = tid & 63, r32 = lane & 31, hi = lane >> 5;
    char* V_lds = lds + LDS_V; char* K_lds = lds + LDS_K;
    float* wsf = (float*)(lds + LDS_WS) + wid * 64; float* li_l = wsf; float* al_l = wsf + 32;
    float m_reg = -1e30f, l_reg = 0.f;
#pragma unroll
    for (int d = 0; d < 4; ++d) o[d] = f32x16{};
    bf16x8 qr[4];
    const bf16_t* Qw = Qb + (size_t)(wid * QBLK + r32) * NIN + hi * 8;
#pragma unroll
    for (int d0 = 0; d0 < 4; ++d0) qr[d0] = *reinterpret_cast<const bf16x8*>(Qw + d0 * 16);
    const int sr = tid >> 4, sc = (tid & 15) * 8, vst0 = v_st(sr, sc), vst1 = v_st(32 + sr, sc);
    const int krow = tid >> 3, kc8 = (tid & 7) * 8, kst = KSWZ64(krow, kc8 * 2);
    const int vb0 = (int)(uintptr_t)V_lds + v_rd_base(lane);
    struct { bf16x8 vs0, vs1, ks; } sr_[2];
#define SLOAD(i, k0) do { sr_[i].vs0 = *reinterpret_cast<const bf16x8*>(&Vh[(size_t)((k0) + sr) * NIN + sc]); sr_[i].vs1 = *reinterpret_cast<const bf16x8*>(&Vh[(size_t)((k0) + 32 + sr) * NIN + sc]); \
    sr_[i].ks = *reinterpret_cast<const bf16x8*>(&Kh[(size_t)((k0) + krow) * NIN + kc8]); } while (0)
#define SWRITE(b, i) do { *(bf16x8*)(V_lds + (b) * SHM_V + vst0) = sr_[i].vs0; *(bf16x8*)(V_lds + (b) * SHM_V + vst1) = sr_[i].vs1; \
    *(bf16x8*)(K_lds + (b) * SHM_K + kst) = sr_[i].ks; } while (0)
#define SWAIT() asm volatile("s_waitcnt vmcnt(3)" ::: "memory")
#define RESC(a) do { if (__any((a) < 1.f)) { if (hi == 0) al_l[r32] = (a); asm volatile("s_waitcnt lgkmcnt(0)" ::: "memory"); \
    _Pragma("unroll") for (int d = 0; d < 4; ++d) _Pragma("unroll") for (int r = 0; r < 16; ++r) o[d][r] *= al_l[crow(r, hi)]; } } while (0)
    f32x16 pA0, pA1, pB0, pB1; float mnA, mnB, alA, alB; bf16x8 pa0, pa1, pa2, pa3;
    constexpr int SE = 0, SO = 1;
    __syncthreads();
    SLOAD(SE, 0); asm volatile("s_waitcnt vmcnt(0)" ::: "memory"); SWRITE(0, SE); __syncthreads();
    qkt(pA0, pA1, K_lds, qr, r32, hi); partialSM(pA0, pA1, m_reg, mnA, alA);
    SLOAD(SO, KVBLK); if (2 < NT) SLOAD(SE, 2 * KVBLK);
    SWAIT(); SWRITE(1, SO); __syncthreads();
    for (int j = 1; j + 1 < NT; j += 2) {
        qkt(pB0, pB1, K_lds + SHM_K, qr, r32, hi); maskfill(pB0, pB1, j > my_last);
        finishSM(pA0, pA1, alA, l_reg, pa0, pa1, pa2, pa3);
        SLOAD(SO, (j + 2) * KVBLK);
        pv_d0(o, vb0, pa0, pa1, pa2, pa3); partialSM(pB0, pB1, m_reg, mnB, alB);
        __syncthreads(); SWAIT(); SWRITE(0, SE);
        RESC(alB); __syncthreads();
        qkt(pA0, pA1, K_lds, qr, r32, hi); maskfill(pA0, pA1, j + 1 > my_last);
        finishSM(pB0, pB1, alB, l_reg, pa0, pa1, pa2, pa3);
        if (j + 3 < NT) SLOAD(SE, (j + 3) * KVBLK);
        pv_d0(o, vb0 + SHM_V, pa0, pa1, pa2, pa3); partialSM(pA0, pA1, m_reg, mnA, alA);
        __syncthreads(); SWAIT(); SWRITE(1, SO);
        RESC(alA); __syncthreads();
    }
    SBAR(); qkt(pB0, pB1, K_lds + SHM_K, qr, r32, hi); maskfill(pB0, pB1, NT - 1 > my_last);
    finishSM(pA0, pA1, alA, l_reg, pa0, pa1, pa2, pa3); SBAR();
    pv_d0(o, vb0, pa0, pa1, pa2, pa3); partialSM(pB0, pB1, m_reg, mnB, alB);
    __syncthreads(); RESC(alB);
    finishSM(pB0, pB1, alB, l_reg, pa0, pa1, pa2, pa3); SBAR();
    pv_d0(o, vb0 + SHM_V, pa0, pa1, pa2, pa3);
    if (hi == 0) li_l[r32] = l_reg;
    asm volatile("s_waitcnt lgkmcnt(0)" ::: "memory");
#pragma unroll
    for (int r = 0; r < 16; ++r) {
        const float rl = __builtin_amdgcn_rcpf(li_l[crow(r, hi)]);
#pragma unroll
        for (int d = 0; d < 4; ++d) o[d][r] *= rl;
    }
    asm volatile("s_waitcnt vmcnt(0)" ::: "memory");
    __syncthreads();
#undef SLOAD
#undef SWRITE
#undef SWAIT
#undef RESC
}
}

__device__ __forceinline__ void p3_attn_unit(const Params& p, Ctx& F, int b, int h, int qb, float* oscr) {
    const bf16_t* proj = (const bf16_t*)(p.ws + WS_PROJ);
    bf16_t* ycat = (bf16_t*)(p.ws + WS_YCAT);
    const float lam = ((const float*)(p.ws + WS_MISC))[0];
    const float* subw = p.in[15];
    const int tid = F.tid, wid = F.wave, lane = F.lane, r32 = lane & 31, hi = lane >> 5;
    const size_t rowbase = (size_t)b * SEQ; const int q0 = qb * 256;
    const int NT = (q0 + 256) / 64, my_last = (q0 + 32 * wid) / 64;
    f32x16 o[4];
    for (int j = 0; j < 2; ++j) {
        const bf16_t* Qb = proj + (rowbase + q0) * NIN + PQ + h * 128 + j * 64;
        const bf16_t* Kh = proj + rowbase * NIN + PK + h * 128 + j * 64;
        const bf16_t* Vh = proj + rowbase * NIN + PV + h * 128;
        att::attn_pass(Qb, Kh, Vh, NT, my_last, (char*)F.lds, o);
        if (j == 0) {
            float* my = oscr + tid * 64;
#pragma unroll
            for (int d = 0; d < 4; ++d)
#pragma unroll
                for (int r4 = 0; r4 < 4; ++r4) *(f32x4*)(my + d * 16 + r4 * 4) = (f32x4){o[d][4 * r4], o[d][4 * r4 + 1], o[d][4 * r4 + 2], o[d][4 * r4 + 3]};
        }
    }
    float wv[4];
#pragma unroll
    for (int d = 0; d < 4; ++d) wv[d] = subw[d * 32 + r32] * (1.f - LAMBDA_INIT);
#pragma unroll
    for (int r = 0; r < 16; ++r) {
        float v[4]; float ss = 0.f;
#pragma unroll
        for (int d = 0; d < 4; ++d) { v[d] = oscr[tid * 64 + d * 16 + r] - lam * o[d][r]; ss += v[d] * v[d]; }
        ss += __shfl_xor(ss, 1); ss += __shfl_xor(ss, 2); ss += __shfl_xor(ss, 4); ss += __shfl_xor(ss, 8); ss += __shfl_xor(ss, 16);
        const float rs = rsqrtf(ss * (1.f / 128.f) + EPSN);
        const size_t row = rowbase + q0 + wid * 32 + att::crow(r, hi);
#pragma unroll
        for (int d = 0; d < 4; ++d) ycat[row * DM + 512 + h * 128 + d * 32 + r32] = (bf16_t)f2bf(v[d] * rs * wv[d]);
    }
}

__device__ __forceinline__ void phase3(const Params& p, Ctx& F) {
#if defined(PROBE_PHASE) && (PROBE_PHASE == 30 || PROBE_PHASE == 31)
    F.ta = __builtin_amdgcn_s_memrealtime();
#endif
    p3_scan(p, F);
#if defined(PROBE_PHASE) && (PROBE_PHASE == 30 || PROBE_PHASE == 31)
    VM_WAIT(); F.tb = __builtin_amdgcn_s_memrealtime();
#endif
    float* oscr = p.out + (size_t)F.vcu * (64 * 512);
    for (int ui = F.vcu; ui < 512; ui += F.G) {
        const int pi = ui & 255, bh = pi >> 3, s = pi & 7, b = bh >> 2, h = bh & 3;
        p3_attn_unit(p, F, b, h, ui < 256 ? 15 - s : s, oscr);
    }
#if defined(PROBE_PHASE) && (PROBE_PHASE == 30 || PROBE_PHASE == 31)
    VM_WAIT(); F.tc = __builtin_amdgcn_s_memrealtime();
#endif
}

constexpr int P4_PREV = 0, P4_CM = 69632, P4_ACS = 87040, P4_Y = 88064, Y_LD = 257;
static_assert(P4_Y + 64 * Y_LD * 4 <= LDS_BYTES, "P4 LDS");
__device__ __forceinline__ void p4_load(const bf16_t* states, const bf16_t* cmc, int tid, int b, int c, int g, u32x4 (&pv)[8], u32x4 (&cv)[2]) {
    const size_t tbase = (size_t)b * SEQ + (size_t)c * CHUNK;
#pragma unroll
    for (int i = 0; i < 8; ++i) {
        const int e = tid + 512 * i, n8 = e & 15, pp = (e >> 4) & 63, h = e >> 10;
        pv[i] = *(const u32x4*)(states + ((((size_t)b * NCH + c) * 8 + g * 4 + h) * 64 + pp) * 128 + n8 * 8);
    }
#pragma unroll
    for (int i = 0; i < 2; ++i) {
        const int e = tid + 512 * i, l = e >> 4, c8 = e & 15;
        cv[i] = *(const u32x4*)(cmc + (tbase + l) * 256 + g * 128 + c8 * 8);
    }
}
__device__ __forceinline__ void p4_unit(const Params& p, Ctx& F, int b, int c, int g, u32x4 (&pv)[8], u32x4 (&cv)[2], bool has_next, int nb, int nc, int ng) {
    unsigned char* ws = p.ws;
    const bf16_t* proj = (const bf16_t*)(ws + WS_PROJ);
    bf16_t* ycat = (bf16_t*)(ws + WS_YCAT); const bf16_t* cmc = (const bf16_t*)(ws + WS_CMC);
    const bf16_t* states = (const bf16_t*)(ws + WS_STATES); const float* acs_g = (const float*)(ws + WS_ACS);
    const float* normw = p.in[8];
    LAS bf16_t* PREV = (LAS bf16_t*)(F.lds + P4_PREV); LAS bf16_t* CM = (LAS bf16_t*)(F.lds + P4_CM);
    LAS float* ACS = (LAS float*)(F.lds + P4_ACS); LAS float* Y = (LAS float*)(F.lds + P4_Y);
    const int tid = F.tid, lane = F.lane, wave = F.wave, fr = lane & 15, fq = lane >> 4;
    const size_t tbase = (size_t)b * SEQ + (size_t)c * CHUNK;
#pragma unroll
    for (int i = 0; i < 8; ++i) {
        const int e = tid + 512 * i, n8 = e & 15, pp = (e >> 4) & 63, h = e >> 10;
        *(LAS u32x4*)(PREV + (h * 64 + pp) * BM_LD + n8 * 8) = pv[i];
    }
#pragma unroll
    for (int i = 0; i < 2; ++i) {
        const int e = tid + 512 * i, l = e >> 4, c8 = e & 15;
        *(LAS u32x4*)(CM + l * BM_LD + c8 * 8) = cv[i];
    }
    if (has_next) p4_load(states, cmc, tid, nb, nc, ng, pv, cv);
    if (tid < 256) { const int l = tid >> 2, h = tid & 3; ACS[l * 4 + h] = acs_g[(tbase + l) * 8 + g * 4 + h]; }
    __syncthreads();
    {
        const int h = wave >> 1;
#pragma unroll
        for (int mq = 0; mq < 2; ++mq) {
            const int mt = 2 * (wave & 1) + mq;
            bf16x8 a[4];
#pragma unroll
            for (int ks = 0; ks < 4; ++ks) a[ks] = *(const LAS bf16x8*)(CM + (mt * 16 + fr) * BM_LD + ks * 32 + fq * 8);
#pragma unroll
            for (int nt = 0; nt < 4; ++nt) {
                f32x4 acc = {0.f, 0.f, 0.f, 0.f};
#pragma unroll
                for (int ks = 0; ks < 4; ++ks) {
                    const bf16x8 bq = *(const LAS bf16x8*)(PREV + (h * 64 + nt * 16 + fr) * BM_LD + ks * 32 + fq * 8);
                    acc = mfma16(a[ks], bq, acc);
                }
#pragma unroll
                for (int j = 0; j < 4; ++j) {
                    const int l = mt * 16 + 4 * fq + j, col = h * 64 + nt * 16 + fr;
                    Y[l * Y_LD + col] = acc[j] * __expf(ACS[l * 4 + h]);
                }
            }
        }
    }
    __syncthreads();
    {
        const int c8 = lane & 31, hr = lane >> 5;
        const f32x4 nw0 = *(const f32x4*)(normw + g * 256 + c8 * 8), nw1 = *(const f32x4*)(normw + g * 256 + c8 * 8 + 4);
#pragma unroll 2
        for (int r = 0; r < 4; ++r) {
            const int l = wave * 8 + r * 2 + hr;
            const size_t t = tbase + l;
            const u32x4 yl = *(const u32x4*)(ycat + t * DM + g * 256 + c8 * 8);
            const u32x4 zz = *(const u32x4*)(proj + t * NIN + PZ + g * 256 + c8 * 8);
            float v[8]; float ss = 0.f;
#pragma unroll
            for (int e = 0; e < 4; ++e) {
                const float y0 = bf2f(yl[e] & 0xffffu) + Y[l * Y_LD + c8 * 8 + 2 * e], y1 = bf2f(yl[e] >> 16) + Y[l * Y_LD + c8 * 8 + 2 * e + 1];
                v[2 * e] = y0 * silu_f(bf2f(zz[e] & 0xffffu)); v[2 * e + 1] = y1 * silu_f(bf2f(zz[e] >> 16));
                ss += v[2 * e] * v[2 * e] + v[2 * e + 1] * v[2 * e + 1];
            }
            ss += __shfl_xor(ss, 1); ss += __shfl_xor(ss, 2); ss += __shfl_xor(ss, 4); ss += __shfl_xor(ss, 8); ss += __shfl_xor(ss, 16);
            const float rs = rsqrtf(ss * (1.f / 256.f) + EPSN);
            u32x4 o;
            o.x = pk2(v[0] * rs * nw0[0], v[1] * rs * nw0[1]); o.y = pk2(v[2] * rs * nw0[2], v[3] * rs * nw0[3]);
            o.z = pk2(v[4] * rs * nw1[0], v[5] * rs * nw1[1]); o.w = pk2(v[6] * rs * nw1[2], v[7] * rs * nw1[3]);
            *(u32x4*)(ycat + t * DM + g * 256 + c8 * 8) = o;
        }
    }
    __syncthreads();
}
__device__ __forceinline__ void phase4(const Params& p, Ctx& F) {
    const bf16_t* states = (const bf16_t*)(p.ws + WS_STATES); const bf16_t* cmc = (const bf16_t*)(p.ws + WS_CMC);
    u32x4 pv[8], cv[2];
    if (F.vcu < NB * NCH * 2) p4_load(states, cmc, F.tid, F.vcu >> 7, (F.vcu >> 1) & 63, F.vcu & 1, pv, cv);
    for (int u = F.vcu; u < NB * NCH * 2; u += F.G) {
        const int g = u & 1, c = (u >> 1) & 63, b = u >> 7;
        const int un = u + F.G;
        p4_unit(p, F, b, c, g, pv, cv, un < NB * NCH * 2, un >> 7, (un >> 1) & 63, un & 1);
    }
}

__device__ __forceinline__ unsigned f2ord(float f) { const unsigned u = __float_as_uint(f); return (u >> 31) ? ~u : (u | 0x80000000u); }
__device__ __forceinline__ float ord2f(unsigned u) { return __uint_as_float((u >> 31) ? (u & 0x7fffffffu) : ~u); }
#define CE_DESC(A, B) do { const unsigned hi_ = (A) > (B) ? (A) : (B); const unsigned lo_ = (A) > (B) ? (B) : (A); (A) = hi_; (B) = lo_; } while (0)
template <int K, int J> __device__ __forceinline__ void bstage(unsigned (&r)[16]) {
#pragma unroll
    for (int i = 0; i < 16; ++i) { const int l = i ^ J; if (l > i) { if ((i & K) == 0) CE_DESC(r[i], r[l]); else CE_DESC(r[l], r[i]); } }
}
__device__ __forceinline__ void bitonic_merge16(unsigned (&r)[16]) { bstage<16, 8>(r); bstage<16, 4>(r); bstage<16, 2>(r); bstage<16, 1>(r); }
__device__ __forceinline__ void bitonic_sort16(unsigned (&r)[16]) {
    bstage<2, 1>(r); bstage<4, 2>(r); bstage<4, 1>(r); bstage<8, 4>(r); bstage<8, 2>(r); bstage<8, 1>(r); bitonic_merge16(r);
}
__device__ __forceinline__ void top16_merge(unsigned (&r)[16], const unsigned (&n)[16]) {
#pragma unroll
    for (int i = 0; i < 16; ++i) r[i] = r[i] > n[15 - i] ? r[i] : n[15 - i];
    bitonic_merge16(r);
}
template <int XM> __device__ __forceinline__ unsigned quad_xor(unsigned v) {
    static_assert(XM == 1 || XM == 2, "quad permute");
    return (unsigned)__builtin_amdgcn_mov_dpp((int)v, XM == 1 ? 0xB1 : 0x4E, 0xf, 0xf, true);
}
template <int XM> __device__ __forceinline__ void top16_merge_lane_t(unsigned (&r)[16]) {
    unsigned n[16];
#pragma unroll
    for (int i = 0; i < 16; ++i) n[i] = quad_xor<XM>(r[i]);
    top16_merge(r, n);
}
__device__ __forceinline__ void top16_merge_lane(unsigned (&r)[16], int xm) {
    if (xm == 1) top16_merge_lane_t<1>(r); else top16_merge_lane_t<2>(r);
}
__device__ __forceinline__ void p7_cand_table(LAS unsigned char* CAND, int tid) {
    if (tid < 52) {
        int c = 0; unsigned char v = 255;
        for (int a = 0; a < 16; ++a) for (int b = 0; b < 16 / (a + 1); ++b) { if (c == tid) v = (unsigned char)(a * 16 + b); ++c; }
        CAND[tid] = v;
    }
}
__device__ __forceinline__ void route16(const bf16_t* qp, const float* rowsq, float* gwo, size_t t0, int lane, LAS unsigned* lists, const LAS unsigned char* CAND, LAS unsigned short* IDX) {
    const int tok = lane >> 2, part = lane & 3;
    const float r2 = rsqrtf(rowsq[t0 + tok] * (1.f / DM) + EPSN);
    u32x4 nxt[2][4];
#pragma unroll
    for (int j = 0; j < 2; ++j)
#pragma unroll
        for (int q = 0; q < 4; ++q) nxt[j][q] = __builtin_nontemporal_load((const u32x4*)(qp + (t0 + tok) * 2048 + j * 128 + part * 32 + q * 8));
#pragma unroll 1
    for (int h = 0; h < 8; ++h) {
        u32x4 raw[2][4];
#pragma unroll
        for (int j = 0; j < 2; ++j)
#pragma unroll
            for (int q = 0; q < 4; ++q) raw[j][q] = nxt[j][q];
        if (h < 7) {
#pragma unroll
            for (int j = 0; j < 2; ++j)
#pragma unroll
                for (int q = 0; q < 4; ++q) nxt[j][q] = __builtin_nontemporal_load((const u32x4*)(qp + (t0 + tok) * 2048 + (h + 1) * 256 + j * 128 + part * 32 + q * 8));
        }
#pragma unroll
        for (int j = 0; j < 2; ++j) {
            unsigned r[16], n[16];
#pragma unroll
            for (int q = 0; q < 2; ++q)
#pragma unroll
                for (int e = 0; e < 4; ++e) {
                    r[q * 8 + 2 * e]     = (f2ord(bf2f(raw[j][q][e] & 0xffffu) * r2) & ~127u) | (unsigned)(part * 32 + q * 8 + 2 * e);
                    r[q * 8 + 2 * e + 1] = (f2ord(bf2f(raw[j][q][e] >> 16) * r2) & ~127u) | (unsigned)(part * 32 + q * 8 + 2 * e + 1);
                    n[q * 8 + 2 * e]     = (f2ord(bf2f(raw[j][2 + q][e] & 0xffffu) * r2) & ~127u) | (unsigned)(part * 32 + 16 + q * 8 + 2 * e);
                    n[q * 8 + 2 * e + 1] = (f2ord(bf2f(raw[j][2 + q][e] >> 16) * r2) & ~127u) | (unsigned)(part * 32 + 16 + q * 8 + 2 * e + 1);
                }
            bitonic_sort16(r); bitonic_sort16(n);
            top16_merge(r, n);
            top16_merge_lane(r, 1);
            top16_merge_lane(r, 2);
            if (part == 0) {
#pragma unroll
                for (int k = 0; k < 16; ++k) lists[(tok * 2 + j) * 16 + k] = r[k];
            }
        }
        LDS_WAIT(); __builtin_amdgcn_wave_barrier();
        {
            const LAS unsigned* l0 = lists + (2 * tok) * 16; const LAS unsigned* l1 = lists + (2 * tok + 1) * 16;
            unsigned r[16];
#pragma unroll
            for (int m = 0; m < 13; ++m) {
                const unsigned ab = CAND[part + 4 * m];
                const unsigned a = (ab >> 4) & 15u, bb = ab & 15u;
                const float sum = ord2f(l0[a] & ~127u) + ord2f(l1[bb] & ~127u);
                r[m] = ab == 255u ? 0u : ((f2ord(sum) & ~255u) | ab);
            }
            r[13] = 0u; r[14] = 0u; r[15] = 0u;
            bitonic_sort16(r);
            top16_merge_lane(r, 1);
            top16_merge_lane(r, 2);
            float val[16]; unsigned ex[16]; float mx = -1e30f;
#pragma unroll
            for (int k = 0; k < 16; ++k) {
                const unsigned pos = r[k] & 255u, a = pos >> 4, bb = pos & 15u;
                const unsigned w0 = l0[a], w1 = l1[bb];
                ex[k] = (w0 & 127u) * 128u + (w1 & 127u);
                val[k] = ord2f(w0 & ~127u) + ord2f(w1 & ~127u);
                mx = fmaxf(mx, val[k]);
            }
            float sum = 0.f;
#pragma unroll
            for (int k = 0; k < 16; ++k) { val[k] = __expf(val[k] - mx); sum += val[k]; }
            const float inv = __builtin_amdgcn_rcpf(sum);
            float* go = gwo + ((t0 + tok) * 8 + h) * 16;
            if (part == 0) {
#pragma unroll
                for (int k = 0; k < 16; ++k) { IDX[tok * 128 + h * 16 + k] = (unsigned short)ex[k]; go[k] = val[k] * inv; }
            }
        }
        LDS_WAIT(); __builtin_amdgcn_wave_barrier();
    }
}

__device__ __forceinline__ void xcd_pace(const XcdBarrier& b, int slot) {
    __syncthreads();
    if (threadIdx.x == 0) {
        const unsigned nloc = b.st[0];
        unsigned* w = b.bar + XCD_BAR_WORDS + (slot * 16 + (int)b.x) * 16;
        (void)xb_add(w, 1u);
        unsigned sp = 0;
        while (xb_ld(w) < nloc && ++sp < 3000u) __builtin_amdgcn_s_sleep(1);
    }
    __syncthreads();
}
__device__ __forceinline__ float gelu_erf(float x) { return 0.5f * x * (1.f + erff(x * 0.70710678118654752f)); }
typedef float f32x2 __attribute__((ext_vector_type(2)));
constexpr int P8_NSL = 8, P8_SLC = DM / P8_NSL, P8_KS = P8_SLC / 32;
constexpr float P8_XS = 32.f;
static_assert(P8_SLC == 128, "lane mappings assume 128-column (128-byte) slices");
__device__ __forceinline__ void phase8(const Params& p, Ctx& F, const XcdBarrier& bar) {
    const bool pace = false;
    unsigned char* ws = p.ws;
    const unsigned char* uq = ws + WS_UB; const unsigned char* vq = ws + WS_VB;
    const float* rsu = (const float*)(ws + WS_RSU); const float* rsv = (const float*)(ws + WS_RSV);
    const bf16_t* x1b = (const bf16_t*)(ws + WS_X1B);
    const float* rowsq = (const float*)(ws + WS_CTL) + CW_ROWSQ;
    const float* gwi = (const float*)(ws + WS_GW);
    float* out = p.out;
    const int lane = F.lane, fr = lane & 15, fq = lane >> 4;
    LAS unsigned short* IDX = (LAS unsigned short*)(F.lds + F.wave * 20480);
    LAS float* COEF = (LAS float*)(F.lds + F.wave * 20480 + 4096);
    LAS unsigned char* STG = (LAS unsigned char*)COEF;
    LAS unsigned char* CAND = STG + 2048;
    __syncthreads();
    p7_cand_table(CAND, lane);
    LDS_WAIT(); __builtin_amdgcn_wave_barrier();
    for (int task = F.gw; task < TOK / 16; task += F.ngw) {
        const size_t t0 = (size_t)task * 16;
#if defined(PROBE_PHASE) && PROBE_PHASE == 82
        F.ta = __builtin_amdgcn_s_memrealtime();
#endif
        route16((const bf16_t*)(ws + WS_QP), rowsq, (float*)(ws + WS_GW), t0, lane, (LAS unsigned*)STG, CAND, IDX);
#if defined(PROBE_PHASE) && PROBE_PHASE == 82
        F.tb = __builtin_amdgcn_s_memrealtime();
#endif
        const float r2 = rsqrtf(rowsq[t0 + fr] * (1.f / DM) + EPSN);
        VM_WAIT(); LDS_WAIT(); __builtin_amdgcn_wave_barrier();
#if defined(PROBE_PHASE) && (PROBE_PHASE == 80 || PROBE_PHASE == 81)
        F.ta = __builtin_amdgcn_s_memrealtime();
#endif
        f32x4 accU[8];
#pragma unroll
        for (int h = 0; h < 8; ++h) accU[h] = (f32x4){0.f, 0.f, 0.f, 0.f};
        const int lrow = lane >> 3, lch = lane & 7;
        const int wofs0 = lrow * 128 + ((lch ^ (lrow & 7)) << 4), wofs1 = wofs0 + 1024;
        const float xsc = r2 * P8_XS;
#ifdef U_FP4
        typedef int v8i __attribute__((ext_vector_type(8)));
        int rofs4[2];
#pragma unroll
        for (int m = 0; m < 2; ++m) rofs4[m] = fr * 128 + (((4 * m + fq) ^ (fr & 7)) << 4);
#pragma unroll 1
        for (int sl = 0; sl < 4; ++sl) {
            v8i xf[2];
#pragma unroll
            for (int m = 0; m < 2; ++m) {
                const bf16_t* xp = x1b + (t0 + fr) * DM + sl * 256 + 128 * m + 16 * fq;
#pragma unroll
                for (int q = 0; q < 4; ++q) {
                    const u32x4 xv = *(const u32x4*)(xp + 64 * (q >> 1) + 8 * (q & 1));
                    int lo = 0, hi = 0;
                    lo = __builtin_amdgcn_cvt_pk_fp8_f32(bf2f(xv[0] & 0xffffu) * xsc, bf2f(xv[0] >> 16) * xsc, lo, false);
                    lo = __builtin_amdgcn_cvt_pk_fp8_f32(bf2f(xv[1] & 0xffffu) * xsc, bf2f(xv[1] >> 16) * xsc, lo, true);
                    hi = __builtin_amdgcn_cvt_pk_fp8_f32(bf2f(xv[2] & 0xffffu) * xsc, bf2f(xv[2] >> 16) * xsc, hi, false);
                    hi = __builtin_amdgcn_cvt_pk_fp8_f32(bf2f(xv[3] & 0xffffu) * xsc, bf2f(xv[3] >> 16) * xsc, hi, true);
                    xf[m][2 * q] = lo; xf[m][2 * q + 1] = hi;
                }
            }
            const unsigned char* ubs = uq + sl * 128 + lch * 16;
#pragma unroll 1
            for (int j0 = 0; j0 < 16; ++j0) {
                const bool mine = (fr == j0);
                v8i bm[2];
#pragma unroll
                for (int m = 0; m < 2; ++m)
#pragma unroll
                    for (int q = 0; q < 8; ++q) bm[m][q] = mine ? xf[m][q] : 0;
                u32x4 g0[8], g1[8];
#pragma unroll
                for (int h = 0; h < 8; ++h) {
                    const unsigned e0 = IDX[j0 * 128 + h * 16 + lrow], e1 = IDX[j0 * 128 + h * 16 + lrow + 8];
                    g0[h] = *(const u32x4*)(ubs + (size_t)e0 * (DM / 2));
                    g1[h] = *(const u32x4*)(ubs + (size_t)e1 * (DM / 2));
                }
#pragma unroll
                for (int hg = 0; hg < 2; ++hg) {
#pragma unroll
                    for (int h = 0; h < 4; ++h) {
                        *(LAS u32x4*)(STG + h * 2048 + wofs0) = g0[hg * 4 + h];
                        *(LAS u32x4*)(STG + h * 2048 + wofs1) = g1[hg * 4 + h];
                    }
                    __builtin_amdgcn_wave_barrier();
#pragma unroll
                    for (int h = 0; h < 4; ++h)
#pragma unroll
                        for (int m = 0; m < 2; ++m) {
                            const u32x4 a16 = *(const LAS u32x4*)(STG + h * 2048 + rofs4[m]);
                            const v8i av = {(int)a16.x, (int)a16.y, (int)a16.z, (int)a16.w, 0, 0, 0, 0};
                            accU[hg * 4 + h] = __builtin_amdgcn_mfma_scale_f32_16x16x128_f8f6f4(av, bm[m], accU[hg * 4 + h], 4, 0, 0, 0, 0, 0);
                        }
                    __builtin_amdgcn_wave_barrier();
                }
            }
        }
#else
        int rofs[P8_KS];
#pragma unroll
        for (int ks = 0; ks < P8_KS; ++ks) rofs[ks] = fr * 128 + (((2 * ks + (fq >> 1)) ^ (fr & 7)) << 4) + (fq & 1) * 8;
#pragma unroll 1
        for (int sl = 0; sl < P8_NSL; ++sl) {
            if (pace) xcd_pace(bar, sl);
            long xf[P8_KS];
#pragma unroll
            for (int ks = 0; ks < P8_KS; ++ks) {
                const u32x4 xv = *(const u32x4*)(x1b + (t0 + fr) * DM + sl * P8_SLC + ks * 32 + 8 * fq);
                int lo = 0, hi = 0;
                lo = __builtin_amdgcn_cvt_pk_fp8_f32(bf2f(xv[0] & 0xffffu) * xsc, bf2f(xv[0] >> 16) * xsc, lo, false);
                lo = __builtin_amdgcn_cvt_pk_fp8_f32(bf2f(xv[1] & 0xffffu) * xsc, bf2f(xv[1] >> 16) * xsc, lo, true);
                hi = __builtin_amdgcn_cvt_pk_fp8_f32(bf2f(xv[2] & 0xffffu) * xsc, bf2f(xv[2] >> 16) * xsc, hi, false);
                hi = __builtin_amdgcn_cvt_pk_fp8_f32(bf2f(xv[3] & 0xffffu) * xsc, bf2f(xv[3] >> 16) * xsc, hi, true);
                xf[ks] = (long)(((unsigned long long)(unsigned)hi << 32) | (unsigned long long)(unsigned)lo);
            }
            const unsigned char* ubs = uq + sl * P8_SLC + lch * 16;
#pragma unroll 1
            for (int j0 = 0; j0 < 16; ++j0) {
                const bool mine = (fr == j0);
                long bm[P8_KS];
#pragma unroll
                for (int ks = 0; ks < P8_KS; ++ks) bm[ks] = mine ? xf[ks] : 0l;
                u32x4 g0[8], g1[8];
#pragma unroll
                for (int h = 0; h < 8; ++h) {
                    const unsigned e0 = IDX[j0 * 128 + h * 16 + lrow], e1 = IDX[j0 * 128 + h * 16 + lrow + 8];
                    g0[h] = *(const u32x4*)(ubs + (size_t)e0 * DM);
                    g1[h] = *(const u32x4*)(ubs + (size_t)e1 * DM);
                }
#pragma unroll
                for (int hg = 0; hg < 2; ++hg) {
#pragma unroll
                    for (int h = 0; h < 4; ++h) {
                        *(LAS u32x4*)(STG + h * 2048 + wofs0) = g0[hg * 4 + h];
                        *(LAS u32x4*)(STG + h * 2048 + wofs1) = g1[hg * 4 + h];
                    }
                    __builtin_amdgcn_wave_barrier();
#pragma unroll
                    for (int h = 0; h < 4; ++h)
#pragma unroll
                        for (int ks = 0; ks < P8_KS; ++ks) {
                            const long a = *(const LAS long*)(STG + h * 2048 + rofs[ks]);
                            accU[hg * 4 + h] = __builtin_amdgcn_mfma_f32_16x16x32_fp8_fp8(a, bm[ks], accU[hg * 4 + h], 0, 0, 0);
                        }
                    __builtin_amdgcn_wave_barrier();
                }
            }
        }
#endif
        LDS_WAIT(); __builtin_amdgcn_wave_barrier();
#pragma unroll
        for (int h = 0; h < 8; ++h) {
            const f32x4 gv = *(const f32x4*)(gwi + (t0 + fr) * 128 + h * 16 + 4 * fq);
#pragma unroll
            for (int jj = 0; jj < 4; ++jj) {
                const int slot = h * 16 + 4 * fq + jj;
                const unsigned e = IDX[fr * 128 + slot];
                const float hv = accU[h][jj] * rsu[e] * (1.f / P8_XS);
                COEF[fr * 128 + slot] = gv[jj] * gelu_erf(hv) * rsv[e];
            }
        }
        LDS_WAIT(); __builtin_amdgcn_wave_barrier();
#if defined(PROBE_PHASE) && (PROBE_PHASE == 80 || PROBE_PHASE == 81)
        F.tb = __builtin_amdgcn_s_memrealtime();
#endif
#ifdef V_VALU
        const int sub = lane & 7, rg = lane >> 3;
#pragma unroll 1
        for (int sl = 0; sl < P8_NSL; ++sl) {
            const unsigned char* vbs = vq + sl * P8_SLC + sub * 16;
#pragma unroll 1
            for (int j0 = 0; j0 < 16; ++j0) {
                f32x2 acc[8];
#pragma unroll
                for (int q = 0; q < 8; ++q) acc[q] = (f32x2){0.f, 0.f};
#pragma unroll
                for (int ib = 0; ib < 2; ++ib) {
                    u32x4 w[8]; float cf[8];
#pragma unroll
                    for (int it = 0; it < 8; ++it) {
                        const int slot = (ib * 8 + it) * 8 + rg;
                        const unsigned e = IDX[j0 * 128 + slot];
                        cf[it] = COEF[j0 * 128 + slot];
                        w[it] = *(const u32x4*)(vbs + (size_t)e * DM);
                    }
#pragma unroll
                    for (int it = 0; it < 8; ++it)
#pragma unroll
                        for (int q = 0; q < 4; ++q) {
                            acc[2 * q] += __builtin_amdgcn_cvt_pk_f32_fp8((int)w[it][q], false) * cf[it];
                            acc[2 * q + 1] += __builtin_amdgcn_cvt_pk_f32_fp8((int)w[it][q], true) * cf[it];
                        }
                }
#pragma unroll
                for (int q = 0; q < 8; ++q) {
                    acc[q].x += __shfl_xor(acc[q].x, 8); acc[q].y += __shfl_xor(acc[q].y, 8);
                    acc[q].x += __shfl_xor(acc[q].x, 16); acc[q].y += __shfl_xor(acc[q].y, 16);
                    acc[q].x += __shfl_xor(acc[q].x, 32); acc[q].y += __shfl_xor(acc[q].y, 32);
                }
                if (rg == 0) {
                    float* orow = out + (t0 + j0) * DM + sl * P8_SLC + sub * 16;
                    const bf16_t* xrow = x1b + (t0 + j0) * DM + sl * P8_SLC + sub * 16;
#pragma unroll
                    for (int q = 0; q < 4; ++q) {
                        const u32x2 xv = *(const u32x2*)(xrow + 4 * q);
                        f32x4 o = {bf2f(xv.x & 0xffffu), bf2f(xv.x >> 16), bf2f(xv.y & 0xffffu), bf2f(xv.y >> 16)};
                        o[0] += acc[2 * q].x; o[1] += acc[2 * q].y; o[2] += acc[2 * q + 1].x; o[3] += acc[2 * q + 1].y;
                        *(f32x4*)(orow + 4 * q) = o;
                    }
                }
            }
        }
#elif defined(V_FP4)
        typedef int v2i __attribute__((ext_vector_type(2)));
        typedef int v8i __attribute__((ext_vector_type(8)));
        v8i cq8; float inv_cs;
        {
            f32x4 cv[2][4]; float cmax = 0.f;
#pragma unroll
            for (int hf = 0; hf < 2; ++hf)
#pragma unroll
                for (int q = 0; q < 4; ++q) {
                    cv[hf][q] = *(const LAS f32x4*)(COEF + fr * 128 + hf * 64 + 16 * fq + 4 * q);
                    cmax = fmaxf(cmax, fmaxf(fmaxf(fabsf(cv[hf][q][0]), fabsf(cv[hf][q][1])), fmaxf(fabsf(cv[hf][q][2]), fabsf(cv[hf][q][3]))));
                }
            cmax = fmaxf(cmax, __shfl_xor(cmax, 16)); cmax = fmaxf(cmax, __shfl_xor(cmax, 32));
            const float cs = cmax > 0.f ? 240.f / cmax : 1.f; inv_cs = cmax > 0.f ? cmax * (1.f / 240.f) : 1.f;
#pragma unroll
            for (int hf = 0; hf < 2; ++hf)
#pragma unroll
                for (int q = 0; q < 4; ++q) {
                    int pk = 0;
                    pk = __builtin_amdgcn_cvt_pk_fp8_f32(cv[hf][q][0] * cs, cv[hf][q][1] * cs, pk, false);
                    pk = __builtin_amdgcn_cvt_pk_fp8_f32(cv[hf][q][2] * cs, cv[hf][q][3] * cs, pk, true);
                    cq8[hf * 4 + q] = pk;
                }
        }
        LDS_WAIT(); __builtin_amdgcn_wave_barrier();
        int vwofs[16];
#pragma unroll
        for (int i = 0; i < 16; ++i) { const int rr = lrow + 8 * i; vwofs[i] = rr * 128 + ((lch ^ ((rr >> 1) & 7)) << 4); }
        int vrow_[2], vsw_[2];
#pragma unroll
        for (int t = 0; t < 2; ++t) { vrow_[t] = 32 * fq + 16 * t + fr; vsw_[t] = (vrow_[t] >> 1) & 7; }
#pragma unroll 1
        for (int sl = 0; sl < 4; ++sl) {
            f32x4 accV[16];
#pragma unroll
            for (int ct = 0; ct < 16; ++ct) accV[ct] = (f32x4){0.f, 0.f, 0.f, 0.f};
            const unsigned char* vbs = vq + sl * 128 + lch * 16;
#pragma unroll 1
            for (int j0 = 0; j0 < 16; ++j0) {
                const bool mine = (fr == j0);
                u32x4 g[16];
#pragma unroll
                for (int i = 0; i < 16; ++i) {
                    const unsigned e = IDX[j0 * 128 + lrow + 8 * i];
                    g[i] = *(const u32x4*)(vbs + (size_t)e * (DM / 2));
                }
#pragma unroll
                for (int i = 0; i < 16; ++i) *(LAS u32x4*)(STG + vwofs[i]) = g[i];
                __builtin_amdgcn_wave_barrier();
                v8i bmq;
#pragma unroll
                for (int q = 0; q < 8; ++q) bmq[q] = mine ? cq8[q] : 0;
#pragma unroll
                for (int ct = 0; ct < 16; ++ct) {
                    const v2i r0 = __builtin_amdgcn_ds_read_tr4_b64_v2i32((LAS v2i*)(STG + vrow_[0] * 128 + (((ct >> 1) ^ vsw_[0]) << 4) + (ct & 1) * 8));
                    const v2i r1 = __builtin_amdgcn_ds_read_tr4_b64_v2i32((LAS v2i*)(STG + vrow_[1] * 128 + (((ct >> 1) ^ vsw_[1]) << 4) + (ct & 1) * 8));
                    const v8i av = {r0.x, r0.y, r1.x, r1.y, 0, 0, 0, 0};
                    accV[ct] = __builtin_amdgcn_mfma_scale_f32_16x16x128_f8f6f4(av, bmq, accV[ct], 4, 0, 0, 0, 0, 0);
                }
                __builtin_amdgcn_wave_barrier();
            }
            float* orow = out + (t0 + fr) * DM + sl * 256 + 4 * fq;
            const bf16_t* xrow = x1b + (t0 + fr) * DM + sl * 256 + 4 * fq;
#pragma unroll
            for (int ct = 0; ct < 16; ++ct) {
                const u32x2 xv = *(const u32x2*)(xrow + ct * 16);
                f32x4 o = {bf2f(xv.x & 0xffffu), bf2f(xv.x >> 16), bf2f(xv.y & 0xffffu), bf2f(xv.y >> 16)};
                o += accV[ct] * inv_cs;
                __builtin_nontemporal_store(o, (f32x4*)(orow + ct * 16));
            }
        }
#else
        typedef int v2i __attribute__((ext_vector_type(2)));
        long cq[4]; float inv_cs;
        {
            f32x4 cv[4][2]; float cmax = 0.f;
#pragma unroll
            for (int kk = 0; kk < 4; ++kk)
#pragma unroll
                for (int q = 0; q < 2; ++q) {
                    cv[kk][q] = *(const LAS f32x4*)(COEF + fr * 128 + kk * 32 + 8 * fq + 4 * q);
                    cmax = fmaxf(cmax, fmaxf(fmaxf(fabsf(cv[kk][q][0]), fabsf(cv[kk][q][1])), fmaxf(fabsf(cv[kk][q][2]), fabsf(cv[kk][q][3]))));
                }
            cmax = fmaxf(cmax, __shfl_xor(cmax, 16)); cmax = fmaxf(cmax, __shfl_xor(cmax, 32));
            const float cs = cmax > 0.f ? 240.f / cmax : 1.f; inv_cs = cmax > 0.f ? cmax * (1.f / 240.f) : 1.f;
#pragma unroll
            for (int kk = 0; kk < 4; ++kk) {
                int lo = 0, hi = 0;
                lo = __builtin_amdgcn_cvt_pk_fp8_f32(cv[kk][0][0] * cs, cv[kk][0][1] * cs, lo, false);
                lo = __builtin_amdgcn_cvt_pk_fp8_f32(cv[kk][0][2] * cs, cv[kk][0][3] * cs, lo, true);
                hi = __builtin_amdgcn_cvt_pk_fp8_f32(cv[kk][1][0] * cs, cv[kk][1][1] * cs, hi, false);
                hi = __builtin_amdgcn_cvt_pk_fp8_f32(cv[kk][1][2] * cs, cv[kk][1][3] * cs, hi, true);
                cq[kk] = (long)(((unsigned long long)(unsigned)hi << 32) | (unsigned long long)(unsigned)lo);
            }
        }
        LDS_WAIT(); __builtin_amdgcn_wave_barrier();
        const int vrow = 8 * fq + (fr >> 1);
        const int vrd0 = vrow * 128 + (fr & 1) * 8, vsw = (vrow >> 1) & 7;
        int vwofs[4];
#pragma unroll
        for (int i = 0; i < 4; ++i) { const int rr = lrow + 8 * i; vwofs[i] = rr * 128 + ((lch ^ ((rr >> 1) & 7)) << 4); }
#pragma unroll 1
        for (int sl = 0; sl < P8_NSL; ++sl) {
            if (pace) xcd_pace(bar, P8_NSL + sl);
            f32x4 accV[8];
#pragma unroll
            for (int ct = 0; ct < 8; ++ct) accV[ct] = (f32x4){0.f, 0.f, 0.f, 0.f};
            const unsigned char* vbs = vq + sl * P8_SLC + lch * 16;
#pragma unroll 1
            for (int j0 = 0; j0 < 16; ++j0) {
                const bool mine = (fr == j0);
                u32x4 g[4][4];
#pragma unroll
                for (int kk = 0; kk < 4; ++kk)
#pragma unroll
                    for (int i = 0; i < 4; ++i) {
                        const unsigned e = IDX[j0 * 128 + kk * 32 + lrow + 8 * i];
                        g[kk][i] = *(const u32x4*)(vbs + (size_t)e * DM);
                    }
#pragma unroll
                for (int kk = 0; kk < 4; ++kk) {
                    LAS unsigned char* T = STG + (kk & 1) * 4096;
#pragma unroll
                    for (int i = 0; i < 4; ++i) *(LAS u32x4*)(T + vwofs[i]) = g[kk][i];
                    __builtin_amdgcn_wave_barrier();
                    const long bmq = mine ? cq[kk] : 0l;
#pragma unroll
                    for (int ct = 0; ct < 8; ++ct) {
                        const v2i av = __builtin_amdgcn_ds_read_tr8_b64_v2i32((LAS v2i*)(T + vrd0 + ((ct ^ vsw) << 4)));
                        const long a = (long)(((unsigned long long)(unsigned)av.y << 32) | (unsigned long long)(unsigned)av.x);
                        accV[ct] = __builtin_amdgcn_mfma_f32_16x16x32_fp8_fp8(a, bmq, accV[ct], 0, 0, 0);
                    }
                    __builtin_amdgcn_wave_barrier();
                }
            }
            float* orow = out + (t0 + fr) * DM + sl * P8_SLC + 4 * fq;
            const bf16_t* xrow = x1b + (t0 + fr) * DM + sl * P8_SLC + 4 * fq;
#pragma unroll
            for (int ct = 0; ct < 8; ++ct) {
                const u32x2 xv = *(const u32x2*)(xrow + ct * 16);
                f32x4 o = {bf2f(xv.x & 0xffffu), bf2f(xv.x >> 16), bf2f(xv.y & 0xffffu), bf2f(xv.y >> 16)};
                o += accV[ct] * inv_cs;
                __builtin_nontemporal_store(o, (f32x4*)(orow + ct * 16));
            }
        }
#endif
#if defined(PROBE_PHASE) && PROBE_PHASE >= 80
        F.tc = __builtin_amdgcn_s_memrealtime();
#endif
        LDS_WAIT(); __builtin_amdgcn_wave_barrier();
    }
}

constexpr int NPHASE = 9;
#ifndef N_LAUNCHES
#define N_LAUNCHES 1
#endif
constexpr int MISC_OFF = LDS_BYTES - 128;
__global__ void __launch_bounds__(512, 2) fwd_kernel(Params p) {
    extern __shared__ __attribute__((aligned(16))) unsigned char lds_raw[];
    Ctx F; F.ta = F.tb = F.tc = 0;
    F.lds = (LAS unsigned char*)lds_raw;
    F.tid = threadIdx.x; F.lane = F.tid & 63; F.wave = __builtin_amdgcn_readfirstlane(F.tid >> 6);
    F.G = gridDim.x; { const int bx = blockIdx.x; F.vcu = (F.G % 8 == 0) ? (bx % 8) * (F.G / 8) + bx / 8 : bx; }
    F.gw = F.vcu * 8 + F.wave; F.ngw = F.G * 8;
    unsigned char* ws = p.ws;
    const int lo = p.ph_lo, hi = p.ph_hi;
    volatile LAS unsigned* MISC = (volatile LAS unsigned*)(F.lds + MISC_OFF);
    if (F.tid < 32) MISC[F.tid] = 0u;
    __syncthreads();
#ifdef CG_FIRST_SYNC
    XcdBarrier bar; bar.bar = (unsigned*)(ws + WS_CTL) + CW_BAR; bar.x = 0; bar.st = MISC + 8;
    for (int i = blockIdx.x * 512 + F.tid; i < XCD_BAR_WORDS + PACE_WORDS; i += F.G * 512) __hip_atomic_store(bar.bar + i, 0u, __ATOMIC_RELAXED, __HIP_MEMORY_SCOPE_AGENT);
#else
    XcdBarrier bar = xcd_barrier_post((unsigned*)(ws + WS_CTL) + CW_BAR, MISC + 8);
#endif
#ifdef ONLY_PHASE
#define IN(k) ((k)==ONLY_PHASE)
#else
#define IN(k) (lo <= (k) && (k) < hi)
#endif
#ifdef PROBE_PHASE
    unsigned long long tp0 = __builtin_amdgcn_s_memrealtime(), tp1 = 0; const unsigned long long tstart = tp0;
#define PSTAMP(k) do { if ((k) + 1 == PROBE_PHASE) tp0 = __builtin_amdgcn_s_memrealtime(); if ((k) == PROBE_PHASE) tp1 = __builtin_amdgcn_s_memrealtime(); } while (0)
#else
#define PSTAMP(k) do {} while (0)
#endif
#define SEAM(k) do { if (IN(k) && ((k) == 6 ? IN(8) : IN((k) + 1))) xcd_barrier(bar); PSTAMP(k); } while (0)
    if (IN(0)) phase0(p, F);
#ifdef CG_FIRST_SYNC
    if (IN(0) && IN(1)) { cooperative_groups::this_grid().sync(); bar = xcd_barrier_post((unsigned*)(ws + WS_CTL) + CW_BAR, MISC + 8); }
    PSTAMP(0);
#else
    SEAM(0);
#endif
    if (IN(1)) {
        pg8::Gemm g{(const pg8::bf16_t*)(ws + WS_XB), (const pg8::bf16_t*)(ws + WS_WINT), TOK, NIN, DM};
        pg8::StaticOrder S; S.init(TOK, NIN, F.G, (int)blockIdx.x);
        pg8::EpiProj E{(pg8::bf16_t*)(ws + WS_PROJ), NIN, p.in[9], p.in[10], (const float*)(ws + WS_ROPE), (const float*)(ws + WS_ROPE) + SEQ * 8,
                       (LAS float*)(F.lds + pg8::STAGE_BYTES), PQ, PK, PV, SEQ - 1, EPSN};
        pg8::gemm_phase<pg8::EpiProj, pg8::StaticOrder, true, true>(F.lds, g, S, E);
    }
    SEAM(1);
    if (IN(2)) phase2(p, F);
    SEAM(2);
#if defined(PROBE_PHASE) && PROBE_PHASE == 84
    const unsigned long long t3s = __builtin_amdgcn_s_memrealtime();
#endif
    if (IN(3)) phase3(p, F);
#if defined(PROBE_PHASE) && PROBE_PHASE == 84
    { const unsigned long long tend = __builtin_amdgcn_s_memrealtime();
      if (F.tid == 0) { unsigned* mw = (unsigned*)(ws + WS_MISC); const unsigned d = (unsigned)(tend - t3s); atomicMax(mw + 2, d); atomicMin(mw + 3, d); atomicAdd(mw + 4, d >> 8); } }
#endif
    SEAM(3);
    if (IN(4)) phase4(p, F);
    SEAM(4);
    if (IN(5)) {
        pg8::Gemm g{(const pg8::bf16_t*)(ws + WS_YCAT), (const pg8::bf16_t*)(ws + WS_WOUTT), TOK, DM, DM};
        pg8::StaticOrder S; S.init(TOK, DM, F.G, (int)blockIdx.x);
        pg8::EpiResid E{(const pg8::bf16_t*)(ws + WS_XB), (const float*)(ws + WS_RSTD), (pg8::bf16_t*)(ws + WS_X1B), (float*)(ws + WS_CTL) + CW_ROWSQ, DM};
        pg8::gemm_phase<pg8::EpiResid, pg8::StaticOrder, true, true>(F.lds, g, S, E);
    }
    SEAM(5);
    if (IN(6)) {
        pg8::Gemm g{(const pg8::bf16_t*)(ws + WS_X1B), (const pg8::bf16_t*)(ws + WS_WQT), TOK, 2048, DM};
        pg8::StaticOrder S; S.init(TOK, 2048, F.G, (int)blockIdx.x);
        pg8::EpiBf16<0> E{(pg8::bf16_t*)(ws + WS_QP), 2048, nullptr, 0, 0, 1.f};
        pg8::gemm_phase<pg8::EpiBf16<0>, pg8::StaticOrder, true, true>(F.lds, g, S, E);
    }
    SEAM(6);
    PSTAMP(7);
#if defined(PROBE_PHASE) && PROBE_PHASE == 83
    tp0 = __builtin_amdgcn_s_memrealtime();
#endif
#ifdef PROBE_PHASE
    const unsigned sv_nloc = MISC[8], sv_nx = MISC[9];
#endif
    if (IN(8)) phase8(p, F, bar);
#ifdef PROBE_PHASE
    __syncthreads(); if (F.tid == 0) { MISC[8] = sv_nloc; MISC[9] = sv_nx; } __syncthreads();
#endif
#if defined(PROBE_PHASE) && PROBE_PHASE == 83
    {
        const unsigned long long tend = __builtin_amdgcn_s_memrealtime();
        if (F.tid == 0) { unsigned* mw = (unsigned*)(ws + WS_MISC); const unsigned d = (unsigned)(tend - tp0);
            atomicMax(mw + 2, d); atomicMin(mw + 3, d); atomicAdd(mw + 4, d >> 8); }
    }
#endif
#ifdef PROBE_PHASE
    xcd_barrier(bar);
    PSTAMP(8);
#if PROBE_PHASE == 83 || PROBE_PHASE == 84
    { const unsigned* mw = (const unsigned*)(ws + WS_MISC);
      const unsigned vmax = __hip_atomic_load(mw + 2, __ATOMIC_RELAXED, __HIP_MEMORY_SCOPE_AGENT), vmin = __hip_atomic_load(mw + 3, __ATOMIC_RELAXED, __HIP_MEMORY_SCOPE_AGENT), vsum = __hip_atomic_load(mw + 4, __ATOMIC_RELAXED, __HIP_MEMORY_SCOPE_AGENT);
      tp0 = 0; tp1 = PROBE_SUB == 0 ? vmax : (PROBE_SUB == 1 ? vmin : (unsigned)(((unsigned long long)vsum << 8) / gridDim.x)); }
#elif PROBE_PHASE == 9
    tp0 = tstart; tp1 = __builtin_amdgcn_s_memrealtime();
#elif PROBE_PHASE == 80 || PROBE_PHASE == 20 || PROBE_PHASE == 30 || PROBE_PHASE == 82
    tp0 = F.ta; tp1 = F.tb;
#elif PROBE_PHASE == 81 || PROBE_PHASE == 21 || PROBE_PHASE == 31
    tp0 = F.tb; tp1 = F.tc;
#endif
#if PROBE_PHASE == 98
    {
        typedef int v2i __attribute__((ext_vector_type(2)));
        float result = 0.f;
        __syncthreads();
        if (blockIdx.x == 0 && F.wave == 0) {
            LAS unsigned char* T = (LAS unsigned char*)F.lds;
            if (F.lane < 16) {
                unsigned long long w = 0ull;
                for (int c = 0; c < 16; ++c) { const unsigned long long nib = (PROBE_SUB == 0) ? (unsigned long long)F.lane : (unsigned long long)c; w |= nib << (4 * c); }
                *(LAS unsigned long long*)(T + F.lane * 8) = w;
            }
            LDS_WAIT(); __builtin_amdgcn_wave_barrier();
            const v2i rv_ = __builtin_amdgcn_ds_read_tr4_b64_v2i32((LAS v2i*)(T + (F.lane & 15) * 8));
            const unsigned long long got = ((unsigned long long)(unsigned)rv_.y << 32) | (unsigned long long)(unsigned)rv_.x;
            unsigned long long want = 0ull;
            for (int j = 0; j < 16; ++j) { const unsigned long long nib = (PROBE_SUB == 0) ? (unsigned long long)j : (unsigned long long)(F.lane & 15); want |= nib << (4 * j); }
            const unsigned long long bal = __ballot(got == want);
            result = (float)__popcll(bal);
        }
        if (blockIdx.x == 0 && F.tid == 0) { VM_WAIT(); p.out[0] += result; }
    }
#elif PROBE_PHASE == 99
    {
        typedef int v8i __attribute__((ext_vector_type(8)));
        float result = 0.f;
        if (blockIdx.x == 0 && F.wave == 0) {
            const int fr_ = F.lane & 15, fq_ = F.lane >> 4;
            v8i bv;
#pragma unroll
            for (int q = 0; q < 8; ++q) { unsigned w = 0; for (int bb = 0; bb < 4; ++bb) { unsigned pcode = (unsigned)(32 * fq_ + 4 * q + bb); if (pcode == 127u) pcode = 126u; w |= pcode << (8 * bb); } bv[q] = (int)w; }
            int matches = 0, firstbad = -1, firstbadval = -1;
            for (int ga = 0; ga < 4; ++ga)
                for (int ja = 0; ja < 32; ++ja) {
                    v8i av = {0, 0, 0, 0, 0, 0, 0, 0};
                    if (fr_ == 0 && fq_ == ga) { const unsigned nib = 2u << (4 * (ja & 7)); const int wsel = ja >> 3;
                        av[0] = wsel == 0 ? (int)nib : 0; av[1] = wsel == 1 ? (int)nib : 0; av[2] = wsel == 2 ? (int)nib : 0; av[3] = wsel == 3 ? (int)nib : 0; }
                    f32x4 c = {0.f, 0.f, 0.f, 0.f};
                    c = __builtin_amdgcn_mfma_scale_f32_16x16x128_f8f6f4(av, bv, c, 4, 0, 0, 0, 0, 0);
                    int pk = 0; pk = __builtin_amdgcn_cvt_pk_fp8_f32(c[0], 0.f, pk, false);
                    const int got = __shfl(pk & 255, 0);
                    int want = 32 * ga + ja; if (want == 127) want = 126;
                    if (got == want) ++matches; else if (firstbad < 0) { firstbad = 32 * ga + ja; firstbadval = got; }
                }
#if PROBE_SUB == 0
            result = (float)matches;
#elif PROBE_SUB == 1
            result = (float)firstbad;
#else
            result = (float)firstbadval;
#endif
        }
        if (blockIdx.x == 0 && F.tid == 0) { VM_WAIT(); p.out[0] += result; }
    }
#else
    if (blockIdx.x == 0 && F.tid == 0) { VM_WAIT(); p.out[0] += (float)(tp1 - tp0) * (1.0f / (float)(PROBE_DIV)); }
#endif
#endif
#undef IN
#undef SEAM
}

extern "C" void kernel_launch(void* const* d_in, const int* in_sizes, int n_in, void* d_out, int out_size, void* d_ws, size_t ws_size, hipStream_t stream) {
    static int grid = 0;
    if (grid == 0) {
        if (n_in != 22 || in_sizes[0] != TOK * DM || out_size != TOK * DM || ws_size < WS_END) {
            fprintf(stderr, "kernel_launch: unexpected shapes: n_in %d in0 %d out %d ws %zu\n", n_in, n_in > 0 ? in_sizes[0] : -1, out_size, ws_size); grid = -1; return; }
        if (hipFuncSetAttribute((const void*)fwd_kernel, hipFuncAttributeMaxDynamicSharedMemorySize, LDS_BYTES) != hipSuccess) { fprintf(stderr, "kernel_launch: hipFuncSetAttribute failed\n"); grid = -1; return; }
        int dev = 0, cus = 0, per_cu = 0;
        if (hipGetDevice(&dev) != hipSuccess || hipDeviceGetAttribute(&cus, hipDeviceAttributeMultiprocessorCount, dev) != hipSuccess) { grid = -1; return; }
        if (hipOccupancyMaxActiveBlocksPerMultiprocessor(&per_cu, (const void*)fwd_kernel, 512, LDS_BYTES) != hipSuccess || per_cu < 1) { fprintf(stderr, "kernel_launch: occupancy query failed (%d)\n", per_cu); (void)hipGetLastError(); per_cu = 1; }
        grid = cus * (per_cu > 1 ? 1 : per_cu);
    }
    if (grid < 0) return;
#ifndef CG_FIRST_SYNC
    (void)hipMemsetAsync((char*)d_ws + WS_CTL + (size_t)CW_BAR * 4, 0, (size_t)(XCD_BAR_WORDS + PACE_WORDS) * 4, stream);
#endif
    Params a{};
    for (int i = 0; i < 22; ++i) a.in[i] = (const float*)d_in[i];
    a.out = (float*)d_out; a.ws = (unsigned char*)d_ws;
#if N_LAUNCHES == 1
    a.ph_lo = 0; a.ph_hi = NPHASE;
#ifdef USE_COOP_LAUNCH
    { void* args[] = {&a};
      hipError_t e = hipLaunchCooperativeKernel((const void*)fwd_kernel, dim3(grid), dim3(512), args, LDS_BYTES, stream);
      if (e != hipSuccess) fprintf(stderr, "kernel_launch: cooperative launch failed: %s (grid %d)\n", hipGetErrorString(e), grid); }
#else
    hipLaunchKernelGGL(fwd_kernel, dim3(grid), dim3(512), LDS_BYTES, stream, a);
#endif
#else
    for (int ph = 0; ph < NPHASE; ++ph) {
        a.ph_lo = ph; a.ph_hi = ph + 1;
        hipLaunchKernelGGL(fwd_kernel, dim3(grid), dim3(512), LDS_BYTES, stream, a);
    }
#endif
    const hipError_t le = hipPeekAtLastError();
    if (le != hipSuccess) fprintf(stderr, "kernel_launch: launch failed: %s\n", hipGetErrorName(le));
}
```

```cpp
#include <hip/hip_runtime.h>
#include <hip/hip_cooperative_groups.h>
#include <cstdio>
#include <cstdint>
#define USE_COOP_LAUNCH 1
#define U_FP4 1
#define V_FP4 1

#define LAS __attribute__((address_space(3)))
#define GAS __attribute__((address_space(1)))
typedef unsigned short bf16_t;
typedef short bf16x8 __attribute__((ext_vector_type(8)));
typedef short s16x4 __attribute__((ext_vector_type(4)));
typedef float f32x4 __attribute__((ext_vector_type(4)));
typedef float f32x8 __attribute__((ext_vector_type(8)));
typedef float f32x16 __attribute__((ext_vector_type(16)));
typedef unsigned u32x4 __attribute__((ext_vector_type(4)));
typedef unsigned u32x2 __attribute__((ext_vector_type(2)));

constexpr int NB = 8, SEQ = 4096, TOK = NB * SEQ, DM = 1024;
constexpr int NIN = 3072;
constexpr int PZ = 0, PXS = 512, PBM = 1024, PCM = 1280, PQ = 1536, PK = 2048, PV = 2560;
constexpr int CHUNK = 64, NCH = SEQ / CHUNK;
constexpr int NHS = 8;
constexpr float EPSN = 1e-6f;
constexpr int PEER_H = 8, NKEYS = 128, TOPK = 16;
constexpr float LAMBDA_INIT = 0.2f;

constexpr size_t MiB = 1u << 20;
constexpr size_t WS_CTL = 0, CTL_BYTES = 1 * MiB;
constexpr size_t WS_WINT = 1 * MiB;
constexpr size_t WS_WOUTT = 7 * MiB;
constexpr size_t WS_WQT = 9 * MiB;
constexpr size_t WS_KEYS = 13 * MiB;
constexpr size_t WS_ROPE = 13 * MiB + 512 * 1024;
constexpr size_t WS_MISC = 13 * MiB + 768 * 1024;
constexpr size_t WS_RSU = WS_MISC + 64 * 1024;
constexpr size_t WS_RSV = WS_MISC + 128 * 1024;
constexpr size_t WS_DTRAW = 14 * MiB;
constexpr size_t WS_ACS = 15 * MiB;
constexpr size_t WS_CDEC = 16 * MiB;
constexpr size_t WS_RSTD = 17 * MiB;
constexpr size_t WS_UB = 20 * MiB;
constexpr size_t WS_VB = 52 * MiB;
constexpr size_t WS_XB = 84 * MiB;
constexpr size_t WS_YCAT = 420 * MiB;
constexpr size_t WS_PROJ = 148 * MiB;
constexpr size_t WS_QP = WS_PROJ;
constexpr size_t WS_IDX = 276 * MiB;
constexpr size_t WS_GW = 292 * MiB;
constexpr size_t WS_CMC = 340 * MiB;
constexpr size_t WS_STATES = 356 * MiB;
constexpr size_t WS_X1B = WS_STATES;
constexpr size_t WS_END = 484 * MiB;
constexpr int CW_BAR = 4096;
constexpr int CW_ROWSQ = 131072;
static_assert((CW_ROWSQ + TOK) * 4 <= (int)CTL_BYTES, "ctl");

constexpr int PACE_WORDS = 32 * 16 * 16;
constexpr int LDS_BYTES = 163840;

__device__ __forceinline__ float bf2f(unsigned h) { return __uint_as_float(h << 16); }
typedef float f32x2_cv __attribute__((ext_vector_type(2)));
typedef __bf16 bf16x2_cv __attribute__((ext_vector_type(2)));
__device__ __forceinline__ unsigned pk2(float lo, float hi) { const f32x2_cv v = {lo, hi}; return __builtin_bit_cast(unsigned, __builtin_convertvector(v, bf16x2_cv)); }
__device__ __forceinline__ unsigned f2bf(float f) { return pk2(f, 0.f) & 0xffffu; }
#define DPP_F(v, ctrl) __builtin_bit_cast(float, __builtin_amdgcn_mov_dpp(__builtin_bit_cast(int, (v)), (ctrl), 0xf, 0xf, true))
__device__ __forceinline__ float wave_sum(float v) {
    v += DPP_F(v, 0xB1); v += DPP_F(v, 0x4E);
    v += DPP_F(v, 0x124); v += DPP_F(v, 0x128);
    { auto r = __builtin_amdgcn_permlane16_swap(__float_as_uint(v), __float_as_uint(v), false, false); v = __uint_as_float(r[0]) + __uint_as_float(r[1]); }
    { auto r = __builtin_amdgcn_permlane32_swap(__float_as_uint(v), __float_as_uint(v), false, false); v = __uint_as_float(r[0]) + __uint_as_float(r[1]); }
    return v;
}
__device__ __forceinline__ float wave_max(float v) {
    v = fmaxf(v, DPP_F(v, 0xB1)); v = fmaxf(v, DPP_F(v, 0x4E));
    v = fmaxf(v, DPP_F(v, 0x124)); v = fmaxf(v, DPP_F(v, 0x128));
    { auto r = __builtin_amdgcn_permlane16_swap(__float_as_uint(v), __float_as_uint(v), false, false); v = fmaxf(__uint_as_float(r[0]), __uint_as_float(r[1])); }
    { auto r = __builtin_amdgcn_permlane32_swap(__float_as_uint(v), __float_as_uint(v), false, false); v = fmaxf(__uint_as_float(r[0]), __uint_as_float(r[1])); }
    return v;
}
__device__ __forceinline__ float silu_f(float x) { return x * __builtin_amdgcn_rcpf(1.f + __expf(-x)); }
__device__ __forceinline__ f32x4 mfma16(bf16x8 a, bf16x8 b, f32x4 c) { return __builtin_amdgcn_mfma_f32_16x16x32_bf16(a, b, c, 0, 0, 0); }
__device__ __forceinline__ f32x16 mfma32(bf16x8 a, bf16x8 b, f32x16 c) { return __builtin_amdgcn_mfma_f32_32x32x16_bf16(a, b, c, 0, 0, 0); }
#define LDS_WAIT() asm volatile("s_waitcnt lgkmcnt(0)" ::: "memory")
#define VM_WAIT() asm volatile("s_waitcnt vmcnt(0)" ::: "memory")

#define XB_TMO      128
#define XB_XCNT(j)  (256  + 64 * (j))
#define XB_XSUB(j)  (1280 + 64 * (j))
#define XB_XGEN(j)  (2304 + 64 * (j))
#define XB_TOP      3328
#define XB_TOPGEN   3392
#define XCD_BAR_WORDS 3456
#define XB_SPIN_CAP (1u << 21)

__device__ __forceinline__ unsigned xb_ld(unsigned* p)              { return __hip_atomic_load(p, __ATOMIC_RELAXED, __HIP_MEMORY_SCOPE_AGENT); }
__device__ __forceinline__ unsigned xb_add(unsigned* p, unsigned v) { return __hip_atomic_fetch_add(p, v, __ATOMIC_RELAXED, __HIP_MEMORY_SCOPE_AGENT); }
__device__ __forceinline__ unsigned xb_xcc_id() { return (unsigned)__builtin_amdgcn_s_getreg((3 << 11) | 20) & 0xFu; }
#define XB_SPIN(cond, bar) do { unsigned _sp = 0; while (cond) { __builtin_amdgcn_s_sleep(1); \
    if ((++_sp & 255u) == 0u) { if (xb_ld(&(bar)[XB_TMO])) break; if (_sp > XB_SPIN_CAP) { atomicAdd(&(bar)[XB_TMO], 1u); break; } } } } while (0)

struct XcdBarrier {
    unsigned* bar; unsigned x;
    volatile LAS unsigned* st;
};

__device__ __forceinline__ XcdBarrier xcd_barrier_post(unsigned* bar, volatile LAS unsigned* st) {
    XcdBarrier b; b.bar = bar; b.x = xb_xcc_id(); b.st = st;
    if (threadIdx.x == 0) (void)xb_add(&bar[XB_XCNT(b.x)], 1u);
    return b;
}
__device__ __forceinline__ void xcd_barrier_complete(unsigned* bar, unsigned x, unsigned& nloc, unsigned& nx) {
    const unsigned G = gridDim.x * gridDim.y * gridDim.z;
    unsigned sum, cnt, mine, sp = 0u;
    for (;;) {
        sum = 0u; cnt = 0u; mine = 0u;
#pragma unroll
        for (unsigned j = 0; j < 16; ++j) { const unsigned c = xb_ld(&bar[XB_XCNT(j)]); sum += c; cnt += (c > 0u) ? 1u : 0u; mine = (j == x) ? c : mine; }
        if (sum == G) break;
        __builtin_amdgcn_s_sleep(1);
        if ((++sp & 255u) == 0u) { if (xb_ld(&bar[XB_TMO])) break; if (sp > XB_SPIN_CAP) { atomicAdd(&bar[XB_TMO], 1u); break; } }
    }
    nloc = mine > 0u ? mine : 1u; nx = cnt > 0u ? cnt : 1u;
}

__device__ __forceinline__ void xcd_barrier(const XcdBarrier& b) {
    asm volatile("s_waitcnt vmcnt(0)" ::: "memory");
    __syncthreads();
    if (threadIdx.x == 0) {
        unsigned* bar = b.bar;
        __builtin_amdgcn_s_waitcnt(0);
        unsigned nloc = b.st[0], nx = b.st[1];
        if (nloc == 0u) { xcd_barrier_complete(bar, b.x, nloc, nx); b.st[0] = nloc; b.st[1] = nx; }
        const unsigned old = xb_add(&bar[XB_XSUB(b.x)], 1u);
        const unsigned gen = old / nloc;
        if (old + 1u == (gen + 1u) * nloc) {
            __builtin_amdgcn_fence(__ATOMIC_RELEASE, "agent");
            asm volatile("s_waitcnt vmcnt(0)" ::: "memory");
            const unsigned og = xb_add(&bar[XB_TOP], 1u);
            const unsigned tg = og / nx;
            if (og + 1u == (tg + 1u) * nx) xb_add(&bar[XB_TOPGEN], 1u);
            else XB_SPIN(xb_ld(&bar[XB_TOPGEN]) == tg, bar);
            __builtin_amdgcn_fence(__ATOMIC_ACQUIRE, "agent");
            xb_add(&bar[XB_XGEN(b.x)], 1u);
            asm volatile("s_waitcnt vmcnt(0)" ::: "memory");
        } else {
            XB_SPIN(xb_ld(&bar[XB_XGEN(b.x)]) == gen, bar);
            __builtin_amdgcn_fence(__ATOMIC_ACQUIRE, "agent");
            asm volatile("s_waitcnt vmcnt(0)" ::: "memory");
        }
    }
    __syncthreads();
}
namespace pg8 {
#define PG8_LAS __attribute__((address_space(3)))
typedef unsigned short bf16_t;
typedef short bf16x8 __attribute__((ext_vector_type(8)));
typedef float f32x4 __attribute__((ext_vector_type(4)));
typedef unsigned u32x4 __attribute__((ext_vector_type(4)));
constexpr int BM = 256, BK = 64, HALF = 128, HTB = HALF * BK * 2  , STAGE_BYTES = 8 * HTB, NXCD = 8, WGM = 8;

__host__ __device__ __forceinline__ int lds_byte(int r, int c) { const int st = (r >> 4) * 2 + (c >> 5), rr = r & 15, cc = c & 31, ob = rr * 64 + cc * 2; return st * 1024 + (ob ^ (((ob >> 9) & 1) << 5)); }
__host__ __device__ __forceinline__ void stage_rc(int b, int& R, int& C) { const int st = b / 1024, sb = b % 1024, swz = sb ^ (((sb >> 9) & 1) << 5); R = (st >> 1) * 16 + swz / 64; C = (st & 1) * 32 + (swz % 64) / 2; }
__host__ __device__ __forceinline__ int perm32(int rho) { const int n = rho >> 4, i = rho & 15; return 8 * (i >> 2) + 4 * n + (i & 3); }

struct Unit { int pm, pn; };
struct Gemm { const bf16_t* A; const bf16_t* Bt; int M, N, K; };

struct StaticOrder {
    int nM, nN, nwg, G, c;
    __host__ __device__ void init(int M, int N, int G_, int c_) { nM = M / BM; nN = N / BM; nwg = nM * nN; G = G_; c = c_; }
    __host__ __device__ bool next(int i, Unit& u) const {
        const long L = (long)i * G + c; if (L >= nwg) return false;
        int wgid = (int)L; { const int q = nwg / NXCD, r = nwg % NXCD, xcd = wgid % NXCD, off = wgid / NXCD; wgid = (xcd < r ? xcd * (q + 1) : r * (q + 1) + (xcd - r) * q) + off; }
        const int nig = WGM * nN, gid = wgid / nig, fm = gid * WGM, gsz = (nM - fm) < WGM ? (nM - fm) : WGM;
        u.pm = fm + ((wgid % nig) % gsz); u.pn = (wgid % nig) / gsz; return true;
    }
    __device__ __forceinline__ void a_ready(const Unit&) const {}
    __device__ __forceinline__ void done(const Unit&) const {}
};

__device__ __forceinline__ unsigned cvt_pk_bf16(float lo, float hi) { unsigned r; asm volatile("v_cvt_pk_bf16_f32 %0, %1, %2" : "=v"(r) : "v"(lo), "v"(hi)); return r; }
typedef float f32x2 __attribute__((ext_vector_type(2)));
__device__ __forceinline__ f32x2 gelu_pk(f32x2 v) {
    const f32x2 av = __builtin_elementwise_abs(v), d = av * 0.2316418882f + 1.0f;
    f32x2 t; t.x = __builtin_amdgcn_rcpf(d.x); t.y = __builtin_amdgcn_rcpf(d.y);
    f32x2 q = t * 0.5307027145f + (-0.7265760135f); q = q * t + 0.7107068705f; q = q * t + (-0.142248368f); q = q * t + 0.127414796f; q = q * t;
    const f32x2 s = (v * v) * (-0.72134752044f);
    f32x2 e; e.x = __builtin_amdgcn_exp2f(s.x); e.y = __builtin_amdgcn_exp2f(s.y);
    const f32x2 m = v * (q * e), r = v - m;
    f32x2 o; o.x = v.x < 0.f ? m.x : r.x; o.y = v.y < 0.f ? m.y : r.y; return o;
}

template <int ACT  > struct EpiBf16 {
    static constexpr bool PERM = true, AFTER_DRAIN = false; static_assert(ACT == 0 || ACT == 1, "EpiBf16: ACT is 0 (none) or 1 (gelu_pk)");
    bf16_t* O; int ldc; const float* bias; int split_cols; size_t split_stride; float scale0;
    __device__ __forceinline__ void operator()(const f32x4 (&acc)[2][2][4][2], const Unit& u, int wr, int wc, int fr, int fq) const {
        const int row0 = u.pm * BM + wr * 64 + fr; int colt = u.pn * BM; bf16_t* base = O;
        float sc = 1.f; if (split_cols) { const int t = colt / split_cols; base += (size_t)t * split_stride; colt -= t * split_cols; if (t == 0) sc = scale0; }
        const int col0 = colt + wc * 32 + 8 * fq, bcol0 = u.pn * BM + wc * 32 + 8 * fq;
        f32x4 bv[2][2];
#pragma unroll
        for (int bj = 0; bj < 2; ++bj)
#pragma unroll
            for (int n = 0; n < 2; ++n) bv[bj][n] = bias ? *(const f32x4*)(bias + bcol0 + bj * HALF + 4 * n) : (f32x4){0.f, 0.f, 0.f, 0.f};
#pragma unroll
        for (int ai = 0; ai < 2; ++ai)
#pragma unroll
            for (int m = 0; m < 4; ++m) { bf16_t* rowp = base + (size_t)(row0 + ai * HALF + m * 16) * ldc + col0;
#pragma unroll
                for (int bj = 0; bj < 2; ++bj) { f32x4 v0 = acc[ai][bj][m][0] + bv[bj][0], v1 = acc[ai][bj][m][1] + bv[bj][1];
                    if (ACT == 1) { f32x2 a = gelu_pk((f32x2){v0[0], v0[1]}), b = gelu_pk((f32x2){v0[2], v0[3]}), c = gelu_pk((f32x2){v1[0], v1[1]}), d = gelu_pk((f32x2){v1[2], v1[3]});
                        v0 = (f32x4){a.x, a.y, b.x, b.y}; v1 = (f32x4){c.x, c.y, d.x, d.y}; }
                    v0 = v0 * sc; v1 = v1 * sc; u32x4 w; w.x = cvt_pk_bf16(v0[0], v0[1]); w.y = cvt_pk_bf16(v0[2], v0[3]); w.z = cvt_pk_bf16(v1[0], v1[1]); w.w = cvt_pk_bf16(v1[2], v1[3]);
                    *(u32x4*)(rowp + bj * HALF) = w; } }
    }
};

struct EpiResid {
    static constexpr bool PERM = false, AFTER_DRAIN = false;
    const bf16_t* xn; const float* xscale; bf16_t* xb; float* rowsq; int ldc;
    __device__ __forceinline__ void operator()(const f32x4 (&acc)[2][2][4][2], const Unit& u, int wr, int wc, int fr, int fq) const {
        typedef unsigned u32x2v __attribute__((ext_vector_type(2)));
        const int col0 = u.pn * BM + wc * 32 + 4 * fq;
        const size_t base = (size_t)(u.pm * BM + wr * 64 + fr) * ldc + col0;
        u32x2v xv[2][4]; float xs[2];
#define EPR_LOAD(SET, G) do { const int r_ = ((G) >> 2) * HALF + ((G) & 3) * 16; const size_t off_ = base + (size_t)r_ * ldc; xs[SET] = xscale[u.pm * BM + wr * 64 + fr + r_]; \
        _Pragma("unroll") for (int bj = 0; bj < 2; ++bj) _Pragma("unroll") for (int n = 0; n < 2; ++n) xv[SET][bj * 2 + n] = __builtin_nontemporal_load((const u32x2v*)(xn + off_ + bj * HALF + n * 16)); } while (0)
        EPR_LOAD(0, 0);
#pragma unroll
        for (int g = 0; g < 8; ++g) {
            const int ai = g >> 2, m = g & 3;
            if (g + 1 < 8) { if ((g & 1) == 0) EPR_LOAD(1, g + 1); else EPR_LOAD(0, g + 1); }
            const int row = u.pm * BM + ai * HALF + wr * 64 + m * 16 + fr;
            const size_t off = base + (size_t)(ai * HALF + m * 16) * ldc;
            const float sc = xs[g & 1];
            float ss = 0.f;
#pragma unroll
            for (int bj = 0; bj < 2; ++bj)
#pragma unroll
                for (int n = 0; n < 2; ++n) {
                    const size_t c = off + bj * HALF + n * 16;
                    const u32x2v xr = xv[g & 1][bj * 2 + n];
                    f32x4 o = acc[ai][bj][m][n];
                    o[0] += __uint_as_float(xr.x << 16) * sc; o[1] += __uint_as_float(xr.x & 0xffff0000u) * sc;
                    o[2] += __uint_as_float(xr.y << 16) * sc; o[3] += __uint_as_float(xr.y & 0xffff0000u) * sc;
                    ss += (o[0] * o[0] + o[1] * o[1]) + (o[2] * o[2] + o[3] * o[3]);
                    u32x2v w; w.x = cvt_pk_bf16(o[0], o[1]); w.y = cvt_pk_bf16(o[2], o[3]);
                    *(u32x2v*)(xb + c) = w;
                }
            ss += __shfl_xor(ss, 16); ss += __shfl_xor(ss, 32);
            if (fq == 0) atomicAdd(rowsq + row, ss);
        }
#undef EPR_LOAD
    }
};

struct EpiProj {
    static constexpr bool PERM = true, AFTER_DRAIN = false;
    bf16_t* O; int ldc; const float* qnw; const float* knw; const float* cosT; const float* sinT; PG8_LAS float* xch; int q_lo, k_lo, k_hi, seq_mask; float eps;
    __device__ __forceinline__ void operator()(const f32x4 (&acc)[2][2][4][2], const Unit& u, int wr, int wc, int fr, int fq) const {
        const int colt = u.pn * BM, row0 = u.pm * BM + wr * 64 + fr, col0 = colt + wc * 32 + 8 * fq;
        if (colt < q_lo || colt >= k_hi) {
#pragma unroll
            for (int ai = 0; ai < 2; ++ai)
#pragma unroll
                for (int m = 0; m < 4; ++m) { bf16_t* rowp = O + (size_t)(row0 + ai * HALF + m * 16) * ldc + col0;
#pragma unroll
                    for (int bj = 0; bj < 2; ++bj) { const f32x4 v0 = acc[ai][bj][m][0], v1 = acc[ai][bj][m][1];
                        u32x4 w; w.x = cvt_pk_bf16(v0[0], v0[1]); w.y = cvt_pk_bf16(v0[2], v0[3]); w.z = cvt_pk_bf16(v1[0], v1[1]); w.w = cvt_pk_bf16(v1[2], v1[3]);
                        *(u32x4*)(rowp + bj * HALF) = w; } }
            return;
        }
        const float* nw = colt < k_lo ? qnw : knw;
#pragma unroll
        for (int ai = 0; ai < 2; ++ai)
#pragma unroll
            for (int m = 0; m < 4; ++m)
#pragma unroll
                for (int bj = 0; bj < 2; ++bj) {
                    const f32x4 a = acc[ai][bj][m][0], b = acc[ai][bj][m][1];
                    float ss = ((a[0] * a[0] + a[1] * a[1]) + (a[2] * a[2] + a[3] * a[3])) + ((b[0] * b[0] + b[1] * b[1]) + (b[2] * b[2] + b[3] * b[3]));
                    ss += __shfl_xor(ss, 16); ss += __shfl_xor(ss, 32);
                    if (fq == 0) xch[((ai * HALF + wr * 64 + m * 16 + fr) * 4 + bj * 2 + (wc >> 1)) * 2 + (wc & 1)] = ss;
                }
        asm volatile("s_waitcnt lgkmcnt(0)" ::: "memory"); __builtin_amdgcn_s_barrier(); asm volatile("" ::: "memory");
        float wv[8];
#pragma unroll
        for (int n = 0; n < 2; ++n)
#pragma unroll
            for (int j = 0; j < 4; ++j) wv[4 * n + j] = nw[32 * (wc & 1) + 8 * fq + 4 * n + j];
        const bool rot = ((wc & 1) == 0) && (fq < 2);
#pragma unroll
        for (int ai = 0; ai < 2; ++ai)
#pragma unroll
            for (int m = 0; m < 4; ++m) {
                const int rl = ai * HALF + wr * 64 + m * 16 + fr, row = u.pm * BM + rl, pos = row & seq_mask;
                f32x4 cs0 = {1.f, 1.f, 1.f, 1.f}, cs1 = cs0, sn0 = {0.f, 0.f, 0.f, 0.f}, sn1 = sn0;
                if (rot) { cs0 = *(const f32x4*)(cosT + pos * 8); cs1 = *(const f32x4*)(cosT + pos * 8 + 4); sn0 = *(const f32x4*)(sinT + pos * 8); sn1 = *(const f32x4*)(sinT + pos * 8 + 4); }
                bf16_t* rowp = O + (size_t)row * ldc + col0;
#pragma unroll
                for (int bj = 0; bj < 2; ++bj) {
                    const int xi = (rl * 4 + bj * 2 + (wc >> 1)) * 2;
                    const float rs = rsqrtf((xch[xi] + xch[xi + 1]) * (1.f / 64.f) + eps);
                    f32x4 y0 = acc[ai][bj][m][0] * rs, y1 = acc[ai][bj][m][1] * rs;
#pragma unroll
                    for (int j = 0; j < 4; ++j) { y0[j] *= wv[j]; y1[j] *= wv[4 + j]; }
                    f32x4 p0, p1;
#pragma unroll
                    for (int j = 0; j < 4; ++j) { p0[j] = __shfl_xor(y0[j], 16); p1[j] = __shfl_xor(y1[j], 16); }
                    if (rot) {
                        if (fq == 0) { y0 = y0 * cs0 - p0 * sn0; y1 = y1 * cs1 - p1 * sn1; }
                        else { y0 = p0 * sn0 + y0 * cs0; y1 = p1 * sn1 + y1 * cs1; }
                    }
                    u32x4 w; w.x = cvt_pk_bf16(y0[0], y0[1]); w.y = cvt_pk_bf16(y0[2], y0[3]); w.z = cvt_pk_bf16(y1[0], y1[1]); w.w = cvt_pk_bf16(y1[2], y1[3]);
                    *(u32x4*)(rowp + bj * HALF) = w;
                }
            }
    }
};

template <class Epi, class Sched, bool ALIGN_EPI = false, bool SP2 = false>
__device__ __forceinline__ void gemm_phase(PG8_LAS unsigned char* lds, const Gemm g, const Sched& S, const Epi& E) {
    const int tid = threadIdx.x, wid = __builtin_amdgcn_readfirstlane(tid >> 6), lane = tid & 63, wr = wid >> 2, wc = wid & 3, fr = lane & 15, fq = lane >> 4;
    const int K = g.K, nt = K / BK;
    unsigned voffA[2], voffB[2];
#pragma unroll
    for (int i = 0; i < 2; ++i) { int R, C; stage_rc(tid * 16 + i * 8192, R, C); const int Rb = Epi::PERM ? ((R & ~31) + perm32(R & 31)) : R;
        voffA[i] = (unsigned)(R * K + C) * 2u; voffB[i] = (unsigned)(Rb * K + C) * 2u; }
    const size_t kstep = (size_t)(BK * 2);
    const size_t hstep = (size_t)HALF * K * 2;
    const size_t tstep = 2 * hstep;
    const unsigned ldsw = (unsigned)wid * 1024u;
    const int aoff = lds_byte(wr * 64 + fr, fq * 8), boff = lds_byte(wc * 32 + fr, fq * 8);
#define PG8_SA(b, h) (((b) * 2 + (h)) * HTB)
#define PG8_SB(b, h) ((4 + (b) * 2 + (h)) * HTB)
#define PG8_STAGE(bufoff, gbase, voff) do { _Pragma("unroll") for (int _i = 0; _i < 2; ++_i) \
        __builtin_amdgcn_global_load_lds((const unsigned*)((const char*)(gbase) + (voff)[_i]), (PG8_LAS unsigned*)(lds + (bufoff) + ldsw + _i * 8192), 16, 0, 0); } while (0)
#define PG8_LDA(dst, b, h) do { _Pragma("unroll") for (int m = 0; m < 4; ++m) _Pragma("unroll") for (int k = 0; k < 2; ++k) dst[m][k] = *(const PG8_LAS bf16x8*)(lds + PG8_SA(b, h) + aoff + m * 2048 + k * 1024); } while (0)
#define PG8_LDB(dst, b, h) do { _Pragma("unroll") for (int n = 0; n < 2; ++n) _Pragma("unroll") for (int k = 0; k < 2; ++k) dst[n][k] = *(const PG8_LAS bf16x8*)(lds + PG8_SB(b, h) + boff + n * 2048 + k * 1024); } while (0)
#define PG8_MMA(ai, bj, At, Bt) do { __builtin_amdgcn_s_setprio(1); _Pragma("unroll") for (int m = 0; m < 4; ++m) _Pragma("unroll") for (int n = 0; n < 2; ++n) _Pragma("unroll") for (int k = 0; k < 2; ++k) \
        acc[ai][bj][m][n] = __builtin_amdgcn_mfma_f32_16x16x32_bf16(Bt[n][k], At[m][k], acc[ai][bj][m][n], 0, 0, 0); __builtin_amdgcn_s_setprio(0); } while (0)
#define PG8_WAIT_V(n) asm volatile("s_waitcnt vmcnt(" #n ")" ::: "memory")
#define PG8_WAIT_L(n) asm volatile("s_waitcnt lgkmcnt(" #n ")" ::: "memory")
#define PG8_BAR __builtin_amdgcn_s_barrier()
#define PG8_SCHED __builtin_amdgcn_sched_barrier(0)
    Unit cur, nxt; int ui = 0;
    if (!S.next(0, cur)) return;
    f32x4 acc[2][2][4][2];
#pragma unroll
    for (int a = 0; a < 2; ++a)
#pragma unroll
        for (int b = 0; b < 2; ++b)
#pragma unroll
            for (int m = 0; m < 4; ++m)
#pragma unroll
                for (int n = 0; n < 2; ++n) acc[a][b][m][n] = (f32x4){0.f, 0.f, 0.f, 0.f};
    bf16x8 At[4][2], B0[2][2], B1[2][2];
    const char* cA = (const char*)g.A + (size_t)cur.pm * tstep; const char* cB = (const char*)g.Bt + (size_t)cur.pn * tstep;
    S.a_ready(cur);
    if constexpr (SP2) {
        PG8_STAGE(PG8_SB(0, 0), cB, voffB); PG8_STAGE(PG8_SB(0, 1), cB + hstep, voffB); PG8_STAGE(PG8_SA(0, 0), cA, voffA); PG8_STAGE(PG8_SA(0, 1), cA + hstep, voffA);
        if (wr == 1) PG8_BAR;
        PG8_WAIT_V(2); PG8_BAR;
        PG8_STAGE(PG8_SB(1, 0), cB + kstep, voffB); PG8_STAGE(PG8_SA(1, 0), cA + kstep, voffA); PG8_STAGE(PG8_SB(1, 1), cB + hstep + kstep, voffB);
        PG8_WAIT_V(6); PG8_BAR;
    } else {
        PG8_STAGE(PG8_SB(0, 0), cB, voffB); PG8_STAGE(PG8_SA(0, 0), cA, voffA); PG8_STAGE(PG8_SB(0, 1), cB + hstep, voffB); PG8_STAGE(PG8_SA(0, 1), cA + hstep, voffA);
        if (wr == 1) PG8_BAR;
        PG8_WAIT_V(4); PG8_BAR;
        PG8_STAGE(PG8_SB(1, 0), cB + kstep, voffB); PG8_STAGE(PG8_SA(1, 0), cA + kstep, voffA); PG8_STAGE(PG8_SB(1, 1), cB + hstep + kstep, voffB);
        PG8_WAIT_V(6); PG8_BAR;
    }
    for (;;) {
        const bool has_next = S.next(ui + 1, nxt);
        const char* nA = has_next ? (const char*)g.A + (size_t)nxt.pm * tstep : cA; const char* nB = has_next ? (const char*)g.Bt + (size_t)nxt.pn * tstep : cB;
        for (int t = 0; t < nt; t += 2) {
            const bool last = (t == nt - 2);
            const char* a1 = cA + (size_t)(t + 1) * kstep;
            const char* a2 = last ? nA : cA + (size_t)(t + 2) * kstep; const char* b2 = last ? nB : cB + (size_t)(t + 2) * kstep;
            const char* a3 = a2 + kstep; const char* b3 = b2 + kstep;
            if (last && has_next) S.a_ready(nxt);
            if constexpr (SP2) {
            PG8_LDB(B0, 0, 0); PG8_LDB(B1, 0, 1); PG8_SCHED; PG8_LDA(At, 0, 0); PG8_STAGE(PG8_SA(1, 1), a1 + hstep, voffA);
            PG8_WAIT_V(8); PG8_WAIT_L(0); PG8_BAR; PG8_MMA(0, 0, At, B0); PG8_MMA(0, 1, At, B1); PG8_BAR; PG8_SCHED;
            PG8_LDA(At, 0, 1); PG8_STAGE(PG8_SB(0, 0), b2, voffB); PG8_STAGE(PG8_SB(0, 1), b2 + hstep, voffB); PG8_STAGE(PG8_SA(0, 0), a2, voffA);
            PG8_WAIT_V(8); PG8_WAIT_L(0); PG8_BAR; PG8_MMA(1, 0, At, B0); PG8_MMA(1, 1, At, B1); PG8_BAR; PG8_SCHED;
            PG8_LDB(B0, 1, 0); PG8_LDB(B1, 1, 1); PG8_SCHED; PG8_LDA(At, 1, 0); PG8_STAGE(PG8_SA(0, 1), a2 + hstep, voffA);
            PG8_WAIT_V(8); PG8_WAIT_L(0); PG8_BAR; PG8_MMA(0, 0, At, B0); PG8_MMA(0, 1, At, B1); PG8_BAR; PG8_SCHED;
            PG8_LDA(At, 1, 1); PG8_STAGE(PG8_SB(1, 0), b3, voffB); PG8_STAGE(PG8_SB(1, 1), b3 + hstep, voffB); PG8_STAGE(PG8_SA(1, 0), a3, voffA);
            PG8_WAIT_V(8); PG8_WAIT_L(0); PG8_BAR; PG8_MMA(1, 0, At, B0); PG8_MMA(1, 1, At, B1); PG8_BAR; PG8_SCHED;
            } else {
            PG8_LDB(B0, 0, 0); PG8_SCHED; PG8_LDA(At, 0, 0); PG8_STAGE(PG8_SA(1, 1), a1 + hstep, voffA);
            PG8_WAIT_L(8); PG8_BAR; PG8_WAIT_L(0); PG8_MMA(0, 0, At, B0); PG8_BAR; PG8_SCHED;
            PG8_LDB(B1, 0, 1); PG8_STAGE(PG8_SB(0, 0), b2, voffB);
            PG8_BAR; PG8_WAIT_L(0); PG8_MMA(0, 1, At, B1); PG8_BAR;
            PG8_LDA(At, 0, 1); PG8_STAGE(PG8_SA(0, 0), a2, voffA);
            PG8_BAR; PG8_WAIT_L(0); PG8_MMA(1, 0, At, B0); PG8_BAR; PG8_SCHED;
            PG8_STAGE(PG8_SB(0, 1), b2 + hstep, voffB);
            PG8_WAIT_V(6); PG8_BAR; PG8_MMA(1, 1, At, B1); PG8_BAR;
            PG8_LDB(B0, 1, 0); PG8_SCHED; PG8_LDA(At, 1, 0); PG8_STAGE(PG8_SA(0, 1), a2 + hstep, voffA);
            PG8_WAIT_L(8); PG8_BAR; PG8_WAIT_L(0); PG8_MMA(0, 0, At, B0); PG8_BAR; PG8_SCHED;
            PG8_LDB(B1, 1, 1); PG8_STAGE(PG8_SB(1, 0), b3, voffB);
            PG8_BAR; PG8_WAIT_L(0); PG8_MMA(0, 1, At, B1); PG8_BAR;
            PG8_LDA(At, 1, 1); PG8_STAGE(PG8_SA(1, 0), a3, voffA);
            PG8_BAR; PG8_WAIT_L(0); PG8_MMA(1, 0, At, B0); PG8_BAR; PG8_SCHED;
            PG8_STAGE(PG8_SB(1, 1), b3 + hstep, voffB);
            PG8_WAIT_V(6); PG8_BAR; PG8_MMA(1, 1, At, B1); PG8_BAR;
            }
        }
        if constexpr (ALIGN_EPI) { if (wr == 0) PG8_BAR; }
        if constexpr (!Epi::AFTER_DRAIN) { E(acc, cur, wr, wc, fr, fq); S.done(cur); }
        if (!has_next) break;
#pragma unroll
        for (int a = 0; a < 2; ++a)
#pragma unroll
            for (int b = 0; b < 2; ++b)
#pragma unroll
                for (int m = 0; m < 4; ++m)
#pragma unroll
                    for (int n = 0; n < 2; ++n) acc[a][b][m][n] = (f32x4){0.f, 0.f, 0.f, 0.f};
        cur = nxt; cA = nA; cB = nB; ++ui;
        if constexpr (ALIGN_EPI) { if (wr == 1) PG8_BAR; }
    }
    PG8_WAIT_V(0);
    if constexpr (!ALIGN_EPI) { if (wr == 0) PG8_BAR; }
    PG8_BAR;
    if constexpr (Epi::AFTER_DRAIN) { E.fused(acc, cur, wr, wc, fr, fq, lds, wid, lane); S.done(cur); }
#undef PG8_SA
#undef PG8_SB
#undef PG8_STAGE
#undef PG8_LDA
#undef PG8_LDB
#undef PG8_MMA
#undef PG8_WAIT_V
#undef PG8_WAIT_L
#undef PG8_BAR
#undef PG8_SCHED
}
}

struct Params {
    const float* in[22];
    float* out;
    unsigned char* ws;
    int ph_lo, ph_hi;
};
struct Ctx { LAS unsigned char* lds; int tid, lane, wave, vcu, G, gw, ngw; unsigned long long ta, tb, tc; };

__device__ __forceinline__ void p0_transpose_item(const float* W, int K, int Nreal, int thresh, const float* ksc, bf16_t* WT, LAS float* scr, int item, int nblk, int lane) {
    const int kb = item / nblk, nb = item % nblk, k0 = 64 * kb, n0 = 32 * nb;
    const int nr0 = n0 + (n0 >= thresh ? 8 : 0);
#pragma unroll 8
    for (int i = 0; i < 32; ++i) {
        const int kk = 2 * i + (lane >> 5);
        const float sc = ksc ? ksc[k0 + kk] : 1.f;
        scr[kk * 33 + (lane & 31)] = W[(size_t)(k0 + kk) * Nreal + nr0 + (lane & 31)] * sc;
    }
    LDS_WAIT(); asm volatile("" ::: "memory");
    const int c = lane & 7;
#pragma unroll
    for (int j = 0; j < 4; ++j) {
        const int n = (lane >> 3) + 8 * j; const LAS float* s = scr + (8 * c) * 33 + n;
        u32x4 o; o.x = pk2(s[0 * 33], s[1 * 33]); o.y = pk2(s[2 * 33], s[3 * 33]); o.z = pk2(s[4 * 33], s[5 * 33]); o.w = pk2(s[6 * 33], s[7 * 33]);
        *(u32x4*)(WT + (size_t)(n0 + n) * K + k0 + 8 * c) = o;
    }
    LDS_WAIT(); asm volatile("" ::: "memory");
}

__device__ __forceinline__ void phase0(const Params& p, Ctx& F) {
    const float* x = p.in[0]; const float* mixw = p.in[1]; const float* w_in = p.in[2];
    const float* w_out = p.in[16]; const float* ffnw = p.in[17]; const float* w_q = p.in[18]; const float* keys = p.in[19];
    const float* pu = p.in[20]; const float* pv = p.in[21];
    unsigned char* ws = p.ws;
    LAS float* scr = (LAS float*)(F.lds + F.wave * 8448);
    LAS float* wdt = (LAS float*)(F.lds + 69632);
    {
        constexpr int WLD = 132;
        LAS float* WQS = (LAS float*)F.lds;
        LAS float* KYS = (LAS float*)(F.lds + 64 * WLD * 4);
        bf16_t* wefft = (bf16_t*)(ws + WS_WQT);
        for (int u = F.vcu; u < 256; u += F.G) {
            const int hj = u >> 4, kt = u & 15;
            __syncthreads();
#pragma unroll
            for (int i = 0; i < 4; ++i) {
                const int pc = F.tid + 512 * i, k = pc >> 5, d4 = pc & 31;
                const f32x4 v = *(const f32x4*)(w_q + (size_t)(64 * kt + k) * 2048 + hj * 128 + d4 * 4);
                *(LAS f32x4*)(WQS + k * WLD + d4 * 4) = v * ffnw[64 * kt + k];
            }
#pragma unroll
            for (int i = 0; i < 8; ++i) {
                const int pc = F.tid + 512 * i, n = pc >> 5, d4 = pc & 31;
                *(LAS f32x4*)(KYS + n * WLD + d4 * 4) = *(const f32x4*)(keys + ((size_t)hj * 128 + n) * 128 + d4 * 4);
            }
            __syncthreads();
            const int fr_ = F.lane & 15, fq_ = F.lane >> 4, mt = F.wave >> 1, nt0 = (F.wave & 1) * 4;
            f32x4 acc[4];
#pragma unroll
            for (int q = 0; q < 4; ++q) acc[q] = (f32x4){0.f, 0.f, 0.f, 0.f};
#pragma unroll 4
            for (int ks = 0; ks < 32; ++ks) {
                const float av = WQS[(mt * 16 + fr_) * WLD + 4 * ks + fq_];
#pragma unroll
                for (int q = 0; q < 4; ++q) {
                    const float bv = KYS[((nt0 + q) * 16 + fr_) * WLD + 4 * ks + fq_];
                    acc[q] = __builtin_amdgcn_mfma_f32_16x16x4f32(av, bv, acc[q], 0, 0, 0);
                }
            }
#pragma unroll
            for (int q = 0; q < 4; ++q) {
                u32x2 w; w.x = pk2(acc[q][0], acc[q][1]); w.y = pk2(acc[q][2], acc[q][3]);
                *(u32x2*)(wefft + ((size_t)hj * 128 + (nt0 + q) * 16 + fr_) * DM + 64 * kt + mt * 16 + 4 * fq_) = w;
            }
        }
        __syncthreads();
    }
    for (int k = F.tid; k < DM; k += 512) {
        const float s = mixw[k];
        const f32x4 a = *(const f32x4*)(w_in + (size_t)k * 3080 + 1536), b = *(const f32x4*)(w_in + (size_t)k * 3080 + 1540);
        *(LAS f32x4*)(wdt + k * 8) = a * s; *(LAS f32x4*)(wdt + k * 8 + 4) = b * s;
    }
    __syncthreads();
    constexpr int I_IN = 16 * 96, I_OUT = 16 * 32;
    for (int it = F.gw; it < I_IN + I_OUT; it += F.ngw) {
        int r = it;
        if (r < I_IN) { p0_transpose_item(w_in, DM, 3080, 1536, mixw, (bf16_t*)(ws + WS_WINT), scr, r, 96, F.lane); continue; } r -= I_IN;
        p0_transpose_item(w_out, DM, DM, 1 << 30, nullptr, (bf16_t*)(ws + WS_WOUTT), scr, r, 32, F.lane);
    }
    const int gtid = F.vcu * 512 + F.tid, nthr = F.G * 512;
    for (int i = gtid; i < TOK; i += nthr) ((float*)(ws + WS_CTL) + CW_ROWSQ)[i] = 0.f;
    for (int i = gtid; i < SEQ * 8; i += nthr) {
        const int pos = i >> 3, f = i & 7;
        const float inv = powf(500000.0f, -(float)(2 * f) / 16.0f);
        const float ang = (float)pos * inv;
        ((float*)(ws + WS_ROPE))[i] = cosf(ang);
        ((float*)(ws + WS_ROPE))[SEQ * 8 + i] = sinf(ang);
    }
#if defined(PROBE_PHASE) && (PROBE_PHASE == 83 || PROBE_PHASE == 84)
    if (F.gw == 0 && F.lane == 0) { unsigned* mw = (unsigned*)(ws + WS_MISC); mw[2] = 0u; mw[3] = 0xffffffffu; mw[4] = 0u; }
#endif
    if (F.gw == 0) {
        const float a = p.in[11][F.lane] * p.in[12][F.lane], b = p.in[13][F.lane] * p.in[14][F.lane];
        const float sa = wave_sum(a), sb = wave_sum(b);
        if (F.lane == 0) ((float*)(ws + WS_MISC))[0] = expf(sa) - expf(sb) + LAMBDA_INIT;
    }
    {
        float* rsu = (float*)(ws + WS_RSU); float* rsv = (float*)(ws + WS_RSV);
        for (int r0 = F.gw; r0 < 2 * 16384; r0 += 4 * F.ngw) {
            f32x4 a[4][4]; float amax[4];
#pragma unroll
            for (int u = 0; u < 4; ++u) {
                const int r = min(r0 + u * F.ngw, 2 * 16384 - 1); const bool isU = r < 16384; const int e = r & 16383;
                const float* src = (isU ? pu : pv) + (size_t)e * DM + 16 * F.lane;
#pragma unroll
                for (int q = 0; q < 4; ++q) a[u][q] = __builtin_nontemporal_load((const f32x4*)(src + 4 * q));
            }
#pragma unroll
            for (int u = 0; u < 4; ++u) {
                const int r = min(r0 + u * F.ngw, 2 * 16384 - 1); const bool isU = r < 16384;
                amax[u] = 0.f;
#pragma unroll
                for (int q = 0; q < 4; ++q) {
                    if (isU) a[u][q] = a[u][q] * *(const f32x4*)(ffnw + 16 * F.lane + 4 * q);
                    amax[u] = fmaxf(amax[u], fmaxf(fmaxf(fabsf(a[u][q][0]), fabsf(a[u][q][1])), fmaxf(fabsf(a[u][q][2]), fabsf(a[u][q][3]))));
                }
            }
#pragma unroll
            for (int u = 0; u < 4; ++u) amax[u] = wave_max(amax[u]);
#pragma unroll
            for (int u = 0; u < 4; ++u) {
                const int r = min(r0 + u * F.ngw, 2 * 16384 - 1); const bool isU = r < 16384; const int e = r & 16383;
#ifdef U_FP4
#ifdef V_FP4
#define V_FP4_ON 1
#else
#define V_FP4_ON 0
#endif
#ifndef FP4_NIB_SWAP
#define FP4_NIB_SWAP 0
#endif
                if (isU || V_FP4_ON) {
                    const float s4 = amax[u] > 0.f ? 6.f / amax[u] : 1.f;
                    if (F.lane == 0) (isU ? rsu : rsv)[e] = amax[u] > 0.f ? amax[u] * (1.f / 6.f) : 1.f;
                    u32x2 o4;
#pragma unroll
                    for (int hq = 0; hq < 2; ++hq) {
                        unsigned w = 0u;
#pragma unroll
                        for (int q2 = 0; q2 < 2; ++q2)
#pragma unroll
                            for (int el = 0; el < 4; ++el) {
                                const float qv = a[u][hq * 2 + q2][el] * s4, m = fabsf(qv);
                                const unsigned c = (unsigned)(m > 0.25f) + (unsigned)(m > 0.75f) + (unsigned)(m > 1.25f) + (unsigned)(m > 1.75f) + (unsigned)(m > 2.5f) + (unsigned)(m > 3.5f) + (unsigned)(m > 5.0f)
                                                 + (qv < 0.f ? 8u : 0u);
                                w |= c << (4 * ((q2 * 4 + el) ^ FP4_NIB_SWAP));
                            }
                        o4[hq] = w;
                    }
                    *(u32x2*)(ws + (isU ? WS_UB : WS_VB) + (size_t)e * (DM / 2) + 8 * F.lane) = o4;
                    continue;
                }
#endif
                const float sc = amax[u] > 0.f ? 240.f / amax[u] : 1.f;
                if (F.lane == 0) (isU ? rsu : rsv)[e] = amax[u] > 0.f ? amax[u] * (1.f / 240.f) : 1.f;
                u32x4 o;
#pragma unroll
                for (int q = 0; q < 4; ++q) {
                    int pk = 0;
                    pk = __builtin_amdgcn_cvt_pk_fp8_f32(a[u][q][0] * sc, a[u][q][1] * sc, pk, false);
                    pk = __builtin_amdgcn_cvt_pk_fp8_f32(a[u][q][2] * sc, a[u][q][3] * sc, pk, true);
                    o[q] = (unsigned)pk;
                }
                *(u32x4*)(ws + (isU ? WS_UB : WS_VB) + (size_t)e * DM + 16 * F.lane) = o;
            }
        }
    }
    bf16_t* xb = (bf16_t*)(ws + WS_XB); float* dtraw = (float*)(ws + WS_DTRAW);
    for (int m0 = F.gw; m0 < TOK; m0 += 2 * F.ngw) {
        f32x4 v[2][4]; float ss[2];
#pragma unroll
        for (int u = 0; u < 2; ++u) {
            const int m = m0 + u * F.ngw; ss[u] = 0.f;
            const f32x4* xr = (const f32x4*)(x + (size_t)(m < TOK ? m : m0) * DM) + F.lane;
#pragma unroll
            for (int j = 0; j < 4; ++j) v[u][j] = __builtin_nontemporal_load(xr + 64 * j);
        }
#pragma unroll
        for (int u = 0; u < 2; ++u)
#pragma unroll
            for (int j = 0; j < 4; ++j) ss[u] += (v[u][j][0] * v[u][j][0] + v[u][j][1] * v[u][j][1]) + (v[u][j][2] * v[u][j][2] + v[u][j][3] * v[u][j][3]);
        f32x4 d0[2], d1[2];
#pragma unroll
        for (int u = 0; u < 2; ++u) { d0[u] = (f32x4){0.f, 0.f, 0.f, 0.f}; d1[u] = (f32x4){0.f, 0.f, 0.f, 0.f}; }
#pragma unroll
        for (int j = 0; j < 4; ++j)
#pragma unroll
            for (int e = 0; e < 4; ++e) {
                const int k = 256 * j + 4 * F.lane + e;
                const f32x4 w0 = *(const LAS f32x4*)(wdt + k * 8), w1 = *(const LAS f32x4*)(wdt + k * 8 + 4);
#pragma unroll
                for (int u = 0; u < 2; ++u) { d0[u] += w0 * v[u][j][e]; d1[u] += w1 * v[u][j][e]; }
            }
#pragma unroll
        for (int u = 0; u < 2; ++u) {
            ss[u] = wave_sum(ss[u]);
#pragma unroll
            for (int e = 0; e < 4; ++e) { d0[u][e] = wave_sum(d0[u][e]); d1[u][e] = wave_sum(d1[u][e]); }
        }
#pragma unroll
        for (int u = 0; u < 2; ++u) {
            const int m = m0 + u * F.ngw;
            if (m < TOK) {
                const float r = rsqrtf(ss[u] * (1.f / DM) + EPSN);
                if (F.lane == 0) ((float*)(ws + WS_RSTD))[m] = sqrtf(ss[u] * (1.f / DM) + EPSN);
                if (F.lane == 0) { *(f32x4*)(dtraw + (size_t)m * 8) = d0[u] * r; *(f32x4*)(dtraw + (size_t)m * 8 + 4) = d1[u] * r; }
                unsigned long long* o8 = (unsigned long long*)(xb + (size_t)m * DM) + F.lane;
#pragma unroll
                for (int j = 0; j < 4; ++j) o8[64 * j] = (unsigned long long)pk2(v[u][j][0] * r, v[u][j][1] * r) | ((unsigned long long)pk2(v[u][j][2] * r, v[u][j][3] * r) << 32);
            }
        }
    }
}

__device__ __forceinline__ void p2_qk_prepass(const Params& p, Ctx& F) {
    bf16_t* proj = (bf16_t*)(p.ws + WS_PROJ);
    const float* qnw = p.in[9]; const float* knw = p.in[10];
    const float* cosT = (const float*)(p.ws + WS_ROPE); const float* sinT = cosT + SEQ * 8;
    const int sub = F.lane & 7;
    float wq[8], wk[8];
#pragma unroll
    for (int e = 0; e < 8; ++e) { wq[e] = qnw[sub * 8 + e]; wk[e] = knw[sub * 8 + e]; }
    for (int base = F.gw; base < TOK * 2; base += 8 * F.ngw) {
        u32x4 raw[8];
#pragma unroll
        for (int u = 0; u < 8; ++u) {
            const int wsi = base + u * F.ngw;
            raw[u] = (wsi < TOK * 2) ? *(const u32x4*)(proj + (size_t)(wsi >> 1) * NIN + ((wsi & 1) ? PK : PQ) + F.lane * 8) : (u32x4){0u, 0u, 0u, 0u};
        }
#pragma unroll
        for (int u = 0; u < 8; ++u) {
            const int wsi = base + u * F.ngw;
            const int t = wsi >> 1, which = wsi & 1;
            float v[8];
#pragma unroll
            for (int e = 0; e < 4; ++e) { v[2 * e] = bf2f(raw[u][e] & 0xffffu); v[2 * e + 1] = bf2f(raw[u][e] >> 16); }
            float ss = 0.f;
#pragma unroll
            for (int e = 0; e < 8; ++e) ss += v[e] * v[e];
            ss += __shfl_xor(ss, 1); ss += __shfl_xor(ss, 2); ss += __shfl_xor(ss, 4);
            const float rs = rsqrtf(ss * (1.f / 64.f) + EPSN);
            const int pos = t & (SEQ - 1);
            float o[8];
#pragma unroll
            for (int e = 0; e < 8; ++e) {
                const float y = v[e] * rs * (which ? wk[e] : wq[e]);
                const float other = __shfl_xor(y, 1);
                float r = y;
                if (sub < 2) {
                    const float c = cosT[pos * 8 + e], sn = sinT[pos * 8 + e];
                    r = (sub == 0) ? (y * c - other * sn) : (other * sn + y * c);
                }
                o[e] = r;
            }
            u32x4 ov; ov.x = pk2(o[0], o[1]); ov.y = pk2(o[2], o[3]); ov.z = pk2(o[4], o[5]); ov.w = pk2(o[6], o[7]);
            if (wsi < TOK * 2) *(u32x4*)(proj + (size_t)t * NIN + (which ? PK : PQ) + F.lane * 8) = ov;
        }
    }
}

constexpr int P2_XS = 0, P2_BM = 33792, P2_CM = 51200, P2_CB = 68608, P2_MH = 85248, P2_XW = 122112, P2_ACS = 155904, P2_DT = 156928, P2_FAC = 157952;
constexpr int XS_LD = 264, BM_LD = 136, MH_LD = 72, CB_LD = 65;
static_assert(P2_FAC + 1024 <= LDS_BYTES, "P2 LDS");

__device__ __forceinline__ void p2_load_raw(const bf16_t* proj, int tid, int b, int c, int g, u32x4 (&rv)[11]) {
    const int cg = tid & 63, rg = tid >> 6, lc = cg * 8;
    const int pcol = lc < 256 ? PXS + g * 256 + lc : (lc < 384 ? PBM + g * 128 + (lc - 256) : PCM + g * 128 + (lc - 384));
#pragma unroll
    for (int i = 0; i < 11; ++i) {
        const int f = c * CHUNK + rg * 8 - 3 + i;
        u32x4 v = {0u, 0u, 0u, 0u};
        if (f >= 0) v = *(const u32x4*)(proj + ((size_t)b * SEQ + f) * NIN + pcol);
        rv[i] = v;
    }
}
__device__ __forceinline__ void p2_ssd_unit(const Params& p, Ctx& F, int b, int c, int g, u32x4 (&rv)[11], bool has_next, int nb, int nc, int ng) {
    unsigned char* ws = p.ws;
    const bf16_t* proj = (const bf16_t*)(ws + WS_PROJ);
    bf16_t* ycat = (bf16_t*)(ws + WS_YCAT); bf16_t* cmc = (bf16_t*)(ws + WS_CMC);
    bf16_t* states = (bf16_t*)(ws + WS_STATES); float* acs_g = (float*)(ws + WS_ACS); float* cdec = (float*)(ws + WS_CDEC);
    const float* dtraw = (const float*)(ws + WS_DTRAW);
    const float* conv_w = p.in[3]; const float* conv_b = p.in[4]; const float* dt_bias = p.in[5]; const float* a_log = p.in[6]; const float* d_skip = p.in[7];
    LAS bf16_t* XS = (LAS bf16_t*)(F.lds + P2_XS); LAS bf16_t* BM = (LAS bf16_t*)(F.lds + P2_BM); LAS bf16_t* CM = (LAS bf16_t*)(F.lds + P2_CM);
    LAS float* CB = (LAS float*)(F.lds + P2_CB); LAS bf16_t* MH = (LAS bf16_t*)(F.lds + P2_MH); LAS bf16_t* XW = (LAS bf16_t*)(F.lds + P2_XW);
    LAS float* ACS = (LAS float*)(F.lds + P2_ACS); LAS float* DT = (LAS float*)(F.lds + P2_DT); LAS float* FAC = (LAS float*)(F.lds + P2_FAC);
    const int tid = F.tid, lane = F.lane, wave = F.wave, fr = lane & 15, fq = lane >> 4;
    const size_t tbase = (size_t)b * SEQ + (size_t)c * CHUNK;
#ifndef SKIP_A
    {
        const int cg = tid & 63, rg = tid >> 6, lc = cg * 8;
        int pcol, dld, dcol, kind;
        if (lc < 256) { pcol = PXS + g * 256 + lc; dld = XS_LD; dcol = lc; kind = 0; }
        else if (lc < 384) { pcol = PBM + g * 128 + (lc - 256); dld = BM_LD; dcol = lc - 256; kind = 1; }
        else { pcol = PCM + g * 128 + (lc - 384); dld = BM_LD; dcol = lc - 384; kind = 2; }
        LAS bf16_t* dst = kind == 0 ? XS : (kind == 1 ? BM : CM);
        const int ch = pcol - 512;
        float cw[4][8], cbv[8];
#pragma unroll
        for (int w = 0; w < 4; ++w) {
            const f32x4 a = *(const f32x4*)(conv_w + w * 1024 + ch), bq = *(const f32x4*)(conv_w + w * 1024 + ch + 4);
#pragma unroll
            for (int e = 0; e < 4; ++e) { cw[w][e] = a[e]; cw[w][4 + e] = bq[e]; }
        }
        { const f32x4 a = *(const f32x4*)(conv_b + ch), bq = *(const f32x4*)(conv_b + ch + 4);
#pragma unroll
          for (int e = 0; e < 4; ++e) { cbv[e] = a[e]; cbv[4 + e] = bq[e]; } }
#pragma unroll
        for (int r = 0; r < 8; ++r) {
            const int l = rg * 8 + r;
            float o[8];
#pragma unroll
            for (int e = 0; e < 8; ++e) o[e] = cbv[e];
#pragma unroll
            for (int w = 0; w < 4; ++w)
#pragma unroll
                for (int e = 0; e < 4; ++e) {
                    o[2 * e] += cw[w][2 * e] * bf2f(rv[r + w][e] & 0xffffu);
                    o[2 * e + 1] += cw[w][2 * e + 1] * bf2f(rv[r + w][e] >> 16);
                }
#pragma unroll
            for (int e = 0; e < 8; ++e) o[e] = silu_f(o[e]);
            u32x4 ov; ov.x = pk2(o[0], o[1]); ov.y = pk2(o[2], o[3]); ov.z = pk2(o[4], o[5]); ov.w = pk2(o[6], o[7]);
            *(LAS u32x4*)(dst + l * dld + dcol) = ov;
            if (kind == 2) *(u32x4*)(cmc + (tbase + l) * 256 + g * 128 + dcol) = ov;
        }
    }
#endif
    if (has_next) p2_load_raw(proj, tid, nb, nc, ng, rv);
    if (tid < 256) {
        const int l = tid >> 2, h = tid & 3, hh = g * 4 + h;
        const float v = dtraw[(tbase + l) * 8 + hh] + dt_bias[hh];
        const float dt = v > 20.f ? v : log1pf(expf(v));
        DT[l * 4 + h] = dt;
        ACS[l * 4 + h] = dt * (-expf(a_log[hh]));
    }
    __syncthreads();
    if (wave < 4) {
        float s = ACS[lane * 4 + wave];
#pragma unroll
        for (int o = 1; o < 64; o <<= 1) { const float t = __shfl_up(s, o); if (lane >= o) s += t; }
        ACS[lane * 4 + wave] = s;
        if (lane == 63) cdec[((size_t)b * NCH + c) * 8 + g * 4 + wave] = expf(s);
    }
    __syncthreads();
    if (tid < 256) {
        const int l = tid >> 2, h = tid & 3;
        acs_g[(tbase + l) * 8 + g * 4 + h] = ACS[l * 4 + h];
        FAC[l * 4 + h] = DT[l * 4 + h] * expf(ACS[63 * 4 + h] - ACS[l * 4 + h]);
    }
#pragma unroll
    for (int q = 0; q < 2; ++q) {
        const int tile = wave * 2 + q, mt = tile >> 2, nt = tile & 3;
        f32x4 acc = {0.f, 0.f, 0.f, 0.f};
#pragma unroll
        for (int ks = 0; ks < 4; ++ks) {
            const bf16x8 a = *(const LAS bf16x8*)(CM + (mt * 16 + fr) * BM_LD + ks * 32 + fq * 8);
            const bf16x8 bq = *(const LAS bf16x8*)(BM + (nt * 16 + fr) * BM_LD + ks * 32 + fq * 8);
            acc = mfma16(a, bq, acc);
        }
#pragma unroll
        for (int j = 0; j < 4; ++j) CB[(mt * 16 + 4 * fq + j) * CB_LD + nt * 16 + fr] = acc[j];
    }
    __syncthreads();
    {
        const int sI = lane;
        float as_[4], ds_[4];
#pragma unroll
        for (int h = 0; h < 4; ++h) { as_[h] = ACS[sI * 4 + h]; ds_[h] = DT[sI * 4 + h]; }
#pragma unroll 2
        for (int li = 0; li < 8; ++li) {
            const int l = li * 8 + wave;
            const float cb = CB[l * CB_LD + sI];
#pragma unroll
            for (int h = 0; h < 4; ++h) {
                const float v = (sI <= l) ? cb * __expf(ACS[l * 4 + h] - as_[h]) * ds_[h] : 0.f;
                MH[(h * 64 + l) * MH_LD + sI] = (bf16_t)f2bf(v);
            }
        }
#pragma unroll
        for (int i = 0; i < 4; ++i) {
            const int pc = tid + 512 * i, l = pc >> 5, c8 = pc & 31;
            const u32x4 xv = *(const LAS u32x4*)(XS + l * XS_LD + c8 * 8);
            const float f = FAC[l * 4 + (c8 >> 3)];
            u32x4 o;
#pragma unroll
            for (int e = 0; e < 4; ++e) o[e] = pk2(bf2f(xv[e] & 0xffffu) * f, bf2f(xv[e] >> 16) * f);
            *(LAS u32x4*)(XW + l * XS_LD + c8 * 8) = o;
        }
    }
    __syncthreads();
    typedef short v4i16 __attribute__((ext_vector_type(4)));
#define TR16(PTR) __builtin_amdgcn_ds_read_tr16_b64_v4i16((LAS v4i16*)(PTR))
#define CAT8(LO, HI) (bf16x8){LO[0], LO[1], LO[2], LO[3], HI[0], HI[1], HI[2], HI[3]}
    const int trr = fr >> 2, trc = 4 * (fr & 3);
#ifndef SKIP_E
    {
        const int h = wave >> 1, hh = g * 4 + h; const float dsk = d_skip[hh];
#pragma unroll 1
        for (int mq = 0; mq < 2; ++mq) {
            const int lt = 2 * (wave & 1) + mq;
            bf16x8 bmh[2];
#pragma unroll
            for (int ks = 0; ks < 2; ++ks) bmh[ks] = *(const LAS bf16x8*)(MH + (h * 64 + lt * 16 + fr) * MH_LD + ks * 32 + fq * 8);
#pragma unroll 1
            for (int pt = 0; pt < 4; ++pt) {
                f32x4 acc = {0.f, 0.f, 0.f, 0.f};
#pragma unroll
                for (int ks = 0; ks < 2; ++ks) {
                    const LAS bf16_t* bp = XS + (ks * 32 + 8 * fq + trr) * XS_LD + h * 64 + pt * 16 + trc;
                    const v4i16 lo = TR16(bp), hi = TR16(bp + 4 * XS_LD);
                    acc = mfma16(CAT8(lo, hi), bmh[ks], acc);
                }
                const int l = lt * 16 + fr, pp = pt * 16 + 4 * fq;
                const u32x2 xv = *(const LAS u32x2*)(XS + l * XS_LD + h * 64 + pp);
                u32x2 w;
                w.x = pk2(acc[0] + bf2f(xv.x & 0xffffu) * dsk, acc[1] + bf2f(xv.x >> 16) * dsk);
                w.y = pk2(acc[2] + bf2f(xv.y & 0xffffu) * dsk, acc[3] + bf2f(xv.y >> 16) * dsk);
                *(u32x2*)(ycat + (tbase + l) * DM + g * 256 + h * 64 + pp) = w;
            }
        }
    }
#endif
#ifndef SKIP_F
    {
        const int h = wave >> 1, hh = g * 4 + h;
        bf16_t* sbase = states + (((size_t)b * NCH + c) * 8 + hh) * 64 * 128;
#pragma unroll 1
        for (int mq = 0; mq < 2; ++mq) {
            const int mt = 2 * (wave & 1) + mq;
            bf16x8 xw[2];
#pragma unroll
            for (int ks = 0; ks < 2; ++ks) {
                const LAS bf16_t* bp = XW + (ks * 32 + 8 * fq + trr) * XS_LD + h * 64 + mt * 16 + trc;
                const v4i16 lo = TR16(bp), hi = TR16(bp + 4 * XS_LD);
                xw[ks] = CAT8(lo, hi);
            }
#pragma unroll 1
            for (int nt = 0; nt < 8; ++nt) {
                f32x4 acc = {0.f, 0.f, 0.f, 0.f};
#pragma unroll
                for (int ks = 0; ks < 2; ++ks) {
                    const LAS bf16_t* ap = BM + (ks * 32 + 8 * fq + trr) * BM_LD + nt * 16 + trc;
                    const v4i16 lo = TR16(ap), hi = TR16(ap + 4 * BM_LD);
                    acc = mfma16(CAT8(lo, hi), xw[ks], acc);
                }
                u32x2 w; w.x = pk2(acc[0], acc[1]); w.y = pk2(acc[2], acc[3]);
                *(u32x2*)(sbase + (size_t)(mt * 16 + fr) * 128 + nt * 16 + 4 * fq) = w;
            }
        }
    }
#undef TR16
#undef CAT8
#endif
    __syncthreads();
}

__device__ __forceinline__ void phase2(const Params& p, Ctx& F) {
#if defined(PROBE_PHASE) && (PROBE_PHASE == 20 || PROBE_PHASE == 21)
    F.ta = __builtin_amdgcn_s_memrealtime();
#endif
#ifdef USE_QK_PREPASS
    p2_qk_prepass(p, F);
#endif
#if defined(PROBE_PHASE) && (PROBE_PHASE == 20 || PROBE_PHASE == 21)
    VM_WAIT(); F.tb = __builtin_amdgcn_s_memrealtime();
#endif
    {
        const bf16_t* proj = (const bf16_t*)(p.ws + WS_PROJ);
        u32x4 rv[11];
        if (F.vcu < NB * NCH * 2) p2_load_raw(proj, F.tid, F.vcu >> 7, (F.vcu >> 1) & 63, F.vcu & 1, rv);
        for (int u = F.vcu; u < NB * NCH * 2; u += F.G) {
            const int g = u & 1, c = (u >> 1) & 63, b = u >> 7;
            const int un = u + F.G;
            p2_ssd_unit(p, F, b, c, g, rv, un < NB * NCH * 2, un >> 7, (un >> 1) & 63, un & 1);
        }
    }
#if defined(PROBE_PHASE) && (PROBE_PHASE == 20 || PROBE_PHASE == 21)
    VM_WAIT(); F.tc = __builtin_amdgcn_s_memrealtime();
#endif
}

__device__ __forceinline__ void p3_scan(const Params& p, Ctx& F) {
    bf16_t* states = (bf16_t*)(p.ws + WS_STATES); const float* cdec = (const float*)(p.ws + WS_CDEC);
    const int gtid = F.vcu * 512 + F.tid, nthr = F.G * 512;
    for (int e = gtid; e < NB * 8 * 64 * 32; e += nthr) {
        const int n4 = e & 31, pp = (e >> 5) & 63, hh = (e >> 11) & 7, b = e >> 14;
        f32x4 carry = {0.f, 0.f, 0.f, 0.f};
        for (int c0 = 0; c0 < NCH; c0 += 16) {
            u32x2 s[16]; float dc[16];
#pragma unroll
            for (int i = 0; i < 16; ++i) {
                s[i] = *(const u32x2*)(states + ((((size_t)b * NCH + c0 + i) * 8 + hh) * 64 + pp) * 128 + n4 * 4);
                dc[i] = cdec[((size_t)b * NCH + c0 + i) * 8 + hh];
            }
#pragma unroll
            for (int i = 0; i < 16; ++i) {
                u32x2 w; w.x = pk2(carry[0], carry[1]); w.y = pk2(carry[2], carry[3]);
                *(u32x2*)(states + ((((size_t)b * NCH + c0 + i) * 8 + hh) * 64 + pp) * 128 + n4 * 4) = w;
                const f32x4 sv = {bf2f(s[i].x & 0xffffu), bf2f(s[i].x >> 16), bf2f(s[i].y & 0xffffu), bf2f(s[i].y >> 16)};
                carry = carry * dc[i] + sv;
            }
        }
    }
}

namespace att {
constexpr int NW = 8, QBLK = 32, KVBLK = 64;
constexpr float SCALE = 0.125f, THR = 8.f;
constexpr int SHM_V = KVBLK * 128 * 2, SHM_K = KVBLK * 64 * 2;
constexpr int SLOT = SHM_V + SHM_K, NSLOT = 4, LDS_WS = NSLOT * SLOT, LDS_END = LDS_WS + NW * 64 * 4;
#define KSWZ64(row, colB) ((row) * 128 + ((colB) ^ ((((row) >> 1) & 7) << 4)))
#define SBAR() __builtin_amdgcn_sched_barrier(0)
__device__ __forceinline__ int crow(int r, int hi) { return (r & 3) + 8 * (r >> 2) + 4 * hi; }
__device__ __forceinline__ unsigned cvtpk(float lo, float hi) { unsigned r; asm volatile("v_cvt_pk_bf16_f32 %0, %1, %2" : "=v"(r) : "v"(lo), "v"(hi)); return r; }

__device__ __forceinline__ void partialSM(f32x16& p0, f32x16& p1, float& m_reg, float& mn, float& alpha) {
    constexpr float C = SCALE * 1.4426950408889634f;
    float pmax = p0[0];
#pragma unroll
    for (int r = 1; r < 16; ++r) pmax = fmaxf(pmax, p0[r]);
#pragma unroll
    for (int r = 0; r < 16; ++r) pmax = fmaxf(pmax, p1[r]);
    { auto rr = __builtin_amdgcn_permlane32_swap(__float_as_uint(pmax), __float_as_uint(pmax), false, false);
      pmax = fmaxf(__uint_as_float(rr[0]), __uint_as_float(rr[1])); }
    if (__builtin_expect(__all(pmax - m_reg <= THR / SCALE), 1)) { mn = m_reg; alpha = 1.f; }
    else { mn = fmaxf(m_reg, pmax); alpha = __builtin_amdgcn_exp2f((m_reg - mn) * C); m_reg = mn; }
    const float mnC = -mn * C;
#pragma unroll
    for (int r = 0; r < 16; ++r) p0[r] = fmaf(p0[r], C, mnC);
#pragma unroll
    for (int r = 0; r < 16; ++r) p1[r] = fmaf(p1[r], C, mnC);
#pragma unroll
    for (int r = 0; r < 16; ++r) p0[r] = __builtin_amdgcn_exp2f(p0[r]);
}
__device__ __forceinline__ void finishSM(f32x16& p0, f32x16& p1, float alpha, float& l_reg, bf16x8& pa0, bf16x8& pa1, bf16x8& pa2, bf16x8& pa3) {
#pragma unroll
    for (int r = 0; r < 16; ++r) p1[r] = __builtin_amdgcn_exp2f(p1[r]);
    float ps = 0;
#pragma unroll
    for (int r = 0; r < 16; ++r) ps += p0[r];
#pragma unroll
    for (int r = 0; r < 16; ++r) ps += p1[r];
    { auto rr = __builtin_amdgcn_permlane32_swap(__float_as_uint(ps), __float_as_uint(ps), false, false);
      ps = __uint_as_float(rr[0]) + __uint_as_float(rr[1]); }
    l_reg = l_reg * alpha + ps;
#define PK4(P, BASE, OUT) do { unsigned a0 = cvtpk(P[BASE + 0], P[BASE + 1]), a1 = cvtpk(P[BASE + 2], P[BASE + 3]);   \
    unsigned b0 = cvtpk(P[BASE + 4], P[BASE + 5]), b1 = cvtpk(P[BASE + 6], P[BASE + 7]);                              \
    auto r0 = __builtin_amdgcn_permlane32_swap(a0, b0, false, false); auto r1 = __builtin_amdgcn_permlane32_swap(a1, b1, false, false); \
    u32x4 w = {r0[0], r1[0], r0[1], r1[1]}; OUT = *reinterpret_cast<bf16x8*>(&w); } while (0)
    PK4(p0, 0, pa0); PK4(p0, 8, pa1); PK4(p1, 0, pa2); PK4(p1, 8, pa3);
#undef PK4
}
__device__ __forceinline__ void qkt(f32x16& p0, f32x16& p1, const char* Ks, const bf16x8* qr, int r32, int hi) {
    p0 = f32x16{}; p1 = f32x16{};
#pragma unroll
    for (int d0 = 0; d0 < 4; ++d0) {
        const int cb = (d0 * 16 + hi * 8) * 2;
        const bf16x8 b0 = *reinterpret_cast<const bf16x8*>(Ks + KSWZ64(r32, cb));
        const bf16x8 b1 = *reinterpret_cast<const bf16x8*>(Ks + KSWZ64(32 + r32, cb));
        p0 = mfma32(b0, qr[d0], p0);
        p1 = mfma32(b1, qr[d0], p1);
    }
}
__device__ __forceinline__ void maskfill(f32x16& p0, f32x16& p1, bool m) {
    if (m) {
        asm volatile("; masked tile");
#pragma unroll
        for (int r = 0; r < 16; ++r) { p0[r] = -1e30f; p1[r] = -1e30f; }
    }
}
__device__ __forceinline__ int v_st(int k, int c) { const int kk = (k & ~0xC) | ((k & 4) << 1) | ((k & 8) >> 1); return ((kk >> 3) * 4 + (c >> 5)) * 512 + ((kk & 7) * 32 + (c & 31)) * 2; }
__device__ __forceinline__ int v_rd_base(int lane) { return ((lane & 3) << 3) | (((lane >> 2) & 3) << 6) | (((lane >> 4) & 1) << 5) | (((lane >> 5) & 1) << 8); }
constexpr int v_rd_off(int d0, int ks, int half) { return d0 * 512 + ks * 4096 + half * 2048; }
template <int OFF> __device__ __forceinline__ s16x4 tr_read(int vb) {
    s16x4 r; asm volatile("ds_read_b64_tr_b16 %0, %1 offset:%2" : "=&v"(r) : "v"(vb), "i"(OFF) : "memory"); return r;
}
template <int D0> __device__ __forceinline__ void pv_one(f32x16& od, int vb, bf16x8 pa0, bf16x8 pa1, bf16x8 pa2, bf16x8 pa3) {
    const s16x4 l0 = tr_read<v_rd_off(D0, 0, 0)>(vb), h0 = tr_read<v_rd_off(D0, 0, 1)>(vb), l1 = tr_read<v_rd_off(D0, 1, 0)>(vb), h1 = tr_read<v_rd_off(D0, 1, 1)>(vb);
    const s16x4 l2 = tr_read<v_rd_off(D0, 2, 0)>(vb), h2 = tr_read<v_rd_off(D0, 2, 1)>(vb), l3 = tr_read<v_rd_off(D0, 3, 0)>(vb), h3 = tr_read<v_rd_off(D0, 3, 1)>(vb);
    asm volatile("s_waitcnt lgkmcnt(0)" ::: "memory"); SBAR();
#define PKV(L, H) (bf16x8){L[0], L[1], L[2], L[3], H[0], H[1], H[2], H[3]}
    od = mfma32(pa0, PKV(l0, h0), od);
    od = mfma32(pa1, PKV(l1, h1), od);
    od = mfma32(pa2, PKV(l2, h2), od);
    od = mfma32(pa3, PKV(l3, h3), od);
#undef PKV
}
__device__ __forceinline__ void pv_d0(f32x16* o, int vb, bf16x8 pa0, bf16x8 pa1, bf16x8 pa2, bf16x8 pa3) {
    pv_one<0>(o[0], vb, pa0, pa1, pa2, pa3); pv_one<1>(o[1], vb, pa0, pa1, pa2, pa3); pv_one<2>(o[2], vb, pa0, pa1, pa2, pa3); pv_one<3>(o[3], vb, pa0, pa1, pa2, pa3);
}

__device__ __forceinline__ void attn_pass(const bf16_t* __restrict__ Qb, const bf16_t* __restrict__ Kh, const bf16_t* __restrict__ Vh, int NT, int my_last, LAS unsigned char* ldsl, f32x16 (&o)[4]) {
    const int tid = threadIdx.x, wid = __builtin_amdgcn_readfirstlane(tid >> 6), lane = tid & 63, r32 = lane & 31, hi = lane >> 5;
    char* lds = (char*)ldsl;
    float* wsf = (float*)(lds + LDS_WS) + wid * 64; float* li_l = wsf; float* al_l = wsf + 32;
    float m_reg = -1e30f, l_reg = 0.f;
#pragma unroll
    for (int d = 0; d < 4; ++d) o[d] = f32x16{};
    bf16x8 qr[4];
    const bf16_t* Qw = Qb + (size_t)(wid * QBLK + r32) * NIN + hi * 8;
#pragma unroll
    for (int d0 = 0; d0 < 4; ++d0) qr[d0] = *reinterpret_cast<const bf16x8*>(Qw + d0 * 16);
    const int krow = 8 * wid + (lane >> 3);
    const unsigned kofs = (unsigned)(krow * NIN + (((lane & 7) ^ ((krow >> 1) & 7)) * 8)) * 2u;
    const int kk = 8 * wid + ((lane >> 2) & 7), vk = (kk & ~0xC) | ((kk & 4) << 1) | ((kk & 8) >> 1);
    const unsigned vofs = (unsigned)(vk * NIN + (lane >> 5) * 32 + (lane & 3) * 8) * 2u;
    const int vb0 = (int)(uintptr_t)lds + v_rd_base(lane);
#define DMA(t) do { const int s_ = (t) & 3; const size_t g_ = (size_t)(t) * (size_t)(KVBLK * NIN * 2); LAS unsigned char* d_ = ldsl + s_ * SLOT; \
    __builtin_amdgcn_global_load_lds((const GAS unsigned*)((const char*)Vh + g_ + vofs), (LAS unsigned*)(d_ + wid * 2048), 16, 0, 0); \
    __builtin_amdgcn_global_load_lds((const GAS unsigned*)((const char*)Vh + g_ + vofs + 128), (LAS unsigned*)(d_ + wid * 2048 + 1024), 16, 0, 0); \
    __builtin_amdgcn_global_load_lds((const GAS unsigned*)((const char*)Kh + g_ + kofs), (LAS unsigned*)(d_ + SHM_V + wid * 1024), 16, 0, 0); } while (0)
#define KS(t) (lds + ((t) & 3) * SLOT + SHM_V)
#define VB(t) (vb0 + ((t) & 3) * SLOT)
#define LANDED(more) do { if (more) asm volatile("s_waitcnt vmcnt(3)" ::: "memory"); else asm volatile("s_waitcnt vmcnt(0)" ::: "memory"); } while (0)
#define RESC(a) do { if (__any((a) < 1.f)) { if (hi == 0) al_l[r32] = (a); asm volatile("s_waitcnt lgkmcnt(0)" ::: "memory"); \
    _Pragma("unroll") for (int d = 0; d < 4; ++d) _Pragma("unroll") for (int r = 0; r < 16; ++r) o[d][r] *= al_l[crow(r, hi)]; } } while (0)
    f32x16 pA0, pA1, pB0, pB1; float mnA, mnB, alA, alB; bf16x8 pa0, pa1, pa2, pa3;
    __syncthreads();
    DMA(0); DMA(1); DMA(2);
    asm volatile("s_waitcnt vmcnt(6)" ::: "memory"); __syncthreads();
    qkt(pA0, pA1, KS(0), qr, r32, hi); partialSM(pA0, pA1, m_reg, mnA, alA);
    asm volatile("s_waitcnt vmcnt(3)" ::: "memory"); __syncthreads(); DMA(3);
    for (int j = 1; j + 1 < NT; j += 2) {
        qkt(pB0, pB1, KS(j), qr, r32, hi); maskfill(pB0, pB1, j > my_last);
        finishSM(pA0, pA1, alA, l_reg, pa0, pa1, pa2, pa3);
        pv_d0(o, VB(j - 1), pa0, pa1, pa2, pa3); partialSM(pB0, pB1, m_reg, mnB, alB);
        LANDED(j + 2 < NT); RESC(alB); __syncthreads(); if (j + 3 < NT) DMA(j + 3);
        qkt(pA0, pA1, KS(j + 1), qr, r32, hi); maskfill(pA0, pA1, j + 1 > my_last);
        finishSM(pB0, pB1, alB, l_reg, pa0, pa1, pa2, pa3);
        pv_d0(o, VB(j), pa0, pa1, pa2, pa3); partialSM(pA0, pA1, m_reg, mnA, alA);
        LANDED(j + 3 < NT); RESC(alA); __syncthreads(); if (j + 4 < NT) DMA(j + 4);
    }
    SBAR(); qkt(pB0, pB1, KS(NT - 1), qr, r32, hi); maskfill(pB0, pB1, NT - 1 > my_last);
    finishSM(pA0, pA1, alA, l_reg, pa0, pa1, pa2, pa3); SBAR();
    pv_d0(o, VB(NT - 2), pa0, pa1, pa2, pa3); partialSM(pB0, pB1, m_reg, mnB, alB);
    RESC(alB);
    finishSM(pB0, pB1, alB, l_reg, pa0, pa1, pa2, pa3); SBAR();
    pv_d0(o, VB(NT - 1), pa0, pa1, pa2, pa3);
    if (hi == 0) li_l[r32] = l_reg;
    asm volatile("s_waitcnt lgkmcnt(0)" ::: "memory");
#pragma unroll
    for (int r = 0; r < 16; ++r) {
        const float rl = __builtin_amdgcn_rcpf(li_l[crow(r, hi)]);
#pragma unroll
        for (int d = 0; d < 4; ++d) o[d][r] *= rl;
    }
    asm volatile("s_waitcnt vmcnt(0)" ::: "memory");
    __syncthreads();
#undef DMA
#undef KS
#undef VB
#undef LANDED
#undef RESC
}
}

__device__ __forceinline__ void p3_attn_unit(const Params& p, Ctx& F, int b, int h, int qb, float* oscr) {
    const bf16_t* proj = (const bf16_t*)(p.ws + WS_PROJ);
    bf16_t* ycat = (bf16_t*)(p.ws + WS_YCAT);
    const float lam = ((const float*)(p.ws + WS_MISC))[0];
    const float* subw = p.in[15];
    const int tid = F.tid, wid = F.wave, lane = F.lane, r32 = lane & 31, hi = lane >> 5;
    const size_t rowbase = (size_t)b * SEQ; const int q0 = qb * 256;
    const int NT = (q0 + 256) / 64, my_last = (q0 + 32 * wid) / 64;
    f32x16 o[4];
    for (int j = 0; j < 2; ++j) {
        const bf16_t* Qb = proj + (rowbase + q0) * NIN + PQ + h * 128 + j * 64;
        const bf16_t* Kh = proj + rowbase * NIN + PK + h * 128 + j * 64;
        const bf16_t* Vh = proj + rowbase * NIN + PV + h * 128;
        att::attn_pass(Qb, Kh, Vh, NT, my_last, F.lds, o);
        if (j == 0) {
            float* my = oscr + tid * 64;
#pragma unroll
            for (int d = 0; d < 4; ++d)
#pragma unroll
                for (int r4 = 0; r4 < 4; ++r4) *(f32x4*)(my + d * 16 + r4 * 4) = (f32x4){o[d][4 * r4], o[d][4 * r4 + 1], o[d][4 * r4 + 2], o[d][4 * r4 + 3]};
        }
    }
    float wv[4];
#pragma unroll
    for (int d = 0; d < 4; ++d) wv[d] = subw[d * 32 + r32] * (1.f - LAMBDA_INIT);
#pragma unroll
    for (int r = 0; r < 16; ++r) {
        float v[4]; float ss = 0.f;
#pragma unroll
        for (int d = 0; d < 4; ++d) { v[d] = oscr[tid * 64 + d * 16 + r] - lam * o[d][r]; ss += v[d] * v[d]; }
        ss += __shfl_xor(ss, 1); ss += __shfl_xor(ss, 2); ss += __shfl_xor(ss, 4); ss += __shfl_xor(ss, 8); ss += __shfl_xor(ss, 16);
        const float rs = rsqrtf(ss * (1.f / 128.f) + EPSN);
        const size_t row = rowbase + q0 + wid * 32 + att::crow(r, hi);
#pragma unroll
        for (int d = 0; d < 4; ++d) ycat[row * DM + 512 + h * 128 + d * 32 + r32] = (bf16_t)f2bf(v[d] * rs * wv[d]);
    }
}

__device__ __forceinline__ void phase3(const Params& p, Ctx& F) {
#if defined(PROBE_PHASE) && (PROBE_PHASE == 30 || PROBE_PHASE == 31)
    F.ta = __builtin_amdgcn_s_memrealtime();
#endif
    p3_scan(p, F);
#if defined(PROBE_PHASE) && (PROBE_PHASE == 30 || PROBE_PHASE == 31)
    VM_WAIT(); F.tb = __builtin_amdgcn_s_memrealtime();
#endif
    float* oscr = p.out + (size_t)F.vcu * (64 * 512);
    for (int ui = F.vcu; ui < 512; ui += F.G) {
        const int pi = ui & 255, bh = pi >> 3, s = pi & 7, b = bh >> 2, h = bh & 3;
        p3_attn_unit(p, F, b, h, ui < 256 ? 15 - s : s, oscr);
    }
#if defined(PROBE_PHASE) && (PROBE_PHASE == 30 || PROBE_PHASE == 31)
    VM_WAIT(); F.tc = __builtin_amdgcn_s_memrealtime();
#endif
}

constexpr int P4_PREV = 0, P4_CM = 69632, P4_ACS = 87040, P4_Y = 88064, Y_LD = 257;
static_assert(P4_Y + 64 * Y_LD * 4 <= LDS_BYTES, "P4 LDS");
__device__ __forceinline__ void p4_load(const bf16_t* states, const bf16_t* cmc, int tid, int b, int c, int g, u32x4 (&pv)[8], u32x4 (&cv)[2]) {
    const size_t tbase = (size_t)b * SEQ + (size_t)c * CHUNK;
#pragma unroll
    for (int i = 0; i < 8; ++i) {
        const int e = tid + 512 * i, n8 = e & 15, pp = (e >> 4) & 63, h = e >> 10;
        pv[i] = *(const u32x4*)(states + ((((size_t)b * NCH + c) * 8 + g * 4 + h) * 64 + pp) * 128 + n8 * 8);
    }
#pragma unroll
    for (int i = 0; i < 2; ++i) {
        const int e = tid + 512 * i, l = e >> 4, c8 = e & 15;
        cv[i] = *(const u32x4*)(cmc + (tbase + l) * 256 + g * 128 + c8 * 8);
    }
}
__device__ __forceinline__ void p4_unit(const Params& p, Ctx& F, int b, int c, int g, u32x4 (&pv)[8], u32x4 (&cv)[2], bool has_next, int nb, int nc, int ng) {
    unsigned char* ws = p.ws;
    const bf16_t* proj = (const bf16_t*)(ws + WS_PROJ);
    bf16_t* ycat = (bf16_t*)(ws + WS_YCAT); const bf16_t* cmc = (const bf16_t*)(ws + WS_CMC);
    const bf16_t* states = (const bf16_t*)(ws + WS_STATES); const float* acs_g = (const float*)(ws + WS_ACS);
    const float* normw = p.in[8];
    LAS bf16_t* PREV = (LAS bf16_t*)(F.lds + P4_PREV); LAS bf16_t* CM = (LAS bf16_t*)(F.lds + P4_CM);
    LAS float* ACS = (LAS float*)(F.lds + P4_ACS); LAS float* Y = (LAS float*)(F.lds + P4_Y);
    const int tid = F.tid, lane = F.lane, wave = F.wave, fr = lane & 15, fq = lane >> 4;
    const size_t tbase = (size_t)b * SEQ + (size_t)c * CHUNK;
#pragma unroll
    for (int i = 0; i < 8; ++i) {
        const int e = tid + 512 * i, n8 = e & 15, pp = (e >> 4) & 63, h = e >> 10;
        *(LAS u32x4*)(PREV + (h * 64 + pp) * BM_LD + n8 * 8) = pv[i];
    }
#pragma unroll
    for (int i = 0; i < 2; ++i) {
        const int e = tid + 512 * i, l = e >> 4, c8 = e & 15;
        *(LAS u32x4*)(CM + l * BM_LD + c8 * 8) = cv[i];
    }
    if (has_next) p4_load(states, cmc, tid, nb, nc, ng, pv, cv);
    if (tid < 256) { const int l = tid >> 2, h = tid & 3; ACS[l * 4 + h] = acs_g[(tbase + l) * 8 + g * 4 + h]; }
    __syncthreads();
    {
        const int h = wave >> 1;
#pragma unroll
        for (int mq = 0; mq < 2; ++mq) {
            const int mt = 2 * (wave & 1) + mq;
            bf16x8 a[4];
#pragma unroll
            for (int ks = 0; ks < 4; ++ks) a[ks] = *(const LAS bf16x8*)(CM + (mt * 16 + fr) * BM_LD + ks * 32 + fq * 8);
#pragma unroll
            for (int nt = 0; nt < 4; ++nt) {
                f32x4 acc = {0.f, 0.f, 0.f, 0.f};
#pragma unroll
                for (int ks = 0; ks < 4; ++ks) {
                    const bf16x8 bq = *(const LAS bf16x8*)(PREV + (h * 64 + nt * 16 + fr) * BM_LD + ks * 32 + fq * 8);
                    acc = mfma16(a[ks], bq, acc);
                }
#pragma unroll
                for (int j = 0; j < 4; ++j) {
                    const int l = mt * 16 + 4 * fq + j, col = h * 64 + nt * 16 + fr;
                    Y[l * Y_LD + col] = acc[j] * __expf(ACS[l * 4 + h]);
                }
            }
        }
    }
    __syncthreads();
    {
        const int c8 = lane & 31, hr = lane >> 5;
        const f32x4 nw0 = *(const f32x4*)(normw + g * 256 + c8 * 8), nw1 = *(const f32x4*)(normw + g * 256 + c8 * 8 + 4);
#pragma unroll 2
        for (int r = 0; r < 4; ++r) {
            const int l = wave * 8 + r * 2 + hr;
            const size_t t = tbase + l;
            const u32x4 yl = *(const u32x4*)(ycat + t * DM + g * 256 + c8 * 8);
            const u32x4 zz = *(const u32x4*)(proj + t * NIN + PZ + g * 256 + c8 * 8);
            float v[8]; float ss = 0.f;
#pragma unroll
            for (int e = 0; e < 4; ++e) {
                const float y0 = bf2f(yl[e] & 0xffffu) + Y[l * Y_LD + c8 * 8 + 2 * e], y1 = bf2f(yl[e] >> 16) + Y[l * Y_LD + c8 * 8 + 2 * e + 1];
                v[2 * e] = y0 * silu_f(bf2f(zz[e] & 0xffffu)); v[2 * e + 1] = y1 * silu_f(bf2f(zz[e] >> 16));
                ss += v[2 * e] * v[2 * e] + v[2 * e + 1] * v[2 * e + 1];
            }
            ss += __shfl_xor(ss, 1); ss += __shfl_xor(ss, 2); ss += __shfl_xor(ss, 4); ss += __shfl_xor(ss, 8); ss += __shfl_xor(ss, 16);
            const float rs = rsqrtf(ss * (1.f / 256.f) + EPSN);
            u32x4 o;
            o.x = pk2(v[0] * rs * nw0[0], v[1] * rs * nw0[1]); o.y = pk2(v[2] * rs * nw0[2], v[3] * rs * nw0[3]);
            o.z = pk2(v[4] * rs * nw1[0], v[5] * rs * nw1[1]); o.w = pk2(v[6] * rs * nw1[2], v[7] * rs * nw1[3]);
            *(u32x4*)(ycat + t * DM + g * 256 + c8 * 8) = o;
        }
    }
    __syncthreads();
}
__device__ __forceinline__ void phase4(const Params& p, Ctx& F) {
    const bf16_t* states = (const bf16_t*)(p.ws + WS_STATES); const bf16_t* cmc = (const bf16_t*)(p.ws + WS_CMC);
    u32x4 pv[8], cv[2];
    if (F.vcu < NB * NCH * 2) p4_load(states, cmc, F.tid, F.vcu >> 7, (F.vcu >> 1) & 63, F.vcu & 1, pv, cv);
    for (int u = F.vcu; u < NB * NCH * 2; u += F.G) {
        const int g = u & 1, c = (u >> 1) & 63, b = u >> 7;
        const int un = u + F.G;
        p4_unit(p, F, b, c, g, pv, cv, un < NB * NCH * 2, un >> 7, (un >> 1) & 63, un & 1);
    }
}

__device__ __forceinline__ unsigned f2ord(float f) { const unsigned u = __float_as_uint(f); return (u >> 31) ? ~u : (u | 0x80000000u); }
__device__ __forceinline__ float ord2f(unsigned u) { return __uint_as_float((u >> 31) ? (u & 0x7fffffffu) : ~u); }
#define CE_DESC(A, B) do { const unsigned hi_ = (A) > (B) ? (A) : (B); const unsigned lo_ = (A) > (B) ? (B) : (A); (A) = hi_; (B) = lo_; } while (0)
template <int K, int J> __device__ __forceinline__ void bstage(unsigned (&r)[16]) {
#pragma unroll
    for (int i = 0; i < 16; ++i) { const int l = i ^ J; if (l > i) { if ((i & K) == 0) CE_DESC(r[i], r[l]); else CE_DESC(r[l], r[i]); } }
}
__device__ __forceinline__ void bitonic_merge16(unsigned (&r)[16]) { bstage<16, 8>(r); bstage<16, 4>(r); bstage<16, 2>(r); bstage<16, 1>(r); }
__device__ __forceinline__ void bitonic_sort16(unsigned (&r)[16]) {
    bstage<2, 1>(r); bstage<4, 2>(r); bstage<4, 1>(r); bstage<8, 4>(r); bstage<8, 2>(r); bstage<8, 1>(r); bitonic_merge16(r);
}
__device__ __forceinline__ void top16_merge(unsigned (&r)[16], const unsigned (&n)[16]) {
#pragma unroll
    for (int i = 0; i < 16; ++i) r[i] = r[i] > n[15 - i] ? r[i] : n[15 - i];
    bitonic_merge16(r);
}
template <int XM> __device__ __forceinline__ unsigned quad_xor(unsigned v) {
    static_assert(XM == 1 || XM == 2, "quad permute");
    return (unsigned)__builtin_amdgcn_mov_dpp((int)v, XM == 1 ? 0xB1 : 0x4E, 0xf, 0xf, true);
}
template <int XM> __device__ __forceinline__ void top16_merge_lane_t(unsigned (&r)[16]) {
    unsigned n[16];
#pragma unroll
    for (int i = 0; i < 16; ++i) n[i] = quad_xor<XM>(r[i]);
    top16_merge(r, n);
}
__device__ __forceinline__ void top16_merge_lane(unsigned (&r)[16], int xm) {
    if (xm == 1) top16_merge_lane_t<1>(r); else top16_merge_lane_t<2>(r);
}
__device__ __forceinline__ void p7_cand_table(LAS unsigned char* CAND, int tid) {
    if (tid < 52) {
        int c = 0; unsigned char v = 255;
        for (int a = 0; a < 16; ++a) for (int b = 0; b < 16 / (a + 1); ++b) { if (c == tid) v = (unsigned char)(a * 16 + b); ++c; }
        CAND[tid] = v;
    }
}
__device__ __forceinline__ void route16(const bf16_t* qp, const float* rowsq, float* gwo, size_t t0, int lane, LAS unsigned* lists, const LAS unsigned char* CAND, LAS unsigned short* IDX) {
    const int tok = lane >> 2, part = lane & 3;
    const float r2 = rsqrtf(rowsq[t0 + tok] * (1.f / DM) + EPSN);
    u32x4 nxt[2][4];
#pragma unroll
    for (int j = 0; j < 2; ++j)
#pragma unroll
        for (int q = 0; q < 4; ++q) nxt[j][q] = __builtin_nontemporal_load((const u32x4*)(qp + (t0 + tok) * 2048 + j * 128 + part * 32 + q * 8));
#pragma unroll 1
    for (int h = 0; h < 8; ++h) {
        u32x4 raw[2][4];
#pragma unroll
        for (int j = 0; j < 2; ++j)
#pragma unroll
            for (int q = 0; q < 4; ++q) raw[j][q] = nxt[j][q];
        if (h < 7) {
#pragma unroll
            for (int j = 0; j < 2; ++j)
#pragma unroll
                for (int q = 0; q < 4; ++q) nxt[j][q] = __builtin_nontemporal_load((const u32x4*)(qp + (t0 + tok) * 2048 + (h + 1) * 256 + j * 128 + part * 32 + q * 8));
        }
#pragma unroll
        for (int j = 0; j < 2; ++j) {
            unsigned r[16], n[16];
#pragma unroll
            for (int q = 0; q < 2; ++q)
#pragma unroll
                for (int e = 0; e < 4; ++e) {
                    r[q * 8 + 2 * e]     = (f2ord(bf2f(raw[j][q][e] & 0xffffu) * r2) & ~127u) | (unsigned)(part * 32 + q * 8 + 2 * e);
                    r[q * 8 + 2 * e + 1] = (f2ord(bf2f(raw[j][q][e] >> 16) * r2) & ~127u) | (unsigned)(part * 32 + q * 8 + 2 * e + 1);
                    n[q * 8 + 2 * e]     = (f2ord(bf2f(raw[j][2 + q][e] & 0xffffu) * r2) & ~127u) | (unsigned)(part * 32 + 16 + q * 8 + 2 * e);
                    n[q * 8 + 2 * e + 1] = (f2ord(bf2f(raw[j][2 + q][e] >> 16) * r2) & ~127u) | (unsigned)(part * 32 + 16 + q * 8 + 2 * e + 1);
                }
            bitonic_sort16(r); bitonic_sort16(n);
            top16_merge(r, n);
            top16_merge_lane(r, 1);
            top16_merge_lane(r, 2);
            if (part == 0) {
#pragma unroll
                for (int k = 0; k < 16; ++k) lists[(tok * 2 + j) * 16 + k] = r[k];
            }
        }
        LDS_WAIT(); __builtin_amdgcn_wave_barrier();
        {
            const LAS unsigned* l0 = lists + (2 * tok) * 16; const LAS unsigned* l1 = lists + (2 * tok + 1) * 16;
            unsigned r[16];
#pragma unroll
            for (int m = 0; m < 13; ++m) {
                const unsigned ab = CAND[part + 4 * m];
                const unsigned a = (ab >> 4) & 15u, bb = ab & 15u;
                const float sum = ord2f(l0[a] & ~127u) + ord2f(l1[bb] & ~127u);
                r[m] = ab == 255u ? 0u : ((f2ord(sum) & ~255u) | ab);
            }
            r[13] = 0u; r[14] = 0u; r[15] = 0u;
            bitonic_sort16(r);
            top16_merge_lane(r, 1);
            top16_merge_lane(r, 2);
            float val[16]; unsigned ex[16]; float mx = -1e30f;
#pragma unroll
            for (int k = 0; k < 16; ++k) {
                const unsigned pos = r[k] & 255u, a = pos >> 4, bb = pos & 15u;
                const unsigned w0 = l0[a], w1 = l1[bb];
                ex[k] = (w0 & 127u) * 128u + (w1 & 127u);
                val[k] = ord2f(w0 & ~127u) + ord2f(w1 & ~127u);
                mx = fmaxf(mx, val[k]);
            }
            float sum = 0.f;
#pragma unroll
            for (int k = 0; k < 16; ++k) { val[k] = __expf(val[k] - mx); sum += val[k]; }
            const float inv = __builtin_amdgcn_rcpf(sum);
            float* go = gwo + ((t0 + tok) * 8 + h) * 16;
            if (part == 0) {
#pragma unroll
                for (int k = 0; k < 16; ++k) { IDX[tok * 128 + h * 16 + k] = (unsigned short)ex[k]; go[k] = val[k] * inv; }
            }
        }
        LDS_WAIT(); __builtin_amdgcn_wave_barrier();
    }
}

__device__ __forceinline__ void xcd_pace(const XcdBarrier& b, int slot) {
    __syncthreads();
    if (threadIdx.x == 0) {
        const unsigned nloc = b.st[0];
        unsigned* w = b.bar + XCD_BAR_WORDS + (slot * 16 + (int)b.x) * 16;
        (void)xb_add(w, 1u);
        unsigned sp = 0;
        while (xb_ld(w) < nloc && ++sp < 3000u) __builtin_amdgcn_s_sleep(1);
    }
    __syncthreads();
}
__device__ __forceinline__ float gelu_erf(float x) { return 0.5f * x * (1.f + erff(x * 0.70710678118654752f)); }
typedef float f32x2 __attribute__((ext_vector_type(2)));
constexpr int P8_NSL = 8, P8_SLC = DM / P8_NSL, P8_KS = P8_SLC / 32;
constexpr float P8_XS = 32.f;
static_assert(P8_SLC == 128, "lane mappings assume 128-column (128-byte) slices");
__device__ __forceinline__ void phase8(const Params& p, Ctx& F, const XcdBarrier& bar) {
    const bool pace = false;
    unsigned char* ws = p.ws;
    const unsigned char* uq = ws + WS_UB; const unsigned char* vq = ws + WS_VB;
    const float* rsu = (const float*)(ws + WS_RSU); const float* rsv = (const float*)(ws + WS_RSV);
    const bf16_t* x1b = (const bf16_t*)(ws + WS_X1B);
    const float* rowsq = (const float*)(ws + WS_CTL) + CW_ROWSQ;
    const float* gwi = (const float*)(ws + WS_GW);
    float* out = p.out;
    const int lane = F.lane, fr = lane & 15, fq = lane >> 4;
    LAS unsigned short* IDX = (LAS unsigned short*)(F.lds + F.wave * 20480);
    LAS float* COEF = (LAS float*)(F.lds + F.wave * 20480 + 4096);
    LAS unsigned char* STG = (LAS unsigned char*)COEF;
    LAS unsigned char* CAND = STG + 2048;
    __syncthreads();
    p7_cand_table(CAND, lane);
    LDS_WAIT(); __builtin_amdgcn_wave_barrier();
    for (int task = F.gw; task < TOK / 16; task += F.ngw) {
        const size_t t0 = (size_t)task * 16;
#if defined(PROBE_PHASE) && PROBE_PHASE == 82
        F.ta = __builtin_amdgcn_s_memrealtime();
#endif
        route16((const bf16_t*)(ws + WS_QP), rowsq, (float*)(ws + WS_GW), t0, lane, (LAS unsigned*)STG, CAND, IDX);
#if defined(PROBE_PHASE) && PROBE_PHASE == 82
        F.tb = __builtin_amdgcn_s_memrealtime();
#endif
        const float r2 = rsqrtf(rowsq[t0 + fr] * (1.f / DM) + EPSN);
        VM_WAIT(); LDS_WAIT(); __builtin_amdgcn_wave_barrier();
#if defined(PROBE_PHASE) && (PROBE_PHASE == 80 || PROBE_PHASE == 81)
        F.ta = __builtin_amdgcn_s_memrealtime();
#endif
        f32x4 accU[8];
#pragma unroll
        for (int h = 0; h < 8; ++h) accU[h] = (f32x4){0.f, 0.f, 0.f, 0.f};
        const int lrow = lane >> 3, lch = lane & 7;
        const int wofs0 = lrow * 128 + ((lch ^ (lrow & 7)) << 4), wofs1 = wofs0 + 1024;
        const float xsc = r2 * P8_XS;
#ifdef U_FP4
        typedef int v8i __attribute__((ext_vector_type(8)));
        int rofs4[2];
#pragma unroll
        for (int m = 0; m < 2; ++m) rofs4[m] = fr * 128 + (((4 * m + fq) ^ (fr & 7)) << 4);
#pragma unroll 1
        for (int sl = 0; sl < 4; ++sl) {
            v8i xf[2];
#pragma unroll
            for (int m = 0; m < 2; ++m) {
                const bf16_t* xp = x1b + (t0 + fr) * DM + sl * 256 + 128 * m + 16 * fq;
#pragma unroll
                for (int q = 0; q < 4; ++q) {
                    const u32x4 xv = *(const u32x4*)(xp + 64 * (q >> 1) + 8 * (q & 1));
                    int lo = 0, hi = 0;
                    lo = __builtin_amdgcn_cvt_pk_fp8_f32(bf2f(xv[0] & 0xffffu) * xsc, bf2f(xv[0] >> 16) * xsc, lo, false);
                    lo = __builtin_amdgcn_cvt_pk_fp8_f32(bf2f(xv[1] & 0xffffu) * xsc, bf2f(xv[1] >> 16) * xsc, lo, true);
                    hi = __builtin_amdgcn_cvt_pk_fp8_f32(bf2f(xv[2] & 0xffffu) * xsc, bf2f(xv[2] >> 16) * xsc, hi, false);
                    hi = __builtin_amdgcn_cvt_pk_fp8_f32(bf2f(xv[3] & 0xffffu) * xsc, bf2f(xv[3] >> 16) * xsc, hi, true);
                    xf[m][2 * q] = lo; xf[m][2 * q + 1] = hi;
                }
            }
            const unsigned char* ubs = uq + sl * 128 + lch * 16;
#pragma unroll 1
            for (int j0 = 0; j0 < 16; ++j0) {
                const bool mine = (fr == j0);
                v8i bm[2];
#pragma unroll
                for (int m = 0; m < 2; ++m)
#pragma unroll
                    for (int q = 0; q < 8; ++q) bm[m][q] = mine ? xf[m][q] : 0;
                u32x4 g0[8], g1[8];
#pragma unroll
                for (int h = 0; h < 8; ++h) {
                    const unsigned e0 = IDX[j0 * 128 + h * 16 + lrow], e1 = IDX[j0 * 128 + h * 16 + lrow + 8];
                    g0[h] = *(const u32x4*)(ubs + (size_t)e0 * (DM / 2));
                    g1[h] = *(const u32x4*)(ubs + (size_t)e1 * (DM / 2));
                }
#pragma unroll
                for (int hg = 0; hg < 2; ++hg) {
#pragma unroll
                    for (int h = 0; h < 4; ++h) {
                        *(LAS u32x4*)(STG + h * 2048 + wofs0) = g0[hg * 4 + h];
                        *(LAS u32x4*)(STG + h * 2048 + wofs1) = g1[hg * 4 + h];
                    }
                    __builtin_amdgcn_wave_barrier();
#pragma unroll
                    for (int h = 0; h < 4; ++h)
#pragma unroll
                        for (int m = 0; m < 2; ++m) {
                            const u32x4 a16 = *(const LAS u32x4*)(STG + h * 2048 + rofs4[m]);
                            const v8i av = {(int)a16.x, (int)a16.y, (int)a16.z, (int)a16.w, 0, 0, 0, 0};
                            accU[hg * 4 + h] = __builtin_amdgcn_mfma_scale_f32_16x16x128_f8f6f4(av, bm[m], accU[hg * 4 + h], 4, 0, 0, 0, 0, 0);
                        }
                    __builtin_amdgcn_wave_barrier();
                }
            }
        }
#else
        int rofs[P8_KS];
#pragma unroll
        for (int ks = 0; ks < P8_KS; ++ks) rofs[ks] = fr * 128 + (((2 * ks + (fq >> 1)) ^ (fr & 7)) << 4) + (fq & 1) * 8;
#pragma unroll 1
        for (int sl = 0; sl < P8_NSL; ++sl) {
            if (pace) xcd_pace(bar, sl);
            long xf[P8_KS];
#pragma unroll
            for (int ks = 0; ks < P8_KS; ++ks) {
                const u32x4 xv = *(const u32x4*)(x1b + (t0 + fr) * DM + sl * P8_SLC + ks * 32 + 8 * fq);
                int lo = 0, hi = 0;
                lo = __builtin_amdgcn_cvt_pk_fp8_f32(bf2f(xv[0] & 0xffffu) * xsc, bf2f(xv[0] >> 16) * xsc, lo, false);
                lo = __builtin_amdgcn_cvt_pk_fp8_f32(bf2f(xv[1] & 0xffffu) * xsc, bf2f(xv[1] >> 16) * xsc, lo, true);
                hi = __builtin_amdgcn_cvt_pk_fp8_f32(bf2f(xv[2] & 0xffffu) * xsc, bf2f(xv[2] >> 16) * xsc, hi, false);
                hi = __builtin_amdgcn_cvt_pk_fp8_f32(bf2f(xv[3] & 0xffffu) * xsc, bf2f(xv[3] >> 16) * xsc, hi, true);
                xf[ks] = (long)(((unsigned long long)(unsigned)hi << 32) | (unsigned long long)(unsigned)lo);
            }
            const unsigned char* ubs = uq + sl * P8_SLC + lch * 16;
#pragma unroll 1
            for (int j0 = 0; j0 < 16; ++j0) {
                const bool mine = (fr == j0);
                long bm[P8_KS];
#pragma unroll
                for (int ks = 0; ks < P8_KS; ++ks) bm[ks] = mine ? xf[ks] : 0l;
                u32x4 g0[8], g1[8];
#pragma unroll
                for (int h = 0; h < 8; ++h) {
                    const unsigned e0 = IDX[j0 * 128 + h * 16 + lrow], e1 = IDX[j0 * 128 + h * 16 + lrow + 8];
                    g0[h] = *(const u32x4*)(ubs + (size_t)e0 * DM);
                    g1[h] = *(const u32x4*)(ubs + (size_t)e1 * DM);
                }
#pragma unroll
                for (int hg = 0; hg < 2; ++hg) {
#pragma unroll
                    for (int h = 0; h < 4; ++h) {
                        *(LAS u32x4*)(STG + h * 2048 + wofs0) = g0[hg * 4 + h];
                        *(LAS u32x4*)(STG + h * 2048 + wofs1) = g1[hg * 4 + h];
                    }
                    __builtin_amdgcn_wave_barrier();
#pragma unroll
                    for (int h = 0; h < 4; ++h)
#pragma unroll
                        for (int ks = 0; ks < P8_KS; ++ks) {
                            const long a = *(const LAS long*)(STG + h * 2048 + rofs[ks]);
                            accU[hg * 4 + h] = __builtin_amdgcn_mfma_f32_16x16x32_fp8_fp8(a, bm[ks], accU[hg * 4 + h], 0, 0, 0);
                        }
                    __builtin_amdgcn_wave_barrier();
                }
            }
        }
#endif
        LDS_WAIT(); __builtin_amdgcn_wave_barrier();
#pragma unroll
        for (int h = 0; h < 8; ++h) {
            const f32x4 gv = *(const f32x4*)(gwi + (t0 + fr) * 128 + h * 16 + 4 * fq);
#pragma unroll
            for (int jj = 0; jj < 4; ++jj) {
                const int slot = h * 16 + 4 * fq + jj;
                const unsigned e = IDX[fr * 128 + slot];
                const float hv = accU[h][jj] * rsu[e] * (1.f / P8_XS);
                COEF[fr * 128 + slot] = gv[jj] * gelu_erf(hv) * rsv[e];
            }
        }
        LDS_WAIT(); __builtin_amdgcn_wave_barrier();
#if defined(PROBE_PHASE) && (PROBE_PHASE == 80 || PROBE_PHASE == 81)
        F.tb = __builtin_amdgcn_s_memrealtime();
#endif
#ifdef V_VALU
        const int sub = lane & 7, rg = lane >> 3;
#pragma unroll 1
        for (int sl = 0; sl < P8_NSL; ++sl) {
            const unsigned char* vbs = vq + sl * P8_SLC + sub * 16;
#pragma unroll 1
            for (int j0 = 0; j0 < 16; ++j0) {
                f32x2 acc[8];
#pragma unroll
                for (int q = 0; q < 8; ++q) acc[q] = (f32x2){0.f, 0.f};
#pragma unroll
                for (int ib = 0; ib < 2; ++ib) {
                    u32x4 w[8]; float cf[8];
#pragma unroll
                    for (int it = 0; it < 8; ++it) {
                        const int slot = (ib * 8 + it) * 8 + rg;
                        const unsigned e = IDX[j0 * 128 + slot];
                        cf[it] = COEF[j0 * 128 + slot];
                        w[it] = *(const u32x4*)(vbs + (size_t)e * DM);
                    }
#pragma unroll
                    for (int it = 0; it < 8; ++it)
#pragma unroll
                        for (int q = 0; q < 4; ++q) {
                            acc[2 * q] += __builtin_amdgcn_cvt_pk_f32_fp8((int)w[it][q], false) * cf[it];
                            acc[2 * q + 1] += __builtin_amdgcn_cvt_pk_f32_fp8((int)w[it][q], true) * cf[it];
                        }
                }
#pragma unroll
                for (int q = 0; q < 8; ++q) {
                    acc[q].x += __shfl_xor(acc[q].x, 8); acc[q].y += __shfl_xor(acc[q].y, 8);
                    acc[q].x += __shfl_xor(acc[q].x, 16); acc[q].y += __shfl_xor(acc[q].y, 16);
                    acc[q].x += __shfl_xor(acc[q].x, 32); acc[q].y += __shfl_xor(acc[q].y, 32);
                }
                if (rg == 0) {
                    float* orow = out + (t0 + j0) * DM + sl * P8_SLC + sub * 16;
                    const bf16_t* xrow = x1b + (t0 + j0) * DM + sl * P8_SLC + sub * 16;
#pragma unroll
                    for (int q = 0; q < 4; ++q) {
                        const u32x2 xv = *(const u32x2*)(xrow + 4 * q);
                        f32x4 o = {bf2f(xv.x & 0xffffu), bf2f(xv.x >> 16), bf2f(xv.y & 0xffffu), bf2f(xv.y >> 16)};
                        o[0] += acc[2 * q].x; o[1] += acc[2 * q].y; o[2] += acc[2 * q + 1].x; o[3] += acc[2 * q + 1].y;
                        *(f32x4*)(orow + 4 * q) = o;
                    }
                }
            }
        }
#elif defined(V_FP4)
        typedef int v2i __attribute__((ext_vector_type(2)));
        typedef int v8i __attribute__((ext_vector_type(8)));
        v8i cq8; float inv_cs;
        {
            f32x4 cv[2][4]; float cmax = 0.f;
#pragma unroll
            for (int hf = 0; hf < 2; ++hf)
#pragma unroll
                for (int q = 0; q < 4; ++q) {
                    cv[hf][q] = *(const LAS f32x4*)(COEF + fr * 128 + hf * 64 + 16 * fq + 4 * q);
                    cmax = fmaxf(cmax, fmaxf(fmaxf(fabsf(cv[hf][q][0]), fabsf(cv[hf][q][1])), fmaxf(fabsf(cv[hf][q][2]), fabsf(cv[hf][q][3]))));
                }
            cmax = fmaxf(cmax, __shfl_xor(cmax, 16)); cmax = fmaxf(cmax, __shfl_xor(cmax, 32));
            const float cs = cmax > 0.f ? 240.f / cmax : 1.f; inv_cs = cmax > 0.f ? cmax * (1.f / 240.f) : 1.f;
#pragma unroll
            for (int hf = 0; hf < 2; ++hf)
#pragma unroll
                for (int q = 0; q < 4; ++q) {
                    int pk = 0;
                    pk = __builtin_amdgcn_cvt_pk_fp8_f32(cv[hf][q][0] * cs, cv[hf][q][1] * cs, pk, false);
                    pk = __builtin_amdgcn_cvt_pk_fp8_f32(cv[hf][q][2] * cs, cv[hf][q][3] * cs, pk, true);
                    cq8[hf * 4 + q] = pk;
                }
        }
        LDS_WAIT(); __builtin_amdgcn_wave_barrier();
        int vwofs[16];
#pragma unroll
        for (int i = 0; i < 16; ++i) { const int rr = lrow + 8 * i; vwofs[i] = rr * 128 + ((lch ^ ((rr >> 1) & 7)) << 4); }
        int vrow_[2], vsw_[2];
#pragma unroll
        for (int t = 0; t < 2; ++t) { vrow_[t] = 32 * fq + 16 * t + fr; vsw_[t] = (vrow_[t] >> 1) & 7; }
#pragma unroll 1
        for (int sl = 0; sl < 4; ++sl) {
            f32x4 accV[16];
#pragma unroll
            for (int ct = 0; ct < 16; ++ct) accV[ct] = (f32x4){0.f, 0.f, 0.f, 0.f};
            const unsigned char* vbs = vq + sl * 128 + lch * 16;
#pragma unroll 1
            for (int j0 = 0; j0 < 16; ++j0) {
                const bool mine = (fr == j0);
                u32x4 g[16];
#pragma unroll
                for (int i = 0; i < 16; ++i) {
                    const unsigned e = IDX[j0 * 128 + lrow + 8 * i];
                    g[i] = *(const u32x4*)(vbs + (size_t)e * (DM / 2));
                }
#pragma unroll
                for (int i = 0; i < 16; ++i) *(LAS u32x4*)(STG + vwofs[i]) = g[i];
                __builtin_amdgcn_wave_barrier();
                v8i bmq;
#pragma unroll
                for (int q = 0; q < 8; ++q) bmq[q] = mine ? cq8[q] : 0;
#pragma unroll
                for (int ct = 0; ct < 16; ++ct) {
                    const v2i r0 = __builtin_amdgcn_ds_read_tr4_b64_v2i32((LAS v2i*)(STG + vrow_[0] * 128 + (((ct >> 1) ^ vsw_[0]) << 4) + (ct & 1) * 8));
                    const v2i r1 = __builtin_amdgcn_ds_read_tr4_b64_v2i32((LAS v2i*)(STG + vrow_[1] * 128 + (((ct >> 1) ^ vsw_[1]) << 4) + (ct & 1) * 8));
                    const v8i av = {r0.x, r0.y, r1.x, r1.y, 0, 0, 0, 0};
                    accV[ct] = __builtin_amdgcn_mfma_scale_f32_16x16x128_f8f6f4(av, bmq, accV[ct], 4, 0, 0, 0, 0, 0);
                }
                __builtin_amdgcn_wave_barrier();
            }
            float* orow = out + (t0 + fr) * DM + sl * 256 + 4 * fq;
            const bf16_t* xrow = x1b + (t0 + fr) * DM + sl * 256 + 4 * fq;
#pragma unroll
            for (int ct = 0; ct < 16; ++ct) {
                const u32x2 xv = *(const u32x2*)(xrow + ct * 16);
                f32x4 o = {bf2f(xv.x & 0xffffu), bf2f(xv.x >> 16), bf2f(xv.y & 0xffffu), bf2f(xv.y >> 16)};
                o += accV[ct] * inv_cs;
                __builtin_nontemporal_store(o, (f32x4*)(orow + ct * 16));
            }
        }
#else
        typedef int v2i __attribute__((ext_vector_type(2)));
        long cq[4]; float inv_cs;
        {
            f32x4 cv[4][2]; float cmax = 0.f;
#pragma unroll
            for (int kk = 0; kk < 4; ++kk)
#pragma unroll
                for (int q = 0; q < 2; ++q) {
                    cv[kk][q] = *(const LAS f32x4*)(COEF + fr * 128 + kk * 32 + 8 * fq + 4 * q);
                    cmax = fmaxf(cmax, fmaxf(fmaxf(fabsf(cv[kk][q][0]), fabsf(cv[kk][q][1])), fmaxf(fabsf(cv[kk][q][2]), fabsf(cv[kk][q][3]))));
                }
            cmax = fmaxf(cmax, __shfl_xor(cmax, 16)); cmax = fmaxf(cmax, __shfl_xor(cmax, 32));
            const float cs = cmax > 0.f ? 240.f / cmax : 1.f; inv_cs = cmax > 0.f ? cmax * (1.f / 240.f) : 1.f;
#pragma unroll
            for (int kk = 0; kk < 4; ++kk) {
                int lo = 0, hi = 0;
                lo = __builtin_amdgcn_cvt_pk_fp8_f32(cv[kk][0][0] * cs, cv[kk][0][1] * cs, lo, false);
                lo = __builtin_amdgcn_cvt_pk_fp8_f32(cv[kk][0][2] * cs, cv[kk][0][3] * cs, lo, true);
                hi = __builtin_amdgcn_cvt_pk_fp8_f32(cv[kk][1][0] * cs, cv[kk][1][1] * cs, hi, false);
                hi = __builtin_amdgcn_cvt_pk_fp8_f32(cv[kk][1][2] * cs, cv[kk][1][3] * cs, hi, true);
                cq[kk] = (long)(((unsigned long long)(unsigned)hi << 32) | (unsigned long long)(unsigned)lo);
            }
        }
        LDS_WAIT(); __builtin_amdgcn_wave_barrier();
        const int vrow = 8 * fq + (fr >> 1);
        const int vrd0 = vrow * 128 + (fr & 1) * 8, vsw = (vrow >> 1) & 7;
        int vwofs[4];
#pragma unroll
        for (int i = 0; i < 4; ++i) { const int rr = lrow + 8 * i; vwofs[i] = rr * 128 + ((lch ^ ((rr >> 1) & 7)) << 4); }
#pragma unroll 1
        for (int sl = 0; sl < P8_NSL; ++sl) {
            if (pace) xcd_pace(bar, P8_NSL + sl);
            f32x4 accV[8];
#pragma unroll
            for (int ct = 0; ct < 8; ++ct) accV[ct] = (f32x4){0.f, 0.f, 0.f, 0.f};
            const unsigned char* vbs = vq + sl * P8_SLC + lch * 16;
#pragma unroll 1
            for (int j0 = 0; j0 < 16; ++j0) {
                const bool mine = (fr == j0);
                u32x4 g[4][4];
#pragma unroll
                for (int kk = 0; kk < 4; ++kk)
#pragma unroll
                    for (int i = 0; i < 4; ++i) {
                        const unsigned e = IDX[j0 * 128 + kk * 32 + lrow + 8 * i];
                        g[kk][i] = *(const u32x4*)(vbs + (size_t)e * DM);
                    }
#pragma unroll
                for (int kk = 0; kk < 4; ++kk) {
                    LAS unsigned char* T = STG + (kk & 1) * 4096;
#pragma unroll
                    for (int i = 0; i < 4; ++i) *(LAS u32x4*)(T + vwofs[i]) = g[kk][i];
                    __builtin_amdgcn_wave_barrier();
                    const long bmq = mine ? cq[kk] : 0l;
#pragma unroll
                    for (int ct = 0; ct < 8; ++ct) {
                        const v2i av = __builtin_amdgcn_ds_read_tr8_b64_v2i32((LAS v2i*)(T + vrd0 + ((ct ^ vsw) << 4)));
                        const long a = (long)(((unsigned long long)(unsigned)av.y << 32) | (unsigned long long)(unsigned)av.x);
                        accV[ct] = __builtin_amdgcn_mfma_f32_16x16x32_fp8_fp8(a, bmq, accV[ct], 0, 0, 0);
                    }
                    __builtin_amdgcn_wave_barrier();
                }
            }
            float* orow = out + (t0 + fr) * DM + sl * P8_SLC + 4 * fq;
            const bf16_t* xrow = x1b + (t0 + fr) * DM + sl * P8_SLC + 4 * fq;
#pragma unroll
            for (int ct = 0; ct < 8; ++ct) {
                const u32x2 xv = *(const u32x2*)(xrow + ct * 16);
                f32x4 o = {bf2f(xv.x & 0xffffu), bf2f(xv.x >> 16), bf2f(xv.y & 0xffffu), bf2f(xv.y >> 16)};
                o += accV[ct] * inv_cs;
                __builtin_nontemporal_store(o, (f32x4*)(orow + ct * 16));
            }
        }
#endif
#if defined(PROBE_PHASE) && PROBE_PHASE >= 80
        F.tc = __builtin_amdgcn_s_memrealtime();
#endif
        LDS_WAIT(); __builtin_amdgcn_wave_barrier();
    }
}

constexpr int NPHASE = 9;
#ifndef N_LAUNCHES
#define N_LAUNCHES 1
#endif
constexpr int MISC_OFF = LDS_BYTES - 128;
__global__ void __launch_bounds__(512, 2) fwd_kernel(Params p) {
    extern __shared__ __attribute__((aligned(16))) unsigned char lds_raw[];
    Ctx F; F.ta = F.tb = F.tc = 0;
    F.lds = (LAS unsigned char*)lds_raw;
    F.tid = threadIdx.x; F.lane = F.tid & 63; F.wave = __builtin_amdgcn_readfirstlane(F.tid >> 6);
    F.G = gridDim.x; { const int bx = blockIdx.x; F.vcu = (F.G % 8 == 0) ? (bx % 8) * (F.G / 8) + bx / 8 : bx; }
    F.gw = F.vcu * 8 + F.wave; F.ngw = F.G * 8;
    unsigned char* ws = p.ws;
    const int lo = p.ph_lo, hi = p.ph_hi;
    volatile LAS unsigned* MISC = (volatile LAS unsigned*)(F.lds + MISC_OFF);
    if (F.tid < 32) MISC[F.tid] = 0u;
    __syncthreads();
#ifdef CG_FIRST_SYNC
    XcdBarrier bar; bar.bar = (unsigned*)(ws + WS_CTL) + CW_BAR; bar.x = 0; bar.st = MISC + 8;
    for (int i = blockIdx.x * 512 + F.tid; i < XCD_BAR_WORDS + PACE_WORDS; i += F.G * 512) __hip_atomic_store(bar.bar + i, 0u, __ATOMIC_RELAXED, __HIP_MEMORY_SCOPE_AGENT);
#else
    XcdBarrier bar = xcd_barrier_post((unsigned*)(ws + WS_CTL) + CW_BAR, MISC + 8);
#endif
#ifdef ONLY_PHASE
#define IN(k) ((k)==ONLY_PHASE)
#else
#define IN(k) (lo <= (k) && (k) < hi)
#endif
#ifdef PROBE_PHASE
    unsigned long long tp0 = __builtin_amdgcn_s_memrealtime(), tp1 = 0; const unsigned long long tstart = tp0;
#define PSTAMP(k) do { if ((k) + 1 == PROBE_PHASE) tp0 = __builtin_amdgcn_s_memrealtime(); if ((k) == PROBE_PHASE) tp1 = __builtin_amdgcn_s_memrealtime(); } while (0)
#else
#define PSTAMP(k) do {} while (0)
#endif
#define SEAM(k) do { if (IN(k) && ((k) == 6 ? IN(8) : IN((k) + 1))) xcd_barrier(bar); PSTAMP(k); } while (0)
    if (IN(0)) phase0(p, F);
#ifdef CG_FIRST_SYNC
    if (IN(0) && IN(1)) { cooperative_groups::this_grid().sync(); bar = xcd_barrier_post((unsigned*)(ws + WS_CTL) + CW_BAR, MISC + 8); }
    PSTAMP(0);
#else
    SEAM(0);
#endif
    if (IN(1)) {
        pg8::Gemm g{(const pg8::bf16_t*)(ws + WS_XB), (const pg8::bf16_t*)(ws + WS_WINT), TOK, NIN, DM};
        pg8::StaticOrder S; S.init(TOK, NIN, F.G, (int)blockIdx.x);
        pg8::EpiProj E{(pg8::bf16_t*)(ws + WS_PROJ), NIN, p.in[9], p.in[10], (const float*)(ws + WS_ROPE), (const float*)(ws + WS_ROPE) + SEQ * 8,
                       (LAS float*)(F.lds + pg8::STAGE_BYTES), PQ, PK, PV, SEQ - 1, EPSN};
        pg8::gemm_phase<pg8::EpiProj, pg8::StaticOrder, true, true>(F.lds, g, S, E);
    }
    SEAM(1);
    if (IN(2)) phase2(p, F);
    SEAM(2);
#if defined(PROBE_PHASE) && PROBE_PHASE == 84
    const unsigned long long t3s = __builtin_amdgcn_s_memrealtime();
#endif
    if (IN(3)) phase3(p, F);
#if defined(PROBE_PHASE) && PROBE_PHASE == 84
    { const unsigned long long tend = __builtin_amdgcn_s_memrealtime();
      if (F.tid == 0) { unsigned* mw = (unsigned*)(ws + WS_MISC); const unsigned d = (unsigned)(tend - t3s); atomicMax(mw + 2, d); atomicMin(mw + 3, d); atomicAdd(mw + 4, d >> 8); } }
#endif
    SEAM(3);
    if (IN(4)) phase4(p, F);
    SEAM(4);
    if (IN(5)) {
        pg8::Gemm g{(const pg8::bf16_t*)(ws + WS_YCAT), (const pg8::bf16_t*)(ws + WS_WOUTT), TOK, DM, DM};
        pg8::StaticOrder S; S.init(TOK, DM, F.G, (int)blockIdx.x);
        pg8::EpiResid E{(const pg8::bf16_t*)(ws + WS_XB), (const float*)(ws + WS_RSTD), (pg8::bf16_t*)(ws + WS_X1B), (float*)(ws + WS_CTL) + CW_ROWSQ, DM};
        pg8::gemm_phase<pg8::EpiResid, pg8::StaticOrder, true, true>(F.lds, g, S, E);
    }
    SEAM(5);
    if (IN(6)) {
        pg8::Gemm g{(const pg8::bf16_t*)(ws + WS_X1B), (const pg8::bf16_t*)(ws + WS_WQT), TOK, 2048, DM};
        pg8::StaticOrder S; S.init(TOK, 2048, F.G, (int)blockIdx.x);
        pg8::EpiBf16<0> E{(pg8::bf16_t*)(ws + WS_QP), 2048, nullptr, 0, 0, 1.f};
        pg8::gemm_phase<pg8::EpiBf16<0>, pg8::StaticOrder, true, true>(F.lds, g, S, E);
    }
    SEAM(6);
    PSTAMP(7);
#if defined(PROBE_PHASE) && PROBE_PHASE == 83
    tp0 = __builtin_amdgcn_s_memrealtime();
#endif
#ifdef PROBE_PHASE
    const unsigned sv_nloc = MISC[8], sv_nx = MISC[9];
#endif
    if (IN(8)) phase8(p, F, bar);
#ifdef PROBE_PHASE
    __syncthreads(); if (F.tid == 0) { MISC[8] = sv_nloc; MISC[9] = sv_nx; } __syncthreads();
#endif
#if defined(PROBE_PHASE) && PROBE_PHASE == 83
    {
        const unsigned long long tend = __builtin_amdgcn_s_memrealtime();
        if (F.tid == 0) { unsigned* mw = (unsigned*)(ws + WS_MISC); const unsigned d = (unsigned)(tend - tp0);
            atomicMax(mw + 2, d); atomicMin(mw + 3, d); atomicAdd(mw + 4, d >> 8); }
    }
#endif
#ifdef PROBE_PHASE
    xcd_barrier(bar);
    PSTAMP(8);
#if PROBE_PHASE == 83 || PROBE_PHASE == 84
    { const unsigned* mw = (const unsigned*)(ws + WS_MISC);
      const unsigned vmax = __hip_atomic_load(mw + 2, __ATOMIC_RELAXED, __HIP_MEMORY_SCOPE_AGENT), vmin = __hip_atomic_load(mw + 3, __ATOMIC_RELAXED, __HIP_MEMORY_SCOPE_AGENT), vsum = __hip_atomic_load(mw + 4, __ATOMIC_RELAXED, __HIP_MEMORY_SCOPE_AGENT);
      tp0 = 0; tp1 = PROBE_SUB == 0 ? vmax : (PROBE_SUB == 1 ? vmin : (unsigned)(((unsigned long long)vsum << 8) / gridDim.x)); }
#elif PROBE_PHASE == 9
    tp0 = tstart; tp1 = __builtin_amdgcn_s_memrealtime();
#elif PROBE_PHASE == 80 || PROBE_PHASE == 20 || PROBE_PHASE == 30 || PROBE_PHASE == 82
    tp0 = F.ta; tp1 = F.tb;
#elif PROBE_PHASE == 81 || PROBE_PHASE == 21 || PROBE_PHASE == 31
    tp0 = F.tb; tp1 = F.tc;
#endif
#if PROBE_PHASE == 98
    {
        typedef int v2i __attribute__((ext_vector_type(2)));
        float result = 0.f;
        __syncthreads();
        if (blockIdx.x == 0 && F.wave == 0) {
            LAS unsigned char* T = (LAS unsigned char*)F.lds;
            if (F.lane < 16) {
                unsigned long long w = 0ull;
                for (int c = 0; c < 16; ++c) { const unsigned long long nib = (PROBE_SUB == 0) ? (unsigned long long)F.lane : (unsigned long long)c; w |= nib << (4 * c); }
                *(LAS unsigned long long*)(T + F.lane * 8) = w;
            }
            LDS_WAIT(); __builtin_amdgcn_wave_barrier();
            const v2i rv_ = __builtin_amdgcn_ds_read_tr4_b64_v2i32((LAS v2i*)(T + (F.lane & 15) * 8));
            const unsigned long long got = ((unsigned long long)(unsigned)rv_.y << 32) | (unsigned long long)(unsigned)rv_.x;
            unsigned long long want = 0ull;
            for (int j = 0; j < 16; ++j) { const unsigned long long nib = (PROBE_SUB == 0) ? (unsigned long long)j : (unsigned long long)(F.lane & 15); want |= nib << (4 * j); }
            const unsigned long long bal = __ballot(got == want);
            result = (float)__popcll(bal);
        }
        if (blockIdx.x == 0 && F.tid == 0) { VM_WAIT(); p.out[0] += result; }
    }
#elif PROBE_PHASE == 99
    {
        typedef int v8i __attribute__((ext_vector_type(8)));
        float result = 0.f;
        if (blockIdx.x == 0 && F.wave == 0) {
            const int fr_ = F.lane & 15, fq_ = F.lane >> 4;
            v8i bv;
#pragma unroll
            for (int q = 0; q < 8; ++q) { unsigned w = 0; for (int bb = 0; bb < 4; ++bb) { unsigned pcode = (unsigned)(32 * fq_ + 4 * q + bb); if (pcode == 127u) pcode = 126u; w |= pcode << (8 * bb); } bv[q] = (int)w; }
            int matches = 0, firstbad = -1, firstbadval = -1;
            for (int ga = 0; ga < 4; ++ga)
                for (int ja = 0; ja < 32; ++ja) {
                    v8i av = {0, 0, 0, 0, 0, 0, 0, 0};
                    if (fr_ == 0 && fq_ == ga) { const unsigned nib = 2u << (4 * (ja & 7)); const int wsel = ja >> 3;
                        av[0] = wsel == 0 ? (int)nib : 0; av[1] = wsel == 1 ? (int)nib : 0; av[2] = wsel == 2 ? (int)nib : 0; av[3] = wsel == 3 ? (int)nib : 0; }
                    f32x4 c = {0.f, 0.f, 0.f, 0.f};
                    c = __builtin_amdgcn_mfma_scale_f32_16x16x128_f8f6f4(av, bv, c, 4, 0, 0, 0, 0, 0);
                    int pk = 0; pk = __builtin_amdgcn_cvt_pk_fp8_f32(c[0], 0.f, pk, false);
                    const int got = __shfl(pk & 255, 0);
                    int want = 32 * ga + ja; if (want == 127) want = 126;
                    if (got == want) ++matches; else if (firstbad < 0) { firstbad = 32 * ga + ja; firstbadval = got; }
                }
#if PROBE_SUB == 0
            result = (float)matches;
#elif PROBE_SUB == 1
            result = (float)firstbad;
#else
            result = (float)firstbadval;
#endif
        }
        if (blockIdx.x == 0 && F.tid == 0) { VM_WAIT(); p.out[0] += result; }
    }
#else
    if (blockIdx.x == 0 && F.tid == 0) { VM_WAIT(); p.out[0] += (float)(tp1 - tp0) * (1.0f / (float)(PROBE_DIV)); }
#endif
#endif
#undef IN
#undef SEAM
}

extern "C" void kernel_launch(void* const* d_in, const int* in_sizes, int n_in, void* d_out, int out_size, void* d_ws, size_t ws_size, hipStream_t stream) {
    static int grid = 0;
    if (grid == 0) {
        if (n_in != 22 || in_sizes[0] != TOK * DM || out_size != TOK * DM || ws_size < WS_END) {
            fprintf(stderr, "kernel_launch: unexpected shapes: n_in %d in0 %d out %d ws %zu\n", n_in, n_in > 0 ? in_sizes[0] : -1, out_size, ws_size); grid = -1; return; }
        if (hipFuncSetAttribute((const void*)fwd_kernel, hipFuncAttributeMaxDynamicSharedMemorySize, LDS_BYTES) != hipSuccess) { fprintf(stderr, "kernel_launch: hipFuncSetAttribute failed\n"); grid = -1; return; }
        int dev = 0, cus = 0, per_cu = 0;
        if (hipGetDevice(&dev) != hipSuccess || hipDeviceGetAttribute(&cus, hipDeviceAttributeMultiprocessorCount, dev) != hipSuccess) { grid = -1; return; }
        if (hipOccupancyMaxActiveBlocksPerMultiprocessor(&per_cu, (const void*)fwd_kernel, 512, LDS_BYTES) != hipSuccess || per_cu < 1) { fprintf(stderr, "kernel_launch: occupancy query failed (%d)\n", per_cu); (void)hipGetLastError(); per_cu = 1; }
        grid = cus * (per_cu > 1 ? 1 : per_cu);
    }
    if (grid < 0) return;
#ifndef CG_FIRST_SYNC
    (void)hipMemsetAsync((char*)d_ws + WS_CTL + (size_t)CW_BAR * 4, 0, (size_t)(XCD_BAR_WORDS + PACE_WORDS) * 4, stream);
#endif
    Params a{};
    for (int i = 0; i < 22; ++i) a.in[i] = (const float*)d_in[i];
    a.out = (float*)d_out; a.ws = (unsigned char*)d_ws;
#if N_LAUNCHES == 1
    a.ph_lo = 0; a.ph_hi = NPHASE;
#ifdef USE_COOP_LAUNCH
    { void* args[] = {&a};
      hipError_t e = hipLaunchCooperativeKernel((const void*)fwd_kernel, dim3(grid), dim3(512), args, LDS_BYTES, stream);
      if (e != hipSuccess) fprintf(stderr, "kernel_launch: cooperative launch failed: %s (grid %d)\n", hipGetErrorString(e), grid); }
#else
    hipLaunchKernelGGL(fwd_kernel, dim3(grid), dim3(512), LDS_BYTES, stream, a);
#endif
#else
    for (int ph = 0; ph < NPHASE; ++ph) {
        a.ph_lo = ph; a.ph_hi = ph + 1;
        hipLaunchKernelGGL(fwd_kernel, dim3(grid), dim3(512), LDS_BYTES, stream, a);
    }
#endif
    const hipError_t le = hipPeekAtLastError();
    if (le != hipSuccess) fprintf(stderr, "kernel_launch: launch failed: %s\n", hipGetErrorName(le));
}
```

```cpp
#include <hip/hip_runtime.h>
#include <hip/hip_cooperative_groups.h>
#include <cstdio>
#include <cstdint>
#define USE_COOP_LAUNCH 1
#define U_FP4 1
#define V_FP4 1

#define LAS __attribute__((address_space(3)))
#define GAS __attribute__((address_space(1)))
typedef unsigned short bf16_t;
typedef short bf16x8 __attribute__((ext_vector_type(8)));
typedef short s16x4 __attribute__((ext_vector_type(4)));
typedef float f32x4 __attribute__((ext_vector_type(4)));
typedef float f32x8 __attribute__((ext_vector_type(8)));
typedef float f32x16 __attribute__((ext_vector_type(16)));
typedef unsigned u32x4 __attribute__((ext_vector_type(4)));
typedef unsigned u32x2 __attribute__((ext_vector_type(2)));

constexpr int NB = 8, SEQ = 4096, TOK = NB * SEQ, DM = 1024;
constexpr int NIN = 3072;
constexpr int PZ = 0, PXS = 512, PBM = 1024, PCM = 1280, PQ = 1536, PK = 2048, PV = 2560;
constexpr int CHUNK = 64, NCH = SEQ / CHUNK;
constexpr int NHS = 8;
constexpr float EPSN = 1e-6f;
constexpr int PEER_H = 8, NKEYS = 128, TOPK = 16;
constexpr float LAMBDA_INIT = 0.2f;

constexpr size_t MiB = 1u << 20;
constexpr size_t WS_CTL = 0, CTL_BYTES = 1 * MiB;
constexpr size_t WS_WINT = 1 * MiB;
constexpr size_t WS_WOUTT = 7 * MiB;
constexpr size_t WS_WQT = 9 * MiB;
constexpr size_t WS_KEYS = 13 * MiB;
constexpr size_t WS_ROPE = 13 * MiB + 512 * 1024;
constexpr size_t WS_MISC = 13 * MiB + 768 * 1024;
constexpr size_t WS_RSU = WS_MISC + 64 * 1024;
constexpr size_t WS_RSV = WS_MISC + 128 * 1024;
constexpr size_t WS_DTRAW = 14 * MiB;
constexpr size_t WS_ACS = 15 * MiB;
constexpr size_t WS_CDEC = 16 * MiB;
constexpr size_t WS_RSTD = 17 * MiB;
constexpr size_t WS_UB = 20 * MiB;
constexpr size_t WS_VB = 52 * MiB;
constexpr size_t WS_XB = 84 * MiB;
constexpr size_t WS_YCAT = 420 * MiB;
constexpr size_t WS_PROJ = 148 * MiB;
constexpr size_t WS_QP = WS_PROJ;
constexpr size_t WS_IDX = 276 * MiB;
constexpr size_t WS_GW = 292 * MiB;
constexpr size_t WS_CMC = 340 * MiB;
constexpr size_t WS_STATES = 356 * MiB;
constexpr size_t WS_X1B = WS_STATES;
constexpr size_t WS_END = 484 * MiB;
constexpr int CW_BAR = 4096;
constexpr int CW_ROWSQ = 131072;
static_assert((CW_ROWSQ + TOK) * 4 <= (int)CTL_BYTES, "ctl");

constexpr int PACE_WORDS = 32 * 16 * 16;
constexpr int LDS_BYTES = 163840;

__device__ __forceinline__ float bf2f(unsigned h) { return __uint_as_float(h << 16); }
typedef float f32x2_cv __attribute__((ext_vector_type(2)));
typedef __bf16 bf16x2_cv __attribute__((ext_vector_type(2)));
__device__ __forceinline__ unsigned pk2(float lo, float hi) { const f32x2_cv v = {lo, hi}; return __builtin_bit_cast(unsigned, __builtin_convertvector(v, bf16x2_cv)); }
__device__ __forceinline__ unsigned f2bf(float f) { return pk2(f, 0.f) & 0xffffu; }
#define DPP_F(v, ctrl) __builtin_bit_cast(float, __builtin_amdgcn_mov_dpp(__builtin_bit_cast(int, (v)), (ctrl), 0xf, 0xf, true))
__device__ __forceinline__ float wave_sum(float v) {
    v += DPP_F(v, 0xB1); v += DPP_F(v, 0x4E);
    v += DPP_F(v, 0x124); v += DPP_F(v, 0x128);
    { auto r = __builtin_amdgcn_permlane16_swap(__float_as_uint(v), __float_as_uint(v), false, false); v = __uint_as_float(r[0]) + __uint_as_float(r[1]); }
    { auto r = __builtin_amdgcn_permlane32_swap(__float_as_uint(v), __float_as_uint(v), false, false); v = __uint_as_float(r[0]) + __uint_as_float(r[1]); }
    return v;
}
__device__ __forceinline__ float wave_max(float v) {
    v = fmaxf(v, DPP_F(v, 0xB1)); v = fmaxf(v, DPP_F(v, 0x4E));
    v = fmaxf(v, DPP_F(v, 0x124)); v = fmaxf(v, DPP_F(v, 0x128));
    { auto r = __builtin_amdgcn_permlane16_swap(__float_as_uint(v), __float_as_uint(v), false, false); v = fmaxf(__uint_as_float(r[0]), __uint_as_float(r[1])); }
    { auto r = __builtin_amdgcn_permlane32_swap(__float_as_uint(v), __float_as_uint(v), false, false); v = fmaxf(__uint_as_float(r[0]), __uint_as_float(r[1])); }
    return v;
}
__device__ __forceinline__ float silu_f(float x) { return x * __builtin_amdgcn_rcpf(1.f + __expf(-x)); }
__device__ __forceinline__ f32x4 mfma16(bf16x8 a, bf16x8 b, f32x4 c) { return __builtin_amdgcn_mfma_f32_16x16x32_bf16(a, b, c, 0, 0, 0); }
__device__ __forceinline__ f32x16 mfma32(bf16x8 a, bf16x8 b, f32x16 c) { return __builtin_amdgcn_mfma_f32_32x32x16_bf16(a, b, c, 0, 0, 0); }
#define LDS_WAIT() asm volatile("s_waitcnt lgkmcnt(0)" ::: "memory")
#define VM_WAIT() asm volatile("s_waitcnt vmcnt(0)" ::: "memory")

#define XB_TMO      128
#define XB_XCNT(j)  (256  + 64 * (j))
#define XB_XSUB(j)  (1280 + 64 * (j))
#define XB_XGEN(j)  (2304 + 64 * (j))
#define XB_TOP      3328
#define XB_TOPGEN   3392
#define XCD_BAR_WORDS 3456
#define XB_SPIN_CAP (1u << 21)

__device__ __forceinline__ unsigned xb_ld(unsigned* p)              { return __hip_atomic_load(p, __ATOMIC_RELAXED, __HIP_MEMORY_SCOPE_AGENT); }
__device__ __forceinline__ unsigned xb_add(unsigned* p, unsigned v) { return __hip_atomic_fetch_add(p, v, __ATOMIC_RELAXED, __HIP_MEMORY_SCOPE_AGENT); }
__device__ __forceinline__ unsigned xb_xcc_id() { return (unsigned)__builtin_amdgcn_s_getreg((3 << 11) | 20) & 0xFu; }
#define XB_SPIN(cond, bar) do { unsigned _sp = 0; while (cond) { __builtin_amdgcn_s_sleep(1); \
    if ((++_sp & 255u) == 0u) { if (xb_ld(&(bar)[XB_TMO])) break; if (_sp > XB_SPIN_CAP) { atomicAdd(&(bar)[XB_TMO], 1u); break; } } } } while (0)

struct XcdBarrier {
    unsigned* bar; unsigned x;
    volatile LAS unsigned* st;
};

__device__ __forceinline__ XcdBarrier xcd_barrier_post(unsigned* bar, volatile LAS unsigned* st) {
    XcdBarrier b; b.bar = bar; b.x = xb_xcc_id(); b.st = st;
    if (threadIdx.x == 0) (void)xb_add(&bar[XB_XCNT(b.x)], 1u);
    return b;
}
__device__ __forceinline__ void xcd_barrier_complete(unsigned* bar, unsigned x, unsigned& nloc, unsigned& nx) {
    const unsigned G = gridDim.x * gridDim.y * gridDim.z;
    unsigned sum, cnt, mine, sp = 0u;
    for (;;) {
        sum = 0u; cnt = 0u; mine = 0u;
#pragma unroll
        for (unsigned j = 0; j < 16; ++j) { const unsigned c = xb_ld(&bar[XB_XCNT(j)]); sum += c; cnt += (c > 0u) ? 1u : 0u; mine = (j == x) ? c : mine; }
        if (sum == G) break;
        __builtin_amdgcn_s_sleep(1);
        if ((++sp & 255u) == 0u) { if (xb_ld(&bar[XB_TMO])) break; if (sp > XB_SPIN_CAP) { atomicAdd(&bar[XB_TMO], 1u); break; } }
    }
    nloc = mine > 0u ? mine : 1u; nx = cnt > 0u ? cnt : 1u;
}

__device__ __forceinline__ void xcd_barrier(const XcdBarrier& b) {
    asm volatile("s_waitcnt vmcnt(0)" ::: "memory");
    __syncthreads();
    if (threadIdx.x == 0) {
        unsigned* bar = b.bar;
        __builtin_amdgcn_s_waitcnt(0);
        unsigned nloc = b.st[0], nx = b.st[1];
        if (nloc == 0u) { xcd_barrier_complete(bar, b.x, nloc, nx); b.st[0] = nloc; b.st[1] = nx; }
        const unsigned old = xb_add(&bar[XB_XSUB(b.x)], 1u);
        const unsigned gen = old / nloc;
        if (old + 1u == (gen + 1u) * nloc) {
            __builtin_amdgcn_fence(__ATOMIC_RELEASE, "agent");
            asm volatile("s_waitcnt vmcnt(0)" ::: "memory");
            const unsigned og = xb_add(&bar[XB_TOP], 1u);
            const unsigned tg = og / nx;
            if (og + 1u == (tg + 1u) * nx) xb_add(&bar[XB_TOPGEN], 1u);
            else XB_SPIN(xb_ld(&bar[XB_TOPGEN]) == tg, bar);
            __builtin_amdgcn_fence(__ATOMIC_ACQUIRE, "agent");
            xb_add(&bar[XB_XGEN(b.x)], 1u);
            asm volatile("s_waitcnt vmcnt(0)" ::: "memory");
        } else {
            XB_SPIN(xb_ld(&bar[XB_XGEN(b.x)]) == gen, bar);
            __builtin_amdgcn_fence(__ATOMIC_ACQUIRE, "agent");
            asm volatile("s_waitcnt vmcnt(0)" ::: "memory");
        }
    }
    __syncthreads();
}
namespace pg8 {
#define PG8_LAS __attribute__((address_space(3)))
typedef unsigned short bf16_t;
typedef short bf16x8 __attribute__((ext_vector_type(8)));
typedef float f32x4 __attribute__((ext_vector_type(4)));
typedef unsigned u32x4 __attribute__((ext_vector_type(4)));
constexpr int BM = 256, BK = 64, HALF = 128, HTB = HALF * BK * 2  , STAGE_BYTES = 8 * HTB, NXCD = 8, WGM = 8;

__host__ __device__ __forceinline__ int lds_byte(int r, int c) { const int st = (r >> 4) * 2 + (c >> 5), rr = r & 15, cc = c & 31, ob = rr * 64 + cc * 2; return st * 1024 + (ob ^ (((ob >> 9) & 1) << 5)); }
__host__ __device__ __forceinline__ void stage_rc(int b, int& R, int& C) { const int st = b / 1024, sb = b % 1024, swz = sb ^ (((sb >> 9) & 1) << 5); R = (st >> 1) * 16 + swz / 64; C = (st & 1) * 32 + (swz % 64) / 2; }
__host__ __device__ __forceinline__ int perm32(int rho) { const int n = rho >> 4, i = rho & 15; return 8 * (i >> 2) + 4 * n + (i & 3); }

struct Unit { int pm, pn; };
struct Gemm { const bf16_t* A; const bf16_t* Bt; int M, N, K; };

struct StaticOrder {
    int nM, nN, nwg, G, c;
    __host__ __device__ void init(int M, int N, int G_, int c_) { nM = M / BM; nN = N / BM; nwg = nM * nN; G = G_; c = c_; }
    __host__ __device__ bool next(int i, Unit& u) const {
        const long L = (long)i * G + c; if (L >= nwg) return false;
        int wgid = (int)L; { const int q = nwg / NXCD, r = nwg % NXCD, xcd = wgid % NXCD, off = wgid / NXCD; wgid = (xcd < r ? xcd * (q + 1) : r * (q + 1) + (xcd - r) * q) + off; }
        const int nig = WGM * nN, gid = wgid / nig, fm = gid * WGM, gsz = (nM - fm) < WGM ? (nM - fm) : WGM;
        u.pm = fm + ((wgid % nig) % gsz); u.pn = (wgid % nig) / gsz; return true;
    }
    __device__ __forceinline__ void a_ready(const Unit&) const {}
    __device__ __forceinline__ void done(const Unit&) const {}
};

__device__ __forceinline__ unsigned cvt_pk_bf16(float lo, float hi) { unsigned r; asm volatile("v_cvt_pk_bf16_f32 %0, %1, %2" : "=v"(r) : "v"(lo), "v"(hi)); return r; }
typedef float f32x2 __attribute__((ext_vector_type(2)));
__device__ __forceinline__ f32x2 gelu_pk(f32x2 v) {
    const f32x2 av = __builtin_elementwise_abs(v), d = av * 0.2316418882f + 1.0f;
    f32x2 t; t.x = __builtin_amdgcn_rcpf(d.x); t.y = __builtin_amdgcn_rcpf(d.y);
    f32x2 q = t * 0.5307027145f + (-0.7265760135f); q = q * t + 0.7107068705f; q = q * t + (-0.142248368f); q = q * t + 0.127414796f; q = q * t;
    const f32x2 s = (v * v) * (-0.72134752044f);
    f32x2 e; e.x = __builtin_amdgcn_exp2f(s.x); e.y = __builtin_amdgcn_exp2f(s.y);
    const f32x2 m = v * (q * e), r = v - m;
    f32x2 o; o.x = v.x < 0.f ? m.x : r.x; o.y = v.y < 0.f ? m.y : r.y; return o;
}

template <int ACT  > struct EpiBf16 {
    static constexpr bool PERM = true, AFTER_DRAIN = false; static_assert(ACT == 0 || ACT == 1, "EpiBf16: ACT is 0 (none) or 1 (gelu_pk)");
    bf16_t* O; int ldc; const float* bias; int split_cols; size_t split_stride; float scale0;
    __device__ __forceinline__ void operator()(const f32x4 (&acc)[2][2][4][2], const Unit& u, int wr, int wc, int fr, int fq) const {
        const int row0 = u.pm * BM + wr * 64 + fr; int colt = u.pn * BM; bf16_t* base = O;
        float sc = 1.f; if (split_cols) { const int t = colt / split_cols; base += (size_t)t * split_stride; colt -= t * split_cols; if (t == 0) sc = scale0; }
        const int col0 = colt + wc * 32 + 8 * fq, bcol0 = u.pn * BM + wc * 32 + 8 * fq;
        f32x4 bv[2][2];
#pragma unroll
        for (int bj = 0; bj < 2; ++bj)
#pragma unroll
            for (int n = 0; n < 2; ++n) bv[bj][n] = bias ? *(const f32x4*)(bias + bcol0 + bj * HALF + 4 * n) : (f32x4){0.f, 0.f, 0.f, 0.f};
#pragma unroll
        for (int ai = 0; ai < 2; ++ai)
#pragma unroll
            for (int m = 0; m < 4; ++m) { bf16_t* rowp = base + (size_t)(row0 + ai * HALF + m * 16) * ldc + col0;
#pragma unroll
                for (int bj = 0; bj < 2; ++bj) { f32x4 v0 = acc[ai][bj][m][0] + bv[bj][0], v1 = acc[ai][bj][m][1] + bv[bj][1];
                    if (ACT == 1) { f32x2 a = gelu_pk((f32x2){v0[0], v0[1]}), b = gelu_pk((f32x2){v0[2], v0[3]}), c = gelu_pk((f32x2){v1[0], v1[1]}), d = gelu_pk((f32x2){v1[2], v1[3]});
                        v0 = (f32x4){a.x, a.y, b.x, b.y}; v1 = (f32x4){c.x, c.y, d.x, d.y}; }
                    v0 = v0 * sc; v1 = v1 * sc; u32x4 w; w.x = cvt_pk_bf16(v0[0], v0[1]); w.y = cvt_pk_bf16(v0[2], v0[3]); w.z = cvt_pk_bf16(v1[0], v1[1]); w.w = cvt_pk_bf16(v1[2], v1[3]);
                    *(u32x4*)(rowp + bj * HALF) = w; } }
    }
};

struct EpiResid {
    static constexpr bool PERM = false, AFTER_DRAIN = false;
    const bf16_t* xn; const float* xscale; bf16_t* xb; float* rowsq; int ldc;
    __device__ __forceinline__ void operator()(const f32x4 (&acc)[2][2][4][2], const Unit& u, int wr, int wc, int fr, int fq) const {
        typedef unsigned u32x2v __attribute__((ext_vector_type(2)));
        const int col0 = u.pn * BM + wc * 32 + 4 * fq;
        const size_t base = (size_t)(u.pm * BM + wr * 64 + fr) * ldc + col0;
        u32x2v xv[2][4]; float xs[2];
#define EPR_LOAD(SET, G) do { const int r_ = ((G) >> 2) * HALF + ((G) & 3) * 16; const size_t off_ = base + (size_t)r_ * ldc; xs[SET] = xscale[u.pm * BM + wr * 64 + fr + r_]; \
        _Pragma("unroll") for (int bj = 0; bj < 2; ++bj) _Pragma("unroll") for (int n = 0; n < 2; ++n) xv[SET][bj * 2 + n] = __builtin_nontemporal_load((const u32x2v*)(xn + off_ + bj * HALF + n * 16)); } while (0)
        EPR_LOAD(0, 0);
#pragma unroll
        for (int g = 0; g < 8; ++g) {
            const int ai = g >> 2, m = g & 3;
            if (g + 1 < 8) { if ((g & 1) == 0) EPR_LOAD(1, g + 1); else EPR_LOAD(0, g + 1); }
            const int row = u.pm * BM + ai * HALF + wr * 64 + m * 16 + fr;
            const size_t off = base + (size_t)(ai * HALF + m * 16) * ldc;
            const float sc = xs[g & 1];
            float ss = 0.f;
#pragma unroll
            for (int bj = 0; bj < 2; ++bj)
#pragma unroll
                for (int n = 0; n < 2; ++n) {
                    const size_t c = off + bj * HALF + n * 16;
                    const u32x2v xr = xv[g & 1][bj * 2 + n];
                    f32x4 o = acc[ai][bj][m][n];
                    o[0] += __uint_as_float(xr.x << 16) * sc; o[1] += __uint_as_float(xr.x & 0xffff0000u) * sc;
                    o[2] += __uint_as_float(xr.y << 16) * sc; o[3] += __uint_as_float(xr.y & 0xffff0000u) * sc;
                    ss += (o[0] * o[0] + o[1] * o[1]) + (o[2] * o[2] + o[3] * o[3]);
                    u32x2v w; w.x = cvt_pk_bf16(o[0], o[1]); w.y = cvt_pk_bf16(o[2], o[3]);
                    *(u32x2v*)(xb + c) = w;
                }
            ss += __shfl_xor(ss, 16); ss += __shfl_xor(ss, 32);
            if (fq == 0) atomicAdd(rowsq + row, ss);
        }
#undef EPR_LOAD
    }
};

struct EpiProj {
    static constexpr bool PERM = true, AFTER_DRAIN = false;
    bf16_t* O; int ldc; const float* qnw; const float* knw; const float* cosT; const float* sinT; PG8_LAS float* xch; int q_lo, k_lo, k_hi, seq_mask; float eps;
    __device__ __forceinline__ void operator()(const f32x4 (&acc)[2][2][4][2], const Unit& u, int wr, int wc, int fr, int fq) const {
        const int colt = u.pn * BM, row0 = u.pm * BM + wr * 64 + fr, col0 = colt + wc * 32 + 8 * fq;
        if (colt < q_lo || colt >= k_hi) {
#pragma unroll
            for (int ai = 0; ai < 2; ++ai)
#pragma unroll
                for (int m = 0; m < 4; ++m) { bf16_t* rowp = O + (size_t)(row0 + ai * HALF + m * 16) * ldc + col0;
#pragma unroll
                    for (int bj = 0; bj < 2; ++bj) { const f32x4 v0 = acc[ai][bj][m][0], v1 = acc[ai][bj][m][1];
                        u32x4 w; w.x = cvt_pk_bf16(v0[0], v0[1]); w.y = cvt_pk_bf16(v0[2], v0[3]); w.z = cvt_pk_bf16(v1[0], v1[1]); w.w = cvt_pk_bf16(v1[2], v1[3]);
                        *(u32x4*)(rowp + bj * HALF) = w; } }
            return;
        }
        const float* nw = colt < k_lo ? qnw : knw;
#pragma unroll
        for (int ai = 0; ai < 2; ++ai)
#pragma unroll
            for (int m = 0; m < 4; ++m)
#pragma unroll
                for (int bj = 0; bj < 2; ++bj) {
                    const f32x4 a = acc[ai][bj][m][0], b = acc[ai][bj][m][1];
                    float ss = ((a[0] * a[0] + a[1] * a[1]) + (a[2] * a[2] + a[3] * a[3])) + ((b[0] * b[0] + b[1] * b[1]) + (b[2] * b[2] + b[3] * b[3]));
                    ss += __shfl_xor(ss, 16); ss += __shfl_xor(ss, 32);
                    if (fq == 0) xch[((ai * HALF + wr * 64 + m * 16 + fr) * 4 + bj * 2 + (wc >> 1)) * 2 + (wc & 1)] = ss;
                }
        asm volatile("s_waitcnt lgkmcnt(0)" ::: "memory"); __builtin_amdgcn_s_barrier(); asm volatile("" ::: "memory");
        float wv[8];
#pragma unroll
        for (int n = 0; n < 2; ++n)
#pragma unroll
            for (int j = 0; j < 4; ++j) wv[4 * n + j] = nw[32 * (wc & 1) + 8 * fq + 4 * n + j];
        const bool rot = ((wc & 1) == 0) && (fq < 2);
#pragma unroll
        for (int ai = 0; ai < 2; ++ai)
#pragma unroll
            for (int m = 0; m < 4; ++m) {
                const int rl = ai * HALF + wr * 64 + m * 16 + fr, row = u.pm * BM + rl, pos = row & seq_mask;
                f32x4 cs0 = {1.f, 1.f, 1.f, 1.f}, cs1 = cs0, sn0 = {0.f, 0.f, 0.f, 0.f}, sn1 = sn0;
                if (rot) { cs0 = *(const f32x4*)(cosT + pos * 8); cs1 = *(const f32x4*)(cosT + pos * 8 + 4); sn0 = *(const f32x4*)(sinT + pos * 8); sn1 = *(const f32x4*)(sinT + pos * 8 + 4); }
                bf16_t* rowp = O + (size_t)row * ldc + col0;
#pragma unroll
                for (int bj = 0; bj < 2; ++bj) {
                    const int xi = (rl * 4 + bj * 2 + (wc >> 1)) * 2;
                    const float rs = rsqrtf((xch[xi] + xch[xi + 1]) * (1.f / 64.f) + eps);
                    f32x4 y0 = acc[ai][bj][m][0] * rs, y1 = acc[ai][bj][m][1] * rs;
#pragma unroll
                    for (int j = 0; j < 4; ++j) { y0[j] *= wv[j]; y1[j] *= wv[4 + j]; }
                    f32x4 p0, p1;
#pragma unroll
                    for (int j = 0; j < 4; ++j) { p0[j] = __shfl_xor(y0[j], 16); p1[j] = __shfl_xor(y1[j], 16); }
                    if (rot) {
                        if (fq == 0) { y0 = y0 * cs0 - p0 * sn0; y1 = y1 * cs1 - p1 * sn1; }
                        else { y0 = p0 * sn0 + y0 * cs0; y1 = p1 * sn1 + y1 * cs1; }
                    }
                    u32x4 w; w.x = cvt_pk_bf16(y0[0], y0[1]); w.y = cvt_pk_bf16(y0[2], y0[3]); w.z = cvt_pk_bf16(y1[0], y1[1]); w.w = cvt_pk_bf16(y1[2], y1[3]);
                    *(u32x4*)(rowp + bj * HALF) = w;
                }
            }
    }
};

template <class Epi, class Sched, bool ALIGN_EPI = false, bool SP2 = false>
__device__ __forceinline__ void gemm_phase(PG8_LAS unsigned char* lds, const Gemm g, const Sched& S, const Epi& E) {
    const int tid = threadIdx.x, wid = __builtin_amdgcn_readfirstlane(tid >> 6), lane = tid & 63, wr = wid >> 2, wc = wid & 3, fr = lane & 15, fq = lane >> 4;
    const int K = g.K, nt = K / BK;
    unsigned voffA[2], voffB[2];
#pragma unroll
    for (int i = 0; i < 2; ++i) { int R, C; stage_rc(tid * 16 + i * 8192, R, C); const int Rb = Epi::PERM ? ((R & ~31) + perm32(R & 31)) : R;
        voffA[i] = (unsigned)(R * K + C) * 2u; voffB[i] = (unsigned)(Rb * K + C) * 2u; }
    const size_t kstep = (size_t)(BK * 2);
    const size_t hstep = (size_t)HALF * K * 2;
    const size_t tstep = 2 * hstep;
    const unsigned ldsw = (unsigned)wid * 1024u;
    const int aoff = lds_byte(wr * 64 + fr, fq * 8), boff = lds_byte(wc * 32 + fr, fq * 8);
#define PG8_SA(b, h) (((b) * 2 + (h)) * HTB)
#define PG8_SB(b, h) ((4 + (b) * 2 + (h)) * HTB)
#define PG8_STAGE(bufoff, gbase, voff) do { _Pragma("unroll") for (int _i = 0; _i < 2; ++_i) \
        __builtin_amdgcn_global_load_lds((const unsigned*)((const char*)(gbase) + (voff)[_i]), (PG8_LAS unsigned*)(lds + (bufoff) + ldsw + _i * 8192), 16, 0, 0); } while (0)
#define PG8_LDA(dst, b, h) do { _Pragma("unroll") for (int m = 0; m < 4; ++m) _Pragma("unroll") for (int k = 0; k < 2; ++k) dst[m][k] = *(const PG8_LAS bf16x8*)(lds + PG8_SA(b, h) + aoff + m * 2048 + k * 1024); } while (0)
#define PG8_LDB(dst, b, h) do { _Pragma("unroll") for (int n = 0; n < 2; ++n) _Pragma("unroll") for (int k = 0; k < 2; ++k) dst[n][k] = *(const PG8_LAS bf16x8*)(lds + PG8_SB(b, h) + boff + n * 2048 + k * 1024); } while (0)
#define PG8_MMA(ai, bj, At, Bt) do { __builtin_amdgcn_s_setprio(1); _Pragma("unroll") for (int m = 0; m < 4; ++m) _Pragma("unroll") for (int n = 0; n < 2; ++n) _Pragma("unroll") for (int k = 0; k < 2; ++k) \
        acc[ai][bj][m][n] = __builtin_amdgcn_mfma_f32_16x16x32_bf16(Bt[n][k], At[m][k], acc[ai][bj][m][n], 0, 0, 0); __builtin_amdgcn_s_setprio(0); } while (0)
#define PG8_WAIT_V(n) asm volatile("s_waitcnt vmcnt(" #n ")" ::: "memory")
#define PG8_WAIT_L(n) asm volatile("s_waitcnt lgkmcnt(" #n ")" ::: "memory")
#define PG8_BAR __builtin_amdgcn_s_barrier()
#define PG8_SCHED __builtin_amdgcn_sched_barrier(0)
    Unit cur, nxt; int ui = 0;
    if (!S.next(0, cur)) return;
    f32x4 acc[2][2][4][2];
#pragma unroll
    for (int a = 0; a < 2; ++a)
#pragma unroll
        for (int b = 0; b < 2; ++b)
#pragma unroll
            for (int m = 0; m < 4; ++m)
#pragma unroll
                for (int n = 0; n < 2; ++n) acc[a][b][m][n] = (f32x4){0.f, 0.f, 0.f, 0.f};
    bf16x8 At[4][2], B0[2][2], B1[2][2];
    const char* cA = (const char*)g.A + (size_t)cur.pm * tstep; const char* cB = (const char*)g.Bt + (size_t)cur.pn * tstep;
    S.a_ready(cur);
    if constexpr (SP2) {
        PG8_STAGE(PG8_SB(0, 0), cB, voffB); PG8_STAGE(PG8_SB(0, 1), cB + hstep, voffB); PG8_STAGE(PG8_SA(0, 0), cA, voffA); PG8_STAGE(PG8_SA(0, 1), cA + hstep, voffA);
        if (wr == 1) PG8_BAR;
        PG8_WAIT_V(2); PG8_BAR;
        PG8_STAGE(PG8_SB(1, 0), cB + kstep, voffB); PG8_STAGE(PG8_SA(1, 0), cA + kstep, voffA); PG8_STAGE(PG8_SB(1, 1), cB + hstep + kstep, voffB);
        PG8_WAIT_V(6); PG8_BAR;
    } else {
        PG8_STAGE(PG8_SB(0, 0), cB, voffB); PG8_STAGE(PG8_SA(0, 0), cA, voffA); PG8_STAGE(PG8_SB(0, 1), cB + hstep, voffB); PG8_STAGE(PG8_SA(0, 1), cA + hstep, voffA);
        if (wr == 1) PG8_BAR;
        PG8_WAIT_V(4); PG8_BAR;
        PG8_STAGE(PG8_SB(1, 0), cB + kstep, voffB); PG8_STAGE(PG8_SA(1, 0), cA + kstep, voffA); PG8_STAGE(PG8_SB(1, 1), cB + hstep + kstep, voffB);
        PG8_WAIT_V(6); PG8_BAR;
    }
    for (;;) {
        const bool has_next = S.next(ui + 1, nxt);
        const char* nA = has_next ? (const char*)g.A + (size_t)nxt.pm * tstep : cA; const char* nB = has_next ? (const char*)g.Bt + (size_t)nxt.pn * tstep : cB;
        for (int t = 0; t < nt; t += 2) {
            const bool last = (t == nt - 2);
            const char* a1 = cA + (size_t)(t + 1) * kstep;
            const char* a2 = last ? nA : cA + (size_t)(t + 2) * kstep; const char* b2 = last ? nB : cB + (size_t)(t + 2) * kstep;
            const char* a3 = a2 + kstep; const char* b3 = b2 + kstep;
            if (last && has_next) S.a_ready(nxt);
            if constexpr (SP2) {
            PG8_LDB(B0, 0, 0); PG8_LDB(B1, 0, 1); PG8_SCHED; PG8_LDA(At, 0, 0); PG8_STAGE(PG8_SA(1, 1), a1 + hstep, voffA);
            PG8_WAIT_V(8); PG8_WAIT_L(0); PG8_BAR; PG8_MMA(0, 0, At, B0); PG8_MMA(0, 1, At, B1); PG8_BAR; PG8_SCHED;
            PG8_LDA(At, 0, 1); PG8_STAGE(PG8_SB(0, 0), b2, voffB); PG8_STAGE(PG8_SB(0, 1), b2 + hstep, voffB); PG8_STAGE(PG8_SA(0, 0), a2, voffA);
            PG8_WAIT_V(8); PG8_WAIT_L(0); PG8_BAR; PG8_MMA(1, 0, At, B0); PG8_MMA(1, 1, At, B1); PG8_BAR; PG8_SCHED;
            PG8_LDB(B0, 1, 0); PG8_LDB(B1, 1, 1); PG8_SCHED; PG8_LDA(At, 1, 0); PG8_STAGE(PG8_SA(0, 1), a2 + hstep, voffA);
            PG8_WAIT_V(8); PG8_WAIT_L(0); PG8_BAR; PG8_MMA(0, 0, At, B0); PG8_MMA(0, 1, At, B1); PG8_BAR; PG8_SCHED;
            PG8_LDA(At, 1, 1); PG8_STAGE(PG8_SB(1, 0), b3, voffB); PG8_STAGE(PG8_SB(1, 1), b3 + hstep, voffB); PG8_STAGE(PG8_SA(1, 0), a3, voffA);
            PG8_WAIT_V(8); PG8_WAIT_L(0); PG8_BAR; PG8_MMA(1, 0, At, B0); PG8_MMA(1, 1, At, B1); PG8_BAR; PG8_SCHED;
            } else {
            PG8_LDB(B0, 0, 0); PG8_SCHED; PG8_LDA(At, 0, 0); PG8_STAGE(PG8_SA(1, 1), a1 + hstep, voffA);
            PG8_WAIT_L(8); PG8_BAR; PG8_WAIT_L(0); PG8_MMA(0, 0, At, B0); PG8_BAR; PG8_SCHED;
            PG8_LDB(B1, 0, 1); PG8_STAGE(PG8_SB(0, 0), b2, voffB);
            PG8_BAR; PG8_WAIT_L(0); PG8_MMA(0, 1, At, B1); PG8_BAR;
            PG8_LDA(At, 0, 1); PG8_STAGE(PG8_SA(0, 0), a2, voffA);
            PG8_BAR; PG8_WAIT_L(0); PG8_MMA(1, 0, At, B0); PG8_BAR; PG8_SCHED;
            PG8_STAGE(PG8_SB(0, 1), b2 + hstep, voffB);
            PG8_WAIT_V(6); PG8_BAR; PG8_MMA(1, 1, At, B1); PG8_BAR;
            PG8_LDB(B0, 1, 0); PG8_SCHED; PG8_LDA(At, 1, 0); PG8_STAGE(PG8_SA(0, 1), a2 + hstep, voffA);
            PG8_WAIT_L(8); PG8_BAR; PG8_WAIT_L(0); PG8_MMA(0, 0, At, B0); PG8_BAR; PG8_SCHED;
            PG8_LDB(B1, 1, 1); PG8_STAGE(PG8_SB(1, 0), b3, voffB);
            PG8_BAR; PG8_WAIT_L(0); PG8_MMA(0, 1, At, B1); PG8_BAR;
            PG8_LDA(At, 1, 1); PG8_STAGE(PG8_SA(1, 0), a3, voffA);
            PG8_BAR; PG8_WAIT_L(0); PG8_MMA(1, 0, At, B0); PG8_BAR; PG8_SCHED;
            PG8_STAGE(PG8_SB(1, 1), b3 + hstep, voffB);
            PG8_WAIT_V(6); PG8_BAR; PG8_MMA(1, 1, At, B1); PG8_BAR;
            }
        }
        if constexpr (ALIGN_EPI) { if (wr == 0) PG8_BAR; }
        if constexpr (!Epi::AFTER_DRAIN) { E(acc, cur, wr, wc, fr, fq); S.done(cur); }
        if (!has_next) break;
#pragma unroll
        for (int a = 0; a < 2; ++a)
#pragma unroll
            for (int b = 0; b < 2; ++b)
#pragma unroll
                for (int m = 0; m < 4; ++m)
#pragma unroll
                    for (int n = 0; n < 2; ++n) acc[a][b][m][n] = (f32x4){0.f, 0.f, 0.f, 0.f};
        cur = nxt; cA = nA; cB = nB; ++ui;
        if constexpr (ALIGN_EPI) { if (wr == 1) PG8_BAR; }
    }
    PG8_WAIT_V(0);
    if constexpr (!ALIGN_EPI) { if (wr == 0) PG8_BAR; }
    PG8_BAR;
    if constexpr (Epi::AFTER_DRAIN) { E.fused(acc, cur, wr, wc, fr, fq, lds, wid, lane); S.done(cur); }
#undef PG8_SA
#undef PG8_SB
#undef PG8_STAGE
#undef PG8_LDA
#undef PG8_LDB
#undef PG8_MMA
#undef PG8_WAIT_V
#undef PG8_WAIT_L
#undef PG8_BAR
#undef PG8_SCHED
}
}

struct Params {
    const float* in[22];
    float* out;
    unsigned char* ws;
    int ph_lo, ph_hi;
};
struct Ctx { LAS unsigned char* lds; int tid, lane, wave, vcu, G, gw, ngw; unsigned long long ta, tb, tc; };

__device__ __forceinline__ void p0_transpose_item(const float* W, int K, int Nreal, int thresh, const float* ksc, bf16_t* WT, LAS float* scr, int item, int nblk, int lane) {
    const int kb = item / nblk, nb = item % nblk, k0 = 64 * kb, n0 = 32 * nb;
    const int nr0 = n0 + (n0 >= thresh ? 8 : 0);
#pragma unroll 8
    for (int i = 0; i < 32; ++i) {
        const int kk = 2 * i + (lane >> 5);
        const float sc = ksc ? ksc[k0 + kk] : 1.f;
        scr[kk * 33 + (lane & 31)] = W[(size_t)(k0 + kk) * Nreal + nr0 + (lane & 31)] * sc;
    }
    LDS_WAIT(); asm volatile("" ::: "memory");
    const int c = lane & 7;
#pragma unroll
    for (int j = 0; j < 4; ++j) {
        const int n = (lane >> 3) + 8 * j; const LAS float* s = scr + (8 * c) * 33 + n;
        u32x4 o; o.x = pk2(s[0 * 33], s[1 * 33]); o.y = pk2(s[2 * 33], s[3 * 33]); o.z = pk2(s[4 * 33], s[5 * 33]); o.w = pk2(s[6 * 33], s[7 * 33]);
        *(u32x4*)(WT + (size_t)(n0 + n) * K + k0 + 8 * c) = o;
    }
    LDS_WAIT(); asm volatile("" ::: "memory");
}

__device__ __forceinline__ void phase0(const Params& p, Ctx& F) {
    const float* x = p.in[0]; const float* mixw = p.in[1]; const float* w_in = p.in[2];
    const float* w_out = p.in[16]; const float* ffnw = p.in[17]; const float* w_q = p.in[18]; const float* keys = p.in[19];
    const float* pu = p.in[20]; const float* pv = p.in[21];
    unsigned char* ws = p.ws;
    LAS float* scr = (LAS float*)(F.lds + F.wave * 8448);
    LAS float* wdt = (LAS float*)(F.lds + 69632);
    {
        constexpr int WLD = 132;
        LAS float* WQS = (LAS float*)F.lds;
        LAS float* KYS = (LAS float*)(F.lds + 64 * WLD * 4);
        bf16_t* wefft = (bf16_t*)(ws + WS_WQT);
        for (int u = F.vcu; u < 256; u += F.G) {
            const int hj = u >> 4, kt = u & 15;
            __syncthreads();
#pragma unroll
            for (int i = 0; i < 4; ++i) {
                const int pc = F.tid + 512 * i, k = pc >> 5, d4 = pc & 31;
                const f32x4 v = *(const f32x4*)(w_q + (size_t)(64 * kt + k) * 2048 + hj * 128 + d4 * 4);
                *(LAS f32x4*)(WQS + k * WLD + d4 * 4) = v * ffnw[64 * kt + k];
            }
#pragma unroll
            for (int i = 0; i < 8; ++i) {
                const int pc = F.tid + 512 * i, n = pc >> 5, d4 = pc & 31;
                *(LAS f32x4*)(KYS + n * WLD + d4 * 4) = *(const f32x4*)(keys + ((size_t)hj * 128 + n) * 128 + d4 * 4);
            }
            __syncthreads();
            const int fr_ = F.lane & 15, fq_ = F.lane >> 4, mt = F.wave >> 1, nt0 = (F.wave & 1) * 4;
            f32x4 acc[4];
#pragma unroll
            for (int q = 0; q < 4; ++q) acc[q] = (f32x4){0.f, 0.f, 0.f, 0.f};
#pragma unroll 4
            for (int ks = 0; ks < 32; ++ks) {
                const float av = WQS[(mt * 16 + fr_) * WLD + 4 * ks + fq_];
#pragma unroll
                for (int q = 0; q < 4; ++q) {
                    const float bv = KYS[((nt0 + q) * 16 + fr_) * WLD + 4 * ks + fq_];
                    acc[q] = __builtin_amdgcn_mfma_f32_16x16x4f32(av, bv, acc[q], 0, 0, 0);
                }
            }
#pragma unroll
            for (int q = 0; q < 4; ++q) {
                u32x2 w; w.x = pk2(acc[q][0], acc[q][1]); w.y = pk2(acc[q][2], acc[q][3]);
                *(u32x2*)(wefft + ((size_t)hj * 128 + (nt0 + q) * 16 + fr_) * DM + 64 * kt + mt * 16 + 4 * fq_) = w;
            }
        }
        __syncthreads();
    }
    for (int k = F.tid; k < DM; k += 512) {
        const float s = mixw[k];
        const f32x4 a = *(const f32x4*)(w_in + (size_t)k * 3080 + 1536), b = *(const f32x4*)(w_in + (size_t)k * 3080 + 1540);
        *(LAS f32x4*)(wdt + k * 8) = a * s; *(LAS f32x4*)(wdt + k * 8 + 4) = b * s;
    }
    __syncthreads();
    constexpr int I_IN = 16 * 96, I_OUT = 16 * 32;
    for (int it = F.gw; it < I_IN + I_OUT; it += F.ngw) {
        int r = it;
        if (r < I_IN) { p0_transpose_item(w_in, DM, 3080, 1536, mixw, (bf16_t*)(ws + WS_WINT), scr, r, 96, F.lane); continue; } r -= I_IN;
        p0_transpose_item(w_out, DM, DM, 1 << 30, nullptr, (bf16_t*)(ws + WS_WOUTT), scr, r, 32, F.lane);
    }
    const int gtid = F.vcu * 512 + F.tid, nthr = F.G * 512;
    for (int i = gtid; i < TOK; i += nthr) ((float*)(ws + WS_CTL) + CW_ROWSQ)[i] = 0.f;
    for (int i = gtid; i < SEQ * 8; i += nthr) {
        const int pos = i >> 3, f = i & 7;
        const float inv = powf(500000.0f, -(float)(2 * f) / 16.0f);
        const float ang = (float)pos * inv;
        ((float*)(ws + WS_ROPE))[i] = cosf(ang);
        ((float*)(ws + WS_ROPE))[SEQ * 8 + i] = sinf(ang);
    }
#if defined(PROBE_PHASE) && (PROBE_PHASE == 83 || PROBE_PHASE == 84)
    if (F.gw == 0 && F.lane == 0) { unsigned* mw = (unsigned*)(ws + WS_MISC); mw[2] = 0u; mw[3] = 0xffffffffu; mw[4] = 0u; }
#endif
    if (F.gw == 0) {
        const float a = p.in[11][F.lane] * p.in[12][F.lane], b = p.in[13][F.lane] * p.in[14][F.lane];
        const float sa = wave_sum(a), sb = wave_sum(b);
        if (F.lane == 0) ((float*)(ws + WS_MISC))[0] = expf(sa) - expf(sb) + LAMBDA_INIT;
    }
    {
        float* rsu = (float*)(ws + WS_RSU); float* rsv = (float*)(ws + WS_RSV);
        for (int r0 = F.gw; r0 < 2 * 16384; r0 += 4 * F.ngw) {
            f32x4 a[4][4]; float amax[4];
#pragma unroll
            for (int u = 0; u < 4; ++u) {
                const int r = min(r0 + u * F.ngw, 2 * 16384 - 1); const bool isU = r < 16384; const int e = r & 16383;
                const float* src = (isU ? pu : pv) + (size_t)e * DM + 16 * F.lane;
#pragma unroll
                for (int q = 0; q < 4; ++q) a[u][q] = __builtin_nontemporal_load((const f32x4*)(src + 4 * q));
            }
#pragma unroll
            for (int u = 0; u < 4; ++u) {
                const int r = min(r0 + u * F.ngw, 2 * 16384 - 1); const bool isU = r < 16384;
                amax[u] = 0.f;
#pragma unroll
                for (int q = 0; q < 4; ++q) {
                    if (isU) a[u][q] = a[u][q] * *(const f32x4*)(ffnw + 16 * F.lane + 4 * q);
                    amax[u] = fmaxf(amax[u], fmaxf(fmaxf(fabsf(a[u][q][0]), fabsf(a[u][q][1])), fmaxf(fabsf(a[u][q][2]), fabsf(a[u][q][3]))));
                }
            }
#pragma unroll
            for (int u = 0; u < 4; ++u) amax[u] = wave_max(amax[u]);
#pragma unroll
            for (int u = 0; u < 4; ++u) {
                const int r = min(r0 + u * F.ngw, 2 * 16384 - 1); const bool isU = r < 16384; const int e = r & 16383;
#ifdef U_FP4
#ifdef V_FP4
#define V_FP4_ON 1
#else
#define V_FP4_ON 0
#endif
#ifndef FP4_NIB_SWAP
#define FP4_NIB_SWAP 0
#endif
                if (isU || V_FP4_ON) {
                    const float s4 = amax[u] > 0.f ? 6.f / amax[u] : 1.f;
                    if (F.lane == 0) (isU ? rsu : rsv)[e] = amax[u] > 0.f ? amax[u] * (1.f / 6.f) : 1.f;
                    u32x2 o4;
#pragma unroll
                    for (int hq = 0; hq < 2; ++hq) {
                        unsigned w = 0u;
#pragma unroll
                        for (int q2 = 0; q2 < 2; ++q2)
#pragma unroll
                            for (int el = 0; el < 4; ++el) {
                                const float qv = a[u][hq * 2 + q2][el] * s4, m = fabsf(qv);
                                const unsigned c = (unsigned)(m > 0.25f) + (unsigned)(m > 0.75f) + (unsigned)(m > 1.25f) + (unsigned)(m > 1.75f) + (unsigned)(m > 2.5f) + (unsigned)(m > 3.5f) + (unsigned)(m > 5.0f)
                                                 + (qv < 0.f ? 8u : 0u);
                                w |= c << (4 * ((q2 * 4 + el) ^ FP4_NIB_SWAP));
                            }
                        o4[hq] = w;
                    }
                    *(u32x2*)(ws + (isU ? WS_UB : WS_VB) + (size_t)e * (DM / 2) + 8 * F.lane) = o4;
                    continue;
                }
#endif
                const float sc = amax[u] > 0.f ? 240.f / amax[u] : 1.f;
                if (F.lane == 0) (isU ? rsu : rsv)[e] = amax[u] > 0.f ? amax[u] * (1.f / 240.f) : 1.f;
                u32x4 o;
#pragma unroll
                for (int q = 0; q < 4; ++q) {
                    int pk = 0;
                    pk = __builtin_amdgcn_cvt_pk_fp8_f32(a[u][q][0] * sc, a[u][q][1] * sc, pk, false);
                    pk = __builtin_amdgcn_cvt_pk_fp8_f32(a[u][q][2] * sc, a[u][q][3] * sc, pk, true);
                    o[q] = (unsigned)pk;
                }
                *(u32x4*)(ws + (isU ? WS_UB : WS_VB) + (size_t)e * DM + 16 * F.lane) = o;
            }
        }
    }
    bf16_t* xb = (bf16_t*)(ws + WS_XB); float* dtraw = (float*)(ws + WS_DTRAW);
    for (int m0 = F.gw; m0 < TOK; m0 += 2 * F.ngw) {
        f32x4 v[2][4]; float ss[2];
#pragma unroll
        for (int u = 0; u < 2; ++u) {
            const int m = m0 + u * F.ngw; ss[u] = 0.f;
            const f32x4* xr = (const f32x4*)(x + (size_t)(m < TOK ? m : m0) * DM) + F.lane;
#pragma unroll
            for (int j = 0; j < 4; ++j) v[u][j] = __builtin_nontemporal_load(xr + 64 * j);
        }
#pragma unroll
        for (int u = 0; u < 2; ++u)
#pragma unroll
            for (int j = 0; j < 4; ++j) ss[u] += (v[u][j][0] * v[u][j][0] + v[u][j][1] * v[u][j][1]) + (v[u][j][2] * v[u][j][2] + v[u][j][3] * v[u][j][3]);
        f32x4 d0[2], d1[2];
#pragma unroll
        for (int u = 0; u < 2; ++u) { d0[u] = (f32x4){0.f, 0.f, 0.f, 0.f}; d1[u] = (f32x4){0.f, 0.f, 0.f, 0.f}; }
#pragma unroll
        for (int j = 0; j < 4; ++j)
#pragma unroll
            for (int e = 0; e < 4; ++e) {
                const int k = 256 * j + 4 * F.lane + e;
                const f32x4 w0 = *(const LAS f32x4*)(wdt + k * 8), w1 = *(const LAS f32x4*)(wdt + k * 8 + 4);
#pragma unroll
                for (int u = 0; u < 2; ++u) { d0[u] += w0 * v[u][j][e]; d1[u] += w1 * v[u][j][e]; }
            }
#pragma unroll
        for (int u = 0; u < 2; ++u) {
            ss[u] = wave_sum(ss[u]);
#pragma unroll
            for (int e = 0; e < 4; ++e) { d0[u][e] = wave_sum(d0[u][e]); d1[u][e] = wave_sum(d1[u][e]); }
        }
#pragma unroll
        for (int u = 0; u < 2; ++u) {
            const int m = m0 + u * F.ngw;
            if (m < TOK) {
                const float r = rsqrtf(ss[u] * (1.f / DM) + EPSN);
                if (F.lane == 0) ((float*)(ws + WS_RSTD))[m] = sqrtf(ss[u] * (1.f / DM) + EPSN);
                if (F.lane == 0) { *(f32x4*)(dtraw + (size_t)m * 8) = d0[u] * r; *(f32x4*)(dtraw + (size_t)m * 8 + 4) = d1[u] * r; }
                unsigned long long* o8 = (unsigned long long*)(xb + (size_t)m * DM) + F.lane;
#pragma unroll
                for (int j = 0; j < 4; ++j) o8[64 * j] = (unsigned long long)pk2(v[u][j][0] * r, v[u][j][1] * r) | ((unsigned long long)pk2(v[u][j][2] * r, v[u][j][3] * r) << 32);
            }
        }
    }
}

__device__ __forceinline__ void p2_qk_prepass(const Params& p, Ctx& F) {
    bf16_t* proj = (bf16_t*)(p.ws + WS_PROJ);
    const float* qnw = p.in[9]; const float* knw = p.in[10];
    const float* cosT = (const float*)(p.ws + WS_ROPE); const float* sinT = cosT + SEQ * 8;
    const int sub = F.lane & 7;
    float wq[8], wk[8];
#pragma unroll
    for (int e = 0; e < 8; ++e) { wq[e] = qnw[sub * 8 + e]; wk[e] = knw[sub * 8 + e]; }
    for (int base = F.gw; base < TOK * 2; base += 8 * F.ngw) {
        u32x4 raw[8];
#pragma unroll
        for (int u = 0; u < 8; ++u) {
            const int wsi = base + u * F.ngw;
            raw[u] = (wsi < TOK * 2) ? *(const u32x4*)(proj + (size_t)(wsi >> 1) * NIN + ((wsi & 1) ? PK : PQ) + F.lane * 8) : (u32x4){0u, 0u, 0u, 0u};
        }
#pragma unroll
        for (int u = 0; u < 8; ++u) {
            const int wsi = base + u * F.ngw;
            const int t = wsi >> 1, which = wsi & 1;
            float v[8];
#pragma unroll
            for (int e = 0; e < 4; ++e) { v[2 * e] = bf2f(raw[u][e] & 0xffffu); v[2 * e + 1] = bf2f(raw[u][e] >> 16); }
            float ss = 0.f;
#pragma unroll
            for (int e = 0; e < 8; ++e) ss += v[e] * v[e];
            ss += __shfl_xor(ss, 1); ss += __shfl_xor(ss, 2); ss += __shfl_xor(ss, 4);
            const float rs = rsqrtf(ss * (1.f / 64.f) + EPSN);
            const int pos = t & (SEQ - 1);
            float o[8];
#pragma unroll
            for (int e = 0; e < 8; ++e) {
                const float y = v[e] * rs * (which ? wk[e] : wq[e]);
                const float other = __shfl_xor(y, 1);
                float r = y;
                if (sub < 2) {
                    const float c = cosT[pos * 8 + e], sn = sinT[pos * 8 + e];
                    r = (sub == 0) ? (y * c - other * sn) : (other * sn + y * c);
                }
                o[e] = r;
            }
            u32x4 ov; ov.x = pk2(o[0], o[1]); ov.y = pk2(o[2], o[3]); ov.z = pk2(o[4], o[5]); ov.w = pk2(o[6], o[7]);
            if (wsi < TOK * 2) *(u32x4*)(proj + (size_t)t * NIN + (which ? PK : PQ) + F.lane * 8) = ov;
        }
    }
}

constexpr int P2_XS = 0, P2_BM = 33792, P2_CM = 51200, P2_CB = 68608, P2_MH = 85248, P2_XW = 122112, P2_ACS = 155904, P2_DT = 156928, P2_FAC = 157952;
constexpr int XS_LD = 264, BM_LD = 136, MH_LD = 72, CB_LD = 65;
static_assert(P2_FAC + 1024 <= LDS_BYTES, "P2 LDS");

__device__ __forceinline__ void p2_load_raw(const bf16_t* proj, int tid, int b, int c, int g, u32x4 (&rv)[11]) {
    const int cg = tid & 63, rg = tid >> 6, lc = cg * 8;
    const int pcol = lc < 256 ? PXS + g * 256 + lc : (lc < 384 ? PBM + g * 128 + (lc - 256) : PCM + g * 128 + (lc - 384));
#pragma unroll
    for (int i = 0; i < 11; ++i) {
        const int f = c * CHUNK + rg * 8 - 3 + i;
        u32x4 v = {0u, 0u, 0u, 0u};
        if (f >= 0) v = *(const u32x4*)(proj + ((size_t)b * SEQ + f) * NIN + pcol);
        rv[i] = v;
    }
}
__device__ __forceinline__ void p2_ssd_unit(const Params& p, Ctx& F, int b, int c, int g, u32x4 (&rv)[11], bool has_next, int nb, int nc, int ng) {
    unsigned char* ws = p.ws;
    const bf16_t* proj = (const bf16_t*)(ws + WS_PROJ);
    bf16_t* ycat = (bf16_t*)(ws + WS_YCAT); bf16_t* cmc = (bf16_t*)(ws + WS_CMC);
    bf16_t* states = (bf16_t*)(ws + WS_STATES); float* acs_g = (float*)(ws + WS_ACS); float* cdec = (float*)(ws + WS_CDEC);
    const float* dtraw = (const float*)(ws + WS_DTRAW);
    const float* conv_w = p.in[3]; const float* conv_b = p.in[4]; const float* dt_bias = p.in[5]; const float* a_log = p.in[6]; const float* d_skip = p.in[7];
    LAS bf16_t* XS = (LAS bf16_t*)(F.lds + P2_XS); LAS bf16_t* BM = (LAS bf16_t*)(F.lds + P2_BM); LAS bf16_t* CM = (LAS bf16_t*)(F.lds + P2_CM);
    LAS float* CB = (LAS float*)(F.lds + P2_CB); LAS bf16_t* MH = (LAS bf16_t*)(F.lds + P2_MH); LAS bf16_t* XW = (LAS bf16_t*)(F.lds + P2_XW);
    LAS float* ACS = (LAS float*)(F.lds + P2_ACS); LAS float* DT = (LAS float*)(F.lds + P2_DT); LAS float* FAC = (LAS float*)(F.lds + P2_FAC);
    const int tid = F.tid, lane = F.lane, wave = F.wave, fr = lane & 15, fq = lane >> 4;
    const size_t tbase = (size_t)b * SEQ + (size_t)c * CHUNK;
#ifndef SKIP_A
    {
        const int cg = tid & 63, rg = tid >> 6, lc = cg * 8;
        int pcol, dld, dcol, kind;
        if (lc < 256) { pcol = PXS + g * 256 + lc; dld = XS_LD; dcol = lc; kind = 0; }
        else if (lc < 384) { pcol = PBM + g * 128 + (lc - 256); dld = BM_LD; dcol = lc - 256; kind = 1; }
        else { pcol = PCM + g * 128 + (lc - 384); dld = BM_LD; dcol = lc - 384; kind = 2; }
        LAS bf16_t* dst = kind == 0 ? XS : (kind == 1 ? BM : CM);
        const int ch = pcol - 512;
        float cw[4][8], cbv[8];
#pragma unroll
        for (int w = 0; w < 4; ++w) {
            const f32x4 a = *(const f32x4*)(conv_w + w * 1024 + ch), bq = *(const f32x4*)(conv_w + w * 1024 + ch + 4);
#pragma unroll
            for (int e = 0; e < 4; ++e) { cw[w][e] = a[e]; cw[w][4 + e] = bq[e]; }
        }
        { const f32x4 a = *(const f32x4*)(conv_b + ch), bq = *(const f32x4*)(conv_b + ch + 4);
#pragma unroll
          for (int e = 0; e < 4; ++e) { cbv[e] = a[e]; cbv[4 + e] = bq[e]; } }
#pragma unroll
        for (int r = 0; r < 8; ++r) {
            const int l = rg * 8 + r;
            float o[8];
#pragma unroll
            for (int e = 0; e < 8; ++e) o[e] = cbv[e];
#pragma unroll
            for (int w = 0; w < 4; ++w)
#pragma unroll
                for (int e = 0; e < 4; ++e) {
                    o[2 * e] += cw[w][2 * e] * bf2f(rv[r + w][e] & 0xffffu);
                    o[2 * e + 1] += cw[w][2 * e + 1] * bf2f(rv[r + w][e] >> 16);
                }
#pragma unroll
            for (int e = 0; e < 8; ++e) o[e] = silu_f(o[e]);
            u32x4 ov; ov.x = pk2(o[0], o[1]); ov.y = pk2(o[2], o[3]); ov.z = pk2(o[4], o[5]); ov.w = pk2(o[6], o[7]);
            *(LAS u32x4*)(dst + l * dld + dcol) = ov;
            if (kind == 2) *(u32x4*)(cmc + (tbase + l) * 256 + g * 128 + dcol) = ov;
        }
    }
#endif
    if (has_next) p2_load_raw(proj, tid, nb, nc, ng, rv);
    if (tid < 256) {
        const int l = tid >> 2, h = tid & 3, hh = g * 4 + h;
        const float v = dtraw[(tbase + l) * 8 + hh] + dt_bias[hh];
        const float dt = v > 20.f ? v : log1pf(expf(v));
        DT[l * 4 + h] = dt;
        ACS[l * 4 + h] = dt * (-expf(a_log[hh]));
    }
    __syncthreads();
    if (wave < 4) {
        float s = ACS[lane * 4 + wave];
#pragma unroll
        for (int o = 1; o < 64; o <<= 1) { const float t = __shfl_up(s, o); if (lane >= o) s += t; }
        ACS[lane * 4 + wave] = s;
        if (lane == 63) cdec[((size_t)b * NCH + c) * 8 + g * 4 + wave] = expf(s);
    }
    __syncthreads();
    if (tid < 256) {
        const int l = tid >> 2, h = tid & 3;
        acs_g[(tbase + l) * 8 + g * 4 + h] = ACS[l * 4 + h];
        FAC[l * 4 + h] = DT[l * 4 + h] * expf(ACS[63 * 4 + h] - ACS[l * 4 + h]);
    }
#pragma unroll
    for (int q = 0; q < 2; ++q) {
        const int tile = wave * 2 + q, mt = tile >> 2, nt = tile & 3;
        f32x4 acc = {0.f, 0.f, 0.f, 0.f};
#pragma unroll
        for (int ks = 0; ks < 4; ++ks) {
            const bf16x8 a = *(const LAS bf16x8*)(CM + (mt * 16 + fr) * BM_LD + ks * 32 + fq * 8);
            const bf16x8 bq = *(const LAS bf16x8*)(BM + (nt * 16 + fr) * BM_LD + ks * 32 + fq * 8);
            acc = mfma16(a, bq, acc);
        }
#pragma unroll
        for (int j = 0; j < 4; ++j) CB[(mt * 16 + 4 * fq + j) * CB_LD + nt * 16 + fr] = acc[j];
    }
    __syncthreads();
    {
        const int sI = lane;
        float as_[4], ds_[4];
#pragma unroll
        for (int h = 0; h < 4; ++h) { as_[h] = ACS[sI * 4 + h]; ds_[h] = DT[sI * 4 + h]; }
#pragma unroll 2
        for (int li = 0; li < 8; ++li) {
            const int l = li * 8 + wave;
            const float cb = CB[l * CB_LD + sI];
#pragma unroll
            for (int h = 0; h < 4; ++h) {
                const float v = (sI <= l) ? cb * __expf(ACS[l * 4 + h] - as_[h]) * ds_[h] : 0.f;
                MH[(h * 64 + l) * MH_LD + sI] = (bf16_t)f2bf(v);
            }
        }
#pragma unroll
        for (int i = 0; i < 4; ++i) {
            const int pc = tid + 512 * i, l = pc >> 5, c8 = pc & 31;
            const u32x4 xv = *(const LAS u32x4*)(XS + l * XS_LD + c8 * 8);
            const float f = FAC[l * 4 + (c8 >> 3)];
            u32x4 o;
#pragma unroll
            for (int e = 0; e < 4; ++e) o[e] = pk2(bf2f(xv[e] & 0xffffu) * f, bf2f(xv[e] >> 16) * f);
            *(LAS u32x4*)(XW + l * XS_LD + c8 * 8) = o;
        }
    }
    __syncthreads();
    typedef short v4i16 __attribute__((ext_vector_type(4)));
#define TR16(PTR) __builtin_amdgcn_ds_read_tr16_b64_v4i16((LAS v4i16*)(PTR))
#define CAT8(LO, HI) (bf16x8){LO[0], LO[1], LO[2], LO[3], HI[0], HI[1], HI[2], HI[3]}
    const int trr = fr >> 2, trc = 4 * (fr & 3);
#ifndef SKIP_E
    {
        const int h = wave >> 1, hh = g * 4 + h; const float dsk = d_skip[hh];
#pragma unroll 1
        for (int mq = 0; mq < 2; ++mq) {
            const int lt = 2 * (wave & 1) + mq;
            bf16x8 bmh[2];
#pragma unroll
            for (int ks = 0; ks < 2; ++ks) bmh[ks] = *(const LAS bf16x8*)(MH + (h * 64 + lt * 16 + fr) * MH_LD + ks * 32 + fq * 8);
#pragma unroll 1
            for (int pt = 0; pt < 4; ++pt) {
                f32x4 acc = {0.f, 0.f, 0.f, 0.f};
#pragma unroll
                for (int ks = 0; ks < 2; ++ks) {
                    const LAS bf16_t* bp = XS + (ks * 32 + 8 * fq + trr) * XS_LD + h * 64 + pt * 16 + trc;
                    const v4i16 lo = TR16(bp), hi = TR16(bp + 4 * XS_LD);
                    acc = mfma16(CAT8(lo, hi), bmh[ks], acc);
                }
                const int l = lt * 16 + fr, pp = pt * 16 + 4 * fq;
                const u32x2 xv = *(const LAS u32x2*)(XS + l * XS_LD + h * 64 + pp);
                u32x2 w;
                w.x = pk2(acc[0] + bf2f(xv.x & 0xffffu) * dsk, acc[1] + bf2f(xv.x >> 16) * dsk);
                w.y = pk2(acc[2] + bf2f(xv.y & 0xffffu) * dsk, acc[3] + bf2f(xv.y >> 16) * dsk);
                *(u32x2*)(ycat + (tbase + l) * DM + g * 256 + h * 64 + pp) = w;
            }
        }
    }
#endif
#ifndef SKIP_F
    {
        const int h = wave >> 1, hh = g * 4 + h;
        bf16_t* sbase = states + (((size_t)b * NCH + c) * 8 + hh) * 64 * 128;
#pragma unroll 1
        for (int mq = 0; mq < 2; ++mq) {
            const int mt = 2 * (wave & 1) + mq;
            bf16x8 xw[2];
#pragma unroll
            for (int ks = 0; ks < 2; ++ks) {
                const LAS bf16_t* bp = XW + (ks * 32 + 8 * fq + trr) * XS_LD + h * 64 + mt * 16 + trc;
                const v4i16 lo = TR16(bp), hi = TR16(bp + 4 * XS_LD);
                xw[ks] = CAT8(lo, hi);
            }
#pragma unroll 1
            for (int nt = 0; nt < 8; ++nt) {
                f32x4 acc = {0.f, 0.f, 0.f, 0.f};
#pragma unroll
                for (int ks = 0; ks < 2; ++ks) {
                    const LAS bf16_t* ap = BM + (ks * 32 + 8 * fq + trr) * BM_LD + nt * 16 + trc;
                    const v4i16 lo = TR16(ap), hi = TR16(ap + 4 * BM_LD);
                    acc = mfma16(CAT8(lo, hi), xw[ks], acc);
                }
                u32x2 w; w.x = pk2(acc[0], acc[1]); w.y = pk2(acc[2], acc[3]);
                *(u32x2*)(sbase + (size_t)(mt * 16 + fr) * 128 + nt * 16 + 4 * fq) = w;
            }
        }
    }
#undef TR16
#undef CAT8
#endif
    __syncthreads();
}

__device__ __forceinline__ void phase2(const Params& p, Ctx& F) {
#if defined(PROBE_PHASE) && (PROBE_PHASE == 20 || PROBE_PHASE == 21)
    F.ta = __builtin_amdgcn_s_memrealtime();
#endif
#ifdef USE_QK_PREPASS
    p2_qk_prepass(p, F);
#endif
#if defined(PROBE_PHASE) && (PROBE_PHASE == 20 || PROBE_PHASE == 21)
    VM_WAIT(); F.tb = __builtin_amdgcn_s_memrealtime();
#endif
    {
        const bf16_t* proj = (const bf16_t*)(p.ws + WS_PROJ);
        u32x4 rv[11];
        if (F.vcu < NB * NCH * 2) p2_load_raw(proj, F.tid, F.vcu >> 7, (F.vcu >> 1) & 63, F.vcu & 1, rv);
        for (int u = F.vcu; u < NB * NCH * 2; u += F.G) {
            const int g = u & 1, c = (u >> 1) & 63, b = u >> 7;
            const int un = u + F.G;
            p2_ssd_unit(p, F, b, c, g, rv, un < NB * NCH * 2, un >> 7, (un >> 1) & 63, un & 1);
        }
    }
#if defined(PROBE_PHASE) && (PROBE_PHASE == 20 || PROBE_PHASE == 21)
    VM_WAIT(); F.tc = __builtin_amdgcn_s_memrealtime();
#endif
}

__device__ __forceinline__ void p3_scan(const Params& p, Ctx& F) {
    bf16_t* states = (bf16_t*)(p.ws + WS_STATES); const float* cdec = (const float*)(p.ws + WS_CDEC);
    const int gtid = F.vcu * 512 + F.tid, nthr = F.G * 512;
    for (int e = gtid; e < NB * 8 * 64 * 32; e += nthr) {
        const int n4 = e & 31, pp = (e >> 5) & 63, hh = (e >> 11) & 7, b = e >> 14;
        f32x4 carry = {0.f, 0.f, 0.f, 0.f};
        for (int c0 = 0; c0 < NCH; c0 += 16) {
            u32x2 s[16]; float dc[16];
#pragma unroll
            for (int i = 0; i < 16; ++i) {
                s[i] = *(const u32x2*)(states + ((((size_t)b * NCH + c0 + i) * 8 + hh) * 64 + pp) * 128 + n4 * 4);
                dc[i] = cdec[((size_t)b * NCH + c0 + i) * 8 + hh];
            }
#pragma unroll
            for (int i = 0; i < 16; ++i) {
                u32x2 w; w.x = pk2(carry[0], carry[1]); w.y = pk2(carry[2], carry[3]);
                *(u32x2*)(states + ((((size_t)b * NCH + c0 + i) * 8 + hh) * 64 + pp) * 128 + n4 * 4) = w;
                const f32x4 sv = {bf2f(s[i].x & 0xffffu), bf2f(s[i].x >> 16), bf2f(s[i].y & 0xffffu), bf2f(s[i].y >> 16)};
                carry = carry * dc[i] + sv;
            }
        }
    }
}

namespace att {
constexpr int NW = 8, QBLK = 32, KVBLK = 64;
constexpr float SCALE = 0.125f, THR = 8.f;
constexpr int SHM_V = KVBLK * 128 * 2, SHM_K = KVBLK * 64 * 2;
constexpr int SLOT = SHM_V + SHM_K, NSLOT = 6, LDS_WS = NSLOT * SLOT, LDS_END = LDS_WS + NW * 64 * 4;
#define KSWZ64(row, colB) ((row) * 128 + ((colB) ^ ((((row) >> 1) & 7) << 4)))
#define SBAR() __builtin_amdgcn_sched_barrier(0)
#if defined(ATT_ABL) && (ATT_ABL == 3 || ATT_ABL == 5)
#define QMMA(a, b, c) (c)
#else
#define QMMA(a, b, c) mfma32(a, b, c)
#endif
__device__ __forceinline__ int crow(int r, int hi) { return (r & 3) + 8 * (r >> 2) + 4 * hi; }
__device__ __forceinline__ unsigned cvtpk(float lo, float hi) { unsigned r; asm volatile("v_cvt_pk_bf16_f32 %0, %1, %2" : "=v"(r) : "v"(lo), "v"(hi)); return r; }

__device__ __forceinline__ void partialSM(f32x16& p0, f32x16& p1, float& m_reg, float& mn, float& alpha) {
#if defined(ATT_ABL) && (ATT_ABL == 4 || ATT_ABL == 5)
    mn = m_reg; alpha = 1.f; return;
#endif
    constexpr float C = SCALE * 1.4426950408889634f;
    float pmax = p0[0];
#pragma unroll
    for (int r = 1; r < 16; ++r) pmax = fmaxf(pmax, p0[r]);
#pragma unroll
    for (int r = 0; r < 16; ++r) pmax = fmaxf(pmax, p1[r]);
    { auto rr = __builtin_amdgcn_permlane32_swap(__float_as_uint(pmax), __float_as_uint(pmax), false, false);
      pmax = fmaxf(__uint_as_float(rr[0]), __uint_as_float(rr[1])); }
    if (__builtin_expect(__all(pmax - m_reg <= THR / SCALE), 1)) { mn = m_reg; alpha = 1.f; }
    else { mn = fmaxf(m_reg, pmax); alpha = __builtin_amdgcn_exp2f((m_reg - mn) * C); m_reg = mn; }
    const float mnC = -mn * C;
#pragma unroll
    for (int r = 0; r < 16; ++r) p0[r] = fmaf(p0[r], C, mnC);
#pragma unroll
    for (int r = 0; r < 16; ++r) p1[r] = fmaf(p1[r], C, mnC);
#if !defined(ATT_ABL) || ATT_ABL != 1
#pragma unroll
    for (int r = 0; r < 16; ++r) p0[r] = __builtin_amdgcn_exp2f(p0[r]);
#endif
}
__device__ __forceinline__ void finishSM(f32x16& p0, f32x16& p1, float alpha, float& l_reg, bf16x8& pa0, bf16x8& pa1, bf16x8& pa2, bf16x8& pa3) {
#if !defined(ATT_ABL) || (ATT_ABL != 1 && ATT_ABL != 4 && ATT_ABL != 5)
#pragma unroll
    for (int r = 0; r < 16; ++r) p1[r] = __builtin_amdgcn_exp2f(p1[r]);
#endif
    float ps = 0;
#if !defined(ATT_ABL) || (ATT_ABL != 4 && ATT_ABL != 5)
#pragma unroll
    for (int r = 0; r < 16; ++r) ps += p0[r];
#pragma unroll
    for (int r = 0; r < 16; ++r) ps += p1[r];
#endif
    { auto rr = __builtin_amdgcn_permlane32_swap(__float_as_uint(ps), __float_as_uint(ps), false, false);
      ps = __uint_as_float(rr[0]) + __uint_as_float(rr[1]); }
    l_reg = l_reg * alpha + ps;
#define PK4(P, BASE, OUT) do { unsigned a0 = cvtpk(P[BASE + 0], P[BASE + 1]), a1 = cvtpk(P[BASE + 2], P[BASE + 3]);   \
    unsigned b0 = cvtpk(P[BASE + 4], P[BASE + 5]), b1 = cvtpk(P[BASE + 6], P[BASE + 7]);                              \
    auto r0 = __builtin_amdgcn_permlane32_swap(a0, b0, false, false); auto r1 = __builtin_amdgcn_permlane32_swap(a1, b1, false, false); \
    u32x4 w = {r0[0], r1[0], r0[1], r1[1]}; OUT = *reinterpret_cast<bf16x8*>(&w); } while (0)
    PK4(p0, 0, pa0); PK4(p0, 8, pa1); PK4(p1, 0, pa2); PK4(p1, 8, pa3);
#undef PK4
}
template <int OFF> __device__ __forceinline__ bf16x8 k_read(int a) {
    bf16x8 r; asm volatile("ds_read_b128 %0, %1 offset:%2" : "=&v"(r) : "v"(a), "i"(OFF) : "memory"); return r;
}
__device__ __forceinline__ void qkt(f32x16& p0, f32x16& p1, int ks, const int (&ka)[4], const bf16x8* qr) {
    p0 = f32x16{}; p1 = f32x16{};
    const bf16x8 a0 = k_read<0>(ks + ka[0]), b0 = k_read<4096>(ks + ka[0]), a1 = k_read<0>(ks + ka[1]), b1 = k_read<4096>(ks + ka[1]);
    const bf16x8 a2 = k_read<0>(ks + ka[2]), b2 = k_read<4096>(ks + ka[2]), a3 = k_read<0>(ks + ka[3]), b3 = k_read<4096>(ks + ka[3]);
    asm volatile("s_waitcnt lgkmcnt(6)" ::: "memory"); SBAR();
    p0 = QMMA(a0, qr[0], p0); p1 = QMMA(b0, qr[0], p1);
    asm volatile("s_waitcnt lgkmcnt(4)" ::: "memory"); SBAR();
    p0 = QMMA(a1, qr[1], p0); p1 = QMMA(b1, qr[1], p1);
    asm volatile("s_waitcnt lgkmcnt(2)" ::: "memory"); SBAR();
    p0 = QMMA(a2, qr[2], p0); p1 = QMMA(b2, qr[2], p1);
    asm volatile("s_waitcnt lgkmcnt(0)" ::: "memory"); SBAR();
    p0 = QMMA(a3, qr[3], p0); p1 = QMMA(b3, qr[3], p1);
}
__device__ __forceinline__ void maskfill(f32x16& p0, f32x16& p1, bool m) {
    if (m) {
        asm volatile("; masked tile");
#pragma unroll
        for (int r = 0; r < 16; ++r) { p0[r] = -1e30f; p1[r] = -1e30f; }
    }
}
__device__ __forceinline__ int v_st(int k, int c) { const int kk = (k & ~0xC) | ((k & 4) << 1) | ((k & 8) >> 1); return ((kk >> 3) * 4 + (c >> 5)) * 512 + ((kk & 7) * 32 + (c & 31)) * 2; }
__device__ __forceinline__ int v_rd_base(int lane) { return ((lane & 3) << 3) | (((lane >> 2) & 3) << 6) | (((lane >> 4) & 1) << 5) | (((lane >> 5) & 1) << 8); }
constexpr int v_rd_off(int d0, int ks, int half) { return d0 * 512 + ks * 4096 + half * 2048; }
template <int OFF> __device__ __forceinline__ s16x4 tr_read(int vb) {
    s16x4 r; asm volatile("ds_read_b64_tr_b16 %0, %1 offset:%2" : "=&v"(r) : "v"(vb), "i"(OFF) : "memory"); return r;
}
struct VF { s16x4 l0, h0, l1, h1, l2, h2, l3, h3; };
template <int D0> __device__ __forceinline__ void v_issue(VF& f, int vb) {
    f.l0 = tr_read<v_rd_off(D0, 0, 0)>(vb); f.h0 = tr_read<v_rd_off(D0, 0, 1)>(vb); f.l1 = tr_read<v_rd_off(D0, 1, 0)>(vb); f.h1 = tr_read<v_rd_off(D0, 1, 1)>(vb);
    f.l2 = tr_read<v_rd_off(D0, 2, 0)>(vb); f.h2 = tr_read<v_rd_off(D0, 2, 1)>(vb); f.l3 = tr_read<v_rd_off(D0, 3, 0)>(vb); f.h3 = tr_read<v_rd_off(D0, 3, 1)>(vb);
}
__device__ __forceinline__ void v_mma(f32x16& od, const VF& f, bf16x8 pa0, bf16x8 pa1, bf16x8 pa2, bf16x8 pa3) {
#define PKV(L, H) (bf16x8){L[0], L[1], L[2], L[3], H[0], H[1], H[2], H[3]}
#if defined(ATT_ABL) && (ATT_ABL == 2 || ATT_ABL == 5)
    asm volatile("" :: "v"(f.l0), "v"(f.h0), "v"(f.l1), "v"(f.h1), "v"(f.l2), "v"(f.h2), "v"(f.l3), "v"(f.h3));
#else
    od = mfma32(pa0, PKV(f.l0, f.h0), od);
    od = mfma32(pa1, PKV(f.l1, f.h1), od);
    od = mfma32(pa2, PKV(f.l2, f.h2), od);
    od = mfma32(pa3, PKV(f.l3, f.h3), od);
#endif
#undef PKV
}
__device__ __forceinline__ void pv_d0(f32x16* o, int vb, bf16x8 pa0, bf16x8 pa1, bf16x8 pa2, bf16x8 pa3) {
    VF A, B;
    v_issue<0>(A, vb); v_issue<1>(B, vb);
    asm volatile("s_waitcnt lgkmcnt(8)" ::: "memory"); SBAR();
    v_mma(o[0], A, pa0, pa1, pa2, pa3); SBAR();
    v_issue<2>(A, vb);
    asm volatile("s_waitcnt lgkmcnt(8)" ::: "memory"); SBAR();
    v_mma(o[1], B, pa0, pa1, pa2, pa3); SBAR();
    v_issue<3>(B, vb);
    asm volatile("s_waitcnt lgkmcnt(8)" ::: "memory"); SBAR();
    v_mma(o[2], A, pa0, pa1, pa2, pa3);
    asm volatile("s_waitcnt lgkmcnt(0)" ::: "memory"); SBAR();
    v_mma(o[3], B, pa0, pa1, pa2, pa3);
}
__device__ __forceinline__ void m_stage(f32x16& p0, f32x16& p1, int ks, const int (&ka)[4], const bf16x8* qr, f32x16* o, int vb, bf16x8 pa0, bf16x8 pa1, bf16x8 pa2, bf16x8 pa3) {
    SBAR();
    p0 = f32x16{}; p1 = f32x16{};
    const bf16x8 a0 = k_read<0>(ks + ka[0]), b0 = k_read<4096>(ks + ka[0]), a1 = k_read<0>(ks + ka[1]), b1 = k_read<4096>(ks + ka[1]);
    const bf16x8 a2 = k_read<0>(ks + ka[2]), b2 = k_read<4096>(ks + ka[2]), a3 = k_read<0>(ks + ka[3]), b3 = k_read<4096>(ks + ka[3]);
    VF A, B;
    v_issue<0>(A, vb);
    asm volatile("s_waitcnt lgkmcnt(14)" ::: "memory"); SBAR();
    p0 = QMMA(a0, qr[0], p0); p1 = QMMA(b0, qr[0], p1);
    asm volatile("s_waitcnt lgkmcnt(12)" ::: "memory"); SBAR();
    p0 = QMMA(a1, qr[1], p0); p1 = QMMA(b1, qr[1], p1);
    asm volatile("s_waitcnt lgkmcnt(10)" ::: "memory"); SBAR();
    p0 = QMMA(a2, qr[2], p0); p1 = QMMA(b2, qr[2], p1);
    asm volatile("s_waitcnt lgkmcnt(8)" ::: "memory"); SBAR();
    p0 = QMMA(a3, qr[3], p0); p1 = QMMA(b3, qr[3], p1); SBAR();
    v_issue<1>(B, vb);
    asm volatile("s_waitcnt lgkmcnt(8)" ::: "memory"); SBAR();
    v_mma(o[0], A, pa0, pa1, pa2, pa3); SBAR();
    v_issue<2>(A, vb);
    asm volatile("s_waitcnt lgkmcnt(8)" ::: "memory"); SBAR();
    v_mma(o[1], B, pa0, pa1, pa2, pa3); SBAR();
    v_issue<3>(B, vb);
    asm volatile("s_waitcnt lgkmcnt(8)" ::: "memory"); SBAR();
    v_mma(o[2], A, pa0, pa1, pa2, pa3);
    asm volatile("s_waitcnt lgkmcnt(0)" ::: "memory"); SBAR();
    v_mma(o[3], B, pa0, pa1, pa2, pa3);
    SBAR();
}
__device__ __forceinline__ void v_stage(f32x16& p0, f32x16& p1, float& m_reg, float& l_reg, float& alpha, bf16x8& pa0, bf16x8& pa1, bf16x8& pa2, bf16x8& pa3) {
    SBAR();
    float mn;
    partialSM(p0, p1, m_reg, mn, alpha);
    finishSM(p0, p1, alpha, l_reg, pa0, pa1, pa2, pa3);
    SBAR();
}

__device__ __forceinline__ void attn_pass(const bf16_t* __restrict__ Qb, const bf16_t* __restrict__ Kh, const bf16_t* __restrict__ Vh, int NT, int my_last, LAS unsigned char* ldsl, f32x16 (&o)[4]) {
    const int tid = threadIdx.x, wid = __builtin_amdgcn_readfirstlane(tid >> 6), lane = tid & 63, r32 = lane & 31, hi = lane >> 5;
    const bool gA = wid < 4;
    char* lds = (char*)ldsl;
    float* wsf = (float*)(lds + LDS_WS) + wid * 64; float* li_l = wsf; float* al_l = wsf + 32;
    float m_reg = -1e30f, l_reg = 0.f;
#pragma unroll
    for (int d = 0; d < 4; ++d) o[d] = f32x16{};
    bf16x8 qr[4];
    const bf16_t* Qw = Qb + (size_t)(wid * QBLK + r32) * NIN + hi * 8;
#pragma unroll
    for (int d0 = 0; d0 < 4; ++d0) qr[d0] = *reinterpret_cast<const bf16x8*>(Qw + d0 * 16);
    const int krow = 8 * wid + (lane >> 3);
    const unsigned kofs = (unsigned)(krow * NIN + (((lane & 7) ^ ((krow >> 1) & 7)) * 8)) * 2u;
    const int kk = 8 * wid + ((lane >> 2) & 7), vk = (kk & ~0xC) | ((kk & 4) << 1) | ((kk & 8) >> 1);
    const unsigned vofs = (unsigned)(vk * NIN + (lane >> 5) * 32 + (lane & 3) * 8) * 2u;
    const int vb0 = (int)(uintptr_t)lds + v_rd_base(lane), kb0 = (int)(uintptr_t)lds + SHM_V;
    int ka[4];
#pragma unroll
    for (int d0 = 0; d0 < 4; ++d0) ka[d0] = KSWZ64(r32, (d0 * 16 + hi * 8) * 2);
#define SOFF(t) ((int)((unsigned)(t) % (unsigned)NSLOT) * SLOT)
#define DMA(t) do { const size_t g_ = (size_t)(t) * (size_t)(KVBLK * NIN * 2); LAS unsigned char* d_ = ldsl + SOFF(t); \
    __builtin_amdgcn_global_load_lds((const GAS unsigned*)((const char*)Vh + g_ + vofs), (LAS unsigned*)(d_ + wid * 2048), 16, 0, 0); \
    __builtin_amdgcn_global_load_lds((const GAS unsigned*)((const char*)Vh + g_ + vofs + 128), (LAS unsigned*)(d_ + wid * 2048 + 1024), 16, 0, 0); \
    __builtin_amdgcn_global_load_lds((const GAS unsigned*)((const char*)Kh + g_ + kofs), (LAS unsigned*)(d_ + SHM_V + wid * 1024), 16, 0, 0); } while (0)
#define KS(t) (kb0 + SOFF(t))
#define VB(t) (vb0 + SOFF(t))
#define WBAR() do { asm volatile("" ::: "memory"); __builtin_amdgcn_s_barrier(); asm volatile("" ::: "memory"); } while (0)
#define EVENT(e) do { if ((e) + 3 < NT) asm volatile("s_waitcnt vmcnt(3)" ::: "memory"); else asm volatile("s_waitcnt vmcnt(0)" ::: "memory"); \
    WBAR(); if ((e) + 4 < NT) DMA((e) + 4); } while (0)
#define MID(t) do { if (!gA && (t) <= NT - 2) EVENT((t) - 1); } while (0)
#define END(t) do { if (gA && (t) <= NT - 3) EVENT(t); } while (0)
#define RESC(a) do { if (__any((a) < 1.f)) { if (hi == 0) al_l[r32] = (a); asm volatile("s_waitcnt lgkmcnt(0)" ::: "memory"); \
    _Pragma("unroll") for (int d = 0; d < 4; ++d) _Pragma("unroll") for (int r = 0; r < 16; ++r) o[d][r] *= al_l[crow(r, hi)]; } } while (0)
    f32x16 pA0, pA1, pB0, pB1; float al; bf16x8 pa0, pa1, pa2, pa3;
    __syncthreads();
    DMA(0); DMA(1); DMA(2); DMA(3);
    asm volatile("s_waitcnt vmcnt(9)" ::: "memory"); WBAR();
    if (gA) { asm volatile("s_waitcnt vmcnt(6)" ::: "memory"); WBAR(); }
    qkt(pA0, pA1, KS(0), ka, qr);
    if (!gA) { asm volatile("s_waitcnt vmcnt(6)" ::: "memory"); WBAR(); }
    END(0);
    qkt(pB0, pB1, KS(1), ka, qr); maskfill(pB0, pB1, 1 > my_last);
    MID(1);
    v_stage(pA0, pA1, m_reg, l_reg, al, pa0, pa1, pa2, pa3);
    END(1);
    for (int t = 2; t < NT; t += 2) {
        m_stage(pA0, pA1, KS(t), ka, qr, o, VB(t - 2), pa0, pa1, pa2, pa3); maskfill(pA0, pA1, t > my_last);
        MID(t);
        v_stage(pB0, pB1, m_reg, l_reg, al, pa0, pa1, pa2, pa3); RESC(al);
        END(t);
        m_stage(pB0, pB1, KS(t + 1), ka, qr, o, VB(t - 1), pa0, pa1, pa2, pa3); maskfill(pB0, pB1, t + 1 > my_last);
        MID(t + 1);
        v_stage(pA0, pA1, m_reg, l_reg, al, pa0, pa1, pa2, pa3); RESC(al);
        END(t + 1);
    }
    pv_d0(o, VB(NT - 2), pa0, pa1, pa2, pa3);
    v_stage(pB0, pB1, m_reg, l_reg, al, pa0, pa1, pa2, pa3); RESC(al);
    pv_d0(o, VB(NT - 1), pa0, pa1, pa2, pa3);
    if (hi == 0) li_l[r32] = l_reg;
    asm volatile("s_waitcnt lgkmcnt(0)" ::: "memory");
#pragma unroll
    for (int r = 0; r < 16; ++r) {
        const float rl = __builtin_amdgcn_rcpf(li_l[crow(r, hi)]);
#pragma unroll
        for (int d = 0; d < 4; ++d) o[d][r] *= rl;
    }
    asm volatile("s_waitcnt vmcnt(0)" ::: "memory");
    __syncthreads();
#undef SOFF
#undef DMA
#undef KS
#undef VB
#undef WBAR
#undef EVENT
#undef MID
#undef END
#undef RESC
}
}

__device__ __forceinline__ void p3_attn_unit(const Params& p, Ctx& F, int b, int h, int qb, float* oscr) {
    const bf16_t* proj = (const bf16_t*)(p.ws + WS_PROJ);
    bf16_t* ycat = (bf16_t*)(p.ws + WS_YCAT);
    const float lam = ((const float*)(p.ws + WS_MISC))[0];
    const float* subw = p.in[15];
    const int tid = F.tid, wid = F.wave, lane = F.lane, r32 = lane & 31, hi = lane >> 5;
    const size_t rowbase = (size_t)b * SEQ; const int q0 = qb * 256;
    const int NT = (q0 + 256) / 64, my_last = (q0 + 32 * wid) / 64;
    f32x16 o[4];
    for (int j = 0; j < 2; ++j) {
        const bf16_t* Qb = proj + (rowbase + q0) * NIN + PQ + h * 128 + j * 64;
        const bf16_t* Kh = proj + rowbase * NIN + PK + h * 128 + j * 64;
        const bf16_t* Vh = proj + rowbase * NIN + PV + h * 128;
        att::attn_pass(Qb, Kh, Vh, NT, my_last, F.lds, o);
        if (j == 0) {
            float* my = oscr + tid * 64;
#pragma unroll
            for (int d = 0; d < 4; ++d)
#pragma unroll
                for (int r4 = 0; r4 < 4; ++r4) *(f32x4*)(my + d * 16 + r4 * 4) = (f32x4){o[d][4 * r4], o[d][4 * r4 + 1], o[d][4 * r4 + 2], o[d][4 * r4 + 3]};
        }
    }
    float wv[4];
#pragma unroll
    for (int d = 0; d < 4; ++d) wv[d] = subw[d * 32 + r32] * (1.f - LAMBDA_INIT);
#pragma unroll
    for (int r = 0; r < 16; ++r) {
        float v[4]; float ss = 0.f;
#pragma unroll
        for (int d = 0; d < 4; ++d) { v[d] = oscr[tid * 64 + d * 16 + r] - lam * o[d][r]; ss += v[d] * v[d]; }
        ss += __shfl_xor(ss, 1); ss += __shfl_xor(ss, 2); ss += __shfl_xor(ss, 4); ss += __shfl_xor(ss, 8); ss += __shfl_xor(ss, 16);
        const float rs = rsqrtf(ss * (1.f / 128.f) + EPSN);
        const size_t row = rowbase + q0 + wid * 32 + att::crow(r, hi);
#pragma unroll
        for (int d = 0; d < 4; ++d) ycat[row * DM + 512 + h * 128 + d * 32 + r32] = (bf16_t)f2bf(v[d] * rs * wv[d]);
    }
}

__device__ __forceinline__ void phase3(const Params& p, Ctx& F) {
#if defined(PROBE_PHASE) && (PROBE_PHASE == 30 || PROBE_PHASE == 31)
    F.ta = __builtin_amdgcn_s_memrealtime();
#endif
    p3_scan(p, F);
#if defined(PROBE_PHASE) && (PROBE_PHASE == 30 || PROBE_PHASE == 31)
    VM_WAIT(); F.tb = __builtin_amdgcn_s_memrealtime();
#endif
#ifdef ATT_ABL
    float* oscr = (float*)(p.ws + WS_GW) + (size_t)F.vcu * (64 * 512);
#else
    float* oscr = p.out + (size_t)F.vcu * (64 * 512);
#endif
    for (int ui = F.vcu; ui < 512; ui += F.G) {
        const int pi = ui & 255, bh = pi >> 3, s = pi & 7, b = bh >> 2, h = bh & 3;
        p3_attn_unit(p, F, b, h, ui < 256 ? 15 - s : s, oscr);
    }
#if defined(PROBE_PHASE) && (PROBE_PHASE == 30 || PROBE_PHASE == 31)
    VM_WAIT(); F.tc = __builtin_amdgcn_s_memrealtime();
#endif
}

constexpr int P4_PREV = 0, P4_CM = 69632, P4_ACS = 87040, P4_Y = 88064, Y_LD = 257;
static_assert(P4_Y + 64 * Y_LD * 4 <= LDS_BYTES, "P4 LDS");
__device__ __forceinline__ void p4_load(const bf16_t* states, const bf16_t* cmc, int tid, int b, int c, int g, u32x4 (&pv)[8], u32x4 (&cv)[2]) {
    const size_t tbase = (size_t)b * SEQ + (size_t)c * CHUNK;
#pragma unroll
    for (int i = 0; i < 8; ++i) {
        const int e = tid + 512 * i, n8 = e & 15, pp = (e >> 4) & 63, h = e >> 10;
        pv[i] = *(const u32x4*)(states + ((((size_t)b * NCH + c) * 8 + g * 4 + h) * 64 + pp) * 128 + n8 * 8);
    }
#pragma unroll
    for (int i = 0; i < 2; ++i) {
        const int e = tid + 512 * i, l = e >> 4, c8 = e & 15;
        cv[i] = *(const u32x4*)(cmc + (tbase + l) * 256 + g * 128 + c8 * 8);
    }
}
__device__ __forceinline__ void p4_unit(const Params& p, Ctx& F, int b, int c, int g, u32x4 (&pv)[8], u32x4 (&cv)[2], bool has_next, int nb, int nc, int ng) {
    unsigned char* ws = p.ws;
    const bf16_t* proj = (const bf16_t*)(ws + WS_PROJ);
    bf16_t* ycat = (bf16_t*)(ws + WS_YCAT); const bf16_t* cmc = (const bf16_t*)(ws + WS_CMC);
    const bf16_t* states = (const bf16_t*)(ws + WS_STATES); const float* acs_g = (const float*)(ws + WS_ACS);
    const float* normw = p.in[8];
    LAS bf16_t* PREV = (LAS bf16_t*)(F.lds + P4_PREV); LAS bf16_t* CM = (LAS bf16_t*)(F.lds + P4_CM);
    LAS float* ACS = (LAS float*)(F.lds + P4_ACS); LAS float* Y = (LAS float*)(F.lds + P4_Y);
    const int tid = F.tid, lane = F.lane, wave = F.wave, fr = lane & 15, fq = lane >> 4;
    const size_t tbase = (size_t)b * SEQ + (size_t)c * CHUNK;
#pragma unroll
    for (int i = 0; i < 8; ++i) {
        const int e = tid + 512 * i, n8 = e & 15, pp = (e >> 4) & 63, h = e >> 10;
        *(LAS u32x4*)(PREV + (h * 64 + pp) * BM_LD + n8 * 8) = pv[i];
    }
#pragma unroll
    for (int i = 0; i < 2; ++i) {
        const int e = tid + 512 * i, l = e >> 4, c8 = e & 15;
        *(LAS u32x4*)(CM + l * BM_LD + c8 * 8) = cv[i];
    }
    if (has_next) p4_load(states, cmc, tid, nb, nc, ng, pv, cv);
    if (tid < 256) { const int l = tid >> 2, h = tid & 3; ACS[l * 4 + h] = acs_g[(tbase + l) * 8 + g * 4 + h]; }
    __syncthreads();
    {
        const int h = wave >> 1;
#pragma unroll
        for (int mq = 0; mq < 2; ++mq) {
            const int mt = 2 * (wave & 1) + mq;
            bf16x8 a[4];
#pragma unroll
            for (int ks = 0; ks < 4; ++ks) a[ks] = *(const LAS bf16x8*)(CM + (mt * 16 + fr) * BM_LD + ks * 32 + fq * 8);
#pragma unroll
            for (int nt = 0; nt < 4; ++nt) {
                f32x4 acc = {0.f, 0.f, 0.f, 0.f};
#pragma unroll
                for (int ks = 0; ks < 4; ++ks) {
                    const bf16x8 bq = *(const LAS bf16x8*)(PREV + (h * 64 + nt * 16 + fr) * BM_LD + ks * 32 + fq * 8);
                    acc = mfma16(a[ks], bq, acc);
                }
#pragma unroll
                for (int j = 0; j < 4; ++j) {
                    const int l = mt * 16 + 4 * fq + j, col = h * 64 + nt * 16 + fr;
                    Y[l * Y_LD + col] = acc[j] * __expf(ACS[l * 4 + h]);
                }
            }
        }
    }
    __syncthreads();
    {
        const int c8 = lane & 31, hr = lane >> 5;
        const f32x4 nw0 = *(const f32x4*)(normw + g * 256 + c8 * 8), nw1 = *(const f32x4*)(normw + g * 256 + c8 * 8 + 4);
#pragma unroll 2
        for (int r = 0; r < 4; ++r) {
            const int l = wave * 8 + r * 2 + hr;
            const size_t t = tbase + l;
            const u32x4 yl = *(const u32x4*)(ycat + t * DM + g * 256 + c8 * 8);
            const u32x4 zz = *(const u32x4*)(proj + t * NIN + PZ + g * 256 + c8 * 8);
            float v[8]; float ss = 0.f;
#pragma unroll
            for (int e = 0; e < 4; ++e) {
                const float y0 = bf2f(yl[e] & 0xffffu) + Y[l * Y_LD + c8 * 8 + 2 * e], y1 = bf2f(yl[e] >> 16) + Y[l * Y_LD + c8 * 8 + 2 * e + 1];
                v[2 * e] = y0 * silu_f(bf2f(zz[e] & 0xffffu)); v[2 * e + 1] = y1 * silu_f(bf2f(zz[e] >> 16));
                ss += v[2 * e] * v[2 * e] + v[2 * e + 1] * v[2 * e + 1];
            }
            ss += __shfl_xor(ss, 1); ss += __shfl_xor(ss, 2); ss += __shfl_xor(ss, 4); ss += __shfl_xor(ss, 8); ss += __shfl_xor(ss, 16);
            const float rs = rsqrtf(ss * (1.f / 256.f) + EPSN);
            u32x4 o;
            o.x = pk2(v[0] * rs * nw0[0], v[1] * rs * nw0[1]); o.y = pk2(v[2] * rs * nw0[2], v[3] * rs * nw0[3]);
            o.z = pk2(v[4] * rs * nw1[0], v[5] * rs * nw1[1]); o.w = pk2(v[6] * rs * nw1[2], v[7] * rs * nw1[3]);
            *(u32x4*)(ycat + t * DM + g * 256 + c8 * 8) = o;
        }
    }
    __syncthreads();
}
__device__ __forceinline__ void phase4(const Params& p, Ctx& F) {
    const bf16_t* states = (const bf16_t*)(p.ws + WS_STATES); const bf16_t* cmc = (const bf16_t*)(p.ws + WS_CMC);
    u32x4 pv[8], cv[2];
    if (F.vcu < NB * NCH * 2) p4_load(states, cmc, F.tid, F.vcu >> 7, (F.vcu >> 1) & 63, F.vcu & 1, pv, cv);
    for (int u = F.vcu; u < NB * NCH * 2; u += F.G) {
        const int g = u & 1, c = (u >> 1) & 63, b = u >> 7;
        const int un = u + F.G;
        p4_unit(p, F, b, c, g, pv, cv, un < NB * NCH * 2, un >> 7, (un >> 1) & 63, un & 1);
    }
}

__device__ __forceinline__ unsigned f2ord(float f) { const unsigned u = __float_as_uint(f); return (u >> 31) ? ~u : (u | 0x80000000u); }
__device__ __forceinline__ float ord2f(unsigned u) { return __uint_as_float((u >> 31) ? (u & 0x7fffffffu) : ~u); }
#define CE_DESC(A, B) do { const unsigned hi_ = (A) > (B) ? (A) : (B); const unsigned lo_ = (A) > (B) ? (B) : (A); (A) = hi_; (B) = lo_; } while (0)
template <int K, int J> __device__ __forceinline__ void bstage(unsigned (&r)[16]) {
#pragma unroll
    for (int i = 0; i < 16; ++i) { const int l = i ^ J; if (l > i) { if ((i & K) == 0) CE_DESC(r[i], r[l]); else CE_DESC(r[l], r[i]); } }
}
__device__ __forceinline__ void bitonic_merge16(unsigned (&r)[16]) { bstage<16, 8>(r); bstage<16, 4>(r); bstage<16, 2>(r); bstage<16, 1>(r); }
__device__ __forceinline__ void bitonic_sort16(unsigned (&r)[16]) {
    bstage<2, 1>(r); bstage<4, 2>(r); bstage<4, 1>(r); bstage<8, 4>(r); bstage<8, 2>(r); bstage<8, 1>(r); bitonic_merge16(r);
}
__device__ __forceinline__ void top16_merge(unsigned (&r)[16], const unsigned (&n)[16]) {
#pragma unroll
    for (int i = 0; i < 16; ++i) r[i] = r[i] > n[15 - i] ? r[i] : n[15 - i];
    bitonic_merge16(r);
}
template <int XM> __device__ __forceinline__ unsigned quad_xor(unsigned v) {
    static_assert(XM == 1 || XM == 2, "quad permute");
    return (unsigned)__builtin_amdgcn_mov_dpp((int)v, XM == 1 ? 0xB1 : 0x4E, 0xf, 0xf, true);
}
template <int XM> __device__ __forceinline__ void top16_merge_lane_t(unsigned (&r)[16]) {
    unsigned n[16];
#pragma unroll
    for (int i = 0; i < 16; ++i) n[i] = quad_xor<XM>(r[i]);
    top16_merge(r, n);
}
__device__ __forceinline__ void top16_merge_lane(unsigned (&r)[16], int xm) {
    if (xm == 1) top16_merge_lane_t<1>(r); else top16_merge_lane_t<2>(r);
}
__device__ __forceinline__ void p7_cand_table(LAS unsigned char* CAND, int tid) {
    if (tid < 52) {
        int c = 0; unsigned char v = 255;
        for (int a = 0; a < 16; ++a) for (int b = 0; b < 16 / (a + 1); ++b) { if (c == tid) v = (unsigned char)(a * 16 + b); ++c; }
        CAND[tid] = v;
    }
}
__device__ __forceinline__ void route16(const bf16_t* qp, const float* rowsq, float* gwo, size_t t0, int lane, LAS unsigned* lists, const LAS unsigned char* CAND, LAS unsigned short* IDX) {
    const int tok = lane >> 2, part = lane & 3;
    const float r2 = rsqrtf(rowsq[t0 + tok] * (1.f / DM) + EPSN);
    u32x4 nxt[2][4];
#pragma unroll
    for (int j = 0; j < 2; ++j)
#pragma unroll
        for (int q = 0; q < 4; ++q) nxt[j][q] = __builtin_nontemporal_load((const u32x4*)(qp + (t0 + tok) * 2048 + j * 128 + part * 32 + q * 8));
#pragma unroll 1
    for (int h = 0; h < 8; ++h) {
        u32x4 raw[2][4];
#pragma unroll
        for (int j = 0; j < 2; ++j)
#pragma unroll
            for (int q = 0; q < 4; ++q) raw[j][q] = nxt[j][q];
        if (h < 7) {
#pragma unroll
            for (int j = 0; j < 2; ++j)
#pragma unroll
                for (int q = 0; q < 4; ++q) nxt[j][q] = __builtin_nontemporal_load((const u32x4*)(qp + (t0 + tok) * 2048 + (h + 1) * 256 + j * 128 + part * 32 + q * 8));
        }
#pragma unroll
        for (int j = 0; j < 2; ++j) {
            unsigned r[16], n[16];
#pragma unroll
            for (int q = 0; q < 2; ++q)
#pragma unroll
                for (int e = 0; e < 4; ++e) {
                    r[q * 8 + 2 * e]     = (f2ord(bf2f(raw[j][q][e] & 0xffffu) * r2) & ~127u) | (unsigned)(part * 32 + q * 8 + 2 * e);
                    r[q * 8 + 2 * e + 1] = (f2ord(bf2f(raw[j][q][e] >> 16) * r2) & ~127u) | (unsigned)(part * 32 + q * 8 + 2 * e + 1);
                    n[q * 8 + 2 * e]     = (f2ord(bf2f(raw[j][2 + q][e] & 0xffffu) * r2) & ~127u) | (unsigned)(part * 32 + 16 + q * 8 + 2 * e);
                    n[q * 8 + 2 * e + 1] = (f2ord(bf2f(raw[j][2 + q][e] >> 16) * r2) & ~127u) | (unsigned)(part * 32 + 16 + q * 8 + 2 * e + 1);
                }
            bitonic_sort16(r); bitonic_sort16(n);
            top16_merge(r, n);
            top16_merge_lane(r, 1);
            top16_merge_lane(r, 2);
            if (part == 0) {
#pragma unroll
                for (int k = 0; k < 16; ++k) lists[(tok * 2 + j) * 16 + k] = r[k];
            }
        }
        LDS_WAIT(); __builtin_amdgcn_wave_barrier();
        {
            const LAS unsigned* l0 = lists + (2 * tok) * 16; const LAS unsigned* l1 = lists + (2 * tok + 1) * 16;
            unsigned r[16];
#pragma unroll
            for (int m = 0; m < 13; ++m) {
                const unsigned ab = CAND[part + 4 * m];
                const unsigned a = (ab >> 4) & 15u, bb = ab & 15u;
                const float sum = ord2f(l0[a] & ~127u) + ord2f(l1[bb] & ~127u);
                r[m] = ab == 255u ? 0u : ((f2ord(sum) & ~255u) | ab);
            }
            r[13] = 0u; r[14] = 0u; r[15] = 0u;
            bitonic_sort16(r);
            top16_merge_lane(r, 1);
            top16_merge_lane(r, 2);
            float val[16]; unsigned ex[16]; float mx = -1e30f;
#pragma unroll
            for (int k = 0; k < 16; ++k) {
                const unsigned pos = r[k] & 255u, a = pos >> 4, bb = pos & 15u;
                const unsigned w0 = l0[a], w1 = l1[bb];
                ex[k] = (w0 & 127u) * 128u + (w1 & 127u);
                val[k] = ord2f(w0 & ~127u) + ord2f(w1 & ~127u);
                mx = fmaxf(mx, val[k]);
            }
            float sum = 0.f;
#pragma unroll
            for (int k = 0; k < 16; ++k) { val[k] = __expf(val[k] - mx); sum += val[k]; }
            const float inv = __builtin_amdgcn_rcpf(sum);
            float* go = gwo + ((t0 + tok) * 8 + h) * 16;
            if (part == 0) {
#pragma unroll
                for (int k = 0; k < 16; ++k) { IDX[tok * 128 + h * 16 + k] = (unsigned short)ex[k]; go[k] = val[k] * inv; }
            }
        }
        LDS_WAIT(); __builtin_amdgcn_wave_barrier();
    }
}

__device__ __forceinline__ void xcd_pace(const XcdBarrier& b, int slot) {
    __syncthreads();
    if (threadIdx.x == 0) {
        const unsigned nloc = b.st[0];
        unsigned* w = b.bar + XCD_BAR_WORDS + (slot * 16 + (int)b.x) * 16;
        (void)xb_add(w, 1u);
        unsigned sp = 0;
        while (xb_ld(w) < nloc && ++sp < 3000u) __builtin_amdgcn_s_sleep(1);
    }
    __syncthreads();
}
__device__ __forceinline__ float gelu_erf(float x) { return 0.5f * x * (1.f + erff(x * 0.70710678118654752f)); }
typedef float f32x2 __attribute__((ext_vector_type(2)));
constexpr int P8_NSL = 8, P8_SLC = DM / P8_NSL, P8_KS = P8_SLC / 32;
constexpr float P8_XS = 32.f;
static_assert(P8_SLC == 128, "lane mappings assume 128-column (128-byte) slices");
__device__ __forceinline__ void phase8(const Params& p, Ctx& F, const XcdBarrier& bar) {
    const bool pace = false;
    unsigned char* ws = p.ws;
    const unsigned char* uq = ws + WS_UB; const unsigned char* vq = ws + WS_VB;
    const float* rsu = (const float*)(ws + WS_RSU); const float* rsv = (const float*)(ws + WS_RSV);
    const bf16_t* x1b = (const bf16_t*)(ws + WS_X1B);
    const float* rowsq = (const float*)(ws + WS_CTL) + CW_ROWSQ;
    const float* gwi = (const float*)(ws + WS_GW);
    float* out = p.out;
    const int lane = F.lane, fr = lane & 15, fq = lane >> 4;
    LAS unsigned short* IDX = (LAS unsigned short*)(F.lds + F.wave * 20480);
    LAS float* COEF = (LAS float*)(F.lds + F.wave * 20480 + 4096);
    LAS unsigned char* STG = (LAS unsigned char*)COEF;
    LAS unsigned char* CAND = STG + 2048;
    __syncthreads();
    p7_cand_table(CAND, lane);
    LDS_WAIT(); __builtin_amdgcn_wave_barrier();
    for (int task = F.gw; task < TOK / 16; task += F.ngw) {
        const size_t t0 = (size_t)task * 16;
#if defined(PROBE_PHASE) && PROBE_PHASE == 82
        F.ta = __builtin_amdgcn_s_memrealtime();
#endif
        route16((const bf16_t*)(ws + WS_QP), rowsq, (float*)(ws + WS_GW), t0, lane, (LAS unsigned*)STG, CAND, IDX);
#if defined(PROBE_PHASE) && PROBE_PHASE == 82
        F.tb = __builtin_amdgcn_s_memrealtime();
#endif
        const float r2 = rsqrtf(rowsq[t0 + fr] * (1.f / DM) + EPSN);
        VM_WAIT(); LDS_WAIT(); __builtin_amdgcn_wave_barrier();
#if defined(PROBE_PHASE) && (PROBE_PHASE == 80 || PROBE_PHASE == 81)
        F.ta = __builtin_amdgcn_s_memrealtime();
#endif
        f32x4 accU[8];
#pragma unroll
        for (int h = 0; h < 8; ++h) accU[h] = (f32x4){0.f, 0.f, 0.f, 0.f};
        const int lrow = lane >> 3, lch = lane & 7;
        const int wofs0 = lrow * 128 + ((lch ^ (lrow & 7)) << 4), wofs1 = wofs0 + 1024;
        const float xsc = r2 * P8_XS;
#ifdef U_FP4
        typedef int v8i __attribute__((ext_vector_type(8)));
        int rofs4[2];
#pragma unroll
        for (int m = 0; m < 2; ++m) rofs4[m] = fr * 128 + (((4 * m + fq) ^ (fr & 7)) << 4);
#pragma unroll 1
        for (int sl = 0; sl < 4; ++sl) {
            v8i xf[2];
#pragma unroll
            for (int m = 0; m < 2; ++m) {
                const bf16_t* xp = x1b + (t0 + fr) * DM + sl * 256 + 128 * m + 16 * fq;
#pragma unroll
                for (int q = 0; q < 4; ++q) {
                    const u32x4 xv = *(const u32x4*)(xp + 64 * (q >> 1) + 8 * (q & 1));
                    int lo = 0, hi = 0;
                    lo = __builtin_amdgcn_cvt_pk_fp8_f32(bf2f(xv[0] & 0xffffu) * xsc, bf2f(xv[0] >> 16) * xsc, lo, false);
                    lo = __builtin_amdgcn_cvt_pk_fp8_f32(bf2f(xv[1] & 0xffffu) * xsc, bf2f(xv[1] >> 16) * xsc, lo, true);
                    hi = __builtin_amdgcn_cvt_pk_fp8_f32(bf2f(xv[2] & 0xffffu) * xsc, bf2f(xv[2] >> 16) * xsc, hi, false);
                    hi = __builtin_amdgcn_cvt_pk_fp8_f32(bf2f(xv[3] & 0xffffu) * xsc, bf2f(xv[3] >> 16) * xsc, hi, true);
                    xf[m][2 * q] = lo; xf[m][2 * q + 1] = hi;
                }
            }
            const unsigned char* ubs = uq + sl * 128 + lch * 16;
#pragma unroll 1
            for (int j0 = 0; j0 < 16; ++j0) {
                const bool mine = (fr == j0);
                v8i bm[2];
#pragma unroll
                for (int m = 0; m < 2; ++m)
#pragma unroll
                    for (int q = 0; q < 8; ++q) bm[m][q] = mine ? xf[m][q] : 0;
                u32x4 g0[8], g1[8];
#pragma unroll
                for (int h = 0; h < 8; ++h) {
                    const unsigned e0 = IDX[j0 * 128 + h * 16 + lrow], e1 = IDX[j0 * 128 + h * 16 + lrow + 8];
                    g0[h] = *(const u32x4*)(ubs + (size_t)e0 * (DM / 2));
                    g1[h] = *(const u32x4*)(ubs + (size_t)e1 * (DM / 2));
                }
#pragma unroll
                for (int hg = 0; hg < 2; ++hg) {
#pragma unroll
                    for (int h = 0; h < 4; ++h) {
                        *(LAS u32x4*)(STG + h * 2048 + wofs0) = g0[hg * 4 + h];
                        *(LAS u32x4*)(STG + h * 2048 + wofs1) = g1[hg * 4 + h];
                    }
                    __builtin_amdgcn_wave_barrier();
#pragma unroll
                    for (int h = 0; h < 4; ++h)
#pragma unroll
                        for (int m = 0; m < 2; ++m) {
                            const u32x4 a16 = *(const LAS u32x4*)(STG + h * 2048 + rofs4[m]);
                            const v8i av = {(int)a16.x, (int)a16.y, (int)a16.z, (int)a16.w, 0, 0, 0, 0};
                            accU[hg * 4 + h] = __builtin_amdgcn_mfma_scale_f32_16x16x128_f8f6f4(av, bm[m], accU[hg * 4 + h], 4, 0, 0, 0, 0, 0);
                        }
                    __builtin_amdgcn_wave_barrier();
                }
            }
        }
#else
        int rofs[P8_KS];
#pragma unroll
        for (int ks = 0; ks < P8_KS; ++ks) rofs[ks] = fr * 128 + (((2 * ks + (fq >> 1)) ^ (fr & 7)) << 4) + (fq & 1) * 8;
#pragma unroll 1
        for (int sl = 0; sl < P8_NSL; ++sl) {
            if (pace) xcd_pace(bar, sl);
            long xf[P8_KS];
#pragma unroll
            for (int ks = 0; ks < P8_KS; ++ks) {
                const u32x4 xv = *(const u32x4*)(x1b + (t0 + fr) * DM + sl * P8_SLC + ks * 32 + 8 * fq);
                int lo = 0, hi = 0;
                lo = __builtin_amdgcn_cvt_pk_fp8_f32(bf2f(xv[0] & 0xffffu) * xsc, bf2f(xv[0] >> 16) * xsc, lo, false);
                lo = __builtin_amdgcn_cvt_pk_fp8_f32(bf2f(xv[1] & 0xffffu) * xsc, bf2f(xv[1] >> 16) * xsc, lo, true);
                hi = __builtin_amdgcn_cvt_pk_fp8_f32(bf2f(xv[2] & 0xffffu) * xsc, bf2f(xv[2] >> 16) * xsc, hi, false);
                hi = __builtin_amdgcn_cvt_pk_fp8_f32(bf2f(xv[3] & 0xffffu) * xsc, bf2f(xv[3] >> 16) * xsc, hi, true);
                xf[ks] = (long)(((unsigned long long)(unsigned)hi << 32) | (unsigned long long)(unsigned)lo);
            }
            const unsigned char* ubs = uq + sl * P8_SLC + lch * 16;
#pragma unroll 1
            for (int j0 = 0; j0 < 16; ++j0) {
                const bool mine = (fr == j0);
                long bm[P8_KS];
#pragma unroll
                for (int ks = 0; ks < P8_KS; ++ks) bm[ks] = mine ? xf[ks] : 0l;
                u32x4 g0[8], g1[8];
#pragma unroll
                for (int h = 0; h < 8; ++h) {
                    const unsigned e0 = IDX[j0 * 128 + h * 16 + lrow], e1 = IDX[j0 * 128 + h * 16 + lrow + 8];
                    g0[h] = *(const u32x4*)(ubs + (size_t)e0 * DM);
                    g1[h] = *(const u32x4*)(ubs + (size_t)e1 * DM);
                }
#pragma unroll
                for (int hg = 0; hg < 2; ++hg) {
#pragma unroll
                    for (int h = 0; h < 4; ++h) {
                        *(LAS u32x4*)(STG + h * 2048 + wofs0) = g0[hg * 4 + h];
                        *(LAS u32x4*)(STG + h * 2048 + wofs1) = g1[hg * 4 + h];
                    }
                    __builtin_amdgcn_wave_barrier();
#pragma unroll
                    for (int h = 0; h < 4; ++h)
#pragma unroll
                        for (int ks = 0; ks < P8_KS; ++ks) {
                            const long a = *(const LAS long*)(STG + h * 2048 + rofs[ks]);
                            accU[hg * 4 + h] = __builtin_amdgcn_mfma_f32_16x16x32_fp8_fp8(a, bm[ks], accU[hg * 4 + h], 0, 0, 0);
                        }
                    __builtin_amdgcn_wave_barrier();
                }
            }
        }
#endif
        LDS_WAIT(); __builtin_amdgcn_wave_barrier();
#pragma unroll
        for (int h = 0; h < 8; ++h) {
            const f32x4 gv = *(const f32x4*)(gwi + (t0 + fr) * 128 + h * 16 + 4 * fq);
#pragma unroll
            for (int jj = 0; jj < 4; ++jj) {
                const int slot = h * 16 + 4 * fq + jj;
                const unsigned e = IDX[fr * 128 + slot];
                const float hv = accU[h][jj] * rsu[e] * (1.f / P8_XS);
                COEF[fr * 128 + slot] = gv[jj] * gelu_erf(hv) * rsv[e];
            }
        }
        LDS_WAIT(); __builtin_amdgcn_wave_barrier();
#if defined(PROBE_PHASE) && (PROBE_PHASE == 80 || PROBE_PHASE == 81)
        F.tb = __builtin_amdgcn_s_memrealtime();
#endif
#ifdef V_VALU
        const int sub = lane & 7, rg = lane >> 3;
#pragma unroll 1
        for (int sl = 0; sl < P8_NSL; ++sl) {
            const unsigned char* vbs = vq + sl * P8_SLC + sub * 16;
#pragma unroll 1
            for (int j0 = 0; j0 < 16; ++j0) {
                f32x2 acc[8];
#pragma unroll
                for (int q = 0; q < 8; ++q) acc[q] = (f32x2){0.f, 0.f};
#pragma unroll
                for (int ib = 0; ib < 2; ++ib) {
                    u32x4 w[8]; float cf[8];
#pragma unroll
                    for (int it = 0; it < 8; ++it) {
                        const int slot = (ib * 8 + it) * 8 + rg;
                        const unsigned e = IDX[j0 * 128 + slot];
                        cf[it] = COEF[j0 * 128 + slot];
                        w[it] = *(const u32x4*)(vbs + (size_t)e * DM);
                    }
#pragma unroll
                    for (int it = 0; it < 8; ++it)
#pragma unroll
                        for (int q = 0; q < 4; ++q) {
                            acc[2 * q] += __builtin_amdgcn_cvt_pk_f32_fp8((int)w[it][q], false) * cf[it];
                            acc[2 * q + 1] += __builtin_amdgcn_cvt_pk_f32_fp8((int)w[it][q], true) * cf[it];
                        }
                }
#pragma unroll
                for (int q = 0; q < 8; ++q) {
                    acc[q].x += __shfl_xor(acc[q].x, 8); acc[q].y += __shfl_xor(acc[q].y, 8);
                    acc[q].x += __shfl_xor(acc[q].x, 16); acc[q].y += __shfl_xor(acc[q].y, 16);
                    acc[q].x += __shfl_xor(acc[q].x, 32); acc[q].y += __shfl_xor(acc[q].y, 32);
                }
                if (rg == 0) {
                    float* orow = out + (t0 + j0) * DM + sl * P8_SLC + sub * 16;
                    const bf16_t* xrow = x1b + (t0 + j0) * DM + sl * P8_SLC + sub * 16;
#pragma unroll
                    for (int q = 0; q < 4; ++q) {
                        const u32x2 xv = *(const u32x2*)(xrow + 4 * q);
                        f32x4 o = {bf2f(xv.x & 0xffffu), bf2f(xv.x >> 16), bf2f(xv.y & 0xffffu), bf2f(xv.y >> 16)};
                        o[0] += acc[2 * q].x; o[1] += acc[2 * q].y; o[2] += acc[2 * q + 1].x; o[3] += acc[2 * q + 1].y;
                        *(f32x4*)(orow + 4 * q) = o;
                    }
                }
            }
        }
#elif defined(V_FP4)
        typedef int v2i __attribute__((ext_vector_type(2)));
        typedef int v8i __attribute__((ext_vector_type(8)));
        v8i cq8; float inv_cs;
        {
            f32x4 cv[2][4]; float cmax = 0.f;
#pragma unroll
            for (int hf = 0; hf < 2; ++hf)
#pragma unroll
                for (int q = 0; q < 4; ++q) {
                    cv[hf][q] = *(const LAS f32x4*)(COEF + fr * 128 + hf * 64 + 16 * fq + 4 * q);
                    cmax = fmaxf(cmax, fmaxf(fmaxf(fabsf(cv[hf][q][0]), fabsf(cv[hf][q][1])), fmaxf(fabsf(cv[hf][q][2]), fabsf(cv[hf][q][3]))));
                }
            cmax = fmaxf(cmax, __shfl_xor(cmax, 16)); cmax = fmaxf(cmax, __shfl_xor(cmax, 32));
            const float cs = cmax > 0.f ? 240.f / cmax : 1.f; inv_cs = cmax > 0.f ? cmax * (1.f / 240.f) : 1.f;
#pragma unroll
            for (int hf = 0; hf < 2; ++hf)
#pragma unroll
                for (int q = 0; q < 4; ++q) {
                    int pk = 0;
                    pk = __builtin_amdgcn_cvt_pk_fp8_f32(cv[hf][q][0] * cs, cv[hf][q][1] * cs, pk, false);
                    pk = __builtin_amdgcn_cvt_pk_fp8_f32(cv[hf][q][2] * cs, cv[hf][q][3] * cs, pk, true);
                    cq8[hf * 4 + q] = pk;
                }
        }
        LDS_WAIT(); __builtin_amdgcn_wave_barrier();
        int vwofs[16];
#pragma unroll
        for (int i = 0; i < 16; ++i) { const int rr = lrow + 8 * i; vwofs[i] = rr * 128 + ((lch ^ ((rr >> 1) & 7)) << 4); }
        int vrow_[2], vsw_[2];
#pragma unroll
        for (int t = 0; t < 2; ++t) { vrow_[t] = 32 * fq + 16 * t + fr; vsw_[t] = (vrow_[t] >> 1) & 7; }
#pragma unroll 1
        for (int sl = 0; sl < 4; ++sl) {
            f32x4 accV[16];
#pragma unroll
            for (int ct = 0; ct < 16; ++ct) accV[ct] = (f32x4){0.f, 0.f, 0.f, 0.f};
            const unsigned char* vbs = vq + sl * 128 + lch * 16;
#pragma unroll 1
            for (int j0 = 0; j0 < 16; ++j0) {
                const bool mine = (fr == j0);
                u32x4 g[16];
#pragma unroll
                for (int i = 0; i < 16; ++i) {
                    const unsigned e = IDX[j0 * 128 + lrow + 8 * i];
                    g[i] = *(const u32x4*)(vbs + (size_t)e * (DM / 2));
                }
#pragma unroll
                for (int i = 0; i < 16; ++i) *(LAS u32x4*)(STG + vwofs[i]) = g[i];
                __builtin_amdgcn_wave_barrier();
                v8i bmq;
#pragma unroll
                for (int q = 0; q < 8; ++q) bmq[q] = mine ? cq8[q] : 0;
#pragma unroll
                for (int ct = 0; ct < 16; ++ct) {
                    const v2i r0 = __builtin_amdgcn_ds_read_tr4_b64_v2i32((LAS v2i*)(STG + vrow_[0] * 128 + (((ct >> 1) ^ vsw_[0]) << 4) + (ct & 1) * 8));
                    const v2i r1 = __builtin_amdgcn_ds_read_tr4_b64_v2i32((LAS v2i*)(STG + vrow_[1] * 128 + (((ct >> 1) ^ vsw_[1]) << 4) + (ct & 1) * 8));
                    const v8i av = {r0.x, r0.y, r1.x, r1.y, 0, 0, 0, 0};
                    accV[ct] = __builtin_amdgcn_mfma_scale_f32_16x16x128_f8f6f4(av, bmq, accV[ct], 4, 0, 0, 0, 0, 0);
                }
                __builtin_amdgcn_wave_barrier();
            }
            float* orow = out + (t0 + fr) * DM + sl * 256 + 4 * fq;
            const bf16_t* xrow = x1b + (t0 + fr) * DM + sl * 256 + 4 * fq;
#pragma unroll
            for (int ct = 0; ct < 16; ++ct) {
                const u32x2 xv = *(const u32x2*)(xrow + ct * 16);
                f32x4 o = {bf2f(xv.x & 0xffffu), bf2f(xv.x >> 16), bf2f(xv.y & 0xffffu), bf2f(xv.y >> 16)};
                o += accV[ct] * inv_cs;
                __builtin_nontemporal_store(o, (f32x4*)(orow + ct * 16));
            }
        }
#else
        typedef int v2i __attribute__((ext_vector_type(2)));
        long cq[4]; float inv_cs;
        {
            f32x4 cv[4][2]; float cmax = 0.f;
#pragma unroll
            for (int kk = 0; kk < 4; ++kk)
#pragma unroll
                for (int q = 0; q < 2; ++q) {
                    cv[kk][q] = *(const LAS f32x4*)(COEF + fr * 128 + kk * 32 + 8 * fq + 4 * q);
                    cmax = fmaxf(cmax, fmaxf(fmaxf(fabsf(cv[kk][q][0]), fabsf(cv[kk][q][1])), fmaxf(fabsf(cv[kk][q][2]), fabsf(cv[kk][q][3]))));
                }
            cmax = fmaxf(cmax, __shfl_xor(cmax, 16)); cmax = fmaxf(cmax, __shfl_xor(cmax, 32));
            const float cs = cmax > 0.f ? 240.f / cmax : 1.f; inv_cs = cmax > 0.f ? cmax * (1.f / 240.f) : 1.f;
#pragma unroll
            for (int kk = 0; kk < 4; ++kk) {
                int lo = 0, hi = 0;
                lo = __builtin_amdgcn_cvt_pk_fp8_f32(cv[kk][0][0] * cs, cv[kk][0][1] * cs, lo, false);
                lo = __builtin_amdgcn_cvt_pk_fp8_f32(cv[kk][0][2] * cs, cv[kk][0][3] * cs, lo, true);
                hi = __builtin_amdgcn_cvt_pk_fp8_f32(cv[kk][1][0] * cs, cv[kk][1][1] * cs, hi, false);
                hi = __builtin_amdgcn_cvt_pk_fp8_f32(cv[kk][1][2] * cs, cv[kk][1][3] * cs, hi, true);
                cq[kk] = (long)(((unsigned long long)(unsigned)hi << 32) | (unsigned long long)(unsigned)lo);
            }
        }
        LDS_WAIT(); __builtin_amdgcn_wave_barrier();
        const int vrow = 8 * fq + (fr >> 1);
        const int vrd0 = vrow * 128 + (fr & 1) * 8, vsw = (vrow >> 1) & 7;
        int vwofs[4];
#pragma unroll
        for (int i = 0; i < 4; ++i) { const int rr = lrow + 8 * i; vwofs[i] = rr * 128 + ((lch ^ ((rr >> 1) & 7)) << 4); }
#pragma unroll 1
        for (int sl = 0; sl < P8_NSL; ++sl) {
            if (pace) xcd_pace(bar, P8_NSL + sl);
            f32x4 accV[8];
#pragma unroll
            for (int ct = 0; ct < 8; ++ct) accV[ct] = (f32x4){0.f, 0.f, 0.f, 0.f};
            const unsigned char* vbs = vq + sl * P8_SLC + lch * 16;
#pragma unroll 1
            for (int j0 = 0; j0 < 16; ++j0) {
                const bool mine = (fr == j0);
                u32x4 g[4][4];
#pragma unroll
                for (int kk = 0; kk < 4; ++kk)
#pragma unroll
                    for (int i = 0; i < 4; ++i) {
                        const unsigned e = IDX[j0 * 128 + kk * 32 + lrow + 8 * i];
                        g[kk][i] = *(const u32x4*)(vbs + (size_t)e * DM);
                    }
#pragma unroll
                for (int kk = 0; kk < 4; ++kk) {
                    LAS unsigned char* T = STG + (kk & 1) * 4096;
#pragma unroll
                    for (int i = 0; i < 4; ++i) *(LAS u32x4*)(T + vwofs[i]) = g[kk][i];
                    __builtin_amdgcn_wave_barrier();
                    const long bmq = mine ? cq[kk] : 0l;
#pragma unroll
                    for (int ct = 0; ct < 8; ++ct) {
                        const v2i av = __builtin_amdgcn_ds_read_tr8_b64_v2i32((LAS v2i*)(T + vrd0 + ((ct ^ vsw) << 4)));
                        const long a = (long)(((unsigned long long)(unsigned)av.y << 32) | (unsigned long long)(unsigned)av.x);
                        accV[ct] = __builtin_amdgcn_mfma_f32_16x16x32_fp8_fp8(a, bmq, accV[ct], 0, 0, 0);
                    }
                    __builtin_amdgcn_wave_barrier();
                }
            }
            float* orow = out + (t0 + fr) * DM + sl * P8_SLC + 4 * fq;
            const bf16_t* xrow = x1b + (t0 + fr) * DM + sl * P8_SLC + 4 * fq;
#pragma unroll
            for (int ct = 0; ct < 8; ++ct) {
                const u32x2 xv = *(const u32x2*)(xrow + ct * 16);
                f32x4 o = {bf2f(xv.x & 0xffffu), bf2f(xv.x >> 16), bf2f(xv.y & 0xffffu), bf2f(xv.y >> 16)};
                o += accV[ct] * inv_cs;
                __builtin_nontemporal_store(o, (f32x4*)(orow + ct * 16));
            }
        }
#endif
#if defined(PROBE_PHASE) && PROBE_PHASE >= 80
        F.tc = __builtin_amdgcn_s_memrealtime();
#endif
        LDS_WAIT(); __builtin_amdgcn_wave_barrier();
    }
}

constexpr int NPHASE = 9;
#ifndef N_LAUNCHES
#define N_LAUNCHES 1
#endif
constexpr int MISC_OFF = LDS_BYTES - 128;
__global__ void __launch_bounds__(512, 2) fwd_kernel(Params p) {
    extern __shared__ __attribute__((aligned(16))) unsigned char lds_raw[];
    Ctx F; F.ta = F.tb = F.tc = 0;
    F.lds = (LAS unsigned char*)lds_raw;
    F.tid = threadIdx.x; F.lane = F.tid & 63; F.wave = __builtin_amdgcn_readfirstlane(F.tid >> 6);
    F.G = gridDim.x; { const int bx = blockIdx.x; F.vcu = (F.G % 8 == 0) ? (bx % 8) * (F.G / 8) + bx / 8 : bx; }
    F.gw = F.vcu * 8 + F.wave; F.ngw = F.G * 8;
    unsigned char* ws = p.ws;
    const int lo = p.ph_lo, hi = p.ph_hi;
    volatile LAS unsigned* MISC = (volatile LAS unsigned*)(F.lds + MISC_OFF);
    if (F.tid < 32) MISC[F.tid] = 0u;
    __syncthreads();
#ifdef CG_FIRST_SYNC
    XcdBarrier bar; bar.bar = (unsigned*)(ws + WS_CTL) + CW_BAR; bar.x = 0; bar.st = MISC + 8;
    for (int i = blockIdx.x * 512 + F.tid; i < XCD_BAR_WORDS + PACE_WORDS; i += F.G * 512) __hip_atomic_store(bar.bar + i, 0u, __ATOMIC_RELAXED, __HIP_MEMORY_SCOPE_AGENT);
#else
    XcdBarrier bar = xcd_barrier_post((unsigned*)(ws + WS_CTL) + CW_BAR, MISC + 8);
#endif
#ifdef ONLY_PHASE
#define IN(k) ((k)==ONLY_PHASE)
#else
#define IN(k) (lo <= (k) && (k) < hi)
#endif
#ifdef PROBE_PHASE
    unsigned long long tp0 = __builtin_amdgcn_s_memrealtime(), tp1 = 0; const unsigned long long tstart = tp0;
#define PSTAMP(k) do { if ((k) + 1 == PROBE_PHASE) tp0 = __builtin_amdgcn_s_memrealtime(); if ((k) == PROBE_PHASE) tp1 = __builtin_amdgcn_s_memrealtime(); } while (0)
#else
#define PSTAMP(k) do {} while (0)
#endif
#define SEAM(k) do { if (IN(k) && ((k) == 6 ? IN(8) : IN((k) + 1))) xcd_barrier(bar); PSTAMP(k); } while (0)
    if (IN(0)) phase0(p, F);
#ifdef CG_FIRST_SYNC
    if (IN(0) && IN(1)) { cooperative_groups::this_grid().sync(); bar = xcd_barrier_post((unsigned*)(ws + WS_CTL) + CW_BAR, MISC + 8); }
    PSTAMP(0);
#else
    SEAM(0);
#endif
    if (IN(1)) {
        pg8::Gemm g{(const pg8::bf16_t*)(ws + WS_XB), (const pg8::bf16_t*)(ws + WS_WINT), TOK, NIN, DM};
        pg8::StaticOrder S; S.init(TOK, NIN, F.G, (int)blockIdx.x);
        pg8::EpiProj E{(pg8::bf16_t*)(ws + WS_PROJ), NIN, p.in[9], p.in[10], (const float*)(ws + WS_ROPE), (const float*)(ws + WS_ROPE) + SEQ * 8,
                       (LAS float*)(F.lds + pg8::STAGE_BYTES), PQ, PK, PV, SEQ - 1, EPSN};
        pg8::gemm_phase<pg8::EpiProj, pg8::StaticOrder, true, true>(F.lds, g, S, E);
    }
    SEAM(1);
    if (IN(2)) phase2(p, F);
    SEAM(2);
#if defined(PROBE_PHASE) && PROBE_PHASE == 84
    const unsigned long long t3s = __builtin_amdgcn_s_memrealtime();
#endif
    if (IN(3)) phase3(p, F);
#if defined(PROBE_PHASE) && PROBE_PHASE == 84
    { const unsigned long long tend = __builtin_amdgcn_s_memrealtime();
      if (F.tid == 0) { unsigned* mw = (unsigned*)(ws + WS_MISC); const unsigned d = (unsigned)(tend - t3s); atomicMax(mw + 2, d); atomicMin(mw + 3, d); atomicAdd(mw + 4, d >> 8); } }
#endif
    SEAM(3);
    if (IN(4)) phase4(p, F);
    SEAM(4);
    if (IN(5)) {
        pg8::Gemm g{(const pg8::bf16_t*)(ws + WS_YCAT), (const pg8::bf16_t*)(ws + WS_WOUTT), TOK, DM, DM};
        pg8::StaticOrder S; S.init(TOK, DM, F.G, (int)blockIdx.x);
        pg8::EpiResid E{(const pg8::bf16_t*)(ws + WS_XB), (const float*)(ws + WS_RSTD), (pg8::bf16_t*)(ws + WS_X1B), (float*)(ws + WS_CTL) + CW_ROWSQ, DM};
        pg8::gemm_phase<pg8::EpiResid, pg8::StaticOrder, true, true>(F.lds, g, S, E);
    }
    SEAM(5);
    if (IN(6)) {
        pg8::Gemm g{(const pg8::bf16_t*)(ws + WS_X1B), (const pg8::bf16_t*)(ws + WS_WQT), TOK, 2048, DM};
        pg8::StaticOrder S; S.init(TOK, 2048, F.G, (int)blockIdx.x);
        pg8::EpiBf16<0> E{(pg8::bf16_t*)(ws + WS_QP), 2048, nullptr, 0, 0, 1.f};
        pg8::gemm_phase<pg8::EpiBf16<0>, pg8::StaticOrder, true, true>(F.lds, g, S, E);
    }
    SEAM(6);
    PSTAMP(7);
#if defined(PROBE_PHASE) && PROBE_PHASE == 83
    tp0 = __builtin_amdgcn_s_memrealtime();
#endif
#ifdef PROBE_PHASE
    const unsigned sv_nloc = MISC[8], sv_nx = MISC[9];
#endif
    if (IN(8)) phase8(p, F, bar);
#ifdef PROBE_PHASE
    __syncthreads(); if (F.tid == 0) { MISC[8] = sv_nloc; MISC[9] = sv_nx; } __syncthreads();
#endif
#if defined(PROBE_PHASE) && PROBE_PHASE == 83
    {
        const unsigned long long tend = __builtin_amdgcn_s_memrealtime();
        if (F.tid == 0) { unsigned* mw = (unsigned*)(ws + WS_MISC); const unsigned d = (unsigned)(tend - tp0);
            atomicMax(mw + 2, d); atomicMin(mw + 3, d); atomicAdd(mw + 4, d >> 8); }
    }
#endif
#ifdef PROBE_PHASE
    xcd_barrier(bar);
    PSTAMP(8);
#if PROBE_PHASE == 83 || PROBE_PHASE == 84
    { const unsigned* mw = (const unsigned*)(ws + WS_MISC);
      const unsigned vmax = __hip_atomic_load(mw + 2, __ATOMIC_RELAXED, __HIP_MEMORY_SCOPE_AGENT), vmin = __hip_atomic_load(mw + 3, __ATOMIC_RELAXED, __HIP_MEMORY_SCOPE_AGENT), vsum = __hip_atomic_load(mw + 4, __ATOMIC_RELAXED, __HIP_MEMORY_SCOPE_AGENT);
      tp0 = 0; tp1 = PROBE_SUB == 0 ? vmax : (PROBE_SUB == 1 ? vmin : (unsigned)(((unsigned long long)vsum << 8) / gridDim.x)); }
#elif PROBE_PHASE == 9
    tp0 = tstart; tp1 = __builtin_amdgcn_s_memrealtime();
#elif PROBE_PHASE == 80 || PROBE_PHASE == 20 || PROBE_PHASE == 30 || PROBE_PHASE == 82
    tp0 = F.ta; tp1 = F.tb;
#elif PROBE_PHASE == 81 || PROBE_PHASE == 21 || PROBE_PHASE == 31
    tp0 = F.tb; tp1 = F.tc;
#endif
#if PROBE_PHASE == 98
    {
        typedef int v2i __attribute__((ext_vector_type(2)));
        float result = 0.f;
        __syncthreads();
        if (blockIdx.x == 0 && F.wave == 0) {
            LAS unsigned char* T = (LAS unsigned char*)F.lds;
            if (F.lane < 16) {
                unsigned long long w = 0ull;
                for (int c = 0; c < 16; ++c) { const unsigned long long nib = (PROBE_SUB == 0) ? (unsigned long long)F.lane : (unsigned long long)c; w |= nib << (4 * c); }
                *(LAS unsigned long long*)(T + F.lane * 8) = w;
            }
            LDS_WAIT(); __builtin_amdgcn_wave_barrier();
            const v2i rv_ = __builtin_amdgcn_ds_read_tr4_b64_v2i32((LAS v2i*)(T + (F.lane & 15) * 8));
            const unsigned long long got = ((unsigned long long)(unsigned)rv_.y << 32) | (unsigned long long)(unsigned)rv_.x;
            unsigned long long want = 0ull;
            for (int j = 0; j < 16; ++j) { const unsigned long long nib = (PROBE_SUB == 0) ? (unsigned long long)j : (unsigned long long)(F.lane & 15); want |= nib << (4 * j); }
            const unsigned long long bal = __ballot(got == want);
            result = (float)__popcll(bal);
        }
        if (blockIdx.x == 0 && F.tid == 0) { VM_WAIT(); p.out[0] += result; }
    }
#elif PROBE_PHASE == 99
    {
        typedef int v8i __attribute__((ext_vector_type(8)));
        float result = 0.f;
        if (blockIdx.x == 0 && F.wave == 0) {
            const int fr_ = F.lane & 15, fq_ = F.lane >> 4;
            v8i bv;
#pragma unroll
            for (int q = 0; q < 8; ++q) { unsigned w = 0; for (int bb = 0; bb < 4; ++bb) { unsigned pcode = (unsigned)(32 * fq_ + 4 * q + bb); if (pcode == 127u) pcode = 126u; w |= pcode << (8 * bb); } bv[q] = (int)w; }
            int matches = 0, firstbad = -1, firstbadval = -1;
            for (int ga = 0; ga < 4; ++ga)
                for (int ja = 0; ja < 32; ++ja) {
                    v8i av = {0, 0, 0, 0, 0, 0, 0, 0};
                    if (fr_ == 0 && fq_ == ga) { const unsigned nib = 2u << (4 * (ja & 7)); const int wsel = ja >> 3;
                        av[0] = wsel == 0 ? (int)nib : 0; av[1] = wsel == 1 ? (int)nib : 0; av[2] = wsel == 2 ? (int)nib : 0; av[3] = wsel == 3 ? (int)nib : 0; }
                    f32x4 c = {0.f, 0.f, 0.f, 0.f};
                    c = __builtin_amdgcn_mfma_scale_f32_16x16x128_f8f6f4(av, bv, c, 4, 0, 0, 0, 0, 0);
                    int pk = 0; pk = __builtin_amdgcn_cvt_pk_fp8_f32(c[0], 0.f, pk, false);
                    const int got = __shfl(pk & 255, 0);
                    int want = 32 * ga + ja; if (want == 127) want = 126;
                    if (got == want) ++matches; else if (firstbad < 0) { firstbad = 32 * ga + ja; firstbadval = got; }
                }
#if PROBE_SUB == 0
            result = (float)matches;
#elif PROBE_SUB == 1
            result = (float)firstbad;
#else
            result = (float)firstbadval;
#endif
        }
        if (blockIdx.x == 0 && F.tid == 0) { VM_WAIT(); p.out[0] += result; }
    }
#else
#ifndef PROBE_OFF
#define PROBE_OFF 0
#endif
#ifdef ATT_ABL
    for (size_t i = (size_t)blockIdx.x * 512 + F.tid; i < (size_t)TOK * DM; i += (size_t)F.G * 512) p.out[i] = 1.0f;
    if (blockIdx.x == 0 && F.tid == 0) { VM_WAIT(); p.out[0] = ((float)(tp1 - tp0) - (float)(PROBE_OFF)) * (1.0f / (float)(PROBE_DIV)); }
#else
    if (blockIdx.x == 0 && F.tid == 0) { VM_WAIT(); p.out[0] += ((float)(tp1 - tp0) - (float)(PROBE_OFF)) * (1.0f / (float)(PROBE_DIV)); }
#endif
#endif
#endif
#undef IN
#undef SEAM
}

extern "C" void kernel_launch(void* const* d_in, const int* in_sizes, int n_in, void* d_out, int out_size, void* d_ws, size_t ws_size, hipStream_t stream) {
    static int grid = 0;
    if (grid == 0) {
        if (n_in != 22 || in_sizes[0] != TOK * DM || out_size != TOK * DM || ws_size < WS_END) {
            fprintf(stderr, "kernel_launch: unexpected shapes: n_in %d in0 %d out %d ws %zu\n", n_in, n_in > 0 ? in_sizes[0] : -1, out_size, ws_size); grid = -1; return; }
        if (hipFuncSetAttribute((const void*)fwd_kernel, hipFuncAttributeMaxDynamicSharedMemorySize, LDS_BYTES) != hipSuccess) { fprintf(stderr, "kernel_launch: hipFuncSetAttribute failed\n"); grid = -1; return; }
        int dev = 0, cus = 0, per_cu = 0;
        if (hipGetDevice(&dev) != hipSuccess || hipDeviceGetAttribute(&cus, hipDeviceAttributeMultiprocessorCount, dev) != hipSuccess) { grid = -1; return; }
        if (hipOccupancyMaxActiveBlocksPerMultiprocessor(&per_cu, (const void*)fwd_kernel, 512, LDS_BYTES) != hipSuccess || per_cu < 1) { fprintf(stderr, "kernel_launch: occupancy query failed (%d)\n", per_cu); (void)hipGetLastError(); per_cu = 1; }
        grid = cus * (per_cu > 1 ? 1 : per_cu);
    }
    if (grid < 0) return;
#ifndef CG_FIRST_SYNC
    (void)hipMemsetAsync((char*)d_ws + WS_CTL + (size_t)CW_BAR * 4, 0, (size_t)(XCD_BAR_WORDS + PACE_WORDS) * 4, stream);
#endif
    Params a{};
    for (int i = 0; i < 22; ++i) a.in[i] = (const float*)d_in[i];
    a.out = (float*)d_out; a.ws = (unsigned char*)d_ws;
#if N_LAUNCHES == 1
    a.ph_lo = 0; a.ph_hi = NPHASE;
#ifdef ATT_ABL
    a.ph_hi = 4;
#endif
#ifdef USE_COOP_LAUNCH
    { void* args[] = {&a};
      hipError_t e = hipLaunchCooperativeKernel((const void*)fwd_kernel, dim3(grid), dim3(512), args, LDS_BYTES, stream);
      if (e != hipSuccess) fprintf(stderr, "kernel_launch: cooperative launch failed: %s (grid %d)\n", hipGetErrorString(e), grid); }
#else
    hipLaunchKernelGGL(fwd_kernel, dim3(grid), dim3(512), LDS_BYTES, stream, a);
#endif
#else
    for (int ph = 0; ph < NPHASE; ++ph) {
        a.ph_lo = ph; a.ph_hi = ph + 1;
        hipLaunchKernelGGL(fwd_kernel, dim3(grid), dim3(512), LDS_BYTES, stream, a);
    }
#endif
    const hipError_t le = hipPeekAtLastError();
    if (le != hipSuccess) fprintf(stderr, "kernel_launch: launch failed: %s\n", hipGetErrorName(le));
}
```

```cpp
#include <hip/hip_runtime.h>
#include <hip/hip_cooperative_groups.h>
#include <cstdio>
#include <cstdint>
#define USE_COOP_LAUNCH 1
#define SELF_ZERO 1
#define U_FP4 1
#define V_FP4 1

#define LAS __attribute__((address_space(3)))
#define GAS __attribute__((address_space(1)))
typedef unsigned short bf16_t;
typedef short bf16x8 __attribute__((ext_vector_type(8)));
typedef short s16x4 __attribute__((ext_vector_type(4)));
typedef float f32x4 __attribute__((ext_vector_type(4)));
typedef float f32x8 __attribute__((ext_vector_type(8)));
typedef float f32x16 __attribute__((ext_vector_type(16)));
typedef unsigned u32x4 __attribute__((ext_vector_type(4)));
typedef unsigned u32x2 __attribute__((ext_vector_type(2)));

constexpr int NB = 8, SEQ = 4096, TOK = NB * SEQ, DM = 1024;
constexpr int NIN = 3072;
constexpr int PZ = 0, PXS = 512, PBM = 1024, PCM = 1280, PQ = 1536, PK = 2048, PV = 2560;
constexpr int CHUNK = 64, NCH = SEQ / CHUNK;
constexpr int NHS = 8;
constexpr float EPSN = 1e-6f;
constexpr int PEER_H = 8, NKEYS = 128, TOPK = 16;
constexpr float LAMBDA_INIT = 0.2f;

constexpr size_t MiB = 1u << 20;
constexpr size_t WS_CTL = 0, CTL_BYTES = 1 * MiB;
constexpr size_t WS_WINT = 1 * MiB;
constexpr size_t WS_WOUTT = 7 * MiB;
constexpr size_t WS_WQT = 9 * MiB;
constexpr size_t WS_KEYS = 13 * MiB;
constexpr size_t WS_ROPE = 13 * MiB + 512 * 1024;
constexpr size_t WS_MISC = 13 * MiB + 768 * 1024;
constexpr size_t WS_RSU = WS_MISC + 64 * 1024;
constexpr size_t WS_RSV = WS_MISC + 128 * 1024;
constexpr size_t WS_DTRAW = 14 * MiB;
constexpr size_t WS_ACS = 15 * MiB;
constexpr size_t WS_CDEC = 16 * MiB;
constexpr size_t WS_RSTD = 17 * MiB;
constexpr size_t WS_UB = 20 * MiB;
constexpr size_t WS_VB = 52 * MiB;
constexpr size_t WS_XB = 84 * MiB;
constexpr size_t WS_YCAT = 420 * MiB;
constexpr size_t WS_PROJ = 148 * MiB;
constexpr size_t WS_QP = WS_PROJ;
constexpr size_t WS_IDX = 276 * MiB;
constexpr size_t WS_GW = 292 * MiB;
constexpr size_t OUT_S8 = 64 * MiB;
constexpr size_t WS_TSC = 41 * MiB;
constexpr size_t WS_SSC = 40 * MiB;
constexpr size_t WS_CMC = 340 * MiB;
constexpr size_t WS_STATES = 356 * MiB;
constexpr size_t WS_X1B = WS_STATES;
constexpr size_t WS_END = 484 * MiB;
constexpr int CW_BAR = 4096;
constexpr int CW_ROWSQ = 131072;
static_assert((CW_ROWSQ + TOK) * 4 <= (int)CTL_BYTES, "ctl");

constexpr int PACE_WORDS = 32 * 16 * 16;
constexpr int LDS_BYTES = 163840;

__device__ __forceinline__ float bf2f(unsigned h) { return __uint_as_float(h << 16); }
typedef float f32x2_cv __attribute__((ext_vector_type(2)));
typedef __bf16 bf16x2_cv __attribute__((ext_vector_type(2)));
__device__ __forceinline__ unsigned pk2(float lo, float hi) { const f32x2_cv v = {lo, hi}; return __builtin_bit_cast(unsigned, __builtin_convertvector(v, bf16x2_cv)); }
__device__ __forceinline__ unsigned f2bf(float f) { return pk2(f, 0.f) & 0xffffu; }
#define DPP_F(v, ctrl) __builtin_bit_cast(float, __builtin_amdgcn_mov_dpp(__builtin_bit_cast(int, (v)), (ctrl), 0xf, 0xf, true))
__device__ __forceinline__ float wave_sum(float v) {
    v += DPP_F(v, 0xB1); v += DPP_F(v, 0x4E);
    v += DPP_F(v, 0x124); v += DPP_F(v, 0x128);
    { auto r = __builtin_amdgcn_permlane16_swap(__float_as_uint(v), __float_as_uint(v), false, false); v = __uint_as_float(r[0]) + __uint_as_float(r[1]); }
    { auto r = __builtin_amdgcn_permlane32_swap(__float_as_uint(v), __float_as_uint(v), false, false); v = __uint_as_float(r[0]) + __uint_as_float(r[1]); }
    return v;
}
__device__ __forceinline__ float wave_max(float v) {
    v = fmaxf(v, DPP_F(v, 0xB1)); v = fmaxf(v, DPP_F(v, 0x4E));
    v = fmaxf(v, DPP_F(v, 0x124)); v = fmaxf(v, DPP_F(v, 0x128));
    { auto r = __builtin_amdgcn_permlane16_swap(__float_as_uint(v), __float_as_uint(v), false, false); v = fmaxf(__uint_as_float(r[0]), __uint_as_float(r[1])); }
    { auto r = __builtin_amdgcn_permlane32_swap(__float_as_uint(v), __float_as_uint(v), false, false); v = fmaxf(__uint_as_float(r[0]), __uint_as_float(r[1])); }
    return v;
}
__device__ __forceinline__ float silu_f(float x) { return x * __builtin_amdgcn_rcpf(1.f + __expf(-x)); }
__device__ __forceinline__ f32x4 mfma16(bf16x8 a, bf16x8 b, f32x4 c) { return __builtin_amdgcn_mfma_f32_16x16x32_bf16(a, b, c, 0, 0, 0); }
__device__ __forceinline__ f32x16 mfma32(bf16x8 a, bf16x8 b, f32x16 c) { return __builtin_amdgcn_mfma_f32_32x32x16_bf16(a, b, c, 0, 0, 0); }
#define LDS_WAIT() asm volatile("s_waitcnt lgkmcnt(0)" ::: "memory")
#define VM_WAIT() asm volatile("s_waitcnt vmcnt(0)" ::: "memory")

#define XB_TMO      128
#define XB_XCNT(j)  (256  + 64 * (j))
#define XB_XSUB(j)  (1280 + 64 * (j))
#define XB_XGEN(j)  (2304 + 64 * (j))
#define XB_TOP      3328
#define XB_TOPGEN   3392
#define XCD_BAR_WORDS 3456
#define XB_SPIN_CAP (1u << 21)

__device__ __forceinline__ unsigned xb_ld(unsigned* p)              { return __hip_atomic_load(p, __ATOMIC_RELAXED, __HIP_MEMORY_SCOPE_AGENT); }
__device__ __forceinline__ unsigned xb_add(unsigned* p, unsigned v) { return __hip_atomic_fetch_add(p, v, __ATOMIC_RELAXED, __HIP_MEMORY_SCOPE_AGENT); }
__device__ __forceinline__ unsigned xb_xcc_id() { return (unsigned)__builtin_amdgcn_s_getreg((3 << 11) | 20) & 0xFu; }
#define XB_SPIN(cond, bar) do { unsigned _sp = 0; while (cond) { __builtin_amdgcn_s_sleep(1); \
    if ((++_sp & 255u) == 0u) { if (xb_ld(&(bar)[XB_TMO])) break; if (_sp > XB_SPIN_CAP) { atomicAdd(&(bar)[XB_TMO], 1u); break; } } } } while (0)

struct XcdBarrier {
    unsigned* bar; unsigned x;
    volatile LAS unsigned* st;
};

__device__ __forceinline__ XcdBarrier xcd_barrier_post(unsigned* bar, volatile LAS unsigned* st) {
    XcdBarrier b; b.bar = bar; b.x = xb_xcc_id(); b.st = st;
    if (threadIdx.x == 0) (void)xb_add(&bar[XB_XCNT(b.x)], 1u);
    return b;
}
__device__ __forceinline__ void xcd_barrier_complete(unsigned* bar, unsigned x, unsigned& nloc, unsigned& nx) {
    const unsigned G = gridDim.x * gridDim.y * gridDim.z;
    unsigned sum, cnt, mine, sp = 0u;
    for (;;) {
        sum = 0u; cnt = 0u; mine = 0u;
#pragma unroll
        for (unsigned j = 0; j < 16; ++j) { const unsigned c = xb_ld(&bar[XB_XCNT(j)]); sum += c; cnt += (c > 0u) ? 1u : 0u; mine = (j == x) ? c : mine; }
        if (sum == G) break;
        __builtin_amdgcn_s_sleep(1);
        if ((++sp & 255u) == 0u) { if (xb_ld(&bar[XB_TMO])) break; if (sp > XB_SPIN_CAP) { atomicAdd(&bar[XB_TMO], 1u); break; } }
    }
    nloc = mine > 0u ? mine : 1u; nx = cnt > 0u ? cnt : 1u;
}

__device__ __forceinline__ void xcd_barrier(const XcdBarrier& b) {
    asm volatile("s_waitcnt vmcnt(0)" ::: "memory");
    __syncthreads();
    if (threadIdx.x == 0) {
        unsigned* bar = b.bar;
        __builtin_amdgcn_s_waitcnt(0);
        unsigned nloc = b.st[0], nx = b.st[1];
        if (nloc == 0u) { xcd_barrier_complete(bar, b.x, nloc, nx); b.st[0] = nloc; b.st[1] = nx; }
        const unsigned old = xb_add(&bar[XB_XSUB(b.x)], 1u);
        const unsigned gen = old / nloc;
        if (old + 1u == (gen + 1u) * nloc) {
            __builtin_amdgcn_fence(__ATOMIC_RELEASE, "agent");
            asm volatile("s_waitcnt vmcnt(0)" ::: "memory");
            const unsigned og = xb_add(&bar[XB_TOP], 1u);
            const unsigned tg = og / nx;
            if (og + 1u == (tg + 1u) * nx) xb_add(&bar[XB_TOPGEN], 1u);
            else XB_SPIN(xb_ld(&bar[XB_TOPGEN]) == tg, bar);
            __builtin_amdgcn_fence(__ATOMIC_ACQUIRE, "agent");
            xb_add(&bar[XB_XGEN(b.x)], 1u);
            asm volatile("s_waitcnt vmcnt(0)" ::: "memory");
        } else {
            XB_SPIN(xb_ld(&bar[XB_XGEN(b.x)]) == gen, bar);
            __builtin_amdgcn_fence(__ATOMIC_ACQUIRE, "agent");
            asm volatile("s_waitcnt vmcnt(0)" ::: "memory");
        }
    }
    __syncthreads();
}
namespace pg8 {
#define PG8_LAS __attribute__((address_space(3)))
typedef unsigned short bf16_t;
typedef short bf16x8 __attribute__((ext_vector_type(8)));
typedef float f32x4 __attribute__((ext_vector_type(4)));
typedef unsigned u32x4 __attribute__((ext_vector_type(4)));
constexpr int BM = 256, BK = 64, HALF = 128, HTB = HALF * BK * 2  , STAGE_BYTES = 8 * HTB, NXCD = 8, WGM = 4;

__host__ __device__ __forceinline__ int lds_byte(int r, int c) { const int st = (r >> 4) * 2 + (c >> 5), rr = r & 15, cc = c & 31, ob = rr * 64 + cc * 2; return st * 1024 + (ob ^ (((ob >> 9) & 1) << 5)); }
__host__ __device__ __forceinline__ void stage_rc(int b, int& R, int& C) { const int st = b / 1024, sb = b % 1024, swz = sb ^ (((sb >> 9) & 1) << 5); R = (st >> 1) * 16 + swz / 64; C = (st & 1) * 32 + (swz % 64) / 2; }
__host__ __device__ __forceinline__ int perm32(int rho) { const int n = rho >> 4, i = rho & 15; return 8 * (i >> 2) + 4 * n + (i & 3); }

struct Unit { int pm, pn; };
struct Gemm { const bf16_t* A; const bf16_t* Bt; int M, N, K; };

struct StaticOrder {
    int nM, nN, nwg, G, c;
    __host__ __device__ void init(int M, int N, int G_, int c_) { nM = M / BM; nN = N / BM; nwg = nM * nN; G = G_; c = c_; }
    __host__ __device__ bool next(int i, Unit& u) const {
        const long L = (long)i * G + c; if (L >= nwg) return false;
        int wgid = (int)L; { const int q = nwg / NXCD, r = nwg % NXCD, xcd = wgid % NXCD, off = wgid / NXCD; wgid = (xcd < r ? xcd * (q + 1) : r * (q + 1) + (xcd - r) * q) + off; }
        const int nig = WGM * nN, gid = wgid / nig, fm = gid * WGM, gsz = (nM - fm) < WGM ? (nM - fm) : WGM;
        u.pm = fm + ((wgid % nig) % gsz); u.pn = (wgid % nig) / gsz; return true;
    }
    __device__ __forceinline__ void a_ready(const Unit&) const {}
    __device__ __forceinline__ void done(const Unit&) const {}
};

__device__ __forceinline__ unsigned cvt_pk_bf16(float lo, float hi) { unsigned r; asm volatile("v_cvt_pk_bf16_f32 %0, %1, %2" : "=v"(r) : "v"(lo), "v"(hi)); return r; }
typedef float f32x2 __attribute__((ext_vector_type(2)));
__device__ __forceinline__ f32x2 gelu_pk(f32x2 v) {
    const f32x2 av = __builtin_elementwise_abs(v), d = av * 0.2316418882f + 1.0f;
    f32x2 t; t.x = __builtin_amdgcn_rcpf(d.x); t.y = __builtin_amdgcn_rcpf(d.y);
    f32x2 q = t * 0.5307027145f + (-0.7265760135f); q = q * t + 0.7107068705f; q = q * t + (-0.142248368f); q = q * t + 0.127414796f; q = q * t;
    const f32x2 s = (v * v) * (-0.72134752044f);
    f32x2 e; e.x = __builtin_amdgcn_exp2f(s.x); e.y = __builtin_amdgcn_exp2f(s.y);
    const f32x2 m = v * (q * e), r = v - m;
    f32x2 o; o.x = v.x < 0.f ? m.x : r.x; o.y = v.y < 0.f ? m.y : r.y; return o;
}

template <int ACT  > struct EpiBf16 {
    static constexpr bool PERM = true, AFTER_DRAIN = false; static_assert(ACT == 0 || ACT == 1, "EpiBf16: ACT is 0 (none) or 1 (gelu_pk)");
    bf16_t* O; int ldc; const float* bias; int split_cols; size_t split_stride; float scale0;
    __device__ __forceinline__ void operator()(const f32x4 (&acc)[2][2][4][2], const Unit& u, int wr, int wc, int fr, int fq) const {
        const int row0 = u.pm * BM + wr * 64 + fr; int colt = u.pn * BM; bf16_t* base = O;
        float sc = 1.f; if (split_cols) { const int t = colt / split_cols; base += (size_t)t * split_stride; colt -= t * split_cols; if (t == 0) sc = scale0; }
        const int col0 = colt + wc * 32 + 8 * fq, bcol0 = u.pn * BM + wc * 32 + 8 * fq;
        f32x4 bv[2][2];
#pragma unroll
        for (int bj = 0; bj < 2; ++bj)
#pragma unroll
            for (int n = 0; n < 2; ++n) bv[bj][n] = bias ? *(const f32x4*)(bias + bcol0 + bj * HALF + 4 * n) : (f32x4){0.f, 0.f, 0.f, 0.f};
#pragma unroll
        for (int ai = 0; ai < 2; ++ai)
#pragma unroll
            for (int m = 0; m < 4; ++m) { bf16_t* rowp = base + (size_t)(row0 + ai * HALF + m * 16) * ldc + col0;
#pragma unroll
                for (int bj = 0; bj < 2; ++bj) { f32x4 v0 = acc[ai][bj][m][0] + bv[bj][0], v1 = acc[ai][bj][m][1] + bv[bj][1];
                    if (ACT == 1) { f32x2 a = gelu_pk((f32x2){v0[0], v0[1]}), b = gelu_pk((f32x2){v0[2], v0[3]}), c = gelu_pk((f32x2){v1[0], v1[1]}), d = gelu_pk((f32x2){v1[2], v1[3]});
                        v0 = (f32x4){a.x, a.y, b.x, b.y}; v1 = (f32x4){c.x, c.y, d.x, d.y}; }
                    v0 = v0 * sc; v1 = v1 * sc; u32x4 w; w.x = cvt_pk_bf16(v0[0], v0[1]); w.y = cvt_pk_bf16(v0[2], v0[3]); w.z = cvt_pk_bf16(v1[0], v1[1]); w.w = cvt_pk_bf16(v1[2], v1[3]);
                    *(u32x4*)(rowp + bj * HALF) = w; } }
    }
};

__device__ __forceinline__ float epi_sum_16_32(float v) {
    { auto r = __builtin_amdgcn_permlane16_swap(__float_as_uint(v), __float_as_uint(v), false, false); v = __uint_as_float(r[0]) + __uint_as_float(r[1]); }
    { auto r = __builtin_amdgcn_permlane32_swap(__float_as_uint(v), __float_as_uint(v), false, false); v = __uint_as_float(r[0]) + __uint_as_float(r[1]); }
    return v;
}
__device__ __forceinline__ float epi_xor16(float v, bool odd_row) {
    auto r = __builtin_amdgcn_permlane16_swap(__float_as_uint(v), __float_as_uint(v), false, false);
    return __uint_as_float(odd_row ? r[0] : r[1]);
}

struct EpiResid {
    static constexpr bool PERM = true, AFTER_DRAIN = false;
    const bf16_t* xn; const float* xscale; bf16_t* xb; float* rowsq; int ldc;
    __device__ __forceinline__ void operator()(const f32x4 (&acc)[2][2][4][2], const Unit& u, int wr, int wc, int fr, int fq) const {
        const int col0 = u.pn * BM + wc * 32 + 8 * fq;
        const size_t base = (size_t)(u.pm * BM + wr * 64 + fr) * ldc + col0;
        u32x4 xv[2][2]; float xs[2];
#define EPR_LOAD(SET, G) do { const int r_ = ((G) >> 2) * HALF + ((G) & 3) * 16; const size_t off_ = base + (size_t)r_ * ldc; xs[SET] = xscale[u.pm * BM + wr * 64 + fr + r_]; \
        _Pragma("unroll") for (int bj = 0; bj < 2; ++bj) xv[SET][bj] = __builtin_nontemporal_load((const u32x4*)(xn + off_ + bj * HALF)); } while (0)
        EPR_LOAD(0, 0);
#pragma unroll
        for (int g = 0; g < 8; ++g) {
            const int ai = g >> 2, m = g & 3;
            if (g + 1 < 8) { if ((g & 1) == 0) EPR_LOAD(1, g + 1); else EPR_LOAD(0, g + 1); }
            const int row = u.pm * BM + ai * HALF + wr * 64 + m * 16 + fr;
            const size_t off = base + (size_t)(ai * HALF + m * 16) * ldc;
            const float sc = xs[g & 1];
            float ss = 0.f;
#pragma unroll
            for (int bj = 0; bj < 2; ++bj) {
                const u32x4 xr = xv[g & 1][bj];
                f32x4 o0 = acc[ai][bj][m][0], o1 = acc[ai][bj][m][1];
                o0[0] += __uint_as_float(xr.x << 16) * sc; o0[1] += __uint_as_float(xr.x & 0xffff0000u) * sc;
                o0[2] += __uint_as_float(xr.y << 16) * sc; o0[3] += __uint_as_float(xr.y & 0xffff0000u) * sc;
                o1[0] += __uint_as_float(xr.z << 16) * sc; o1[1] += __uint_as_float(xr.z & 0xffff0000u) * sc;
                o1[2] += __uint_as_float(xr.w << 16) * sc; o1[3] += __uint_as_float(xr.w & 0xffff0000u) * sc;
                ss += ((o0[0] * o0[0] + o0[1] * o0[1]) + (o0[2] * o0[2] + o0[3] * o0[3])) + ((o1[0] * o1[0] + o1[1] * o1[1]) + (o1[2] * o1[2] + o1[3] * o1[3]));
                u32x4 w; w.x = cvt_pk_bf16(o0[0], o0[1]); w.y = cvt_pk_bf16(o0[2], o0[3]); w.z = cvt_pk_bf16(o1[0], o1[1]); w.w = cvt_pk_bf16(o1[2], o1[3]);
                *(u32x4*)(xb + off + bj * HALF) = w;
            }
            ss = epi_sum_16_32(ss);
            if (fq == 0) atomicAdd(rowsq + row, ss);
        }
#undef EPR_LOAD
    }
};

struct EpiProj {
    static constexpr bool PERM = true, AFTER_DRAIN = false;
    bf16_t* O; int ldc; const float* qnw; const float* knw; const float* cosT; const float* sinT; PG8_LAS float* xch; int q_lo, k_lo, k_hi, seq_mask; float eps;
    __device__ __forceinline__ void operator()(const f32x4 (&acc)[2][2][4][2], const Unit& u, int wr, int wc, int fr, int fq) const {
        const int colt = u.pn * BM, row0 = u.pm * BM + wr * 64 + fr, col0 = colt + wc * 32 + 8 * fq;
        if (colt < q_lo || colt >= k_hi) {
#pragma unroll
            for (int ai = 0; ai < 2; ++ai)
#pragma unroll
                for (int m = 0; m < 4; ++m) { bf16_t* rowp = O + (size_t)(row0 + ai * HALF + m * 16) * ldc + col0;
#pragma unroll
                    for (int bj = 0; bj < 2; ++bj) { const f32x4 v0 = acc[ai][bj][m][0], v1 = acc[ai][bj][m][1];
                        u32x4 w; w.x = cvt_pk_bf16(v0[0], v0[1]); w.y = cvt_pk_bf16(v0[2], v0[3]); w.z = cvt_pk_bf16(v1[0], v1[1]); w.w = cvt_pk_bf16(v1[2], v1[3]);
                        *(u32x4*)(rowp + bj * HALF) = w; } }
            return;
        }
        const float* nw = colt < k_lo ? qnw : knw;
        const float nsc = colt < k_lo ? 0.18033688011112042f : 1.f;
#pragma unroll
        for (int ai = 0; ai < 2; ++ai)
#pragma unroll
            for (int m = 0; m < 4; ++m)
#pragma unroll
                for (int bj = 0; bj < 2; ++bj) {
                    const f32x4 a = acc[ai][bj][m][0], b = acc[ai][bj][m][1];
                    float ss = ((a[0] * a[0] + a[1] * a[1]) + (a[2] * a[2] + a[3] * a[3])) + ((b[0] * b[0] + b[1] * b[1]) + (b[2] * b[2] + b[3] * b[3]));
                    ss = epi_sum_16_32(ss);
                    if (fq == 0) xch[((ai * HALF + wr * 64 + m * 16 + fr) * 4 + bj * 2 + (wc >> 1)) * 2 + (wc & 1)] = ss;
                }
        asm volatile("s_waitcnt lgkmcnt(0)" ::: "memory"); __builtin_amdgcn_s_barrier(); asm volatile("" ::: "memory");
        float wv[8];
#pragma unroll
        for (int n = 0; n < 2; ++n)
#pragma unroll
            for (int j = 0; j < 4; ++j) wv[4 * n + j] = nw[32 * (wc & 1) + 8 * fq + 4 * n + j] * nsc;
        const bool rot = ((wc & 1) == 0) && (fq < 2);
#pragma unroll
        for (int ai = 0; ai < 2; ++ai)
#pragma unroll
            for (int m = 0; m < 4; ++m) {
                const int rl = ai * HALF + wr * 64 + m * 16 + fr, row = u.pm * BM + rl, pos = row & seq_mask;
                f32x4 cs0 = {1.f, 1.f, 1.f, 1.f}, cs1 = cs0, sn0 = {0.f, 0.f, 0.f, 0.f}, sn1 = sn0;
                if (rot) { cs0 = *(const f32x4*)(cosT + pos * 8); cs1 = *(const f32x4*)(cosT + pos * 8 + 4); sn0 = *(const f32x4*)(sinT + pos * 8); sn1 = *(const f32x4*)(sinT + pos * 8 + 4); }
                bf16_t* rowp = O + (size_t)row * ldc + col0;
#pragma unroll
                for (int bj = 0; bj < 2; ++bj) {
                    const int xi = (rl * 4 + bj * 2 + (wc >> 1)) * 2;
                    const float rs = rsqrtf((xch[xi] + xch[xi + 1]) * (1.f / 64.f) + eps);
                    f32x4 y0 = acc[ai][bj][m][0] * rs, y1 = acc[ai][bj][m][1] * rs;
#pragma unroll
                    for (int j = 0; j < 4; ++j) { y0[j] *= wv[j]; y1[j] *= wv[4 + j]; }
                    f32x4 p0, p1;
#pragma unroll
                    for (int j = 0; j < 4; ++j) { p0[j] = epi_xor16(y0[j], (fq & 1) != 0); p1[j] = epi_xor16(y1[j], (fq & 1) != 0); }
                    if (rot) {
                        if (fq == 0) { y0 = y0 * cs0 - p0 * sn0; y1 = y1 * cs1 - p1 * sn1; }
                        else { y0 = p0 * sn0 + y0 * cs0; y1 = p1 * sn1 + y1 * cs1; }
                    }
                    u32x4 w; w.x = cvt_pk_bf16(y0[0], y0[1]); w.y = cvt_pk_bf16(y0[2], y0[3]); w.z = cvt_pk_bf16(y1[0], y1[1]); w.w = cvt_pk_bf16(y1[2], y1[3]);
                    *(u32x4*)(rowp + bj * HALF) = w;
                }
            }
    }
};

template <class Epi, class Sched, bool ALIGN_EPI = false, bool SP2 = false>
__device__ __forceinline__ void gemm_phase(PG8_LAS unsigned char* lds, const Gemm g, const Sched& S, const Epi& E) {
    const int tid = threadIdx.x, wid = __builtin_amdgcn_readfirstlane(tid >> 6), lane = tid & 63, wr = wid >> 2, wc = wid & 3, fr = lane & 15, fq = lane >> 4;
    const int K = g.K, nt = K / BK;
    unsigned voffA[2], voffB[2];
#pragma unroll
    for (int i = 0; i < 2; ++i) { int R, C; stage_rc(tid * 16 + i * 8192, R, C); const int Rb = Epi::PERM ? ((R & ~31) + perm32(R & 31)) : R;
        voffA[i] = (unsigned)(R * K + C) * 2u; voffB[i] = (unsigned)(Rb * K + C) * 2u; }
    const size_t kstep = (size_t)(BK * 2);
    const size_t hstep = (size_t)HALF * K * 2;
    const size_t tstep = 2 * hstep;
    const unsigned ldsw = (unsigned)wid * 1024u;
    const int aoff = lds_byte(wr * 64 + fr, fq * 8), boff = lds_byte(wc * 32 + fr, fq * 8);
#define PG8_SA(b, h) (((b) * 2 + (h)) * HTB)
#define PG8_SB(b, h) ((4 + (b) * 2 + (h)) * HTB)
#define PG8_STAGE(bufoff, gbase, voff) do { _Pragma("unroll") for (int _i = 0; _i < 2; ++_i) \
        __builtin_amdgcn_global_load_lds((const unsigned*)((const char*)(gbase) + (voff)[_i]), (PG8_LAS unsigned*)(lds + (bufoff) + ldsw + _i * 8192), 16, 0, 0); } while (0)
#define PG8_LDA(dst, b, h) do { _Pragma("unroll") for (int m = 0; m < 4; ++m) _Pragma("unroll") for (int k = 0; k < 2; ++k) dst[m][k] = *(const PG8_LAS bf16x8*)(lds + PG8_SA(b, h) + aoff + m * 2048 + k * 1024); } while (0)
#define PG8_LDB(dst, b, h) do { _Pragma("unroll") for (int n = 0; n < 2; ++n) _Pragma("unroll") for (int k = 0; k < 2; ++k) dst[n][k] = *(const PG8_LAS bf16x8*)(lds + PG8_SB(b, h) + boff + n * 2048 + k * 1024); } while (0)
#define PG8_MMA(ai, bj, At, Bt) do { __builtin_amdgcn_s_setprio(1); _Pragma("unroll") for (int m = 0; m < 4; ++m) _Pragma("unroll") for (int n = 0; n < 2; ++n) _Pragma("unroll") for (int k = 0; k < 2; ++k) \
        acc[ai][bj][m][n] = __builtin_amdgcn_mfma_f32_16x16x32_bf16(Bt[n][k], At[m][k], acc[ai][bj][m][n], 0, 0, 0); __builtin_amdgcn_s_setprio(0); } while (0)
#define PG8_WAIT_V(n) asm volatile("s_waitcnt vmcnt(" #n ")" ::: "memory")
#define PG8_WAIT_L(n) asm volatile("s_waitcnt lgkmcnt(" #n ")" ::: "memory")
#define PG8_BAR __builtin_amdgcn_s_barrier()
#define PG8_SCHED __builtin_amdgcn_sched_barrier(0)
    Unit cur, nxt; int ui = 0;
    if (!S.next(0, cur)) return;
    f32x4 acc[2][2][4][2];
#pragma unroll
    for (int a = 0; a < 2; ++a)
#pragma unroll
        for (int b = 0; b < 2; ++b)
#pragma unroll
            for (int m = 0; m < 4; ++m)
#pragma unroll
                for (int n = 0; n < 2; ++n) acc[a][b][m][n] = (f32x4){0.f, 0.f, 0.f, 0.f};
    bf16x8 At[4][2], B0[2][2], B1[2][2];
    const char* cA = (const char*)g.A + (size_t)cur.pm * tstep; const char* cB = (const char*)g.Bt + (size_t)cur.pn * tstep;
    S.a_ready(cur);
    if constexpr (SP2) {
        PG8_STAGE(PG8_SB(0, 0), cB, voffB); PG8_STAGE(PG8_SB(0, 1), cB + hstep, voffB); PG8_STAGE(PG8_SA(0, 0), cA, voffA); PG8_STAGE(PG8_SA(0, 1), cA + hstep, voffA);
        if (wr == 1) PG8_BAR;
        PG8_WAIT_V(2); PG8_BAR;
        PG8_STAGE(PG8_SB(1, 0), cB + kstep, voffB); PG8_STAGE(PG8_SA(1, 0), cA + kstep, voffA); PG8_STAGE(PG8_SB(1, 1), cB + hstep + kstep, voffB);
        PG8_WAIT_V(6); PG8_BAR;
    } else {
        PG8_STAGE(PG8_SB(0, 0), cB, voffB); PG8_STAGE(PG8_SA(0, 0), cA, voffA); PG8_STAGE(PG8_SB(0, 1), cB + hstep, voffB); PG8_STAGE(PG8_SA(0, 1), cA + hstep, voffA);
        if (wr == 1) PG8_BAR;
        PG8_WAIT_V(4); PG8_BAR;
        PG8_STAGE(PG8_SB(1, 0), cB + kstep, voffB); PG8_STAGE(PG8_SA(1, 0), cA + kstep, voffA); PG8_STAGE(PG8_SB(1, 1), cB + hstep + kstep, voffB);
        PG8_WAIT_V(6); PG8_BAR;
    }
    for (;;) {
        const bool has_next = S.next(ui + 1, nxt);
        const char* nA = has_next ? (const char*)g.A + (size_t)nxt.pm * tstep : cA; const char* nB = has_next ? (const char*)g.Bt + (size_t)nxt.pn * tstep : cB;
        for (int t = 0; t < nt; t += 2) {
            const bool last = (t == nt - 2);
            const char* a1 = cA + (size_t)(t + 1) * kstep;
            const char* a2 = last ? nA : cA + (size_t)(t + 2) * kstep; const char* b2 = last ? nB : cB + (size_t)(t + 2) * kstep;
            const char* a3 = a2 + kstep; const char* b3 = b2 + kstep;
            if (last && has_next) S.a_ready(nxt);
            if constexpr (SP2) {
            PG8_LDB(B0, 0, 0); PG8_LDB(B1, 0, 1); PG8_SCHED; PG8_LDA(At, 0, 0); PG8_STAGE(PG8_SA(1, 1), a1 + hstep, voffA);
            PG8_WAIT_V(8); PG8_WAIT_L(0); PG8_BAR; PG8_MMA(0, 0, At, B0); PG8_MMA(0, 1, At, B1); PG8_BAR; PG8_SCHED;
            PG8_LDA(At, 0, 1); PG8_STAGE(PG8_SB(0, 0), b2, voffB); PG8_STAGE(PG8_SB(0, 1), b2 + hstep, voffB); PG8_STAGE(PG8_SA(0, 0), a2, voffA);
            PG8_WAIT_V(8); PG8_WAIT_L(0); PG8_BAR; PG8_MMA(1, 0, At, B0); PG8_MMA(1, 1, At, B1); PG8_BAR; PG8_SCHED;
            PG8_LDB(B0, 1, 0); PG8_LDB(B1, 1, 1); PG8_SCHED; PG8_LDA(At, 1, 0); PG8_STAGE(PG8_SA(0, 1), a2 + hstep, voffA);
            PG8_WAIT_V(8); PG8_WAIT_L(0); PG8_BAR; PG8_MMA(0, 0, At, B0); PG8_MMA(0, 1, At, B1); PG8_BAR; PG8_SCHED;
            PG8_LDA(At, 1, 1); PG8_STAGE(PG8_SB(1, 0), b3, voffB); PG8_STAGE(PG8_SB(1, 1), b3 + hstep, voffB); PG8_STAGE(PG8_SA(1, 0), a3, voffA);
            PG8_WAIT_V(8); PG8_WAIT_L(0); PG8_BAR; PG8_MMA(1, 0, At, B0); PG8_MMA(1, 1, At, B1); PG8_BAR; PG8_SCHED;
            } else {
            PG8_LDB(B0, 0, 0); PG8_SCHED; PG8_LDA(At, 0, 0); PG8_STAGE(PG8_SA(1, 1), a1 + hstep, voffA);
            PG8_WAIT_L(8); PG8_BAR; PG8_WAIT_L(0); PG8_MMA(0, 0, At, B0); PG8_BAR; PG8_SCHED;
            PG8_LDB(B1, 0, 1); PG8_STAGE(PG8_SB(0, 0), b2, voffB);
            PG8_BAR; PG8_WAIT_L(0); PG8_MMA(0, 1, At, B1); PG8_BAR;
            PG8_LDA(At, 0, 1); PG8_STAGE(PG8_SA(0, 0), a2, voffA);
            PG8_BAR; PG8_WAIT_L(0); PG8_MMA(1, 0, At, B0); PG8_BAR; PG8_SCHED;
            PG8_STAGE(PG8_SB(0, 1), b2 + hstep, voffB);
            PG8_WAIT_V(6); PG8_BAR; PG8_MMA(1, 1, At, B1); PG8_BAR;
            PG8_LDB(B0, 1, 0); PG8_SCHED; PG8_LDA(At, 1, 0); PG8_STAGE(PG8_SA(0, 1), a2 + hstep, voffA);
            PG8_WAIT_L(8); PG8_BAR; PG8_WAIT_L(0); PG8_MMA(0, 0, At, B0); PG8_BAR; PG8_SCHED;
            PG8_LDB(B1, 1, 1); PG8_STAGE(PG8_SB(1, 0), b3, voffB);
            PG8_BAR; PG8_WAIT_L(0); PG8_MMA(0, 1, At, B1); PG8_BAR;
            PG8_LDA(At, 1, 1); PG8_STAGE(PG8_SA(1, 0), a3, voffA);
            PG8_BAR; PG8_WAIT_L(0); PG8_MMA(1, 0, At, B0); PG8_BAR; PG8_SCHED;
            PG8_STAGE(PG8_SB(1, 1), b3 + hstep, voffB);
            PG8_WAIT_V(6); PG8_BAR; PG8_MMA(1, 1, At, B1); PG8_BAR;
            }
        }
        if constexpr (ALIGN_EPI) { if (wr == 0) PG8_BAR; }
        if constexpr (!Epi::AFTER_DRAIN) { E(acc, cur, wr, wc, fr, fq); S.done(cur); }
        if (!has_next) break;
#pragma unroll
        for (int a = 0; a < 2; ++a)
#pragma unroll
            for (int b = 0; b < 2; ++b)
#pragma unroll
                for (int m = 0; m < 4; ++m)
#pragma unroll
                    for (int n = 0; n < 2; ++n) acc[a][b][m][n] = (f32x4){0.f, 0.f, 0.f, 0.f};
        cur = nxt; cA = nA; cB = nB; ++ui;
        if constexpr (ALIGN_EPI) { if (wr == 1) PG8_BAR; }
    }
    PG8_WAIT_V(0);
    if constexpr (!ALIGN_EPI) { if (wr == 0) PG8_BAR; }
    PG8_BAR;
    if constexpr (Epi::AFTER_DRAIN) { E.fused(acc, cur, wr, wc, fr, fq, lds, wid, lane); S.done(cur); }
#undef PG8_SA
#undef PG8_SB
#undef PG8_STAGE
#undef PG8_LDA
#undef PG8_LDB
#undef PG8_MMA
#undef PG8_WAIT_V
#undef PG8_WAIT_L
#undef PG8_BAR
#undef PG8_SCHED
}
}

struct Params {
    const float* in[22];
    float* out;
    unsigned char* ws;
    int ph_lo, ph_hi;
};
struct Ctx { LAS unsigned char* lds; int tid, lane, wave, vcu, G, gw, ngw; unsigned long long ta, tb, tc; unsigned tacc[4]; };

__device__ __forceinline__ void p0_transpose_item(const float* W, int K, int Nreal, int thresh, const float* ksc, bf16_t* WT, LAS float* scr, int item, int nblk, int lane) {
    const int kb = item / nblk, nb = item % nblk, k0 = 64 * kb, n0 = 32 * nb;
    const int nr0 = n0 + (n0 >= thresh ? 8 : 0);
#pragma unroll 8
    for (int i = 0; i < 32; ++i) {
        const int kk = 2 * i + (lane >> 5);
        const float sc = ksc ? ksc[k0 + kk] : 1.f;
        scr[kk * 33 + (lane & 31)] = W[(size_t)(k0 + kk) * Nreal + nr0 + (lane & 31)] * sc;
    }
    LDS_WAIT(); asm volatile("" ::: "memory");
    const int c = lane & 7;
#pragma unroll
    for (int j = 0; j < 4; ++j) {
        const int n = (lane >> 3) + 8 * j; const LAS float* s = scr + (8 * c) * 33 + n;
        u32x4 o; o.x = pk2(s[0 * 33], s[1 * 33]); o.y = pk2(s[2 * 33], s[3 * 33]); o.z = pk2(s[4 * 33], s[5 * 33]); o.w = pk2(s[6 * 33], s[7 * 33]);
        *(u32x4*)(WT + (size_t)(n0 + n) * K + k0 + 8 * c) = o;
    }
    LDS_WAIT(); asm volatile("" ::: "memory");
}

__device__ __forceinline__ void phase0(const Params& p, Ctx& F) {
    const float* x = p.in[0]; const float* mixw = p.in[1]; const float* w_in = p.in[2];
    const float* w_out = p.in[16]; const float* ffnw = p.in[17]; const float* w_q = p.in[18]; const float* keys = p.in[19];
    const float* pu = p.in[20]; const float* pv = p.in[21];
    unsigned char* ws = p.ws;
    LAS float* scr = (LAS float*)(F.lds + F.wave * 8448);
    LAS float* wdt = (LAS float*)(F.lds + 69632);
    {
        constexpr int WLD = 132;
        LAS float* WQS = (LAS float*)F.lds;
        LAS float* KYS = (LAS float*)(F.lds + 64 * WLD * 4);
        bf16_t* wefft = (bf16_t*)(ws + WS_WQT);
        for (int u = F.vcu; u < 256; u += F.G) {
            const int hj = u >> 4, kt = u & 15;
            __syncthreads();
#pragma unroll
            for (int i = 0; i < 4; ++i) {
                const int pc = F.tid + 512 * i, k = pc >> 5, d4 = pc & 31;
                const f32x4 v = *(const f32x4*)(w_q + (size_t)(64 * kt + k) * 2048 + hj * 128 + d4 * 4);
                *(LAS f32x4*)(WQS + k * WLD + d4 * 4) = v * ffnw[64 * kt + k];
            }
#pragma unroll
            for (int i = 0; i < 8; ++i) {
                const int pc = F.tid + 512 * i, n = pc >> 5, d4 = pc & 31;
                *(LAS f32x4*)(KYS + n * WLD + d4 * 4) = *(const f32x4*)(keys + ((size_t)hj * 128 + n) * 128 + d4 * 4);
            }
            __syncthreads();
            const int fr_ = F.lane & 15, fq_ = F.lane >> 4, mt = F.wave >> 1, nt0 = (F.wave & 1) * 4;
            f32x4 acc[4];
#pragma unroll
            for (int q = 0; q < 4; ++q) acc[q] = (f32x4){0.f, 0.f, 0.f, 0.f};
#pragma unroll 4
            for (int ks = 0; ks < 32; ++ks) {
                const float av = WQS[(mt * 16 + fr_) * WLD + 4 * ks + fq_];
#pragma unroll
                for (int q = 0; q < 4; ++q) {
                    const float bv = KYS[((nt0 + q) * 16 + fr_) * WLD + 4 * ks + fq_];
                    acc[q] = __builtin_amdgcn_mfma_f32_16x16x4f32(av, bv, acc[q], 0, 0, 0);
                }
            }
#pragma unroll
            for (int q = 0; q < 4; ++q) {
                u32x2 w; w.x = pk2(acc[q][0], acc[q][1]); w.y = pk2(acc[q][2], acc[q][3]);
                *(u32x2*)(wefft + ((size_t)hj * 128 + (nt0 + q) * 16 + fr_) * DM + 64 * kt + mt * 16 + 4 * fq_) = w;
            }
        }
        __syncthreads();
    }
    for (int k = F.tid; k < DM; k += 512) {
        const float s = mixw[k];
        const f32x4 a = *(const f32x4*)(w_in + (size_t)k * 3080 + 1536), b = *(const f32x4*)(w_in + (size_t)k * 3080 + 1540);
        *(LAS f32x4*)(wdt + k * 8) = a * s; *(LAS f32x4*)(wdt + k * 8 + 4) = b * s;
    }
    __syncthreads();
    constexpr int I_IN = 16 * 96, I_OUT = 16 * 32;
    for (int it = F.gw; it < I_IN + I_OUT; it += F.ngw) {
        int r = it;
        if (r < I_IN) { p0_transpose_item(w_in, DM, 3080, 1536, mixw, (bf16_t*)(ws + WS_WINT), scr, r, 96, F.lane); continue; } r -= I_IN;
        p0_transpose_item(w_out, DM, DM, 1 << 30, nullptr, (bf16_t*)(ws + WS_WOUTT), scr, r, 32, F.lane);
    }
    const int gtid = F.vcu * 512 + F.tid, nthr = F.G * 512;
    for (int i = gtid; i < TOK; i += nthr) ((float*)(ws + WS_CTL) + CW_ROWSQ)[i] = 0.f;
    for (int i = gtid; i < SEQ * 8; i += nthr) {
        const int pos = i >> 3, f = i & 7;
        const float inv = powf(500000.0f, -(float)(2 * f) / 16.0f);
        const float ang = (float)pos * inv;
        float rv_ = ang * 0.15915494309189535f; rv_ -= rintf(rv_);
        ((float*)(ws + WS_ROPE))[i] = __builtin_amdgcn_cosf(rv_);
        ((float*)(ws + WS_ROPE))[SEQ * 8 + i] = __builtin_amdgcn_sinf(rv_);
    }
#if defined(PROBE_PHASE) && (PROBE_PHASE == 83 || PROBE_PHASE == 84)
    if (F.gw == 0 && F.lane == 0) { unsigned* mw = (unsigned*)(ws + WS_MISC); mw[2] = 0u; mw[3] = 0xffffffffu; mw[4] = 0u; }
#endif
    if (F.gw == 0) {
        const float a = p.in[11][F.lane] * p.in[12][F.lane], b = p.in[13][F.lane] * p.in[14][F.lane];
        const float sa = wave_sum(a), sb = wave_sum(b);
        if (F.lane == 0) ((float*)(ws + WS_MISC))[0] = expf(sa) - expf(sb) + LAMBDA_INIT;
        const float qm = wave_max(fabsf(p.in[9][F.lane])), km = wave_max(fabsf(p.in[10][F.lane]));
        if (F.lane == 0) ((float*)(ws + WS_MISC))[1] = 64.f * qm * km * 0.18033688011112042f * 1.02f;
    }
    {
        float* rsu = (float*)(ws + WS_RSU); float* rsv = (float*)(ws + WS_RSV);
        for (int r0 = F.gw; r0 < 2 * 16384; r0 += 4 * F.ngw) {
            f32x4 a[4][4]; float amax[4];
#pragma unroll
            for (int u = 0; u < 4; ++u) {
                const int r = min(r0 + u * F.ngw, 2 * 16384 - 1); const bool isU = r < 16384; const int e = r & 16383;
                const float* src = (isU ? pu : pv) + (size_t)e * DM + 16 * F.lane;
#pragma unroll
                for (int q = 0; q < 4; ++q) a[u][q] = __builtin_nontemporal_load((const f32x4*)(src + 4 * q));
            }
#pragma unroll
            for (int u = 0; u < 4; ++u) {
                const int r = min(r0 + u * F.ngw, 2 * 16384 - 1); const bool isU = r < 16384;
                amax[u] = 0.f;
#pragma unroll
                for (int q = 0; q < 4; ++q) {
                    if (isU) a[u][q] = a[u][q] * *(const f32x4*)(ffnw + 16 * F.lane + 4 * q);
                    amax[u] = fmaxf(amax[u], fmaxf(fmaxf(fabsf(a[u][q][0]), fabsf(a[u][q][1])), fmaxf(fabsf(a[u][q][2]), fabsf(a[u][q][3]))));
                }
            }
#pragma unroll
            for (int u = 0; u < 4; ++u) amax[u] = wave_max(amax[u]);
#pragma unroll
            for (int u = 0; u < 4; ++u) {
                const int r = min(r0 + u * F.ngw, 2 * 16384 - 1); const bool isU = r < 16384; const int e = r & 16383;
#ifdef U_FP4
#ifdef V_FP4
#define V_FP4_ON 1
#else
#define V_FP4_ON 0
#endif
#ifndef FP4_NIB_SWAP
#define FP4_NIB_SWAP 0
#endif
                if (isU || V_FP4_ON) {
                    const float s4 = amax[u] > 0.f ? 6.f / amax[u] : 1.f;
                    if (F.lane == 0) (isU ? rsu : rsv)[e] = amax[u] > 0.f ? amax[u] * (1.f / 6.f) : 1.f;
                    u32x2 o4;
#pragma unroll
                    for (int hq = 0; hq < 2; ++hq) {
                        unsigned w = 0u;
#pragma unroll
                        for (int q2 = 0; q2 < 2; ++q2)
#pragma unroll
                            for (int el = 0; el < 4; ++el) {
                                const float qv = a[u][hq * 2 + q2][el] * s4, m = fabsf(qv);
                                const unsigned c = (unsigned)(m > 0.25f) + (unsigned)(m > 0.75f) + (unsigned)(m > 1.25f) + (unsigned)(m > 1.75f) + (unsigned)(m > 2.5f) + (unsigned)(m > 3.5f) + (unsigned)(m > 5.0f)
                                                 + (qv < 0.f ? 8u : 0u);
                                w |= c << (4 * ((q2 * 4 + el) ^ FP4_NIB_SWAP));
                            }
                        o4[hq] = w;
                    }
                    *(u32x2*)(ws + (isU ? WS_UB : WS_VB) + (size_t)e * (DM / 2) + 8 * F.lane) = o4;
                    continue;
                }
#endif
                const float sc = amax[u] > 0.f ? 240.f / amax[u] : 1.f;
                if (F.lane == 0) (isU ? rsu : rsv)[e] = amax[u] > 0.f ? amax[u] * (1.f / 240.f) : 1.f;
                u32x4 o;
#pragma unroll
                for (int q = 0; q < 4; ++q) {
                    int pk = 0;
                    pk = __builtin_amdgcn_cvt_pk_fp8_f32(a[u][q][0] * sc, a[u][q][1] * sc, pk, false);
                    pk = __builtin_amdgcn_cvt_pk_fp8_f32(a[u][q][2] * sc, a[u][q][3] * sc, pk, true);
                    o[q] = (unsigned)pk;
                }
                *(u32x4*)(ws + (isU ? WS_UB : WS_VB) + (size_t)e * DM + 16 * F.lane) = o;
            }
        }
    }
    bf16_t* xb = (bf16_t*)(ws + WS_XB); float* dtraw = (float*)(ws + WS_DTRAW);
    for (int m0 = F.gw; m0 < TOK; m0 += 2 * F.ngw) {
        f32x4 v[2][4]; float ss[2];
#pragma unroll
        for (int u = 0; u < 2; ++u) {
            const int m = m0 + u * F.ngw; ss[u] = 0.f;
            const f32x4* xr = (const f32x4*)(x + (size_t)(m < TOK ? m : m0) * DM) + F.lane;
#pragma unroll
            for (int j = 0; j < 4; ++j) v[u][j] = __builtin_nontemporal_load(xr + 64 * j);
        }
#pragma unroll
        for (int u = 0; u < 2; ++u)
#pragma unroll
            for (int j = 0; j < 4; ++j) ss[u] += (v[u][j][0] * v[u][j][0] + v[u][j][1] * v[u][j][1]) + (v[u][j][2] * v[u][j][2] + v[u][j][3] * v[u][j][3]);
        f32x4 d0[2], d1[2];
#pragma unroll
        for (int u = 0; u < 2; ++u) { d0[u] = (f32x4){0.f, 0.f, 0.f, 0.f}; d1[u] = (f32x4){0.f, 0.f, 0.f, 0.f}; }
#pragma unroll
        for (int j = 0; j < 4; ++j)
#pragma unroll
            for (int e = 0; e < 4; ++e) {
                const int k = 256 * j + 4 * F.lane + e;
                const f32x4 w0 = *(const LAS f32x4*)(wdt + k * 8), w1 = *(const LAS f32x4*)(wdt + k * 8 + 4);
#pragma unroll
                for (int u = 0; u < 2; ++u) { d0[u] += w0 * v[u][j][e]; d1[u] += w1 * v[u][j][e]; }
            }
#pragma unroll
        for (int u = 0; u < 2; ++u) {
            ss[u] = wave_sum(ss[u]);
#pragma unroll
            for (int e = 0; e < 4; ++e) { d0[u][e] = wave_sum(d0[u][e]); d1[u][e] = wave_sum(d1[u][e]); }
        }
#pragma unroll
        for (int u = 0; u < 2; ++u) {
            const int m = m0 + u * F.ngw;
            if (m < TOK) {
                const float r = rsqrtf(ss[u] * (1.f / DM) + EPSN);
                if (F.lane == 0) ((float*)(ws + WS_RSTD))[m] = sqrtf(ss[u] * (1.f / DM) + EPSN);
                if (F.lane == 0) { *(f32x4*)(dtraw + (size_t)m * 8) = d0[u] * r; *(f32x4*)(dtraw + (size_t)m * 8 + 4) = d1[u] * r; }
                unsigned long long* o8 = (unsigned long long*)(xb + (size_t)m * DM) + F.lane;
#pragma unroll
                for (int j = 0; j < 4; ++j) o8[64 * j] = (unsigned long long)pk2(v[u][j][0] * r, v[u][j][1] * r) | ((unsigned long long)pk2(v[u][j][2] * r, v[u][j][3] * r) << 32);
            }
        }
    }
}

__device__ __forceinline__ void p2_qk_prepass(const Params& p, Ctx& F) {
    bf16_t* proj = (bf16_t*)(p.ws + WS_PROJ);
    const float* qnw = p.in[9]; const float* knw = p.in[10];
    const float* cosT = (const float*)(p.ws + WS_ROPE); const float* sinT = cosT + SEQ * 8;
    const int sub = F.lane & 7;
    float wq[8], wk[8];
#pragma unroll
    for (int e = 0; e < 8; ++e) { wq[e] = qnw[sub * 8 + e]; wk[e] = knw[sub * 8 + e]; }
    for (int base = F.gw; base < TOK * 2; base += 8 * F.ngw) {
        u32x4 raw[8];
#pragma unroll
        for (int u = 0; u < 8; ++u) {
            const int wsi = base + u * F.ngw;
            raw[u] = (wsi < TOK * 2) ? *(const u32x4*)(proj + (size_t)(wsi >> 1) * NIN + ((wsi & 1) ? PK : PQ) + F.lane * 8) : (u32x4){0u, 0u, 0u, 0u};
        }
#pragma unroll
        for (int u = 0; u < 8; ++u) {
            const int wsi = base + u * F.ngw;
            const int t = wsi >> 1, which = wsi & 1;
            float v[8];
#pragma unroll
            for (int e = 0; e < 4; ++e) { v[2 * e] = bf2f(raw[u][e] & 0xffffu); v[2 * e + 1] = bf2f(raw[u][e] >> 16); }
            float ss = 0.f;
#pragma unroll
            for (int e = 0; e < 8; ++e) ss += v[e] * v[e];
            ss += __shfl_xor(ss, 1); ss += __shfl_xor(ss, 2); ss += __shfl_xor(ss, 4);
            const float rs = rsqrtf(ss * (1.f / 64.f) + EPSN);
            const int pos = t & (SEQ - 1);
            float o[8];
#pragma unroll
            for (int e = 0; e < 8; ++e) {
                const float y = v[e] * rs * (which ? wk[e] : wq[e]);
                const float other = __shfl_xor(y, 1);
                float r = y;
                if (sub < 2) {
                    const float c = cosT[pos * 8 + e], sn = sinT[pos * 8 + e];
                    r = (sub == 0) ? (y * c - other * sn) : (other * sn + y * c);
                }
                o[e] = r;
            }
            u32x4 ov; ov.x = pk2(o[0], o[1]); ov.y = pk2(o[2], o[3]); ov.z = pk2(o[4], o[5]); ov.w = pk2(o[6], o[7]);
            if (wsi < TOK * 2) *(u32x4*)(proj + (size_t)t * NIN + (which ? PK : PQ) + F.lane * 8) = ov;
        }
    }
}

constexpr int P2_XS = 0, P2_BM = 33792, P2_CM = 51200, P2_CB = 68608, P2_MH = 85248, P2_XW = 122112, P2_ACS = 155904, P2_DT = 156928, P2_FAC = 157952;
constexpr int XS_LD = 264, BM_LD = 136, MH_LD = 72, CB_LD = 65;
static_assert(P2_FAC + 1024 <= LDS_BYTES, "P2 LDS");

__device__ __forceinline__ void p2_load_raw(const bf16_t* proj, int tid, int b, int c, int g, u32x4 (&rv)[11]) {
    const int cg = tid & 63, rg = tid >> 6, lc = cg * 8;
    const int pcol = lc < 256 ? PXS + g * 256 + lc : (lc < 384 ? PBM + g * 128 + (lc - 256) : PCM + g * 128 + (lc - 384));
#pragma unroll
    for (int i = 0; i < 11; ++i) {
        const int f = c * CHUNK + rg * 8 - 3 + i;
        u32x4 v = {0u, 0u, 0u, 0u};
        if (f >= 0) v = *(const u32x4*)(proj + ((size_t)b * SEQ + f) * NIN + pcol);
        rv[i] = v;
    }
}
__device__ __forceinline__ void p2_ssd_unit(const Params& p, Ctx& F, int b, int c, int g, u32x4 (&rv)[11], bool has_next, int nb, int nc, int ng) {
    unsigned char* ws = p.ws;
    const bf16_t* proj = (const bf16_t*)(ws + WS_PROJ);
    bf16_t* ycat = (bf16_t*)(ws + WS_YCAT); bf16_t* cmc = (bf16_t*)(ws + WS_CMC);
    bf16_t* states = (bf16_t*)(ws + WS_STATES); float* acs_g = (float*)(ws + WS_ACS); float* cdec = (float*)(ws + WS_CDEC);
    const float* dtraw = (const float*)(ws + WS_DTRAW);
    const float* conv_w = p.in[3]; const float* conv_b = p.in[4]; const float* dt_bias = p.in[5]; const float* a_log = p.in[6]; const float* d_skip = p.in[7];
    LAS bf16_t* XS = (LAS bf16_t*)(F.lds + P2_XS); LAS bf16_t* BM = (LAS bf16_t*)(F.lds + P2_BM); LAS bf16_t* CM = (LAS bf16_t*)(F.lds + P2_CM);
    LAS float* CB = (LAS float*)(F.lds + P2_CB); LAS bf16_t* MH = (LAS bf16_t*)(F.lds + P2_MH); LAS bf16_t* XW = (LAS bf16_t*)(F.lds + P2_XW);
    LAS float* ACS = (LAS float*)(F.lds + P2_ACS); LAS float* DT = (LAS float*)(F.lds + P2_DT); LAS float* FAC = (LAS float*)(F.lds + P2_FAC);
    const int tid = F.tid, lane = F.lane, wave = F.wave, fr = lane & 15, fq = lane >> 4;
    const size_t tbase = (size_t)b * SEQ + (size_t)c * CHUNK;
    float dtr_ = 0.f, dtb_ = 0.f, alg_ = 0.f;
    if (tid < 256) { const int l_ = tid >> 2, hh_ = g * 4 + (tid & 3); dtr_ = dtraw[(tbase + l_) * 8 + hh_]; dtb_ = dt_bias[hh_]; alg_ = a_log[hh_]; }
#ifndef SKIP_A
    {
        const int cg = tid & 63, rg = tid >> 6, lc = cg * 8;
        int pcol, dld, dcol, kind;
        if (lc < 256) { pcol = PXS + g * 256 + lc; dld = XS_LD; dcol = lc; kind = 0; }
        else if (lc < 384) { pcol = PBM + g * 128 + (lc - 256); dld = BM_LD; dcol = lc - 256; kind = 1; }
        else { pcol = PCM + g * 128 + (lc - 384); dld = BM_LD; dcol = lc - 384; kind = 2; }
        LAS bf16_t* dst = kind == 0 ? XS : (kind == 1 ? BM : CM);
        const int ch = pcol - 512;
        float cw[4][8], cbv[8];
#pragma unroll
        for (int w = 0; w < 4; ++w) {
            const f32x4 a = *(const f32x4*)(conv_w + w * 1024 + ch), bq = *(const f32x4*)(conv_w + w * 1024 + ch + 4);
#pragma unroll
            for (int e = 0; e < 4; ++e) { cw[w][e] = a[e]; cw[w][4 + e] = bq[e]; }
        }
        { const f32x4 a = *(const f32x4*)(conv_b + ch), bq = *(const f32x4*)(conv_b + ch + 4);
#pragma unroll
          for (int e = 0; e < 4; ++e) { cbv[e] = a[e]; cbv[4 + e] = bq[e]; } }
#pragma unroll
        for (int r = 0; r < 8; ++r) {
            const int l = rg * 8 + r;
            float o[8];
#pragma unroll
            for (int e = 0; e < 8; ++e) o[e] = cbv[e];
#pragma unroll
            for (int w = 0; w < 4; ++w)
#pragma unroll
                for (int e = 0; e < 4; ++e) {
                    o[2 * e] += cw[w][2 * e] * bf2f(rv[r + w][e] & 0xffffu);
                    o[2 * e + 1] += cw[w][2 * e + 1] * bf2f(rv[r + w][e] >> 16);
                }
#pragma unroll
            for (int e = 0; e < 8; ++e) o[e] = silu_f(o[e]);
            u32x4 ov; ov.x = pk2(o[0], o[1]); ov.y = pk2(o[2], o[3]); ov.z = pk2(o[4], o[5]); ov.w = pk2(o[6], o[7]);
            *(LAS u32x4*)(dst + l * dld + dcol) = ov;
            if (kind == 2) *(u32x4*)(cmc + (tbase + l) * 256 + g * 128 + dcol) = ov;
        }
    }
#endif
    if (has_next) p2_load_raw(proj, tid, nb, nc, ng, rv);
    if (tid < 256) {
        const int l = tid >> 2, h = tid & 3;
        const float v = dtr_ + dtb_;
        const float ev_ = __expf(v);
        const float dt = v > 20.f ? v : (v < -5.f ? ev_ * (1.f - 0.5f * ev_) : __logf(1.f + ev_));
        DT[l * 4 + h] = dt;
        ACS[l * 4 + h] = dt * (-__expf(alg_));
    }
    __syncthreads();
    if (wave < 4) {
        float s = ACS[lane * 4 + wave];
        s += DPP_F(s, 0x111); s += DPP_F(s, 0x112); s += DPP_F(s, 0x114); s += DPP_F(s, 0x118);
        {
            const float t0 = __uint_as_float(__builtin_amdgcn_readlane(__float_as_uint(s), 15)), t1 = __uint_as_float(__builtin_amdgcn_readlane(__float_as_uint(s), 31)),
                        t2 = __uint_as_float(__builtin_amdgcn_readlane(__float_as_uint(s), 47));
            const int row = lane >> 4;
            s += (row >= 1 ? t0 : 0.f) + (row >= 2 ? t1 : 0.f) + (row >= 3 ? t2 : 0.f);
        }
        ACS[lane * 4 + wave] = s;
        if (lane == 63) cdec[((size_t)b * NCH + c) * 8 + g * 4 + wave] = __expf(s);
    }
    __syncthreads();
    if (tid < 256) {
        const int l = tid >> 2, h = tid & 3;
        acs_g[(tbase + l) * 8 + g * 4 + h] = ACS[l * 4 + h];
        FAC[l * 4 + h] = DT[l * 4 + h] * __expf(ACS[63 * 4 + h] - ACS[l * 4 + h]);
    }
#pragma unroll
    for (int q = 0; q < 2; ++q) {
        const int tile = wave * 2 + q, mt = tile >> 2, nt = tile & 3;
        f32x4 acc = {0.f, 0.f, 0.f, 0.f};
#pragma unroll
        for (int ks = 0; ks < 4; ++ks) {
            const bf16x8 a = *(const LAS bf16x8*)(CM + (mt * 16 + fr) * BM_LD + ks * 32 + fq * 8);
            const bf16x8 bq = *(const LAS bf16x8*)(BM + (nt * 16 + fr) * BM_LD + ks * 32 + fq * 8);
            acc = mfma16(a, bq, acc);
        }
#pragma unroll
        for (int j = 0; j < 4; ++j) CB[(mt * 16 + 4 * fq + j) * CB_LD + nt * 16 + fr] = acc[j];
    }
    __syncthreads();
    {
        const int sI = lane;
        float as_[4], ds_[4];
#pragma unroll
        for (int h = 0; h < 4; ++h) { as_[h] = ACS[sI * 4 + h]; ds_[h] = DT[sI * 4 + h]; }
#pragma unroll 2
        for (int li = 0; li < 8; ++li) {
            const int l = li * 8 + wave;
            const float cb = CB[l * CB_LD + sI];
#pragma unroll
            for (int h = 0; h < 4; ++h) {
                const float v = (sI <= l) ? cb * __expf(ACS[l * 4 + h] - as_[h]) * ds_[h] : 0.f;
                MH[(h * 64 + l) * MH_LD + sI] = (bf16_t)f2bf(v);
            }
        }
#pragma unroll
        for (int i = 0; i < 4; ++i) {
            const int pc = tid + 512 * i, l = pc >> 5, c8 = pc & 31;
            const u32x4 xv = *(const LAS u32x4*)(XS + l * XS_LD + c8 * 8);
            const float f = FAC[l * 4 + (c8 >> 3)];
            u32x4 o;
#pragma unroll
            for (int e = 0; e < 4; ++e) o[e] = pk2(bf2f(xv[e] & 0xffffu) * f, bf2f(xv[e] >> 16) * f);
            *(LAS u32x4*)(XW + l * XS_LD + c8 * 8) = o;
        }
    }
    __syncthreads();
    typedef short v4i16 __attribute__((ext_vector_type(4)));
#define TR16(PTR) __builtin_amdgcn_ds_read_tr16_b64_v4i16((LAS v4i16*)(PTR))
#define CAT8(LO, HI) (bf16x8){LO[0], LO[1], LO[2], LO[3], HI[0], HI[1], HI[2], HI[3]}
    const int trr = fr >> 2, trc = 4 * (fr & 3);
#ifndef SKIP_E
    {
        const int h = wave >> 1, hh = g * 4 + h; const float dsk = d_skip[hh];
#pragma unroll 1
        for (int mq = 0; mq < 2; ++mq) {
            const int lt = 2 * (wave & 1) + mq;
            bf16x8 bmh[2];
#pragma unroll
            for (int ks = 0; ks < 2; ++ks) bmh[ks] = *(const LAS bf16x8*)(MH + (h * 64 + lt * 16 + fr) * MH_LD + ks * 32 + fq * 8);
#pragma unroll 1
            for (int pg = 0; pg < 2; ++pg) {
                f32x4 acc0 = {0.f, 0.f, 0.f, 0.f}, acc1 = acc0;
#pragma unroll
                for (int ks = 0; ks < 2; ++ks) {
                    const LAS bf16_t* bp = XS + (ks * 32 + 8 * fq + trr) * XS_LD + h * 64 + pg * 32 + 2 * trc;
                    const v4i16 lo0 = TR16(bp), hi0 = TR16(bp + 4 * XS_LD), lo1 = TR16(bp + 4), hi1 = TR16(bp + 4 + 4 * XS_LD);
                    acc0 = mfma16(CAT8(lo0, hi0), bmh[ks], acc0);
                    acc1 = mfma16(CAT8(lo1, hi1), bmh[ks], acc1);
                }
                const int l = lt * 16 + fr, pp = pg * 32 + 8 * fq;
                const u32x4 xv = *(const LAS u32x4*)(XS + l * XS_LD + h * 64 + pp);
                u32x4 w;
                w.x = pk2(acc0[0] + bf2f(xv.x & 0xffffu) * dsk, acc0[1] + bf2f(xv.x >> 16) * dsk);
                w.y = pk2(acc0[2] + bf2f(xv.y & 0xffffu) * dsk, acc0[3] + bf2f(xv.y >> 16) * dsk);
                w.z = pk2(acc1[0] + bf2f(xv.z & 0xffffu) * dsk, acc1[1] + bf2f(xv.z >> 16) * dsk);
                w.w = pk2(acc1[2] + bf2f(xv.w & 0xffffu) * dsk, acc1[3] + bf2f(xv.w >> 16) * dsk);
                *(u32x4*)(ycat + (tbase + l) * DM + g * 256 + h * 64 + pp) = w;
            }
        }
    }
#endif
#ifndef SKIP_F
    {
        const int h = wave >> 1, hh = g * 4 + h;
        unsigned char* s8base = (unsigned char*)p.out + OUT_S8 + ((((size_t)b * NCH + c) * 8 + hh) * 64) * 128;
        float* ssc = (float*)(ws + WS_SSC) + (((size_t)b * 8 + hh) * 64) * 64;
#pragma unroll 1
        for (int mq = 0; mq < 2; ++mq) {
            const int mt = 2 * (wave & 1) + mq;
            bf16x8 xw[2];
#pragma unroll
            for (int ks = 0; ks < 2; ++ks) {
                const LAS bf16_t* bp = XW + (ks * 32 + 8 * fq + trr) * XS_LD + h * 64 + mt * 16 + trc;
                const v4i16 lo = TR16(bp), hi = TR16(bp + 4 * XS_LD);
                xw[ks] = CAT8(lo, hi);
            }
            f32x4 acc[2][4]; float am = 0.f;
#pragma unroll
            for (int ngp = 0; ngp < 2; ++ngp)
#pragma unroll
                for (int sq = 0; sq < 4; ++sq) {
                    f32x4 a = {0.f, 0.f, 0.f, 0.f};
#pragma unroll
                    for (int ks = 0; ks < 2; ++ks) {
                        const LAS bf16_t* ap = BM + (ks * 32 + 8 * fq + trr) * BM_LD + ngp * 64 + 4 * trc + 4 * sq;
                        const v4i16 lo = TR16(ap), hi = TR16(ap + 4 * BM_LD);
                        a = mfma16(CAT8(lo, hi), xw[ks], a);
                    }
                    acc[ngp][sq] = a;
                    am = fmaxf(am, fmaxf(fmaxf(fabsf(a[0]), fabsf(a[1])), fmaxf(fabsf(a[2]), fabsf(a[3]))));
                }
            am = fmaxf(am, __shfl_xor(am, 16)); am = fmaxf(am, __shfl_xor(am, 32));
            const float sc = am > 0.f ? 448.f / am : 1.f;
            if (fq == 0) ssc[(mt * 16 + fr) * 64 + c] = am > 0.f ? am * (1.f / 448.f) : 1.f;
#pragma unroll
            for (int ngp = 0; ngp < 2; ++ngp) {
                u32x4 w;
#pragma unroll
                for (int sq = 0; sq < 4; ++sq) {
                    int pk = 0;
                    pk = __builtin_amdgcn_cvt_pk_fp8_f32(acc[ngp][sq][0] * sc, acc[ngp][sq][1] * sc, pk, false);
                    pk = __builtin_amdgcn_cvt_pk_fp8_f32(acc[ngp][sq][2] * sc, acc[ngp][sq][3] * sc, pk, true);
                    w[sq] = (unsigned)pk;
                }
                *(u32x4*)(s8base + (size_t)(mt * 16 + fr) * 128 + ngp * 64 + 16 * fq) = w;
            }
        }
    }
#undef TR16
#undef CAT8
#endif
    __syncthreads();
}

__device__ __forceinline__ void phase2(const Params& p, Ctx& F) {
#if defined(PROBE_PHASE) && (PROBE_PHASE == 20 || PROBE_PHASE == 21)
    F.ta = __builtin_amdgcn_s_memrealtime();
#endif
#ifdef USE_QK_PREPASS
    p2_qk_prepass(p, F);
#endif
#if defined(PROBE_PHASE) && (PROBE_PHASE == 20 || PROBE_PHASE == 21)
    VM_WAIT(); F.tb = __builtin_amdgcn_s_memrealtime();
#endif
    {
        const bf16_t* proj = (const bf16_t*)(p.ws + WS_PROJ);
        u32x4 rv[11];
        if (F.vcu < NB * NCH * 2) p2_load_raw(proj, F.tid, F.vcu >> 7, (F.vcu >> 1) & 63, F.vcu & 1, rv);
        for (int u = F.vcu; u < NB * NCH * 2; u += F.G) {
            const int g = u & 1, c = (u >> 1) & 63, b = u >> 7;
            const int un = u + F.G;
            p2_ssd_unit(p, F, b, c, g, rv, un < NB * NCH * 2, un >> 7, (un >> 1) & 63, un & 1);
        }
    }
#if defined(PROBE_PHASE) && (PROBE_PHASE == 20 || PROBE_PHASE == 21)
    VM_WAIT(); F.tc = __builtin_amdgcn_s_memrealtime();
#endif
}

__device__ __forceinline__ void p3_scan(const Params& p, Ctx& F) {
    const float* cdec = (const float*)(p.ws + WS_CDEC);
    unsigned char* s8 = (unsigned char*)p.out + OUT_S8; const float* ssc = (const float*)(p.ws + WS_SSC); float* tsc = (float*)(p.ws + WS_TSC);
    const int gtid = F.vcu * 512 + F.tid, nthr = F.G * 512;
    for (int e = gtid; e < NB * 8 * 64 * 32; e += nthr) {
        const int n4 = e & 31, pp = (e >> 5) & 63, hh = (e >> 11) & 7, b = e >> 14;
        const float* scr_ = ssc + (((size_t)b * 8 + hh) * 64 + pp) * 64;
        f32x4 carry = {0.f, 0.f, 0.f, 0.f}; float bound = 0.f;
        unsigned sA[16], sB[16]; float dA[16], dB[16]; f32x4 lA[4], lB[4];
#define SC_LOAD(S, D, L, C0) do { _Pragma("unroll") for (int i = 0; i < 16; ++i) { \
            S[i] = *(const unsigned*)(s8 + ((((size_t)b * NCH + (C0) + i) * 8 + hh) * 64 + pp) * 128 + n4 * 4); D[i] = cdec[((size_t)b * NCH + (C0) + i) * 8 + hh]; } \
            _Pragma("unroll") for (int i = 0; i < 4; ++i) L[i] = *(const f32x4*)(scr_ + (C0) + 4 * i); } while (0)
#define SC_PROC(S, D, L, C0) do { _Pragma("unroll") for (int i = 0; i < 16; ++i) { \
            const float tq = bound > 0.f ? bound * (1.f / 448.f) : 1.f, ti = bound > 0.f ? 448.f / bound : 1.f; \
            int pk = 0; \
            pk = __builtin_amdgcn_cvt_pk_fp8_f32(carry[0] * ti, carry[1] * ti, pk, false); \
            pk = __builtin_amdgcn_cvt_pk_fp8_f32(carry[2] * ti, carry[3] * ti, pk, true); \
            *(unsigned*)(s8 + ((((size_t)b * NCH + (C0) + i) * 8 + hh) * 64 + pp) * 128 + n4 * 4) = (unsigned)pk; \
            if (n4 == 0) tsc[(((size_t)b * NCH + (C0) + i) * 8 + hh) * 64 + pp] = tq; \
            const auto lo = __builtin_amdgcn_cvt_pk_f32_fp8((int)S[i], false), hi = __builtin_amdgcn_cvt_pk_f32_fp8((int)S[i], true); \
            const float q = L[i >> 2][i & 3]; \
            const f32x4 sv = {lo[0] * q, lo[1] * q, hi[0] * q, hi[1] * q}; \
            carry = carry * D[i] + sv; bound = bound * D[i] + q * 448.f; } } while (0)
        SC_LOAD(sA, dA, lA, 0);
        SC_LOAD(sB, dB, lB, 16);
        SC_PROC(sA, dA, lA, 0);
        SC_LOAD(sA, dA, lA, 32);
        SC_PROC(sB, dB, lB, 16);
        SC_LOAD(sB, dB, lB, 48);
        SC_PROC(sA, dA, lA, 32);
        SC_PROC(sB, dB, lB, 48);
#undef SC_LOAD
#undef SC_PROC
    }
}

namespace att {
constexpr int NW = 8, QBLK = 32, KVBLK = 64;
constexpr float SCALE = 0.125f, THR = 8.f;
constexpr int SHM_V = KVBLK * 128 * 2, SHM_K = KVBLK * 64 * 2;
constexpr int SLOT = SHM_V + SHM_K, NSLOT = 6, LDS_WS = NSLOT * SLOT, LDS_END = LDS_WS + NW * 64 * 4;
#define KSWZ64(row, colB) ((row) * 128 + ((colB) ^ ((((row) >> 1) & 7) << 4)))
#define SBAR() __builtin_amdgcn_sched_barrier(0)
#if defined(ATT_ABL) && (ATT_ABL == 3 || ATT_ABL == 5 || ATT_ABL == 6)
#define QMMA(a, b, c) (c)
#else
#define QMMA(a, b, c) mfma32(a, b, c)
#endif
__device__ __forceinline__ int crow(int r, int hi) { return (r & 3) + 8 * (r >> 2) + 4 * hi; }
__device__ __forceinline__ unsigned cvtpk(float lo, float hi) { unsigned r; asm volatile("v_cvt_pk_bf16_f32 %0, %1, %2" : "=v"(r) : "v"(lo), "v"(hi)); return r; }

__device__ __forceinline__ void partialSM(f32x16& p0, f32x16& p1, float& m_reg, float& mn, float& alpha) {
#if defined(ATT_ABL) && (ATT_ABL == 4 || ATT_ABL == 5)
    mn = m_reg; alpha = 1.f; return;
#endif
    constexpr float THR2 = THR * 1.4426950408889634f;
    float pmax = p0[0];
#pragma unroll
    for (int r = 1; r < 16; ++r) pmax = fmaxf(pmax, p0[r]);
#pragma unroll
    for (int r = 0; r < 16; ++r) pmax = fmaxf(pmax, p1[r]);
    { auto rr = __builtin_amdgcn_permlane32_swap(__float_as_uint(pmax), __float_as_uint(pmax), false, false);
      pmax = fmaxf(__uint_as_float(rr[0]), __uint_as_float(rr[1])); }
    if (__builtin_expect(__all(pmax - m_reg <= THR2), 1)) { mn = m_reg; alpha = 1.f; }
    else { mn = fmaxf(m_reg, pmax); alpha = __builtin_amdgcn_exp2f(m_reg - mn); m_reg = mn; }
#pragma unroll
    for (int r = 0; r < 16; ++r) p0[r] = p0[r] - mn;
#pragma unroll
    for (int r = 0; r < 16; ++r) p1[r] = p1[r] - mn;
#if !defined(ATT_ABL) || ATT_ABL != 1
#pragma unroll
    for (int r = 0; r < 16; ++r) p0[r] = __builtin_amdgcn_exp2f(p0[r]);
#endif
}
__device__ __forceinline__ void finishSM(f32x16& p0, f32x16& p1, float alpha, float& l_reg, bf16x8& pa0, bf16x8& pa1, bf16x8& pa2, bf16x8& pa3) {
#if !defined(ATT_ABL) || (ATT_ABL != 1 && ATT_ABL != 4 && ATT_ABL != 5)
#pragma unroll
    for (int r = 0; r < 16; ++r) p1[r] = __builtin_amdgcn_exp2f(p1[r]);
#endif
    float ps = 0;
#if !defined(ATT_ABL) || (ATT_ABL != 4 && ATT_ABL != 5)
#pragma unroll
    for (int r = 0; r < 16; ++r) ps += p0[r];
#pragma unroll
    for (int r = 0; r < 16; ++r) ps += p1[r];
#endif
    { auto rr = __builtin_amdgcn_permlane32_swap(__float_as_uint(ps), __float_as_uint(ps), false, false);
      ps = __uint_as_float(rr[0]) + __uint_as_float(rr[1]); }
    l_reg = l_reg * alpha + ps;
#define PK4(P, BASE, OUT) do { unsigned a0 = cvtpk(P[BASE + 0], P[BASE + 1]), a1 = cvtpk(P[BASE + 2], P[BASE + 3]);   \
    unsigned b0 = cvtpk(P[BASE + 4], P[BASE + 5]), b1 = cvtpk(P[BASE + 6], P[BASE + 7]);                              \
    auto r0 = __builtin_amdgcn_permlane32_swap(a0, b0, false, false); auto r1 = __builtin_amdgcn_permlane32_swap(a1, b1, false, false); \
    u32x4 w = {r0[0], r1[0], r0[1], r1[1]}; OUT = *reinterpret_cast<bf16x8*>(&w); } while (0)
    PK4(p0, 0, pa0); PK4(p0, 8, pa1); PK4(p1, 0, pa2); PK4(p1, 8, pa3);
#undef PK4
}
template <int OFF> __device__ __forceinline__ bf16x8 k_read(int a) {
#if defined(ATT_ABL) && ATT_ABL == 7
    bf16x8 r; asm volatile("; no read %0 %1" : "=&v"(r) : "v"(a)); return r;
#else
    bf16x8 r; asm volatile("ds_read_b128 %0, %1 offset:%2" : "=&v"(r) : "v"(a), "i"(OFF) : "memory"); return r;
#endif
}
__device__ __forceinline__ void qkt(f32x16& p0, f32x16& p1, int ks, const int (&ka)[4], const bf16x8* qr) {
    p0 = f32x16{}; p1 = f32x16{};
    const bf16x8 a0 = k_read<0>(ks + ka[0]), b0 = k_read<4096>(ks + ka[0]), a1 = k_read<0>(ks + ka[1]), b1 = k_read<4096>(ks + ka[1]);
    const bf16x8 a2 = k_read<0>(ks + ka[2]), b2 = k_read<4096>(ks + ka[2]), a3 = k_read<0>(ks + ka[3]), b3 = k_read<4096>(ks + ka[3]);
    asm volatile("s_waitcnt lgkmcnt(6)" ::: "memory"); SBAR();
    p0 = QMMA(a0, qr[0], p0); p1 = QMMA(b0, qr[0], p1);
    asm volatile("s_waitcnt lgkmcnt(4)" ::: "memory"); SBAR();
    p0 = QMMA(a1, qr[1], p0); p1 = QMMA(b1, qr[1], p1);
    asm volatile("s_waitcnt lgkmcnt(2)" ::: "memory"); SBAR();
    p0 = QMMA(a2, qr[2], p0); p1 = QMMA(b2, qr[2], p1);
    asm volatile("s_waitcnt lgkmcnt(0)" ::: "memory"); SBAR();
    p0 = QMMA(a3, qr[3], p0); p1 = QMMA(b3, qr[3], p1);
}
__device__ __forceinline__ void maskfill(f32x16& p0, f32x16& p1, bool m) {
    if (m) {
        asm volatile("; masked tile");
#pragma unroll
        for (int r = 0; r < 16; ++r) { p0[r] = -1e30f; p1[r] = -1e30f; }
    }
}
__device__ __forceinline__ int v_st(int k, int c) { const int kk = (k & ~0xC) | ((k & 4) << 1) | ((k & 8) >> 1); return ((kk >> 3) * 4 + (c >> 5)) * 512 + ((kk & 7) * 32 + (c & 31)) * 2; }
__device__ __forceinline__ int v_rd_base(int lane) { return ((lane & 3) << 3) | (((lane >> 2) & 3) << 6) | (((lane >> 4) & 1) << 5) | (((lane >> 5) & 1) << 8); }
constexpr int v_rd_off(int d0, int ks, int half) { return d0 * 512 + ks * 4096 + half * 2048; }
template <int OFF> __device__ __forceinline__ s16x4 tr_read(int vb) {
#if defined(ATT_ABL) && ATT_ABL == 7
    s16x4 r; asm volatile("; no read %0 %1" : "=&v"(r) : "v"(vb)); return r;
#else
    s16x4 r; asm volatile("ds_read_b64_tr_b16 %0, %1 offset:%2" : "=&v"(r) : "v"(vb), "i"(OFF) : "memory"); return r;
#endif
}
struct VF { s16x4 l0, h0, l1, h1, l2, h2, l3, h3; };
template <int D0> __device__ __forceinline__ void v_issue(VF& f, int vb) {
    f.l0 = tr_read<v_rd_off(D0, 0, 0)>(vb); f.h0 = tr_read<v_rd_off(D0, 0, 1)>(vb); f.l1 = tr_read<v_rd_off(D0, 1, 0)>(vb); f.h1 = tr_read<v_rd_off(D0, 1, 1)>(vb);
    f.l2 = tr_read<v_rd_off(D0, 2, 0)>(vb); f.h2 = tr_read<v_rd_off(D0, 2, 1)>(vb); f.l3 = tr_read<v_rd_off(D0, 3, 0)>(vb); f.h3 = tr_read<v_rd_off(D0, 3, 1)>(vb);
}
__device__ __forceinline__ void v_mma(f32x16& od, const VF& f, bf16x8 pa0, bf16x8 pa1, bf16x8 pa2, bf16x8 pa3) {
#define PKV(L, H) (bf16x8){L[0], L[1], L[2], L[3], H[0], H[1], H[2], H[3]}
#if defined(ATT_ABL) && (ATT_ABL == 2 || ATT_ABL == 5 || ATT_ABL == 6)
    asm volatile("" :: "v"(f.l0), "v"(f.h0), "v"(f.l1), "v"(f.h1), "v"(f.l2), "v"(f.h2), "v"(f.l3), "v"(f.h3));
#else
    od = mfma32(pa0, PKV(f.l0, f.h0), od);
    od = mfma32(pa1, PKV(f.l1, f.h1), od);
    od = mfma32(pa2, PKV(f.l2, f.h2), od);
    od = mfma32(pa3, PKV(f.l3, f.h3), od);
#endif
#undef PKV
}
__device__ __forceinline__ void pv_d0(f32x16* o, int vb, bf16x8 pa0, bf16x8 pa1, bf16x8 pa2, bf16x8 pa3) {
    VF A, B;
    v_issue<0>(A, vb); v_issue<1>(B, vb);
    asm volatile("s_waitcnt lgkmcnt(8)" ::: "memory"); SBAR();
    v_mma(o[0], A, pa0, pa1, pa2, pa3); SBAR();
    v_issue<2>(A, vb);
    asm volatile("s_waitcnt lgkmcnt(8)" ::: "memory"); SBAR();
    v_mma(o[1], B, pa0, pa1, pa2, pa3); SBAR();
    v_issue<3>(B, vb);
    asm volatile("s_waitcnt lgkmcnt(8)" ::: "memory"); SBAR();
    v_mma(o[2], A, pa0, pa1, pa2, pa3);
    asm volatile("s_waitcnt lgkmcnt(0)" ::: "memory"); SBAR();
    v_mma(o[3], B, pa0, pa1, pa2, pa3);
}
__device__ __forceinline__ void m_stage(f32x16& p0, f32x16& p1, int ks, const int (&ka)[4], const bf16x8* qr, f32x16* o, int vb, bf16x8 pa0, bf16x8 pa1, bf16x8 pa2, bf16x8 pa3) {
    SBAR();
    p0 = f32x16{}; p1 = f32x16{};
    const bf16x8 a0 = k_read<0>(ks + ka[0]), b0 = k_read<4096>(ks + ka[0]), a1 = k_read<0>(ks + ka[1]), b1 = k_read<4096>(ks + ka[1]);
    const bf16x8 a2 = k_read<0>(ks + ka[2]), b2 = k_read<4096>(ks + ka[2]), a3 = k_read<0>(ks + ka[3]), b3 = k_read<4096>(ks + ka[3]);
    VF A, B;
    v_issue<0>(A, vb);
    asm volatile("s_waitcnt lgkmcnt(14)" ::: "memory"); SBAR();
    p0 = QMMA(a0, qr[0], p0); p1 = QMMA(b0, qr[0], p1);
    asm volatile("s_waitcnt lgkmcnt(12)" ::: "memory"); SBAR();
    p0 = QMMA(a1, qr[1], p0); p1 = QMMA(b1, qr[1], p1);
    asm volatile("s_waitcnt lgkmcnt(10)" ::: "memory"); SBAR();
    p0 = QMMA(a2, qr[2], p0); p1 = QMMA(b2, qr[2], p1);
    asm volatile("s_waitcnt lgkmcnt(8)" ::: "memory"); SBAR();
    p0 = QMMA(a3, qr[3], p0); p1 = QMMA(b3, qr[3], p1); SBAR();
    v_issue<1>(B, vb);
    asm volatile("s_waitcnt lgkmcnt(8)" ::: "memory"); SBAR();
    v_mma(o[0], A, pa0, pa1, pa2, pa3); SBAR();
    v_issue<2>(A, vb);
    asm volatile("s_waitcnt lgkmcnt(8)" ::: "memory"); SBAR();
    v_mma(o[1], B, pa0, pa1, pa2, pa3); SBAR();
    v_issue<3>(B, vb);
    asm volatile("s_waitcnt lgkmcnt(8)" ::: "memory"); SBAR();
    v_mma(o[2], A, pa0, pa1, pa2, pa3);
    asm volatile("s_waitcnt lgkmcnt(0)" ::: "memory"); SBAR();
    v_mma(o[3], B, pa0, pa1, pa2, pa3);
    SBAR();
}
__device__ __forceinline__ void m_deep(f32x16& p0, f32x16& p1, int ks, const int (&ka)[4], const bf16x8* qr, f32x16* o, int vb, bf16x8 pa0, bf16x8 pa1, bf16x8 pa2, bf16x8 pa3) {
    SBAR();
    p0 = f32x16{}; p1 = f32x16{};
    const bf16x8 a0 = k_read<0>(ks + ka[0]), b0 = k_read<4096>(ks + ka[0]), a1 = k_read<0>(ks + ka[1]), b1 = k_read<4096>(ks + ka[1]);
    const bf16x8 a2 = k_read<0>(ks + ka[2]), b2 = k_read<4096>(ks + ka[2]), a3 = k_read<0>(ks + ka[3]), b3 = k_read<4096>(ks + ka[3]);
    VF A, B, C, D;
    v_issue<0>(A, vb);
    asm volatile("s_waitcnt lgkmcnt(14)" ::: "memory"); SBAR();
    p0 = QMMA(a0, qr[0], p0); p1 = QMMA(b0, qr[0], p1);
    asm volatile("s_waitcnt lgkmcnt(12)" ::: "memory"); SBAR();
    p0 = QMMA(a1, qr[1], p0); p1 = QMMA(b1, qr[1], p1); SBAR();
    v_issue<1>(B, vb);
    asm volatile("s_waitcnt lgkmcnt(15)" ::: "memory"); SBAR();
    p0 = QMMA(a2, qr[2], p0); p1 = QMMA(b2, qr[2], p1);
    p0 = QMMA(a3, qr[3], p0); p1 = QMMA(b3, qr[3], p1); SBAR();
    v_issue<2>(C, vb);
    asm volatile("s_waitcnt lgkmcnt(15)" ::: "memory"); SBAR();
    v_mma(o[0], A, pa0, pa1, pa2, pa3); SBAR();
    v_issue<3>(D, vb);
    asm volatile("s_waitcnt lgkmcnt(15)" ::: "memory"); SBAR();
    v_mma(o[1], B, pa0, pa1, pa2, pa3); SBAR();
    asm volatile("s_waitcnt lgkmcnt(8)" ::: "memory"); SBAR();
    v_mma(o[2], C, pa0, pa1, pa2, pa3);
    asm volatile("s_waitcnt lgkmcnt(0)" ::: "memory"); SBAR();
    v_mma(o[3], D, pa0, pa1, pa2, pa3);
    SBAR();
}
struct KF { bf16x8 a0, b0, a1, b1; };
__device__ __forceinline__ void k_issue(KF& f, int ks, const int (&ka)[4]) {
    f.a0 = k_read<0>(ks + ka[0]); f.b0 = k_read<4096>(ks + ka[0]); f.a1 = k_read<0>(ks + ka[1]); f.b1 = k_read<4096>(ks + ka[1]);
}
__device__ __forceinline__ void m_compute(f32x16& p0, f32x16& p1, const KF& f, int ks, const int (&ka)[4], const bf16x8* qr, f32x16* o, int vb, bf16x8 pa0, bf16x8 pa1, bf16x8 pa2, bf16x8 pa3) {
    SBAR();
    p0 = f32x16{}; p1 = f32x16{};
    const bf16x8 a2 = k_read<0>(ks + ka[2]), b2 = k_read<4096>(ks + ka[2]), a3 = k_read<0>(ks + ka[3]), b3 = k_read<4096>(ks + ka[3]);
    VF A, B;
    asm volatile("s_waitcnt lgkmcnt(4)" ::: "memory"); SBAR();
    p0 = QMMA(f.a0, qr[0], p0); p1 = QMMA(f.b0, qr[0], p1);
    p0 = QMMA(f.a1, qr[1], p0); p1 = QMMA(f.b1, qr[1], p1); SBAR();
    v_issue<0>(A, vb);
    asm volatile("s_waitcnt lgkmcnt(10)" ::: "memory"); SBAR();
    p0 = QMMA(a2, qr[2], p0); p1 = QMMA(b2, qr[2], p1);
    asm volatile("s_waitcnt lgkmcnt(8)" ::: "memory"); SBAR();
    p0 = QMMA(a3, qr[3], p0); p1 = QMMA(b3, qr[3], p1); SBAR();
    v_issue<1>(B, vb);
    asm volatile("s_waitcnt lgkmcnt(8)" ::: "memory"); SBAR();
    v_mma(o[0], A, pa0, pa1, pa2, pa3); SBAR();
    v_issue<2>(A, vb);
    asm volatile("s_waitcnt lgkmcnt(8)" ::: "memory"); SBAR();
    v_mma(o[1], B, pa0, pa1, pa2, pa3); SBAR();
    v_issue<3>(B, vb);
    asm volatile("s_waitcnt lgkmcnt(8)" ::: "memory"); SBAR();
    v_mma(o[2], A, pa0, pa1, pa2, pa3);
    asm volatile("s_waitcnt lgkmcnt(0)" ::: "memory"); SBAR();
    v_mma(o[3], B, pa0, pa1, pa2, pa3);
    SBAR();
}
template <bool BOUNDED>
__device__ __forceinline__ void v_stage(f32x16& p0, f32x16& p1, float& m_reg, float& l_reg, float& alpha, bf16x8& pa0, bf16x8& pa1, bf16x8& pa2, bf16x8& pa3) {
    SBAR();
    if constexpr (BOUNDED) {
#if !defined(ATT_ABL) || (ATT_ABL != 1 && ATT_ABL != 4 && ATT_ABL != 5)
#pragma unroll
        for (int r = 0; r < 16; ++r) p0[r] = __builtin_amdgcn_exp2f(p0[r]);
#endif
        alpha = 1.f;
    } else {
        float mn;
        partialSM(p0, p1, m_reg, mn, alpha);
    }
    finishSM(p0, p1, alpha, l_reg, pa0, pa1, pa2, pa3);
    SBAR();
}

template <bool BOUNDED>
__device__ __forceinline__ void attn_pass(const bf16_t* __restrict__ Qb, const bf16_t* __restrict__ Kh, const bf16_t* __restrict__ Vh, int NT, int my_last, LAS unsigned char* ldsl, f32x16 (&o)[4], unsigned* tacc) {
    const int tid = threadIdx.x, wid = __builtin_amdgcn_readfirstlane(tid >> 6), lane = tid & 63, r32 = lane & 31, hi = lane >> 5;
    const bool gA = wid < 4;
#ifdef ATT_TIMING
    unsigned long long ts0, ts1, ts2, ts3, ts4; unsigned tvm = 0;
#define TSTAMP(v) do { v = __builtin_amdgcn_s_memtime(); asm volatile("s_waitcnt lgkmcnt(0)" ::: "memory"); } while (0)
#define TACC() do { tacc[0] += (unsigned)(ts1 - ts0); tacc[1] += (unsigned)(ts2 - ts1); tacc[2] += (unsigned)(ts3 - ts2); tacc[3] += (unsigned)(ts4 - ts3); ts0 = ts4; } while (0)
#else
#define TSTAMP(v) do {} while (0)
#define TACC() do {} while (0)
#endif
    char* lds = (char*)ldsl;
    float* wsf = (float*)(lds + LDS_WS) + wid * 64; float* li_l = wsf; float* al_l = wsf + 32;
    float m_reg = -1e30f, l_reg = 0.f;
#pragma unroll
    for (int d = 0; d < 4; ++d) o[d] = f32x16{};
    bf16x8 qr[4];
    const bf16_t* Qw = Qb + (size_t)(wid * QBLK + r32) * NIN + hi * 8;
#pragma unroll
    for (int d0 = 0; d0 < 4; ++d0) qr[d0] = *reinterpret_cast<const bf16x8*>(Qw + d0 * 16);
    const int krow = 8 * wid + (lane >> 3);
    const unsigned kofs = (unsigned)(krow * NIN + (((lane & 7) ^ ((krow >> 1) & 7)) * 8)) * 2u;
    const int kk = 8 * wid + ((lane >> 2) & 7), vk = (kk & ~0xC) | ((kk & 4) << 1) | ((kk & 8) >> 1);
    const unsigned vofs = (unsigned)(vk * NIN + (lane >> 5) * 32 + (lane & 3) * 8) * 2u;
    int lz = 0; asm volatile("" : "+s"(lz));
    const int vb0 = (int)(uintptr_t)lds + v_rd_base(lane) + lz, kb0 = (int)(uintptr_t)lds + SHM_V + lz;
    int ka[4];
#pragma unroll
    for (int d0 = 0; d0 < 4; ++d0) ka[d0] = KSWZ64(r32, (d0 * 16 + hi * 8) * 2);
#define SOFF(t) ((int)((unsigned)(t) % (unsigned)NSLOT) * SLOT)
#define DMA(t) do { const size_t g_ = (size_t)(t) * (size_t)(KVBLK * NIN * 2); LAS unsigned char* d_ = ldsl + SOFF(t); \
    __builtin_amdgcn_global_load_lds((const GAS unsigned*)((const char*)Vh + g_ + vofs), (LAS unsigned*)(d_ + wid * 2048), 16, 0, 0); \
    __builtin_amdgcn_global_load_lds((const GAS unsigned*)((const char*)Vh + g_ + vofs + 128), (LAS unsigned*)(d_ + wid * 2048 + 1024), 16, 0, 0); \
    __builtin_amdgcn_global_load_lds((const GAS unsigned*)((const char*)Kh + g_ + kofs), (LAS unsigned*)(d_ + SHM_V + wid * 1024), 16, 0, 0); } while (0)
#define KS(t) (kb0 + SOFF(t))
#define VB(t) (vb0 + SOFF(t))
#define WBAR() do { asm volatile("" ::: "memory"); __builtin_amdgcn_s_barrier(); asm volatile("" ::: "memory"); } while (0)
#if defined(ATT_TIMING) && ATT_TIMING == 2
#define EVENT(e) do { unsigned long long tx0_, tx1_; TSTAMP(tx0_); if ((e) + 3 < NT) asm volatile("s_waitcnt vmcnt(3)" ::: "memory"); else asm volatile("s_waitcnt vmcnt(0)" ::: "memory"); \
    TSTAMP(tx1_); tvm += (unsigned)(tx1_ - tx0_); WBAR(); if ((e) + 4 < NT) DMA((e) + 4); } while (0)
#else
#define EVENT(e) do { if ((e) + 3 < NT) asm volatile("s_waitcnt vmcnt(3)" ::: "memory"); else asm volatile("s_waitcnt vmcnt(0)" ::: "memory"); \
    WBAR(); if ((e) + 4 < NT) DMA((e) + 4); } while (0)
#endif
#define MID(t) do { if (!gA && (t) <= NT - 2) EVENT((t) - 1); } while (0)
#define END(t) do { if (gA && (t) <= NT - 3) EVENT(t); } while (0)
#define RESC(a) do { if constexpr (!BOUNDED) { if (__any((a) < 1.f)) { if (hi == 0) al_l[r32] = (a); asm volatile("s_waitcnt lgkmcnt(0)" ::: "memory"); \
    _Pragma("unroll") for (int d = 0; d < 4; ++d) _Pragma("unroll") for (int r = 0; r < 16; ++r) o[d][r] *= al_l[crow(r, hi)]; } } } while (0)
    f32x16 pA0, pA1, pB0, pB1; float al; bf16x8 pa0, pa1, pa2, pa3;
    __syncthreads();
    DMA(0); DMA(1); DMA(2); DMA(3);
    asm volatile("s_waitcnt vmcnt(9)" ::: "memory"); WBAR();
    if (gA) { asm volatile("s_waitcnt vmcnt(6)" ::: "memory"); WBAR(); }
    qkt(pA0, pA1, KS(0), ka, qr);
    if (!gA) { asm volatile("s_waitcnt vmcnt(6)" ::: "memory"); WBAR(); }
    END(0);
    qkt(pB0, pB1, KS(1), ka, qr);
    MID(1);
    v_stage<BOUNDED>(pA0, pA1, m_reg, l_reg, al, pa0, pa1, pa2, pa3);
    END(1);
    TSTAMP(ts0);
    for (int t = 2; t < NT; t += 2) {
        if constexpr (BOUNDED) m_deep(pA0, pA1, KS(t), ka, qr, o, VB(t - 2), pa0, pa1, pa2, pa3); else m_stage(pA0, pA1, KS(t), ka, qr, o, VB(t - 2), pa0, pa1, pa2, pa3);
        TSTAMP(ts1); MID(t); TSTAMP(ts2);
        if (t - 1 <= my_last) { v_stage<BOUNDED>(pB0, pB1, m_reg, l_reg, al, pa0, pa1, pa2, pa3); RESC(al); } else { pa0 = bf16x8{}; pa1 = bf16x8{}; pa2 = bf16x8{}; pa3 = bf16x8{}; }
        TSTAMP(ts3); END(t); TSTAMP(ts4); TACC();
        if constexpr (BOUNDED) m_deep(pB0, pB1, KS(t + 1), ka, qr, o, VB(t - 1), pa0, pa1, pa2, pa3); else m_stage(pB0, pB1, KS(t + 1), ka, qr, o, VB(t - 1), pa0, pa1, pa2, pa3);
        TSTAMP(ts1); MID(t + 1); TSTAMP(ts2);
        if (t <= my_last) { v_stage<BOUNDED>(pA0, pA1, m_reg, l_reg, al, pa0, pa1, pa2, pa3); RESC(al); } else { pa0 = bf16x8{}; pa1 = bf16x8{}; pa2 = bf16x8{}; pa3 = bf16x8{}; }
        TSTAMP(ts3); END(t + 1); TSTAMP(ts4); TACC();
    }
    pv_d0(o, VB(NT - 2), pa0, pa1, pa2, pa3);
    if (NT - 1 <= my_last) { v_stage<BOUNDED>(pB0, pB1, m_reg, l_reg, al, pa0, pa1, pa2, pa3); RESC(al); } else { pa0 = bf16x8{}; pa1 = bf16x8{}; pa2 = bf16x8{}; pa3 = bf16x8{}; }
    pv_d0(o, VB(NT - 1), pa0, pa1, pa2, pa3);
#if defined(ATT_TIMING) && ATT_TIMING == 2
    tacc[0] += tvm;
#endif
    if (hi == 0) li_l[r32] = l_reg;
    asm volatile("s_waitcnt lgkmcnt(0)" ::: "memory");
#pragma unroll
    for (int r = 0; r < 16; ++r) {
        const float rl = __builtin_amdgcn_rcpf(li_l[crow(r, hi)]);
#pragma unroll
        for (int d = 0; d < 4; ++d) o[d][r] *= rl;
    }
    asm volatile("s_waitcnt vmcnt(0)" ::: "memory");
    __syncthreads();
#undef TSTAMP
#undef TACC
#undef SOFF
#undef DMA
#undef KS
#undef VB
#undef WBAR
#undef EVENT
#undef MID
#undef END
#undef RESC
}
}

__device__ __forceinline__ void p3_attn_unit(const Params& p, Ctx& F, int b, int h, int qb, float* oscr) {
    const bf16_t* proj = (const bf16_t*)(p.ws + WS_PROJ);
    bf16_t* ycat = (bf16_t*)(p.ws + WS_YCAT);
    const float lam = ((const float*)(p.ws + WS_MISC))[0];
#ifndef FAST_LIMIT
#define FAST_LIMIT 48.f
#endif
    const bool bounded = __builtin_amdgcn_readfirstlane(((const float*)(p.ws + WS_MISC))[1] <= FAST_LIMIT ? 1 : 0) != 0;
    const float* subw = p.in[15];
    const int tid = F.tid, wid = F.wave, lane = F.lane, r32 = lane & 31, hi = lane >> 5;
    const size_t rowbase = (size_t)b * SEQ; const int q0 = qb * 256;
    const int NT = (q0 + 256) / 64, my_last = (q0 + 32 * wid) / 64;
    f32x16 o[4];
    for (int j = 0; j < 2; ++j) {
        const bf16_t* Qb = proj + (rowbase + q0) * NIN + PQ + h * 128 + j * 64;
        const bf16_t* Kh = proj + rowbase * NIN + PK + h * 128 + j * 64;
        const bf16_t* Vh = proj + rowbase * NIN + PV + h * 128;
        if (bounded) att::attn_pass<true>(Qb, Kh, Vh, NT, my_last, F.lds, o, F.tacc); else att::attn_pass<false>(Qb, Kh, Vh, NT, my_last, F.lds, o, F.tacc);
        if (j == 0) {
            float* my = oscr + tid * 64;
#pragma unroll
            for (int d = 0; d < 4; ++d)
#pragma unroll
                for (int r4 = 0; r4 < 4; ++r4) *(f32x4*)(my + d * 16 + r4 * 4) = (f32x4){o[d][4 * r4], o[d][4 * r4 + 1], o[d][4 * r4 + 2], o[d][4 * r4 + 3]};
        }
    }
    float wv[4];
#pragma unroll
    for (int d = 0; d < 4; ++d) wv[d] = subw[d * 32 + r32] * (1.f - LAMBDA_INIT);
#pragma unroll
    for (int r = 0; r < 16; ++r) {
        float v[4]; float ss = 0.f;
#pragma unroll
        for (int d = 0; d < 4; ++d) { v[d] = oscr[tid * 64 + d * 16 + r] - lam * o[d][r]; ss += v[d] * v[d]; }
        ss += DPP_F(ss, 0xB1); ss += DPP_F(ss, 0x4E); ss += DPP_F(ss, 0x124); ss += DPP_F(ss, 0x128);
        { auto r_ = __builtin_amdgcn_permlane16_swap(__float_as_uint(ss), __float_as_uint(ss), false, false); ss = __uint_as_float(r_[0]) + __uint_as_float(r_[1]); }
        const float rs = rsqrtf(ss * (1.f / 128.f) + EPSN);
        const size_t row = rowbase + q0 + wid * 32 + att::crow(r, hi);
#pragma unroll
        for (int d = 0; d < 4; ++d) ycat[row * DM + 512 + h * 128 + d * 32 + r32] = (bf16_t)f2bf(v[d] * rs * wv[d]);
    }
}

__device__ __forceinline__ void phase3(const Params& p, Ctx& F) {
#if defined(PROBE_PHASE) && (PROBE_PHASE == 30 || PROBE_PHASE == 31)
    F.ta = __builtin_amdgcn_s_memrealtime();
#endif
    p3_scan(p, F);
#ifdef ATT_TIMING
    F.tacc[0] = F.tacc[1] = F.tacc[2] = F.tacc[3] = 0u;
#endif
#if defined(PROBE_PHASE) && (PROBE_PHASE == 30 || PROBE_PHASE == 31)
    VM_WAIT(); F.tb = __builtin_amdgcn_s_memrealtime();
#endif
#ifdef ATT_ABL
    float* oscr = (float*)(p.ws + WS_GW) + (size_t)F.vcu * (64 * 512);
#else
    float* oscr = p.out + (size_t)F.vcu * (64 * 512);
#endif
    for (int ui = F.vcu; ui < 512; ui += F.G) {
        const int pi = ui & 255, bh = pi >> 3, s = pi & 7, b = bh >> 2, h = bh & 3;
        p3_attn_unit(p, F, b, h, ui < 256 ? 15 - s : s, oscr);
    }
#if defined(PROBE_PHASE) && (PROBE_PHASE == 30 || PROBE_PHASE == 31)
    VM_WAIT(); F.tc = __builtin_amdgcn_s_memrealtime();
#endif
#ifdef ATT_TIMING
    if (blockIdx.x == 0 && F.lane == 0) { unsigned* mw = (unsigned*)(p.ws + WS_MISC) + 16 + F.wave * 4; for (int k = 0; k < 4; ++k) mw[k] = F.tacc[k]; }
#endif
}

__device__ __forceinline__ void phase2_attn_ssd(const Params& p, Ctx& F) {
    {
        float* oscr = p.out + (size_t)F.vcu * (64 * 512);
        for (int ui = F.vcu; ui < 512; ui += F.G) {
            const int pi = ui & 255, bh = pi >> 3, s = pi & 7, b = bh >> 2, h = bh & 3;
            p3_attn_unit(p, F, b, h, ui < 256 ? 15 - s : s, oscr);
        }
    }
    {
        constexpr int NU = NB * NCH * 2;
        const bf16_t* proj = (const bf16_t*)(p.ws + WS_PROJ);
        volatile LAS unsigned* Q = (volatile LAS unsigned*)(F.lds + LDS_BYTES - 128) + 16;
        unsigned* qctr = (unsigned*)(p.ws + WS_CTL) + CW_BAR + XCD_BAR_WORDS + 128;
        __syncthreads();
        if (F.tid == 0) { Q[0] = __hip_atomic_fetch_add(qctr, 1u, __ATOMIC_RELAXED, __HIP_MEMORY_SCOPE_AGENT); Q[1] = __hip_atomic_fetch_add(qctr, 1u, __ATOMIC_RELAXED, __HIP_MEMORY_SCOPE_AGENT); }
        __syncthreads();
        int cur = __builtin_amdgcn_readfirstlane((int)Q[0]), nxt = __builtin_amdgcn_readfirstlane((int)Q[1]);
        __syncthreads();
        u32x4 rv[11];
        if (cur < NU) p2_load_raw(proj, F.tid, cur >> 7, (cur >> 1) & 63, cur & 1, rv);
        while (cur < NU) {
            unsigned nn_r = 0u;
            if (F.tid == 0) nn_r = __hip_atomic_fetch_add(qctr, 1u, __ATOMIC_RELAXED, __HIP_MEMORY_SCOPE_AGENT);
            p2_ssd_unit(p, F, cur >> 7, (cur >> 1) & 63, cur & 1, rv, nxt < NU, nxt >> 7, (nxt >> 1) & 63, nxt & 1);
            if (F.tid == 0) Q[0] = nn_r;
            __syncthreads();
            const int nn = __builtin_amdgcn_readfirstlane((int)Q[0]);
            __syncthreads();
            cur = nxt; nxt = nn;
        }
    }
}

constexpr int P4_PREV = 0, P4_CM = 69632, P4_ACS = 87040, P4_Y = 88064, Y_LD = 257;
static_assert(P4_Y + 64 * Y_LD * 4 <= LDS_BYTES, "P4 LDS");
__device__ __forceinline__ void p4_load(const unsigned char* s8, const float* tsc, const bf16_t* cmc, int tid, int b, int c, int g, u32x4 (&pv)[4], float (&ps)[4], u32x4 (&cv)[2]) {
    const size_t tbase = (size_t)b * SEQ + (size_t)c * CHUNK;
#pragma unroll
    for (int i = 0; i < 4; ++i) {
        const int e = tid + 512 * i, n16 = e & 7, pp = (e >> 3) & 63, h = e >> 9;
        const size_t row = (((size_t)b * NCH + c) * 8 + g * 4 + h) * 64 + pp;
        pv[i] = *(const u32x4*)(s8 + row * 128 + n16 * 16);
        ps[i] = tsc[row];
    }
#pragma unroll
    for (int i = 0; i < 2; ++i) {
        const int e = tid + 512 * i, l = e >> 4, c8 = e & 15;
        cv[i] = *(const u32x4*)(cmc + (tbase + l) * 256 + g * 128 + c8 * 8);
    }
}
__device__ __forceinline__ void p4_unit(const Params& p, Ctx& F, int b, int c, int g, u32x4 (&pv)[4], float (&ps)[4], u32x4 (&cv)[2], bool has_next, int nb, int nc, int ng) {
    unsigned char* ws = p.ws;
    const bf16_t* proj = (const bf16_t*)(ws + WS_PROJ);
    bf16_t* ycat = (bf16_t*)(ws + WS_YCAT); const bf16_t* cmc = (const bf16_t*)(ws + WS_CMC);
    const bf16_t* states = (const bf16_t*)(ws + WS_STATES); const float* acs_g = (const float*)(ws + WS_ACS);
    const float* normw = p.in[8];
    LAS bf16_t* PREV = (LAS bf16_t*)(F.lds + P4_PREV); LAS bf16_t* CM = (LAS bf16_t*)(F.lds + P4_CM);
    LAS float* ACS = (LAS float*)(F.lds + P4_ACS); LAS float* Y = (LAS float*)(F.lds + P4_Y);
    const int tid = F.tid, lane = F.lane, wave = F.wave, fr = lane & 15, fq = lane >> 4;
    const size_t tbase = (size_t)b * SEQ + (size_t)c * CHUNK;
#pragma unroll
    for (int i = 0; i < 4; ++i) {
        const int e = tid + 512 * i, n16 = e & 7, pp = (e >> 3) & 63, h = e >> 9;
        u32x4 w0, w1;
#pragma unroll
        for (int q = 0; q < 4; ++q) {
            const auto lo = __builtin_amdgcn_cvt_pk_f32_fp8((int)pv[i][q], false), hi = __builtin_amdgcn_cvt_pk_f32_fp8((int)pv[i][q], true);
            const unsigned a = pk2(lo[0] * ps[i], lo[1] * ps[i]), bq = pk2(hi[0] * ps[i], hi[1] * ps[i]);
            if (q < 2) { w0[2 * q] = a; w0[2 * q + 1] = bq; } else { w1[2 * (q - 2)] = a; w1[2 * (q - 2) + 1] = bq; }
        }
        *(LAS u32x4*)(PREV + (h * 64 + pp) * BM_LD + n16 * 16) = w0;
        *(LAS u32x4*)(PREV + (h * 64 + pp) * BM_LD + n16 * 16 + 8) = w1;
    }
#pragma unroll
    for (int i = 0; i < 2; ++i) {
        const int e = tid + 512 * i, l = e >> 4, c8 = e & 15;
        *(LAS u32x4*)(CM + l * BM_LD + c8 * 8) = cv[i];
    }
    if (has_next) p4_load((const unsigned char*)p.out + OUT_S8, (const float*)(ws + WS_TSC), cmc, tid, nb, nc, ng, pv, ps, cv);
    if (tid < 256) { const int l = tid >> 2, h = tid & 3; ACS[l * 4 + h] = acs_g[(tbase + l) * 8 + g * 4 + h]; }
    __syncthreads();
    {
        const int h = wave >> 1;
#pragma unroll
        for (int mq = 0; mq < 2; ++mq) {
            const int mt = 2 * (wave & 1) + mq;
            bf16x8 a[4];
#pragma unroll
            for (int ks = 0; ks < 4; ++ks) a[ks] = *(const LAS bf16x8*)(CM + (mt * 16 + fr) * BM_LD + ks * 32 + fq * 8);
            float ev[4];
#pragma unroll
            for (int j = 0; j < 4; ++j) ev[j] = __expf(ACS[(mt * 16 + 4 * fq + j) * 4 + h]);
#pragma unroll
            for (int nt = 0; nt < 4; ++nt) {
                f32x4 acc = {0.f, 0.f, 0.f, 0.f};
#pragma unroll
                for (int ks = 0; ks < 4; ++ks) {
                    const bf16x8 bq = *(const LAS bf16x8*)(PREV + (h * 64 + nt * 16 + fr) * BM_LD + ks * 32 + fq * 8);
                    acc = mfma16(a[ks], bq, acc);
                }
#pragma unroll
                for (int j = 0; j < 4; ++j) {
                    const int l = mt * 16 + 4 * fq + j, col = h * 64 + nt * 16 + fr;
                    Y[l * Y_LD + col] = acc[j] * ev[j];
                }
            }
        }
    }
    __syncthreads();
    {
        const int c8 = lane & 31, hr = lane >> 5;
        const f32x4 nw0 = *(const f32x4*)(normw + g * 256 + c8 * 8), nw1 = *(const f32x4*)(normw + g * 256 + c8 * 8 + 4);
#pragma unroll 2
        for (int r = 0; r < 4; ++r) {
            const int l = wave * 8 + r * 2 + hr;
            const size_t t = tbase + l;
            const u32x4 yl = *(const u32x4*)(ycat + t * DM + g * 256 + c8 * 8);
            const u32x4 zz = *(const u32x4*)(proj + t * NIN + PZ + g * 256 + c8 * 8);
            float v[8]; float ss = 0.f;
#pragma unroll
            for (int e = 0; e < 4; ++e) {
                const float y0 = bf2f(yl[e] & 0xffffu) + Y[l * Y_LD + c8 * 8 + 2 * e], y1 = bf2f(yl[e] >> 16) + Y[l * Y_LD + c8 * 8 + 2 * e + 1];
                v[2 * e] = y0 * silu_f(bf2f(zz[e] & 0xffffu)); v[2 * e + 1] = y1 * silu_f(bf2f(zz[e] >> 16));
                ss += v[2 * e] * v[2 * e] + v[2 * e + 1] * v[2 * e + 1];
            }
            ss += DPP_F(ss, 0xB1); ss += DPP_F(ss, 0x4E); ss += DPP_F(ss, 0x124); ss += DPP_F(ss, 0x128);
            { auto r_ = __builtin_amdgcn_permlane16_swap(__float_as_uint(ss), __float_as_uint(ss), false, false); ss = __uint_as_float(r_[0]) + __uint_as_float(r_[1]); }
            const float rs = rsqrtf(ss * (1.f / 256.f) + EPSN);
            u32x4 o;
            o.x = pk2(v[0] * rs * nw0[0], v[1] * rs * nw0[1]); o.y = pk2(v[2] * rs * nw0[2], v[3] * rs * nw0[3]);
            o.z = pk2(v[4] * rs * nw1[0], v[5] * rs * nw1[1]); o.w = pk2(v[6] * rs * nw1[2], v[7] * rs * nw1[3]);
            *(u32x4*)(ycat + t * DM + g * 256 + c8 * 8) = o;
        }
    }
    __syncthreads();
}
__device__ __forceinline__ void phase4(const Params& p, Ctx& F) {
    const unsigned char* s8 = (const unsigned char*)p.out + OUT_S8; const float* tsc = (const float*)(p.ws + WS_TSC); const bf16_t* cmc = (const bf16_t*)(p.ws + WS_CMC);
    u32x4 pv[4], cv[2]; float ps[4];
    if (F.vcu < NB * NCH * 2) p4_load(s8, tsc, cmc, F.tid, F.vcu >> 7, (F.vcu >> 1) & 63, F.vcu & 1, pv, ps, cv);
    for (int u = F.vcu; u < NB * NCH * 2; u += F.G) {
        const int g = u & 1, c = (u >> 1) & 63, b = u >> 7;
        const int un = u + F.G;
        p4_unit(p, F, b, c, g, pv, ps, cv, un < NB * NCH * 2, un >> 7, (un >> 1) & 63, un & 1);
    }
}

__device__ __forceinline__ unsigned f2ord(float f) { const unsigned u = __float_as_uint(f); return (u >> 31) ? ~u : (u | 0x80000000u); }
__device__ __forceinline__ unsigned ordb(unsigned u) { return u ^ (unsigned)(((int)u >> 31) | (int)0x80000000); }
__device__ __forceinline__ float ord2f(unsigned u) { return __uint_as_float((u >> 31) ? (u & 0x7fffffffu) : ~u); }
__device__ __forceinline__ unsigned kmax(unsigned a, unsigned b) { unsigned r; asm("v_max_f32 %0, %1, %2" : "=v"(r) : "v"(a), "v"(b)); return r; }
__device__ __forceinline__ unsigned kmin(unsigned a, unsigned b) { unsigned r; asm("v_min_f32 %0, %1, %2" : "=v"(r) : "v"(a), "v"(b)); return r; }
#define CE_DESC(A, B) do { const unsigned hi_ = kmax((A), (B)); const unsigned lo_ = kmin((A), (B)); (A) = hi_; (B) = lo_; } while (0)
constexpr unsigned KEY_NEG_INF = 0xff800000u;
template <int K, int J> __device__ __forceinline__ void bstage(unsigned (&r)[16]) {
#pragma unroll
    for (int i = 0; i < 16; ++i) { const int l = i ^ J; if (l > i) { if ((i & K) == 0) CE_DESC(r[i], r[l]); else CE_DESC(r[l], r[i]); } }
}
__device__ __forceinline__ void bitonic_merge16(unsigned (&r)[16]) { bstage<16, 8>(r); bstage<16, 4>(r); bstage<16, 2>(r); bstage<16, 1>(r); }
__device__ __forceinline__ void bitonic_sort16(unsigned (&r)[16]) {
    CE_DESC(r[0], r[13]); CE_DESC(r[1], r[12]); CE_DESC(r[2], r[15]); CE_DESC(r[3], r[14]); CE_DESC(r[4], r[8]); CE_DESC(r[5], r[6]); CE_DESC(r[7], r[11]); CE_DESC(r[9], r[10]);
    CE_DESC(r[0], r[5]); CE_DESC(r[1], r[7]); CE_DESC(r[2], r[9]); CE_DESC(r[3], r[4]); CE_DESC(r[6], r[13]); CE_DESC(r[8], r[14]); CE_DESC(r[10], r[15]); CE_DESC(r[11], r[12]);
    CE_DESC(r[0], r[1]); CE_DESC(r[2], r[3]); CE_DESC(r[4], r[5]); CE_DESC(r[6], r[8]); CE_DESC(r[7], r[9]); CE_DESC(r[10], r[11]); CE_DESC(r[12], r[13]); CE_DESC(r[14], r[15]);
    CE_DESC(r[0], r[2]); CE_DESC(r[1], r[3]); CE_DESC(r[4], r[10]); CE_DESC(r[5], r[11]); CE_DESC(r[6], r[7]); CE_DESC(r[8], r[9]); CE_DESC(r[12], r[14]); CE_DESC(r[13], r[15]);
    CE_DESC(r[1], r[2]); CE_DESC(r[3], r[12]); CE_DESC(r[4], r[6]); CE_DESC(r[5], r[7]); CE_DESC(r[8], r[10]); CE_DESC(r[9], r[11]); CE_DESC(r[13], r[14]);
    CE_DESC(r[1], r[4]); CE_DESC(r[2], r[6]); CE_DESC(r[5], r[8]); CE_DESC(r[7], r[10]); CE_DESC(r[9], r[13]); CE_DESC(r[11], r[14]);
    CE_DESC(r[2], r[4]); CE_DESC(r[3], r[6]); CE_DESC(r[9], r[12]); CE_DESC(r[11], r[13]);
    CE_DESC(r[3], r[5]); CE_DESC(r[6], r[8]); CE_DESC(r[7], r[9]); CE_DESC(r[10], r[12]);
    CE_DESC(r[3], r[4]); CE_DESC(r[5], r[6]); CE_DESC(r[7], r[8]); CE_DESC(r[9], r[10]); CE_DESC(r[11], r[12]);
    CE_DESC(r[6], r[7]); CE_DESC(r[8], r[9]);
}
__device__ __forceinline__ void top16_merge(unsigned (&r)[16], const unsigned (&n)[16]) {
#pragma unroll
    for (int i = 0; i < 16; ++i) r[i] = kmax(r[i], n[15 - i]);
    bitonic_merge16(r);
}
template <int XM> __device__ __forceinline__ unsigned quad_xor(unsigned v) {
    static_assert(XM == 1 || XM == 2, "quad permute");
    return (unsigned)__builtin_amdgcn_mov_dpp((int)v, XM == 1 ? 0xB1 : 0x4E, 0xf, 0xf, true);
}
template <int XM> __device__ __forceinline__ unsigned kmax_quad(unsigned partner_src, unsigned own) {
    static_assert(XM == 1 || XM == 2, "quad permute");
    unsigned r;
    if constexpr (XM == 1) asm("v_max_f32_dpp %0, %1, %2 quad_perm:[1,0,3,2] row_mask:0xf bank_mask:0xf" : "=v"(r) : "v"(partner_src), "v"(own));
    else                   asm("v_max_f32_dpp %0, %1, %2 quad_perm:[2,3,0,1] row_mask:0xf bank_mask:0xf" : "=v"(r) : "v"(partner_src), "v"(own));
    return r;
}
template <int XM, bool SORTED = true> __device__ __forceinline__ void top16_merge_lane_t(unsigned (&r)[16]) {
    unsigned t[16];
#pragma unroll
    for (int i = 0; i < 16; ++i) t[i] = kmax_quad<XM>(r[15 - i], r[i]);
#pragma unroll
    for (int i = 0; i < 16; ++i) r[i] = t[i];
    if constexpr (SORTED) bitonic_merge16(r);
}
__device__ __forceinline__ void top16_merge_lane(unsigned (&r)[16], int xm) {
    if (xm == 1) top16_merge_lane_t<1>(r); else top16_merge_lane_t<2>(r);
}
__device__ __forceinline__ void sort13_desc(unsigned (&r)[16]) {
    CE_DESC(r[1], r[12]); CE_DESC(r[4], r[8]); CE_DESC(r[5], r[6]); CE_DESC(r[7], r[11]); CE_DESC(r[9], r[10]);
    CE_DESC(r[0], r[5]); CE_DESC(r[1], r[7]); CE_DESC(r[2], r[9]); CE_DESC(r[3], r[4]); CE_DESC(r[11], r[12]);
    CE_DESC(r[0], r[1]); CE_DESC(r[2], r[3]); CE_DESC(r[4], r[5]); CE_DESC(r[6], r[8]); CE_DESC(r[7], r[9]); CE_DESC(r[10], r[11]);
    CE_DESC(r[0], r[2]); CE_DESC(r[1], r[3]); CE_DESC(r[4], r[10]); CE_DESC(r[5], r[11]); CE_DESC(r[6], r[7]); CE_DESC(r[8], r[9]);
    CE_DESC(r[1], r[2]); CE_DESC(r[3], r[12]); CE_DESC(r[4], r[6]); CE_DESC(r[5], r[7]); CE_DESC(r[8], r[10]); CE_DESC(r[9], r[11]);
    CE_DESC(r[1], r[4]); CE_DESC(r[2], r[6]); CE_DESC(r[5], r[8]); CE_DESC(r[7], r[10]);
    CE_DESC(r[2], r[4]); CE_DESC(r[3], r[6]); CE_DESC(r[9], r[12]);
    CE_DESC(r[3], r[5]); CE_DESC(r[6], r[8]); CE_DESC(r[7], r[9]); CE_DESC(r[10], r[12]);
    CE_DESC(r[3], r[4]); CE_DESC(r[5], r[6]); CE_DESC(r[7], r[8]); CE_DESC(r[9], r[10]); CE_DESC(r[11], r[12]);
    CE_DESC(r[6], r[7]); CE_DESC(r[8], r[9]);
}
__device__ __forceinline__ void p7_cand_table(LAS unsigned char* CAND, int tid) {
    if (tid < 52) {
        int c = 0; unsigned char v = 255;
        for (int a = 0; a < 16; ++a) for (int b = 0; b < 16 / (a + 1); ++b) { if (c == tid) v = (unsigned char)(a * 16 + b); ++c; }
        CAND[tid] = v;
    }
}
__device__ __forceinline__ void route16(const bf16_t* qp, const float* rowsq, float* gwo, size_t t0, int lane, LAS unsigned* lists, const LAS unsigned char* CAND, LAS unsigned short* IDX) {
    const int tok = lane >> 2, part = lane & 3;
    const float r2 = rsqrtf(rowsq[t0 + tok] * (1.f / DM) + EPSN);
    u32x4 nxt[2][4];
#pragma unroll
    for (int j = 0; j < 2; ++j)
#pragma unroll
        for (int q = 0; q < 4; ++q) nxt[j][q] = __builtin_nontemporal_load((const u32x4*)(qp + (t0 + tok) * 2048 + j * 128 + part * 32 + q * 8));
#pragma unroll 1
    for (int h = 0; h < 8; ++h) {
        u32x4 raw[2][4];
#pragma unroll
        for (int j = 0; j < 2; ++j)
#pragma unroll
            for (int q = 0; q < 4; ++q) raw[j][q] = nxt[j][q];
        if (h < 7) {
#pragma unroll
            for (int j = 0; j < 2; ++j)
#pragma unroll
                for (int q = 0; q < 4; ++q) nxt[j][q] = __builtin_nontemporal_load((const u32x4*)(qp + (t0 + tok) * 2048 + (h + 1) * 256 + j * 128 + part * 32 + q * 8));
        }
#pragma unroll
        for (int j = 0; j < 2; ++j) {
            unsigned r[16], n[16];
#pragma unroll
            for (int q = 0; q < 2; ++q)
#pragma unroll
                for (int e = 0; e < 4; ++e) {
                    r[q * 8 + 2 * e]     = (raw[j][q][e] << 16) | (unsigned)(part * 32 + q * 8 + 2 * e);
                    r[q * 8 + 2 * e + 1] = (raw[j][q][e] & 0xffff0000u) | (unsigned)(part * 32 + q * 8 + 2 * e + 1);
                    n[q * 8 + 2 * e]     = (raw[j][2 + q][e] << 16) | (unsigned)(part * 32 + 16 + q * 8 + 2 * e);
                    n[q * 8 + 2 * e + 1] = (raw[j][2 + q][e] & 0xffff0000u) | (unsigned)(part * 32 + 16 + q * 8 + 2 * e + 1);
                }
            bitonic_sort16(r); bitonic_sort16(n);
            top16_merge(r, n);
            top16_merge_lane(r, 1);
            top16_merge_lane(r, 2);
            if (part == 0) {
#pragma unroll
                for (int k = 0; k < 4; ++k) *(LAS u32x4*)(lists + (tok * 2 + j) * 16 + 4 * k) = (u32x4){r[4 * k], r[4 * k + 1], r[4 * k + 2], r[4 * k + 3]};
            }
        }
        LDS_WAIT(); __builtin_amdgcn_wave_barrier();
        {
            const LAS unsigned* l0 = lists + (2 * tok) * 16; const LAS unsigned* l1 = lists + (2 * tok + 1) * 16;
            unsigned r[16];
#pragma unroll
            for (int m = 0; m < 13; ++m) {
                const unsigned ab = CAND[part + 4 * m];
                const unsigned a = (ab >> 4) & 15u, bb = ab & 15u;
                const float sum = __uint_as_float(l0[a] & ~127u) + __uint_as_float(l1[bb] & ~127u);
                r[m] = (__float_as_uint(sum) & ~255u) | ab;
            }
            r[13] = KEY_NEG_INF; r[14] = KEY_NEG_INF; r[15] = KEY_NEG_INF;
            sort13_desc(r);
            top16_merge_lane_t<1>(r);
            top16_merge_lane_t<2, false>(r);
            float val[4]; unsigned ex[4]; float mx = -1e30f;
#pragma unroll
            for (int i = 0; i < 4; ++i) {
                const unsigned rk = part == 0 ? r[i] : (part == 1 ? r[4 + i] : (part == 2 ? r[7 - i] : r[3 - i]));
                const unsigned pos = rk & 255u, a = pos >> 4, bb = pos & 15u;
                const unsigned w0 = l0[a], w1 = l1[bb];
                ex[i] = (w0 & 127u) * 128u + (w1 & 127u);
                val[i] = (__uint_as_float(w0 & ~127u) + __uint_as_float(w1 & ~127u)) * r2;
                mx = fmaxf(mx, val[i]);
            }
            mx = fmaxf(mx, DPP_F(mx, 0xB1)); mx = fmaxf(mx, DPP_F(mx, 0x4E));
            float sum = 0.f;
#pragma unroll
            for (int i = 0; i < 4; ++i) { val[i] = __expf(val[i] - mx); sum += val[i]; }
            sum += DPP_F(sum, 0xB1); sum += DPP_F(sum, 0x4E);
            const float inv = __builtin_amdgcn_rcpf(sum);
            u32x2 ew; ew.x = ex[0] | (ex[1] << 16); ew.y = ex[2] | (ex[3] << 16);
            *(LAS u32x2*)(IDX + tok * 128 + h * 16 + part * 4) = ew;
            *(f32x4*)(gwo + ((t0 + tok) * 8 + h) * 16 + part * 4) = (f32x4){val[0] * inv, val[1] * inv, val[2] * inv, val[3] * inv};
        }
        LDS_WAIT(); __builtin_amdgcn_wave_barrier();
    }
}

__device__ __forceinline__ void xcd_pace(const XcdBarrier& b, int slot) {
    __syncthreads();
    if (threadIdx.x == 0) {
        const unsigned nloc = b.st[0];
        unsigned* w = b.bar + XCD_BAR_WORDS + (slot * 16 + (int)b.x) * 16;
        (void)xb_add(w, 1u);
        unsigned sp = 0;
        while (xb_ld(w) < nloc && ++sp < 3000u) __builtin_amdgcn_s_sleep(1);
    }
    __syncthreads();
}
__device__ __forceinline__ float gelu_erf(float x) { return 0.5f * x * (1.f + erff(x * 0.70710678118654752f)); }
typedef float f32x2 __attribute__((ext_vector_type(2)));
constexpr int P8_NSL = 8, P8_SLC = DM / P8_NSL, P8_KS = P8_SLC / 32;
constexpr float P8_XS = 32.f;
static_assert(P8_SLC == 128, "lane mappings assume 128-column (128-byte) slices");
__device__ __forceinline__ void phase8(const Params& p, Ctx& F, const XcdBarrier& bar) {
    const bool pace = false;
    unsigned char* ws = p.ws;
    const unsigned char* uq = ws + WS_UB; const unsigned char* vq = ws + WS_VB;
    const float* rsu = (const float*)(ws + WS_RSU); const float* rsv = (const float*)(ws + WS_RSV);
    const bf16_t* x1b = (const bf16_t*)(ws + WS_X1B);
    const float* rowsq = (const float*)(ws + WS_CTL) + CW_ROWSQ;
    const float* gwi = (const float*)(ws + WS_GW);
    float* out = p.out;
    const int lane = F.lane, fr = lane & 15, fq = lane >> 4;
    LAS unsigned short* IDX = (LAS unsigned short*)(F.lds + F.wave * 20480);
    LAS float* COEF = (LAS float*)(F.lds + F.wave * 20480 + 4096);
    LAS unsigned char* STG = (LAS unsigned char*)COEF;
    LAS unsigned char* CAND = STG + 2048;
    __syncthreads();
    p7_cand_table(CAND, lane);
    LDS_WAIT(); __builtin_amdgcn_wave_barrier();
    for (int task = F.gw; task < TOK / 16; task += F.ngw) {
        const size_t t0 = (size_t)task * 16;
#if defined(PROBE_PHASE) && PROBE_PHASE == 82
        F.ta = __builtin_amdgcn_s_memrealtime();
#endif
        route16((const bf16_t*)(ws + WS_QP), rowsq, (float*)(ws + WS_GW), t0, lane, (LAS unsigned*)STG, CAND, IDX);
#if defined(PROBE_PHASE) && PROBE_PHASE == 82
        F.tb = __builtin_amdgcn_s_memrealtime();
#endif
        const float r2 = rsqrtf(rowsq[t0 + fr] * (1.f / DM) + EPSN);
        VM_WAIT(); LDS_WAIT(); __builtin_amdgcn_wave_barrier();
#if defined(PROBE_PHASE) && (PROBE_PHASE == 80 || PROBE_PHASE == 81)
        F.ta = __builtin_amdgcn_s_memrealtime();
#endif
        f32x4 accU[8];
#pragma unroll
        for (int h = 0; h < 8; ++h) accU[h] = (f32x4){0.f, 0.f, 0.f, 0.f};
        const int lrow = lane >> 3, lch = lane & 7;
        const int wofs0 = lrow * 128 + ((lch ^ (lrow & 7)) << 4), wofs1 = wofs0 + 1024;
        const float xsc = r2 * P8_XS;
#ifdef U_FP4
        typedef int v8i __attribute__((ext_vector_type(8)));
        int rofs4[2];
#pragma unroll
        for (int m = 0; m < 2; ++m) rofs4[m] = fr * 128 + (((4 * m + fq) ^ (fr & 7)) << 4);
#pragma unroll 1
        for (int sl = 0; sl < 4; ++sl) {
            v8i xf[2];
#pragma unroll
            for (int m = 0; m < 2; ++m) {
                const bf16_t* xp = x1b + (t0 + fr) * DM + sl * 256 + 128 * m + 16 * fq;
#pragma unroll
                for (int q = 0; q < 4; ++q) {
                    const u32x4 xv = *(const u32x4*)(xp + 64 * (q >> 1) + 8 * (q & 1));
                    int lo = 0, hi = 0;
                    lo = __builtin_amdgcn_cvt_pk_fp8_f32(bf2f(xv[0] & 0xffffu) * xsc, bf2f(xv[0] >> 16) * xsc, lo, false);
                    lo = __builtin_amdgcn_cvt_pk_fp8_f32(bf2f(xv[1] & 0xffffu) * xsc, bf2f(xv[1] >> 16) * xsc, lo, true);
                    hi = __builtin_amdgcn_cvt_pk_fp8_f32(bf2f(xv[2] & 0xffffu) * xsc, bf2f(xv[2] >> 16) * xsc, hi, false);
                    hi = __builtin_amdgcn_cvt_pk_fp8_f32(bf2f(xv[3] & 0xffffu) * xsc, bf2f(xv[3] >> 16) * xsc, hi, true);
                    xf[m][2 * q] = lo; xf[m][2 * q + 1] = hi;
                }
            }
            const unsigned char* ubs = uq + sl * 128 + lch * 16;
#pragma unroll 1
            for (int j0 = 0; j0 < 16; ++j0) {
                const bool mine = (fr == j0);
                v8i bm[2];
#pragma unroll
                for (int m = 0; m < 2; ++m)
#pragma unroll
                    for (int q = 0; q < 8; ++q) bm[m][q] = mine ? xf[m][q] : 0;
                u32x4 g0[8], g1[8];
#pragma unroll
                for (int h = 0; h < 8; ++h) {
                    const unsigned e0 = IDX[j0 * 128 + h * 16 + lrow], e1 = IDX[j0 * 128 + h * 16 + lrow + 8];
                    g0[h] = *(const u32x4*)(ubs + (size_t)e0 * (DM / 2));
                    g1[h] = *(const u32x4*)(ubs + (size_t)e1 * (DM / 2));
                }
#pragma unroll
                for (int hg = 0; hg < 2; ++hg) {
#pragma unroll
                    for (int h = 0; h < 4; ++h) {
                        *(LAS u32x4*)(STG + h * 2048 + wofs0) = g0[hg * 4 + h];
                        *(LAS u32x4*)(STG + h * 2048 + wofs1) = g1[hg * 4 + h];
                    }
                    __builtin_amdgcn_wave_barrier();
#pragma unroll
                    for (int h = 0; h < 4; ++h)
#pragma unroll
                        for (int m = 0; m < 2; ++m) {
                            const u32x4 a16 = *(const LAS u32x4*)(STG + h * 2048 + rofs4[m]);
                            const v8i av = {(int)a16.x, (int)a16.y, (int)a16.z, (int)a16.w, 0, 0, 0, 0};
                            accU[hg * 4 + h] = __builtin_amdgcn_mfma_scale_f32_16x16x128_f8f6f4(av, bm[m], accU[hg * 4 + h], 4, 0, 0, 0, 0, 0);
                        }
                    __builtin_amdgcn_wave_barrier();
                }
            }
        }
#else
        int rofs[P8_KS];
#pragma unroll
        for (int ks = 0; ks < P8_KS; ++ks) rofs[ks] = fr * 128 + (((2 * ks + (fq >> 1)) ^ (fr & 7)) << 4) + (fq & 1) * 8;
#pragma unroll 1
        for (int sl = 0; sl < P8_NSL; ++sl) {
            if (pace) xcd_pace(bar, sl);
            long xf[P8_KS];
#pragma unroll
            for (int ks = 0; ks < P8_KS; ++ks) {
                const u32x4 xv = *(const u32x4*)(x1b + (t0 + fr) * DM + sl * P8_SLC + ks * 32 + 8 * fq);
                int lo = 0, hi = 0;
                lo = __builtin_amdgcn_cvt_pk_fp8_f32(bf2f(xv[0] & 0xffffu) * xsc, bf2f(xv[0] >> 16) * xsc, lo, false);
                lo = __builtin_amdgcn_cvt_pk_fp8_f32(bf2f(xv[1] & 0xffffu) * xsc, bf2f(xv[1] >> 16) * xsc, lo, true);
                hi = __builtin_amdgcn_cvt_pk_fp8_f32(bf2f(xv[2] & 0xffffu) * xsc, bf2f(xv[2] >> 16) * xsc, hi, false);
                hi = __builtin_amdgcn_cvt_pk_fp8_f32(bf2f(xv[3] & 0xffffu) * xsc, bf2f(xv[3] >> 16) * xsc, hi, true);
                xf[ks] = (long)(((unsigned long long)(unsigned)hi << 32) | (unsigned long long)(unsigned)lo);
            }
            const unsigned char* ubs = uq + sl * P8_SLC + lch * 16;
#pragma unroll 1
            for (int j0 = 0; j0 < 16; ++j0) {
                const bool mine = (fr == j0);
                long bm[P8_KS];
#pragma unroll
                for (int ks = 0; ks < P8_KS; ++ks) bm[ks] = mine ? xf[ks] : 0l;
                u32x4 g0[8], g1[8];
#pragma unroll
                for (int h = 0; h < 8; ++h) {
                    const unsigned e0 = IDX[j0 * 128 + h * 16 + lrow], e1 = IDX[j0 * 128 + h * 16 + lrow + 8];
                    g0[h] = *(const u32x4*)(ubs + (size_t)e0 * DM);
                    g1[h] = *(const u32x4*)(ubs + (size_t)e1 * DM);
                }
#pragma unroll
                for (int hg = 0; hg < 2; ++hg) {
#pragma unroll
                    for (int h = 0; h < 4; ++h) {
                        *(LAS u32x4*)(STG + h * 2048 + wofs0) = g0[hg * 4 + h];
                        *(LAS u32x4*)(STG + h * 2048 + wofs1) = g1[hg * 4 + h];
                    }
                    __builtin_amdgcn_wave_barrier();
#pragma unroll
                    for (int h = 0; h < 4; ++h)
#pragma unroll
                        for (int ks = 0; ks < P8_KS; ++ks) {
                            const long a = *(const LAS long*)(STG + h * 2048 + rofs[ks]);
                            accU[hg * 4 + h] = __builtin_amdgcn_mfma_f32_16x16x32_fp8_fp8(a, bm[ks], accU[hg * 4 + h], 0, 0, 0);
                        }
                    __builtin_amdgcn_wave_barrier();
                }
            }
        }
#endif
        LDS_WAIT(); __builtin_amdgcn_wave_barrier();
#pragma unroll
        for (int h = 0; h < 8; ++h) {
            const f32x4 gv = *(const f32x4*)(gwi + (t0 + fr) * 128 + h * 16 + 4 * fq);
#pragma unroll
            for (int jj = 0; jj < 4; ++jj) {
                const int slot = h * 16 + 4 * fq + jj;
                const unsigned e = IDX[fr * 128 + slot];
                const float hv = accU[h][jj] * rsu[e] * (1.f / P8_XS);
                COEF[fr * 128 + slot] = gv[jj] * gelu_erf(hv) * rsv[e];
            }
        }
        LDS_WAIT(); __builtin_amdgcn_wave_barrier();
#if defined(PROBE_PHASE) && (PROBE_PHASE == 80 || PROBE_PHASE == 81)
        F.tb = __builtin_amdgcn_s_memrealtime();
#endif
#ifdef V_VALU
        const int sub = lane & 7, rg = lane >> 3;
#pragma unroll 1
        for (int sl = 0; sl < P8_NSL; ++sl) {
            const unsigned char* vbs = vq + sl * P8_SLC + sub * 16;
#pragma unroll 1
            for (int j0 = 0; j0 < 16; ++j0) {
                f32x2 acc[8];
#pragma unroll
                for (int q = 0; q < 8; ++q) acc[q] = (f32x2){0.f, 0.f};
#pragma unroll
                for (int ib = 0; ib < 2; ++ib) {
                    u32x4 w[8]; float cf[8];
#pragma unroll
                    for (int it = 0; it < 8; ++it) {
                        const int slot = (ib * 8 + it) * 8 + rg;
                        const unsigned e = IDX[j0 * 128 + slot];
                        cf[it] = COEF[j0 * 128 + slot];
                        w[it] = *(const u32x4*)(vbs + (size_t)e * DM);
                    }
#pragma unroll
                    for (int it = 0; it < 8; ++it)
#pragma unroll
                        for (int q = 0; q < 4; ++q) {
                            acc[2 * q] += __builtin_amdgcn_cvt_pk_f32_fp8((int)w[it][q], false) * cf[it];
                            acc[2 * q + 1] += __builtin_amdgcn_cvt_pk_f32_fp8((int)w[it][q], true) * cf[it];
                        }
                }
#pragma unroll
                for (int q = 0; q < 8; ++q) {
                    acc[q].x += __shfl_xor(acc[q].x, 8); acc[q].y += __shfl_xor(acc[q].y, 8);
                    acc[q].x += __shfl_xor(acc[q].x, 16); acc[q].y += __shfl_xor(acc[q].y, 16);
                    acc[q].x += __shfl_xor(acc[q].x, 32); acc[q].y += __shfl_xor(acc[q].y, 32);
                }
                if (rg == 0) {
                    float* orow = out + (t0 + j0) * DM + sl * P8_SLC + sub * 16;
                    const bf16_t* xrow = x1b + (t0 + j0) * DM + sl * P8_SLC + sub * 16;
#pragma unroll
                    for (int q = 0; q < 4; ++q) {
                        const u32x2 xv = *(const u32x2*)(xrow + 4 * q);
                        f32x4 o = {bf2f(xv.x & 0xffffu), bf2f(xv.x >> 16), bf2f(xv.y & 0xffffu), bf2f(xv.y >> 16)};
                        o[0] += acc[2 * q].x; o[1] += acc[2 * q].y; o[2] += acc[2 * q + 1].x; o[3] += acc[2 * q + 1].y;
                        *(f32x4*)(orow + 4 * q) = o;
                    }
                }
            }
        }
#elif defined(V_FP4)
        typedef int v2i __attribute__((ext_vector_type(2)));
        typedef int v8i __attribute__((ext_vector_type(8)));
        v8i cq8; float inv_cs;
        {
            f32x4 cv[2][4]; float cmax = 0.f;
#pragma unroll
            for (int hf = 0; hf < 2; ++hf)
#pragma unroll
                for (int q = 0; q < 4; ++q) {
                    cv[hf][q] = *(const LAS f32x4*)(COEF + fr * 128 + hf * 64 + 16 * fq + 4 * q);
                    cmax = fmaxf(cmax, fmaxf(fmaxf(fabsf(cv[hf][q][0]), fabsf(cv[hf][q][1])), fmaxf(fabsf(cv[hf][q][2]), fabsf(cv[hf][q][3]))));
                }
            cmax = fmaxf(cmax, __shfl_xor(cmax, 16)); cmax = fmaxf(cmax, __shfl_xor(cmax, 32));
            const float cs = cmax > 0.f ? 240.f / cmax : 1.f; inv_cs = cmax > 0.f ? cmax * (1.f / 240.f) : 1.f;
#pragma unroll
            for (int hf = 0; hf < 2; ++hf)
#pragma unroll
                for (int q = 0; q < 4; ++q) {
                    int pk = 0;
                    pk = __builtin_amdgcn_cvt_pk_fp8_f32(cv[hf][q][0] * cs, cv[hf][q][1] * cs, pk, false);
                    pk = __builtin_amdgcn_cvt_pk_fp8_f32(cv[hf][q][2] * cs, cv[hf][q][3] * cs, pk, true);
                    cq8[hf * 4 + q] = pk;
                }
        }
        LDS_WAIT(); __builtin_amdgcn_wave_barrier();
        int vwofs[16];
#pragma unroll
        for (int i = 0; i < 16; ++i) { const int rr = lrow + 8 * i; vwofs[i] = rr * 128 + ((lch ^ ((rr >> 1) & 7)) << 4); }
        int vrow_[2], vsw_[2];
#pragma unroll
        for (int t = 0; t < 2; ++t) { vrow_[t] = 32 * fq + 16 * t + fr; vsw_[t] = (vrow_[t] >> 1) & 7; }
#pragma unroll 1
        for (int sl = 0; sl < 4; ++sl) {
            f32x4 accV[16];
#pragma unroll
            for (int ct = 0; ct < 16; ++ct) accV[ct] = (f32x4){0.f, 0.f, 0.f, 0.f};
            const unsigned char* vbs = vq + sl * 128 + lch * 16;
#pragma unroll 1
            for (int j0 = 0; j0 < 16; ++j0) {
                const bool mine = (fr == j0);
                u32x4 g[16];
#pragma unroll
                for (int i = 0; i < 16; ++i) {
                    const unsigned e = IDX[j0 * 128 + lrow + 8 * i];
                    g[i] = *(const u32x4*)(vbs + (size_t)e * (DM / 2));
                }
#pragma unroll
                for (int i = 0; i < 16; ++i) *(LAS u32x4*)(STG + vwofs[i]) = g[i];
                __builtin_amdgcn_wave_barrier();
                v8i bmq;
#pragma unroll
                for (int q = 0; q < 8; ++q) bmq[q] = mine ? cq8[q] : 0;
#pragma unroll
                for (int ct = 0; ct < 16; ++ct) {
                    const v2i r0 = __builtin_amdgcn_ds_read_tr4_b64_v2i32((LAS v2i*)(STG + vrow_[0] * 128 + (((ct >> 1) ^ vsw_[0]) << 4) + (ct & 1) * 8));
                    const v2i r1 = __builtin_amdgcn_ds_read_tr4_b64_v2i32((LAS v2i*)(STG + vrow_[1] * 128 + (((ct >> 1) ^ vsw_[1]) << 4) + (ct & 1) * 8));
                    const v8i av = {r0.x, r0.y, r1.x, r1.y, 0, 0, 0, 0};
                    accV[ct] = __builtin_amdgcn_mfma_scale_f32_16x16x128_f8f6f4(av, bmq, accV[ct], 4, 0, 0, 0, 0, 0);
                }
                __builtin_amdgcn_wave_barrier();
            }
            float* orow = out + (t0 + fr) * DM + sl * 256 + 4 * fq;
            const bf16_t* xrow = x1b + (t0 + fr) * DM + sl * 256 + 4 * fq;
#pragma unroll
            for (int ct = 0; ct < 16; ++ct) {
                const u32x2 xv = *(const u32x2*)(xrow + ct * 16);
                f32x4 o = {bf2f(xv.x & 0xffffu), bf2f(xv.x >> 16), bf2f(xv.y & 0xffffu), bf2f(xv.y >> 16)};
                o += accV[ct] * inv_cs;
                __builtin_nontemporal_store(o, (f32x4*)(orow + ct * 16));
            }
        }
#else
        typedef int v2i __attribute__((ext_vector_type(2)));
        long cq[4]; float inv_cs;
        {
            f32x4 cv[4][2]; float cmax = 0.f;
#pragma unroll
            for (int kk = 0; kk < 4; ++kk)
#pragma unroll
                for (int q = 0; q < 2; ++q) {
                    cv[kk][q] = *(const LAS f32x4*)(COEF + fr * 128 + kk * 32 + 8 * fq + 4 * q);
                    cmax = fmaxf(cmax, fmaxf(fmaxf(fabsf(cv[kk][q][0]), fabsf(cv[kk][q][1])), fmaxf(fabsf(cv[kk][q][2]), fabsf(cv[kk][q][3]))));
                }
            cmax = fmaxf(cmax, __shfl_xor(cmax, 16)); cmax = fmaxf(cmax, __shfl_xor(cmax, 32));
            const float cs = cmax > 0.f ? 240.f / cmax : 1.f; inv_cs = cmax > 0.f ? cmax * (1.f / 240.f) : 1.f;
#pragma unroll
            for (int kk = 0; kk < 4; ++kk) {
                int lo = 0, hi = 0;
                lo = __builtin_amdgcn_cvt_pk_fp8_f32(cv[kk][0][0] * cs, cv[kk][0][1] * cs, lo, false);
                lo = __builtin_amdgcn_cvt_pk_fp8_f32(cv[kk][0][2] * cs, cv[kk][0][3] * cs, lo, true);
                hi = __builtin_amdgcn_cvt_pk_fp8_f32(cv[kk][1][0] * cs, cv[kk][1][1] * cs, hi, false);
                hi = __builtin_amdgcn_cvt_pk_fp8_f32(cv[kk][1][2] * cs, cv[kk][1][3] * cs, hi, true);
                cq[kk] = (long)(((unsigned long long)(unsigned)hi << 32) | (unsigned long long)(unsigned)lo);
            }
        }
        LDS_WAIT(); __builtin_amdgcn_wave_barrier();
        const int vrow = 8 * fq + (fr >> 1);
        const int vrd0 = vrow * 128 + (fr & 1) * 8, vsw = (vrow >> 1) & 7;
        int vwofs[4];
#pragma unroll
        for (int i = 0; i < 4; ++i) { const int rr = lrow + 8 * i; vwofs[i] = rr * 128 + ((lch ^ ((rr >> 1) & 7)) << 4); }
#pragma unroll 1
        for (int sl = 0; sl < P8_NSL; ++sl) {
            if (pace) xcd_pace(bar, P8_NSL + sl);
            f32x4 accV[8];
#pragma unroll
            for (int ct = 0; ct < 8; ++ct) accV[ct] = (f32x4){0.f, 0.f, 0.f, 0.f};
            const unsigned char* vbs = vq + sl * P8_SLC + lch * 16;
#pragma unroll 1
            for (int j0 = 0; j0 < 16; ++j0) {
                const bool mine = (fr == j0);
                u32x4 g[4][4];
#pragma unroll
                for (int kk = 0; kk < 4; ++kk)
#pragma unroll
                    for (int i = 0; i < 4; ++i) {
                        const unsigned e = IDX[j0 * 128 + kk * 32 + lrow + 8 * i];
                        g[kk][i] = *(const u32x4*)(vbs + (size_t)e * DM);
                    }
#pragma unroll
                for (int kk = 0; kk < 4; ++kk) {
                    LAS unsigned char* T = STG + (kk & 1) * 4096;
#pragma unroll
                    for (int i = 0; i < 4; ++i) *(LAS u32x4*)(T + vwofs[i]) = g[kk][i];
                    __builtin_amdgcn_wave_barrier();
                    const long bmq = mine ? cq[kk] : 0l;
#pragma unroll
                    for (int ct = 0; ct < 8; ++ct) {
                        const v2i av = __builtin_amdgcn_ds_read_tr8_b64_v2i32((LAS v2i*)(T + vrd0 + ((ct ^ vsw) << 4)));
                        const long a = (long)(((unsigned long long)(unsigned)av.y << 32) | (unsigned long long)(unsigned)av.x);
                        accV[ct] = __builtin_amdgcn_mfma_f32_16x16x32_fp8_fp8(a, bmq, accV[ct], 0, 0, 0);
                    }
                    __builtin_amdgcn_wave_barrier();
                }
            }
            float* orow = out + (t0 + fr) * DM + sl * P8_SLC + 4 * fq;
            const bf16_t* xrow = x1b + (t0 + fr) * DM + sl * P8_SLC + 4 * fq;
#pragma unroll
            for (int ct = 0; ct < 8; ++ct) {
                const u32x2 xv = *(const u32x2*)(xrow + ct * 16);
                f32x4 o = {bf2f(xv.x & 0xffffu), bf2f(xv.x >> 16), bf2f(xv.y & 0xffffu), bf2f(xv.y >> 16)};
                o += accV[ct] * inv_cs;
                __builtin_nontemporal_store(o, (f32x4*)(orow + ct * 16));
            }
        }
#endif
#if defined(PROBE_PHASE) && PROBE_PHASE >= 80
        F.tc = __builtin_amdgcn_s_memrealtime();
#endif
        LDS_WAIT(); __builtin_amdgcn_wave_barrier();
    }
}

constexpr int NPHASE = 9;
#ifndef N_LAUNCHES
#define N_LAUNCHES 1
#endif
constexpr int MISC_OFF = LDS_BYTES - 128;
constexpr unsigned ZF_READY = 0x600DF1A6u, ZF_IDLE = 0x1D7E1D7Eu;
__global__ void __launch_bounds__(512, 2) fwd_kernel(Params p) {
    extern __shared__ __attribute__((aligned(16))) unsigned char lds_raw[];
    Ctx F; F.ta = F.tb = F.tc = 0;
    F.lds = (LAS unsigned char*)lds_raw;
    F.tid = threadIdx.x; F.lane = F.tid & 63; F.wave = __builtin_amdgcn_readfirstlane(F.tid >> 6);
    F.G = gridDim.x; { const int bx = blockIdx.x; F.vcu = (F.G % 8 == 0) ? (bx % 8) * (F.G / 8) + bx / 8 : bx; }
    F.gw = F.vcu * 8 + F.wave; F.ngw = F.G * 8;
    unsigned char* ws = p.ws;
    const int lo = p.ph_lo, hi = p.ph_hi;
    volatile LAS unsigned* MISC = (volatile LAS unsigned*)(F.lds + MISC_OFF);
    if (F.tid < 32) MISC[F.tid] = 0u;
    __syncthreads();
#ifdef CG_FIRST_SYNC
    XcdBarrier bar; bar.bar = (unsigned*)(ws + WS_CTL) + CW_BAR; bar.x = 0; bar.st = MISC + 8;
    for (int i = blockIdx.x * 512 + F.tid; i < XCD_BAR_WORDS + PACE_WORDS; i += F.G * 512) __hip_atomic_store(bar.bar + i, 0u, __ATOMIC_RELAXED, __HIP_MEMORY_SCOPE_AGENT);
#elif defined(SELF_ZERO)
    XcdBarrier bar; bar.bar = (unsigned*)(ws + WS_CTL) + CW_BAR; bar.x = 0; bar.st = MISC + 8;
    unsigned* const zflag = (unsigned*)(ws + WS_CTL) + 64;
    if (blockIdx.x == 0) {
        for (int i = F.tid; i < XCD_BAR_WORDS + PACE_WORDS; i += 512) __hip_atomic_store(bar.bar + i, 0u, __ATOMIC_RELAXED, __HIP_MEMORY_SCOPE_AGENT);
        asm volatile("s_waitcnt vmcnt(0)" ::: "memory"); __threadfence(); __syncthreads();
        if (F.tid == 0) __hip_atomic_store(zflag, ZF_READY, __ATOMIC_RELEASE, __HIP_MEMORY_SCOPE_AGENT);
    }
#else
    XcdBarrier bar = xcd_barrier_post((unsigned*)(ws + WS_CTL) + CW_BAR, MISC + 8);
#endif
#ifdef ONLY_PHASE
#define IN(k) ((k)==ONLY_PHASE)
#else
#define IN(k) (lo <= (k) && (k) < hi)
#endif
#ifdef PROBE_PHASE
    unsigned long long tp0 = __builtin_amdgcn_s_memrealtime(), tp1 = 0; const unsigned long long tstart = tp0;
#define PSTAMP(k) do { if ((k) + 1 == PROBE_PHASE) tp0 = __builtin_amdgcn_s_memrealtime(); if ((k) == PROBE_PHASE) tp1 = __builtin_amdgcn_s_memrealtime(); } while (0)
#else
#define PSTAMP(k) do {} while (0)
#endif
#define SEAM(k) do { if (IN(k) && ((k) == 6 ? IN(8) : IN((k) + 1))) xcd_barrier(bar); PSTAMP(k); } while (0)
    if (IN(0)) phase0(p, F);
#ifdef CG_FIRST_SYNC
    if (IN(0) && IN(1)) { cooperative_groups::this_grid().sync(); bar = xcd_barrier_post((unsigned*)(ws + WS_CTL) + CW_BAR, MISC + 8); }
    PSTAMP(0);
#else
#ifdef SELF_ZERO
    if (F.tid == 0) { unsigned sp = 0u; while (__hip_atomic_load(zflag, __ATOMIC_ACQUIRE, __HIP_MEMORY_SCOPE_AGENT) != ZF_READY && ++sp < (1u << 24)) __builtin_amdgcn_s_sleep(2); }
    __syncthreads();
    bar = xcd_barrier_post((unsigned*)(ws + WS_CTL) + CW_BAR, MISC + 8);
#endif
    SEAM(0);
#endif
    if (IN(1)) {
        pg8::Gemm g{(const pg8::bf16_t*)(ws + WS_XB), (const pg8::bf16_t*)(ws + WS_WINT), TOK, NIN, DM};
        pg8::StaticOrder S; S.init(TOK, NIN, F.G, (int)blockIdx.x);
        pg8::EpiProj E{(pg8::bf16_t*)(ws + WS_PROJ), NIN, p.in[9], p.in[10], (const float*)(ws + WS_ROPE), (const float*)(ws + WS_ROPE) + SEQ * 8,
                       (LAS float*)(F.lds + pg8::STAGE_BYTES), PQ, PK, PV, SEQ - 1, EPSN};
        pg8::gemm_phase<pg8::EpiProj, pg8::StaticOrder, true, true>(F.lds, g, S, E);
    }
    SEAM(1);
    if (IN(2)) phase2_attn_ssd(p, F);
    SEAM(2);
#if defined(PROBE_PHASE) && PROBE_PHASE == 84
    const unsigned long long t3s = __builtin_amdgcn_s_memrealtime();
#endif
    if (IN(3)) p3_scan(p, F);
#if defined(PROBE_PHASE) && PROBE_PHASE == 84
    { const unsigned long long tend = __builtin_amdgcn_s_memrealtime();
      if (F.tid == 0) { unsigned* mw = (unsigned*)(ws + WS_MISC); const unsigned d = (unsigned)(tend - t3s); atomicMax(mw + 2, d); atomicMin(mw + 3, d); atomicAdd(mw + 4, d >> 8); } }
#endif
    SEAM(3);
    if (IN(4)) phase4(p, F);
    SEAM(4);
    if (IN(5)) {
        pg8::Gemm g{(const pg8::bf16_t*)(ws + WS_YCAT), (const pg8::bf16_t*)(ws + WS_WOUTT), TOK, DM, DM};
        pg8::StaticOrder S; S.init(TOK, DM, F.G, (int)blockIdx.x);
        pg8::EpiResid E{(const pg8::bf16_t*)(ws + WS_XB), (const float*)(ws + WS_RSTD), (pg8::bf16_t*)(ws + WS_X1B), (float*)(ws + WS_CTL) + CW_ROWSQ, DM};
        pg8::gemm_phase<pg8::EpiResid, pg8::StaticOrder, true, true>(F.lds, g, S, E);
    }
    SEAM(5);
    if (IN(6)) {
        pg8::Gemm g{(const pg8::bf16_t*)(ws + WS_X1B), (const pg8::bf16_t*)(ws + WS_WQT), TOK, 2048, DM};
        pg8::StaticOrder S; S.init(TOK, 2048, F.G, (int)blockIdx.x);
        pg8::EpiBf16<0> E{(pg8::bf16_t*)(ws + WS_QP), 2048, nullptr, 0, 0, 1.f};
        pg8::gemm_phase<pg8::EpiBf16<0>, pg8::StaticOrder, true, true>(F.lds, g, S, E);
    }
    SEAM(6);
    PSTAMP(7);
#if defined(PROBE_PHASE) && PROBE_PHASE == 83
    tp0 = __builtin_amdgcn_s_memrealtime();
#endif
#ifdef PROBE_PHASE
    const unsigned sv_nloc = MISC[8], sv_nx = MISC[9];
#endif
    if (IN(8)) phase8(p, F, bar);
#ifdef SELF_ZERO
    if (blockIdx.x == 0 && F.tid == 0) __hip_atomic_store(zflag, ZF_IDLE, __ATOMIC_RELAXED, __HIP_MEMORY_SCOPE_AGENT);
#endif
#ifdef PROBE_PHASE
    __syncthreads(); if (F.tid == 0) { MISC[8] = sv_nloc; MISC[9] = sv_nx; } __syncthreads();
#endif
#if defined(PROBE_PHASE) && PROBE_PHASE == 83
    {
        const unsigned long long tend = __builtin_amdgcn_s_memrealtime();
        if (F.tid == 0) { unsigned* mw = (unsigned*)(ws + WS_MISC); const unsigned d = (unsigned)(tend - tp0);
            atomicMax(mw + 2, d); atomicMin(mw + 3, d); atomicAdd(mw + 4, d >> 8); }
    }
#endif
#ifdef PROBE_PHASE
    xcd_barrier(bar);
    PSTAMP(8);
#if PROBE_PHASE == 83 || PROBE_PHASE == 84
    { const unsigned* mw = (const unsigned*)(ws + WS_MISC);
      const unsigned vmax = __hip_atomic_load(mw + 2, __ATOMIC_RELAXED, __HIP_MEMORY_SCOPE_AGENT), vmin = __hip_atomic_load(mw + 3, __ATOMIC_RELAXED, __HIP_MEMORY_SCOPE_AGENT), vsum = __hip_atomic_load(mw + 4, __ATOMIC_RELAXED, __HIP_MEMORY_SCOPE_AGENT);
      tp0 = 0; tp1 = PROBE_SUB == 0 ? vmax : (PROBE_SUB == 1 ? vmin : (unsigned)(((unsigned long long)vsum << 8) / gridDim.x)); }
#elif PROBE_PHASE == 32
    tp0 = 0; tp1 = __hip_atomic_load((const unsigned*)(ws + WS_MISC) + 16 + PROBE_SUB, __ATOMIC_RELAXED, __HIP_MEMORY_SCOPE_AGENT);
#elif PROBE_PHASE == 9
    tp0 = tstart; tp1 = __builtin_amdgcn_s_memrealtime();
#elif PROBE_PHASE == 80 || PROBE_PHASE == 20 || PROBE_PHASE == 30 || PROBE_PHASE == 82
    tp0 = F.ta; tp1 = F.tb;
#elif PROBE_PHASE == 81 || PROBE_PHASE == 21 || PROBE_PHASE == 31
    tp0 = F.tb; tp1 = F.tc;
#endif
#if PROBE_PHASE == 98
    {
        typedef int v2i __attribute__((ext_vector_type(2)));
        float result = 0.f;
        __syncthreads();
        if (blockIdx.x == 0 && F.wave == 0) {
            LAS unsigned char* T = (LAS unsigned char*)F.lds;
            if (F.lane < 16) {
                unsigned long long w = 0ull;
                for (int c = 0; c < 16; ++c) { const unsigned long long nib = (PROBE_SUB == 0) ? (unsigned long long)F.lane : (unsigned long long)c; w |= nib << (4 * c); }
                *(LAS unsigned long long*)(T + F.lane * 8) = w;
            }
            LDS_WAIT(); __builtin_amdgcn_wave_barrier();
            const v2i rv_ = __builtin_amdgcn_ds_read_tr4_b64_v2i32((LAS v2i*)(T + (F.lane & 15) * 8));
            const unsigned long long got = ((unsigned long long)(unsigned)rv_.y << 32) | (unsigned long long)(unsigned)rv_.x;
            unsigned long long want = 0ull;
            for (int j = 0; j < 16; ++j) { const unsigned long long nib = (PROBE_SUB == 0) ? (unsigned long long)j : (unsigned long long)(F.lane & 15); want |= nib << (4 * j); }
            const unsigned long long bal = __ballot(got == want);
            result = (float)__popcll(bal);
        }
        if (blockIdx.x == 0 && F.tid == 0) { VM_WAIT(); p.out[0] += result; }
    }
#elif PROBE_PHASE == 99
    {
        typedef int v8i __attribute__((ext_vector_type(8)));
        float result = 0.f;
        if (blockIdx.x == 0 && F.wave == 0) {
            const int fr_ = F.lane & 15, fq_ = F.lane >> 4;
            v8i bv;
#pragma unroll
            for (int q = 0; q < 8; ++q) { unsigned w = 0; for (int bb = 0; bb < 4; ++bb) { unsigned pcode = (unsigned)(32 * fq_ + 4 * q + bb); if (pcode == 127u) pcode = 126u; w |= pcode << (8 * bb); } bv[q] = (int)w; }
            int matches = 0, firstbad = -1, firstbadval = -1;
            for (int ga = 0; ga < 4; ++ga)
                for (int ja = 0; ja < 32; ++ja) {
                    v8i av = {0, 0, 0, 0, 0, 0, 0, 0};
                    if (fr_ == 0 && fq_ == ga) { const unsigned nib = 2u << (4 * (ja & 7)); const int wsel = ja >> 3;
                        av[0] = wsel == 0 ? (int)nib : 0; av[1] = wsel == 1 ? (int)nib : 0; av[2] = wsel == 2 ? (int)nib : 0; av[3] = wsel == 3 ? (int)nib : 0; }
                    f32x4 c = {0.f, 0.f, 0.f, 0.f};
                    c = __builtin_amdgcn_mfma_scale_f32_16x16x128_f8f6f4(av, bv, c, 4, 0, 0, 0, 0, 0);
                    int pk = 0; pk = __builtin_amdgcn_cvt_pk_fp8_f32(c[0], 0.f, pk, false);
                    const int got = __shfl(pk & 255, 0);
                    int want = 32 * ga + ja; if (want == 127) want = 126;
                    if (got == want) ++matches; else if (firstbad < 0) { firstbad = 32 * ga + ja; firstbadval = got; }
                }
#if PROBE_SUB == 0
            result = (float)matches;
#elif PROBE_SUB == 1
            result = (float)firstbad;
#else
            result = (float)firstbadval;
#endif
        }
        if (blockIdx.x == 0 && F.tid == 0) { VM_WAIT(); p.out[0] += result; }
    }
#else
#ifndef PROBE_OFF
#define PROBE_OFF 0
#endif
#ifdef ATT_ABL
    for (size_t i = (size_t)blockIdx.x * 512 + F.tid; i < (size_t)TOK * DM; i += (size_t)F.G * 512) p.out[i] = 1.0f;
    if (blockIdx.x == 0 && F.tid == 0) { VM_WAIT(); p.out[0] = ((float)(tp1 - tp0) - (float)(PROBE_OFF)) * (1.0f / (float)(PROBE_DIV)); }
#else
    if (blockIdx.x == 0 && F.tid == 0) { VM_WAIT(); p.out[0] += ((float)(tp1 - tp0) - (float)(PROBE_OFF)) * (1.0f / (float)(PROBE_DIV)); }
#endif
#endif
#endif
#undef IN
#undef SEAM
}

extern "C" void kernel_launch(void* const* d_in, const int* in_sizes, int n_in, void* d_out, int out_size, void* d_ws, size_t ws_size, hipStream_t stream) {
    static int grid = 0;
    if (grid == 0) {
        if (n_in != 22 || in_sizes[0] != TOK * DM || out_size != TOK * DM || ws_size < WS_END) {
            fprintf(stderr, "kernel_launch: unexpected shapes: n_in %d in0 %d out %d ws %zu\n", n_in, n_in > 0 ? in_sizes[0] : -1, out_size, ws_size); grid = -1; return; }
        if (hipFuncSetAttribute((const void*)fwd_kernel, hipFuncAttributeMaxDynamicSharedMemorySize, LDS_BYTES) != hipSuccess) { fprintf(stderr, "kernel_launch: hipFuncSetAttribute failed\n"); grid = -1; return; }
        int dev = 0, cus = 0, per_cu = 0;
        if (hipGetDevice(&dev) != hipSuccess || hipDeviceGetAttribute(&cus, hipDeviceAttributeMultiprocessorCount, dev) != hipSuccess) { grid = -1; return; }
        if (hipOccupancyMaxActiveBlocksPerMultiprocessor(&per_cu, (const void*)fwd_kernel, 512, LDS_BYTES) != hipSuccess || per_cu < 1) { fprintf(stderr, "kernel_launch: occupancy query failed (%d)\n", per_cu); (void)hipGetLastError(); per_cu = 1; }
        grid = cus * (per_cu > 1 ? 1 : per_cu);
    }
    if (grid < 0) return;
#if !defined(CG_FIRST_SYNC) && !defined(SELF_ZERO)
    (void)hipMemsetAsync((char*)d_ws + WS_CTL + (size_t)CW_BAR * 4, 0, (size_t)(XCD_BAR_WORDS + PACE_WORDS) * 4, stream);
#endif
    Params a{};
    for (int i = 0; i < 22; ++i) a.in[i] = (const float*)d_in[i];
    a.out = (float*)d_out; a.ws = (unsigned char*)d_ws;
#if N_LAUNCHES == 1
    a.ph_lo = 0; a.ph_hi = NPHASE;
#ifdef ATT_ABL
    a.ph_hi = 4;
#endif
#ifdef USE_COOP_LAUNCH
    { void* args[] = {&a};
      hipError_t e = hipLaunchCooperativeKernel((const void*)fwd_kernel, dim3(grid), dim3(512), args, LDS_BYTES, stream);
      if (e != hipSuccess) fprintf(stderr, "kernel_launch: cooperative launch failed: %s (grid %d)\n", hipGetErrorString(e), grid); }
#else
    hipLaunchKernelGGL(fwd_kernel, dim3(grid), dim3(512), LDS_BYTES, stream, a);
#endif
#else
    for (int ph = 0; ph < NPHASE; ++ph) {
        a.ph_lo = ph; a.ph_hi = ph + 1;
        hipLaunchKernelGGL(fwd_kernel, dim3(grid), dim3(512), LDS_BYTES, stream, a);
    }
#endif
    const hipError_t le = hipPeekAtLastError();
    if (le != hipSuccess) fprintf(stderr, "kernel_launch: launch failed: %s\n", hipGetErrorName(le));
}
```
